# Optimizing an MI355X kernel written in HIP

```python
import math
import jax
import jax.numpy as jnp
from jax import lax
import numpy as np

D_MODEL = 1024
BATCH = 2
SEQ = 8192
DEPTH = 4

GRID_W = 64
CTX_LEN = 256
HEAD_DIM = 64
MIX_W = D_MODEL // 2
N_BRANCH = 4
HY_W = MIX_W
HY_ORDER = 2
HY_SHORT = 3
HY_BANDS = 16
HY_EMB = 2 * HY_BANDS + 1
HY_HID = 64
HY_MOD_SHIFT = 0.05
HY_FAST_DECAY = 0.3
HY_SLOW_DECAY = 1.5
HY_TARGET = 1e-2
GDN_H = MIX_W // HEAD_DIM
GDN_CONV = 3
GDN_CHUNK = 64
DIFF_VD = 2 * HEAD_DIM
DIFF_H = MIX_W // DIFF_VD
NA_H = MIX_W // HEAD_DIM
NA_ROWS = 8
NA_COLS = 16
N_EXPERTS = 16
N_GROUPS = 4
TOP_K = 2
EXPERT_FF = D_MODEL // 2
MOE_BLOCK = 128
Q_BLOCK = 128
ROPE_THETA = 10000.0
LN_EPS = 1e-5
RMS_EPS = 1e-6
DN_ALPHA = (2 * DEPTH) ** 0.25
DN_BETA = (8 * DEPTH) ** -0.25
SPLIT_SIZES = (3 * HY_W, 3 * MIX_W, MIX_W, 2 * GDN_H, 2 * GDN_H, 3 * MIX_W, 3 * MIX_W, N_BRANCH * D_MODEL)
SPLIT_IDX = tuple(sum(SPLIT_SIZES[:i + 1]) for i in range(len(SPLIT_SIZES) - 1))
IN_TOTAL = sum(SPLIT_SIZES)

kernel_name = 'hybrid_diffusion_parallel_mixers_grouped_moe'


def layer_norm(x, g=None, b=None):
    xf = x.astype(jnp.float32)
    mu = jnp.mean(xf, -1, keepdims=True)
    var = jnp.mean(jnp.square(xf - mu), -1, keepdims=True)
    y = (xf - mu) * lax.rsqrt(var + LN_EPS)
    if g is not None:
        y = y * g.astype(jnp.float32) + b.astype(jnp.float32)
    return y.astype(x.dtype)


def rms_norm(x, w):
    xf = x.astype(jnp.float32)
    return xf * lax.rsqrt(jnp.mean(jnp.square(xf), -1, keepdims=True) + RMS_EPS) * w.astype(jnp.float32)


def l2_normalize(x):
    return x * lax.rsqrt(jnp.sum(jnp.square(x), -1, keepdims=True) + RMS_EPS)


def modulate(x, shift, scale):
    return layer_norm(x) * (1.0 + scale) + shift


def centred_dwconv(u, w):
    K = w.shape[-1]
    T = u.shape[1]
    up = jnp.pad(u, ((0, 0), (K // 2, K // 2), (0, 0)))
    out = up[:, 0:T, :] * w[:, 0]
    for j in range(1, K):
        out = out + up[:, j:j + T, :] * w[:, j]
    return out


def hyena_filters(L, w1, b1, w2, b2, w3, freq, deltas):
    f32 = jnp.float32
    t = jnp.linspace(0.0, 1.0, L, dtype=f32)[:, None]
    ang = 2.0 * math.pi * jnp.arange(L, dtype=f32)[:, None] / L
    bands = jnp.linspace(1e-4, HY_BANDS - 1, HY_BANDS, dtype=f32)[None, :]
    feats = jnp.concatenate([t, jnp.cos(bands * ang), -jnp.sin(bands * ang)], axis=-1)
    fr = freq.astype(f32)
    h = jnp.sin(fr * (feats @ w1.astype(f32) + b1.astype(f32)))
    h = jnp.sin(fr * (h @ w2.astype(f32) + b2.astype(f32)))
    h = (h @ w3.astype(f32)).reshape(L, 2, HY_ORDER, HY_W)
    window = jnp.exp(-t[:, :, None, None] * jnp.abs(deltas.astype(f32))) + HY_MOD_SHIFT
    h = h * window
    h_fwd, h_bwd = h[:, 0], h[:, 1]
    taps = jnp.concatenate([h_fwd, jnp.zeros_like(h_fwd[:1]), jnp.flip(h_bwd[1:], 0)], axis=0)
    taps = taps / jnp.sum(jnp.abs(taps), axis=0, keepdims=True)
    return jnp.fft.rfft(taps, axis=0)


def hyena_mix(proj, conv_w, skip, filt_f):
    L = proj.shape[1]
    u = centred_dwconv(proj, conv_w).astype(jnp.float32)
    v, x1, x2 = jnp.split(u, 3, axis=-1)
    sk = skip.astype(jnp.float32)
    z = v
    for o, gate in enumerate((x1, x2)):
        zf = jnp.fft.rfft(z, n=2 * L, axis=1)
        y = jnp.fft.irfft(zf * filt_f[:, o], n=2 * L, axis=1)[:, :L]
        z = gate * (y + z * sk[o])
    return z.astype(proj.dtype)


def gated_delta_chunks(q, k, v, g, beta, s0):
    B, T, H, _ = q.shape
    C = GDN_CHUNK
    N = T // C

    def chunks(a):
        return jnp.moveaxis(a.reshape(B, N, C, H, *a.shape[3:]), 3, 1)

    q, k, v, g, beta = chunks(q), chunks(k), chunks(v), chunks(g), chunks(beta)
    gc = jnp.cumsum(g, axis=-1)
    tri = jnp.tril(jnp.ones((C, C), bool))
    strict = jnp.tril(jnp.ones((C, C), bool), -1)
    decay = jnp.exp(jnp.where(tri, gc[..., :, None] - gc[..., None, :], -jnp.inf))
    kb = k * beta[..., None]
    A = jnp.where(strict, jnp.einsum('bhnid,bhnjd->bhnij', kb, k) * decay, 0.0)
    eye = jnp.eye(C, dtype=jnp.float32)
    Tm = lax.linalg.triangular_solve(eye + A, jnp.broadcast_to(eye, A.shape),
                                     left_side=True, lower=True, unit_diagonal=True)
    u_val = jnp.einsum('bhnij,bhnjd->bhnid', Tm, v * beta[..., None])
    w_val = jnp.einsum('bhnij,bhnjd->bhnid', Tm, kb * jnp.exp(gc)[..., None])
    intra = jnp.einsum('bhnid,bhnjd->bhnij', q, k) * decay
    q_dec = q * jnp.exp(gc)[..., None]
    g_last = gc[..., -1]
    k_dec = k * jnp.exp(g_last[..., None] - gc)[..., None]

    def step(S, xs):
        qd, w, u, att, kd, gl = xs
        v_new = u - jnp.einsum('bhcd,bhde->bhce', w, S)
        o = jnp.einsum('bhcd,bhde->bhce', qd, S) + jnp.einsum('bhij,bhje->bhie', att, v_new)
        S = S * jnp.exp(gl)[..., None, None] + jnp.einsum('bhcd,bhce->bhde', kd, v_new)
        return S, o

    xs = tuple(jnp.moveaxis(a, 2, 0) for a in (q_dec, w_val, u_val, intra, k_dec, g_last))
    s_fin, o = lax.scan(step, s0, xs)
    o = jnp.transpose(o, (1, 0, 3, 2, 4)).reshape(B, T, H, -1)
    return o, s_fin


def gdn_mix(qkv, z, a, b, conv_w, a_log, dt_bias, norm_w, init_states, with_output):
    f32 = jnp.float32
    B, T, _ = qkv.shape
    u = jax.nn.silu(centred_dwconv(qkv, conv_w).astype(f32))
    q, k, v = [t.reshape(B, T, GDN_H, HEAD_DIM) for t in jnp.split(u, 3, axis=-1)]
    q = l2_normalize(q) * HEAD_DIM ** -0.5
    k = l2_normalize(k)
    g = -jnp.exp(a_log.astype(f32)) * jax.nn.softplus(a.astype(f32).reshape(B, T, 2, GDN_H) + dt_bias.astype(f32))
    beta = jax.nn.sigmoid(b.astype(f32).reshape(B, T, 2, GDN_H))
    outs, finals = [], []
    for d in range(2):
        rev = (lambda t: jnp.flip(t, 1)) if d == 1 else (lambda t: t)
        o, s_fin = gated_delta_chunks(rev(q), rev(k), rev(v), rev(g[:, :, d]), rev(beta[:, :, d]), init_states[d])
        finals.append(s_fin)
        if with_output:
            outs.append(rev(o))
    if not with_output:
        return None, (finals[0], finals[1])
    o = rms_norm(outs[0] + outs[1], norm_w) * jax.nn.silu(z.astype(f32).reshape(B, T, GDN_H, HEAD_DIM))
    return o.reshape(B, T, GDN_H * HEAD_DIM).astype(qkv.dtype), (finals[0], finals[1])


def axial_rope_angles(n):
    t = jnp.arange(n)
    row = (t // GRID_W).astype(jnp.float32)
    col = (t % GRID_W).astype(jnp.float32)
    nf = HEAD_DIM // 4
    inv = ROPE_THETA ** (-jnp.arange(nf, dtype=jnp.float32) / nf)
    return row[:, None] * inv, col[:, None] * inv


def rope_half(x, ang):
    x1, x2 = jnp.split(x, 2, axis=-1)
    cos, sin = jnp.cos(ang).astype(x.dtype), jnp.sin(ang).astype(x.dtype)
    return jnp.concatenate([x1 * cos - x2 * sin, x1 * sin + x2 * cos], axis=-1)


def axial_rope(x, ang_r, ang_c):
    half = HEAD_DIM // 2
    ar = ang_r[None, :, None, None, :]
    ac = ang_c[None, :, None, None, :]
    return jnp.concatenate([rope_half(x[..., :half], ar), rope_half(x[..., half:], ac)], axis=-1)


def diff_attend(q, k, v, lam):
    s = jnp.einsum('bqhcd,bkhcd->bhcqk', q, k).astype(jnp.float32) * HEAD_DIM ** -0.5
    p = jax.nn.softmax(s, axis=-1)
    a = p[:, :, 0] - lam * p[:, :, 1]
    return jnp.einsum('bhqk,bkhd->bqhd', a.astype(v.dtype), v)


def diff_latent(q, k, v, kc, vc, lam, ang_r, ang_c):
    B, n = q.shape[:2]
    q = axial_rope(q, ang_r, ang_c)
    k_all = jnp.concatenate([axial_rope(k, ang_r, ang_c), kc], axis=1)
    v_all = jnp.concatenate([v, vc], axis=1)
    nb = n // Q_BLOCK
    qb = jnp.swapaxes(q.reshape(B, nb, Q_BLOCK, *q.shape[2:]), 0, 1)
    o = lax.map(lambda qi: diff_attend(qi, k_all, v_all, lam), qb)
    return jnp.swapaxes(o, 0, 1).reshape(B, n, DIFF_H, DIFF_VD)


def diff_finish(o, norm_w, lam_init):
    B, T = o.shape[:2]
    return (rms_norm(o, norm_w) * (1.0 - lam_init)).reshape(B, T, DIFF_H * DIFF_VD).astype(o.dtype)


def split_diff(p):
    B, T, _ = p.shape
    q, k, v = jnp.split(p, 3, axis=-1)
    return (q.reshape(B, T, DIFF_H, 2, HEAD_DIM), k.reshape(B, T, DIFF_H, 2, HEAD_DIM),
            v.reshape(B, T, DIFF_H, DIFF_VD))


def dense_attend(q, k, v):
    s = jnp.einsum('bqhd,bkhd->bhqk', q, k).astype(jnp.float32) * HEAD_DIM ** -0.5
    p = jax.nn.softmax(s, axis=-1)
    return jnp.einsum('bhqk,bkhd->bqhd', p.astype(v.dtype), v)


def na_latent(q, k, v, kc, vc, rpb):
    B, n, H, dh = q.shape
    R = n // GRID_W
    kh, kw = min(NA_ROWS, R), NA_COLS
    grid = lambda t: t.reshape(B, R, GRID_W, H, dh)
    kg, vg = grid(k), grid(v)
    cols = jnp.arange(GRID_W)
    cstart = jnp.clip(cols - kw // 2, 0, GRID_W - kw)
    col_ok = (cols[None, :] >= cstart[:, None]) & (cols[None, :] < cstart[:, None] + kw)
    mask = jnp.broadcast_to(col_ok[:, None, :], (GRID_W, kh, GRID_W)).reshape(GRID_W, kh * GRID_W)
    dc = jnp.clip(cols[None, :] - cols[:, None], -(kw - 1), kw - 1) + (kw - 1)
    rpb_c = rpb.astype(jnp.float32)[:, :, dc]
    scale = dh ** -0.5

    def row(args):
        r, qr = args
        rs = jnp.clip(r - kh // 2, 0, R - kh)
        kr = lax.dynamic_slice_in_dim(kg, rs, kh, axis=1).reshape(B, kh * GRID_W, H, dh)
        vr = lax.dynamic_slice_in_dim(vg, rs, kh, axis=1).reshape(B, kh * GRID_W, H, dh)
        dr = rs + jnp.arange(kh) - r + (NA_ROWS - 1)
        bias = jnp.transpose(rpb_c[:, dr], (0, 2, 1, 3)).reshape(H, GRID_W, kh * GRID_W)
        s_win = jnp.einsum('bqhd,bkhd->bhqk', qr, kr).astype(jnp.float32) * scale + bias[None]
        s_win = jnp.where(mask, s_win, -jnp.inf)
        s_ctx = jnp.einsum('bqhd,bkhd->bhqk', qr, kc).astype(jnp.float32) * scale
        p = jax.nn.softmax(jnp.concatenate([s_win, s_ctx], axis=-1), axis=-1).astype(v.dtype)
        nw = kh * GRID_W
        return (jnp.einsum('bhqk,bkhd->bqhd', p[..., :nw], vr)
                + jnp.einsum('bhqk,bkhd->bqhd', p[..., nw:], vc))

    o = lax.map(row, (jnp.arange(R), jnp.swapaxes(grid(q), 0, 1)))
    return jnp.swapaxes(o, 0, 1).reshape(B, n, H * dh)


def merge_branches(ys, gate_cols, proj, w_o):
    br = jnp.einsum('btmc,mcd->btmd', jnp.stack(ys, axis=2), proj)
    g = jax.nn.sigmoid(gate_cols.reshape(gate_cols.shape[0], gate_cols.shape[1], N_BRANCH, -1))
    return jnp.sum(g * br, axis=2) @ w_o


def moe_ffn(u, router_w, router_b, w1, w3, w2):
    n_tok, d = u.shape
    s = jax.nn.sigmoid((u @ router_w).astype(jnp.float32))
    sel = s + router_b.astype(jnp.float32)
    per = N_EXPERTS // N_GROUPS
    group_score = lax.top_k(sel.reshape(n_tok, N_GROUPS, per), TOP_K)[0].sum(-1)
    best_group = jnp.argmax(group_score, axis=-1)
    in_group = (jnp.arange(N_EXPERTS) // per)[None, :] == best_group[:, None]
    _, idx = lax.top_k(jnp.where(in_group, sel, -jnp.inf), TOP_K)
    wts = jnp.take_along_axis(s, idx, axis=-1)
    wts = wts / jnp.sum(wts, -1, keepdims=True)
    n_slot = n_tok * TOP_K
    e_flat = idx.reshape(-1).astype(jnp.int32)
    t_flat = jnp.repeat(jnp.arange(n_tok, dtype=jnp.int32), TOP_K)
    w_flat = wts.reshape(-1)
    order = jnp.argsort(e_flat)
    e_s, t_s, w_s = e_flat[order], t_flat[order], w_flat[order]
    counts = jax.ops.segment_sum(jnp.ones_like(e_flat), e_flat, num_segments=N_EXPERTS)
    padded = (counts + MOE_BLOCK - 1) // MOE_BLOCK * MOE_BLOCK
    start = jnp.cumsum(counts) - counts
    pend = jnp.cumsum(padded)
    pstart = pend - padded
    dest = pstart[e_s] + jnp.arange(n_slot, dtype=jnp.int32) - start[e_s]
    n_blk = -(-n_slot // MOE_BLOCK) + N_EXPERTS
    cap = n_blk * MOE_BLOCK
    buf_tok = jnp.full((cap,), n_tok, jnp.int32).at[dest].set(t_s)
    buf_w = jnp.zeros((cap,), jnp.float32).at[dest].set(w_s)
    blk_exp = jnp.minimum(jnp.searchsorted(pend, jnp.arange(n_blk, dtype=jnp.int32) * MOE_BLOCK, side='right'),
                          N_EXPERTS - 1)
    u_pad = jnp.concatenate([u, jnp.zeros((1, d), u.dtype)], axis=0)
    xb = u_pad[buf_tok].reshape(n_blk, MOE_BLOCK, d)

    def expert_block(args):
        xi, e = args
        return (jax.nn.silu(xi @ w1[e]) * (xi @ w3[e])) @ w2[e]

    yb = lax.map(expert_block, (xb, blk_exp)).reshape(cap, d)
    y = jax.ops.segment_sum(yb * buf_w[:, None].astype(yb.dtype), buf_tok, num_segments=n_tok + 1)
    return y[:n_tok]


def setup_inputs(seed: int = 0) -> dict:
    key = jax.random.key(seed)
    ks = iter(jax.random.split(key, 48))
    f32 = jnp.float32
    nrm = lambda shape, s: jax.random.normal(next(ks), shape, f32) * s
    D = D_MODEL
    max_decay = math.log(HY_TARGET) / HY_FAST_DECAY
    min_decay = math.log(HY_TARGET) / HY_SLOW_DECAY
    base_decay = jnp.linspace(min_decay, max_decay, HY_W, dtype=f32)
    dt = jnp.exp(jax.random.uniform(next(ks), (DEPTH, 2, GDN_H), f32, math.log(1e-3), math.log(1e-1)))
    return {
        'x': nrm((BATCH, SEQ, D), 1.0),
        'c': nrm((BATCH, D), 1.0),
        'ctx': nrm((BATCH, CTX_LEN, D), 1.0),
        'c_ctx': nrm((D,), 1.0),
        'w_mod': nrm((DEPTH, D, 6 * D), D ** -0.5),
        'b_mod': nrm((DEPTH, 6 * D), 0.02),
        'w_in': nrm((DEPTH, D, IN_TOTAL), D ** -0.5),
        'hy_conv': nrm((DEPTH, 3 * HY_W, HY_SHORT), HY_SHORT ** -0.5),
        'hy_w1': nrm((DEPTH, HY_EMB, HY_HID), HY_EMB ** -0.5),
        'hy_b1': nrm((DEPTH, HY_HID), 0.02),
        'hy_w2': nrm((DEPTH, HY_HID, HY_HID), HY_HID ** -0.5),
        'hy_b2': nrm((DEPTH, HY_HID), 0.02),
        'hy_w3': nrm((DEPTH, HY_HID, 2 * HY_ORDER * HY_W), HY_HID ** -0.5),
        'hy_freq': 1.0 + nrm((DEPTH, HY_HID), 0.02),
        'hy_deltas': base_decay * (1.0 + nrm((DEPTH, 2, HY_ORDER, HY_W), 0.02)),
        'hy_skip': nrm((DEPTH, HY_ORDER, HY_W), 0.5),
        'gdn_conv': nrm((DEPTH, 3 * MIX_W, GDN_CONV), GDN_CONV ** -0.5),
        'gdn_a_log': jnp.log(jax.random.uniform(next(ks), (DEPTH, 2, GDN_H), f32, 1.0, 16.0)),
        'gdn_dt_bias': dt + jnp.log(-jnp.expm1(-dt)),
        'gdn_norm': 1.0 + nrm((DEPTH, HEAD_DIM), 0.02),
        'diff_lam': nrm((DEPTH, 4, HEAD_DIM), 0.1),
        'diff_norm': 1.0 + nrm((DEPTH, DIFF_VD), 0.02),
        'na_rpb': nrm((DEPTH, NA_H, 2 * NA_ROWS - 1, 2 * NA_COLS - 1), 0.02),
        'branch_proj': nrm((DEPTH, N_BRANCH, MIX_W, D), MIX_W ** -0.5 * DN_BETA),
        'w_out': nrm((DEPTH, D, D), D ** -0.5 * DN_BETA),
        'ln_g': 1.0 + nrm((DEPTH, 2, D), 0.02),
        'ln_b': nrm((DEPTH, 2, D), 0.02),
        'router_w': nrm((D, N_EXPERTS), D ** -0.5),
        'router_b': nrm((N_EXPERTS,), 0.01),
        'exp_w1': nrm((DEPTH, N_EXPERTS, D, EXPERT_FF), D ** -0.5),
        'exp_w3': nrm((DEPTH, N_EXPERTS, D, EXPERT_FF), D ** -0.5),
        'exp_w2': nrm((DEPTH, N_EXPERTS, EXPERT_FF, D), EXPERT_FF ** -0.5 * DN_BETA),
    }


def reference(x, c, ctx, c_ctx, w_mod, b_mod, w_in, hy_conv, hy_w1, hy_b1, hy_w2, hy_b2, hy_w3, hy_freq,
              hy_deltas, hy_skip, gdn_conv, gdn_a_log, gdn_dt_bias, gdn_norm, diff_lam, diff_norm, na_rpb,
              branch_proj, w_out, ln_g, ln_b, router_w, router_b, exp_w1, exp_w3, exp_w2):
    B, n, D = x.shape
    m = ctx.shape[1]
    ang_r, ang_c = axial_rope_angles(n)
    zero_state = jnp.zeros((B, GDN_H, HEAD_DIM, HEAD_DIM), jnp.float32)
    xc = ctx
    for l in range(DEPTH):
        ctx_out = l < DEPTH - 1
        mx = jnp.split((jax.nn.silu(c) @ w_mod[l] + b_mod[l])[:, None, :], 6, axis=-1)
        mc = jnp.split((jax.nn.silu(c_ctx) @ w_mod[l] + b_mod[l])[None, None, :], 6, axis=-1)

        hx = modulate(x, mx[0], mx[1])
        hc = modulate(xc, mc[0], mc[1])
        hy_x, gqkv_x, gz_x, ga_x, gb_x, dqkv_x, nqkv_x, gate_x = jnp.split(hx @ w_in[l], SPLIT_IDX, axis=-1)
        hy_c, gqkv_c, gz_c, ga_c, gb_c, dqkv_c, nqkv_c, gate_c = jnp.split(hc @ w_in[l], SPLIT_IDX, axis=-1)
        filt = (hy_w1[l], hy_b1[l], hy_w2[l], hy_b2[l], hy_w3[l], hy_freq[l], hy_deltas[l])

        ya_x = hyena_mix(hy_x, hy_conv[l], hy_skip[l], hyena_filters(n, *filt))

        gdn_p = (gdn_conv[l], gdn_a_log[l], gdn_dt_bias[l], gdn_norm[l])
        yb_c, st_c = gdn_mix(gqkv_c, gz_c, ga_c, gb_c, *gdn_p, (zero_state, zero_state), ctx_out)
        yb_x, _ = gdn_mix(gqkv_x, gz_x, ga_x, gb_x, *gdn_p, st_c, True)

        lq1, lk1, lq2, lk2 = diff_lam[l].astype(jnp.float32)
        lam_init = 0.8 - 0.6 * math.exp(-0.3 * l)
        lam = jnp.exp(jnp.sum(lq1 * lk1)) - jnp.exp(jnp.sum(lq2 * lk2)) + lam_init
        dq_x, dk_x, dv_x = split_diff(dqkv_x)
        dq_c, dk_c, dv_c = split_diff(dqkv_c)
        yc_x = diff_finish(diff_latent(dq_x, dk_x, dv_x, dk_c, dv_c, lam, ang_r, ang_c), diff_norm[l], lam_init)

        nq_x, nk_x, nv_x = [t.reshape(B, n, NA_H, HEAD_DIM) for t in jnp.split(nqkv_x, 3, axis=-1)]
        nq_c, nk_c, nv_c = [t.reshape(B, m, NA_H, HEAD_DIM) for t in jnp.split(nqkv_c, 3, axis=-1)]
        yd_x = na_latent(nq_x, nk_x, nv_x, nk_c, nv_c, na_rpb[l])

        mix_x = merge_branches([ya_x, yb_x, yc_x, yd_x], gate_x, branch_proj[l], w_out[l])
        x = layer_norm(DN_ALPHA * x + mx[2] * mix_x, ln_g[l, 0], ln_b[l, 0])
        if ctx_out:
            ya_c = hyena_mix(hy_c, hy_conv[l], hy_skip[l], hyena_filters(m, *filt))
            yc_c = diff_finish(diff_attend(dq_c, dk_c, dv_c, lam), diff_norm[l], lam_init)
            yd_c = dense_attend(nq_c, nk_c, nv_c).reshape(B, m, NA_H * HEAD_DIM)
            mix_c = merge_branches([ya_c, yb_c, yc_c, yd_c], gate_c, branch_proj[l], w_out[l])
            xc = layer_norm(DN_ALPHA * xc + mc[2] * mix_c, ln_g[l, 0], ln_b[l, 0])

        h2x = modulate(x, mx[3], mx[4]).reshape(B * n, D)
        if ctx_out:
            h2c = modulate(xc, mc[3], mc[4]).reshape(B * m, D)
            y_all = moe_ffn(jnp.concatenate([h2x, h2c], axis=0), router_w, router_b, exp_w1[l], exp_w3[l], exp_w2[l])
            y_x = y_all[:B * n].reshape(B, n, D)
            y_c = y_all[B * n:].reshape(B, m, D)
            xc = layer_norm(DN_ALPHA * xc + mc[5] * y_c, ln_g[l, 1], ln_b[l, 1])
        else:
            y_x = moe_ffn(h2x, router_w, router_b, exp_w1[l], exp_w3[l], exp_w2[l]).reshape(B, n, D)
        x = layer_norm(DN_ALPHA * x + mx[5] * y_x, ln_g[l, 1], ln_b[l, 1])
    return x
```

```cpp
#ifdef CPU_EMU
#define SCHED_FENCE()
#define WAIT_LGKM()
#define WAIT_VM0()
#else
#include <hip/hip_runtime.h>
typedef short bf16x8 __attribute__((ext_vector_type(8)));
typedef float f32x4 __attribute__((ext_vector_type(4)));
#define SCHED_FENCE() __builtin_amdgcn_sched_barrier(0)
#define WAIT_LGKM() asm volatile("s_waitcnt lgkmcnt(0)" ::: "memory")
#define WAIT_VM0() asm volatile("s_waitcnt vmcnt(0)" ::: "memory")
#endif
#include <cstdint>
#include <cstddef>
#include <cstring>
#include <cstdlib>

typedef unsigned short bf16_t;
typedef unsigned int u32;
typedef u32 U2 __attribute__((ext_vector_type(2)));
typedef u32 U4 __attribute__((ext_vector_type(4)));
typedef float F4 __attribute__((ext_vector_type(4)));
typedef float F2 __attribute__((ext_vector_type(2)));

#ifdef SMALL_DIMS
constexpr int D = 256, BATCH = 2, SEQ = 1024, DEPTH = 2, CTX = 128, GRID_MAX = 8;
#else
constexpr int D = 1024, BATCH = 2, SEQ = 8192, DEPTH = 4, CTX = 256, GRID_MAX = 256;
#endif
constexpr int NTH = 512;
constexpr int GW = 64, HD = 64;
constexpr int MW = D / 2;
constexpr int HYW = MW, HY_HID = 64, HY_BANDS = 16, HY_EMB = 33;
constexpr int GH = MW / 64, DH = MW / 128, NH = MW / 64;
constexpr int NE = 16, EFF = D / 2;
constexpr int NLAT = BATCH * SEQ, NCTX = BATCH * CTX, NTOK = NLAT + NCTX;
constexpr int KEYS = SEQ + CTX;
constexpr int IN_TOTAL = 13 * MW + 4 * GH + 4 * D;
constexpr int SRC_HY = 0, SRC_GQKV = 3 * MW, SRC_GZ = 6 * MW, SRC_GA = 7 * MW, SRC_DQKV = 7 * MW + 4 * GH, SRC_NQKV = 10 * MW + 4 * GH, SRC_GATE = 13 * MW + 4 * GH;
constexpr int MY_HY = 0, MY_GQKV = 3 * MW, MY_GZ = 6 * MW, MY_DQKV = 7 * MW, MY_NQKV = 10 * MW, MY_GAB = 13 * MW, MY_GATE = 13 * MW + 128, NPROJ1 = 13 * MW + 128, NPROJ = NPROJ1 + 4 * D;
constexpr float LN_EPS = 1e-5f, RMS_EPS = 1e-6f;
constexpr int NSLOT = 2 * NTOK;
constexpr int R_ROWS = SEQ / GW;
constexpr int NCH_LAT = SEQ / 64, NCH_CTX = CTX / 64, NCH = NCH_LAT + NCH_CTX;
constexpr int NTASK_GDN = BATCH * GH * 2 * NCH;
static_assert(NTOK % 256 == 0 && MW % 128 == 0 && SEQ % 256 == 0 && CTX % 64 == 0, "dims");

constexpr size_t al256(size_t x) { return (x + 255) & ~(size_t)255; }
constexpr size_t SZ_BAR = 16384;
constexpr size_t OFF_BAR = 0;
constexpr size_t OFF_CNT = OFF_BAR + SZ_BAR;
constexpr size_t OFF_MODP = OFF_CNT + 4096;
constexpr size_t OFF_MOD = OFF_MODP + al256((size_t)DEPTH * 8 * 3 * 6 * D * 4);
constexpr size_t OFF_XS = OFF_MOD + al256((size_t)DEPTH * 3 * 6 * D * 4);
constexpr size_t OFF_H = OFF_XS + (size_t)NTOK * D * 4;
constexpr size_t OFF_GZ = OFF_H + (size_t)NTOK * D * 2;
constexpr size_t OFF_GAB = OFF_GZ + (size_t)NTOK * MW * 2;
constexpr size_t OFF_GB = OFF_GAB + (size_t)NTOK * 32 * 4;
constexpr size_t OFF_Y = OFF_GB + (size_t)NTOK * 4 * GH * 4;
constexpr size_t OFF_WIN = OFF_Y + (size_t)NTOK * 4 * MW * 2;
constexpr size_t OFF_BP = OFF_WIN + (size_t)NPROJ * D * 2;
constexpr size_t OFF_WO = OFF_BP + (size_t)D * 4 * MW * 2;
constexpr size_t OFF_H2F = OFF_WO + (size_t)D * D * 2;
constexpr size_t OFF_TOKE = OFF_H2F + al256((size_t)KEYS * 64 * 4);
constexpr size_t OFF_TOKR = OFF_TOKE + (size_t)NTOK * 2 * 4;
constexpr size_t OFF_TOKW = OFF_TOKR + (size_t)NTOK * 2 * 4;
constexpr size_t OFF_ELIST = OFF_TOKW + (size_t)NTOK * 2 * 4;
constexpr size_t OFF_RC = OFF_ELIST + (size_t)NE * NTOK * 4;
constexpr size_t OFF_DVT = OFF_RC;
constexpr size_t OFF_NVT = OFF_DVT + (size_t)BATCH * MW * KEYS * 2;
constexpr size_t OFF_GQ = OFF_NVT + (size_t)BATCH * MW * KEYS * 2;
constexpr size_t OFF_GK = OFF_GQ + (size_t)NTOK * MW * 2;
constexpr size_t OFF_GV = OFF_GK + (size_t)NTOK * MW * 2;
constexpr size_t OFF_RA = OFF_GV + (size_t)NTOK * MW * 2;
constexpr size_t SZ_SEG3 = (size_t)NTOK * 3 * MW * 2;
constexpr size_t OFF_SEG_HY = OFF_RA;
constexpr size_t OFF_SEG_GQKV = OFF_RA + SZ_SEG3;
constexpr size_t OFF_SEG_DQKV = OFF_RA + 2 * SZ_SEG3;
constexpr size_t OFF_SEG_NQKV = OFF_RA + 3 * SZ_SEG3;
constexpr size_t SZ_RA = 4 * SZ_SEG3;
constexpr size_t OFF_OF = OFF_RA;
constexpr size_t OFF_OB = OFF_OF + (size_t)NTOK * MW * 4;
constexpr size_t OFF_YAT = OFF_OB + (size_t)NTOK * MW * 4;
constexpr size_t OFF_HF = OFF_RA;
constexpr size_t OFF_ZT = OFF_HF + (size_t)GRID_MAX * 2 * SEQ * 8;
constexpr size_t OFF_SEG_GATE = OFF_RA;
constexpr size_t OFF_W13 = OFF_RA;
constexpr size_t OFF_W2 = OFF_W13 + (size_t)NE * 2 * EFF * D * 2;
static_assert(OFF_YAT + (size_t)BATCH * MW * KEYS * 2 <= OFF_SEG_DQKV, "R1 overflow");
static_assert(OFF_ZT + (size_t)GRID_MAX * 2 * SEQ * 4 <= OFF_YAT, "hyena scratch overflow");
static_assert((size_t)NTOK * 4 * D * 2 <= SZ_RA, "gate overflow");
static_assert(OFF_W2 + (size_t)NE * D * EFF * 2 <= OFF_RA + SZ_RA, "expert weights overflow");
constexpr size_t OFF_RB = OFF_RA + SZ_RA;
constexpr size_t OFF_HYT = OFF_RB;
constexpr size_t OFF_WU = OFF_HYT + (size_t)BATCH * 3 * MW * KEYS * 2;
constexpr size_t OFF_MIXG = OFF_RB;
constexpr size_t OFF_MIX = OFF_MIXG + (size_t)NTOK * D * 2;
constexpr size_t OFF_HMID = OFF_MIX + (size_t)NTOK * D * 4;
constexpr size_t OFF_YE = OFF_HMID + (size_t)(NSLOT + 256) * EFF * 2;
constexpr size_t SZ_RB_LATE = OFF_YE + (size_t)(NSLOT + 256) * D * 2 - OFF_RB;
constexpr size_t SZ_RB_EARLY = OFF_WU + (size_t)NTASK_GDN * 2 * 64 * 64 * 2 - OFF_RB;
constexpr size_t SZ_RB = SZ_RB_LATE > SZ_RB_EARLY ? SZ_RB_LATE : SZ_RB_EARLY;
constexpr size_t WS_NEED = OFF_RB + SZ_RB;

struct Params {
    const float *x, *c, *ctx, *c_ctx, *w_mod, *b_mod, *w_in, *hy_conv, *hy_w1, *hy_b1, *hy_w2, *hy_b2, *hy_w3, *hy_freq, *hy_deltas, *hy_skip,
        *gdn_conv, *gdn_a_log, *gdn_dt_bias, *gdn_norm, *diff_lam, *diff_norm, *na_rpb, *branch_proj, *w_out, *ln_g, *ln_b, *router_w, *router_b,
        *exp_w1, *exp_w3, *exp_w2;
    float* out; char* ws; long long stop_phase;
};

#ifdef CPU_EMU
#define TID() ((int)threadIdx.x)
#define BID() ((int)blockIdx.x)
#else
__device__ __forceinline__ int TID() { int t = threadIdx.x; asm volatile("" : "+v"(t)); return t; }
__device__ __forceinline__ int BID() { int t = blockIdx.x; asm volatile("" : "+s"(t)); return t; }
#endif
__device__ __forceinline__ u32 f2u(float f) { union { float f; u32 u; } c; c.f = f; return c.u; }
__device__ __forceinline__ float u2f(u32 u) { union { float f; u32 u; } c; c.u = u; return c.f; }
__device__ __forceinline__ bf16_t f2bf(float f) { u32 u = f2u(f); u += 0x7fffu + ((u >> 16) & 1u); return (bf16_t)(u >> 16); }
__device__ __forceinline__ float bf2f(bf16_t h) { return u2f(((u32)h) << 16); }
__device__ __forceinline__ u32 pack2(float lo, float hi) { return (u32)f2bf(lo) | ((u32)f2bf(hi) << 16); }
__device__ __forceinline__ float bflo(u32 w) { return u2f(w << 16); }
__device__ __forceinline__ float bfhi(u32 w) { return u2f(w & 0xffff0000u); }
__device__ __forceinline__ float siluf(float x) { return x / (1.0f + __expf(-x)); }
__device__ __forceinline__ float sigmoidf(float x) { return 1.0f / (1.0f + __expf(-x)); }
__device__ __forceinline__ float wave_sum(float v) { for (int o = 32; o; o >>= 1) v += __shfl_xor(v, o); return v; }
__device__ __forceinline__ float wave_max(float v) { for (int o = 32; o; o >>= 1) v = fmaxf(v, __shfl_xor(v, o)); return v; }
__device__ __forceinline__ bf16x8 ld8(const bf16_t* p) { return *(const bf16x8*)p; }
__device__ __forceinline__ bf16x8 mk8(U2 a, U2 b) { union { struct { U2 a, b; } s; bf16x8 v; } c; c.s.a = a; c.s.b = b; return c.v; }
__device__ __forceinline__ bf16x8 mk8u(u32 a, u32 b, u32 c0, u32 d) { union { u32 u[4]; bf16x8 v; } c; c.u[0] = a; c.u[1] = b; c.u[2] = c0; c.u[3] = d; return c.v; }
#define MFMA16(a, b, c) __builtin_amdgcn_mfma_f32_16x16x32_bf16(a, b, c, 0, 0, 0)
__device__ __forceinline__ int mod_row(int tok) { return tok < NLAT ? tok / SEQ : 2; }
__device__ __forceinline__ void tok_bk(int tok, int& b, int& key) { if (tok < NLAT) { b = tok / SEQ; key = tok - b * SEQ; } else { int t = tok - NLAT; b = t / CTX; key = SEQ + t - b * CTX; } }
__device__ __forceinline__ int bk_tok(int b, int key) { return key < SEQ ? b * SEQ + key : NLAT + b * CTX + (key - SEQ); }
#ifdef CPU_EMU
struct XcdBarrier { int dummy; };
#define GSYNC() emu_grid_sync()
#else
#define XB_TMO      128
#define XB_XCNT(j)  (256  + 64 * (j))
#define XB_XSUB(j)  (1280 + 64 * (j))
#define XB_XGEN(j)  (2304 + 64 * (j))
#define XB_TOP      3328
#define XB_TOPGEN   3392
#define XCD_BAR_WORDS 3456
#define XB_SPIN_CAP (1u << 22)
#define LAS __attribute__((address_space(3)))
__device__ __forceinline__ unsigned xb_ld(unsigned* p)              { return __hip_atomic_load(p, __ATOMIC_RELAXED, __HIP_MEMORY_SCOPE_AGENT); }
__device__ __forceinline__ unsigned xb_add(unsigned* p, unsigned v) { return __hip_atomic_fetch_add(p, v, __ATOMIC_RELAXED, __HIP_MEMORY_SCOPE_AGENT); }
__device__ __forceinline__ unsigned xb_xcc_id() { return (unsigned)__builtin_amdgcn_s_getreg((3 << 11) | 20) & 0xFu; }
#define XB_SPIN(cond, bar) do { unsigned _sp = 0; while (cond) { __builtin_amdgcn_s_sleep(1); \
    if ((++_sp & 255u) == 0u) { if (xb_ld(&(bar)[XB_TMO])) break; if (_sp > XB_SPIN_CAP) { atomicAdd(&(bar)[XB_TMO], 1u); break; } } } } while (0)
struct XcdBarrier { unsigned* bar; unsigned x; volatile LAS unsigned* st; };
__device__ __forceinline__ XcdBarrier xcd_barrier_post(unsigned* bar, volatile LAS unsigned* st) {
    XcdBarrier b; b.bar = bar; b.x = xb_xcc_id(); b.st = st;
    if (threadIdx.x == 0) (void)xb_add(&bar[XB_XCNT(b.x)], 1u);
    return b;
}
__device__ __forceinline__ void xcd_barrier_complete(unsigned* bar, unsigned x, unsigned& nloc, unsigned& nx) {
    const unsigned G = gridDim.x * gridDim.y * gridDim.z;
    unsigned sum, cnt, mine, sp = 0u;
    for (;;) {
        sum = 0u; cnt = 0u; mine = 0u;
#pragma unroll
        for (unsigned j = 0; j < 16; ++j) { const unsigned c = xb_ld(&bar[XB_XCNT(j)]); sum += c; cnt += (c > 0u) ? 1u : 0u; mine = (j == x) ? c : mine; }
        if (sum == G) break;
        __builtin_amdgcn_s_sleep(1);
        if ((++sp & 255u) == 0u) { if (xb_ld(&bar[XB_TMO])) break; if (sp > XB_SPIN_CAP) { atomicAdd(&bar[XB_TMO], 1u); break; } }
    }
    nloc = mine > 0u ? mine : 1u; nx = cnt > 0u ? cnt : 1u;
}
__device__ __forceinline__ void xcd_barrier(const XcdBarrier& b) {
    asm volatile("s_waitcnt vmcnt(0)" ::: "memory");
    __syncthreads();
    if (threadIdx.x == 0) {
        unsigned* bar = b.bar;
        __builtin_amdgcn_s_waitcnt(0);
        unsigned nloc = b.st[0], nx = b.st[1];
        if (nloc == 0u) { xcd_barrier_complete(bar, b.x, nloc, nx); b.st[0] = nloc; b.st[1] = nx; }
        const unsigned old = xb_add(&bar[XB_XSUB(b.x)], 1u);
        const unsigned gen = old / nloc;
        if (old + 1u == (gen + 1u) * nloc) {
            __builtin_amdgcn_fence(__ATOMIC_RELEASE, "agent");
            asm volatile("s_waitcnt vmcnt(0)" ::: "memory");
            const unsigned og = xb_add(&bar[XB_TOP], 1u);
            const unsigned tg = og / nx;
            if (og + 1u == (tg + 1u) * nx) xb_add(&bar[XB_TOPGEN], 1u);
            else XB_SPIN(xb_ld(&bar[XB_TOPGEN]) == tg, bar);
            __builtin_amdgcn_fence(__ATOMIC_ACQUIRE, "agent");
            xb_add(&bar[XB_XGEN(b.x)], 1u);
            asm volatile("s_waitcnt vmcnt(0)" ::: "memory");
        } else {
            XB_SPIN(xb_ld(&bar[XB_XGEN(b.x)]) == gen, bar);
            __builtin_amdgcn_fence(__ATOMIC_ACQUIRE, "agent");
            asm volatile("s_waitcnt vmcnt(0)" ::: "memory");
        }
    }
    __syncthreads();
}
#define GSYNC() xcd_barrier(xbar)
#endif

constexpr int G_BM = 256, G_BN = 128, G_BK = 64, G_LD = 72;
constexpr int G_STAGE = (G_BM + G_BN) * G_LD * 2;
constexpr int G_LDS = 2 * G_STAGE;

template <int MT = 4, class ARow>
__device__ __forceinline__ void gemm_tile(char* lds, ARow arow  , const bf16_t* Bt, long ldb, int K, f32x4 (&acc)[MT][4]) {
    const int tid = TID(), wid = tid >> 6, lane = tid & 63, wm = wid >> 1, wn = wid & 1, l15 = lane & 15, g = lane >> 4;
#pragma unroll
    for (int m = 0; m < MT; ++m)
#pragma unroll
        for (int n = 0; n < 4; ++n) acc[m][n] = (f32x4){0.f, 0.f, 0.f, 0.f};
    const bf16_t* ap[MT]; const bf16_t* bp[2];
#pragma unroll
    for (int i = 0; i < MT; ++i) { int pc = tid + i * NTH; int r = pc >> 3, s = pc & 7; ap[i] = arow(r) + s * 8; }
#pragma unroll
    for (int i = 0; i < 2; ++i) { int pc = tid + i * NTH; int r = pc >> 3, s = pc & 7; bp[i] = Bt + (long)r * ldb + s * 8; }
    U4 ra[MT], rb[2];
    const int nk = K / G_BK;
#pragma unroll
    for (int i = 0; i < MT; ++i) ra[i] = *(const U4*)(ap[i]);
#pragma unroll
    for (int i = 0; i < 2; ++i) rb[i] = *(const U4*)(bp[i]);
    __syncthreads();
    {
        bf16_t* sA = (bf16_t*)lds; bf16_t* sB = sA + G_BM * G_LD;
#pragma unroll
        for (int i = 0; i < MT; ++i) { int pc = tid + i * NTH; int r = pc >> 3, s = pc & 7; *(U4*)(sA + r * G_LD + s * 8) = ra[i]; }
#pragma unroll
        for (int i = 0; i < 2; ++i) { int pc = tid + i * NTH; int r = pc >> 3, s = pc & 7; *(U4*)(sB + r * G_LD + s * 8) = rb[i]; }
    }
    __syncthreads();
    for (int kt = 0; kt < nk; ++kt) {
        const bool more = kt + 1 < nk;
        if (more) {
#pragma unroll
            for (int i = 0; i < MT; ++i) ra[i] = *(const U4*)(ap[i] + (kt + 1) * G_BK);
#pragma unroll
            for (int i = 0; i < 2; ++i) rb[i] = *(const U4*)(bp[i] + (kt + 1) * G_BK);
        }
        const bf16_t* sA = (const bf16_t*)(lds + (kt & 1) * G_STAGE); const bf16_t* sB = sA + G_BM * G_LD;
#pragma unroll
        for (int ks = 0; ks < 2; ++ks) {
            bf16x8 af[MT], bfr[4];
#pragma unroll
            for (int m = 0; m < MT; ++m) af[m] = ld8(sA + (wm * 16 * MT + m * 16 + l15) * G_LD + ks * 32 + g * 8);
#pragma unroll
            for (int n = 0; n < 4; ++n) bfr[n] = ld8(sB + (wn * 64 + n * 16 + l15) * G_LD + ks * 32 + g * 8);
#pragma unroll
            for (int m = 0; m < MT; ++m)
#pragma unroll
                for (int n = 0; n < 4; ++n) acc[m][n] = MFMA16(bfr[n], af[m], acc[m][n]);
        }
        if (more) {
            bf16_t* dA = (bf16_t*)(lds + ((kt + 1) & 1) * G_STAGE); bf16_t* dB = dA + G_BM * G_LD;
#pragma unroll
            for (int i = 0; i < MT; ++i) { int pc = tid + i * NTH; int r = pc >> 3, s = pc & 7; *(U4*)(dA + r * G_LD + s * 8) = ra[i]; }
#pragma unroll
            for (int i = 0; i < 2; ++i) { int pc = tid + i * NTH; int r = pc >> 3, s = pc & 7; *(U4*)(dB + r * G_LD + s * 8) = rb[i]; }
        }
        __syncthreads();
    }
}

template <class SrcFn>
__device__ __forceinline__ void cvt_tile(char* lds, SrcFn srcp, int k0, int n0, bf16_t* dst, long dst_ld) {
    float* t = (float*)lds;
    const int tid = TID();
    __syncthreads();
#pragma unroll
    for (int i = 0; i < 2; ++i) { int kk = (tid >> 4) + 32 * i, n4 = (tid & 15) * 4; const float* sp = srcp(k0 + kk, n0 + n4);
        F4 v = sp ? *(const F4*)sp : (F4){0.f, 0.f, 0.f, 0.f};
        t[kk * 65 + n4] = v.x; t[kk * 65 + n4 + 1] = v.y; t[kk * 65 + n4 + 2] = v.z; t[kk * 65 + n4 + 3] = v.w; }
    __syncthreads();
    { int n = tid >> 3, k8 = (tid & 7) * 8; U4 o;
        o.x = pack2(t[(k8 + 0) * 65 + n], t[(k8 + 1) * 65 + n]); o.y = pack2(t[(k8 + 2) * 65 + n], t[(k8 + 3) * 65 + n]);
        o.z = pack2(t[(k8 + 4) * 65 + n], t[(k8 + 5) * 65 + n]); o.w = pack2(t[(k8 + 6) * 65 + n], t[(k8 + 7) * 65 + n]);
        *(U4*)(dst + (long)(n0 + n) * dst_ld + k0 + k8) = o; }
}

__device__ __forceinline__ void tr_tile(char* lds, const bf16_t* src, long ld, int tok0, int col0, int ncols, int cdst0, bf16_t* dst) {
    bf16_t* t = (bf16_t*)lds;
    const int tid = TID();
    __syncthreads();
    { int r = tid >> 3, s = tid & 7; *(U4*)(t + r * 72 + s * 8) = *(const U4*)(src + (long)(tok0 + r) * ld + col0 + s * 8); }
    __syncthreads();
    { int c = tid >> 3, t8 = (tid & 7) * 8; int b, key; tok_bk(tok0, b, key);
        U4 o; o.x = (u32)t[(t8 + 0) * 72 + c] | ((u32)t[(t8 + 1) * 72 + c] << 16); o.y = (u32)t[(t8 + 2) * 72 + c] | ((u32)t[(t8 + 3) * 72 + c] << 16);
        o.z = (u32)t[(t8 + 4) * 72 + c] | ((u32)t[(t8 + 5) * 72 + c] << 16); o.w = (u32)t[(t8 + 6) * 72 + c] | ((u32)t[(t8 + 7) * 72 + c] << 16);
        *(U4*)(dst + ((long)b * ncols + cdst0 + c) * KEYS + key + t8) = o; }
}
#define WSP(T, off) ((T*)(p.ws + (off)))
constexpr float DN_ALPHA_F =
#ifdef SMALL_DIMS
    1.4142135623730951f;
#else
    1.681792830507429f;
#endif

__device__ __forceinline__ void phase_prologue(const Params& p, char* lds) {
    const int tid = TID(), G = gridDim.x, bid = BID();
    float* XS = WSP(float, OFF_XS);
    for (long i = (long)bid * NTH + tid; i < (long)NTOK * D / 4; i += (long)G * NTH) {
        long e = i * 4; F4 v = e < (long)NLAT * D ? *(const F4*)(p.x + e) : *(const F4*)(p.ctx + (e - (long)NLAT * D));
        *(F4*)(XS + e) = v;
    }
    float* sc = (float*)lds;
    for (int i = tid; i < 3 * D; i += NTH) { int r = i / D, k = i - r * D; float v = r < 2 ? p.c[r * D + k] : p.c_ctx[k]; sc[i] = siluf(v); }
    __syncthreads();
    float* MODP = WSP(float, OFF_MODP);
    constexpr int NCHK = 6 * D / NTH, KS = D / 8;
    for (int it = bid; it < DEPTH * 8 * NCHK; it += G) {
        int l = it / (8 * NCHK), rem = it - l * 8 * NCHK, s = rem / NCHK, ch = rem - s * NCHK;
        int n = ch * NTH + tid; const float* w = p.w_mod + ((long)l * D + s * KS) * 6 * D + n;
        float a0 = 0.f, a1 = 0.f, a2 = 0.f;
#pragma unroll 8
        for (int k = 0; k < KS; ++k) { float wv = w[(long)k * 6 * D]; a0 += sc[s * KS + k] * wv; a1 += sc[D + s * KS + k] * wv; a2 += sc[2 * D + s * KS + k] * wv; }
        float* o = MODP + (((long)l * 8 + s) * 3) * 6 * D + n; o[0] = a0; o[6 * D] = a1; o[12 * D] = a2;
    }
}

__device__ __forceinline__ void phase_weights(const Params& p, char* lds, int l) {
    const int tid = TID(), G = gridDim.x, bid = BID(), lane = tid & 63, wid = tid >> 6;
    if (l == 0) {
        const float* MODP = WSP(float, OFF_MODP); float* MOD = WSP(float, OFF_MOD);
        for (int i = bid * NTH + tid; i < DEPTH * 3 * 6 * D; i += G * NTH) { int ll = i / (18 * D), rem = i - ll * 18 * D, n = rem % (6 * D);
            float a = p.b_mod[ll * 6 * D + n];
#pragma unroll
            for (int s = 0; s < 8; ++s) a += MODP[((long)ll * 8 + s) * 18 * D + rem];
            MOD[i] = a; }
    }
    if (bid == 0 && tid < 64) WSP(u32, OFF_CNT)[tid] = 0u;
    constexpr int U_WIN = (NPROJ / 64) * (D / 64), U_BP = 4 * (MW / 64) * (D / 64), U_WO = (D / 64) * (D / 64);
    for (int u = bid; u < U_WIN + U_BP + U_WO; u += G) {
        if (u < U_WIN) { int nt = u / (D / 64), kt = u - nt * (D / 64); const float* src = p.w_in + (long)l * D * IN_TOTAL;
            auto sp = [&](int k, int n) -> const float* { int sc;
                if (n < MY_DQKV) sc = n; else if (n < MY_GAB) sc = n + 4 * GH; else if (n < MY_GATE) { int j = n - MY_GAB; if (j >= 4 * GH) return nullptr; sc = SRC_GA + j; } else sc = SRC_GATE + (n - MY_GATE);
                return src + (long)k * IN_TOTAL + sc; };
            cvt_tile(lds, sp, kt * 64, nt * 64, WSP(bf16_t, OFF_WIN), D);
        } else if (u < U_WIN + U_BP) { int v = u - U_WIN; int m = v / ((MW / 64) * (D / 64)), r = v - m * ((MW / 64) * (D / 64)), nt = r / (MW / 64), kt = r - nt * (MW / 64);
            const float* src = p.branch_proj + ((long)(l * 4 + m) * MW) * D;
            auto sp = [&](int k, int n) -> const float* { return src + (long)k * D + n; };
            cvt_tile(lds, sp, kt * 64, nt * 64, WSP(bf16_t, OFF_BP) + m * MW, 4 * MW);
        } else { int v = u - U_WIN - U_BP; int nt = v / (D / 64), kt = v - nt * (D / 64); const float* src = p.w_out + (long)l * D * D;
            auto sp = [&](int k, int n) -> const float* { return src + (long)k * D + n; };
            cvt_tile(lds, sp, kt * 64, nt * 64, WSP(bf16_t, OFF_WO), D);
        }
    }
    float* H2F = WSP(float, OFF_H2F);
    const float* w1 = p.hy_w1 + (long)l * HY_EMB * 64; const float* b1 = p.hy_b1 + l * 64; const float* w2 = p.hy_w2 + (long)l * 64 * 64; const float* b2 = p.hy_b2 + l * 64; const float fr = p.hy_freq[l * 64 + lane];
    for (int pos = bid * 8 + wid; pos < KEYS; pos += G * 8) {
        int L = pos < SEQ ? SEQ : CTX, t = pos < SEQ ? pos : pos - SEQ;
        float feat = 0.f;
        if (lane == 0) feat = (float)t / (float)(L - 1);
        else if (lane < 33) { int bi = (lane - 1) & 15; float band = 1e-4f + (float)bi * ((15.0f - 1e-4f) / 15.0f); float ang = 6.283185307179586f * (float)t / (float)L; float a = band * ang;
            feat = lane < 17 ? cosf(a) : -sinf(a); }
        float a1 = b1[lane];
        for (int e = 0; e < HY_EMB; ++e) a1 += __shfl(feat, e) * w1[e * 64 + lane];
        float h1 = sinf(fr * a1);
        float a2 = b2[lane];
        for (int i = 0; i < 64; ++i) a2 += __shfl(h1, i) * w2[i * 64 + lane];
        H2F[(long)pos * 64 + lane] = sinf(fr * a2);
    }
}

__device__ __forceinline__ void phase_expert_weights(const Params& p, char* lds, int l) {
    const int G = gridDim.x, bid = BID();
    constexpr int U13 = (2 * EFF / 64) * (D / 64), U2_ = (D / 64) * (EFF / 64);
    for (int u = bid; u < NE * (U13 + U2_); u += G) {
        int e = u / (U13 + U2_), v = u - e * (U13 + U2_);
        if (v < U13) { int nt = v / (D / 64), kt = v - nt * (D / 64);
            const float* s1 = p.exp_w1 + ((long)(l * NE + e) * D) * EFF; const float* s3 = p.exp_w3 + ((long)(l * NE + e) * D) * EFF;
            const long d13 = (long)((uintptr_t)s1 - (uintptr_t)s3);
            auto sp = [&](int k, int n) -> const float* { int grp = n >> 5, w = n & 31; return (const float*)((uintptr_t)s3 + (uintptr_t)(w < 16 ? d13 : 0L)) + (long)k * EFF + grp * 16 + (w & 15); };
            cvt_tile(lds, sp, kt * 64, nt * 64, WSP(bf16_t, OFF_W13) + (long)e * 2 * EFF * D, D);
        } else { int w = v - U13; int nt = w / (EFF / 64), kt = w - nt * (EFF / 64); const float* s2 = p.exp_w2 + ((long)(l * NE + e) * EFF) * D;
            auto sp = [&](int k, int n) -> const float* { return s2 + (long)k * D + n; };
            cvt_tile(lds, sp, kt * 64, nt * 64, WSP(bf16_t, OFF_W2) + (long)e * D * EFF, EFF);
        }
    }
}

constexpr int RV = D / 256;
__device__ __forceinline__ void row_stats(const F4 (&v)[RV], float& mean, float& rstd) {
    float s = 0.f;
#pragma unroll
    for (int i = 0; i < RV; ++i) s += (v[i].x + v[i].y) + (v[i].z + v[i].w);
    mean = wave_sum(s) * (1.0f / D);
    float q = 0.f;
#pragma unroll
    for (int i = 0; i < RV; ++i) { float a = v[i].x - mean, b = v[i].y - mean, c = v[i].z - mean, d = v[i].w - mean; q += (a * a + b * b) + (c * c + d * d); }
    rstd = rsqrtf(wave_sum(q) * (1.0f / D) + LN_EPS);
}
__device__ __forceinline__ void row_modulate_store(const F4 (&v)[RV], float mean, float rstd, const float* shift, const float* scale, bf16_t* dst, int lane, F4 (*keep)[RV] = nullptr) {
#pragma unroll
    for (int i = 0; i < RV; ++i) { int n = (i * 64 + lane) * 4; F4 sh = *(const F4*)(shift + n), sc = *(const F4*)(scale + n);
        F4 h; h.x = (v[i].x - mean) * rstd * (1.0f + sc.x) + sh.x; h.y = (v[i].y - mean) * rstd * (1.0f + sc.y) + sh.y; h.z = (v[i].z - mean) * rstd * (1.0f + sc.z) + sh.z; h.w = (v[i].w - mean) * rstd * (1.0f + sc.w) + sh.w;
        U2 o; o.x = pack2(h.x, h.y); o.y = pack2(h.z, h.w); *(U2*)(dst + n) = o; if (keep) (*keep)[i] = h; }
}

__device__ __forceinline__ void phase_modulate0(const Params& p, int l) {
    const int tid = TID(), lane = tid & 63, wid = tid >> 6;
    const float* XS = WSP(float, OFF_XS); bf16_t* H = WSP(bf16_t, OFF_H); const float* MOD = WSP(float, OFF_MOD) + (long)l * 18 * D;
    for (int row = BID() * 8 + wid; row < NTOK; row += gridDim.x * 8) {
        F4 v[RV];
#pragma unroll
        for (int i = 0; i < RV; ++i) v[i] = *(const F4*)(XS + (long)row * D + (i * 64 + lane) * 4);
        float mean, rstd; row_stats(v, mean, rstd);
        const float* m = MOD + mod_row(row) * 6 * D;
        row_modulate_store(v, mean, rstd, m, m + D, H + (long)row * D, lane);
    }
}

__device__ __forceinline__ void phase_post_mix(const Params& p, int l) {
    const int tid = TID(), lane = tid & 63, wid = tid >> 6;
    float* XS = WSP(float, OFF_XS); const float* MIX = WSP(float, OFF_MIX); bf16_t* H = WSP(bf16_t, OFF_H); const float* MOD = WSP(float, OFF_MOD) + (long)l * 18 * D;
    const float* lng = p.ln_g + (long)(l * 2 + 0) * D; const float* lnb = p.ln_b + (long)(l * 2 + 0) * D;
    u32* CNT = WSP(u32, OFF_CNT); int* TOKE = WSP(int, OFF_TOKE); int* TOKR = WSP(int, OFF_TOKR); float* TOKW = WSP(float, OFF_TOKW); int* ELIST = WSP(int, OFF_ELIST);
    const int nrows = (l == DEPTH - 1) ? NLAT : NTOK;
    for (int row = BID() * 8 + wid; row < nrows; row += gridDim.x * 8) {
        const float* m = MOD + mod_row(row) * 6 * D;
        F4 v[RV];
#pragma unroll
        for (int i = 0; i < RV; ++i) { int n = (i * 64 + lane) * 4; F4 x = *(const F4*)(XS + (long)row * D + n), mx = *(const F4*)(MIX + (long)row * D + n), g2 = *(const F4*)(m + 2 * D + n);
            v[i].x = DN_ALPHA_F * x.x + g2.x * mx.x; v[i].y = DN_ALPHA_F * x.y + g2.y * mx.y; v[i].z = DN_ALPHA_F * x.z + g2.z * mx.z; v[i].w = DN_ALPHA_F * x.w + g2.w * mx.w; }
        float mean, rstd; row_stats(v, mean, rstd);
#pragma unroll
        for (int i = 0; i < RV; ++i) { int n = (i * 64 + lane) * 4; F4 g = *(const F4*)(lng + n), b = *(const F4*)(lnb + n);
            v[i].x = (v[i].x - mean) * rstd * g.x + b.x; v[i].y = (v[i].y - mean) * rstd * g.y + b.y; v[i].z = (v[i].z - mean) * rstd * g.z + b.z; v[i].w = (v[i].w - mean) * rstd * g.w + b.w;
            *(F4*)(XS + (long)row * D + n) = v[i]; }
        row_stats(v, mean, rstd);
        F4 h[RV];
        row_modulate_store(v, mean, rstd, m + 3 * D, m + 4 * D, H + (long)row * D, lane, &h);
        float lg[16];
#pragma unroll
        for (int e = 0; e < 16; ++e) lg[e] = 0.f;
#pragma unroll
        for (int i = 0; i < RV; ++i) { int n = (i * 64 + lane) * 4; const float hv[4] = {h[i].x, h[i].y, h[i].z, h[i].w};
#pragma unroll
            for (int j = 0; j < 4; ++j) { const float* rw = p.router_w + (long)(n + j) * 16;
#pragma unroll
                for (int q = 0; q < 4; ++q) { F4 w = *(const F4*)(rw + q * 4); lg[q * 4] += hv[j] * w.x; lg[q * 4 + 1] += hv[j] * w.y; lg[q * 4 + 2] += hv[j] * w.z; lg[q * 4 + 3] += hv[j] * w.w; } } }
        float s[16], sel[16];
#pragma unroll
        for (int e = 0; e < 16; ++e) { lg[e] = wave_sum(lg[e]); s[e] = sigmoidf(lg[e]); sel[e] = s[e] + p.router_b[e]; }
        float gs[4];
#pragma unroll
        for (int gq = 0; gq < 4; ++gq) { float a = sel[gq * 4], b = sel[gq * 4 + 1], c = sel[gq * 4 + 2], d = sel[gq * 4 + 3];
            float m1 = fmaxf(fmaxf(a, b), fmaxf(c, d)); float lo_ab = fminf(a, b), hi_ab = fmaxf(a, b), lo_cd = fminf(c, d), hi_cd = fmaxf(c, d);
            float m2 = fmaxf(fminf(hi_ab, hi_cd), fmaxf(lo_ab, lo_cd)); gs[gq] = m1 + m2; }
        int bg = 0; float bv = gs[0];
#pragma unroll
        for (int gq = 1; gq < 4; ++gq) if (gs[gq] > bv) { bv = gs[gq]; bg = gq; }
        float c0 = 0.f, c1 = 0.f, c2 = 0.f, c3 = 0.f, t0 = 0.f, t1 = 0.f, t2 = 0.f, t3 = 0.f;
#pragma unroll
        for (int gq = 0; gq < 4; ++gq) if (gq == bg) { c0 = sel[gq * 4]; c1 = sel[gq * 4 + 1]; c2 = sel[gq * 4 + 2]; c3 = sel[gq * 4 + 3]; t0 = s[gq * 4]; t1 = s[gq * 4 + 1]; t2 = s[gq * 4 + 2]; t3 = s[gq * 4 + 3]; }
        int i0 = 0; float v0 = c0, w0 = t0;
        if (c1 > v0) { v0 = c1; i0 = 1; w0 = t1; } if (c2 > v0) { v0 = c2; i0 = 2; w0 = t2; } if (c3 > v0) { v0 = c3; i0 = 3; w0 = t3; }
        int i1 = -1; float v1 = -3.0e38f, w1 = 0.f;
        if (i0 != 0 && c0 > v1) { v1 = c0; i1 = 0; w1 = t0; } if (i0 != 1 && c1 > v1) { v1 = c1; i1 = 1; w1 = t1; } if (i0 != 2 && c2 > v1) { v1 = c2; i1 = 2; w1 = t2; } if (i0 != 3 && c3 > v1) { v1 = c3; i1 = 3; w1 = t3; }
        if (lane == 0) { float ws = w0 + w1; int e0 = bg * 4 + i0, e1 = bg * 4 + i1;
            int r0 = (int)atomicAdd(&CNT[e0], 1u), r1 = (int)atomicAdd(&CNT[e1], 1u);
            ELIST[(long)e0 * NTOK + r0] = row; ELIST[(long)e1 * NTOK + r1] = row;
            TOKE[row * 2] = e0; TOKE[row * 2 + 1] = e1; TOKR[row * 2] = r0; TOKR[row * 2 + 1] = r1; TOKW[row * 2] = w0 / ws; TOKW[row * 2 + 1] = w1 / ws; }
    }
}

__device__ __forceinline__ void phase_post_moe(const Params& p, int l) {
    const int tid = TID(), lane = tid & 63, wid = tid >> 6;
    float* XS = WSP(float, OFF_XS); bf16_t* H = WSP(bf16_t, OFF_H); const float* MOD = WSP(float, OFF_MOD) + (long)l * 18 * D;
    const bf16_t* YE = WSP(bf16_t, OFF_YE);
    const float* lng = p.ln_g + (long)(l * 2 + 1) * D; const float* lnb = p.ln_b + (long)(l * 2 + 1) * D;
    const u32* CNT = WSP(u32, OFF_CNT); const int* TOKE = WSP(int, OFF_TOKE); const int* TOKR = WSP(int, OFF_TOKR); const float* TOKW = WSP(float, OFF_TOKW);
    const bool last = (l == DEPTH - 1);
    const int nrows = last ? NLAT : NTOK;
    int eoff = 0;
    { int c = lane < 16 ? (int)CNT[lane] : 0; int incl = c;
        for (int o = 1; o < 16; o <<= 1) { int t = __shfl_up(incl, o); if (lane >= o) incl += t; }
        eoff = incl - c; }
    for (int row = BID() * 8 + wid; row < nrows; row += gridDim.x * 8) {
        const float* m = MOD + mod_row(row) * 6 * D;
        int e0 = TOKE[row * 2], e1 = TOKE[row * 2 + 1];
        long p0 = (long)__shfl(eoff, e0) + TOKR[row * 2], p1 = (long)__shfl(eoff, e1) + TOKR[row * 2 + 1];
        float w0 = TOKW[row * 2], w1 = TOKW[row * 2 + 1];
        F4 v[RV];
#pragma unroll
        for (int i = 0; i < RV; ++i) { int n = (i * 64 + lane) * 4; F4 x = *(const F4*)(XS + (long)row * D + n), g5 = *(const F4*)(m + 5 * D + n);
            U2 a = *(const U2*)(YE + p0 * D + n), b = *(const U2*)(YE + p1 * D + n);
            float y0 = w0 * bflo(a.x) + w1 * bflo(b.x), y1 = w0 * bfhi(a.x) + w1 * bfhi(b.x), y2 = w0 * bflo(a.y) + w1 * bflo(b.y), y3 = w0 * bfhi(a.y) + w1 * bfhi(b.y);
            v[i].x = DN_ALPHA_F * x.x + g5.x * y0; v[i].y = DN_ALPHA_F * x.y + g5.y * y1; v[i].z = DN_ALPHA_F * x.z + g5.z * y2; v[i].w = DN_ALPHA_F * x.w + g5.w * y3; }
        float mean, rstd; row_stats(v, mean, rstd);
        float* dst = last ? p.out + (long)row * D : XS + (long)row * D;
#pragma unroll
        for (int i = 0; i < RV; ++i) { int n = (i * 64 + lane) * 4; F4 g = *(const F4*)(lng + n), b = *(const F4*)(lnb + n);
            v[i].x = (v[i].x - mean) * rstd * g.x + b.x; v[i].y = (v[i].y - mean) * rstd * g.y + b.y; v[i].z = (v[i].z - mean) * rstd * g.z + b.z; v[i].w = (v[i].w - mean) * rstd * g.w + b.w;
            *(F4*)(dst + n) = v[i]; }
        if (!last) { row_stats(v, mean, rstd); const float* m2 = m + 18 * D; row_modulate_store(v, mean, rstd, m2, m2 + D, H + (long)row * D, lane); }
    }
}
__device__ __forceinline__ void st4bf(bf16_t* dst, f32x4 v) { U2 o; o.x = pack2(v[0], v[1]); o.y = pack2(v[2], v[3]); *(U2*)dst = o; }

__device__ __forceinline__ void phase_inproj(const Params& p, char* lds, int part  ) {
    const int tid = TID(), wid = tid >> 6, lane = tid & 63, wm = wid >> 1, wn = wid & 1, l15 = lane & 15, g = lane >> 4;
    const bf16_t* H = WSP(bf16_t, OFF_H); const bf16_t* W = WSP(bf16_t, OFF_WIN);
    const int ncol0 = part == 0 ? 0 : NPROJ1, ncols = part == 0 ? NPROJ1 : 4 * D, ntn = ncols / G_BN, ntm = NTOK / G_BM;
    for (int u = BID(); u < ntm * ntn; u += gridDim.x) {
        const int tn = u / ntm, tm = u - tn * ntm;
        const int row0 = tm * G_BM, col0 = ncol0 + tn * G_BN;
        f32x4 acc[4][4];
        gemm_tile(lds, [&](int r) { return H + (long)(row0 + r) * D; }, W + (long)col0 * D, D, D, acc);
        const int cw = col0 + wn * 64;
        bf16_t* dst; int ld, cl;
        if (cw < MY_GQKV) { dst = WSP(bf16_t, OFF_SEG_HY); ld = 3 * MW; cl = cw - MY_HY; }
        else if (cw < MY_GZ) { dst = WSP(bf16_t, OFF_SEG_GQKV); ld = 3 * MW; cl = cw - MY_GQKV; }
        else if (cw < MY_DQKV) { dst = WSP(bf16_t, OFF_GZ); ld = MW; cl = cw - MY_GZ; }
        else if (cw < MY_NQKV) { dst = WSP(bf16_t, OFF_SEG_DQKV); ld = 3 * MW; cl = cw - MY_DQKV; }
        else if (cw < MY_GAB) { dst = WSP(bf16_t, OFF_SEG_NQKV); ld = 3 * MW; cl = cw - MY_NQKV; }
        else if (cw < MY_GATE) { dst = nullptr; ld = 32; cl = cw - MY_GAB; }
        else { dst = WSP(bf16_t, OFF_SEG_GATE); ld = 4 * D; cl = cw - MY_GATE; }
        if (dst) {
#pragma unroll
            for (int m = 0; m < 4; ++m) { long row = row0 + wm * 64 + m * 16 + l15;
#pragma unroll
                for (int n = 0; n < 4; ++n) st4bf(dst + row * ld + cl + n * 16 + g * 4, acc[m][n]); }
        } else if (cl == 0) {
            float* GAB = WSP(float, OFF_GAB);
#pragma unroll
            for (int m = 0; m < 4; ++m) { long row = row0 + wm * 64 + m * 16 + l15;
#pragma unroll
                for (int n = 0; n < 2; ++n) { F4 o; o.x = acc[m][n][0]; o.y = acc[m][n][1]; o.z = acc[m][n][2]; o.w = acc[m][n][3]; *(F4*)(GAB + row * 32 + n * 16 + g * 4) = o; } }
        }
    }
}

__device__ __forceinline__ void phase_prep(const Params& p, char* lds, int l) {
    const int tid = TID(), G = gridDim.x, bid = BID(), lane = tid & 63, wid = tid >> 6;
    constexpr int TT = NTOK / 64, CT_HY = 3 * MW / 64, CT_V = MW / 64, U_TR = TT * (CT_HY + 2 * CT_V);
    for (int u = bid; u < U_TR; u += G) {
        int tt = u % TT, c = u / TT;
        if (c < CT_HY) tr_tile(lds, WSP(bf16_t, OFF_SEG_HY), 3 * MW, tt * 64, c * 64, 3 * MW, c * 64, WSP(bf16_t, OFF_HYT));
        else if (c < CT_HY + CT_V) { int cc = c - CT_HY; tr_tile(lds, WSP(bf16_t, OFF_SEG_DQKV), 3 * MW, tt * 64, 2 * MW + cc * 64, MW, cc * 64, WSP(bf16_t, OFF_DVT)); }
        else { int cc = c - CT_HY - CT_V; tr_tile(lds, WSP(bf16_t, OFF_SEG_NQKV), 3 * MW, tt * 64, 2 * MW + cc * 64, MW, cc * 64, WSP(bf16_t, OFF_NVT)); }
    }
    {
        bf16_t* DQ = WSP(bf16_t, OFF_SEG_DQKV);
        constexpr int NV = 4 * DH;
        for (long i = (long)bid * NTH + tid; i < (long)NLAT * 32; i += (long)G * NTH) {
            int tok = (int)(i >> 5), f2 = (int)(i & 31);
            int t = tok % SEQ; int axis = f2 >> 4, f = f2 & 15;
            float pos = axis == 0 ? (float)(t / GW) : (float)(t % GW);
            float inv = powf(10000.0f, -(float)f / 16.0f);
            float ang = pos * inv, sn = sinf(ang), cs = cosf(ang);
            bf16_t* base = DQ + (long)tok * 3 * MW + axis * 32 + f;
#pragma unroll
            for (int v = 0; v < NV; ++v) { bf16_t* q = base + v * 64; float x1 = bf2f(q[0]), x2 = bf2f(q[16]); q[0] = f2bf(x1 * cs - x2 * sn); q[16] = f2bf(x1 * sn + x2 * cs); }
        }
    }
    {
        const bf16_t* SG = WSP(bf16_t, OFF_SEG_GQKV); bf16_t* GQ = WSP(bf16_t, OFF_GQ); bf16_t* GK = WSP(bf16_t, OFF_GK); bf16_t* GV = WSP(bf16_t, OFF_GV);
        const float* cw = p.gdn_conv + (long)l * 3 * MW * 3;
        for (long i = (long)bid * 8 + wid; i < (long)NTOK * GH; i += (long)G * 8) {
            int tok = (int)(i / GH), h = (int)(i - (long)tok * GH);
            int seq0, len; if (tok < NLAT) { seq0 = (tok / SEQ) * SEQ; len = SEQ; } else { seq0 = NLAT + ((tok - NLAT) / CTX) * CTX; len = CTX; }
            int t = tok - seq0; bool hasp = t > 0, hasn = t + 1 < len;
            float u[3];
#pragma unroll
            for (int part = 0; part < 3; ++part) { int c = part * MW + h * 64 + lane; const bf16_t* s = SG + (long)tok * 3 * MW + c;
                float a = bf2f(s[0]) * cw[c * 3 + 1];
                if (hasp) a += bf2f(s[-3 * MW]) * cw[c * 3 + 0];
                if (hasn) a += bf2f(s[3 * MW]) * cw[c * 3 + 2];
                u[part] = siluf(a); }
            float nq = wave_sum(u[0] * u[0]), nk = wave_sum(u[1] * u[1]);
            GQ[(long)tok * MW + h * 64 + lane] = f2bf(u[0] * rsqrtf(nq + RMS_EPS) * 0.125f);
            GK[(long)tok * MW + h * 64 + lane] = f2bf(u[1] * rsqrtf(nk + RMS_EPS));
            GV[(long)tok * MW + h * 64 + lane] = f2bf(u[2]);
        }
        const float* GAB = WSP(float, OFF_GAB); float* GB = WSP(float, OFF_GB);
        for (long i = (long)bid * NTH + tid; i < (long)NTOK * 2 * GH; i += (long)G * NTH) {
            int tok = (int)(i / (2 * GH)), dh = (int)(i - (long)tok * 2 * GH);
            float a = GAB[(long)tok * 32 + dh], b = GAB[(long)tok * 32 + 2 * GH + dh];
            float xa = a + p.gdn_dt_bias[l * 2 * GH + dh]; float sp = xa > 20.f ? xa : log1pf(__expf(xa));
            GB[(long)tok * 4 * GH + dh] = -__expf(p.gdn_a_log[l * 2 * GH + dh]) * sp;
            GB[(long)tok * 4 * GH + 2 * GH + dh] = sigmoidf(b);
        }
    }
}
constexpr int A_LD = 72;
template <int DV> struct AttnLds { static constexpr int K_BYTES = 64 * A_LD * 2, V_BYTES = DV * A_LD * 2, STAGE = K_BYTES + V_BYTES, TOTAL = 2 * STAGE; };
constexpr float LOG2E = 1.4426950408889634f;
constexpr float NEG_BIG = -1.0e30f;

template <int NQT, int DV, class QRow, class KTile, class MaskFn>
__device__ __forceinline__ void attn_core(char* lds, QRow qrow  , KTile ktile  ,
                                          int ntiles, MaskFn mask  , f32x4 (&oacc)[DV / 16][NQT], float (&lsum)[NQT]) {
    const int tid = TID(), wid = tid >> 6, lane = tid & 63, l15 = lane & 15, g = lane >> 4;
    constexpr int NDT = DV / 16, NVL = DV / 64;
    typedef AttnLds<DV> L;
    bf16x8 qf[NQT][2];
#pragma unroll
    for (int qt = 0; qt < NQT; ++qt) { const bf16_t* q = qrow(wid * NQT * 16 + qt * 16 + l15);
#pragma unroll
        for (int ks = 0; ks < 2; ++ks) qf[qt][ks] = ld8(q + ks * 32 + g * 8); }
    float mrun[NQT];
#pragma unroll
    for (int qt = 0; qt < NQT; ++qt) { mrun[qt] = NEG_BIG; lsum[qt] = 0.f;
#pragma unroll
        for (int dt = 0; dt < NDT; ++dt) oacc[dt][qt] = (f32x4){0.f, 0.f, 0.f, 0.f}; }
    const int sr = tid >> 3, ss = tid & 7;
    U4 rk, rv[NVL];
    { const bf16_t *kp, *vp; long kld, vld; ktile(0, kp, kld, vp, vld);
        rk = *(const U4*)(kp + (long)sr * kld + ss * 8);
#pragma unroll
        for (int i = 0; i < NVL; ++i) rv[i] = *(const U4*)(vp + (long)(sr + 64 * i) * vld + ss * 8); }
    __syncthreads();
    { bf16_t* sK = (bf16_t*)lds; bf16_t* sV = (bf16_t*)(lds + L::K_BYTES);
        *(U4*)(sK + sr * A_LD + ss * 8) = rk;
#pragma unroll
        for (int i = 0; i < NVL; ++i) *(U4*)(sV + (sr + 64 * i) * A_LD + ss * 8) = rv[i]; }
    __syncthreads();
    for (int t = 0; t < ntiles; ++t) {
        const bool more = t + 1 < ntiles;
        if (more) { const bf16_t *kp, *vp; long kld, vld; ktile(t + 1, kp, kld, vp, vld);
            rk = *(const U4*)(kp + (long)sr * kld + ss * 8);
#pragma unroll
            for (int i = 0; i < NVL; ++i) rv[i] = *(const U4*)(vp + (long)(sr + 64 * i) * vld + ss * 8); }
        const bf16_t* sK = (const bf16_t*)(lds + (t & 1) * L::STAGE); const bf16_t* sV = (const bf16_t*)(lds + (t & 1) * L::STAGE + L::K_BYTES);
        f32x4 s[4][NQT];
#pragma unroll
        for (int mt = 0; mt < 4; ++mt) {
#pragma unroll
            for (int qt = 0; qt < NQT; ++qt) s[mt][qt] = (f32x4){0.f, 0.f, 0.f, 0.f};
#pragma unroll
            for (int ks = 0; ks < 2; ++ks) { bf16x8 kf = ld8(sK + (mt * 16 + l15) * A_LD + ks * 32 + g * 8);
#pragma unroll
                for (int qt = 0; qt < NQT; ++qt) s[mt][qt] = MFMA16(kf, qf[qt][ks], s[mt][qt]); }
        }
        bf16x8 pf[2][NQT];
#pragma unroll
        for (int qt = 0; qt < NQT; ++qt) {
            const int qi = wid * NQT * 16 + qt * 16 + l15;
            float mx = NEG_BIG;
#pragma unroll
            for (int mt = 0; mt < 4; ++mt)
#pragma unroll
                for (int j = 0; j < 4; ++j) { float v = mask(t, mt * 16 + g * 4 + j, qi, s[mt][qt][j] * (0.125f * LOG2E)); s[mt][qt][j] = v; mx = fmaxf(mx, v); }
            mx = fmaxf(mx, __shfl_xor(mx, 16)); mx = fmaxf(mx, __shfl_xor(mx, 32));
            const float mnew = fmaxf(mrun[qt], mx), alpha = exp2f(mrun[qt] - mnew); mrun[qt] = mnew;
            float ps = 0.f;
#pragma unroll
            for (int mt = 0; mt < 4; ++mt)
#pragma unroll
                for (int j = 0; j < 4; ++j) { float pv = exp2f(s[mt][qt][j] - mnew); s[mt][qt][j] = pv; ps += pv; }
            lsum[qt] = lsum[qt] * alpha + ps;
#pragma unroll
            for (int dt = 0; dt < NDT; ++dt) oacc[dt][qt] *= alpha;
#pragma unroll
            for (int kb = 0; kb < 2; ++kb) pf[kb][qt] = mk8u(pack2(s[2 * kb][qt][0], s[2 * kb][qt][1]), pack2(s[2 * kb][qt][2], s[2 * kb][qt][3]),
                                                             pack2(s[2 * kb + 1][qt][0], s[2 * kb + 1][qt][1]), pack2(s[2 * kb + 1][qt][2], s[2 * kb + 1][qt][3]));
        }
#pragma unroll
        for (int dt = 0; dt < NDT; ++dt)
#pragma unroll
            for (int kb = 0; kb < 2; ++kb) { const bf16_t* vr = sV + (dt * 16 + l15) * A_LD + kb * 32 + g * 4;
                bf16x8 vf = mk8(*(const U2*)vr, *(const U2*)(vr + 16));
#pragma unroll
                for (int qt = 0; qt < NQT; ++qt) oacc[dt][qt] = MFMA16(vf, pf[kb][qt], oacc[dt][qt]); }
        if (more) { bf16_t* dK = (bf16_t*)(lds + ((t + 1) & 1) * L::STAGE); bf16_t* dV = (bf16_t*)(lds + ((t + 1) & 1) * L::STAGE + L::K_BYTES);
            *(U4*)(dK + sr * A_LD + ss * 8) = rk;
#pragma unroll
            for (int i = 0; i < NVL; ++i) *(U4*)(dV + (sr + 64 * i) * A_LD + ss * 8) = rv[i]; }
        __syncthreads();
    }
#pragma unroll
    for (int qt = 0; qt < NQT; ++qt) { float l = lsum[qt]; l += __shfl_xor(l, 16); l += __shfl_xor(l, 32); lsum[qt] = l; }
}

struct NoMask { __device__ __forceinline__ float operator()(int, int, int, float s) const { return s; } };

template <int NQT>
__device__ __forceinline__ void diff_attn_item(const Params& p, char* lds, int l, int b, int h, int q0, bool ctxq, float lam, float lam_init) {
    const int tid = TID(), wid = tid >> 6, lane = tid & 63, l15 = lane & 15, g = lane >> 4;
    const bf16_t* DQ = WSP(bf16_t, OFF_SEG_DQKV); const bf16_t* DVT = WSP(bf16_t, OFF_DVT); bf16_t* Y = WSP(bf16_t, OFF_Y);
    const int tok_q0 = ctxq ? NLAT + b * CTX + q0 : b * SEQ + q0;
    const int t_first = ctxq ? SEQ / 64 : 0, ntiles = ctxq ? CTX / 64 : KEYS / 64;
    f32x4 o1[8][NQT]; float l1[NQT];
    {
        auto qrow = [&](int i) { return DQ + (long)(tok_q0 + i) * 3 * MW + h * 128; };
        auto kt = [&](int t, const bf16_t*& kp, long& kld, const bf16_t*& vp, long& vld) { int tt = t_first + t; int tok = bk_tok(b, tt * 64);
            kp = DQ + (long)tok * 3 * MW + MW + h * 128; kld = 3 * MW; vp = DVT + ((long)b * MW + h * 128) * KEYS + tt * 64; vld = KEYS; };
        attn_core<NQT, 128>(lds, qrow, kt, ntiles, NoMask(), o1, l1);
    }
    U2 o1p[8][NQT];
#pragma unroll
    for (int qt = 0; qt < NQT; ++qt) { float inv = 1.0f / l1[qt];
#pragma unroll
        for (int dt = 0; dt < 8; ++dt) { f32x4 v = o1[dt][qt] * inv; o1p[dt][qt].x = pack2(v[0], v[1]); o1p[dt][qt].y = pack2(v[2], v[3]); } }
    f32x4 o2[8][NQT]; float l2[NQT];
    {
        auto qrow = [&](int i) { return DQ + (long)(tok_q0 + i) * 3 * MW + h * 128 + 64; };
        auto kt = [&](int t, const bf16_t*& kp, long& kld, const bf16_t*& vp, long& vld) { int tt = t_first + t; int tok = bk_tok(b, tt * 64);
            kp = DQ + (long)tok * 3 * MW + MW + h * 128 + 64; kld = 3 * MW; vp = DVT + ((long)b * MW + h * 128) * KEYS + tt * 64; vld = KEYS; };
        attn_core<NQT, 128>(lds, qrow, kt, ntiles, NoMask(), o2, l2);
    }
    const float* nw = p.diff_norm + l * 128;
#pragma unroll
    for (int qt = 0; qt < NQT; ++qt) { float inv = lam / l2[qt]; float ss = 0.f;
#pragma unroll
        for (int dt = 0; dt < 8; ++dt) { f32x4 a = (f32x4){bflo(o1p[dt][qt].x), bfhi(o1p[dt][qt].x), bflo(o1p[dt][qt].y), bfhi(o1p[dt][qt].y)}; o2[dt][qt] = a - o2[dt][qt] * inv;
#pragma unroll
            for (int j = 0; j < 4; ++j) ss += o2[dt][qt][j] * o2[dt][qt][j]; }
        ss += __shfl_xor(ss, 16); ss += __shfl_xor(ss, 32);
        const float r = rsqrtf(ss * (1.0f / 128.0f) + RMS_EPS) * (1.0f - lam_init);
        const long row = tok_q0 + wid * NQT * 16 + qt * 16 + l15;
#pragma unroll
        for (int dt = 0; dt < 8; ++dt) { F4 w = *(const F4*)(nw + dt * 16 + g * 4); f32x4 v = o2[dt][qt];
            v[0] *= r * w.x; v[1] *= r * w.y; v[2] *= r * w.z; v[3] *= r * w.w;
            st4bf(Y + row * 4 * MW + 2 * MW + h * 128 + dt * 16 + g * 4, v); }
    }
}

struct NaMask {
    const float* rpb;
    int r0, rs0, nct;
    __device__ __forceinline__ float operator()(int t, int kk, int qi, float s) const {
        if (t < nct) return s;
        const int kr = rs0 + (t - nct), kc = kk, qr = r0 + (qi >> 6), qc = qi & 63;
        int rs = qr - 4; rs = rs < 0 ? 0 : (rs > R_ROWS - 8 ? R_ROWS - 8 : rs);
        int cs = qc - 8; cs = cs < 0 ? 0 : (cs > GW - 16 ? GW - 16 : cs);
        const bool ok = (kr >= rs) && (kr < rs + 8) && (kc >= cs) && (kc < cs + 16);
        int dc = kc - qc; dc = dc < -15 ? -15 : (dc > 15 ? 15 : dc);
        int dr = kr - qr + 7; dr = dr < 0 ? 0 : (dr > 14 ? 14 : dr);
        return ok ? s + rpb[dr * 31 + dc + 15] : NEG_BIG;
    }
};
__device__ __forceinline__ void na_attn_item(const Params& p, char* lds, int l, int b, int h, int rp) {
    const int tid = TID(), wid = tid >> 6, lane = tid & 63, l15 = lane & 15, g = lane >> 4;
    const bf16_t* NQ = WSP(bf16_t, OFF_SEG_NQKV); const bf16_t* NVT = WSP(bf16_t, OFF_NVT); bf16_t* Y = WSP(bf16_t, OFF_Y);
    float* rpb = (float*)(lds + AttnLds<64>::TOTAL);
    __syncthreads();
    for (int i = tid; i < 15 * 31; i += NTH) rpb[i] = p.na_rpb[((long)(l * NH + h) * 15) * 31 + i] * LOG2E;
    const int r0 = rp * 2; int rs0 = r0 - 4; rs0 = rs0 < 0 ? 0 : (rs0 > R_ROWS - 8 ? R_ROWS - 8 : rs0);
    int nwin = R_ROWS - rs0; nwin = nwin > 9 ? 9 : nwin;
    constexpr int NCT = CTX / 64;
    NaMask mk; mk.rpb = rpb; mk.r0 = r0; mk.rs0 = rs0; mk.nct = NCT;
    const int tok_q0 = b * SEQ + r0 * 64;
    auto qrow = [&](int i) { return NQ + (long)(tok_q0 + i) * 3 * MW + h * 64; };
    auto kt = [&](int t, const bf16_t*& kp, long& kld, const bf16_t*& vp, long& vld) { int key = t < NCT ? SEQ + t * 64 : (rs0 + t - NCT) * 64; int tok = bk_tok(b, key);
        kp = NQ + (long)tok * 3 * MW + MW + h * 64; kld = 3 * MW; vp = NVT + ((long)b * MW + h * 64) * KEYS + key; vld = KEYS; };
    f32x4 o[4][1]; float ls[1];
    attn_core<1, 64>(lds, qrow, kt, NCT + nwin, mk, o, ls);
    const float inv = 1.0f / ls[0]; const long row = tok_q0 + wid * 16 + l15;
#pragma unroll
    for (int dt = 0; dt < 4; ++dt) { f32x4 v = o[dt][0] * inv; st4bf(Y + row * 4 * MW + 3 * MW + h * 64 + dt * 16 + g * 4, v); }
}
__device__ __forceinline__ void na_ctx_item(const Params& p, char* lds, int b, int h, int q0) {
    const int tid = TID(), wid = tid >> 6, lane = tid & 63, l15 = lane & 15, g = lane >> 4;
    const bf16_t* NQ = WSP(bf16_t, OFF_SEG_NQKV); const bf16_t* NVT = WSP(bf16_t, OFF_NVT); bf16_t* Y = WSP(bf16_t, OFF_Y);
    const int tok_q0 = NLAT + b * CTX + q0;
    auto qrow = [&](int i) { return NQ + (long)(tok_q0 + i) * 3 * MW + h * 64; };
    auto kt = [&](int t, const bf16_t*& kp, long& kld, const bf16_t*& vp, long& vld) { int key = SEQ + t * 64; int tok = bk_tok(b, key);
        kp = NQ + (long)tok * 3 * MW + MW + h * 64; kld = 3 * MW; vp = NVT + ((long)b * MW + h * 64) * KEYS + key; vld = KEYS; };
    f32x4 o[4][1]; float ls[1];
    attn_core<1, 64>(lds, qrow, kt, CTX / 64, NoMask(), o, ls);
    const float inv = 1.0f / ls[0]; const long row = tok_q0 + wid * 16 + l15;
#pragma unroll
    for (int dt = 0; dt < 4; ++dt) { f32x4 v = o[dt][0] * inv; st4bf(Y + row * 4 * MW + 3 * MW + h * 64 + dt * 16 + g * 4, v); }
}
static_assert(NTASK_GDN % 4 == 0, "gdn tasks");
__device__ __forceinline__ void gdn_decode(int chain, int n, int& b, int& h, int& dir, int& base, int& T, int& c) {
    dir = chain & 1; int bh = chain >> 1; h = bh % GH; b = bh / GH;
    if (n < NCH_CTX) { base = NLAT + b * CTX; T = CTX; c = n; } else { base = b * SEQ; T = SEQ; c = n - NCH_CTX; }
}
__device__ __forceinline__ int gdn_pos(int dir, int T, int c, int i) { int r = 64 * c + i; return dir ? T - 1 - r : r; }

constexpr int GP_K = 0, GP_V = 9216, GP_A = 18432, GP_F = GP_A + 64 * 64 * 4, GP_PAIR = GP_F + 1024;
__device__ __forceinline__ void gdn_chunk_prep4(const Params& p, char* lds, int l, int task0) {
    const int tid = TID(), wid = tid >> 6, lane = tid & 63, l15 = lane & 15, g = lane >> 4, pr = wid >> 1, w2 = wid & 1, t2 = tid & 127;
    const int task = task0 + pr, chain = task / NCH, n = task - chain * NCH;
    int b, h, dir, base, T, c; gdn_decode(chain, n, b, h, dir, base, T, c);
    char* L = lds + pr * GP_PAIR;
    bf16_t* Kt = (bf16_t*)(L + GP_K); bf16_t* Vt = (bf16_t*)(L + GP_V); float* Af = (float*)(L + GP_A); float* gcs = (float*)(L + GP_F); float* bet = gcs + 64; float* fac = gcs + 128;
    const bf16_t* GK = WSP(bf16_t, OFF_GK); const bf16_t* GV = WSP(bf16_t, OFF_GV); const float* GB = WSP(float, OFF_GB);
    __syncthreads();
#pragma unroll
    for (int q = 0; q < 4; ++q) { int pc = t2 + 128 * q, i = pc >> 3, s = pc & 7; long tok = base + gdn_pos(dir, T, c, i);
        *(U4*)(Kt + i * 72 + s * 8) = *(const U4*)(GK + tok * MW + h * 64 + s * 8);
        *(U4*)(Vt + i * 72 + s * 8) = *(const U4*)(GV + tok * MW + h * 64 + s * 8); }
    if (w2 == 0) { long tok = base + gdn_pos(dir, T, c, lane); float gi = GB[tok * 4 * GH + dir * GH + h], be = GB[tok * 4 * GH + 2 * GH + dir * GH + h];
        float cs = gi;
        for (int o = 1; o < 64; o <<= 1) { float t = __shfl_up(cs, o); if (lane >= o) cs += t; }
        gcs[lane] = cs; bet[lane] = be; fac[lane] = be * __expf(cs); }
    __syncthreads();
#pragma unroll
    for (int mi = 0; mi < 2; ++mi) { const int mt = w2 * 2 + mi;
        bf16x8 af[2];
#pragma unroll
        for (int ks = 0; ks < 2; ++ks) af[ks] = ld8(Kt + (mt * 16 + l15) * 72 + ks * 32 + g * 8);
#pragma unroll
        for (int nt = 0; nt < 4; ++nt) { f32x4 acc = (f32x4){0.f, 0.f, 0.f, 0.f};
#pragma unroll
            for (int ks = 0; ks < 2; ++ks) acc = MFMA16(af[ks], ld8(Kt + (nt * 16 + l15) * 72 + ks * 32 + g * 8), acc);
            const int jj = nt * 16 + l15; const float gj = gcs[jj];
#pragma unroll
            for (int j = 0; j < 4; ++j) { const int i = mt * 16 + g * 4 + j; Af[i * 64 + jj] = jj < i ? bet[i] * acc[j] * __expf(gcs[i] - gj) : 0.f; } }
    }
    __syncthreads();
    {
        const bf16_t* src = w2 == 0 ? Kt : Vt; const float* scl = w2 == 0 ? fac : bet;
        float x[64];
#pragma unroll
        for (int i = 0; i < 64; ++i) x[i] = scl[i] * bf2f(src[i * 72 + lane]);
#pragma unroll
        for (int j = 0; j < 63; ++j) { const float xj = x[j];
            const float* Afj = Af + j;
#ifndef CPU_EMU
            { int z; asm volatile("v_mov_b32 %0, 0" : "=v"(z) : "v"(xj)); Afj += z; }
#endif
#pragma unroll
            for (int i = j + 1; i < 64; ++i) x[i] -= Afj[i * 64] * xj; }
        bf16_t* dst = WSP(bf16_t, OFF_WU) + ((long)task * 2 + w2) * 4096 + lane;
#pragma unroll
        for (int i = 0; i < 64; ++i) dst[i * 64] = f2bf(x[i]);
    }
}

constexpr int GS_W = 0, GS_Q = 9216, GS_K = 18432, GS_KT = 27648, GS_GC = 36864, GS_STAGE = 36864 + 512;
constexpr int GS_ST = 2 * GS_STAGE, GS_VNT = GS_ST + 2 * 4608, GS_VNT2 = GS_VNT + 4608, GS_ATT = GS_VNT2 + 4608, GS_TOTAL = GS_ATT + 9216;
__device__ __forceinline__ void phase_gdn_scan(const Params& p, char* lds, int l) {
    const int tid = TID(), bid = BID(), wid = tid >> 6, lane = tid & 63, l15 = lane & 15, g = lane >> 4, mt = wid >> 1, nt = wid & 1;
    constexpr int NCHAIN = BATCH * GH * 2;
    for (int cb = bid; cb < NCHAIN * 2; cb += (int)gridDim.x) {
    const int chain = cb >> 1, half = cb & 1;
    const bf16_t* GQ = WSP(bf16_t, OFF_GQ); const bf16_t* GK = WSP(bf16_t, OFF_GK); const float* GB = WSP(float, OFF_GB); const bf16_t* WU = WSP(bf16_t, OFF_WU);
    const int sr = tid >> 3, ss = tid & 7;
    f32x4 sacc = (f32x4){0.f, 0.f, 0.f, 0.f};
    U4 rw, rq, rk; float ucur[4], unext[4]; float gnext = 0.f;
    auto load_chunk = [&](int n) {
        int b, h, dir, base, T, c; gdn_decode(chain, n, b, h, dir, base, T, c);
        const long task = (long)chain * NCH + n; const long tok = base + gdn_pos(dir, T, c, sr);
        rw = *(const U4*)(WU + (task * 2 + 0) * 4096 + sr * 64 + ss * 8);
        rq = *(const U4*)(GQ + tok * MW + h * 64 + ss * 8);
        rk = *(const U4*)(GK + tok * MW + h * 64 + ss * 8);
#pragma unroll
        for (int j = 0; j < 4; ++j) unext[j] = bf2f(WU[(task * 2 + 1) * 4096 + (mt * 16 + g * 4 + j) * 64 + half * 32 + nt * 16 + l15]);
        if (wid == 0) { const long tk = base + gdn_pos(dir, T, c, lane); gnext = GB[tk * 4 * GH + dir * GH + h]; }
    };
    auto store_chunk = [&](int st) {
        char* S = lds + st * GS_STAGE;
        *(U4*)((bf16_t*)(S + GS_W) + sr * 72 + ss * 8) = rw;
        *(U4*)((bf16_t*)(S + GS_Q) + sr * 72 + ss * 8) = rq;
        *(U4*)((bf16_t*)(S + GS_K) + sr * 72 + ss * 8) = rk;
        bf16_t* KT = (bf16_t*)(S + GS_KT);
        const u32 kw[4] = {rk.x, rk.y, rk.z, rk.w};
#pragma unroll
        for (int e = 0; e < 4; ++e) { KT[(ss * 8 + 2 * e) * 72 + sr] = (bf16_t)(kw[e] & 0xffffu); KT[(ss * 8 + 2 * e + 1) * 72 + sr] = (bf16_t)(kw[e] >> 16); }
        if (wid == 0) { float cs = gnext;
            for (int o = 1; o < 64; o <<= 1) { float t = __shfl_up(cs, o); if (lane >= o) cs += t; }
            ((float*)(S + GS_GC))[lane] = cs; }
    };
    __syncthreads();
    { bf16_t* ST0 = (bf16_t*)(lds + GS_ST); for (int i = tid; i < 32 * 72; i += NTH) ST0[i] = 0; }
    load_chunk(0); store_chunk(0);
#pragma unroll
    for (int j = 0; j < 4; ++j) ucur[j] = unext[j];
    __syncthreads();
    for (int n = 0; n < NCH; ++n) {
        const int st = n & 1;
        if (n + 1 < NCH) load_chunk(n + 1);
        const char* S = lds + st * GS_STAGE;
        const bf16_t* Wt = (const bf16_t*)(S + GS_W); const bf16_t* Qt = (const bf16_t*)(S + GS_Q); const bf16_t* Kt = (const bf16_t*)(S + GS_K); const bf16_t* KT = (const bf16_t*)(S + GS_KT);
        const float* gc = (const float*)(S + GS_GC);
        const bf16_t* STc = (const bf16_t*)(lds + GS_ST + st * 4608); bf16_t* STn = (bf16_t*)(lds + GS_ST + (st ^ 1) * 4608);
        bf16_t* VNT = (bf16_t*)(lds + GS_VNT); bf16_t* VNT2 = (bf16_t*)(lds + GS_VNT2); bf16_t* ATT = (bf16_t*)(lds + GS_ATT);
        const float gl = gc[63];
#pragma unroll
        for (int q = 0; q < 2; ++q) { const int tile = wid * 2 + q, it = tile >> 2, jt = tile & 3;
            f32x4 acc = (f32x4){0.f, 0.f, 0.f, 0.f};
            if (jt <= it) {
#pragma unroll
                for (int ks = 0; ks < 2; ++ks) acc = MFMA16(ld8(Kt + (jt * 16 + l15) * 72 + ks * 32 + g * 8), ld8(Qt + (it * 16 + l15) * 72 + ks * 32 + g * 8), acc);
            }
            const int i = it * 16 + l15; const float gi = gc[i]; float v[4];
#pragma unroll
            for (int j = 0; j < 4; ++j) { const int jp = jt * 16 + g * 4 + j; v[j] = jp <= i ? acc[j] * __expf(gi - gc[jp]) : 0.f; }
            U2 o; o.x = pack2(v[0], v[1]); o.y = pack2(v[2], v[3]); *(U2*)(ATT + i * 72 + jt * 16 + g * 4) = o; }
        {
            f32x4 acc = (f32x4){0.f, 0.f, 0.f, 0.f};
#pragma unroll
            for (int ks = 0; ks < 2; ++ks) acc = MFMA16(ld8(Wt + (mt * 16 + l15) * 72 + ks * 32 + g * 8), ld8(STc + (nt * 16 + l15) * 72 + ks * 32 + g * 8), acc);
            float vn[4], vn2[4];
#pragma unroll
            for (int j = 0; j < 4; ++j) { vn[j] = ucur[j] - acc[j]; vn2[j] = vn[j] * __expf(gl - gc[mt * 16 + g * 4 + j]); }
            U2 o; o.x = pack2(vn[0], vn[1]); o.y = pack2(vn[2], vn[3]); *(U2*)(VNT + (nt * 16 + l15) * 72 + mt * 16 + g * 4) = o;
            U2 o2; o2.x = pack2(vn2[0], vn2[1]); o2.y = pack2(vn2[2], vn2[3]); *(U2*)(VNT2 + (nt * 16 + l15) * 72 + mt * 16 + g * 4) = o2;
        }
        __syncthreads();
        {
            f32x4 a1 = (f32x4){0.f, 0.f, 0.f, 0.f}, a2 = (f32x4){0.f, 0.f, 0.f, 0.f};
#pragma unroll
            for (int ks = 0; ks < 2; ++ks) { a1 = MFMA16(ld8(Qt + (mt * 16 + l15) * 72 + ks * 32 + g * 8), ld8(STc + (nt * 16 + l15) * 72 + ks * 32 + g * 8), a1);
                a2 = MFMA16(ld8(ATT + (mt * 16 + l15) * 72 + ks * 32 + g * 8), ld8(VNT + (nt * 16 + l15) * 72 + ks * 32 + g * 8), a2); }
            int b, h, dir, base, T, c; gdn_decode(chain, n, b, h, dir, base, T, c);
            float* O = WSP(float, dir ? OFF_OB : OFF_OF);
#pragma unroll
            for (int j = 0; j < 4; ++j) { const int i = mt * 16 + g * 4 + j; const long tok = base + gdn_pos(dir, T, c, i);
                O[tok * MW + h * 64 + half * 32 + nt * 16 + l15] = __expf(gc[i]) * a1[j] + a2[j]; }
        }
        {
            f32x4 acc = sacc * __expf(gl);
#pragma unroll
            for (int ks = 0; ks < 2; ++ks) acc = MFMA16(ld8(KT + (mt * 16 + l15) * 72 + ks * 32 + g * 8), ld8(VNT2 + (nt * 16 + l15) * 72 + ks * 32 + g * 8), acc);
            sacc = acc;
            U2 o; o.x = pack2(acc[0], acc[1]); o.y = pack2(acc[2], acc[3]); *(U2*)(STn + (nt * 16 + l15) * 72 + mt * 16 + g * 4) = o;
        }
        if (n + 1 < NCH) { store_chunk(st ^ 1);
#pragma unroll
            for (int j = 0; j < 4; ++j) ucur[j] = unext[j]; }
        __syncthreads();
    }
    }
}
constexpr int HY_X = 0, HY_T1 = 2 * SEQ * 8, HY_T2 = HY_T1 + 128 * 8, HY_W3 = HY_T2 + 128 * 8, HY_RED = HY_W3 + 2 * 64 * 4, HY_TOTAL = HY_RED + 64 * 4;
static_assert(HY_TOTAL <= 160 * 1024 - 64, "hyena lds");
__device__ __forceinline__ F2 cmul(F2 a, F2 b) { return (F2){a.x * b.x - a.y * b.y, a.x * b.y + a.y * b.x}; }
__device__ __forceinline__ F2 cmulc(F2 a, F2 b) { return (F2){a.x * b.x + a.y * b.y, a.y * b.x - a.x * b.y}; }
__device__ __forceinline__ F2 twid(const F2* T1, const F2* T2, int q) { return cmul(T1[q >> 7], T2[q & 127]); }

__device__ __forceinline__ void fft_fwd(F2* X, const F2* T1, const F2* T2, int N, int tid) {
    int M = N;
    for (; M >= 4; M >>= 2) {
        const int q4 = M >> 2, sh = N / M;
        for (int idx = tid; idx < (N >> 2); idx += NTH) { const int blk = idx / q4, j = idx - blk * q4, p0 = blk * M + j;
            F2 x0 = X[p0], x1 = X[p0 + q4], x2 = X[p0 + 2 * q4], x3 = X[p0 + 3 * q4];
            const F2 w1 = twid(T1, T2, j * sh), w2 = twid(T1, T2, 2 * j * sh);
            F2 a0 = x0 + x2, a2 = cmul(x0 - x2, w1), a1 = x1 + x3, d = cmul(x1 - x3, w1); F2 a3 = (F2){d.y, -d.x};
            X[p0] = a0 + a1; X[p0 + q4] = cmul(a0 - a1, w2); X[p0 + 2 * q4] = a2 + a3; X[p0 + 3 * q4] = cmul(a2 - a3, w2); }
        __syncthreads();
    }
    if (M == 2) { for (int idx = tid; idx < (N >> 1); idx += NTH) { F2 x0 = X[2 * idx], x1 = X[2 * idx + 1]; X[2 * idx] = x0 + x1; X[2 * idx + 1] = x0 - x1; } __syncthreads(); }
}
__device__ __forceinline__ void fft_inv(F2* X, const F2* T1, const F2* T2, int N, int tid) {
    int lg = 0; while ((1 << lg) < N) ++lg;
    int M = 4;
    if (lg & 1) { for (int idx = tid; idx < (N >> 1); idx += NTH) { F2 y0 = X[2 * idx], y1 = X[2 * idx + 1]; X[2 * idx] = y0 + y1; X[2 * idx + 1] = y0 - y1; } __syncthreads(); M = 8; }
    for (; M <= N; M <<= 2) {
        const int q4 = M >> 2, sh = N / M;
        for (int idx = tid; idx < (N >> 2); idx += NTH) { const int blk = idx / q4, j = idx - blk * q4, p0 = blk * M + j;
            F2 y0 = X[p0], y1 = X[p0 + q4], y2 = X[p0 + 2 * q4], y3 = X[p0 + 3 * q4];
            const F2 w1 = twid(T1, T2, j * sh), w2 = twid(T1, T2, 2 * j * sh);
            F2 t = cmulc(y1, w2); F2 a0 = y0 + t, a1 = y0 - t; t = cmulc(y3, w2); F2 a2 = y2 + t, a3 = y2 - t;
            t = cmulc(a2, w1); X[p0] = a0 + t; X[p0 + 2 * q4] = a0 - t;
            F2 u = cmulc(a3, w1); t = (F2){-u.y, u.x}; X[p0 + q4] = a1 + t; X[p0 + 3 * q4] = a1 - t; }
        __syncthreads();
    }
}

__device__ __forceinline__ void hyena_item(const Params& p, char* lds, int l, int ch, bool ctxs) {
    const int tid = TID(), bid = BID(), lane = tid & 63, wid = tid >> 6;
    const int L = ctxs ? CTX : SEQ, N = 2 * L, k0 = ctxs ? SEQ : 0;
    F2* X = (F2*)(lds + HY_X); F2* T1 = (F2*)(lds + HY_T1); F2* T2 = (F2*)(lds + HY_T2); float* w3s = (float*)(lds + HY_W3); float* red = (float*)(lds + HY_RED);
    const bf16_t* HYT = WSP(bf16_t, OFF_HYT); const float* H2F = WSP(float, OFF_H2F) + (long)k0 * 64;
    F2* HF = WSP(F2, OFF_HF) + (long)bid * 2 * SEQ; float* ZT = WSP(float, OFF_ZT) + (long)bid * 2 * SEQ; bf16_t* YAT = WSP(bf16_t, OFF_YAT);
    __syncthreads();
    if (tid < 128) { float s, c; float a = -6.283185307179586f * (float)(tid * 128) / (float)N; s = sinf(a); c = cosf(a); T1[tid] = (F2){c, s}; }
    else if (tid < 256) { int b_ = tid - 128; float s, c; float a = -6.283185307179586f * (float)b_ / (float)N; s = sinf(a); c = cosf(a); T2[b_] = (F2){c, s}; }
    auto hyu = [&](int seg, int b, int t) -> float { const int col = seg * MW + ch; const bf16_t* r = HYT + ((long)b * 3 * MW + col) * KEYS + k0 + t; const float* w = p.hy_conv + ((long)l * 3 * MW + col) * 3;
        float a = bf2f(r[0]) * w[1]; if (t > 0) a += bf2f(r[-1]) * w[0]; if (t + 1 < L) a += bf2f(r[1]) * w[2]; return a; };
    for (int o = 0; o < 2; ++o) {
        const int colf = o * HYW + ch, colb = 2 * HYW + o * HYW + ch;
        if (tid < 128) { int d = tid >> 6, k = tid & 63; w3s[d * 64 + k] = p.hy_w3[((long)l * 64 + k) * 4 * HYW + (d ? colb : colf)]; }
        __syncthreads();
        const float df = fabsf(p.hy_deltas[((long)(l * 2 + 0) * 2 + o) * HYW + ch]), db = fabsf(p.hy_deltas[((long)(l * 2 + 1) * 2 + o) * HYW + ch]);
        float nrm = 0.f;
        for (int t = tid; t < L; t += NTH) { const float* hr = H2F + (long)t * 64; float af = 0.f, ab = 0.f;
#pragma unroll
            for (int k4 = 0; k4 < 16; ++k4) { F4 h = *(const F4*)(hr + k4 * 4);
                af += h.x * w3s[k4 * 4] + h.y * w3s[k4 * 4 + 1] + h.z * w3s[k4 * 4 + 2] + h.w * w3s[k4 * 4 + 3];
                ab += h.x * w3s[64 + k4 * 4] + h.y * w3s[64 + k4 * 4 + 1] + h.z * w3s[64 + k4 * 4 + 2] + h.w * w3s[64 + k4 * 4 + 3]; }
            const float tl = (float)t / (float)(L - 1);
            af *= __expf(-tl * df) + 0.05f; ab *= __expf(-tl * db) + 0.05f;
            X[t] = (F2){af, 0.f}; nrm += fabsf(af);
            if (t == 0) X[L] = (F2){0.f, 0.f}; else { X[N - t] = (F2){ab, 0.f}; nrm += fabsf(ab); } }
        nrm = wave_sum(nrm);
        if (lane == 0) red[wid] = nrm;
        __syncthreads();
        float tot = 0.f;
#pragma unroll
        for (int w = 0; w < 8; ++w) tot += red[w];
        const float sc = 1.0f / (tot * (float)N);
        fft_fwd(X, T1, T2, N, tid);
        for (int i = tid; i < N; i += NTH) HF[i] = X[i];
        __syncthreads();
        for (int t = tid; t < L; t += NTH) { float z0, z1; if (o == 0) { z0 = hyu(0, 0, t); z1 = hyu(0, 1, t); } else { z0 = ZT[t]; z1 = ZT[SEQ + t]; }
            X[t] = (F2){z0, z1}; X[L + t] = (F2){0.f, 0.f}; }
        __syncthreads();
        fft_fwd(X, T1, T2, N, tid);
        for (int i = tid; i < N; i += NTH) X[i] = cmul(X[i], HF[i]);
        __syncthreads();
        fft_inv(X, T1, T2, N, tid);
        const float sk = p.hy_skip[((long)l * 2 + o) * HYW + ch];
        for (int t = tid; t < L; t += NTH) { F2 y = X[t]; float z0, z1; if (o == 0) { z0 = hyu(0, 0, t); z1 = hyu(0, 1, t); } else { z0 = ZT[t]; z1 = ZT[SEQ + t]; }
            float r0 = hyu(1 + o, 0, t) * (y.x * sc + z0 * sk), r1 = hyu(1 + o, 1, t) * (y.y * sc + z1 * sk);
            if (o == 0) { ZT[t] = r0; ZT[SEQ + t] = r1; }
            else { YAT[((long)0 * MW + ch) * KEYS + k0 + t] = f2bf(r0); YAT[((long)1 * MW + ch) * KEYS + k0 + t] = f2bf(r1); } }
        __syncthreads();
    }
}

__device__ __forceinline__ void phase_mixers(const Params& p, char* lds, int l) {
    const int tid = TID(), bid = BID(), G = gridDim.x, lane = tid & 63;
    const bool ctx_out = l < DEPTH - 1;
    float lam, lam_init;
    { const float* dl = p.diff_lam + (long)l * 4 * 64; float a = wave_sum(dl[lane] * dl[64 + lane]), b = wave_sum(dl[128 + lane] * dl[192 + lane]);
        lam_init = 0.8f - 0.6f * expf(-0.3f * (float)l); lam = expf(a) - expf(b) + lam_init; }
    constexpr int NQT_L = SEQ / 128, U_DL = BATCH * DH * NQT_L;
    for (int u = bid; u < U_DL; u += G) { int b = u / (DH * NQT_L), r = u - b * DH * NQT_L, h = r / NQT_L, qt = r - h * NQT_L; diff_attn_item<1>(p, lds, l, b, h, qt * 128, false, lam, lam_init); }
    for (int ch = bid; ch < MW; ch += G) hyena_item(p, lds, l, ch, false);
    constexpr int U_NA = BATCH * NH * (R_ROWS / 2);
    for (int u = bid; u < U_NA; u += G) { int b = u / (NH * (R_ROWS / 2)), r = u - b * NH * (R_ROWS / 2), h = r / (R_ROWS / 2), rp = r - h * (R_ROWS / 2); na_attn_item(p, lds, l, b, h, rp); }
    for (int it = bid; it < NTASK_GDN / 4; it += G) gdn_chunk_prep4(p, lds, l, it * 4);
    if (ctx_out) {
        constexpr int NQC = CTX / 128;
        for (int u = bid; u < BATCH * DH * NQC; u += G) { int b = u / (DH * NQC), r = u - b * DH * NQC, h = r / NQC, q = r - h * NQC; diff_attn_item<1>(p, lds, l, b, h, q * 128, true, lam, lam_init); }
        for (int u = bid; u < BATCH * NH * NQC; u += G) { int b = u / (NH * NQC), r = u - b * NH * NQC, h = r / NQC, q = r - h * NQC; na_ctx_item(p, lds, b, h, q * 128); }
        for (int ch = bid; ch < MW; ch += G) hyena_item(p, lds, l, ch, true);
    }
}

__device__ __forceinline__ void phase_finish(const Params& p, char* lds, int l) {
    const int tid = TID(), bid = BID(), G = gridDim.x, lane = tid & 63, wid = tid >> 6;
    bf16_t* Y = WSP(bf16_t, OFF_Y);
    { const float* OFp = WSP(float, OFF_OF); const float* OBp = WSP(float, OFF_OB); const bf16_t* GZ = WSP(bf16_t, OFF_GZ); const float nw = p.gdn_norm[l * 64 + lane];
        for (long i = (long)bid * 8 + wid; i < (long)NTOK * GH; i += (long)G * 8) { long tok = i / GH; int h = (int)(i - tok * GH);
            float v = OFp[tok * MW + h * 64 + lane] + OBp[tok * MW + h * 64 + lane];
            float ms = wave_sum(v * v) * (1.0f / 64.0f);
            float z = bf2f(GZ[tok * MW + h * 64 + lane]);
            Y[tok * 4 * MW + MW + h * 64 + lane] = f2bf(v * rsqrtf(ms + RMS_EPS) * nw * siluf(z)); } }
    { const bf16_t* YAT = WSP(bf16_t, OFF_YAT); bf16_t* t = (bf16_t*)lds;
        constexpr int KT_ = KEYS / 64, CT_ = MW / 64;
        for (int u = bid; u < BATCH * CT_ * KT_; u += G) { int b = u / (CT_ * KT_), r = u - b * CT_ * KT_, ct = r / KT_, kt = r - ct * KT_;
            __syncthreads();
            { int c = tid >> 3, s = tid & 7; *(U4*)(t + c * 72 + s * 8) = *(const U4*)(YAT + ((long)b * MW + ct * 64 + c) * KEYS + kt * 64 + s * 8); }
            __syncthreads();
            { int k = tid >> 3, c8 = (tid & 7) * 8; long tok = bk_tok(b, kt * 64 + k);
                U4 o; o.x = (u32)t[(c8 + 0) * 72 + k] | ((u32)t[(c8 + 1) * 72 + k] << 16); o.y = (u32)t[(c8 + 2) * 72 + k] | ((u32)t[(c8 + 3) * 72 + k] << 16);
                o.z = (u32)t[(c8 + 4) * 72 + k] | ((u32)t[(c8 + 5) * 72 + k] << 16); o.w = (u32)t[(c8 + 6) * 72 + k] | ((u32)t[(c8 + 7) * 72 + k] << 16);
                *(U4*)(Y + tok * 4 * MW + ct * 64 + c8) = o; } } }
}
__device__ __forceinline__ void phase_merge1(const Params& p, char* lds, int l) {
    const int tid = TID(), wid = tid >> 6, lane = tid & 63, wm = wid >> 1, wn = wid & 1, l15 = lane & 15, g = lane >> 4;
    const bf16_t* Y = WSP(bf16_t, OFF_Y); const bf16_t* BP = WSP(bf16_t, OFF_BP); const bf16_t* GATE = WSP(bf16_t, OFF_SEG_GATE); bf16_t* MIXG = WSP(bf16_t, OFF_MIXG);
    constexpr int MT = 2, BM1 = 64 * MT, ntm = NTOK / BM1, ntn = D / G_BN;
    for (int u = BID(); u < ntm * ntn; u += gridDim.x) {
        const int tn = u / ntm, tm = u - tn * ntm, row0 = tm * BM1, col0 = tn * G_BN;
        f32x4 tot[MT][4];
#pragma unroll
        for (int m = 0; m < MT; ++m)
#pragma unroll
            for (int n = 0; n < 4; ++n) tot[m][n] = (f32x4){0.f, 0.f, 0.f, 0.f};
        for (int br = 0; br < 4; ++br) {
            f32x4 acc[MT][4];
            gemm_tile<MT>(lds, [&](int r) { return Y + (long)(row0 + r) * 4 * MW + br * MW; }, BP + (long)col0 * 4 * MW + br * MW, 4 * MW, MW, acc);
#pragma unroll
            for (int m = 0; m < MT; ++m) { const long row = row0 + wm * 16 * MT + m * 16 + l15;
#pragma unroll
                for (int n = 0; n < 4; ++n) { U2 gv = *(const U2*)(GATE + row * 4 * D + br * D + col0 + wn * 64 + n * 16 + g * 4);
                    tot[m][n][0] += sigmoidf(bflo(gv.x)) * acc[m][n][0]; tot[m][n][1] += sigmoidf(bfhi(gv.x)) * acc[m][n][1];
                    tot[m][n][2] += sigmoidf(bflo(gv.y)) * acc[m][n][2]; tot[m][n][3] += sigmoidf(bfhi(gv.y)) * acc[m][n][3]; } }
        }
#pragma unroll
        for (int m = 0; m < MT; ++m) { const long row = row0 + wm * 16 * MT + m * 16 + l15;
#pragma unroll
            for (int n = 0; n < 4; ++n) st4bf(MIXG + row * D + col0 + wn * 64 + n * 16 + g * 4, tot[m][n]); }
    }
}
__device__ __forceinline__ void phase_merge2(const Params& p, char* lds, int l) {
    const int tid = TID(), wid = tid >> 6, lane = tid & 63, wm = wid >> 1, wn = wid & 1, l15 = lane & 15, g = lane >> 4;
    const bf16_t* MIXG = WSP(bf16_t, OFF_MIXG); const bf16_t* WO = WSP(bf16_t, OFF_WO); float* MIX = WSP(float, OFF_MIX);
    constexpr int ntm = NTOK / G_BM, ntn = D / G_BN;
    for (int u = BID(); u < ntm * ntn; u += gridDim.x) {
        const int tn = u / ntm, tm = u - tn * ntm, row0 = tm * G_BM, col0 = tn * G_BN;
        f32x4 acc[4][4];
        gemm_tile(lds, [&](int r) { return MIXG + (long)(row0 + r) * D; }, WO + (long)col0 * D, D, D, acc);
#pragma unroll
        for (int m = 0; m < 4; ++m) { const long row = row0 + wm * 64 + m * 16 + l15;
#pragma unroll
            for (int n = 0; n < 4; ++n) { F4 o; o.x = acc[m][n][0]; o.y = acc[m][n][1]; o.z = acc[m][n][2]; o.w = acc[m][n][3]; *(F4*)(MIX + row * D + col0 + wn * 64 + n * 16 + g * 4) = o; } }
    }
}
struct MoeMap { int cnt[NE], off[NE], tile0[NE + 1]; };
__device__ __forceinline__ void moe_map_load(const Params& p, int* sm  ) {
    const int tid = TID();
    __syncthreads();
    if (tid == 0) { const u32* CNT = WSP(u32, OFF_CNT); int o = 0, t = 0;
        for (int e = 0; e < NE; ++e) { int c = (int)CNT[e]; sm[e] = c; sm[NE + e] = o; sm[2 * NE + e] = t; o += c; t += (c + G_BM - 1) / G_BM; }
        sm[3 * NE] = t; }
    __syncthreads();
}
__device__ __forceinline__ void phase_moe1(const Params& p, char* lds, int l) {
    const int tid = TID(), wid = tid >> 6, lane = tid & 63, wm = wid >> 1, wn = wid & 1, l15 = lane & 15, g = lane >> 4;
    int* sm = (int*)(lds + G_LDS);
    moe_map_load(p, sm);
    const bf16_t* H = WSP(bf16_t, OFF_H); const bf16_t* W13 = WSP(bf16_t, OFF_W13); bf16_t* HMID = WSP(bf16_t, OFF_HMID); const int* ELIST = WSP(int, OFF_ELIST);
    constexpr int ntn = 2 * EFF / G_BN;
    const int ntile = sm[3 * NE];
    for (int u = BID(); u < ntile * ntn; u += gridDim.x) {
        const int tn = u / ntile, tg = u - tn * ntile;
        int e = 0;
#pragma unroll
        for (int q = 1; q < NE; ++q) if (tg >= sm[2 * NE + q]) e = q;
        const int mt = tg - sm[2 * NE + e], cnt = sm[e], r0 = mt * G_BM, nrow = cnt - r0 < G_BM ? cnt - r0 : G_BM;
        const int* el = ELIST + (long)e * NTOK;
        f32x4 acc[4][4];
        gemm_tile(lds, [&](int r) { int rr = r < nrow ? r0 + r : r0; return H + (long)el[rr] * D; }, W13 + ((long)e * 2 * EFF + tn * G_BN) * D, D, D, acc);
        const long orow0 = (long)sm[NE + e] + r0;
#pragma unroll
        for (int m = 0; m < 4; ++m) { const int r = wm * 64 + m * 16 + l15;
            if (r < nrow) {
#pragma unroll
                for (int n2 = 0; n2 < 2; ++n2) { f32x4 a = acc[m][2 * n2], b = acc[m][2 * n2 + 1], hmid;
#pragma unroll
                    for (int j = 0; j < 4; ++j) hmid[j] = siluf(a[j]) * b[j];
                    st4bf(HMID + (orow0 + r) * EFF + tn * (G_BN / 2) + wn * 32 + n2 * 16 + g * 4, hmid); } } }
    }
}
__device__ __forceinline__ void phase_moe2(const Params& p, char* lds, int l) {
    const int tid = TID(), wid = tid >> 6, lane = tid & 63, wm = wid >> 1, wn = wid & 1, l15 = lane & 15, g = lane >> 4;
    int* sm = (int*)(lds + G_LDS);
    moe_map_load(p, sm);
    const bf16_t* HMID = WSP(bf16_t, OFF_HMID); const bf16_t* W2 = WSP(bf16_t, OFF_W2); bf16_t* YE = WSP(bf16_t, OFF_YE);
    constexpr int ntn = D / G_BN;
    const int ntile = sm[3 * NE];
    for (int u = BID(); u < ntile * ntn; u += gridDim.x) {
        const int tn = u / ntile, tg = u - tn * ntile;
        int e = 0;
#pragma unroll
        for (int q = 1; q < NE; ++q) if (tg >= sm[2 * NE + q]) e = q;
        const int mt = tg - sm[2 * NE + e], cnt = sm[e], r0 = mt * G_BM, nrow = cnt - r0 < G_BM ? cnt - r0 : G_BM;
        const long orow0 = (long)sm[NE + e] + r0;
        f32x4 acc[4][4];
        gemm_tile(lds, [&](int r) { return HMID + (orow0 + r) * EFF; }, W2 + ((long)e * D + tn * G_BN) * EFF, EFF, EFF, acc);
#pragma unroll
        for (int m = 0; m < 4; ++m) { const int r = wm * 64 + m * 16 + l15;
            if (r < nrow) {
#pragma unroll
                for (int n = 0; n < 4; ++n) st4bf(YE + (orow0 + r) * D + tn * G_BN + wn * 64 + n * 16 + g * 4, acc[m][n]); } }
    }
}
constexpr int LDS_BYTES = 160 * 1024 - 64;
#define PHASE_END(id) do { GSYNC(); if (p.stop_phase == (id)) return; } while (0)

#if defined(CPU_EMU) || !defined(KARG_LAUNDER)
#define PP p_in
#else
__device__ __forceinline__ const Params& launder_params(const Params* q) { asm volatile("" : "+s"(q)); return *q; }
#define PP launder_params(kargs)
#endif
__global__ void __launch_bounds__(NTH, 2) fwd_kernel(Params p_in) {
#ifdef CPU_EMU
    char* lds = emu_lds();
    const Params& p = p_in;
#else
#ifdef KARG_LAUNDER
    const Params* kargs = (const Params*)__builtin_amdgcn_kernarg_segment_ptr();
    const Params& p = *kargs;
#else
    const Params& p = p_in;
#endif
    extern __shared__ __attribute__((aligned(16))) char lds_raw[];
    char* lds = lds_raw + 16;
    if (threadIdx.x == 0) *(uint4*)lds_raw = make_uint4(0u, 0u, 0u, 0u);
    __syncthreads();
    XcdBarrier xbar = xcd_barrier_post((unsigned*)(p.ws + OFF_BAR), (volatile LAS unsigned*)lds_raw);
#endif
    phase_prologue(PP, lds);
    PHASE_END(1);
    for (int l = 0; l < DEPTH; ++l) {
        const int pb = 100 * (l + 1);
        phase_weights(PP, lds, l);
        PHASE_END(pb + 0);
        if (l == 0) { phase_modulate0(PP, l); PHASE_END(pb + 1); }
        phase_inproj(PP, lds, 0);
        PHASE_END(pb + 2);
        phase_prep(PP, lds, l);
        PHASE_END(pb + 3);
        phase_mixers(PP, lds, l);
        PHASE_END(pb + 4);
        phase_gdn_scan(PP, lds, l);
        PHASE_END(pb + 5);
        phase_finish(PP, lds, l);
        PHASE_END(pb + 6);
        phase_inproj(PP, lds, 1);
        PHASE_END(pb + 7);
        phase_merge1(PP, lds, l);
        PHASE_END(pb + 8);
        phase_merge2(PP, lds, l);
        phase_expert_weights(PP, lds, l);
        PHASE_END(pb + 9);
        phase_post_mix(PP, l);
        PHASE_END(pb + 10);
        phase_moe1(PP, lds, l);
        PHASE_END(pb + 11);
        phase_moe2(PP, lds, l);
        PHASE_END(pb + 12);
        phase_post_moe(PP, l);
        PHASE_END(pb + 13);
    }
}

extern "C" void kernel_launch(void* const* d_in, const int* in_sizes, int n_in, void* d_out, int out_size, void* d_ws, size_t ws_size, hipStream_t stream) {
    (void)in_sizes; (void)n_in; (void)out_size;
    if (ws_size < WS_NEED) return;
    Params p;
    memset(&p, 0, sizeof(p));
    const float** pp = (const float**)&p;
    for (int i = 0; i < 32; ++i) pp[i] = (const float*)d_in[i];
    p.out = (float*)d_out; p.ws = (char*)d_ws; p.stop_phase = -1;
#ifdef CPU_EMU
    { const char* sp = getenv("EMU_STOP"); if (sp) p.stop_phase = atoi(sp); }
    memset(d_ws, 0, SZ_BAR);
    int grid = 4; { const char* g = getenv("EMU_GRID"); if (g) grid = atoi(g); }
    emu_launch([](void* a) { fwd_kernel(*(Params*)a); }, &p, grid, NTH, LDS_BYTES);
#else
    static int grid = 0;
    if (!grid) {
        int dev = 0, cus = 0, per_cu = 0;
        (void)hipGetDevice(&dev);
        (void)hipDeviceGetAttribute(&cus, hipDeviceAttributeMultiprocessorCount, dev);
        (void)hipFuncSetAttribute((const void*)fwd_kernel, hipFuncAttributeMaxDynamicSharedMemorySize, LDS_BYTES + 16);
        (void)hipOccupancyMaxActiveBlocksPerMultiprocessor(&per_cu, (const void*)fwd_kernel, NTH, LDS_BYTES + 16);
        grid = per_cu >= 1 ? cus : 0;
        if (grid > GRID_MAX) grid = GRID_MAX;
    }
    if (!grid) return;
    (void)hipMemsetAsync(d_ws, 0, SZ_BAR, stream);
    hipLaunchKernelGGL(fwd_kernel, dim3(grid), dim3(NTH), LDS_BYTES + 16, stream, p);
#endif
}
```

```cpp
#ifdef CPU_EMU
#define SCHED_FENCE()
#define WAIT_LGKM()
#define WAIT_VM0()
#else
#include <hip/hip_runtime.h>
typedef short bf16x8 __attribute__((ext_vector_type(8)));
typedef float f32x4 __attribute__((ext_vector_type(4)));
#define SCHED_FENCE() __builtin_amdgcn_sched_barrier(0)
#define WAIT_LGKM() asm volatile("s_waitcnt lgkmcnt(0)" ::: "memory")
#define WAIT_VM0() asm volatile("s_waitcnt vmcnt(0)" ::: "memory")
#endif
#include <cstdint>
#include <cstddef>
#include <cstring>
#include <cstdlib>

#ifndef REP_DIFF
#define REP_DIFF 1
#endif
#ifndef REP_HY
#define REP_HY 1
#endif
#ifndef REP_NA
#define REP_NA 1
#endif
#ifndef REP_GP
#define REP_GP 1
#endif
#ifndef REP_GS
#define REP_GS 1
#endif
#ifndef REP_IP
#define REP_IP 1
#endif
typedef unsigned short bf16_t;
typedef unsigned int u32;
typedef u32 U2 __attribute__((ext_vector_type(2)));
typedef u32 U4 __attribute__((ext_vector_type(4)));
typedef float F4 __attribute__((ext_vector_type(4)));
typedef float F2 __attribute__((ext_vector_type(2)));

#ifdef SMALL_DIMS
constexpr int D = 256, BATCH = 2, SEQ = 1024, DEPTH = 2, CTX = 128, GRID_MAX = 8;
#else
constexpr int D = 1024, BATCH = 2, SEQ = 8192, DEPTH = 4, CTX = 256, GRID_MAX = 256;
#endif
constexpr int LDS_BYTES = 160 * 1024 - 64;
constexpr int NTH = 512;
constexpr int GW = 64, HD = 64;
constexpr int MW = D / 2;
constexpr int HYW = MW, HY_HID = 64, HY_BANDS = 16, HY_EMB = 33;
constexpr int GH = MW / 64, DH = MW / 128, NH = MW / 64;
constexpr int NE = 16, EFF = D / 2;
constexpr int NLAT = BATCH * SEQ, NCTX = BATCH * CTX, NTOK = NLAT + NCTX;
constexpr int KEYS = SEQ + CTX;
constexpr int IN_TOTAL = 13 * MW + 4 * GH + 4 * D;
constexpr int SRC_HY = 0, SRC_GQKV = 3 * MW, SRC_GZ = 6 * MW, SRC_GA = 7 * MW, SRC_DQKV = 7 * MW + 4 * GH, SRC_NQKV = 10 * MW + 4 * GH, SRC_GATE = 13 * MW + 4 * GH;
constexpr int MY_HY = 0, MY_GQKV = 3 * MW, MY_GZ = 6 * MW, MY_DQKV = 7 * MW, MY_NQKV = 10 * MW, MY_GAB = 13 * MW, MY_GATE = 13 * MW + 128, NPROJ1 = 13 * MW + 128, NPROJ = NPROJ1 + 4 * D;
constexpr float LN_EPS = 1e-5f, RMS_EPS = 1e-6f;
constexpr int NSLOT = 2 * NTOK;
constexpr int R_ROWS = SEQ / GW;
constexpr int NCH_LAT = SEQ / 64, NCH_CTX = CTX / 64, NCH = NCH_LAT + NCH_CTX;
constexpr int NTASK_GDN = BATCH * GH * 2 * NCH;
static_assert(NTOK % 256 == 0 && MW % 128 == 0 && SEQ % 256 == 0 && CTX % 64 == 0, "dims");

constexpr size_t al256(size_t x) { return (x + 255) & ~(size_t)255; }
constexpr size_t SZ_BAR = 16384;
constexpr size_t OFF_BAR = 0;
constexpr size_t OFF_CNT = OFF_BAR + SZ_BAR;
constexpr size_t OFF_MODP = OFF_CNT + 4096;
constexpr size_t OFF_MOD = OFF_MODP + al256((size_t)DEPTH * 8 * 3 * 6 * D * 4);
constexpr size_t OFF_XS = OFF_MOD + al256((size_t)DEPTH * 3 * 6 * D * 4);
constexpr size_t OFF_H = OFF_XS + (size_t)NTOK * D * 4;
constexpr size_t OFF_GZ = OFF_H + (size_t)NTOK * D * 2;
constexpr size_t OFF_GAB = OFF_GZ + (size_t)NTOK * MW * 2;
constexpr size_t OFF_GB = OFF_GAB + (size_t)NTOK * 32 * 4;
constexpr size_t OFF_Y = OFF_GB + (size_t)NTOK * 4 * GH * 4;
constexpr size_t OFF_WIN = OFF_Y + (size_t)NTOK * 4 * MW * 2;
constexpr size_t OFF_BP = OFF_WIN + (size_t)NPROJ * D * 2;
constexpr size_t OFF_WO = OFF_BP + (size_t)D * 4 * MW * 2;
constexpr size_t OFF_H2F = OFF_WO + (size_t)D * D * 2;
constexpr size_t OFF_TOKE = OFF_H2F + al256((size_t)KEYS * 64 * 4);
constexpr size_t OFF_TOKR = OFF_TOKE + (size_t)NTOK * 2 * 4;
constexpr size_t OFF_TOKW = OFF_TOKR + (size_t)NTOK * 2 * 4;
constexpr size_t OFF_ELIST = OFF_TOKW + (size_t)NTOK * 2 * 4;
constexpr size_t OFF_RC = OFF_ELIST + (size_t)NE * NTOK * 4;
constexpr size_t OFF_DVT = OFF_RC;
constexpr size_t OFF_NVT = OFF_DVT + (size_t)BATCH * MW * KEYS * 2;
constexpr size_t OFF_GQ = OFF_NVT + (size_t)BATCH * MW * KEYS * 2;
constexpr size_t OFF_GK = OFF_GQ + (size_t)NTOK * MW * 2;
constexpr size_t OFF_GV = OFF_GK + (size_t)NTOK * MW * 2;
constexpr size_t OFF_RA = OFF_GV + (size_t)NTOK * MW * 2;
constexpr size_t SZ_SEG3 = (size_t)NTOK * 3 * MW * 2;
constexpr size_t OFF_SEG_HY = OFF_RA;
constexpr size_t OFF_SEG_GQKV = OFF_RA + SZ_SEG3;
constexpr size_t OFF_SEG_DQKV = OFF_RA + 2 * SZ_SEG3;
constexpr size_t OFF_SEG_NQKV = OFF_RA + 3 * SZ_SEG3;
constexpr size_t SZ_RA = 4 * SZ_SEG3;
constexpr size_t OFF_OF = OFF_RA;
constexpr size_t OFF_OB = OFF_OF + (size_t)NTOK * MW * 2;
constexpr size_t OFF_YAT = OFF_OB + (size_t)NTOK * MW * 2;
constexpr size_t OFF_HF = OFF_YAT + (size_t)BATCH * MW * KEYS * 2;
constexpr size_t OFF_ZT = OFF_HF + (size_t)GRID_MAX * 2 * SEQ * 8;
constexpr size_t OFF_SEG_GATE = OFF_RA;
constexpr size_t OFF_W13 = OFF_RA;
constexpr size_t OFF_W2 = OFF_W13 + (size_t)NE * 2 * EFF * D * 2;
static_assert(OFF_ZT + (size_t)GRID_MAX * 2 * SEQ * 4 <= OFF_SEG_DQKV, "R1 overflow");
static_assert((size_t)NTOK * 4 * D * 2 <= SZ_RA, "gate overflow");
static_assert(OFF_W2 + (size_t)NE * D * EFF * 2 <= OFF_RA + SZ_RA, "expert weights overflow");
constexpr size_t OFF_RB = OFF_RA + SZ_RA;
constexpr size_t OFF_HYT = OFF_RB;
constexpr size_t OFF_WU = OFF_HYT + (size_t)BATCH * 3 * MW * KEYS * 2;
constexpr size_t OFF_MIXG = OFF_RB;
constexpr size_t OFF_MIX = OFF_MIXG + (size_t)NTOK * D * 2;
constexpr size_t OFF_HMID = OFF_MIX + (size_t)NTOK * D * 4;
constexpr size_t OFF_YE = OFF_HMID + (size_t)(NSLOT + 256) * EFF * 2;
constexpr size_t SZ_RB_LATE = OFF_YE + (size_t)(NSLOT + 256) * D * 2 - OFF_RB;
constexpr size_t SZ_RB_EARLY = OFF_WU + (size_t)NTASK_GDN * 2 * 64 * 64 * 2 - OFF_RB;
constexpr size_t SZ_RB = SZ_RB_LATE > SZ_RB_EARLY ? SZ_RB_LATE : SZ_RB_EARLY;
constexpr size_t WS_NEED = OFF_RB + SZ_RB;

struct Params {
    const float *x, *c, *ctx, *c_ctx, *w_mod, *b_mod, *w_in, *hy_conv, *hy_w1, *hy_b1, *hy_w2, *hy_b2, *hy_w3, *hy_freq, *hy_deltas, *hy_skip,
        *gdn_conv, *gdn_a_log, *gdn_dt_bias, *gdn_norm, *diff_lam, *diff_norm, *na_rpb, *branch_proj, *w_out, *ln_g, *ln_b, *router_w, *router_b,
        *exp_w1, *exp_w3, *exp_w2;
    float* out; char* ws; long long stop_phase;
};

#ifdef CPU_EMU
#define TID() ((int)threadIdx.x)
#define BID() ((int)blockIdx.x)
#else
__device__ __forceinline__ int TID() { int t = threadIdx.x; asm volatile("" : "+v"(t)); return t; }
__device__ __forceinline__ int BID() { int t = blockIdx.x; asm volatile("" : "+s"(t)); return t; }
#endif
__device__ __forceinline__ u32 f2u(float f) { union { float f; u32 u; } c; c.f = f; return c.u; }
__device__ __forceinline__ float u2f(u32 u) { union { float f; u32 u; } c; c.u = u; return c.f; }
__device__ __forceinline__ bf16_t f2bf(float f) { u32 u = f2u(f); u += 0x7fffu + ((u >> 16) & 1u); return (bf16_t)(u >> 16); }
__device__ __forceinline__ float bf2f(bf16_t h) { return u2f(((u32)h) << 16); }
__device__ __forceinline__ u32 pack2(float lo, float hi) { return (u32)f2bf(lo) | ((u32)f2bf(hi) << 16); }
__device__ __forceinline__ float bflo(u32 w) { return u2f(w << 16); }
__device__ __forceinline__ float bfhi(u32 w) { return u2f(w & 0xffff0000u); }
__device__ __forceinline__ float siluf(float x) { return x / (1.0f + __expf(-x)); }
__device__ __forceinline__ float sigmoidf(float x) { return 1.0f / (1.0f + __expf(-x)); }
__device__ __forceinline__ float wave_sum(float v) { for (int o = 32; o; o >>= 1) v += __shfl_xor(v, o); return v; }
__device__ __forceinline__ float wave_max(float v) { for (int o = 32; o; o >>= 1) v = fmaxf(v, __shfl_xor(v, o)); return v; }
__device__ __forceinline__ bf16x8 ld8(const bf16_t* p) { return *(const bf16x8*)p; }
__device__ __forceinline__ bf16x8 mk8(U2 a, U2 b) { union { struct { U2 a, b; } s; bf16x8 v; } c; c.s.a = a; c.s.b = b; return c.v; }
__device__ __forceinline__ bf16x8 mk8u(u32 a, u32 b, u32 c0, u32 d) { union { u32 u[4]; bf16x8 v; } c; c.u[0] = a; c.u[1] = b; c.u[2] = c0; c.u[3] = d; return c.v; }
#define MFMA16(a, b, c) __builtin_amdgcn_mfma_f32_16x16x32_bf16(a, b, c, 0, 0, 0)
__device__ __forceinline__ int mod_row(int tok) { return tok < NLAT ? tok / SEQ : 2; }
__device__ __forceinline__ void tok_bk(int tok, int& b, int& key) { if (tok < NLAT) { b = tok / SEQ; key = tok - b * SEQ; } else { int t = tok - NLAT; b = t / CTX; key = SEQ + t - b * CTX; } }
__device__ __forceinline__ int bk_tok(int b, int key) { return key < SEQ ? b * SEQ + key : NLAT + b * CTX + (key - SEQ); }
#ifdef CPU_EMU
struct XcdBarrier { int dummy; };
#define GSYNC() emu_grid_sync()
#else
#define XB_TMO      128
#define XB_XCNT(j)  (256  + 64 * (j))
#define XB_XSUB(j)  (1280 + 64 * (j))
#define XB_XGEN(j)  (2304 + 64 * (j))
#define XB_TOP      3328
#define XB_TOPGEN   3392
#define XCD_BAR_WORDS 3456
#define XB_SPIN_CAP (1u << 22)
#define LAS __attribute__((address_space(3)))
__device__ __forceinline__ unsigned xb_ld(unsigned* p)              { return __hip_atomic_load(p, __ATOMIC_RELAXED, __HIP_MEMORY_SCOPE_AGENT); }
__device__ __forceinline__ unsigned xb_add(unsigned* p, unsigned v) { return __hip_atomic_fetch_add(p, v, __ATOMIC_RELAXED, __HIP_MEMORY_SCOPE_AGENT); }
__device__ __forceinline__ unsigned xb_xcc_id() { return (unsigned)__builtin_amdgcn_s_getreg((3 << 11) | 20) & 0xFu; }
#define XB_SPIN(cond, bar) do { unsigned _sp = 0; while (cond) { __builtin_amdgcn_s_sleep(1); \
    if ((++_sp & 255u) == 0u) { if (xb_ld(&(bar)[XB_TMO])) break; if (_sp > XB_SPIN_CAP) { atomicAdd(&(bar)[XB_TMO], 1u); break; } } } } while (0)
struct XcdBarrier { unsigned* bar; unsigned x; volatile LAS unsigned* st; };
__device__ __forceinline__ XcdBarrier xcd_barrier_post(unsigned* bar, volatile LAS unsigned* st) {
    XcdBarrier b; b.bar = bar; b.x = xb_xcc_id(); b.st = st;
    if (threadIdx.x == 0) (void)xb_add(&bar[XB_XCNT(b.x)], 1u);
    return b;
}
__device__ __forceinline__ void xcd_barrier_complete(unsigned* bar, unsigned x, unsigned& nloc, unsigned& nx) {
    const unsigned G = gridDim.x * gridDim.y * gridDim.z;
    unsigned sum, cnt, mine, sp = 0u;
    for (;;) {
        sum = 0u; cnt = 0u; mine = 0u;
#pragma unroll
        for (unsigned j = 0; j < 16; ++j) { const unsigned c = xb_ld(&bar[XB_XCNT(j)]); sum += c; cnt += (c > 0u) ? 1u : 0u; mine = (j == x) ? c : mine; }
        if (sum == G) break;
        __builtin_amdgcn_s_sleep(1);
        if ((++sp & 255u) == 0u) { if (xb_ld(&bar[XB_TMO])) break; if (sp > XB_SPIN_CAP) { atomicAdd(&bar[XB_TMO], 1u); break; } }
    }
    nloc = mine > 0u ? mine : 1u; nx = cnt > 0u ? cnt : 1u;
}
__device__ __forceinline__ void xcd_barrier(const XcdBarrier& b) {
    asm volatile("s_waitcnt vmcnt(0)" ::: "memory");
    __syncthreads();
    if (threadIdx.x == 0) {
        unsigned* bar = b.bar;
        __builtin_amdgcn_s_waitcnt(0);
        unsigned nloc = b.st[0], nx = b.st[1];
        if (nloc == 0u) { xcd_barrier_complete(bar, b.x, nloc, nx); b.st[0] = nloc; b.st[1] = nx; }
        const unsigned old = xb_add(&bar[XB_XSUB(b.x)], 1u);
        const unsigned gen = old / nloc;
        if (old + 1u == (gen + 1u) * nloc) {
            __builtin_amdgcn_fence(__ATOMIC_RELEASE, "agent");
            asm volatile("s_waitcnt vmcnt(0)" ::: "memory");
            const unsigned og = xb_add(&bar[XB_TOP], 1u);
            const unsigned tg = og / nx;
            if (og + 1u == (tg + 1u) * nx) xb_add(&bar[XB_TOPGEN], 1u);
            else XB_SPIN(xb_ld(&bar[XB_TOPGEN]) == tg, bar);
            __builtin_amdgcn_fence(__ATOMIC_ACQUIRE, "agent");
            xb_add(&bar[XB_XGEN(b.x)], 1u);
            asm volatile("s_waitcnt vmcnt(0)" ::: "memory");
        } else {
            XB_SPIN(xb_ld(&bar[XB_XGEN(b.x)]) == gen, bar);
            __builtin_amdgcn_fence(__ATOMIC_ACQUIRE, "agent");
            asm volatile("s_waitcnt vmcnt(0)" ::: "memory");
        }
    }
    __syncthreads();
}
#define GSYNC() xcd_barrier(xbar)
#endif

constexpr int G_BM = 256, G_BN = 128, G_BK = 64, G_LD = 72;
constexpr int G_STAGE = (G_BM + G_BN) * G_LD * 2;
constexpr int G_LDS = 2 * G_STAGE;

template <int MT = 4, class ARow>
__device__ __forceinline__ void gemm_tile(char* lds, ARow arow  , const bf16_t* Bt, long ldb, int K, f32x4 (&acc)[MT][4]) {
    const int tid = TID(), wid = tid >> 6, lane = tid & 63, wm = wid >> 1, wn = wid & 1, l15 = lane & 15, g = lane >> 4;
#pragma unroll
    for (int m = 0; m < MT; ++m)
#pragma unroll
        for (int n = 0; n < 4; ++n) acc[m][n] = (f32x4){0.f, 0.f, 0.f, 0.f};
    const bf16_t* ap[MT]; const bf16_t* bp[2];
#pragma unroll
    for (int i = 0; i < MT; ++i) { int pc = tid + i * NTH; int r = pc >> 3, s = pc & 7; ap[i] = arow(r) + s * 8; }
#pragma unroll
    for (int i = 0; i < 2; ++i) { int pc = tid + i * NTH; int r = pc >> 3, s = pc & 7; bp[i] = Bt + (long)r * ldb + s * 8; }
    U4 ra[MT], rb[2];
    const int nk = K / G_BK;
#pragma unroll
    for (int i = 0; i < MT; ++i) ra[i] = *(const U4*)(ap[i]);
#pragma unroll
    for (int i = 0; i < 2; ++i) rb[i] = *(const U4*)(bp[i]);
    __syncthreads();
    {
        bf16_t* sA = (bf16_t*)lds; bf16_t* sB = sA + G_BM * G_LD;
#pragma unroll
        for (int i = 0; i < MT; ++i) { int pc = tid + i * NTH; int r = pc >> 3, s = pc & 7; *(U4*)(sA + r * G_LD + s * 8) = ra[i]; }
#pragma unroll
        for (int i = 0; i < 2; ++i) { int pc = tid + i * NTH; int r = pc >> 3, s = pc & 7; *(U4*)(sB + r * G_LD + s * 8) = rb[i]; }
    }
    __syncthreads();
    for (int kt = 0; kt < nk; ++kt) {
        const bool more = kt + 1 < nk;
        if (more) {
#pragma unroll
            for (int i = 0; i < MT; ++i) ra[i] = *(const U4*)(ap[i] + (kt + 1) * G_BK);
#pragma unroll
            for (int i = 0; i < 2; ++i) rb[i] = *(const U4*)(bp[i] + (kt + 1) * G_BK);
        }
        const bf16_t* sA = (const bf16_t*)(lds + (kt & 1) * G_STAGE); const bf16_t* sB = sA + G_BM * G_LD;
#pragma unroll
        for (int ks = 0; ks < 2; ++ks) {
            bf16x8 af[MT], bfr[4];
#pragma unroll
            for (int m = 0; m < MT; ++m) af[m] = ld8(sA + (wm * 16 * MT + m * 16 + l15) * G_LD + ks * 32 + g * 8);
#pragma unroll
            for (int n = 0; n < 4; ++n) bfr[n] = ld8(sB + (wn * 64 + n * 16 + l15) * G_LD + ks * 32 + g * 8);
#pragma unroll
            for (int m = 0; m < MT; ++m)
#pragma unroll
                for (int n = 0; n < 4; ++n) acc[m][n] = MFMA16(bfr[n], af[m], acc[m][n]);
        }
        if (more) {
            bf16_t* dA = (bf16_t*)(lds + ((kt + 1) & 1) * G_STAGE); bf16_t* dB = dA + G_BM * G_LD;
#pragma unroll
            for (int i = 0; i < MT; ++i) { int pc = tid + i * NTH; int r = pc >> 3, s = pc & 7; *(U4*)(dA + r * G_LD + s * 8) = ra[i]; }
#pragma unroll
            for (int i = 0; i < 2; ++i) { int pc = tid + i * NTH; int r = pc >> 3, s = pc & 7; *(U4*)(dB + r * G_LD + s * 8) = rb[i]; }
        }
        __syncthreads();
    }
}

template <class SrcFn>
__device__ __forceinline__ void cvt_tile(char* lds, SrcFn srcp, int k0, int n0, bf16_t* dst, long dst_ld) {
    float* t = (float*)lds;
    const int tid = TID();
    __syncthreads();
#pragma unroll
    for (int i = 0; i < 2; ++i) { int kk = (tid >> 4) + 32 * i, n4 = (tid & 15) * 4; const float* sp = srcp(k0 + kk, n0 + n4);
        F4 v = sp ? *(const F4*)sp : (F4){0.f, 0.f, 0.f, 0.f};
        t[kk * 65 + n4] = v.x; t[kk * 65 + n4 + 1] = v.y; t[kk * 65 + n4 + 2] = v.z; t[kk * 65 + n4 + 3] = v.w; }
    __syncthreads();
    { int n = tid >> 3, k8 = (tid & 7) * 8; U4 o;
        o.x = pack2(t[(k8 + 0) * 65 + n], t[(k8 + 1) * 65 + n]); o.y = pack2(t[(k8 + 2) * 65 + n], t[(k8 + 3) * 65 + n]);
        o.z = pack2(t[(k8 + 4) * 65 + n], t[(k8 + 5) * 65 + n]); o.w = pack2(t[(k8 + 6) * 65 + n], t[(k8 + 7) * 65 + n]);
        *(U4*)(dst + (long)(n0 + n) * dst_ld + k0 + k8) = o; }
}

__device__ __forceinline__ void tr_tile(char* lds, const bf16_t* src, long ld, int tok0, int col0, int ncols, int cdst0, bf16_t* dst) {
    bf16_t* t = (bf16_t*)lds;
    const int tid = TID();
    __syncthreads();
    { int r = tid >> 3, s = tid & 7; *(U4*)(t + r * 72 + s * 8) = *(const U4*)(src + (long)(tok0 + r) * ld + col0 + s * 8); }
    __syncthreads();
    { int c = tid >> 3, t8 = (tid & 7) * 8; int b, key; tok_bk(tok0, b, key);
        U4 o; o.x = (u32)t[(t8 + 0) * 72 + c] | ((u32)t[(t8 + 1) * 72 + c] << 16); o.y = (u32)t[(t8 + 2) * 72 + c] | ((u32)t[(t8 + 3) * 72 + c] << 16);
        o.z = (u32)t[(t8 + 4) * 72 + c] | ((u32)t[(t8 + 5) * 72 + c] << 16); o.w = (u32)t[(t8 + 6) * 72 + c] | ((u32)t[(t8 + 7) * 72 + c] << 16);
        *(U4*)(dst + ((long)b * ncols + cdst0 + c) * KEYS + key + t8) = o; }
}
#define WSP(T, off) ((T*)(p.ws + (off)))
constexpr float DN_ALPHA_F =
#ifdef SMALL_DIMS
    1.4142135623730951f;
#else
    1.681792830507429f;
#endif

__device__ __forceinline__ void phase_prologue(const Params& p, char* lds) {
    const int tid = TID(), G = gridDim.x, bid = BID();
    float* XS = WSP(float, OFF_XS);
    for (long i = (long)bid * NTH + tid; i < (long)NTOK * D / 4; i += (long)G * NTH) {
        long e = i * 4; F4 v = e < (long)NLAT * D ? *(const F4*)(p.x + e) : *(const F4*)(p.ctx + (e - (long)NLAT * D));
        *(F4*)(XS + e) = v;
    }
    float* sc = (float*)lds;
    for (int i = tid; i < 3 * D; i += NTH) { int r = i / D, k = i - r * D; float v = r < 2 ? p.c[r * D + k] : p.c_ctx[k]; sc[i] = siluf(v); }
    __syncthreads();
    float* MODP = WSP(float, OFF_MODP);
    constexpr int NCHK = 6 * D / NTH, KS = D / 8;
    for (int it = bid; it < DEPTH * 8 * NCHK; it += G) {
        int l = it / (8 * NCHK), rem = it - l * 8 * NCHK, s = rem / NCHK, ch = rem - s * NCHK;
        int n = ch * NTH + tid; const float* w = p.w_mod + ((long)l * D + s * KS) * 6 * D + n;
        float a0 = 0.f, a1 = 0.f, a2 = 0.f;
#pragma unroll 8
        for (int k = 0; k < KS; ++k) { float wv = w[(long)k * 6 * D]; a0 += sc[s * KS + k] * wv; a1 += sc[D + s * KS + k] * wv; a2 += sc[2 * D + s * KS + k] * wv; }
        float* o = MODP + (((long)l * 8 + s) * 3) * 6 * D + n; o[0] = a0; o[6 * D] = a1; o[12 * D] = a2;
    }
}

__device__ __forceinline__ void phase_weights(const Params& p, char* lds, int l) {
    const int tid = TID(), G = gridDim.x, bid = BID(), lane = tid & 63, wid = tid >> 6;
    if (l == 0) {
        const float* MODP = WSP(float, OFF_MODP); float* MOD = WSP(float, OFF_MOD);
        for (int i = bid * NTH + tid; i < DEPTH * 3 * 6 * D; i += G * NTH) { int ll = i / (18 * D), rem = i - ll * 18 * D, n = rem % (6 * D);
            float a = p.b_mod[ll * 6 * D + n];
#pragma unroll
            for (int s = 0; s < 8; ++s) a += MODP[((long)ll * 8 + s) * 18 * D + rem];
            MOD[i] = a; }
    }
    if (bid == 0 && tid < 64) { WSP(u32, OFF_CNT)[tid] = 0u; if (l == 0) WSP(u32, OFF_CNT)[64 + tid] = 0u; }
    constexpr int U_WIN = (NPROJ / 64) * (D / 64), U_BP = 4 * (MW / 64) * (D / 64), U_WO = (D / 64) * (D / 64);
    for (int u = bid; u < U_WIN + U_BP + U_WO; u += G) {
        if (u < U_WIN) { int nt = u / (D / 64), kt = u - nt * (D / 64); const float* src = p.w_in + (long)l * D * IN_TOTAL;
            auto sp = [&](int k, int n) -> const float* { int sc;
                if (n < MY_DQKV) sc = n; else if (n < MY_GAB) sc = n + 4 * GH; else if (n < MY_GATE) { int j = n - MY_GAB; if (j >= 4 * GH) return nullptr; sc = SRC_GA + j; } else sc = SRC_GATE + (n - MY_GATE);
                return src + (long)k * IN_TOTAL + sc; };
            cvt_tile(lds, sp, kt * 64, nt * 64, WSP(bf16_t, OFF_WIN), D);
        } else if (u < U_WIN + U_BP) { int v = u - U_WIN; int m = v / ((MW / 64) * (D / 64)), r = v - m * ((MW / 64) * (D / 64)), nt = r / (MW / 64), kt = r - nt * (MW / 64);
            const float* src = p.branch_proj + ((long)(l * 4 + m) * MW) * D;
            auto sp = [&](int k, int n) -> const float* { return src + (long)k * D + n; };
            cvt_tile(lds, sp, kt * 64, nt * 64, WSP(bf16_t, OFF_BP) + m * MW, 4 * MW);
        } else { int v = u - U_WIN - U_BP; int nt = v / (D / 64), kt = v - nt * (D / 64); const float* src = p.w_out + (long)l * D * D;
            auto sp = [&](int k, int n) -> const float* { return src + (long)k * D + n; };
            cvt_tile(lds, sp, kt * 64, nt * 64, WSP(bf16_t, OFF_WO), D);
        }
    }
    float* H2F = WSP(float, OFF_H2F);
    const float* w1 = p.hy_w1 + (long)l * HY_EMB * 64; const float* b1 = p.hy_b1 + l * 64; const float* w2 = p.hy_w2 + (long)l * 64 * 64; const float* b2 = p.hy_b2 + l * 64; const float fr = p.hy_freq[l * 64 + lane];
    for (int pos = bid * 8 + wid; pos < KEYS; pos += G * 8) {
        int L = pos < SEQ ? SEQ : CTX, t = pos < SEQ ? pos : pos - SEQ;
        float feat = 0.f;
        if (lane == 0) feat = (float)t / (float)(L - 1);
        else if (lane < 33) { int bi = (lane - 1) & 15; float band = 1e-4f + (float)bi * ((15.0f - 1e-4f) / 15.0f); float ang = 6.283185307179586f * (float)t / (float)L; float a = band * ang;
            feat = lane < 17 ? cosf(a) : -sinf(a); }
        float a1 = b1[lane];
        for (int e = 0; e < HY_EMB; ++e) a1 += __shfl(feat, e) * w1[e * 64 + lane];
        float h1 = sinf(fr * a1);
        float a2 = b2[lane];
        for (int i = 0; i < 64; ++i) a2 += __shfl(h1, i) * w2[i * 64 + lane];
        H2F[(long)pos * 64 + lane] = sinf(fr * a2);
    }
}

__device__ __forceinline__ void phase_expert_weights(const Params& p, char* lds, int l) {
    const int G = gridDim.x, bid = BID();
    constexpr int U13 = (2 * EFF / 64) * (D / 64), U2_ = (D / 64) * (EFF / 64);
    for (int u = bid; u < NE * (U13 + U2_); u += G) {
        int e = u / (U13 + U2_), v = u - e * (U13 + U2_);
        if (v < U13) { int nt = v / (D / 64), kt = v - nt * (D / 64);
            const float* s1 = p.exp_w1 + ((long)(l * NE + e) * D) * EFF; const float* s3 = p.exp_w3 + ((long)(l * NE + e) * D) * EFF;
            const long d13 = (long)((uintptr_t)s1 - (uintptr_t)s3);
            auto sp = [&](int k, int n) -> const float* { int grp = n >> 5, w = n & 31; return (const float*)((uintptr_t)s3 + (uintptr_t)(w < 16 ? d13 : 0L)) + (long)k * EFF + grp * 16 + (w & 15); };
            cvt_tile(lds, sp, kt * 64, nt * 64, WSP(bf16_t, OFF_W13) + (long)e * 2 * EFF * D, D);
        } else { int w = v - U13; int nt = w / (EFF / 64), kt = w - nt * (EFF / 64); const float* s2 = p.exp_w2 + ((long)(l * NE + e) * EFF) * D;
            auto sp = [&](int k, int n) -> const float* { return s2 + (long)k * D + n; };
            cvt_tile(lds, sp, kt * 64, nt * 64, WSP(bf16_t, OFF_W2) + (long)e * D * EFF, EFF);
        }
    }
}

constexpr int RV = D / 256;
__device__ __forceinline__ void row_stats(const F4 (&v)[RV], float& mean, float& rstd) {
    float s = 0.f;
#pragma unroll
    for (int i = 0; i < RV; ++i) s += (v[i].x + v[i].y) + (v[i].z + v[i].w);
    mean = wave_sum(s) * (1.0f / D);
    float q = 0.f;
#pragma unroll
    for (int i = 0; i < RV; ++i) { float a = v[i].x - mean, b = v[i].y - mean, c = v[i].z - mean, d = v[i].w - mean; q += (a * a + b * b) + (c * c + d * d); }
    rstd = rsqrtf(wave_sum(q) * (1.0f / D) + LN_EPS);
}
__device__ __forceinline__ void row_modulate_store(const F4 (&v)[RV], float mean, float rstd, const float* shift, const float* scale, bf16_t* dst, int lane, F4 (*keep)[RV] = nullptr) {
#pragma unroll
    for (int i = 0; i < RV; ++i) { int n = (i * 64 + lane) * 4; F4 sh = *(const F4*)(shift + n), sc = *(const F4*)(scale + n);
        F4 h; h.x = (v[i].x - mean) * rstd * (1.0f + sc.x) + sh.x; h.y = (v[i].y - mean) * rstd * (1.0f + sc.y) + sh.y; h.z = (v[i].z - mean) * rstd * (1.0f + sc.z) + sh.z; h.w = (v[i].w - mean) * rstd * (1.0f + sc.w) + sh.w;
        U2 o; o.x = pack2(h.x, h.y); o.y = pack2(h.z, h.w); *(U2*)(dst + n) = o; if (keep) (*keep)[i] = h; }
}

__device__ __forceinline__ void phase_modulate0(const Params& p, int l) {
    const int tid = TID(), lane = tid & 63, wid = tid >> 6;
    const float* XS = WSP(float, OFF_XS); bf16_t* H = WSP(bf16_t, OFF_H); const float* MOD = WSP(float, OFF_MOD) + (long)l * 18 * D;
    for (int row = BID() * 8 + wid; row < NTOK; row += gridDim.x * 8) {
        F4 v[RV];
#pragma unroll
        for (int i = 0; i < RV; ++i) v[i] = *(const F4*)(XS + (long)row * D + (i * 64 + lane) * 4);
        float mean, rstd; row_stats(v, mean, rstd);
        const float* m = MOD + mod_row(row) * 6 * D;
        row_modulate_store(v, mean, rstd, m, m + D, H + (long)row * D, lane);
    }
}

__device__ __forceinline__ void phase_post_mix(const Params& p, int l) {
    const int tid = TID(), lane = tid & 63, wid = tid >> 6;
    float* XS = WSP(float, OFF_XS); const float* MIX = WSP(float, OFF_MIX); bf16_t* H = WSP(bf16_t, OFF_H); const float* MOD = WSP(float, OFF_MOD) + (long)l * 18 * D;
    const float* lng = p.ln_g + (long)(l * 2 + 0) * D; const float* lnb = p.ln_b + (long)(l * 2 + 0) * D;
    u32* CNT = WSP(u32, OFF_CNT); int* TOKE = WSP(int, OFF_TOKE); int* TOKR = WSP(int, OFF_TOKR); float* TOKW = WSP(float, OFF_TOKW); int* ELIST = WSP(int, OFF_ELIST);
    const int nrows = (l == DEPTH - 1) ? NLAT : NTOK;
    for (int row = BID() * 8 + wid; row < nrows; row += gridDim.x * 8) {
        const float* m = MOD + mod_row(row) * 6 * D;
        F4 v[RV];
#pragma unroll
        for (int i = 0; i < RV; ++i) { int n = (i * 64 + lane) * 4; F4 x = *(const F4*)(XS + (long)row * D + n), mx = *(const F4*)(MIX + (long)row * D + n), g2 = *(const F4*)(m + 2 * D + n);
            v[i].x = DN_ALPHA_F * x.x + g2.x * mx.x; v[i].y = DN_ALPHA_F * x.y + g2.y * mx.y; v[i].z = DN_ALPHA_F * x.z + g2.z * mx.z; v[i].w = DN_ALPHA_F * x.w + g2.w * mx.w; }
        float mean, rstd; row_stats(v, mean, rstd);
#pragma unroll
        for (int i = 0; i < RV; ++i) { int n = (i * 64 + lane) * 4; F4 g = *(const F4*)(lng + n), b = *(const F4*)(lnb + n);
            v[i].x = (v[i].x - mean) * rstd * g.x + b.x; v[i].y = (v[i].y - mean) * rstd * g.y + b.y; v[i].z = (v[i].z - mean) * rstd * g.z + b.z; v[i].w = (v[i].w - mean) * rstd * g.w + b.w;
            *(F4*)(XS + (long)row * D + n) = v[i]; }
        row_stats(v, mean, rstd);
        F4 h[RV];
        row_modulate_store(v, mean, rstd, m + 3 * D, m + 4 * D, H + (long)row * D, lane, &h);
        float lg[16];
#pragma unroll
        for (int e = 0; e < 16; ++e) lg[e] = 0.f;
#pragma unroll
        for (int i = 0; i < RV; ++i) { int n = (i * 64 + lane) * 4; const float hv[4] = {h[i].x, h[i].y, h[i].z, h[i].w};
#pragma unroll
            for (int j = 0; j < 4; ++j) { const float* rw = p.router_w + (long)(n + j) * 16;
#pragma unroll
                for (int q = 0; q < 4; ++q) { F4 w = *(const F4*)(rw + q * 4); lg[q * 4] += hv[j] * w.x; lg[q * 4 + 1] += hv[j] * w.y; lg[q * 4 + 2] += hv[j] * w.z; lg[q * 4 + 3] += hv[j] * w.w; } } }
        float s[16], sel[16];
#pragma unroll
        for (int e = 0; e < 16; ++e) { lg[e] = wave_sum(lg[e]); s[e] = sigmoidf(lg[e]); sel[e] = s[e] + p.router_b[e]; }
        float gs[4];
#pragma unroll
        for (int gq = 0; gq < 4; ++gq) { float a = sel[gq * 4], b = sel[gq * 4 + 1], c = sel[gq * 4 + 2], d = sel[gq * 4 + 3];
            float m1 = fmaxf(fmaxf(a, b), fmaxf(c, d)); float lo_ab = fminf(a, b), hi_ab = fmaxf(a, b), lo_cd = fminf(c, d), hi_cd = fmaxf(c, d);
            float m2 = fmaxf(fminf(hi_ab, hi_cd), fmaxf(lo_ab, lo_cd)); gs[gq] = m1 + m2; }
        int bg = 0; float bv = gs[0];
#pragma unroll
        for (int gq = 1; gq < 4; ++gq) if (gs[gq] > bv) { bv = gs[gq]; bg = gq; }
        float c0 = 0.f, c1 = 0.f, c2 = 0.f, c3 = 0.f, t0 = 0.f, t1 = 0.f, t2 = 0.f, t3 = 0.f;
#pragma unroll
        for (int gq = 0; gq < 4; ++gq) if (gq == bg) { c0 = sel[gq * 4]; c1 = sel[gq * 4 + 1]; c2 = sel[gq * 4 + 2]; c3 = sel[gq * 4 + 3]; t0 = s[gq * 4]; t1 = s[gq * 4 + 1]; t2 = s[gq * 4 + 2]; t3 = s[gq * 4 + 3]; }
        int i0 = 0; float v0 = c0, w0 = t0;
        if (c1 > v0) { v0 = c1; i0 = 1; w0 = t1; } if (c2 > v0) { v0 = c2; i0 = 2; w0 = t2; } if (c3 > v0) { v0 = c3; i0 = 3; w0 = t3; }
        int i1 = -1; float v1 = -3.0e38f, w1 = 0.f;
        if (i0 != 0 && c0 > v1) { v1 = c0; i1 = 0; w1 = t0; } if (i0 != 1 && c1 > v1) { v1 = c1; i1 = 1; w1 = t1; } if (i0 != 2 && c2 > v1) { v1 = c2; i1 = 2; w1 = t2; } if (i0 != 3 && c3 > v1) { v1 = c3; i1 = 3; w1 = t3; }
        if (lane == 0) { float ws = w0 + w1; int e0 = bg * 4 + i0, e1 = bg * 4 + i1;
            int r0 = (int)atomicAdd(&CNT[e0], 1u), r1 = (int)atomicAdd(&CNT[e1], 1u);
            ELIST[(long)e0 * NTOK + r0] = row; ELIST[(long)e1 * NTOK + r1] = row;
            TOKE[row * 2] = e0; TOKE[row * 2 + 1] = e1; TOKR[row * 2] = r0; TOKR[row * 2 + 1] = r1; TOKW[row * 2] = w0 / ws; TOKW[row * 2 + 1] = w1 / ws; }
    }
}

__device__ __forceinline__ void phase_post_moe(const Params& p, int l) {
    const int tid = TID(), lane = tid & 63, wid = tid >> 6;
    float* XS = WSP(float, OFF_XS); bf16_t* H = WSP(bf16_t, OFF_H); const float* MOD = WSP(float, OFF_MOD) + (long)l * 18 * D;
    const bf16_t* YE = WSP(bf16_t, OFF_YE);
    const float* lng = p.ln_g + (long)(l * 2 + 1) * D; const float* lnb = p.ln_b + (long)(l * 2 + 1) * D;
    const u32* CNT = WSP(u32, OFF_CNT); const int* TOKE = WSP(int, OFF_TOKE); const int* TOKR = WSP(int, OFF_TOKR); const float* TOKW = WSP(float, OFF_TOKW);
    const bool last = (l == DEPTH - 1);
    const int nrows = last ? NLAT : NTOK;
    int eoff = 0;
    { int c = lane < 16 ? (int)CNT[lane] : 0; int incl = c;
        for (int o = 1; o < 16; o <<= 1) { int t = __shfl_up(incl, o); if (lane >= o) incl += t; }
        eoff = incl - c; }
    for (int row = BID() * 8 + wid; row < nrows; row += gridDim.x * 8) {
        const float* m = MOD + mod_row(row) * 6 * D;
        int e0 = TOKE[row * 2], e1 = TOKE[row * 2 + 1];
        long p0 = (long)__shfl(eoff, e0) + TOKR[row * 2], p1 = (long)__shfl(eoff, e1) + TOKR[row * 2 + 1];
        float w0 = TOKW[row * 2], w1 = TOKW[row * 2 + 1];
        F4 v[RV];
#pragma unroll
        for (int i = 0; i < RV; ++i) { int n = (i * 64 + lane) * 4; F4 x = *(const F4*)(XS + (long)row * D + n), g5 = *(const F4*)(m + 5 * D + n);
            U2 a = *(const U2*)(YE + p0 * D + n), b = *(const U2*)(YE + p1 * D + n);
            float y0 = w0 * bflo(a.x) + w1 * bflo(b.x), y1 = w0 * bfhi(a.x) + w1 * bfhi(b.x), y2 = w0 * bflo(a.y) + w1 * bflo(b.y), y3 = w0 * bfhi(a.y) + w1 * bfhi(b.y);
            v[i].x = DN_ALPHA_F * x.x + g5.x * y0; v[i].y = DN_ALPHA_F * x.y + g5.y * y1; v[i].z = DN_ALPHA_F * x.z + g5.z * y2; v[i].w = DN_ALPHA_F * x.w + g5.w * y3; }
        float mean, rstd; row_stats(v, mean, rstd);
        float* dst = last ? p.out + (long)row * D : XS + (long)row * D;
#pragma unroll
        for (int i = 0; i < RV; ++i) { int n = (i * 64 + lane) * 4; F4 g = *(const F4*)(lng + n), b = *(const F4*)(lnb + n);
            v[i].x = (v[i].x - mean) * rstd * g.x + b.x; v[i].y = (v[i].y - mean) * rstd * g.y + b.y; v[i].z = (v[i].z - mean) * rstd * g.z + b.z; v[i].w = (v[i].w - mean) * rstd * g.w + b.w;
            *(F4*)(dst + n) = v[i]; }
        if (!last) { row_stats(v, mean, rstd); const float* m2 = m + 18 * D; row_modulate_store(v, mean, rstd, m2, m2 + D, H + (long)row * D, lane); }
    }
}
__device__ __forceinline__ void st4bf(bf16_t* dst, f32x4 v) { U2 o; o.x = pack2(v[0], v[1]); o.y = pack2(v[2], v[3]); *(U2*)dst = o; }

__device__ __forceinline__ void phase_inproj(const Params& p, char* lds, int part  ) {
    const int tid = TID(), wid = tid >> 6, lane = tid & 63, wm = wid >> 1, wn = wid & 1, l15 = lane & 15, g = lane >> 4;
    const bf16_t* H = WSP(bf16_t, OFF_H); const bf16_t* W = WSP(bf16_t, OFF_WIN);
    const int ncol0 = part == 0 ? 0 : NPROJ1, ncols = part == 0 ? NPROJ1 : 4 * D, ntn = ncols / G_BN, ntm = NTOK / G_BM;
    for (int u = BID(); u < ntm * ntn; u += gridDim.x) {
        const int tn = u / ntm, tm = u - tn * ntm;
        const int row0 = tm * G_BM, col0 = ncol0 + tn * G_BN;
        f32x4 acc[4][4];
        gemm_tile(lds, [&](int r) { return H + (long)(row0 + r) * D; }, W + (long)col0 * D, D, D, acc);
        const int cw = col0 + wn * 64;
        bf16_t* dst; int ld, cl;
        if (cw < MY_GQKV) { dst = WSP(bf16_t, OFF_SEG_HY); ld = 3 * MW; cl = cw - MY_HY; }
        else if (cw < MY_GZ) { dst = WSP(bf16_t, OFF_SEG_GQKV); ld = 3 * MW; cl = cw - MY_GQKV; }
        else if (cw < MY_DQKV) { dst = WSP(bf16_t, OFF_GZ); ld = MW; cl = cw - MY_GZ; }
        else if (cw < MY_NQKV) { dst = WSP(bf16_t, OFF_SEG_DQKV); ld = 3 * MW; cl = cw - MY_DQKV; }
        else if (cw < MY_GAB) { dst = WSP(bf16_t, OFF_SEG_NQKV); ld = 3 * MW; cl = cw - MY_NQKV; }
        else if (cw < MY_GATE) { dst = nullptr; ld = 32; cl = cw - MY_GAB; }
        else { dst = WSP(bf16_t, OFF_SEG_GATE); ld = 4 * D; cl = cw - MY_GATE; }
        if (dst) {
#pragma unroll
            for (int m = 0; m < 4; ++m) { long row = row0 + wm * 64 + m * 16 + l15;
#pragma unroll
                for (int n = 0; n < 4; ++n) st4bf(dst + row * ld + cl + n * 16 + g * 4, acc[m][n]); }
        } else if (cl == 0) {
            float* GAB = WSP(float, OFF_GAB);
#pragma unroll
            for (int m = 0; m < 4; ++m) { long row = row0 + wm * 64 + m * 16 + l15;
#pragma unroll
                for (int n = 0; n < 2; ++n) { F4 o; o.x = acc[m][n][0]; o.y = acc[m][n][1]; o.z = acc[m][n][2]; o.w = acc[m][n][3]; *(F4*)(GAB + row * 32 + n * 16 + g * 4) = o; } }
        }
    }
}

__device__ __forceinline__ void phase_prep(const Params& p, char* lds, int l) {
    const int tid = TID(), G = gridDim.x, bid = BID(), lane = tid & 63, wid = tid >> 6;
    constexpr int TT = NTOK / 64, CT_HY = 3 * MW / 64, CT_V = MW / 64, U_TR = TT * (CT_HY + 2 * CT_V);
    for (int u = bid; u < U_TR; u += G) {
        int tt = u % TT, c = u / TT;
        if (c < CT_HY) tr_tile(lds, WSP(bf16_t, OFF_SEG_HY), 3 * MW, tt * 64, c * 64, 3 * MW, c * 64, WSP(bf16_t, OFF_HYT));
        else if (c < CT_HY + CT_V) { int cc = c - CT_HY; tr_tile(lds, WSP(bf16_t, OFF_SEG_DQKV), 3 * MW, tt * 64, 2 * MW + cc * 64, MW, cc * 64, WSP(bf16_t, OFF_DVT)); }
        else { int cc = c - CT_HY - CT_V; tr_tile(lds, WSP(bf16_t, OFF_SEG_NQKV), 3 * MW, tt * 64, 2 * MW + cc * 64, MW, cc * 64, WSP(bf16_t, OFF_NVT)); }
    }
    {
        bf16_t* DQ = WSP(bf16_t, OFF_SEG_DQKV);
        constexpr int NV = 4 * DH;
        for (long i = (long)bid * NTH + tid; i < (long)NLAT * 32; i += (long)G * NTH) {
            int tok = (int)(i >> 5), f2 = (int)(i & 31);
            int t = tok % SEQ; int axis = f2 >> 4, f = f2 & 15;
            float pos = axis == 0 ? (float)(t / GW) : (float)(t % GW);
            float inv = powf(10000.0f, -(float)f / 16.0f);
            float ang = pos * inv, sn = sinf(ang), cs = cosf(ang);
            bf16_t* base = DQ + (long)tok * 3 * MW + axis * 32 + f;
#pragma unroll
            for (int v = 0; v < NV; ++v) { bf16_t* q = base + v * 64; float x1 = bf2f(q[0]), x2 = bf2f(q[16]); q[0] = f2bf(x1 * cs - x2 * sn); q[16] = f2bf(x1 * sn + x2 * cs); }
        }
    }
    {
        const bf16_t* SG = WSP(bf16_t, OFF_SEG_GQKV); bf16_t* GQ = WSP(bf16_t, OFF_GQ); bf16_t* GK = WSP(bf16_t, OFF_GK); bf16_t* GV = WSP(bf16_t, OFF_GV);
        const float* cw = p.gdn_conv + (long)l * 3 * MW * 3;
        for (long i = (long)bid * 8 + wid; i < (long)NTOK * GH; i += (long)G * 8) {
            int tok = (int)(i / GH), h = (int)(i - (long)tok * GH);
            int seq0, len; if (tok < NLAT) { seq0 = (tok / SEQ) * SEQ; len = SEQ; } else { seq0 = NLAT + ((tok - NLAT) / CTX) * CTX; len = CTX; }
            int t = tok - seq0; bool hasp = t > 0, hasn = t + 1 < len;
            float u[3];
#pragma unroll
            for (int part = 0; part < 3; ++part) { int c = part * MW + h * 64 + lane; const bf16_t* s = SG + (long)tok * 3 * MW + c;
                float a = bf2f(s[0]) * cw[c * 3 + 1];
                if (hasp) a += bf2f(s[-3 * MW]) * cw[c * 3 + 0];
                if (hasn) a += bf2f(s[3 * MW]) * cw[c * 3 + 2];
                u[part] = siluf(a); }
            float nq = wave_sum(u[0] * u[0]), nk = wave_sum(u[1] * u[1]);
            GQ[(long)tok * MW + h * 64 + lane] = f2bf(u[0] * rsqrtf(nq + RMS_EPS) * 0.125f);
            GK[(long)tok * MW + h * 64 + lane] = f2bf(u[1] * rsqrtf(nk + RMS_EPS));
            GV[(long)tok * MW + h * 64 + lane] = f2bf(u[2]);
        }
        const float* GAB = WSP(float, OFF_GAB); float* GB = WSP(float, OFF_GB);
        for (long i = (long)bid * NTH + tid; i < (long)NTOK * 2 * GH; i += (long)G * NTH) {
            int tok = (int)(i / (2 * GH)), dh = (int)(i - (long)tok * 2 * GH);
            float a = GAB[(long)tok * 32 + dh], b = GAB[(long)tok * 32 + 2 * GH + dh];
            float xa = a + p.gdn_dt_bias[l * 2 * GH + dh]; float sp = xa > 20.f ? xa : log1pf(__expf(xa));
            GB[(long)tok * 4 * GH + dh] = -__expf(p.gdn_a_log[l * 2 * GH + dh]) * sp;
            GB[(long)tok * 4 * GH + 2 * GH + dh] = sigmoidf(b);
        }
    }
}
constexpr int A_LD = 72;
template <int DV> struct AttnLds { static constexpr int K_BYTES = 64 * A_LD * 2, V_BYTES = DV * A_LD * 2, STAGE = K_BYTES + V_BYTES, TOTAL = 2 * STAGE; };
constexpr float LOG2E = 1.4426950408889634f;
constexpr float NEG_BIG = -1.0e30f;

template <int NQT, int DV, class QRow, class KTile, class MaskFn>
__device__ __forceinline__ void attn_core(char* lds, QRow qrow  , KTile ktile  ,
                                          int ntiles, MaskFn mask  , f32x4 (&oacc)[DV / 16][NQT], float (&lsum)[NQT]) {
    const int tid = TID(), wid = tid >> 6, lane = tid & 63, l15 = lane & 15, g = lane >> 4;
    constexpr int NDT = DV / 16, NVL = DV / 64;
    typedef AttnLds<DV> L;
    bf16x8 qf[NQT][2];
#pragma unroll
    for (int qt = 0; qt < NQT; ++qt) { const bf16_t* q = qrow(wid * NQT * 16 + qt * 16 + l15);
#pragma unroll
        for (int ks = 0; ks < 2; ++ks) qf[qt][ks] = ld8(q + ks * 32 + g * 8); }
    float mrun[NQT];
#pragma unroll
    for (int qt = 0; qt < NQT; ++qt) { mrun[qt] = NEG_BIG; lsum[qt] = 0.f;
#pragma unroll
        for (int dt = 0; dt < NDT; ++dt) oacc[dt][qt] = (f32x4){0.f, 0.f, 0.f, 0.f}; }
    const int sr = tid >> 3, ss = tid & 7;
    U4 rk, rv[NVL];
    { const bf16_t *kp, *vp; long kld, vld; ktile(0, kp, kld, vp, vld);
        rk = *(const U4*)(kp + (long)sr * kld + ss * 8);
#pragma unroll
        for (int i = 0; i < NVL; ++i) rv[i] = *(const U4*)(vp + (long)(sr + 64 * i) * vld + ss * 8); }
    __syncthreads();
    { bf16_t* sK = (bf16_t*)lds; bf16_t* sV = (bf16_t*)(lds + L::K_BYTES);
        *(U4*)(sK + sr * A_LD + ss * 8) = rk;
#pragma unroll
        for (int i = 0; i < NVL; ++i) *(U4*)(sV + (sr + 64 * i) * A_LD + ss * 8) = rv[i]; }
    __syncthreads();
    for (int t = 0; t < ntiles; ++t) {
        const bool more = t + 1 < ntiles;
        if (more) { const bf16_t *kp, *vp; long kld, vld; ktile(t + 1, kp, kld, vp, vld);
            rk = *(const U4*)(kp + (long)sr * kld + ss * 8);
#pragma unroll
            for (int i = 0; i < NVL; ++i) rv[i] = *(const U4*)(vp + (long)(sr + 64 * i) * vld + ss * 8); }
        const bf16_t* sK = (const bf16_t*)(lds + (t & 1) * L::STAGE); const bf16_t* sV = (const bf16_t*)(lds + (t & 1) * L::STAGE + L::K_BYTES);
        f32x4 s[4][NQT];
#pragma unroll
        for (int mt = 0; mt < 4; ++mt) {
#pragma unroll
            for (int qt = 0; qt < NQT; ++qt) s[mt][qt] = (f32x4){0.f, 0.f, 0.f, 0.f};
#pragma unroll
            for (int ks = 0; ks < 2; ++ks) { bf16x8 kf = ld8(sK + (mt * 16 + l15) * A_LD + ks * 32 + g * 8);
#pragma unroll
                for (int qt = 0; qt < NQT; ++qt) s[mt][qt] = MFMA16(kf, qf[qt][ks], s[mt][qt]); }
        }
        bf16x8 pf[2][NQT];
#pragma unroll
        for (int qt = 0; qt < NQT; ++qt) {
            const int qi = wid * NQT * 16 + qt * 16 + l15;
            float mx = NEG_BIG;
#pragma unroll
            for (int mt = 0; mt < 4; ++mt)
#pragma unroll
                for (int j = 0; j < 4; ++j) { float v = mask(t, mt * 16 + g * 4 + j, qi, s[mt][qt][j] * (0.125f * LOG2E)); s[mt][qt][j] = v; mx = fmaxf(mx, v); }
            mx = fmaxf(mx, __shfl_xor(mx, 16)); mx = fmaxf(mx, __shfl_xor(mx, 32));
            const float mnew = fmaxf(mrun[qt], mx), alpha = exp2f(mrun[qt] - mnew); mrun[qt] = mnew;
            float ps = 0.f;
#pragma unroll
            for (int mt = 0; mt < 4; ++mt)
#pragma unroll
                for (int j = 0; j < 4; ++j) { float pv = exp2f(s[mt][qt][j] - mnew); s[mt][qt][j] = pv; ps += pv; }
            lsum[qt] = lsum[qt] * alpha + ps;
#pragma unroll
            for (int dt = 0; dt < NDT; ++dt) oacc[dt][qt] *= alpha;
#pragma unroll
            for (int kb = 0; kb < 2; ++kb) pf[kb][qt] = mk8u(pack2(s[2 * kb][qt][0], s[2 * kb][qt][1]), pack2(s[2 * kb][qt][2], s[2 * kb][qt][3]),
                                                             pack2(s[2 * kb + 1][qt][0], s[2 * kb + 1][qt][1]), pack2(s[2 * kb + 1][qt][2], s[2 * kb + 1][qt][3]));
        }
#pragma unroll
        for (int dt = 0; dt < NDT; ++dt)
#pragma unroll
            for (int kb = 0; kb < 2; ++kb) { const bf16_t* vr = sV + (dt * 16 + l15) * A_LD + kb * 32 + g * 4;
                bf16x8 vf = mk8(*(const U2*)vr, *(const U2*)(vr + 16));
#pragma unroll
                for (int qt = 0; qt < NQT; ++qt) oacc[dt][qt] = MFMA16(vf, pf[kb][qt], oacc[dt][qt]); }
        if (more) { bf16_t* dK = (bf16_t*)(lds + ((t + 1) & 1) * L::STAGE); bf16_t* dV = (bf16_t*)(lds + ((t + 1) & 1) * L::STAGE + L::K_BYTES);
            *(U4*)(dK + sr * A_LD + ss * 8) = rk;
#pragma unroll
            for (int i = 0; i < NVL; ++i) *(U4*)(dV + (sr + 64 * i) * A_LD + ss * 8) = rv[i]; }
        __syncthreads();
    }
#pragma unroll
    for (int qt = 0; qt < NQT; ++qt) { float l = lsum[qt]; l += __shfl_xor(l, 16); l += __shfl_xor(l, 32); lsum[qt] = l; }
}

struct NoMask { __device__ __forceinline__ float operator()(int, int, int, float s) const { return s; } };

template <int NQT>
__device__ __forceinline__ void diff_attn_item(const Params& p, char* lds, int l, int b, int h, int q0, bool ctxq, float lam, float lam_init) {
    const int tid = TID(), wid = tid >> 6, lane = tid & 63, l15 = lane & 15, g = lane >> 4;
    const bf16_t* DQ = WSP(bf16_t, OFF_SEG_DQKV); const bf16_t* DVT = WSP(bf16_t, OFF_DVT); bf16_t* Y = WSP(bf16_t, OFF_Y);
    const int tok_q0 = ctxq ? NLAT + b * CTX + q0 : b * SEQ + q0;
    const int t_first = ctxq ? SEQ / 64 : 0, ntiles = ctxq ? CTX / 64 : KEYS / 64;
    f32x4 o1[8][NQT]; float l1[NQT];
    {
        auto qrow = [&](int i) { return DQ + (long)(tok_q0 + i) * 3 * MW + h * 128; };
        auto kt = [&](int t, const bf16_t*& kp, long& kld, const bf16_t*& vp, long& vld) { int tt = t_first + t; int tok = bk_tok(b, tt * 64);
            kp = DQ + (long)tok * 3 * MW + MW + h * 128; kld = 3 * MW; vp = DVT + ((long)b * MW + h * 128) * KEYS + tt * 64; vld = KEYS; };
        attn_core<NQT, 128>(lds, qrow, kt, ntiles, NoMask(), o1, l1);
    }
    U2 o1p[8][NQT];
#pragma unroll
    for (int qt = 0; qt < NQT; ++qt) { float inv = 1.0f / l1[qt];
#pragma unroll
        for (int dt = 0; dt < 8; ++dt) { f32x4 v = o1[dt][qt] * inv; o1p[dt][qt].x = pack2(v[0], v[1]); o1p[dt][qt].y = pack2(v[2], v[3]); } }
    f32x4 o2[8][NQT]; float l2[NQT];
    {
        auto qrow = [&](int i) { return DQ + (long)(tok_q0 + i) * 3 * MW + h * 128 + 64; };
        auto kt = [&](int t, const bf16_t*& kp, long& kld, const bf16_t*& vp, long& vld) { int tt = t_first + t; int tok = bk_tok(b, tt * 64);
            kp = DQ + (long)tok * 3 * MW + MW + h * 128 + 64; kld = 3 * MW; vp = DVT + ((long)b * MW + h * 128) * KEYS + tt * 64; vld = KEYS; };
        attn_core<NQT, 128>(lds, qrow, kt, ntiles, NoMask(), o2, l2);
    }
    const float* nw = p.diff_norm + l * 128;
#pragma unroll
    for (int qt = 0; qt < NQT; ++qt) { float inv = lam / l2[qt]; float ss = 0.f;
#pragma unroll
        for (int dt = 0; dt < 8; ++dt) { f32x4 a = (f32x4){bflo(o1p[dt][qt].x), bfhi(o1p[dt][qt].x), bflo(o1p[dt][qt].y), bfhi(o1p[dt][qt].y)}; o2[dt][qt] = a - o2[dt][qt] * inv;
#pragma unroll
            for (int j = 0; j < 4; ++j) ss += o2[dt][qt][j] * o2[dt][qt][j]; }
        ss += __shfl_xor(ss, 16); ss += __shfl_xor(ss, 32);
        const float r = rsqrtf(ss * (1.0f / 128.0f) + RMS_EPS) * (1.0f - lam_init);
        const long row = tok_q0 + wid * NQT * 16 + qt * 16 + l15;
#pragma unroll
        for (int dt = 0; dt < 8; ++dt) { F4 w = *(const F4*)(nw + dt * 16 + g * 4); f32x4 v = o2[dt][qt];
            v[0] *= r * w.x; v[1] *= r * w.y; v[2] *= r * w.z; v[3] *= r * w.w;
            st4bf(Y + row * 4 * MW + 2 * MW + h * 128 + dt * 16 + g * 4, v); }
    }
}

struct NaMask {
    const float* rpb;
    int r0, rs0, nct;
    __device__ __forceinline__ float operator()(int t, int kk, int qi, float s) const {
        if (t < nct) return s;
        const int kr = rs0 + (t - nct), kc = kk, qr = r0 + (qi >> 6), qc = qi & 63;
        int rs = qr - 4; rs = rs < 0 ? 0 : (rs > R_ROWS - 8 ? R_ROWS - 8 : rs);
        int cs = qc - 8; cs = cs < 0 ? 0 : (cs > GW - 16 ? GW - 16 : cs);
        const bool ok = (kr >= rs) && (kr < rs + 8) && (kc >= cs) && (kc < cs + 16);
        int dc = kc - qc; dc = dc < -15 ? -15 : (dc > 15 ? 15 : dc);
        int dr = kr - qr + 7; dr = dr < 0 ? 0 : (dr > 14 ? 14 : dr);
        return ok ? s + rpb[dr * 31 + dc + 15] : NEG_BIG;
    }
};
__device__ __forceinline__ void na_attn_item(const Params& p, char* lds, int l, int b, int h, int rp) {
    const int tid = TID(), wid = tid >> 6, lane = tid & 63, l15 = lane & 15, g = lane >> 4;
    const bf16_t* NQ = WSP(bf16_t, OFF_SEG_NQKV); const bf16_t* NVT = WSP(bf16_t, OFF_NVT); bf16_t* Y = WSP(bf16_t, OFF_Y);
    float* rpb = (float*)(lds + AttnLds<64>::TOTAL);
    __syncthreads();
    for (int i = tid; i < 15 * 31; i += NTH) rpb[i] = p.na_rpb[((long)(l * NH + h) * 15) * 31 + i] * LOG2E;
    const int r0 = rp * 2; int rs0 = r0 - 4; rs0 = rs0 < 0 ? 0 : (rs0 > R_ROWS - 8 ? R_ROWS - 8 : rs0);
    int nwin = R_ROWS - rs0; nwin = nwin > 9 ? 9 : nwin;
    constexpr int NCT = CTX / 64;
    NaMask mk; mk.rpb = rpb; mk.r0 = r0; mk.rs0 = rs0; mk.nct = NCT;
    const int tok_q0 = b * SEQ + r0 * 64;
    auto qrow = [&](int i) { return NQ + (long)(tok_q0 + i) * 3 * MW + h * 64; };
    auto kt = [&](int t, const bf16_t*& kp, long& kld, const bf16_t*& vp, long& vld) { int key = t < NCT ? SEQ + t * 64 : (rs0 + t - NCT) * 64; int tok = bk_tok(b, key);
        kp = NQ + (long)tok * 3 * MW + MW + h * 64; kld = 3 * MW; vp = NVT + ((long)b * MW + h * 64) * KEYS + key; vld = KEYS; };
    f32x4 o[4][1]; float ls[1];
    attn_core<1, 64>(lds, qrow, kt, NCT + nwin, mk, o, ls);
    const float inv = 1.0f / ls[0]; const long row = tok_q0 + wid * 16 + l15;
#pragma unroll
    for (int dt = 0; dt < 4; ++dt) { f32x4 v = o[dt][0] * inv; st4bf(Y + row * 4 * MW + 3 * MW + h * 64 + dt * 16 + g * 4, v); }
}
__device__ __forceinline__ void na_ctx_item(const Params& p, char* lds, int b, int h, int q0) {
    const int tid = TID(), wid = tid >> 6, lane = tid & 63, l15 = lane & 15, g = lane >> 4;
    const bf16_t* NQ = WSP(bf16_t, OFF_SEG_NQKV); const bf16_t* NVT = WSP(bf16_t, OFF_NVT); bf16_t* Y = WSP(bf16_t, OFF_Y);
    const int tok_q0 = NLAT + b * CTX + q0;
    auto qrow = [&](int i) { return NQ + (long)(tok_q0 + i) * 3 * MW + h * 64; };
    auto kt = [&](int t, const bf16_t*& kp, long& kld, const bf16_t*& vp, long& vld) { int key = SEQ + t * 64; int tok = bk_tok(b, key);
        kp = NQ + (long)tok * 3 * MW + MW + h * 64; kld = 3 * MW; vp = NVT + ((long)b * MW + h * 64) * KEYS + key; vld = KEYS; };
    f32x4 o[4][1]; float ls[1];
    attn_core<1, 64>(lds, qrow, kt, CTX / 64, NoMask(), o, ls);
    const float inv = 1.0f / ls[0]; const long row = tok_q0 + wid * 16 + l15;
#pragma unroll
    for (int dt = 0; dt < 4; ++dt) { f32x4 v = o[dt][0] * inv; st4bf(Y + row * 4 * MW + 3 * MW + h * 64 + dt * 16 + g * 4, v); }
}

#define MFMA32(a, b, c) __builtin_amdgcn_mfma_f32_32x32x16_bf16(a, b, c, 0, 0, 0)
#ifndef CPU_EMU
typedef float f32x16 __attribute__((ext_vector_type(16)));
#endif
constexpr int D32_KLD = 72, D32_VLD = 68;
constexpr int D32_KB = 64 * D32_KLD * 2, D32_VB = 128 * D32_VLD * 2, D32_STAGE = D32_KB + D32_VB, D32_O1 = 2 * D32_STAGE, D32_TOTAL = D32_O1 + 256 * 128 * 2;
static_assert(D32_TOTAL <= 160 * 1024 - 64, "diff32 lds");

__device__ __forceinline__ void diff32_pass(char* lds, const bf16_t* qp  , const bf16_t* kbase  ,
                                            const bf16_t* vbase  , int b, f32x16 (&oacc)[4], float& lsum) {
    const int tid = TID(), lane = tid & 63, r32 = lane & 31, hh = lane >> 5;
    bf16x8 qf[4];
#pragma unroll
    for (int ks = 0; ks < 4; ++ks) qf[ks] = ld8(qp + ks * 16 + hh * 8);
#pragma unroll
    for (int dt = 0; dt < 4; ++dt)
#pragma unroll
        for (int r = 0; r < 16; ++r) oacc[dt][r] = 0.f;
    float mrun = NEG_BIG; lsum = 0.f;
    const int sr = tid >> 3, ss = tid & 7;
    U4 rk, rv[2];
    constexpr int NT = KEYS / 64;
    auto gload = [&](int t) { const long tok = bk_tok(b, t * 64); rk = *(const U4*)(kbase + (tok + sr) * 3 * MW + ss * 8);
#pragma unroll
        for (int i = 0; i < 2; ++i) rv[i] = *(const U4*)(vbase + (long)(sr + 64 * i) * KEYS + t * 64 + ss * 8); };
    auto sstore = [&](int st) { bf16_t* sK = (bf16_t*)(lds + st * D32_STAGE); bf16_t* sV = (bf16_t*)(lds + st * D32_STAGE + D32_KB);
        *(U4*)(sK + sr * D32_KLD + ss * 8) = rk;
#pragma unroll
        for (int i = 0; i < 2; ++i) { bf16_t* d = sV + (sr + 64 * i) * D32_VLD + ss * 8; *(U2*)d = (U2){rv[i].x, rv[i].y}; *(U2*)(d + 4) = (U2){rv[i].z, rv[i].w}; } };
    gload(0);
    __syncthreads();
    sstore(0);
    __syncthreads();
    for (int t = 0; t < NT; ++t) {
        const bool more = t + 1 < NT;
        if (more) gload(t + 1);
        const bf16_t* sK = (const bf16_t*)(lds + (t & 1) * D32_STAGE); const bf16_t* sV = (const bf16_t*)(lds + (t & 1) * D32_STAGE + D32_KB);
        f32x16 s[2];
#pragma unroll
        for (int kt = 0; kt < 2; ++kt) {
#pragma unroll
            for (int r = 0; r < 16; ++r) s[kt][r] = 0.f;
#pragma unroll
            for (int ks = 0; ks < 4; ++ks) s[kt] = MFMA32(ld8(sK + (kt * 32 + r32) * D32_KLD + ks * 16 + hh * 8), qf[ks], s[kt]);
        }
        float mx = NEG_BIG;
#pragma unroll
        for (int kt = 0; kt < 2; ++kt)
#pragma unroll
            for (int r = 0; r < 16; ++r) { s[kt][r] *= (0.125f * LOG2E); mx = fmaxf(mx, s[kt][r]); }
        mx = fmaxf(mx, __shfl_xor(mx, 32));
        const float mnew = fmaxf(mrun, mx), alpha = exp2f(mrun - mnew); mrun = mnew;
        float ps = 0.f;
#pragma unroll
        for (int kt = 0; kt < 2; ++kt)
#pragma unroll
            for (int r = 0; r < 16; ++r) { float pv = exp2f(s[kt][r] - mnew); s[kt][r] = pv; ps += pv; }
        lsum = lsum * alpha + ps;
#pragma unroll
        for (int dt = 0; dt < 4; ++dt) oacc[dt] *= alpha;
#pragma unroll
        for (int kt = 0; kt < 2; ++kt)
#pragma unroll
            for (int sx = 0; sx < 2; ++sx) {
                const bf16x8 pf = mk8u(pack2(s[kt][8 * sx], s[kt][8 * sx + 1]), pack2(s[kt][8 * sx + 2], s[kt][8 * sx + 3]), pack2(s[kt][8 * sx + 4], s[kt][8 * sx + 5]), pack2(s[kt][8 * sx + 6], s[kt][8 * sx + 7]));
#pragma unroll
                for (int dt = 0; dt < 4; ++dt) { const bf16_t* vr = sV + (dt * 32 + r32) * D32_VLD + kt * 32 + sx * 16 + hh * 4;
                    oacc[dt] = MFMA32(mk8(*(const U2*)vr, *(const U2*)(vr + 8)), pf, oacc[dt]); }
            }
        if (more) sstore((t + 1) & 1);
        __syncthreads();
    }
    lsum += __shfl_xor(lsum, 32);
}

__device__ __forceinline__ void diff32_item(const Params& p, char* lds, int l, int b, int h, int q0, float lam, float lam_init) {
    const int tid = TID(), wid = tid >> 6, lane = tid & 63, r32 = lane & 31, hh = lane >> 5;
    const bf16_t* DQ = WSP(bf16_t, OFF_SEG_DQKV); const bf16_t* DVT = WSP(bf16_t, OFF_DVT); bf16_t* Y = WSP(bf16_t, OFF_Y);
    const long qtok = (long)b * SEQ + q0 + wid * 32 + r32;
    const bf16_t* vbase = DVT + ((long)b * MW + h * 128) * KEYS;
    u32* O1 = (u32*)(lds + D32_O1) + (wid * 32 + r32) * 64;
    f32x16 oacc[4]; float ls;
    diff32_pass(lds, DQ + qtok * 3 * MW + h * 128, DQ + MW + h * 128, vbase, b, oacc, ls);
    { const float inv = 1.0f / ls;
#pragma unroll
        for (int dt = 0; dt < 4; ++dt)
#pragma unroll
            for (int q = 0; q < 4; ++q) { const int dv = dt * 32 + 8 * q + 4 * hh;
                *(U2*)(O1 + (dv >> 1)) = (U2){pack2(oacc[dt][4 * q] * inv, oacc[dt][4 * q + 1] * inv), pack2(oacc[dt][4 * q + 2] * inv, oacc[dt][4 * q + 3] * inv)}; } }
    diff32_pass(lds, DQ + qtok * 3 * MW + h * 128 + 64, DQ + MW + h * 128 + 64, vbase, b, oacc, ls);
    const float inv2 = lam / ls; float ss = 0.f;
#pragma unroll
    for (int dt = 0; dt < 4; ++dt)
#pragma unroll
        for (int q = 0; q < 4; ++q) { const int dv = dt * 32 + 8 * q + 4 * hh; const U2 a = *(const U2*)(O1 + (dv >> 1));
            const float v0 = bflo(a.x) - oacc[dt][4 * q] * inv2, v1 = bfhi(a.x) - oacc[dt][4 * q + 1] * inv2, v2 = bflo(a.y) - oacc[dt][4 * q + 2] * inv2, v3 = bfhi(a.y) - oacc[dt][4 * q + 3] * inv2;
            oacc[dt][4 * q] = v0; oacc[dt][4 * q + 1] = v1; oacc[dt][4 * q + 2] = v2; oacc[dt][4 * q + 3] = v3; ss += (v0 * v0 + v1 * v1) + (v2 * v2 + v3 * v3); }
    ss += __shfl_xor(ss, 32);
    const float rr = rsqrtf(ss * (1.0f / 128.0f) + RMS_EPS) * (1.0f - lam_init);
    const float* nw = p.diff_norm + l * 128;
#pragma unroll
    for (int dt = 0; dt < 4; ++dt)
#pragma unroll
        for (int q = 0; q < 4; ++q) { const int dv = dt * 32 + 8 * q + 4 * hh; const F4 w = *(const F4*)(nw + dv);
            f32x4 v = (f32x4){oacc[dt][4 * q] * rr * w.x, oacc[dt][4 * q + 1] * rr * w.y, oacc[dt][4 * q + 2] * rr * w.z, oacc[dt][4 * q + 3] * rr * w.w};
            st4bf(Y + qtok * 4 * MW + 2 * MW + h * 128 + dv, v); }
}
static_assert(NTASK_GDN % 4 == 0, "gdn tasks");
__device__ __forceinline__ void gdn_decode(int chain, int n, int& b, int& h, int& dir, int& base, int& T, int& c) {
    dir = chain & 1; int bh = chain >> 1; h = bh % GH; b = bh / GH;
    if (n < NCH_CTX) { base = NLAT + b * CTX; T = CTX; c = n; } else { base = b * SEQ; T = SEQ; c = n - NCH_CTX; }
}
__device__ __forceinline__ int gdn_pos(int dir, int T, int c, int i) { int r = 64 * c + i; return dir ? T - 1 - r : r; }

constexpr int GP_K = 0, GP_V = 9216, GP_A = 18432, GP_F = GP_A + 64 * 64 * 4, GP_PAIR = GP_F + 1024;
__device__ __forceinline__ void gdn_chunk_prep4(const Params& p, char* lds, int l, int task0) {
    const int tid = TID(), wid = tid >> 6, lane = tid & 63, l15 = lane & 15, g = lane >> 4, pr = wid >> 1, w2 = wid & 1, t2 = tid & 127;
    const int task = task0 + pr, chain = task / NCH, n = task - chain * NCH;
    int b, h, dir, base, T, c; gdn_decode(chain, n, b, h, dir, base, T, c);
    char* L = lds + pr * GP_PAIR;
    bf16_t* Kt = (bf16_t*)(L + GP_K); bf16_t* Vt = (bf16_t*)(L + GP_V); float* Af = (float*)(L + GP_A); float* gcs = (float*)(L + GP_F); float* bet = gcs + 64; float* fac = gcs + 128;
    const bf16_t* GK = WSP(bf16_t, OFF_GK); const bf16_t* GV = WSP(bf16_t, OFF_GV); const float* GB = WSP(float, OFF_GB);
    __syncthreads();
#pragma unroll
    for (int q = 0; q < 4; ++q) { int pc = t2 + 128 * q, i = pc >> 3, s = pc & 7; long tok = base + gdn_pos(dir, T, c, i);
        *(U4*)(Kt + i * 72 + s * 8) = *(const U4*)(GK + tok * MW + h * 64 + s * 8);
        *(U4*)(Vt + i * 72 + s * 8) = *(const U4*)(GV + tok * MW + h * 64 + s * 8); }
    if (w2 == 0) { long tok = base + gdn_pos(dir, T, c, lane); float gi = GB[tok * 4 * GH + dir * GH + h], be = GB[tok * 4 * GH + 2 * GH + dir * GH + h];
        float cs = gi;
        for (int o = 1; o < 64; o <<= 1) { float t = __shfl_up(cs, o); if (lane >= o) cs += t; }
        gcs[lane] = cs; bet[lane] = be; fac[lane] = be * __expf(cs); }
    __syncthreads();
#pragma unroll
    for (int mi = 0; mi < 2; ++mi) { const int mt = w2 * 2 + mi;
        bf16x8 af[2];
#pragma unroll
        for (int ks = 0; ks < 2; ++ks) af[ks] = ld8(Kt + (mt * 16 + l15) * 72 + ks * 32 + g * 8);
#pragma unroll
        for (int nt = 0; nt < 4; ++nt) { f32x4 acc = (f32x4){0.f, 0.f, 0.f, 0.f};
#pragma unroll
            for (int ks = 0; ks < 2; ++ks) acc = MFMA16(af[ks], ld8(Kt + (nt * 16 + l15) * 72 + ks * 32 + g * 8), acc);
            const int jj = nt * 16 + l15; const float gj = gcs[jj];
#pragma unroll
            for (int j = 0; j < 4; ++j) { const int i = mt * 16 + g * 4 + j; Af[i * 64 + jj] = jj < i ? bet[i] * acc[j] * __expf(gcs[i] - gj) : 0.f; } }
    }
    __syncthreads();
    {
        const bf16_t* src = w2 == 0 ? Kt : Vt; const float* scl = w2 == 0 ? fac : bet;
        float x[64];
#pragma unroll
        for (int i = 0; i < 64; ++i) x[i] = scl[i] * bf2f(src[i * 72 + lane]);
#pragma unroll
        for (int j = 0; j < 63; ++j) { const float xj = x[j];
            const float* Afj = Af + j;
#ifndef CPU_EMU
            { int z; asm volatile("v_mov_b32 %0, 0" : "=v"(z) : "v"(xj)); Afj += z; }
#endif
#pragma unroll
            for (int i = j + 1; i < 64; ++i) x[i] -= Afj[i * 64] * xj; }
        bf16_t* dst = WSP(bf16_t, OFF_WU) + ((long)task * 2 + w2) * 4096 + lane;
#pragma unroll
        for (int i = 0; i < 64; ++i) dst[i * 64] = f2bf(x[i]);
    }
}

constexpr int GS_W = 0, GS_Q = 9216, GS_K = 18432, GS_KT = 27648, GS_GC = 36864, GS_STAGE = 36864 + 512;
constexpr int GS_ST = 2 * GS_STAGE, GS_VNT = GS_ST + 2 * 4608, GS_VNT2 = GS_VNT + 4608, GS_ATT = GS_VNT2 + 4608, GS_TOTAL = GS_ATT + 9216;
__device__ __forceinline__ void gdn_scan_item(const Params& p, char* lds, int l, int cb) {
    const int tid = TID(), wid = tid >> 6, lane = tid & 63, l15 = lane & 15, g = lane >> 4, mt = wid >> 1, nt = wid & 1;
    {
    const int chain = cb >> 1, half = cb & 1;
    const bf16_t* GQ = WSP(bf16_t, OFF_GQ); const bf16_t* GK = WSP(bf16_t, OFF_GK); const float* GB = WSP(float, OFF_GB); const bf16_t* WU = WSP(bf16_t, OFF_WU);
    const int sr = tid >> 3, ss = tid & 7;
    f32x4 sacc = (f32x4){0.f, 0.f, 0.f, 0.f};
    U4 rw, rq, rk; float ucur[4], unext[4]; float gnext = 0.f;
    auto load_chunk = [&](int n) {
        int b, h, dir, base, T, c; gdn_decode(chain, n, b, h, dir, base, T, c);
        const long task = (long)chain * NCH + n; const long tok = base + gdn_pos(dir, T, c, sr);
        rw = *(const U4*)(WU + (task * 2 + 0) * 4096 + sr * 64 + ss * 8);
        rq = *(const U4*)(GQ + tok * MW + h * 64 + ss * 8);
        rk = *(const U4*)(GK + tok * MW + h * 64 + ss * 8);
#pragma unroll
        for (int j = 0; j < 4; ++j) unext[j] = bf2f(WU[(task * 2 + 1) * 4096 + (mt * 16 + g * 4 + j) * 64 + half * 32 + nt * 16 + l15]);
        if (wid == 0) { const long tk = base + gdn_pos(dir, T, c, lane); gnext = GB[tk * 4 * GH + dir * GH + h]; }
    };
    auto store_chunk = [&](int st) {
        char* S = lds + st * GS_STAGE;
        *(U4*)((bf16_t*)(S + GS_W) + sr * 72 + ss * 8) = rw;
        *(U4*)((bf16_t*)(S + GS_Q) + sr * 72 + ss * 8) = rq;
        *(U4*)((bf16_t*)(S + GS_K) + sr * 72 + ss * 8) = rk;
        bf16_t* KT = (bf16_t*)(S + GS_KT);
        const u32 kw[4] = {rk.x, rk.y, rk.z, rk.w};
#pragma unroll
        for (int e = 0; e < 4; ++e) { KT[(ss * 8 + 2 * e) * 72 + sr] = (bf16_t)(kw[e] & 0xffffu); KT[(ss * 8 + 2 * e + 1) * 72 + sr] = (bf16_t)(kw[e] >> 16); }
        if (wid == 0) { float cs = gnext;
            for (int o = 1; o < 64; o <<= 1) { float t = __shfl_up(cs, o); if (lane >= o) cs += t; }
            ((float*)(S + GS_GC))[lane] = cs; }
    };
    __syncthreads();
    { bf16_t* ST0 = (bf16_t*)(lds + GS_ST); for (int i = tid; i < 32 * 72; i += NTH) ST0[i] = 0; }
    load_chunk(0); store_chunk(0);
#pragma unroll
    for (int j = 0; j < 4; ++j) ucur[j] = unext[j];
    __syncthreads();
    for (int n = 0; n < NCH; ++n) {
        const int st = n & 1;
        if (n + 1 < NCH) load_chunk(n + 1);
        const char* S = lds + st * GS_STAGE;
        const bf16_t* Wt = (const bf16_t*)(S + GS_W); const bf16_t* Qt = (const bf16_t*)(S + GS_Q); const bf16_t* Kt = (const bf16_t*)(S + GS_K); const bf16_t* KT = (const bf16_t*)(S + GS_KT);
        const float* gc = (const float*)(S + GS_GC);
        const bf16_t* STc = (const bf16_t*)(lds + GS_ST + st * 4608); bf16_t* STn = (bf16_t*)(lds + GS_ST + (st ^ 1) * 4608);
        bf16_t* VNT = (bf16_t*)(lds + GS_VNT); bf16_t* VNT2 = (bf16_t*)(lds + GS_VNT2); bf16_t* ATT = (bf16_t*)(lds + GS_ATT);
        const float gl = gc[63];
#pragma unroll
        for (int q = 0; q < 2; ++q) { const int tile = wid * 2 + q, it = tile >> 2, jt = tile & 3;
            f32x4 acc = (f32x4){0.f, 0.f, 0.f, 0.f};
            if (jt <= it) {
#pragma unroll
                for (int ks = 0; ks < 2; ++ks) acc = MFMA16(ld8(Kt + (jt * 16 + l15) * 72 + ks * 32 + g * 8), ld8(Qt + (it * 16 + l15) * 72 + ks * 32 + g * 8), acc);
            }
            const int i = it * 16 + l15; const float gi = gc[i]; float v[4];
#pragma unroll
            for (int j = 0; j < 4; ++j) { const int jp = jt * 16 + g * 4 + j; v[j] = jp <= i ? acc[j] * __expf(gi - gc[jp]) : 0.f; }
            U2 o; o.x = pack2(v[0], v[1]); o.y = pack2(v[2], v[3]); *(U2*)(ATT + i * 72 + jt * 16 + g * 4) = o; }
        {
            f32x4 acc = (f32x4){0.f, 0.f, 0.f, 0.f};
#pragma unroll
            for (int ks = 0; ks < 2; ++ks) acc = MFMA16(ld8(Wt + (mt * 16 + l15) * 72 + ks * 32 + g * 8), ld8(STc + (nt * 16 + l15) * 72 + ks * 32 + g * 8), acc);
            float vn[4], vn2[4];
#pragma unroll
            for (int j = 0; j < 4; ++j) { vn[j] = ucur[j] - acc[j]; vn2[j] = vn[j] * __expf(gl - gc[mt * 16 + g * 4 + j]); }
            U2 o; o.x = pack2(vn[0], vn[1]); o.y = pack2(vn[2], vn[3]); *(U2*)(VNT + (nt * 16 + l15) * 72 + mt * 16 + g * 4) = o;
            U2 o2; o2.x = pack2(vn2[0], vn2[1]); o2.y = pack2(vn2[2], vn2[3]); *(U2*)(VNT2 + (nt * 16 + l15) * 72 + mt * 16 + g * 4) = o2;
        }
        __syncthreads();
        {
            f32x4 a1 = (f32x4){0.f, 0.f, 0.f, 0.f}, a2 = (f32x4){0.f, 0.f, 0.f, 0.f};
#pragma unroll
            for (int ks = 0; ks < 2; ++ks) { a1 = MFMA16(ld8(Qt + (mt * 16 + l15) * 72 + ks * 32 + g * 8), ld8(STc + (nt * 16 + l15) * 72 + ks * 32 + g * 8), a1);
                a2 = MFMA16(ld8(ATT + (mt * 16 + l15) * 72 + ks * 32 + g * 8), ld8(VNT + (nt * 16 + l15) * 72 + ks * 32 + g * 8), a2); }
            int b, h, dir, base, T, c; gdn_decode(chain, n, b, h, dir, base, T, c);
            bf16_t* O = WSP(bf16_t, dir ? OFF_OB : OFF_OF);
#pragma unroll
            for (int j = 0; j < 4; ++j) { const int i = mt * 16 + g * 4 + j; const long tok = base + gdn_pos(dir, T, c, i);
                O[tok * MW + h * 64 + half * 32 + nt * 16 + l15] = f2bf(__expf(gc[i]) * a1[j] + a2[j]); }
        }
        {
            f32x4 acc = sacc * __expf(gl);
#pragma unroll
            for (int ks = 0; ks < 2; ++ks) acc = MFMA16(ld8(KT + (mt * 16 + l15) * 72 + ks * 32 + g * 8), ld8(VNT2 + (nt * 16 + l15) * 72 + ks * 32 + g * 8), acc);
            sacc = acc;
            U2 o; o.x = pack2(acc[0], acc[1]); o.y = pack2(acc[2], acc[3]); *(U2*)(STn + (nt * 16 + l15) * 72 + mt * 16 + g * 4) = o;
        }
        if (n + 1 < NCH) { store_chunk(st ^ 1);
#pragma unroll
            for (int j = 0; j < 4; ++j) ucur[j] = unext[j]; }
        __syncthreads();
    }
    }
}
constexpr int HY_X = 0, HY_T1 = 2 * SEQ * 8, HY_T2 = HY_T1 + 128 * 8, HY_W3 = HY_T2 + 128 * 8, HY_RED = HY_W3 + 2 * 64 * 4, HY_TOTAL = HY_RED + 64 * 4;
static_assert(HY_TOTAL <= 160 * 1024 - 64, "hyena lds");
__device__ __forceinline__ F2 cmul(F2 a, F2 b) { return (F2){a.x * b.x - a.y * b.y, a.x * b.y + a.y * b.x}; }
__device__ __forceinline__ F2 cmulc(F2 a, F2 b) { return (F2){a.x * b.x + a.y * b.y, a.y * b.x - a.x * b.y}; }
__device__ __forceinline__ F2 twid(const F2* T1, const F2* T2, int q) { return cmul(T1[q >> 7], T2[q & 127]); }

__device__ __forceinline__ void fft_fwd(F2* X, const F2* T1, const F2* T2, int N, int tid) {
    int M = N;
    for (; M >= 4; M >>= 2) {
        const int q4 = M >> 2, sh = N / M;
        for (int idx = tid; idx < (N >> 2); idx += NTH) { const int blk = idx / q4, j = idx - blk * q4, p0 = blk * M + j;
            F2 x0 = X[p0], x1 = X[p0 + q4], x2 = X[p0 + 2 * q4], x3 = X[p0 + 3 * q4];
            const F2 w1 = twid(T1, T2, j * sh), w2 = twid(T1, T2, 2 * j * sh);
            F2 a0 = x0 + x2, a2 = cmul(x0 - x2, w1), a1 = x1 + x3, d = cmul(x1 - x3, w1); F2 a3 = (F2){d.y, -d.x};
            X[p0] = a0 + a1; X[p0 + q4] = cmul(a0 - a1, w2); X[p0 + 2 * q4] = a2 + a3; X[p0 + 3 * q4] = cmul(a2 - a3, w2); }
        __syncthreads();
    }
    if (M == 2) { for (int idx = tid; idx < (N >> 1); idx += NTH) { F2 x0 = X[2 * idx], x1 = X[2 * idx + 1]; X[2 * idx] = x0 + x1; X[2 * idx + 1] = x0 - x1; } __syncthreads(); }
}
__device__ __forceinline__ void fft_inv(F2* X, const F2* T1, const F2* T2, int N, int tid) {
    int lg = 0; while ((1 << lg) < N) ++lg;
    int M = 4;
    if (lg & 1) { for (int idx = tid; idx < (N >> 1); idx += NTH) { F2 y0 = X[2 * idx], y1 = X[2 * idx + 1]; X[2 * idx] = y0 + y1; X[2 * idx + 1] = y0 - y1; } __syncthreads(); M = 8; }
    for (; M <= N; M <<= 2) {
        const int q4 = M >> 2, sh = N / M;
        for (int idx = tid; idx < (N >> 2); idx += NTH) { const int blk = idx / q4, j = idx - blk * q4, p0 = blk * M + j;
            F2 y0 = X[p0], y1 = X[p0 + q4], y2 = X[p0 + 2 * q4], y3 = X[p0 + 3 * q4];
            const F2 w1 = twid(T1, T2, j * sh), w2 = twid(T1, T2, 2 * j * sh);
            F2 t = cmulc(y1, w2); F2 a0 = y0 + t, a1 = y0 - t; t = cmulc(y3, w2); F2 a2 = y2 + t, a3 = y2 - t;
            t = cmulc(a2, w1); X[p0] = a0 + t; X[p0 + 2 * q4] = a0 - t;
            F2 u = cmulc(a3, w1); t = (F2){-u.y, u.x}; X[p0 + q4] = a1 + t; X[p0 + 3 * q4] = a1 - t; }
        __syncthreads();
    }
}

__device__ __forceinline__ void hyena_item(const Params& p, char* lds, int l, int ch, bool ctxs) {
    const int tid = TID(), bid = BID(), lane = tid & 63, wid = tid >> 6;
    const int L = ctxs ? CTX : SEQ, N = 2 * L, k0 = ctxs ? SEQ : 0;
    F2* X = (F2*)(lds + HY_X); F2* T1 = (F2*)(lds + HY_T1); F2* T2 = (F2*)(lds + HY_T2); float* w3s = (float*)(lds + HY_W3); float* red = (float*)(lds + HY_RED);
    const bf16_t* HYT = WSP(bf16_t, OFF_HYT); const float* H2F = WSP(float, OFF_H2F) + (long)k0 * 64;
    F2* HF = WSP(F2, OFF_HF) + (long)bid * 2 * SEQ; float* ZT = WSP(float, OFF_ZT) + (long)bid * 2 * SEQ; bf16_t* YAT = WSP(bf16_t, OFF_YAT);
    __syncthreads();
    if (tid < 128) { float s, c; float a = -6.283185307179586f * (float)(tid * 128) / (float)N; s = sinf(a); c = cosf(a); T1[tid] = (F2){c, s}; }
    else if (tid < 256) { int b_ = tid - 128; float s, c; float a = -6.283185307179586f * (float)b_ / (float)N; s = sinf(a); c = cosf(a); T2[b_] = (F2){c, s}; }
    auto hyu = [&](int seg, int b, int t) -> float { const int col = seg * MW + ch; const bf16_t* r = HYT + ((long)b * 3 * MW + col) * KEYS + k0 + t; const float* w = p.hy_conv + ((long)l * 3 * MW + col) * 3;
        float a = bf2f(r[0]) * w[1]; if (t > 0) a += bf2f(r[-1]) * w[0]; if (t + 1 < L) a += bf2f(r[1]) * w[2]; return a; };
    for (int o = 0; o < 2; ++o) {
        const int colf = o * HYW + ch, colb = 2 * HYW + o * HYW + ch;
        if (tid < 128) { int d = tid >> 6, k = tid & 63; w3s[d * 64 + k] = p.hy_w3[((long)l * 64 + k) * 4 * HYW + (d ? colb : colf)]; }
        __syncthreads();
        const float df = fabsf(p.hy_deltas[((long)(l * 2 + 0) * 2 + o) * HYW + ch]), db = fabsf(p.hy_deltas[((long)(l * 2 + 1) * 2 + o) * HYW + ch]);
        float nrm = 0.f;
        for (int t = tid; t < L; t += NTH) { const float* hr = H2F + (long)t * 64; float af = 0.f, ab = 0.f;
#pragma unroll
            for (int k4 = 0; k4 < 16; ++k4) { F4 h = *(const F4*)(hr + k4 * 4);
                af += h.x * w3s[k4 * 4] + h.y * w3s[k4 * 4 + 1] + h.z * w3s[k4 * 4 + 2] + h.w * w3s[k4 * 4 + 3];
                ab += h.x * w3s[64 + k4 * 4] + h.y * w3s[64 + k4 * 4 + 1] + h.z * w3s[64 + k4 * 4 + 2] + h.w * w3s[64 + k4 * 4 + 3]; }
            const float tl = (float)t / (float)(L - 1);
            af *= __expf(-tl * df) + 0.05f; ab *= __expf(-tl * db) + 0.05f;
            X[t] = (F2){af, 0.f}; nrm += fabsf(af);
            if (t == 0) X[L] = (F2){0.f, 0.f}; else { X[N - t] = (F2){ab, 0.f}; nrm += fabsf(ab); } }
        nrm = wave_sum(nrm);
        if (lane == 0) red[wid] = nrm;
        __syncthreads();
        float tot = 0.f;
#pragma unroll
        for (int w = 0; w < 8; ++w) tot += red[w];
        const float sc = 1.0f / (tot * (float)N);
        fft_fwd(X, T1, T2, N, tid);
        for (int i = tid; i < N; i += NTH) HF[i] = X[i];
        __syncthreads();
        for (int t = tid; t < L; t += NTH) { float z0, z1; if (o == 0) { z0 = hyu(0, 0, t); z1 = hyu(0, 1, t); } else { z0 = ZT[t]; z1 = ZT[SEQ + t]; }
            X[t] = (F2){z0, z1}; X[L + t] = (F2){0.f, 0.f}; }
        __syncthreads();
        fft_fwd(X, T1, T2, N, tid);
        for (int i = tid; i < N; i += NTH) X[i] = cmul(X[i], HF[i]);
        __syncthreads();
        fft_inv(X, T1, T2, N, tid);
        const float sk = p.hy_skip[((long)l * 2 + o) * HYW + ch];
        for (int t = tid; t < L; t += NTH) { F2 y = X[t]; float z0, z1; if (o == 0) { z0 = hyu(0, 0, t); z1 = hyu(0, 1, t); } else { z0 = ZT[t]; z1 = ZT[SEQ + t]; }
            float r0 = hyu(1 + o, 0, t) * (y.x * sc + z0 * sk), r1 = hyu(1 + o, 1, t) * (y.y * sc + z1 * sk);
            if (o == 0) { ZT[t] = r0; ZT[SEQ + t] = r1; }
            else { YAT[((long)0 * MW + ch) * KEYS + k0 + t] = f2bf(r0); YAT[((long)1 * MW + ch) * KEYS + k0 + t] = f2bf(r1); } }
        __syncthreads();
    }
}

__device__ __forceinline__ void phase_gdn_prep(const Params& p, char* lds, int l) {
    const int bid = BID(), G = gridDim.x;
    for (int rep_ = 0; rep_ < REP_GP; ++rep_) for (int it = bid; it < NTASK_GDN / 4; it += G) gdn_chunk_prep4(p, lds, l, it * 4);
}
__device__ __forceinline__ void phase_mixers(const Params& p, char* lds, int l) {
    const int tid = TID(), lane = tid & 63;
    const bool ctx_out = l < DEPTH - 1;
    float lam, lam_init;
    { const float* dl = p.diff_lam + (long)l * 4 * 64; float a = wave_sum(dl[lane] * dl[64 + lane]), b = wave_sum(dl[128 + lane] * dl[192 + lane]);
        lam_init = 0.8f - 0.6f * expf(-0.3f * (float)l); lam = expf(a) - expf(b) + lam_init; }
    constexpr int NSCAN = BATCH * GH * 2 * 2, NQT_L = SEQ / 256, U_DL = BATCH * DH * NQT_L, U_HY = MW, U_NA = BATCH * NH * (R_ROWS / 2);
    constexpr int NQC = CTX / 128, U_DC = BATCH * DH * NQC, U_NC = BATCH * NH * NQC, U_HC = MW;
    const int e0 = NSCAN, e1 = e0 + U_DL, e2 = e1 + U_HY, e3 = e2 + U_NA, e4 = e3 + (ctx_out ? U_DC : 0), e5 = e4 + (ctx_out ? U_NC : 0), e6 = e5 + (ctx_out ? U_HC : 0);
    u32* qctr = WSP(u32, OFF_CNT) + 64 + l;
    int* qs = (int*)(lds + LDS_BYTES - 16);
    for (;;) {
        __syncthreads();
        if (tid == 0) qs[0] = (int)atomicAdd(qctr, 1u);
        __syncthreads();
        const int u = qs[0];
        if (u >= e6) break;
        if (u < e0) gdn_scan_item(p, lds, l, u);
        else if (u < e1) { int v = u - e0; int b = v / (DH * NQT_L), r = v - b * DH * NQT_L, h = r / NQT_L, qt = r - h * NQT_L; diff32_item(p, lds, l, b, h, qt * 256, lam, lam_init); }
        else if (u < e2) hyena_item(p, lds, l, u - e1, false);
        else if (u < e3) { int v = u - e2; int b = v / (NH * (R_ROWS / 2)), r = v - b * NH * (R_ROWS / 2), h = r / (R_ROWS / 2), rp = r - h * (R_ROWS / 2); na_attn_item(p, lds, l, b, h, rp); }
        else if (u < e4) { int v = u - e3; int b = v / (DH * NQC), r = v - b * DH * NQC, h = r / NQC, q = r - h * NQC; diff_attn_item<1>(p, lds, l, b, h, q * 128, true, lam, lam_init); }
        else if (u < e5) { int v = u - e4; int b = v / (NH * NQC), r = v - b * NH * NQC, h = r / NQC, q = r - h * NQC; na_ctx_item(p, lds, b, h, q * 128); }
        else hyena_item(p, lds, l, u - e5, true);
    }
}

__device__ __forceinline__ void phase_finish(const Params& p, char* lds, int l) {
    const int tid = TID(), bid = BID(), G = gridDim.x, lane = tid & 63, wid = tid >> 6;
    bf16_t* Y = WSP(bf16_t, OFF_Y);
    { const bf16_t* OFp = WSP(bf16_t, OFF_OF); const bf16_t* OBp = WSP(bf16_t, OFF_OB); const bf16_t* GZ = WSP(bf16_t, OFF_GZ); const float nw = p.gdn_norm[l * 64 + lane];
        for (long i = (long)bid * 8 + wid; i < (long)NTOK * GH; i += (long)G * 8) { long tok = i / GH; int h = (int)(i - tok * GH);
            float v = bf2f(OFp[tok * MW + h * 64 + lane]) + bf2f(OBp[tok * MW + h * 64 + lane]);
            float ms = wave_sum(v * v) * (1.0f / 64.0f);
            float z = bf2f(GZ[tok * MW + h * 64 + lane]);
            Y[tok * 4 * MW + MW + h * 64 + lane] = f2bf(v * rsqrtf(ms + RMS_EPS) * nw * siluf(z)); } }
    { const bf16_t* YAT = WSP(bf16_t, OFF_YAT); bf16_t* t = (bf16_t*)lds;
        constexpr int KT_ = KEYS / 64, CT_ = MW / 64;
        for (int u = bid; u < BATCH * CT_ * KT_; u += G) { int b = u / (CT_ * KT_), r = u - b * CT_ * KT_, ct = r / KT_, kt = r - ct * KT_;
            __syncthreads();
            { int c = tid >> 3, s = tid & 7; *(U4*)(t + c * 72 + s * 8) = *(const U4*)(YAT + ((long)b * MW + ct * 64 + c) * KEYS + kt * 64 + s * 8); }
            __syncthreads();
            { int k = tid >> 3, c8 = (tid & 7) * 8; long tok = bk_tok(b, kt * 64 + k);
                U4 o; o.x = (u32)t[(c8 + 0) * 72 + k] | ((u32)t[(c8 + 1) * 72 + k] << 16); o.y = (u32)t[(c8 + 2) * 72 + k] | ((u32)t[(c8 + 3) * 72 + k] << 16);
                o.z = (u32)t[(c8 + 4) * 72 + k] | ((u32)t[(c8 + 5) * 72 + k] << 16); o.w = (u32)t[(c8 + 6) * 72 + k] | ((u32)t[(c8 + 7) * 72 + k] << 16);
                *(U4*)(Y + tok * 4 * MW + ct * 64 + c8) = o; } } }
}
__device__ __forceinline__ void phase_merge1(const Params& p, char* lds, int l) {
    const int tid = TID(), wid = tid >> 6, lane = tid & 63, wm = wid >> 1, wn = wid & 1, l15 = lane & 15, g = lane >> 4;
    const bf16_t* Y = WSP(bf16_t, OFF_Y); const bf16_t* BP = WSP(bf16_t, OFF_BP); const bf16_t* GATE = WSP(bf16_t, OFF_SEG_GATE); bf16_t* MIXG = WSP(bf16_t, OFF_MIXG);
    constexpr int MT = 2, BM1 = 64 * MT, ntm = NTOK / BM1, ntn = D / G_BN;
    for (int u = BID(); u < ntm * ntn; u += gridDim.x) {
        const int tn = u / ntm, tm = u - tn * ntm, row0 = tm * BM1, col0 = tn * G_BN;
        f32x4 tot[MT][4];
#pragma unroll
        for (int m = 0; m < MT; ++m)
#pragma unroll
            for (int n = 0; n < 4; ++n) tot[m][n] = (f32x4){0.f, 0.f, 0.f, 0.f};
        for (int br = 0; br < 4; ++br) {
            f32x4 acc[MT][4];
            gemm_tile<MT>(lds, [&](int r) { return Y + (long)(row0 + r) * 4 * MW + br * MW; }, BP + (long)col0 * 4 * MW + br * MW, 4 * MW, MW, acc);
#pragma unroll
            for (int m = 0; m < MT; ++m) { const long row = row0 + wm * 16 * MT + m * 16 + l15;
#pragma unroll
                for (int n = 0; n < 4; ++n) { U2 gv = *(const U2*)(GATE + row * 4 * D + br * D + col0 + wn * 64 + n * 16 + g * 4);
                    tot[m][n][0] += sigmoidf(bflo(gv.x)) * acc[m][n][0]; tot[m][n][1] += sigmoidf(bfhi(gv.x)) * acc[m][n][1];
                    tot[m][n][2] += sigmoidf(bflo(gv.y)) * acc[m][n][2]; tot[m][n][3] += sigmoidf(bfhi(gv.y)) * acc[m][n][3]; } }
        }
#pragma unroll
        for (int m = 0; m < MT; ++m) { const long row = row0 + wm * 16 * MT + m * 16 + l15;
#pragma unroll
            for (int n = 0; n < 4; ++n) st4bf(MIXG + row * D + col0 + wn * 64 + n * 16 + g * 4, tot[m][n]); }
    }
}
__device__ __forceinline__ void phase_merge2(const Params& p, char* lds, int l) {
    const int tid = TID(), wid = tid >> 6, lane = tid & 63, wm = wid >> 1, wn = wid & 1, l15 = lane & 15, g = lane >> 4;
    const bf16_t* MIXG = WSP(bf16_t, OFF_MIXG); const bf16_t* WO = WSP(bf16_t, OFF_WO); float* MIX = WSP(float, OFF_MIX);
    constexpr int ntm = NTOK / G_BM, ntn = D / G_BN;
    for (int u = BID(); u < ntm * ntn; u += gridDim.x) {
        const int tn = u / ntm, tm = u - tn * ntm, row0 = tm * G_BM, col0 = tn * G_BN;
        f32x4 acc[4][4];
        gemm_tile(lds, [&](int r) { return MIXG + (long)(row0 + r) * D; }, WO + (long)col0 * D, D, D, acc);
#pragma unroll
        for (int m = 0; m < 4; ++m) { const long row = row0 + wm * 64 + m * 16 + l15;
#pragma unroll
            for (int n = 0; n < 4; ++n) { F4 o; o.x = acc[m][n][0]; o.y = acc[m][n][1]; o.z = acc[m][n][2]; o.w = acc[m][n][3]; *(F4*)(MIX + row * D + col0 + wn * 64 + n * 16 + g * 4) = o; } }
    }
}
struct MoeMap { int cnt[NE], off[NE], tile0[NE + 1]; };
__device__ __forceinline__ void moe_map_load(const Params& p, int* sm  ) {
    const int tid = TID();
    __syncthreads();
    if (tid == 0) { const u32* CNT = WSP(u32, OFF_CNT); int o = 0, t = 0;
        for (int e = 0; e < NE; ++e) { int c = (int)CNT[e]; sm[e] = c; sm[NE + e] = o; sm[2 * NE + e] = t; o += c; t += (c + G_BM - 1) / G_BM; }
        sm[3 * NE] = t; }
    __syncthreads();
}
__device__ __forceinline__ void phase_moe1(const Params& p, char* lds, int l) {
    const int tid = TID(), wid = tid >> 6, lane = tid & 63, wm = wid >> 1, wn = wid & 1, l15 = lane & 15, g = lane >> 4;
    int* sm = (int*)(lds + G_LDS);
    moe_map_load(p, sm);
    const bf16_t* H = WSP(bf16_t, OFF_H); const bf16_t* W13 = WSP(bf16_t, OFF_W13); bf16_t* HMID = WSP(bf16_t, OFF_HMID); const int* ELIST = WSP(int, OFF_ELIST);
    constexpr int ntn = 2 * EFF / G_BN;
    const int ntile = sm[3 * NE];
    for (int u = BID(); u < ntile * ntn; u += gridDim.x) {
        const int tn = u / ntile, tg = u - tn * ntile;
        int e = 0;
#pragma unroll
        for (int q = 1; q < NE; ++q) if (tg >= sm[2 * NE + q]) e = q;
        const int mt = tg - sm[2 * NE + e], cnt = sm[e], r0 = mt * G_BM, nrow = cnt - r0 < G_BM ? cnt - r0 : G_BM;
        const int* el = ELIST + (long)e * NTOK;
        f32x4 acc[4][4];
        gemm_tile(lds, [&](int r) { int rr = r < nrow ? r0 + r : r0; return H + (long)el[rr] * D; }, W13 + ((long)e * 2 * EFF + tn * G_BN) * D, D, D, acc);
        const long orow0 = (long)sm[NE + e] + r0;
#pragma unroll
        for (int m = 0; m < 4; ++m) { const int r = wm * 64 + m * 16 + l15;
            if (r < nrow) {
#pragma unroll
                for (int n2 = 0; n2 < 2; ++n2) { f32x4 a = acc[m][2 * n2], b = acc[m][2 * n2 + 1], hmid;
#pragma unroll
                    for (int j = 0; j < 4; ++j) hmid[j] = siluf(a[j]) * b[j];
                    st4bf(HMID + (orow0 + r) * EFF + tn * (G_BN / 2) + wn * 32 + n2 * 16 + g * 4, hmid); } } }
    }
}
__device__ __forceinline__ void phase_moe2(const Params& p, char* lds, int l) {
    const int tid = TID(), wid = tid >> 6, lane = tid & 63, wm = wid >> 1, wn = wid & 1, l15 = lane & 15, g = lane >> 4;
    int* sm = (int*)(lds + G_LDS);
    moe_map_load(p, sm);
    const bf16_t* HMID = WSP(bf16_t, OFF_HMID); const bf16_t* W2 = WSP(bf16_t, OFF_W2); bf16_t* YE = WSP(bf16_t, OFF_YE);
    constexpr int ntn = D / G_BN;
    const int ntile = sm[3 * NE];
    for (int u = BID(); u < ntile * ntn; u += gridDim.x) {
        const int tn = u / ntile, tg = u - tn * ntile;
        int e = 0;
#pragma unroll
        for (int q = 1; q < NE; ++q) if (tg >= sm[2 * NE + q]) e = q;
        const int mt = tg - sm[2 * NE + e], cnt = sm[e], r0 = mt * G_BM, nrow = cnt - r0 < G_BM ? cnt - r0 : G_BM;
        const long orow0 = (long)sm[NE + e] + r0;
        f32x4 acc[4][4];
        gemm_tile(lds, [&](int r) { return HMID + (orow0 + r) * EFF; }, W2 + ((long)e * D + tn * G_BN) * EFF, EFF, EFF, acc);
#pragma unroll
        for (int m = 0; m < 4; ++m) { const int r = wm * 64 + m * 16 + l15;
            if (r < nrow) {
#pragma unroll
                for (int n = 0; n < 4; ++n) st4bf(YE + (orow0 + r) * D + tn * G_BN + wn * 64 + n * 16 + g * 4, acc[m][n]); } }
    }
}
#define PHASE_END(id) do { GSYNC(); if (p.stop_phase == (id)) return; } while (0)

#if defined(CPU_EMU) || !defined(KARG_LAUNDER)
#define PP p_in
#else
__device__ __forceinline__ const Params& launder_params(const Params* q) { asm volatile("" : "+s"(q)); return *q; }
#define PP launder_params(kargs)
#endif
__global__ void __launch_bounds__(NTH, 2) fwd_kernel(Params p_in) {
#ifdef CPU_EMU
    char* lds = emu_lds();
    const Params& p = p_in;
#else
#ifdef KARG_LAUNDER
    const Params* kargs = (const Params*)__builtin_amdgcn_kernarg_segment_ptr();
    const Params& p = *kargs;
#else
    const Params& p = p_in;
#endif
    extern __shared__ __attribute__((aligned(16))) char lds_raw[];
    char* lds = lds_raw + 16;
    if (threadIdx.x == 0) *(uint4*)lds_raw = make_uint4(0u, 0u, 0u, 0u);
    __syncthreads();
    XcdBarrier xbar = xcd_barrier_post((unsigned*)(p.ws + OFF_BAR), (volatile LAS unsigned*)lds_raw);
#endif
    phase_prologue(PP, lds);
    PHASE_END(1);
    for (int l = 0; l < DEPTH; ++l) {
        const int pb = 100 * (l + 1);
        phase_weights(PP, lds, l);
        PHASE_END(pb + 0);
        if (l == 0) { phase_modulate0(PP, l); PHASE_END(pb + 1); }
        for (int rep_ = 0; rep_ < REP_IP; ++rep_) phase_inproj(PP, lds, 0);
        PHASE_END(pb + 2);
        phase_prep(PP, lds, l);
        PHASE_END(pb + 3);
        phase_gdn_prep(PP, lds, l);
        PHASE_END(pb + 4);
        phase_mixers(PP, lds, l);
        PHASE_END(pb + 5);
        phase_finish(PP, lds, l);
        PHASE_END(pb + 6);
        for (int rep_ = 0; rep_ < REP_IP; ++rep_) phase_inproj(PP, lds, 1);
        PHASE_END(pb + 7);
        phase_merge1(PP, lds, l);
        PHASE_END(pb + 8);
        phase_merge2(PP, lds, l);
        phase_expert_weights(PP, lds, l);
        PHASE_END(pb + 9);
        phase_post_mix(PP, l);
        PHASE_END(pb + 10);
        phase_moe1(PP, lds, l);
        PHASE_END(pb + 11);
        phase_moe2(PP, lds, l);
        PHASE_END(pb + 12);
        phase_post_moe(PP, l);
        PHASE_END(pb + 13);
    }
}

extern "C" void kernel_launch(void* const* d_in, const int* in_sizes, int n_in, void* d_out, int out_size, void* d_ws, size_t ws_size, hipStream_t stream) {
    (void)in_sizes; (void)n_in; (void)out_size;
    if (ws_size < WS_NEED) return;
    Params p;
    memset(&p, 0, sizeof(p));
    const float** pp = (const float**)&p;
    for (int i = 0; i < 32; ++i) pp[i] = (const float*)d_in[i];
    p.out = (float*)d_out; p.ws = (char*)d_ws; p.stop_phase = -1;
#ifdef CPU_EMU
    { const char* sp = getenv("EMU_STOP"); if (sp) p.stop_phase = atoi(sp); }
    memset(d_ws, 0, SZ_BAR);
    int grid = 4; { const char* g = getenv("EMU_GRID"); if (g) grid = atoi(g); }
    emu_launch([](void* a) { fwd_kernel(*(Params*)a); }, &p, grid, NTH, LDS_BYTES);
#else
    static int grid = 0;
    if (!grid) {
        int dev = 0, cus = 0, per_cu = 0;
        (void)hipGetDevice(&dev);
        (void)hipDeviceGetAttribute(&cus, hipDeviceAttributeMultiprocessorCount, dev);
        (void)hipFuncSetAttribute((const void*)fwd_kernel, hipFuncAttributeMaxDynamicSharedMemorySize, LDS_BYTES + 16);
        (void)hipOccupancyMaxActiveBlocksPerMultiprocessor(&per_cu, (const void*)fwd_kernel, NTH, LDS_BYTES + 16);
        grid = per_cu >= 1 ? cus : 0;
        if (grid > GRID_MAX) grid = GRID_MAX;
    }
    if (!grid) return;
    (void)hipMemsetAsync(d_ws, 0, SZ_BAR, stream);
    hipLaunchKernelGGL(fwd_kernel, dim3(grid), dim3(NTH), LDS_BYTES + 16, stream, p);
#endif
}
```

```cpp
#ifdef CPU_EMU
#define SCHED_FENCE()
#define WAIT_LGKM()
#define WAIT_VM0()
#else
#include <hip/hip_runtime.h>
typedef short bf16x8 __attribute__((ext_vector_type(8)));
typedef float f32x4 __attribute__((ext_vector_type(4)));
#define SCHED_FENCE() __builtin_amdgcn_sched_barrier(0)
#define WAIT_LGKM() asm volatile("s_waitcnt lgkmcnt(0)" ::: "memory")
#define WAIT_VM0() asm volatile("s_waitcnt vmcnt(0)" ::: "memory")
#endif
#include <cstdint>
#include <cstddef>
#include <cstring>
#include <cstdlib>

#ifndef REP_DIFF
#define REP_DIFF 1
#endif
#ifndef REP_HY
#define REP_HY 1
#endif
#ifndef REP_NA
#define REP_NA 1
#endif
#ifndef REP_GP
#define REP_GP 1
#endif
#ifndef REP_GS
#define REP_GS 1
#endif
#ifndef REP_IP
#define REP_IP 1
#endif
#ifndef REP_W
#define REP_W 1
#endif
#ifndef REP_MG
#define REP_MG 1
#endif
#ifndef REP_MOE
#define REP_MOE 1
#endif
#ifndef REP_FIN
#define REP_FIN 1
#endif
typedef unsigned short bf16_t;
typedef unsigned int u32;
constexpr int LDS_BYTES = 160 * 1024 - 64;
typedef u32 U2 __attribute__((ext_vector_type(2)));
typedef u32 U4 __attribute__((ext_vector_type(4)));
typedef float F4 __attribute__((ext_vector_type(4)));
typedef float F2 __attribute__((ext_vector_type(2)));

#ifdef SMALL_DIMS
constexpr int D = 256, BATCH = 2, SEQ = 1024, DEPTH = 2, CTX = 128, GRID_MAX = 8;
#else
constexpr int D = 1024, BATCH = 2, SEQ = 8192, DEPTH = 4, CTX = 256, GRID_MAX = 256;
#endif
constexpr int NTH = 512;
constexpr int GW = 64, HD = 64;
constexpr int MW = D / 2;
constexpr int HYW = MW, HY_HID = 64, HY_BANDS = 16, HY_EMB = 33;
constexpr int GH = MW / 64, DH = MW / 128, NH = MW / 64;
constexpr int NE = 16, EFF = D / 2;
constexpr int NLAT = BATCH * SEQ, NCTX = BATCH * CTX, NTOK = NLAT + NCTX;
constexpr int KEYS = SEQ + CTX;
constexpr int IN_TOTAL = 13 * MW + 4 * GH + 4 * D;
constexpr int SRC_HY = 0, SRC_GQKV = 3 * MW, SRC_GZ = 6 * MW, SRC_GA = 7 * MW, SRC_DQKV = 7 * MW + 4 * GH, SRC_NQKV = 10 * MW + 4 * GH, SRC_GATE = 13 * MW + 4 * GH;
constexpr int GAB_W = ((13 * MW + 128) % 256 == 0) ? 128 : 256;
constexpr int MY_HY = 0, MY_GQKV = 3 * MW, MY_GZ = 6 * MW, MY_DQKV = 7 * MW, MY_NQKV = 10 * MW, MY_GAB = 13 * MW, MY_GATE = 13 * MW + GAB_W, NPROJ1 = 13 * MW + GAB_W, NPROJ = NPROJ1 + 4 * D;
constexpr float LN_EPS = 1e-5f, RMS_EPS = 1e-6f;
constexpr int NSLOT = 2 * NTOK;
constexpr int R_ROWS = SEQ / GW;
constexpr int NCH_LAT = SEQ / 64, NCH_CTX = CTX / 64, NCH = NCH_LAT + NCH_CTX;
constexpr int NTASK_GDN = BATCH * GH * 2 * NCH;
static_assert(KEYS % 192 == 0 && NTOK % 192 == 0 && NTOK % 256 == 0 && MW % 128 == 0 && SEQ % 256 == 0 && CTX % 64 == 0, "dims");

constexpr size_t al256(size_t x) { return (x + 255) & ~(size_t)255; }
constexpr size_t SZ_BAR = 16384;
constexpr size_t OFF_BAR = 0;
constexpr size_t OFF_CNT = OFF_BAR + SZ_BAR;
constexpr size_t OFF_MODP = OFF_CNT + 4096;
constexpr size_t OFF_MOD = OFF_MODP + al256((size_t)DEPTH * 8 * 3 * 6 * D * 4);
constexpr size_t OFF_XS = OFF_MOD + al256((size_t)DEPTH * 3 * 6 * D * 4);
constexpr size_t OFF_H = OFF_XS + (size_t)NTOK * D * 4;
constexpr size_t OFF_GZ = OFF_H + (size_t)NTOK * D * 2;
constexpr size_t OFF_GAB = OFF_GZ + (size_t)NTOK * MW * 2;
constexpr size_t OFF_GB = OFF_GAB + (size_t)NTOK * 32 * 4;
constexpr size_t OFF_Y = OFF_GB + (size_t)NTOK * 4 * GH * 4;
constexpr size_t OFF_WIN = OFF_Y + (size_t)NTOK * 4 * MW * 2;
constexpr size_t OFF_BP = OFF_WIN + (size_t)NPROJ * D * 2;
constexpr size_t OFF_WO = OFF_BP + (size_t)D * 4 * MW * 2;
constexpr size_t OFF_H2F = OFF_WO + (size_t)D * D * 2;
constexpr size_t OFF_H2B = OFF_H2F + al256((size_t)KEYS * 64 * 4);
constexpr size_t OFF_W3T = OFF_H2B + (size_t)KEYS * 128 * 2;
constexpr size_t OFF_RWT = OFF_W3T + (size_t)4 * HYW * 128 * 2;
constexpr size_t OFF_TOKE = OFF_RWT + (size_t)16 * D * 4;
constexpr size_t OFF_TOKR = OFF_TOKE + (size_t)NTOK * 2 * 4;
constexpr size_t OFF_TOKW = OFF_TOKR + (size_t)NTOK * 2 * 4;
constexpr size_t OFF_ELIST = OFF_TOKW + (size_t)NTOK * 2 * 4;
constexpr size_t OFF_RC = OFF_ELIST + (size_t)NE * NTOK * 4;
constexpr size_t OFF_DVT = OFF_RC;
constexpr size_t OFF_NVT = OFF_DVT + (size_t)BATCH * MW * KEYS * 2;
constexpr size_t OFF_GQ = OFF_NVT + (size_t)BATCH * MW * KEYS * 2;
constexpr size_t OFF_GK = OFF_GQ + (size_t)NTOK * MW * 2;
constexpr size_t OFF_GV = OFF_GK + (size_t)NTOK * MW * 2;
constexpr size_t OFF_RA = OFF_GV + (size_t)NTOK * MW * 2;
constexpr size_t SZ_SEG3 = (size_t)NTOK * 3 * MW * 2;
constexpr size_t OFF_SEG_HY = OFF_RA;
constexpr size_t OFF_SEG_GQKV = OFF_RA + SZ_SEG3;
constexpr size_t OFF_SEG_DQKV = OFF_RA + 2 * SZ_SEG3;
constexpr size_t OFF_SEG_NQKV = OFF_RA + 3 * SZ_SEG3;
constexpr size_t SZ_RA_W = (size_t)NTOK * 4 * D * 2 + (size_t)NE * 3 * EFF * D * 2;
constexpr size_t SZ_RA = 4 * SZ_SEG3 > SZ_RA_W ? 4 * SZ_SEG3 : SZ_RA_W;
constexpr size_t OFF_OF = OFF_RA;
constexpr size_t OFF_OB = OFF_OF + (size_t)NTOK * MW * 2;
constexpr size_t OFF_YAT = OFF_OB + (size_t)NTOK * MW * 2;
constexpr size_t OFF_HF = OFF_YAT + (size_t)BATCH * MW * KEYS * 2;
constexpr size_t HY_XN = 2 * SEQ + ((2 * SEQ) >> 6) * 4;
constexpr size_t OFF_SEG_GATE = OFF_RA;
constexpr size_t OFF_W13 = OFF_RA + (size_t)NTOK * 4 * D * 2;
constexpr size_t OFF_W2 = OFF_W13 + (size_t)NE * 2 * EFF * D * 2;
static_assert(OFF_HF + (size_t)GRID_MAX * HY_XN * 8 <= OFF_SEG_DQKV, "R1 overflow");
static_assert((size_t)NTOK * 4 * D * 2 <= SZ_RA, "gate overflow");
static_assert(OFF_W2 + (size_t)NE * D * EFF * 2 <= OFF_RA + SZ_RA, "expert weights overflow");
constexpr size_t OFF_RB = OFF_RA + SZ_RA;
constexpr size_t OFF_HYT = OFF_RB;
constexpr size_t OFF_WU = OFF_HYT + (size_t)BATCH * 3 * MW * KEYS * 2;
constexpr size_t OFF_TAPS = OFF_WU + (size_t)NTASK_GDN * 2 * 64 * 64 * 2;
constexpr size_t OFF_ZT = OFF_TAPS + (size_t)4 * HYW * KEYS * 2;
static_assert((size_t)GRID_MAX * 2 * SEQ * 4 <= (size_t)4 * HYW * KEYS * 2, "ZT overflow");
constexpr size_t OFF_MIXG = OFF_RB;
constexpr size_t OFF_MIX = OFF_MIXG + (size_t)NTOK * D * 2;
constexpr size_t OFF_HMID = OFF_MIX + (size_t)NTOK * D * 4;
constexpr size_t OFF_YE = OFF_HMID + (size_t)(NSLOT + 256) * EFF * 2;
constexpr size_t SZ_RB_LATE = OFF_YE + (size_t)(NSLOT + 256) * D * 2 - OFF_RB;
constexpr size_t SZ_RB_EARLY = OFF_TAPS + (size_t)4 * HYW * KEYS * 4 - OFF_RB;
constexpr size_t SZ_RB = SZ_RB_LATE > SZ_RB_EARLY ? SZ_RB_LATE : SZ_RB_EARLY;
constexpr size_t SZ_WSET = (size_t)NPROJ * D * 2 + (size_t)D * 4 * MW * 2 + (size_t)D * D * 2;
constexpr size_t OFF_WSET2 = OFF_RB + SZ_RB;
constexpr size_t WS_NEED = OFF_WSET2 + SZ_WSET;
__host__ __device__ constexpr size_t off_win(int l) { return (l & 1) ? OFF_WSET2 : OFF_WIN; }
__host__ __device__ constexpr size_t off_bp(int l) { return (l & 1) ? OFF_WSET2 + (size_t)NPROJ * D * 2 : OFF_BP; }
__host__ __device__ constexpr size_t off_wo(int l) { return (l & 1) ? OFF_WSET2 + (size_t)NPROJ * D * 2 + (size_t)D * 4 * MW * 2 : OFF_WO; }

struct Params {
    const float *x, *c, *ctx, *c_ctx, *w_mod, *b_mod, *w_in, *hy_conv, *hy_w1, *hy_b1, *hy_w2, *hy_b2, *hy_w3, *hy_freq, *hy_deltas, *hy_skip,
        *gdn_conv, *gdn_a_log, *gdn_dt_bias, *gdn_norm, *diff_lam, *diff_norm, *na_rpb, *branch_proj, *w_out, *ln_g, *ln_b, *router_w, *router_b,
        *exp_w1, *exp_w3, *exp_w2;
    float* out; char* ws; long long stop_phase;
};

#ifdef CPU_EMU
#define NT_LOAD(ptr) (*(ptr))
#else
#define NT_LOAD(ptr) __builtin_nontemporal_load(ptr)
#endif
#ifdef CPU_EMU
#define GPTR(T, ptr) ((T*)(ptr))
#else
#define GPTR(T, ptr) ((T*)(__attribute__((address_space(1))) T*)(ptr))
#endif
constexpr int LDS_TBL_OFF = LDS_BYTES - 16 - 256;
#ifdef CPU_EMU
__device__ __forceinline__ const float* gin_tbl(int idx) { return ((const float* const*)(emu_lds() + LDS_TBL_OFF))[idx]; }
#else
__device__ __forceinline__ const float* gin_tbl(int idx) { extern __shared__ __attribute__((aligned(16))) char lds_raw[]; return GPTR(const float, ((const float* const*)(lds_raw + 16 + LDS_TBL_OFF))[idx]); }
#endif
#define GIN(expr) gin_tbl((int)(((const char*)&(expr)) - ((const char*)&p)) >> 3)
#ifdef CPU_EMU
#define TID() ((int)threadIdx.x)
#define BID() ((int)blockIdx.x)
#else
__device__ __forceinline__ int TID() { int t = threadIdx.x; asm volatile("" : "+v"(t)); return t; }
__device__ __forceinline__ int BID() { int t = blockIdx.x; asm volatile("" : "+s"(t)); return t; }
#endif
__device__ __forceinline__ u32 f2u(float f) { union { float f; u32 u; } c; c.f = f; return c.u; }
__device__ __forceinline__ float u2f(u32 u) { union { float f; u32 u; } c; c.u = u; return c.f; }
#ifdef CPU_EMU
__device__ __forceinline__ bf16_t f2bf(float f) { u32 u = f2u(f); u += 0x7fffu + ((u >> 16) & 1u); return (bf16_t)(u >> 16); }
#else
typedef __bf16 hw_bf16x2 __attribute__((ext_vector_type(2)));
__device__ __forceinline__ bf16_t f2bf(float f) { const hw_bf16x2 r = __builtin_convertvector((F2){f, 0.f}, hw_bf16x2); u32 u; __builtin_memcpy(&u, &r, 4); return (bf16_t)(u & 0xffffu); }
#endif
__device__ __forceinline__ float bf2f(bf16_t h) { return u2f(((u32)h) << 16); }
#ifdef CPU_EMU
__device__ __forceinline__ u32 pack2(float lo, float hi) { return (u32)f2bf(lo) | ((u32)f2bf(hi) << 16); }
__device__ __forceinline__ float fexp2(float x) { return exp2f(x); }
#else
__device__ __forceinline__ u32 pack2(float lo, float hi) { const hw_bf16x2 r = __builtin_convertvector((F2){lo, hi}, hw_bf16x2); u32 u; __builtin_memcpy(&u, &r, 4); return u; }
__device__ __forceinline__ float fexp2(float x) { return __builtin_amdgcn_exp2f(x); }
#endif
__device__ __forceinline__ float bflo(u32 w) { return u2f(w << 16); }
__device__ __forceinline__ float bfhi(u32 w) { return u2f(w & 0xffff0000u); }
#ifdef CPU_EMU
__device__ __forceinline__ float sigmoidf(float x) { return 1.0f / (1.0f + expf(-x)); }
#else
__device__ __forceinline__ float sigmoidf(float x) { return __builtin_amdgcn_rcpf(1.0f + __builtin_amdgcn_exp2f(x * -1.4426950408889634f)); }
#endif
__device__ __forceinline__ float siluf(float x) { return x * sigmoidf(x); }
#ifdef CPU_EMU
template <int O> __device__ __forceinline__ float xadd(float v) { return v + __shfl_xor(v, O); }
template <int O> __device__ __forceinline__ float xmax(float v) { return fmaxf(v, __shfl_xor(v, O)); }
#else
template <int O> __device__ __forceinline__ float xadd(float v) {
    if constexpr (O == 32) { const auto r = __builtin_amdgcn_permlane32_swap(__float_as_uint(v), __float_as_uint(v), false, false); return __uint_as_float(r[0]) + __uint_as_float(r[1]); }
    else return v + __int_as_float(__builtin_amdgcn_ds_swizzle(__float_as_int(v), (O << 10) | 0x1f)); }
template <int O> __device__ __forceinline__ float xmax(float v) {
    if constexpr (O == 32) { const auto r = __builtin_amdgcn_permlane32_swap(__float_as_uint(v), __float_as_uint(v), false, false); return fmaxf(__uint_as_float(r[0]), __uint_as_float(r[1])); }
    else return fmaxf(v, __int_as_float(__builtin_amdgcn_ds_swizzle(__float_as_int(v), (O << 10) | 0x1f))); }
#endif
__device__ __forceinline__ float wave_sum(float v) { v = xadd<32>(v); v = xadd<16>(v); v = xadd<8>(v); v = xadd<4>(v); v = xadd<2>(v); v = xadd<1>(v); return v; }
__device__ __forceinline__ float wave_max(float v) { v = xmax<32>(v); v = xmax<16>(v); v = xmax<8>(v); v = xmax<4>(v); v = xmax<2>(v); v = xmax<1>(v); return v; }
__device__ __forceinline__ bf16x8 ld8(const bf16_t* p) { return *(const bf16x8*)p; }
__device__ __forceinline__ bf16x8 mk8(U2 a, U2 b) { union { struct { U2 a, b; } s; bf16x8 v; } c; c.s.a = a; c.s.b = b; return c.v; }
__device__ __forceinline__ bf16x8 mk8u(u32 a, u32 b, u32 c0, u32 d) { union { u32 u[4]; bf16x8 v; } c; c.u[0] = a; c.u[1] = b; c.u[2] = c0; c.u[3] = d; return c.v; }
#define MFMA16(a, b, c) __builtin_amdgcn_mfma_f32_16x16x32_bf16(a, b, c, 0, 0, 0)
__device__ __forceinline__ int mod_row(int tok) { return tok < NLAT ? tok / SEQ : 2; }
__device__ __forceinline__ void tok_bk(int tok, int& b, int& key) { if (tok < NLAT) { b = tok / SEQ; key = tok - b * SEQ; } else { int t = tok - NLAT; b = t / CTX; key = SEQ + t - b * CTX; } }
__device__ __forceinline__ int bk_tok(int b, int key) { return key < SEQ ? b * SEQ + key : NLAT + b * CTX + (key - SEQ); }
#ifdef CPU_EMU
struct XcdBarrier { int dummy; };
#define GSYNC() emu_grid_sync()
#else
#define XB_TMO      128
#define XB_XCNT(j)  (256  + 64 * (j))
#define XB_XSUB(j)  (1280 + 64 * (j))
#define XB_XGEN(j)  (2304 + 64 * (j))
#define XB_TOP      3328
#define XB_TOPGEN   3392
#define XCD_BAR_WORDS 3456
#define XB_SPIN_CAP (1u << 22)
#define LAS __attribute__((address_space(3)))
__device__ __forceinline__ unsigned xb_ld(unsigned* p)              { return __hip_atomic_load(p, __ATOMIC_RELAXED, __HIP_MEMORY_SCOPE_AGENT); }
__device__ __forceinline__ unsigned xb_add(unsigned* p, unsigned v) { return __hip_atomic_fetch_add(p, v, __ATOMIC_RELAXED, __HIP_MEMORY_SCOPE_AGENT); }
__device__ __forceinline__ unsigned xb_xcc_id() { return (unsigned)__builtin_amdgcn_s_getreg((3 << 11) | 20) & 0xFu; }
#define XB_SPIN(cond, bar) do { unsigned _sp = 0; while (cond) { __builtin_amdgcn_s_sleep(1); \
    if ((++_sp & 255u) == 0u) { if (xb_ld(&(bar)[XB_TMO])) break; if (_sp > XB_SPIN_CAP) { atomicAdd(&(bar)[XB_TMO], 1u); break; } } } } while (0)
struct XcdBarrier { unsigned* bar; unsigned x; volatile LAS unsigned* st; };
__device__ __forceinline__ XcdBarrier xcd_barrier_post(unsigned* bar, volatile LAS unsigned* st) {
    XcdBarrier b; b.bar = bar; b.x = xb_xcc_id(); b.st = st;
    if (threadIdx.x == 0) (void)xb_add(&bar[XB_XCNT(b.x)], 1u);
    return b;
}
__device__ __forceinline__ void xcd_barrier_complete(unsigned* bar, unsigned x, unsigned& nloc, unsigned& nx) {
    const unsigned G = gridDim.x * gridDim.y * gridDim.z;
    unsigned sum, cnt, mine, sp = 0u;
    for (;;) {
        sum = 0u; cnt = 0u; mine = 0u;
#pragma unroll
        for (unsigned j = 0; j < 16; ++j) { const unsigned c = xb_ld(&bar[XB_XCNT(j)]); sum += c; cnt += (c > 0u) ? 1u : 0u; mine = (j == x) ? c : mine; }
        if (sum == G) break;
        __builtin_amdgcn_s_sleep(1);
        if ((++sp & 255u) == 0u) { if (xb_ld(&bar[XB_TMO])) break; if (sp > XB_SPIN_CAP) { atomicAdd(&bar[XB_TMO], 1u); break; } }
    }
    nloc = mine > 0u ? mine : 1u; nx = cnt > 0u ? cnt : 1u;
}
__device__ __forceinline__ void xcd_barrier(const XcdBarrier& b) {
    asm volatile("s_waitcnt vmcnt(0)" ::: "memory");
    __syncthreads();
    if (threadIdx.x == 0) {
        unsigned* bar = b.bar;
        __builtin_amdgcn_s_waitcnt(0);
        unsigned nloc = b.st[0], nx = b.st[1];
        if (nloc == 0u) { xcd_barrier_complete(bar, b.x, nloc, nx); b.st[0] = nloc; b.st[1] = nx; }
        const unsigned old = xb_add(&bar[XB_XSUB(b.x)], 1u);
        const unsigned gen = old / nloc;
        if (old + 1u == (gen + 1u) * nloc) {
            __builtin_amdgcn_fence(__ATOMIC_RELEASE, "agent");
            asm volatile("s_waitcnt vmcnt(0)" ::: "memory");
            const unsigned og = xb_add(&bar[XB_TOP], 1u);
            const unsigned tg = og / nx;
            if (og + 1u == (tg + 1u) * nx) xb_add(&bar[XB_TOPGEN], 1u);
            else XB_SPIN(xb_ld(&bar[XB_TOPGEN]) == tg, bar);
            __builtin_amdgcn_fence(__ATOMIC_ACQUIRE, "agent");
            xb_add(&bar[XB_XGEN(b.x)], 1u);
            asm volatile("s_waitcnt vmcnt(0)" ::: "memory");
        } else {
            XB_SPIN(xb_ld(&bar[XB_XGEN(b.x)]) == gen, bar);
            __builtin_amdgcn_fence(__ATOMIC_ACQUIRE, "agent");
            asm volatile("s_waitcnt vmcnt(0)" ::: "memory");
        }
    }
    __syncthreads();
}
#define GSYNC() xcd_barrier(xbar)
#endif

constexpr int G_BM = 256, G_BN = 128, G_BK = 64, G_LD = 80;
constexpr int G_STAGE = (G_BM + G_BN) * G_LD * 2;
constexpr int G_LDS = 2 * G_STAGE;

template <int MT = 4, class ARow>
__device__ __forceinline__ void gemm_tile(char* lds, ARow arow  , const bf16_t* Bt, long ldb, int K, f32x4 (&acc)[MT][4]) {
    const int tid = TID(), wid = tid >> 6, lane = tid & 63, wm = wid >> 1, wn = wid & 1, l15 = lane & 15, g = lane >> 4;
#pragma unroll
    for (int m = 0; m < MT; ++m)
#pragma unroll
        for (int n = 0; n < 4; ++n) acc[m][n] = (f32x4){0.f, 0.f, 0.f, 0.f};
    const bf16_t* ap[MT]; const bf16_t* bp[2];
#pragma unroll
    for (int i = 0; i < MT; ++i) { int pc = tid + i * NTH; int r = pc >> 3, s = pc & 7; ap[i] = arow(r) + s * 8; }
#pragma unroll
    for (int i = 0; i < 2; ++i) { int pc = tid + i * NTH; int r = pc >> 3, s = pc & 7; bp[i] = Bt + (long)r * ldb + s * 8; }
    U4 ra[2][MT], rb[2][2];
    const int nk = K / G_BK;
#define GT_LOAD(set, kt) do { _Pragma("unroll") for (int i = 0; i < MT; ++i) ra[set][i] = *(const U4*)(ap[i] + (kt) * G_BK); _Pragma("unroll") for (int i = 0; i < 2; ++i) rb[set][i] = *(const U4*)(bp[i] + (kt) * G_BK); } while (0)
#define GT_STORE(set, st) do { bf16_t* dA = (bf16_t*)(lds + (st) * G_STAGE); bf16_t* dB = dA + G_BM * G_LD; \
        _Pragma("unroll") for (int i = 0; i < MT; ++i) { int pc = tid + i * NTH; int r = pc >> 3, s = pc & 7; *(U4*)(dA + r * G_LD + s * 8) = ra[set][i]; } \
        _Pragma("unroll") for (int i = 0; i < 2; ++i) { int pc = tid + i * NTH; int r = pc >> 3, s = pc & 7; *(U4*)(dB + r * G_LD + s * 8) = rb[set][i]; } } while (0)
#define GT_COMPUTE(st) do { const bf16_t* sA = (const bf16_t*)(lds + (st) * G_STAGE); const bf16_t* sB = sA + G_BM * G_LD; \
        _Pragma("unroll") for (int ks = 0; ks < 2; ++ks) { bf16x8 af[MT], bfr[4]; \
            _Pragma("unroll") for (int m = 0; m < MT; ++m) af[m] = ld8(sA + (wm * 16 * MT + m * 16 + l15) * G_LD + ks * 32 + g * 8); \
            _Pragma("unroll") for (int n = 0; n < 4; ++n) bfr[n] = ld8(sB + (wn * 64 + n * 16 + l15) * G_LD + ks * 32 + g * 8); \
            _Pragma("unroll") for (int m = 0; m < MT; ++m) _Pragma("unroll") for (int n = 0; n < 4; ++n) acc[m][n] = MFMA16(bfr[n], af[m], acc[m][n]); } } while (0)
    GT_LOAD(0, 0);
    GT_LOAD(1, 1);
    __syncthreads();
    GT_STORE(0, 0);
    if (nk > 2) GT_LOAD(0, 2);
    __syncthreads();
    for (int kt = 0; kt < nk; kt += 2) {
        GT_COMPUTE(0);
        GT_STORE(1, 1);
        if (kt + 3 < nk) GT_LOAD(1, kt + 3);
        __syncthreads();
        GT_COMPUTE(1);
        if (kt + 2 < nk) { GT_STORE(0, 0); if (kt + 4 < nk) GT_LOAD(0, kt + 4); }
        __syncthreads();
    }
#undef GT_LOAD
#undef GT_STORE
#undef GT_COMPUTE
}

template <int MT, class Prov, int MODE = 0>
__device__ __forceinline__ void gemm_stream(char* lds, Prov& pv, const long ldb, const int K) {
    const int tid = TID(), wid = tid >> 6, lane = tid & 63, wm = wid >> 1, wn = wid & 1, l15 = lane & 15, g = lane >> 4;
    if (!pv.valid(0)) return;
    const bf16_t* ap[MT]; const bf16_t* bp[2]; const bf16_t* apn[MT]; const bf16_t* bpn[2];
    U4 ra[2][MT], rb[2][2];
    const int nk = K / G_BK;
#define GS_PTRS(AP, BP, i) do { const int tq_ = TID(); _Pragma("unroll") for (int q_ = 0; q_ < MT; ++q_) { int pc = tq_ + q_ * NTH; AP[q_] = pv.arow(i, pc >> 3) + (pc & 7) * 8; } \
        const bf16_t* bb_ = pv.bbase(i); _Pragma("unroll") for (int q_ = 0; q_ < 2; ++q_) { int pc = tq_ + q_ * NTH; BP[q_] = bb_ + (long)(pc >> 3) * ldb + (pc & 7) * 8; } } while (0)
#define GS_LOAD(set, AP, BP, kt) do { _Pragma("unroll") for (int q_ = 0; q_ < MT; ++q_) ra[set][q_] = *(const U4*)(AP[q_] + (kt) * G_BK); _Pragma("unroll") for (int q_ = 0; q_ < 2; ++q_) rb[set][q_] = *(const U4*)(BP[q_] + (kt) * G_BK); } while (0)
#define GS_LOADV(set, v) do { if (MODE == 2 || MODE == 4) break; if ((v) < nk) GS_LOAD(set, ap, bp, (v)); else if (hn) GS_LOAD(set, apn, bpn, (v) - nk); } while (0)
#define GS_STORE(set, st) do { if (MODE == 4) break; bf16_t* dA = (bf16_t*)(lds + (st) * G_STAGE); bf16_t* dB = dA + G_BM * G_LD; \
        _Pragma("unroll") for (int q_ = 0; q_ < MT; ++q_) { int pc = tid + q_ * NTH; *(U4*)(dA + (pc >> 3) * G_LD + (pc & 7) * 8) = ra[set][q_]; } \
        _Pragma("unroll") for (int q_ = 0; q_ < 2; ++q_) { int pc = tid + q_ * NTH; *(U4*)(dB + (pc >> 3) * G_LD + (pc & 7) * 8) = rb[set][q_]; } } while (0)
#define GS_COMPUTE(st) do { if (MODE == 3) break; const bf16_t* sA = (const bf16_t*)(lds + (st) * G_STAGE); const bf16_t* sB = sA + G_BM * G_LD; \
        _Pragma("unroll") for (int ks = 0; ks < 2; ++ks) { bf16x8 af[MT], bfr[4];     \
            _Pragma("unroll") for (int n = 0; n < 4; ++n) bfr[n] = ld8(sB + (wn * 64 + n * 16 + l15) * G_LD + ks * 32 + g * 8); \
            _Pragma("unroll") for (int m = 0; m < MT; ++m) af[m] = ld8(sA + (wm * 16 * MT + m * 16 + l15) * G_LD + ks * 32 + g * 8); \
            SCHED_FENCE(); \
            _Pragma("unroll") for (int m = 0; m < MT; ++m) _Pragma("unroll") for (int n = 0; n < 4; ++n) acc[m][n] = MFMA16(bfr[n], af[m], acc[m][n]); \
            SCHED_FENCE(); } } while (0)
    GS_PTRS(ap, bp, 0);
    GS_LOAD(0, ap, bp, 0);
    GS_LOAD(1, ap, bp, 1);
    __syncthreads();
    for (int i = 0;; ++i) {
        const bool hn = pv.valid(i + 1);
        if (hn) GS_PTRS(apn, bpn, i + 1);
        f32x4 acc[MT][4];
#pragma unroll
        for (int m = 0; m < MT; ++m)
#pragma unroll
            for (int n = 0; n < 4; ++n) acc[m][n] = (f32x4){0.f, 0.f, 0.f, 0.f};
        pv.pre(i);
        GS_STORE(0, 0);
        GS_LOADV(0, 2);
        __syncthreads();
        for (int kt = 0; kt < nk; kt += 2) {
            GS_COMPUTE(0);
            GS_STORE(1, 1);
            GS_LOADV(1, kt + 3);
            __syncthreads();
            GS_COMPUTE(1);
            if (kt + 2 < nk) { GS_STORE(0, 0); GS_LOADV(0, kt + 4); }
            __syncthreads();
        }
        pv.epi(i, acc);
        if (!hn) break;
#pragma unroll
        for (int q_ = 0; q_ < MT; ++q_) ap[q_] = apn[q_];
        bp[0] = bpn[0]; bp[1] = bpn[1];
    }
#undef GS_PTRS
#undef GS_LOAD
#undef GS_LOADV
#undef GS_STORE
#undef GS_COMPUTE
}

template <class SrcFn>
__device__ __forceinline__ void cvt_tile(char* lds, SrcFn srcp, int k0, int n0, bf16_t* dst, long dst_ld) {
    float* t = (float*)lds;
    const int tid = TID();
    __syncthreads();
#pragma unroll
    for (int i = 0; i < 2; ++i) { int kk = (tid >> 4) + 32 * i, n4 = (tid & 15) * 4; const float* sp = srcp(k0 + kk, n0 + n4);
        F4 v = sp ? NT_LOAD((const F4*)sp) : (F4){0.f, 0.f, 0.f, 0.f};
        t[kk * 65 + n4] = v.x; t[kk * 65 + n4 + 1] = v.y; t[kk * 65 + n4 + 2] = v.z; t[kk * 65 + n4 + 3] = v.w; }
    __syncthreads();
    { int n = tid >> 3, k8 = (tid & 7) * 8; U4 o;
        o.x = pack2(t[(k8 + 0) * 65 + n], t[(k8 + 1) * 65 + n]); o.y = pack2(t[(k8 + 2) * 65 + n], t[(k8 + 3) * 65 + n]);
        o.z = pack2(t[(k8 + 4) * 65 + n], t[(k8 + 5) * 65 + n]); o.w = pack2(t[(k8 + 6) * 65 + n], t[(k8 + 7) * 65 + n]);
        *(U4*)(dst + (long)(n0 + n) * dst_ld + k0 + k8) = o; }
}

__device__ __forceinline__ void tr_tile(char* lds, const bf16_t* src, long ld, int tok0, int col0, int ncols, int cdst0, bf16_t* dst) {
    bf16_t* t = (bf16_t*)lds;
    const int tid = TID();
    __syncthreads();
    { int r = tid >> 3, s = tid & 7; *(U4*)(t + r * 72 + s * 8) = *(const U4*)(src + (long)(tok0 + r) * ld + col0 + s * 8); }
    __syncthreads();
    { int c = tid >> 3, t8 = (tid & 7) * 8; int b, key; tok_bk(tok0, b, key);
        U4 o; o.x = (u32)t[(t8 + 0) * 72 + c] | ((u32)t[(t8 + 1) * 72 + c] << 16); o.y = (u32)t[(t8 + 2) * 72 + c] | ((u32)t[(t8 + 3) * 72 + c] << 16);
        o.z = (u32)t[(t8 + 4) * 72 + c] | ((u32)t[(t8 + 5) * 72 + c] << 16); o.w = (u32)t[(t8 + 6) * 72 + c] | ((u32)t[(t8 + 7) * 72 + c] << 16);
        *(U4*)(dst + ((long)b * ncols + cdst0 + c) * KEYS + key + t8) = o; }
}
namespace pg8 {
#ifdef CPU_EMU
#define PG8_LAS
#else
#define PG8_LAS __attribute__((address_space(3)))
#endif
typedef unsigned short bf16_t;
typedef unsigned u32x4 __attribute__((ext_vector_type(4)));
constexpr int BM = 256, BK = 64, HALF = 128, HTB = HALF * BK * 2  , STAGE_BYTES = 8 * HTB, NXCD = 8, WGM = 8;

__host__ __device__ __forceinline__ int lds_byte(int r, int c) { const int st = (r >> 4) * 2 + (c >> 5), rr = r & 15, cc = c & 31, ob = rr * 64 + cc * 2; return st * 1024 + (ob ^ (((ob >> 9) & 1) << 5)); }
__host__ __device__ __forceinline__ void stage_rc(int b, int& R, int& C) { const int st = b / 1024, sb = b % 1024, swz = sb ^ (((sb >> 9) & 1) << 5); R = (st >> 1) * 16 + swz / 64; C = (st & 1) * 32 + (swz % 64) / 2; }
__host__ __device__ __forceinline__ int perm32(int rho) { const int n = rho >> 4, i = rho & 15; return 8 * (i >> 2) + 4 * n + (i & 3); }

struct Unit { int pm, pn; };
struct Gemm { const bf16_t* A; const bf16_t* Bt; int M, N, K; };

struct StaticOrder {
    int nM, nN, nwg, G, c;
    __host__ __device__ void init(int M, int N, int G_, int c_) { nM = M / BM; nN = N / BM; nwg = nM * nN; G = G_; c = c_; }
    __host__ __device__ bool next(int i, Unit& u) const {
        const long L = (long)i * G + c; if (L >= nwg) return false;
        int wgid = (int)L; { const int q = nwg / NXCD, r = nwg % NXCD, xcd = wgid % NXCD, off = wgid / NXCD; wgid = (xcd < r ? xcd * (q + 1) : r * (q + 1) + (xcd - r) * q) + off; }
        const int nig = WGM * nN, gid = wgid / nig, fm = gid * WGM, gsz = (nM - fm) < WGM ? (nM - fm) : WGM;
        u.pm = fm + ((wgid % nig) % gsz); u.pn = (wgid % nig) / gsz; return true;
    }
    __device__ __forceinline__ void a_ready(const Unit&) const {}
    __device__ __forceinline__ void done(const Unit&) const {}
};
template <class Epi, class Sched, bool STAMP = false>
__device__ __forceinline__ void gemm_phase(PG8_LAS unsigned char* lds, const Gemm g, const Sched& S, const Epi& E, unsigned long long* stamps) {
    const int tid = TID(), wid = __builtin_amdgcn_readfirstlane(tid >> 6), lane = tid & 63, wr = wid >> 2, wc = wid & 3, fr = lane & 15, fq = lane >> 4;
    const int K = g.K, nt = K / BK;
    int ts_lo = 0, ts_hi = 0, nts = 0; const unsigned long long rt_entry = STAMP ? (unsigned long long)wall_clock64() : 0ull;
#define PG8_STAMP() do { if (STAMP && wid == 0 && nts < 64) { const unsigned long long _c = (unsigned long long)clock64(); \
        ts_lo = (lane == nts) ? (int)(unsigned)_c : ts_lo; ts_hi = (lane == nts) ? (int)(unsigned)(_c >> 32) : ts_hi; ++nts; } } while (0)
    PG8_STAMP();
    unsigned voffA[2], voffB[2];
#pragma unroll
    for (int i = 0; i < 2; ++i) { int R, C; stage_rc(tid * 16 + i * 8192, R, C); const int Rb = Epi::PERM ? ((R & ~31) + perm32(R & 31)) : R;
        voffA[i] = (unsigned)(R * K + C) * 2u; voffB[i] = (unsigned)(Rb * K + C) * 2u; }
    const size_t kstep = (size_t)(BK * 2);
    const size_t hstep = (size_t)HALF * K * 2;
    const size_t tstep = 2 * hstep;
    const unsigned ldsw = (unsigned)wid * 1024u;
    const int aoff = lds_byte(wr * 64 + fr, fq * 8), boff = lds_byte(wc * 32 + fr, fq * 8);
#define PG8_SA(b, h) (((b) * 2 + (h)) * HTB)
#define PG8_SB(b, h) ((4 + (b) * 2 + (h)) * HTB)
#define PG8_STAGE(bufoff, gbase, voff) do { _Pragma("unroll") for (int _i = 0; _i < 2; ++_i) \
        __builtin_amdgcn_global_load_lds((const unsigned*)((const char*)(gbase) + (voff)[_i]), (PG8_LAS unsigned*)(lds + (bufoff) + ldsw + _i * 8192), 16, 0, 0); } while (0)
#define PG8_LDA(dst, b, h) do { _Pragma("unroll") for (int m = 0; m < 4; ++m) _Pragma("unroll") for (int k = 0; k < 2; ++k) dst[m][k] = *(const PG8_LAS bf16x8*)(lds + PG8_SA(b, h) + aoff + m * 2048 + k * 1024); } while (0)
#define PG8_LDB(dst, b, h) do { _Pragma("unroll") for (int n = 0; n < 2; ++n) _Pragma("unroll") for (int k = 0; k < 2; ++k) dst[n][k] = *(const PG8_LAS bf16x8*)(lds + PG8_SB(b, h) + boff + n * 2048 + k * 1024); } while (0)
#define PG8_MMA(ai, bj, At, Bt) do { __builtin_amdgcn_s_setprio(1); _Pragma("unroll") for (int m = 0; m < 4; ++m) _Pragma("unroll") for (int n = 0; n < 2; ++n) _Pragma("unroll") for (int k = 0; k < 2; ++k) \
        acc[ai][bj][m][n] = __builtin_amdgcn_mfma_f32_16x16x32_bf16(Bt[n][k], At[m][k], acc[ai][bj][m][n], 0, 0, 0); __builtin_amdgcn_s_setprio(0); } while (0)
#ifdef CPU_EMU
#define PG8_WAIT_V(n)
#define PG8_WAIT_L(n)
#else
#define PG8_WAIT_V(n) asm volatile("s_waitcnt vmcnt(" #n ")" ::: "memory")
#define PG8_WAIT_L(n) asm volatile("s_waitcnt lgkmcnt(" #n ")" ::: "memory")
#endif
#define PG8_BAR __builtin_amdgcn_s_barrier()
#define PG8_SCHED __builtin_amdgcn_sched_barrier(0)
    Unit cur, nxt; int ui = 0;
    if (!S.next(0, cur)) return;
    f32x4 acc[2][2][4][2];
#pragma unroll
    for (int a = 0; a < 2; ++a)
#pragma unroll
        for (int b = 0; b < 2; ++b)
#pragma unroll
            for (int m = 0; m < 4; ++m)
#pragma unroll
                for (int n = 0; n < 2; ++n) acc[a][b][m][n] = (f32x4){0.f, 0.f, 0.f, 0.f};
    bf16x8 At[4][2], B0[2][2], B1[2][2];
    const char* cA = (const char*)g.A + (size_t)cur.pm * tstep; const char* cB = (const char*)g.Bt + (size_t)cur.pn * tstep;
    S.a_ready(cur);
    PG8_STAGE(PG8_SB(0, 0), cB, voffB); PG8_STAGE(PG8_SA(0, 0), cA, voffA); PG8_STAGE(PG8_SB(0, 1), cB + hstep, voffB); PG8_STAGE(PG8_SA(0, 1), cA + hstep, voffA);
    if (wr == 1) PG8_BAR;
    PG8_WAIT_V(4); PG8_BAR;
    PG8_STAGE(PG8_SB(1, 0), cB + kstep, voffB); PG8_STAGE(PG8_SA(1, 0), cA + kstep, voffA); PG8_STAGE(PG8_SB(1, 1), cB + hstep + kstep, voffB);
    PG8_WAIT_V(6); PG8_BAR;
    PG8_STAMP();
    for (;;) {
        const bool has_next = S.next(ui + 1, nxt);
        const char* nA = has_next ? (const char*)g.A + (size_t)nxt.pm * tstep : cA; const char* nB = has_next ? (const char*)g.Bt + (size_t)nxt.pn * tstep : cB;
        for (int t = 0; t < nt; t += 2) {
            const bool last = (t == nt - 2);
            const char* a1 = cA + (size_t)(t + 1) * kstep;
            const char* a2 = last ? nA : cA + (size_t)(t + 2) * kstep; const char* b2 = last ? nB : cB + (size_t)(t + 2) * kstep;
            const char* a3 = a2 + kstep; const char* b3 = b2 + kstep;
            if (last && has_next) S.a_ready(nxt);
            PG8_LDB(B0, 0, 0); PG8_SCHED; PG8_LDA(At, 0, 0); PG8_STAGE(PG8_SA(1, 1), a1 + hstep, voffA);
            PG8_WAIT_L(8); PG8_BAR; PG8_WAIT_L(0); PG8_MMA(0, 0, At, B0); PG8_BAR; PG8_SCHED;
            PG8_LDB(B1, 0, 1); PG8_STAGE(PG8_SB(0, 0), b2, voffB);
            PG8_BAR; PG8_WAIT_L(0); PG8_MMA(0, 1, At, B1); PG8_BAR;
            PG8_LDA(At, 0, 1); PG8_STAGE(PG8_SA(0, 0), a2, voffA);
            PG8_BAR; PG8_WAIT_L(0); PG8_MMA(1, 0, At, B0); PG8_BAR; PG8_SCHED;
            PG8_STAGE(PG8_SB(0, 1), b2 + hstep, voffB);
            PG8_WAIT_V(6); PG8_BAR; PG8_MMA(1, 1, At, B1); PG8_BAR;
            PG8_LDB(B0, 1, 0); PG8_SCHED; PG8_LDA(At, 1, 0); PG8_STAGE(PG8_SA(0, 1), a2 + hstep, voffA);
            PG8_WAIT_L(8); PG8_BAR; PG8_WAIT_L(0); PG8_MMA(0, 0, At, B0); PG8_BAR; PG8_SCHED;
            PG8_LDB(B1, 1, 1); PG8_STAGE(PG8_SB(1, 0), b3, voffB);
            PG8_BAR; PG8_WAIT_L(0); PG8_MMA(0, 1, At, B1); PG8_BAR;
            PG8_LDA(At, 1, 1); PG8_STAGE(PG8_SA(1, 0), a3, voffA);
            PG8_BAR; PG8_WAIT_L(0); PG8_MMA(1, 0, At, B0); PG8_BAR; PG8_SCHED;
            PG8_STAGE(PG8_SB(1, 1), b3 + hstep, voffB);
            PG8_WAIT_V(6); PG8_BAR; PG8_MMA(1, 1, At, B1); PG8_BAR;
        }
        PG8_STAMP();
        if constexpr (!Epi::AFTER_DRAIN) { E(acc, cur, wr, wc, fr, fq); S.done(cur); }
        PG8_STAMP();
        if (!has_next) break;
#pragma unroll
        for (int a = 0; a < 2; ++a)
#pragma unroll
            for (int b = 0; b < 2; ++b)
#pragma unroll
                for (int m = 0; m < 4; ++m)
#pragma unroll
                    for (int n = 0; n < 2; ++n) acc[a][b][m][n] = (f32x4){0.f, 0.f, 0.f, 0.f};
        cur = nxt; cA = nA; cB = nB; ++ui;
    }
    PG8_WAIT_V(0);
    if (wr == 0) PG8_BAR;
    PG8_BAR;
    if constexpr (Epi::AFTER_DRAIN) { E.fused(acc, cur, wr, wc, fr, fq, lds, wid, lane); S.done(cur); }
    PG8_STAMP();
    if (STAMP && wid == 0) { stamps[lane] = lane < nts ? (((unsigned long long)(unsigned)ts_hi << 32) | (unsigned)ts_lo) : 0ull;
        if (lane == 62) stamps[62] = rt_entry; if (lane == 63) stamps[63] = (unsigned long long)wall_clock64(); }
#undef PG8_STAMP
#undef PG8_SA
#undef PG8_SB
#undef PG8_STAGE
#undef PG8_LDA
#undef PG8_LDB
#undef PG8_MMA
#undef PG8_WAIT_V
#undef PG8_WAIT_L
#undef PG8_BAR
#undef PG8_SCHED
}


__device__ __forceinline__ unsigned cvt_pk_bf16(float lo, float hi) { return pack2(lo, hi); }
__device__ __forceinline__ long gate_idx(int row, int br, int col) {
    const int tm = row / 192, r = row - tm * 192, wm = r / 48, r2 = r - wm * 48, m = r2 >> 4, l15 = r2 & 15;
    const int tn = col >> 7, c = col & 127, wn = c >> 6, n = (c >> 4) & 3, g = (c >> 2) & 3;
    return ((((long)(tm * (D / 128) + tn) * 4 + br) * 8 + (wm * 2 + wn)) * 12 + (m * 4 + n)) * 256 + (g * 16 + l15) * 4;
}
struct EpiInproj {
    static constexpr bool PERM = true, AFTER_DRAIN = false;
    char* ws; int ncol0;
    static __device__ __forceinline__ void st_tr(bf16_t* dT, long key, const f32x4& v0, const f32x4& v1) {
        dT[key] = f2bf(v0[0]); dT[KEYS + key] = f2bf(v0[1]); dT[2 * KEYS + key] = f2bf(v0[2]); dT[3 * KEYS + key] = f2bf(v0[3]);
        dT[4 * KEYS + key] = f2bf(v1[0]); dT[5 * KEYS + key] = f2bf(v1[1]); dT[6 * KEYS + key] = f2bf(v1[2]); dT[7 * KEYS + key] = f2bf(v1[3]); }
    __device__ __forceinline__ void operator()(const f32x4 (&acc)[2][2][4][2], const Unit& u, int wr_, int wc_, int fr_, int fq_) const {
        const int tid = TID(), wid = tid >> 6, lane = tid & 63, wr = wid >> 2, wc = wid & 3, fr = lane & 15, fq = lane >> 4;
        (void)wr_; (void)wc_; (void)fr_; (void)fq_;
#pragma unroll
        for (int bj = 0; bj < 2; ++bj) {
            const int cw = ncol0 + u.pn * BM + bj * HALF;
            bf16_t* dst = nullptr; bf16_t* dT = nullptr; bf16_t* gatep = nullptr; int ld = 0, cl = 0, ncT = 0; bool gab = false;
            if (cw < MY_GQKV) { dT = GPTR(bf16_t, ws + OFF_HYT); ncT = 3 * MW; cl = cw - MY_HY; }
            else if (cw < MY_GZ) { dst = GPTR(bf16_t, ws + OFF_SEG_GQKV); ld = 3 * MW; cl = cw - MY_GQKV; }
            else if (cw < MY_DQKV) { dst = GPTR(bf16_t, ws + OFF_GZ); ld = MW; cl = cw - MY_GZ; }
            else if (cw < MY_NQKV) { cl = cw - MY_DQKV; if (cl < 2 * MW) { dst = GPTR(bf16_t, ws + OFF_SEG_DQKV); ld = 3 * MW; } else { dT = GPTR(bf16_t, ws + OFF_DVT); ncT = MW; cl -= 2 * MW; } }
            else if (cw < MY_GAB) { cl = cw - MY_NQKV; if (cl < 2 * MW) { dst = GPTR(bf16_t, ws + OFF_SEG_NQKV); ld = 3 * MW; } else { dT = GPTR(bf16_t, ws + OFF_NVT); ncT = MW; cl -= 2 * MW; } }
            else if (cw < MY_GATE) { gab = (cw == MY_GAB) && wc == 0; }
            else { gatep = GPTR(bf16_t, ws + OFF_SEG_GATE); cl = cw - MY_GATE; }
            if (dst) {
#pragma unroll
                for (int ai = 0; ai < 2; ++ai)
#pragma unroll
                    for (int m = 0; m < 4; ++m) { const long row = (long)u.pm * BM + ai * HALF + wr * 64 + m * 16 + fr;
                        const f32x4 v0 = acc[ai][bj][m][0], v1 = acc[ai][bj][m][1];
                        U4 w; w.x = pack2(v0[0], v0[1]); w.y = pack2(v0[2], v0[3]); w.z = pack2(v1[0], v1[1]); w.w = pack2(v1[2], v1[3]);
                        *(U4*)(dst + row * ld + cl + wc * 32 + 8 * fq) = w; }
            } else if (gatep) {
                const int gcol = cl + wc * 32 + 8 * fq, br = gcol / D, col = gcol - br * D;
#pragma unroll
                for (int ai = 0; ai < 2; ++ai)
#pragma unroll
                    for (int m = 0; m < 4; ++m) { const int row = u.pm * BM + ai * HALF + wr * 64 + m * 16 + fr;
                        const f32x4 v0 = acc[ai][bj][m][0], v1 = acc[ai][bj][m][1];
                        bf16_t* q = gatep + gate_idx(row, br, col);
                        *(U2*)q = (U2){pack2(v0[0], v0[1]), pack2(v0[2], v0[3])}; *(U2*)(q + 64) = (U2){pack2(v1[0], v1[1]), pack2(v1[2], v1[3])}; }
            } else if (dT) {
#pragma unroll
                for (int ai = 0; ai < 2; ++ai)
#pragma unroll
                    for (int m = 0; m < 4; ++m) { const int row = u.pm * BM + ai * HALF + wr * 64 + m * 16 + fr; int b, key; tok_bk(row, b, key);
                        st_tr(dT + ((long)b * ncT + cl + wc * 32 + 8 * fq) * KEYS, key, acc[ai][bj][m][0], acc[ai][bj][m][1]); }
            } else if (gab) {
                float* GAB = GPTR(float, ws + OFF_GAB);
#pragma unroll
                for (int ai = 0; ai < 2; ++ai)
#pragma unroll
                    for (int m = 0; m < 4; ++m) { const long row = (long)u.pm * BM + ai * HALF + wr * 64 + m * 16 + fr;
                        const f32x4 v0 = acc[ai][bj][m][0], v1 = acc[ai][bj][m][1];
                        *(F4*)(GAB + row * 32 + 8 * fq) = (F4){v0[0], v0[1], v0[2], v0[3]}; *(F4*)(GAB + row * 32 + 8 * fq + 4) = (F4){v1[0], v1[1], v1[2], v1[3]}; }
            }
        }
    }
};
}

#ifdef CPU_EMU
#define WSP(T, off) GPTR(T, p.ws + (off))
#else
typedef __attribute__((address_space(1))) char* gchar_p;
__device__ __forceinline__ gchar_p ws_opaque(char* w) { gchar_p g = (gchar_p)w; asm volatile("" : "+s"(g)); return g; }
#define WSP(T, off) ((T*)(__attribute__((address_space(1))) T*)(ws_opaque(p.ws) + (off)))
#endif
constexpr float DN_ALPHA_F =
#ifdef SMALL_DIMS
    1.4142135623730951f;
#else
    1.681792830507429f;
#endif

__device__ __forceinline__ void phase_prologue(const Params& p, char* lds) {
    const int tid = TID(), G = gridDim.x, bid = BID();
    { float* RWT = WSP(float, OFF_RWT); for (int i = bid * NTH + tid; i < D * 16; i += G * NTH) RWT[(i & 15) * D + (i >> 4)] = GIN(p.router_w)[i]; }
    float* sc = (float*)lds;
    for (int i = tid; i < 3 * D; i += NTH) { int r = i / D, k = i - r * D; float v = r < 2 ? GIN(p.c)[r * D + k] : GIN(p.c_ctx)[k]; sc[i] = siluf(v); }
    __syncthreads();
    float* MODP = WSP(float, OFF_MODP);
    constexpr int NCHK = 6 * D / NTH, KS = D / 8;
    for (int it = bid; it < DEPTH * 8 * NCHK; it += G) {
        int l = it / (8 * NCHK), rem = it - l * 8 * NCHK, s = rem / NCHK, ch = rem - s * NCHK;
        int n = ch * NTH + tid; const float* w = GIN(p.w_mod) + ((long)l * D + s * KS) * 6 * D + n;
        float a0 = 0.f, a1 = 0.f, a2 = 0.f;
#pragma unroll 8
        for (int k = 0; k < KS; ++k) { float wv = NT_LOAD(w + (long)k * 6 * D); a0 += sc[s * KS + k] * wv; a1 += sc[D + s * KS + k] * wv; a2 += sc[2 * D + s * KS + k] * wv; }
        float* o = MODP + (((long)l * 8 + s) * 3) * 6 * D + n; o[0] = a0; o[6 * D] = a1; o[12 * D] = a2;
    }
}

constexpr int U_WIN = (NPROJ / 64) * (D / 64), U_BP = 4 * (MW / 64) * (D / 64), U_WO = (D / 64) * (D / 64), U_CVT = U_WIN + U_BP + U_WO;
__device__ __forceinline__ void cvt_unit(const Params& p, char* lds, int l, int u) {
    if (u < U_WIN) { int nt = u / (D / 64), kt = u - nt * (D / 64); const float* src = GIN(p.w_in) + (long)l * D * IN_TOTAL;
        auto sp = [&](int k, int n) -> const float* { int sc;
            if (n < MY_DQKV) sc = n; else if (n < MY_GAB) sc = n + 4 * GH; else if (n < MY_GATE) { int j = n - MY_GAB; if (j >= 4 * GH) return nullptr; sc = SRC_GA + j; } else sc = SRC_GATE + (n - MY_GATE);
            return src + (long)k * IN_TOTAL + sc; };
        cvt_tile(lds, sp, kt * 64, nt * 64, WSP(bf16_t, off_win(l)), D);
    } else if (u < U_WIN + U_BP) { int v = u - U_WIN; int m = v / ((MW / 64) * (D / 64)), r = v - m * ((MW / 64) * (D / 64)), nt = r / (MW / 64), kt = r - nt * (MW / 64);
        const float* src = GIN(p.branch_proj) + ((long)(l * 4 + m) * MW) * D;
        auto sp = [&](int k, int n) -> const float* { return src + (long)k * D + n; };
        cvt_tile(lds, sp, kt * 64, nt * 64, WSP(bf16_t, off_bp(l)) + m * MW, 4 * MW);
    } else { int v = u - U_WIN - U_BP; int nt = v / (D / 64), kt = v - nt * (D / 64); const float* src = GIN(p.w_out) + (long)l * D * D;
        auto sp = [&](int k, int n) -> const float* { return src + (long)k * D + n; };
        cvt_tile(lds, sp, kt * 64, nt * 64, WSP(bf16_t, off_wo(l)), D);
    }
}
__device__ __forceinline__ void w3t_chunk(const Params& p, int l, int i0, int n) {
    const int tid = TID(); bf16_t* W3T = WSP(bf16_t, OFF_W3T); const float* w3 = GIN(p.hy_w3) + (long)l * 64 * 4 * HYW;
    for (int i = i0 + tid; i < i0 + n; i += NTH) { const int col = i >> 7, k = i & 127; W3T[i] = k < 64 ? f2bf(w3[(long)k * 4 * HYW + col]) : (bf16_t)0; }
}
__device__ __forceinline__ void h2f_positions(const Params& p, int l, int pos0, int iters) {
    const int tid = TID(), lane = tid & 63, wid = tid >> 6;
    float* H2F = WSP(float, OFF_H2F); bf16_t* H2B = WSP(bf16_t, OFF_H2B);
    const float* w1 = GIN(p.hy_w1) + (long)l * HY_EMB * 64; const float* b1 = GIN(p.hy_b1) + l * 64; const float* w2 = GIN(p.hy_w2) + (long)l * 64 * 64; const float* b2 = GIN(p.hy_b2) + l * 64; const float fr = GIN(p.hy_freq)[l * 64 + lane];
    for (int it = 0; it < iters; ++it) { const int pos = pos0 + it * 8 + wid; if (pos >= KEYS) break;
        int L = pos < SEQ ? SEQ : CTX, t = pos < SEQ ? pos : pos - SEQ;
        float feat = 0.f;
        if (lane == 0) feat = (float)t / (float)(L - 1);
        else if (lane < 33) { int bi = (lane - 1) & 15; float band = 1e-4f + (float)bi * ((15.0f - 1e-4f) / 15.0f); float ang = 6.283185307179586f * (float)t / (float)L; float a = band * ang;
            feat = lane < 17 ? cosf(a) : -sinf(a); }
        float a1 = b1[lane];
        for (int e = 0; e < HY_EMB; ++e) a1 += __shfl(feat, e) * w1[e * 64 + lane];
        float h1 = sinf(fr * a1);
        float a2 = b2[lane];
        for (int i = 0; i < 64; ++i) a2 += __shfl(h1, i) * w2[i * 64 + lane];
        const float hv = sinf(fr * a2); H2F[(long)pos * 64 + lane] = hv; H2B[(long)pos * 128 + lane] = f2bf(hv); H2B[(long)pos * 128 + 64 + lane] = 0; }
}
__device__ __forceinline__ void phase_weights(const Params& p, char* lds, int l) {
    const int tid = TID(), G = gridDim.x, bid = BID();
    { const float* MODP = WSP(float, OFF_MODP); float* MOD = WSP(float, OFF_MOD);
        for (int i = bid * NTH + tid; i < DEPTH * 3 * 6 * D; i += G * NTH) { int ll = i / (18 * D), rem = i - ll * 18 * D, n = rem % (6 * D);
            float a = GIN(p.b_mod)[ll * 6 * D + n];
#pragma unroll
            for (int s = 0; s < 8; ++s) a += MODP[((long)ll * 8 + s) * 18 * D + rem];
            MOD[i] = a; } }
    if (bid == 0 && tid < 64) WSP(u32, OFF_CNT)[64 + tid] = 0u;
    for (int u = bid; u < U_CVT; u += G) cvt_unit(p, lds, l, u);
    for (int c = bid; c < (4 * HYW * 128 + 8191) / 8192; c += G) w3t_chunk(p, l, c * 8192, 8192);
    for (int c = bid; c < (KEYS + 63) / 64; c += G) h2f_positions(p, l, c * 64, 8);
}

__device__ __forceinline__ void phase_expert_weights(const Params& p, char* lds, int l, int bid, int G) {
    constexpr int U13 = (2 * EFF / 64) * (D / 64), U2_ = (D / 64) * (EFF / 64);
    for (int u = bid < 0 ? NE * (U13 + U2_) : bid; u < NE * (U13 + U2_); u += G) {
        int e = u / (U13 + U2_), v = u - e * (U13 + U2_);
        if (v < U13) { int nt = v / (D / 64), kt = v - nt * (D / 64);
            const float* s1 = GIN(p.exp_w1) + ((long)(l * NE + e) * D) * EFF; const float* s3 = GIN(p.exp_w3) + ((long)(l * NE + e) * D) * EFF;
            const long d13 = (long)((uintptr_t)s1 - (uintptr_t)s3);
            auto sp = [&](int k, int n) -> const float* { int grp = n >> 5, w = n & 31; return (const float*)((uintptr_t)s3 + (uintptr_t)(w < 16 ? d13 : 0L)) + (long)k * EFF + grp * 16 + (w & 15); };
            cvt_tile(lds, sp, kt * 64, nt * 64, WSP(bf16_t, OFF_W13) + (long)e * 2 * EFF * D, D);
        } else { int w = v - U13; int nt = w / (EFF / 64), kt = w - nt * (EFF / 64); const float* s2 = GIN(p.exp_w2) + ((long)(l * NE + e) * EFF) * D;
            auto sp = [&](int k, int n) -> const float* { return s2 + (long)k * D + n; };
            cvt_tile(lds, sp, kt * 64, nt * 64, WSP(bf16_t, OFF_W2) + (long)e * D * EFF, EFF);
        }
    }
}

constexpr int RV = D / 256;
__device__ __forceinline__ void row_stats(const F4 (&v)[RV], float& mean, float& rstd) {
    float s = 0.f;
#pragma unroll
    for (int i = 0; i < RV; ++i) s += (v[i].x + v[i].y) + (v[i].z + v[i].w);
    mean = wave_sum(s) * (1.0f / D);
    float q = 0.f;
#pragma unroll
    for (int i = 0; i < RV; ++i) { float a = v[i].x - mean, b = v[i].y - mean, c = v[i].z - mean, d = v[i].w - mean; q += (a * a + b * b) + (c * c + d * d); }
    rstd = rsqrtf(wave_sum(q) * (1.0f / D) + LN_EPS);
}
__device__ __forceinline__ void row_stats2(const F4 (&v)[2][RV], float (&mean)[2], float (&rstd)[2]) {
    float s0 = 0.f, s1 = 0.f;
#pragma unroll
    for (int i = 0; i < RV; ++i) { s0 += (v[0][i].x + v[0][i].y) + (v[0][i].z + v[0][i].w); s1 += (v[1][i].x + v[1][i].y) + (v[1][i].z + v[1][i].w); }
    s0 = xadd<32>(s0); s1 = xadd<32>(s1); s0 = xadd<16>(s0); s1 = xadd<16>(s1); s0 = xadd<8>(s0); s1 = xadd<8>(s1); s0 = xadd<4>(s0); s1 = xadd<4>(s1); s0 = xadd<2>(s0); s1 = xadd<2>(s1); s0 = xadd<1>(s0); s1 = xadd<1>(s1);
    mean[0] = s0 * (1.0f / D); mean[1] = s1 * (1.0f / D);
    float q0 = 0.f, q1 = 0.f;
#pragma unroll
    for (int i = 0; i < RV; ++i) { float a = v[0][i].x - mean[0], b = v[0][i].y - mean[0], c = v[0][i].z - mean[0], d = v[0][i].w - mean[0]; q0 += (a * a + b * b) + (c * c + d * d);
        a = v[1][i].x - mean[1]; b = v[1][i].y - mean[1]; c = v[1][i].z - mean[1]; d = v[1][i].w - mean[1]; q1 += (a * a + b * b) + (c * c + d * d); }
    q0 = xadd<32>(q0); q1 = xadd<32>(q1); q0 = xadd<16>(q0); q1 = xadd<16>(q1); q0 = xadd<8>(q0); q1 = xadd<8>(q1); q0 = xadd<4>(q0); q1 = xadd<4>(q1); q0 = xadd<2>(q0); q1 = xadd<2>(q1); q0 = xadd<1>(q0); q1 = xadd<1>(q1);
    rstd[0] = rsqrtf(q0 * (1.0f / D) + LN_EPS); rstd[1] = rsqrtf(q1 * (1.0f / D) + LN_EPS);
}
__device__ __forceinline__ void row_modulate_store(const F4 (&v)[RV], float mean, float rstd, const float* shift, const float* scale, bf16_t* dst, int lane, F4 (*keep)[RV] = nullptr) {
#pragma unroll
    for (int i = 0; i < RV; ++i) { int n = (i * 64 + lane) * 4; F4 sh = *(const F4*)(shift + n), sc = *(const F4*)(scale + n);
        F4 h; h.x = (v[i].x - mean) * rstd * (1.0f + sc.x) + sh.x; h.y = (v[i].y - mean) * rstd * (1.0f + sc.y) + sh.y; h.z = (v[i].z - mean) * rstd * (1.0f + sc.z) + sh.z; h.w = (v[i].w - mean) * rstd * (1.0f + sc.w) + sh.w;
        U2 o; o.x = pack2(h.x, h.y); o.y = pack2(h.z, h.w); *(U2*)(dst + n) = o; if (keep) (*keep)[i] = h; }
}

__device__ __forceinline__ const float* xs_row(const Params& p, int l, int row) {
    const uintptr_t a = (uintptr_t)(WSP(float, OFF_XS) + (long)row * D);
    const uintptr_t b = row < NLAT ? (uintptr_t)(GIN(p.x) + (long)row * D) : (uintptr_t)(GIN(p.ctx) + (long)(row - NLAT) * D);
    return (const float*)(l == 0 ? b : a);
}
__device__ __forceinline__ void phase_modulate0(const Params& p, int l) {
    const int tid = TID(), lane = tid & 63, wid = tid >> 6;
    const float* XS = WSP(float, OFF_XS); bf16_t* H = WSP(bf16_t, OFF_H); const float* MOD = WSP(float, OFF_MOD) + (long)l * 18 * D;
    for (int row = BID() * 8 + wid; row < NTOK; row += gridDim.x * 8) {
        F4 v[RV]; const float* xr = xs_row(p, l, row);
#pragma unroll
        for (int i = 0; i < RV; ++i) v[i] = *(const F4*)(xr + (i * 64 + lane) * 4);
        float mean, rstd; row_stats(v, mean, rstd);
        const float* m = MOD + mod_row(row) * 6 * D;
        row_modulate_store(v, mean, rstd, m, m + D, H + (long)row * D, lane);
    }
}

__device__ __forceinline__ void phase_post_mix(const Params& p, char* lds, int l, bool dry = false) {
    const int tid = TID(), lane = tid & 63, wid = tid >> 6;
    float* XS = WSP(float, OFF_XS); const bf16_t* MIX = WSP(bf16_t, OFF_MIX); bf16_t* H = WSP(bf16_t, OFF_H); const float* MOD = WSP(float, OFF_MOD) + (long)l * 18 * D;
    const float* lng = GIN(p.ln_g) + (long)(l * 2 + 0) * D; const float* lnb = GIN(p.ln_b) + (long)(l * 2 + 0) * D;
    u32* CNT = WSP(u32, OFF_CNT) + (dry ? 128 : 0); float* XSO = dry ? WSP(float, OFF_YE) : XS; int* TOKE = WSP(int, OFF_TOKE); int* TOKR = WSP(int, OFF_TOKR); float* TOKW = WSP(float, OFF_TOKW); int* ELIST = WSP(int, OFF_ELIST);
    const int nrows = (l == DEPTH - 1) ? NLAT : NTOK;
    float* rwT = (float*)lds; u32* lcnt = (u32*)(lds + 16 * D * 4); u32* lbase = lcnt + 16;
    __syncthreads();
    for (int i = tid; i < D * 16; i += NTH) rwT[(i & 15) * D + (i >> 4)] = GIN(p.router_w)[i];
    if (tid < 16) lcnt[tid] = 0u;
    __syncthreads();
    for (int row = BID() * 8 + wid; row < nrows; row += gridDim.x * 8) {
        const float* m = MOD + mod_row(row) * 6 * D; const float* xr = xs_row(p, l, row);
        F4 v[RV];
#pragma unroll
        for (int i = 0; i < RV; ++i) { int n = (i * 64 + lane) * 4; F4 x = *(const F4*)(xr + n), g2 = *(const F4*)(m + 2 * D + n); const U2 mxp = *(const U2*)(MIX + (long)row * D + n); const F4 mx = (F4){bflo(mxp.x), bfhi(mxp.x), bflo(mxp.y), bfhi(mxp.y)};
            v[i].x = fmaf(g2.x, mx.x, DN_ALPHA_F * x.x); v[i].y = fmaf(g2.y, mx.y, DN_ALPHA_F * x.y); v[i].z = fmaf(g2.z, mx.z, DN_ALPHA_F * x.z); v[i].w = fmaf(g2.w, mx.w, DN_ALPHA_F * x.w); }
        float mean, rstd; row_stats(v, mean, rstd);
#pragma unroll
        for (int i = 0; i < RV; ++i) { int n = (i * 64 + lane) * 4; F4 g = *(const F4*)(lng + n), b = *(const F4*)(lnb + n);
            v[i].x = (v[i].x - mean) * rstd * g.x + b.x; v[i].y = (v[i].y - mean) * rstd * g.y + b.y; v[i].z = (v[i].z - mean) * rstd * g.z + b.z; v[i].w = (v[i].w - mean) * rstd * g.w + b.w;
            *(F4*)(XSO + (long)row * D + n) = v[i]; }
        row_stats(v, mean, rstd);
        F4 h[RV];
        row_modulate_store(v, mean, rstd, m + 3 * D, m + 4 * D, H + (long)row * D, lane, &h);
        float lg[16];
#pragma unroll
        for (int e = 0; e < 16; ++e) lg[e] = 0.f;
        { const float* wp = rwT + lane * 4;
#pragma unroll
            for (int i = 0; i < RV; ++i)
#pragma unroll
                for (int eg = 0; eg < 4; ++eg) {
#pragma unroll
                    for (int e = eg * 4; e < eg * 4 + 4; ++e) { const F4 w = *(const F4*)(wp + e * D + i * 256); lg[e] += (h[i].x * w.x + h[i].y * w.y) + (h[i].z * w.z + h[i].w * w.w); }
#ifndef CPU_EMU
                    { int z; asm volatile("v_mov_b32 %0, 0" : "=v"(z) : "v"(lg[eg * 4 + 3])); wp += z; }
#endif
                } }
        float s[16], sel[16];
#pragma unroll
        for (int e = 0; e < 16; ++e) { lg[e] = wave_sum(lg[e]); s[e] = sigmoidf(lg[e]); sel[e] = s[e] + GIN(p.router_b)[e]; }
        float gs[4];
#pragma unroll
        for (int gq = 0; gq < 4; ++gq) { float a = sel[gq * 4], b = sel[gq * 4 + 1], c = sel[gq * 4 + 2], d = sel[gq * 4 + 3];
            float m1 = fmaxf(fmaxf(a, b), fmaxf(c, d)); float lo_ab = fminf(a, b), hi_ab = fmaxf(a, b), lo_cd = fminf(c, d), hi_cd = fmaxf(c, d);
            float m2 = fmaxf(fminf(hi_ab, hi_cd), fmaxf(lo_ab, lo_cd)); gs[gq] = m1 + m2; }
        int bg = 0; float bv = gs[0];
#pragma unroll
        for (int gq = 1; gq < 4; ++gq) if (gs[gq] > bv) { bv = gs[gq]; bg = gq; }
        float c0 = 0.f, c1 = 0.f, c2 = 0.f, c3 = 0.f, t0 = 0.f, t1 = 0.f, t2 = 0.f, t3 = 0.f;
#pragma unroll
        for (int gq = 0; gq < 4; ++gq) if (gq == bg) { c0 = sel[gq * 4]; c1 = sel[gq * 4 + 1]; c2 = sel[gq * 4 + 2]; c3 = sel[gq * 4 + 3]; t0 = s[gq * 4]; t1 = s[gq * 4 + 1]; t2 = s[gq * 4 + 2]; t3 = s[gq * 4 + 3]; }
        int i0 = 0; float v0 = c0, w0 = t0;
        if (c1 > v0) { v0 = c1; i0 = 1; w0 = t1; } if (c2 > v0) { v0 = c2; i0 = 2; w0 = t2; } if (c3 > v0) { v0 = c3; i0 = 3; w0 = t3; }
        int i1 = -1; float v1 = -3.0e38f, w1 = 0.f;
        if (i0 != 0 && c0 > v1) { v1 = c0; i1 = 0; w1 = t0; } if (i0 != 1 && c1 > v1) { v1 = c1; i1 = 1; w1 = t1; } if (i0 != 2 && c2 > v1) { v1 = c2; i1 = 2; w1 = t2; } if (i0 != 3 && c3 > v1) { v1 = c3; i1 = 3; w1 = t3; }
        if (lane == 0) { float ws = w0 + w1; int e0 = bg * 4 + i0, e1 = bg * 4 + i1;
            int r0 = (int)atomicAdd(&lcnt[e0], 1u), r1 = (int)atomicAdd(&lcnt[e1], 1u);
            TOKE[row * 2] = e0; TOKE[row * 2 + 1] = e1; TOKR[row * 2] = r0; TOKR[row * 2 + 1] = r1; TOKW[row * 2] = w0 / ws; TOKW[row * 2 + 1] = w1 / ws; }
    }
    __syncthreads();
    if (tid < 16) lbase[tid] = lcnt[tid] ? atomicAdd(&CNT[tid], lcnt[tid]) : 0u;
    __syncthreads();
    if (tid < 16) for (int row0 = BID() * 8; row0 < nrows; row0 += (int)gridDim.x * 8) { const int row = row0 + (tid >> 1), k = tid & 1;
        const int e = TOKE[row * 2 + k]; const int r = TOKR[row * 2 + k] + (int)lbase[e]; TOKR[row * 2 + k] = r; ELIST[(long)e * NTOK + r] = row; }
}

__device__ __forceinline__ void phase_post_moe(const Params& p, int l, bool dry = false) {
    const int tid = TID(), lane = tid & 63, wid = tid >> 6;
    float* XS = WSP(float, OFF_XS); bf16_t* H = WSP(bf16_t, OFF_H); const float* MOD = WSP(float, OFF_MOD) + (long)l * 18 * D;
    const bf16_t* YE = WSP(bf16_t, OFF_YE);
    const float* lng = GIN(p.ln_g) + (long)(l * 2 + 1) * D; const float* lnb = GIN(p.ln_b) + (long)(l * 2 + 1) * D;
    const u32* CNT = WSP(u32, OFF_CNT); const int* TOKE = WSP(int, OFF_TOKE); const int* TOKR = WSP(int, OFF_TOKR); const float* TOKW = WSP(float, OFF_TOKW);
    const bool last = (l == DEPTH - 1);
    const int nrows = last ? NLAT : NTOK;
    int eoff = 0;
    { int c = lane < 16 ? (int)CNT[lane] : 0; int incl = c;
        for (int o = 1; o < 16; o <<= 1) { int t = __shfl_up(incl, o); if (lane >= o) incl += t; }
        eoff = incl - c; }
    const int stride = (int)gridDim.x * 8;
    for (int row0 = BID() * 8 + wid; row0 < nrows; row0 += 2 * stride) {
        const bool two = row0 + stride < nrows;
        int rowv[2] = {row0, two ? row0 + stride : row0};
        F4 v[2][RV]; const float* mm[2];
#pragma unroll
        for (int q = 0; q < 2; ++q) { const int row = rowv[q]; mm[q] = MOD + mod_row(row) * 6 * D;
            const int e0 = TOKE[row * 2], e1 = TOKE[row * 2 + 1];
            const long p0 = (long)__shfl(eoff, e0) + TOKR[row * 2], p1 = (long)__shfl(eoff, e1) + TOKR[row * 2 + 1];
            const float w0 = TOKW[row * 2], w1 = TOKW[row * 2 + 1];
#pragma unroll
            for (int i = 0; i < RV; ++i) { int n = (i * 64 + lane) * 4; F4 x = *(const F4*)(XS + (long)row * D + n), g5 = *(const F4*)(mm[q] + 5 * D + n);
                U2 a = *(const U2*)(YE + p0 * D + n), b = *(const U2*)(YE + p1 * D + n);
                float y0 = w0 * bflo(a.x) + w1 * bflo(b.x), y1 = w0 * bfhi(a.x) + w1 * bfhi(b.x), y2 = w0 * bflo(a.y) + w1 * bflo(b.y), y3 = w0 * bfhi(a.y) + w1 * bfhi(b.y);
                v[q][i].x = fmaf(g5.x, y0, DN_ALPHA_F * x.x); v[q][i].y = fmaf(g5.y, y1, DN_ALPHA_F * x.y); v[q][i].z = fmaf(g5.z, y2, DN_ALPHA_F * x.z); v[q][i].w = fmaf(g5.w, y3, DN_ALPHA_F * x.w); } }
        float mean[2], rstd[2]; row_stats2(v, mean, rstd);
#pragma unroll
        for (int q = 0; q < 2; ++q) { if (q == 1 && !two) break; const int row = rowv[q];
            float* dst = dry ? WSP(float, OFF_MIX) + (long)row * D : (last ? GPTR(float, p.out) + (long)row * D : XS + (long)row * D);
#pragma unroll
            for (int i = 0; i < RV; ++i) { int n = (i * 64 + lane) * 4; F4 g = *(const F4*)(lng + n), b = *(const F4*)(lnb + n);
                v[q][i].x = (v[q][i].x - mean[q]) * rstd[q] * g.x + b.x; v[q][i].y = (v[q][i].y - mean[q]) * rstd[q] * g.y + b.y; v[q][i].z = (v[q][i].z - mean[q]) * rstd[q] * g.z + b.z; v[q][i].w = (v[q][i].w - mean[q]) * rstd[q] * g.w + b.w;
                *(F4*)(dst + n) = v[q][i]; } }
        if (!last) { row_stats2(v, mean, rstd);
#pragma unroll
            for (int q = 0; q < 2; ++q) { if (q == 1 && !two) break; const float* m2 = mm[q] + 18 * D; row_modulate_store(v[q], mean[q], rstd[q], m2, m2 + D, H + (long)rowv[q] * D, lane); } }
    }
}
__device__ __forceinline__ void st4bf(bf16_t* dst, f32x4 v) { U2 o; o.x = pack2(v[0], v[1]); o.y = pack2(v[2], v[3]); *(U2*)dst = o; }

__device__ __forceinline__ void phase_inproj(const Params& p, char* lds, int l, int part  ) {
    pg8::Gemm g; g.A = WSP(bf16_t, OFF_H); g.Bt = WSP(bf16_t, off_win(l)) + (long)(part == 0 ? 0 : NPROJ1) * D; g.M = NTOK; g.N = part == 0 ? NPROJ1 : 4 * D; g.K = D;
    pg8::StaticOrder S; S.init(g.M, g.N, (int)gridDim.x, BID());
    pg8::EpiInproj E; E.ws = p.ws; E.ncol0 = part == 0 ? 0 : NPROJ1;
    __syncthreads();
    pg8::gemm_phase<pg8::EpiInproj, pg8::StaticOrder, false>((PG8_LAS unsigned char*)lds, g, S, E, nullptr);
    __syncthreads();
    if (part == 1) {
        const int G = (int)gridDim.x, rem = S.nwg % G, c = BID();
        for (int rep_ = 0; rep_ < REP_W; ++rep_) phase_expert_weights(p, lds, l, rem == 0 ? c : c - rem, rem == 0 ? G : G - rem);
    }
}

__device__ __forceinline__ void phase_prep(const Params& p, char* lds, int l, bool do_rope = true, bool do_c = true, bool do_d = true) {
    const int tid = TID(), G = gridDim.x, bid = BID(), lane = tid & 63, wid = tid >> 6;
    if (bid == 0 && tid < 64) { WSP(u32, OFF_CNT)[tid] = 0u; WSP(u32, OFF_CNT)[128 + tid] = 0u; }
    if (do_rope) {
        bf16_t* DQ = WSP(bf16_t, OFF_SEG_DQKV);
        constexpr int NV = 4 * DH;
        for (long i = (long)bid * NTH + tid; i < (long)NLAT * 32; i += (long)G * NTH) {
            int tok = (int)(i >> 5), f2 = (int)(i & 31);
            int t = tok % SEQ; int axis = f2 >> 4, f = f2 & 15;
            float pos = axis == 0 ? (float)(t / GW) : (float)(t % GW);
            float inv = powf(10000.0f, -(float)f / 16.0f);
            float ang = pos * inv, sn = sinf(ang), cs = cosf(ang);
            bf16_t* base = DQ + (long)tok * 3 * MW + axis * 32 + f;
#pragma unroll
            for (int v = 0; v < NV; ++v) { bf16_t* q = base + v * 64; const float qs = v < 2 * DH ? 0.125f * 1.4426950408889634f : 1.0f;
                float x1 = bf2f(q[0]), x2 = bf2f(q[16]); q[0] = f2bf((x1 * cs - x2 * sn) * qs); q[16] = f2bf((x1 * sn + x2 * cs) * qs); }
        }
    }
    if (do_c) {
        const bf16_t* SG = WSP(bf16_t, OFF_SEG_GQKV); bf16_t* GQ = WSP(bf16_t, OFF_GQ); bf16_t* GK = WSP(bf16_t, OFF_GK); bf16_t* GV = WSP(bf16_t, OFF_GV);
        const float* cwp = GIN(p.gdn_conv) + (long)l * 3 * MW * 3;
        const int sub = tid & 7;
        for (long i = ((long)bid * NTH + tid) >> 3; i < (long)NTOK * GH; i += ((long)G * NTH) >> 3) {
            const int tok = (int)(i / GH), h = (int)(i - (long)tok * GH);
            int seq0, len; if (tok < NLAT) { seq0 = (tok / SEQ) * SEQ; len = SEQ; } else { seq0 = NLAT + ((tok - NLAT) / CTX) * CTX; len = CTX; }
            const int t = tok - seq0; const bool hasp = t > 0, hasn = t + 1 < len;
            float u[3][8];
#pragma unroll
            for (int part = 0; part < 3; ++part) { const int c = part * MW + h * 64 + sub * 8; const bf16_t* s = SG + (long)tok * 3 * MW + c;
                const U4 x1 = *(const U4*)s; const U4 x0 = hasp ? *(const U4*)(s - 3 * MW) : (U4){0u, 0u, 0u, 0u}; const U4 x2 = hasn ? *(const U4*)(s + 3 * MW) : (U4){0u, 0u, 0u, 0u};
                const u32 a0[4] = {x0.x, x0.y, x0.z, x0.w}, a1[4] = {x1.x, x1.y, x1.z, x1.w}, a2[4] = {x2.x, x2.y, x2.z, x2.w};
                float w[24];
#pragma unroll
                for (int q = 0; q < 6; ++q) { const F4 wv = *(const F4*)(cwp + c * 3 + q * 4); w[q * 4] = wv.x; w[q * 4 + 1] = wv.y; w[q * 4 + 2] = wv.z; w[q * 4 + 3] = wv.w; }
#pragma unroll
                for (int e = 0; e < 4; ++e) {
                    float lo = bflo(a0[e]) * w[(2 * e) * 3] + bflo(a1[e]) * w[(2 * e) * 3 + 1] + bflo(a2[e]) * w[(2 * e) * 3 + 2];
                    float hi = bfhi(a0[e]) * w[(2 * e + 1) * 3] + bfhi(a1[e]) * w[(2 * e + 1) * 3 + 1] + bfhi(a2[e]) * w[(2 * e + 1) * 3 + 2];
                    u[part][2 * e] = siluf(lo); u[part][2 * e + 1] = siluf(hi); } }
            float nq = 0.f, nk = 0.f;
#pragma unroll
            for (int e = 0; e < 8; ++e) { nq += u[0][e] * u[0][e]; nk += u[1][e] * u[1][e]; }
            nq = xadd<1>(nq); nq = xadd<2>(nq); nq = xadd<4>(nq);
            nk = xadd<1>(nk); nk = xadd<2>(nk); nk = xadd<4>(nk);
            const float rq = rsqrtf(nq + RMS_EPS) * 0.125f, rk = rsqrtf(nk + RMS_EPS);
            const long o = (long)tok * MW + h * 64 + sub * 8;
            *(U4*)(GQ + o) = (U4){pack2(u[0][0] * rq, u[0][1] * rq), pack2(u[0][2] * rq, u[0][3] * rq), pack2(u[0][4] * rq, u[0][5] * rq), pack2(u[0][6] * rq, u[0][7] * rq)};
            *(U4*)(GK + o) = (U4){pack2(u[1][0] * rk, u[1][1] * rk), pack2(u[1][2] * rk, u[1][3] * rk), pack2(u[1][4] * rk, u[1][5] * rk), pack2(u[1][6] * rk, u[1][7] * rk)};
            *(U4*)(GV + o) = (U4){pack2(u[2][0], u[2][1]), pack2(u[2][2], u[2][3]), pack2(u[2][4], u[2][5]), pack2(u[2][6], u[2][7])};
        }
        const float* GAB = WSP(float, OFF_GAB); float* GB = WSP(float, OFF_GB);
        for (long i = (long)bid * NTH + tid; i < (long)NTOK * 2 * GH; i += (long)G * NTH) {
            int tok = (int)(i / (2 * GH)), dh = (int)(i - (long)tok * 2 * GH);
            float a = GAB[(long)tok * 32 + dh], b = GAB[(long)tok * 32 + 2 * GH + dh];
            float xa = a + GIN(p.gdn_dt_bias)[l * 2 * GH + dh]; float sp = xa > 20.f ? xa : log1pf(__expf(xa));
            GB[(long)tok * 4 * GH + dh] = -__expf(GIN(p.gdn_a_log)[l * 2 * GH + dh]) * sp;
            GB[(long)tok * 4 * GH + 2 * GH + dh] = sigmoidf(b);
        }
    }
    if (do_d) {
        const bf16_t* H2B = WSP(bf16_t, OFF_H2B); const bf16_t* W3T = WSP(bf16_t, OFF_W3T); bf16_t* TAPS = WSP(bf16_t, OFF_TAPS);
        const int wid = tid >> 6, wm = wid >> 1, wn = wid & 1, l15 = lane & 15, g = lane >> 4;
        constexpr int MT = 3, ntm = KEYS / (64 * MT), ntn = 4 * HYW / G_BN;
        for (int u = bid; u < ntm * ntn; u += G) {
            const int tn = u / ntm, tm = u - tn * ntm, row0 = tm * 64 * MT, col0 = tn * G_BN;
            f32x4 acc[MT][4];
            gemm_tile<MT>(lds, [&](int r) { return H2B + (long)(row0 + r) * 128; }, W3T + (long)col0 * 128, 128, 128, acc);
#pragma unroll
            for (int n = 0; n < 4; ++n) { const int colb = col0 + wn * 64 + n * 16 + g * 4;
                const F4 dl4 = *(const F4*)(GIN(p.hy_deltas) + (long)l * 4 * HYW + colb); const float dl[4] = {fabsf(dl4.x), fabsf(dl4.y), fabsf(dl4.z), fabsf(dl4.w)};
#pragma unroll
                for (int m = 0; m < MT; ++m) { const int pos = row0 + wm * 16 * MT + m * 16 + l15; const bool ctxp = pos >= SEQ; const int L = ctxp ? CTX : SEQ, t = ctxp ? pos - SEQ : pos;
                    const float tl = (float)t * (1.0f / (float)(L - 1));
#pragma unroll
                    for (int j = 0; j < 4; ++j) TAPS[(long)(colb + j) * KEYS + pos] = f2bf(acc[m][n][j] * (__expf(-tl * dl[j]) + 0.05f)); } }
        }
    }
}
constexpr int A_LD = 72, AK_LD = 80;
template <int DV> struct AttnLds { static constexpr int K_BYTES = 64 * AK_LD * 2, V_BYTES = DV * A_LD * 2, STAGE = K_BYTES + V_BYTES, TOTAL = 2 * STAGE; };
constexpr float LOG2E = 1.4426950408889634f;
constexpr float NEG_BIG = -1.0e30f;

template <int NQT, int DV, class QRow, class KTile, class MaskFn>
__device__ __forceinline__ void attn_core(char* lds, QRow qrow  , KTile ktile  ,
                                          int ntiles, MaskFn mask  , f32x4 (&oacc)[DV / 16][NQT], float (&lsum)[NQT]) {
    const int tid = TID(), wid = tid >> 6, lane = tid & 63, l15 = lane & 15, g = lane >> 4;
    constexpr int NDT = DV / 16, NVL = DV / 64;
    typedef AttnLds<DV> L;
    bf16x8 qf[NQT][2];
#pragma unroll
    for (int qt = 0; qt < NQT; ++qt) { const bf16_t* q = qrow(wid * NQT * 16 + qt * 16 + l15);
#pragma unroll
        for (int ks = 0; ks < 2; ++ks) qf[qt][ks] = ld8(q + ks * 32 + g * 8); }
    float mrun[NQT];
#pragma unroll
    for (int qt = 0; qt < NQT; ++qt) { mrun[qt] = NEG_BIG; lsum[qt] = 0.f;
#pragma unroll
        for (int dt = 0; dt < NDT; ++dt) oacc[dt][qt] = (f32x4){0.f, 0.f, 0.f, 0.f}; }
    const int sr = tid >> 3, ss = tid & 7;
    U4 rk, rv[NVL];
    { const bf16_t *kp, *vp; long kld, vld; ktile(0, kp, kld, vp, vld);
        rk = *(const U4*)(kp + (long)sr * kld + ss * 8);
#pragma unroll
        for (int i = 0; i < NVL; ++i) rv[i] = *(const U4*)(vp + (long)(sr + 64 * i) * vld + ss * 8); }
    __syncthreads();
    { bf16_t* sK = (bf16_t*)lds; bf16_t* sV = (bf16_t*)(lds + L::K_BYTES);
        *(U4*)(sK + sr * AK_LD + ss * 8) = rk;
#pragma unroll
        for (int i = 0; i < NVL; ++i) *(U4*)(sV + (sr + 64 * i) * A_LD + ss * 8) = rv[i]; }
    __syncthreads();
    for (int t = 0; t < ntiles; ++t) {
        const bool more = t + 1 < ntiles;
        if (more) { const bf16_t *kp, *vp; long kld, vld; ktile(t + 1, kp, kld, vp, vld);
            rk = *(const U4*)(kp + (long)sr * kld + ss * 8);
#pragma unroll
            for (int i = 0; i < NVL; ++i) rv[i] = *(const U4*)(vp + (long)(sr + 64 * i) * vld + ss * 8); }
        const bf16_t* sK = (const bf16_t*)(lds + (t & 1) * L::STAGE); const bf16_t* sV = (const bf16_t*)(lds + (t & 1) * L::STAGE + L::K_BYTES);
        f32x4 s[4][NQT];
#pragma unroll
        for (int mt = 0; mt < 4; ++mt) {
#pragma unroll
            for (int qt = 0; qt < NQT; ++qt) s[mt][qt] = (f32x4){0.f, 0.f, 0.f, 0.f};
#pragma unroll
            for (int ks = 0; ks < 2; ++ks) { bf16x8 kf = ld8(sK + (mt * 16 + l15) * AK_LD + ks * 32 + g * 8);
#pragma unroll
                for (int qt = 0; qt < NQT; ++qt) s[mt][qt] = MFMA16(kf, qf[qt][ks], s[mt][qt]); }
        }
        bf16x8 pf[2][NQT];
#pragma unroll
        for (int qt = 0; qt < NQT; ++qt) {
            const int qi = wid * NQT * 16 + qt * 16 + l15;
            float mx = NEG_BIG;
#pragma unroll
            for (int mt = 0; mt < 4; ++mt)
#pragma unroll
                for (int j = 0; j < 4; ++j) { float v = mask(t, mt, j, qi, s[mt][qt][j] * (0.125f * LOG2E)); s[mt][qt][j] = v; mx = fmaxf(mx, v); }
            mx = xmax<16>(mx); mx = xmax<32>(mx);
            const float mnew = fmaxf(mrun[qt], mx), alpha = fexp2(mrun[qt] - mnew); mrun[qt] = mnew;
            float ps = 0.f;
#pragma unroll
            for (int mt = 0; mt < 4; ++mt)
#pragma unroll
                for (int j = 0; j < 4; ++j) { float pv = fexp2(s[mt][qt][j] - mnew); s[mt][qt][j] = pv; ps += pv; }
            lsum[qt] = lsum[qt] * alpha + ps;
#pragma unroll
            for (int dt = 0; dt < NDT; ++dt) oacc[dt][qt] *= alpha;
#pragma unroll
            for (int kb = 0; kb < 2; ++kb) pf[kb][qt] = mk8u(pack2(s[2 * kb][qt][0], s[2 * kb][qt][1]), pack2(s[2 * kb][qt][2], s[2 * kb][qt][3]),
                                                             pack2(s[2 * kb + 1][qt][0], s[2 * kb + 1][qt][1]), pack2(s[2 * kb + 1][qt][2], s[2 * kb + 1][qt][3]));
        }
#pragma unroll
        for (int dt = 0; dt < NDT; ++dt)
#pragma unroll
            for (int kb = 0; kb < 2; ++kb) { const bf16_t* vr = sV + (dt * 16 + l15) * A_LD + kb * 32 + g * 4;
                bf16x8 vf = mk8(*(const U2*)vr, *(const U2*)(vr + 16));
#pragma unroll
                for (int qt = 0; qt < NQT; ++qt) oacc[dt][qt] = MFMA16(vf, pf[kb][qt], oacc[dt][qt]);
                if (kb == 1 && (dt & 1)) SCHED_FENCE(); }
        if (more) { bf16_t* dK = (bf16_t*)(lds + ((t + 1) & 1) * L::STAGE); bf16_t* dV = (bf16_t*)(lds + ((t + 1) & 1) * L::STAGE + L::K_BYTES);
            *(U4*)(dK + sr * AK_LD + ss * 8) = rk;
#pragma unroll
            for (int i = 0; i < NVL; ++i) *(U4*)(dV + (sr + 64 * i) * A_LD + ss * 8) = rv[i]; }
        __syncthreads();
    }
#pragma unroll
    for (int qt = 0; qt < NQT; ++qt) { float l = lsum[qt]; l = xadd<16>(l); l = xadd<32>(l); lsum[qt] = l; }
}

struct NoMask { __device__ __forceinline__ float operator()(int, int, int, int, float s) const { return s; } };

__device__ __forceinline__ void diff_lambda(const Params& p, int l, float& lam, float& lam_init) {
    const int lane = TID() & 63; const float* dl = GIN(p.diff_lam) + (long)l * 4 * 64;
    const float a = wave_sum(dl[lane] * dl[64 + lane]), b = wave_sum(dl[128 + lane] * dl[192 + lane]);
    int ll = l;
#ifndef CPU_EMU
    asm volatile("" : "+s"(ll));
#endif
    lam_init = 0.8f - 0.6f * expf(-0.3f * (float)ll); lam = expf(a) - expf(b) + lam_init;
}
template <int NQT>
__device__ __forceinline__ void diff_attn_item(const Params& p, char* lds, int l, int b, int h, int q0, bool ctxq) {
    const int tid = TID(), wid = tid >> 6, lane = tid & 63, l15 = lane & 15, g = lane >> 4;
    const bf16_t* DQ = WSP(bf16_t, OFF_SEG_DQKV); const bf16_t* DVT = WSP(bf16_t, OFF_DVT); bf16_t* Y = WSP(bf16_t, OFF_Y);
    const int tok_q0 = ctxq ? NLAT + b * CTX + q0 : b * SEQ + q0;
    const int t_first = ctxq ? SEQ / 64 : 0, ntiles = ctxq ? CTX / 64 : KEYS / 64;
    f32x4 o1[8][NQT]; float l1[NQT];
    {
        auto qrow = [&](int i) { return DQ + (long)(tok_q0 + i) * 3 * MW + h * 128; };
        auto kt = [&](int t, const bf16_t*& kp, long& kld, const bf16_t*& vp, long& vld) { int tt = t_first + t; int tok = bk_tok(b, tt * 64);
            kp = DQ + (long)tok * 3 * MW + MW + h * 128; kld = 3 * MW; vp = DVT + ((long)b * MW + h * 128) * KEYS + tt * 64; vld = KEYS; };
        attn_core<NQT, 128>(lds, qrow, kt, ntiles, NoMask(), o1, l1);
    }
    U2 o1p[8][NQT];
#pragma unroll
    for (int qt = 0; qt < NQT; ++qt) { float inv = 1.0f / l1[qt];
#pragma unroll
        for (int dt = 0; dt < 8; ++dt) { f32x4 v = o1[dt][qt] * inv; o1p[dt][qt].x = pack2(v[0], v[1]); o1p[dt][qt].y = pack2(v[2], v[3]); } }
    f32x4 o2[8][NQT]; float l2[NQT];
    {
        auto qrow = [&](int i) { return DQ + (long)(tok_q0 + i) * 3 * MW + h * 128 + 64; };
        auto kt = [&](int t, const bf16_t*& kp, long& kld, const bf16_t*& vp, long& vld) { int tt = t_first + t; int tok = bk_tok(b, tt * 64);
            kp = DQ + (long)tok * 3 * MW + MW + h * 128 + 64; kld = 3 * MW; vp = DVT + ((long)b * MW + h * 128) * KEYS + tt * 64; vld = KEYS; };
        attn_core<NQT, 128>(lds, qrow, kt, ntiles, NoMask(), o2, l2);
    }
    const int tid2 = TID(), wid2 = tid2 >> 6, l15b = tid2 & 15, gb = (tid2 & 63) >> 4; bf16_t* Yo = WSP(bf16_t, OFF_Y);
    float lam, lam_init; diff_lambda(p, l, lam, lam_init);
    const float* nw = GIN(p.diff_norm) + l * 128;
#pragma unroll
    for (int qt = 0; qt < NQT; ++qt) { float inv = lam / l2[qt]; float ss = 0.f;
#pragma unroll
        for (int dt = 0; dt < 8; ++dt) { f32x4 a = (f32x4){bflo(o1p[dt][qt].x), bfhi(o1p[dt][qt].x), bflo(o1p[dt][qt].y), bfhi(o1p[dt][qt].y)}; o2[dt][qt] = a - o2[dt][qt] * inv;
#pragma unroll
            for (int j = 0; j < 4; ++j) ss += o2[dt][qt][j] * o2[dt][qt][j]; }
        ss = xadd<16>(ss); ss = xadd<32>(ss);
        const float r = rsqrtf(ss * (1.0f / 128.0f) + RMS_EPS) * (1.0f - lam_init);
        const long row = tok_q0 + wid2 * NQT * 16 + qt * 16 + l15b;
#pragma unroll
        for (int dt = 0; dt < 8; ++dt) { F4 w = *(const F4*)(nw + dt * 16 + gb * 4); f32x4 v = o2[dt][qt];
            v[0] *= r * w.x; v[1] *= r * w.y; v[2] *= r * w.z; v[3] *= r * w.w;
            st4bf(Yo + row * 4 * MW + 2 * MW + h * 128 + dt * 16 + gb * 4, v); }
    }
}

struct NaMask {
    const float* rpb;
    int qr, rs, rs0, nct;
    int cidx[16];
    __device__ __forceinline__ float operator()(int t, int mt, int j, int, float s) const {
        if (t < nct) return s;
        const int kr = rs0 + (t - nct), ci = cidx[mt * 4 + j];
        const bool ok = (kr >= rs) && (kr < rs + 8) && (ci >= 0);
        int dr = kr - qr + 7; dr = dr < 0 ? 0 : (dr > 14 ? 14 : dr);
        return ok ? s + rpb[dr * 31 + (ci < 0 ? 0 : ci)] : NEG_BIG;
    }
};
__device__ __forceinline__ void na_attn_item(const Params& p, char* lds, int l, int b, int h, int rp) {
    const int tid = TID(), wid = tid >> 6, lane = tid & 63, l15 = lane & 15, g = lane >> 4;
    const bf16_t* NQ = WSP(bf16_t, OFF_SEG_NQKV); const bf16_t* NVT = WSP(bf16_t, OFF_NVT); bf16_t* Y = WSP(bf16_t, OFF_Y);
    float* rpb = (float*)(lds + AttnLds<64>::TOTAL);
    __syncthreads();
    for (int i = tid; i < 15 * 31; i += NTH) rpb[i] = GIN(p.na_rpb)[((long)(l * NH + h) * 15) * 31 + i] * LOG2E;
    const int r0 = rp * 2; int rs0 = r0 - 4; rs0 = rs0 < 0 ? 0 : (rs0 > R_ROWS - 8 ? R_ROWS - 8 : rs0);
    int nwin = R_ROWS - rs0; nwin = nwin > 9 ? 9 : nwin;
    constexpr int NCT = CTX / 64;
    NaMask mk; mk.rpb = rpb; mk.rs0 = rs0; mk.nct = NCT;
    { const int qi = wid * 16 + l15, qc = qi & 63; mk.qr = r0 + (wid >> 2);
        int rs = mk.qr - 4; mk.rs = rs < 0 ? 0 : (rs > R_ROWS - 8 ? R_ROWS - 8 : rs);
        int cs = qc - 8; cs = cs < 0 ? 0 : (cs > GW - 16 ? GW - 16 : cs);
#pragma unroll
        for (int mt = 0; mt < 4; ++mt)
#pragma unroll
            for (int j = 0; j < 4; ++j) { const int kc = mt * 16 + g * 4 + j; int dc = kc - qc; dc = dc < -15 ? -15 : (dc > 15 ? 15 : dc); mk.cidx[mt * 4 + j] = (kc >= cs && kc < cs + 16) ? dc + 15 : -1; } }
    const int tok_q0 = b * SEQ + r0 * 64;
    auto qrow = [&](int i) { return NQ + (long)(tok_q0 + i) * 3 * MW + h * 64; };
    auto kt = [&](int t, const bf16_t*& kp, long& kld, const bf16_t*& vp, long& vld) { int key = t < NCT ? SEQ + t * 64 : (rs0 + t - NCT) * 64; int tok = bk_tok(b, key);
        kp = NQ + (long)tok * 3 * MW + MW + h * 64; kld = 3 * MW; vp = NVT + ((long)b * MW + h * 64) * KEYS + key; vld = KEYS; };
    f32x4 o[4][1]; float ls[1];
    attn_core<1, 64>(lds, qrow, kt, NCT + nwin, mk, o, ls);
    const float inv = 1.0f / ls[0]; const long row = tok_q0 + wid * 16 + l15;
#pragma unroll
    for (int dt = 0; dt < 4; ++dt) { f32x4 v = o[dt][0] * inv; st4bf(Y + row * 4 * MW + 3 * MW + h * 64 + dt * 16 + g * 4, v); }
}
__device__ __forceinline__ void na_ctx_item(const Params& p, char* lds, int b, int h, int q0) {
    const int tid = TID(), wid = tid >> 6, lane = tid & 63, l15 = lane & 15, g = lane >> 4;
    const bf16_t* NQ = WSP(bf16_t, OFF_SEG_NQKV); const bf16_t* NVT = WSP(bf16_t, OFF_NVT); bf16_t* Y = WSP(bf16_t, OFF_Y);
    const int tok_q0 = NLAT + b * CTX + q0;
    auto qrow = [&](int i) { return NQ + (long)(tok_q0 + i) * 3 * MW + h * 64; };
    auto kt = [&](int t, const bf16_t*& kp, long& kld, const bf16_t*& vp, long& vld) { int key = SEQ + t * 64; int tok = bk_tok(b, key);
        kp = NQ + (long)tok * 3 * MW + MW + h * 64; kld = 3 * MW; vp = NVT + ((long)b * MW + h * 64) * KEYS + key; vld = KEYS; };
    f32x4 o[4][1]; float ls[1];
    attn_core<1, 64>(lds, qrow, kt, CTX / 64, NoMask(), o, ls);
    const float inv = 1.0f / ls[0]; const long row = tok_q0 + wid * 16 + l15;
#pragma unroll
    for (int dt = 0; dt < 4; ++dt) { f32x4 v = o[dt][0] * inv; st4bf(Y + row * 4 * MW + 3 * MW + h * 64 + dt * 16 + g * 4, v); }
}

#define MFMA32(a, b, c) __builtin_amdgcn_mfma_f32_32x32x16_bf16(a, b, c, 0, 0, 0)
#ifndef CPU_EMU
typedef float f32x16 __attribute__((ext_vector_type(16)));
#endif
constexpr int D32_KT = 128;
constexpr int D32_KLD = 80, D32_VLD = D32_KT + 4;
constexpr int D32_KB = D32_KT * D32_KLD * 2, D32_VB = 128 * D32_VLD * 2, D32_STAGE = D32_KB + D32_VB, D32_TOTAL = 2 * D32_STAGE;
static_assert(D32_TOTAL <= 160 * 1024 - 64 && KEYS % D32_KT == 0, "diff32 lds");

__device__ __forceinline__ void diff32_pass(char* lds, const bf16_t* qp  , const bf16_t* kbase  ,
                                            const bf16_t* vbase  , int b, f32x16 (&oacc)[4], float& lsum) {
    const int tid = TID(), lane = tid & 63, r32 = lane & 31, hh = lane >> 5;
    bf16x8 qf[4];
#pragma unroll
    for (int ks = 0; ks < 4; ++ks) qf[ks] = ld8(qp + ks * 16 + hh * 8);
#pragma unroll
    for (int dt = 0; dt < 4; ++dt)
#pragma unroll
        for (int r = 0; r < 16; ++r) oacc[dt][r] = 0.f;
    float mrun = -64.0f; lsum = 0.f;
    f32x16 cinit;
#pragma unroll
    for (int r = 0; r < 16; ++r) cinit[r] = -mrun;
    const int sr = tid >> 3, ss = tid & 7, vr_ = tid >> 4, vs = tid & 15;
    U4 rk[2], rv[4];
    constexpr int NT = KEYS / D32_KT;
    auto gload = [&](int t) { const long tok = bk_tok(b, t * D32_KT);
#pragma unroll
        for (int i = 0; i < 2; ++i) rk[i] = *(const U4*)(kbase + (tok + sr + 64 * i) * 3 * MW + ss * 8);
#pragma unroll
        for (int i = 0; i < 4; ++i) rv[i] = *(const U4*)(vbase + (long)(vr_ + 32 * i) * KEYS + t * D32_KT + vs * 8); };
    auto sstore = [&](int st) { bf16_t* sK = (bf16_t*)(lds + st * D32_STAGE); bf16_t* sV = (bf16_t*)(lds + st * D32_STAGE + D32_KB);
#pragma unroll
        for (int i = 0; i < 2; ++i) *(U4*)(sK + (sr + 64 * i) * D32_KLD + ss * 8) = rk[i];
#pragma unroll
        for (int i = 0; i < 4; ++i) { bf16_t* d = sV + (vr_ + 32 * i) * D32_VLD + vs * 8; *(U2*)d = (U2){rv[i].x, rv[i].y}; *(U2*)(d + 4) = (U2){rv[i].z, rv[i].w}; } };
    gload(0);
    __syncthreads();
    sstore(0);
    __syncthreads();
    for (int t = 0; t < NT; ++t) {
        const bool more = t + 1 < NT;
        if (more) gload(t + 1);
#pragma unroll 1
        for (int sub = 0; sub < 2; ++sub) {
        const bf16_t* sK = (const bf16_t*)(lds + (t & 1) * D32_STAGE) + sub * 64 * D32_KLD; const bf16_t* sV = (const bf16_t*)(lds + (t & 1) * D32_STAGE + D32_KB) + sub * 64;
        f32x16 s[2];
        {
            bf16x8 kf[2][4];
#pragma unroll
            for (int kt = 0; kt < 2; ++kt)
#pragma unroll
                for (int ks = 0; ks < 4; ++ks) kf[kt][ks] = ld8(sK + (kt * 32 + r32) * D32_KLD + ks * 16 + hh * 8);
            SCHED_FENCE();
#pragma unroll
            for (int kt = 0; kt < 2; ++kt) {
                s[kt] = MFMA32(kf[kt][0], qf[0], cinit);
#pragma unroll
                for (int ks = 1; ks < 4; ++ks) s[kt] = MFMA32(kf[kt][ks], qf[ks], s[kt]);
            }
        }
        float mx = -3.0e38f;
#pragma unroll
        for (int kt = 0; kt < 2; ++kt)
#pragma unroll
            for (int r = 0; r < 16; ++r) mx = fmaxf(mx, s[kt][r]);
        mx = xmax<32>(mx);
        if (__ballot(mx > 6.0f) != 0ull) {
            const float d = fmaxf(mx, 0.f), alpha = fexp2(-d);
            mrun += d; lsum *= alpha;
#pragma unroll
            for (int r = 0; r < 16; ++r) cinit[r] = -mrun;
#pragma unroll
            for (int kt = 0; kt < 2; ++kt)
#pragma unroll
                for (int r = 0; r < 16; ++r) s[kt][r] -= d;
#pragma unroll
            for (int dt = 0; dt < 4; ++dt) oacc[dt] *= alpha;
        }
        float ps = 0.f;
#pragma unroll
        for (int kt = 0; kt < 2; ++kt)
#pragma unroll
            for (int r = 0; r < 16; ++r) { float pv = fexp2(s[kt][r]); s[kt][r] = pv; ps += pv; }
        lsum += ps;
        {
            bf16x8 va[4], vb[4];
#define D32_LDV(dst, kt, sx) _Pragma("unroll") for (int dt = 0; dt < 4; ++dt) { const bf16_t* vr = sV + (dt * 32 + r32) * D32_VLD + (kt) * 32 + (sx) * 16 + hh * 4; dst[dt] = mk8(*(const U2*)vr, *(const U2*)(vr + 8)); }
#define D32_PF(kt, sx) mk8u(pack2(s[kt][8 * (sx)], s[kt][8 * (sx) + 1]), pack2(s[kt][8 * (sx) + 2], s[kt][8 * (sx) + 3]), pack2(s[kt][8 * (sx) + 4], s[kt][8 * (sx) + 5]), pack2(s[kt][8 * (sx) + 6], s[kt][8 * (sx) + 7]))
#define D32_MMA(src, pf) _Pragma("unroll") for (int dt = 0; dt < 4; ++dt) oacc[dt] = MFMA32(src[dt], pf, oacc[dt]);
            D32_LDV(va, 0, 0) D32_LDV(vb, 0, 1)
            const bf16x8 p0 = D32_PF(0, 0), p1 = D32_PF(0, 1), p2 = D32_PF(1, 0), p3 = D32_PF(1, 1);
            SCHED_FENCE();
            D32_MMA(va, p0) D32_LDV(va, 1, 0)
            SCHED_FENCE();
            D32_MMA(vb, p1) D32_LDV(vb, 1, 1)
            SCHED_FENCE();
            D32_MMA(va, p2)
            D32_MMA(vb, p3)
#undef D32_LDV
#undef D32_PF
#undef D32_MMA
        }
        }
        if (more) sstore((t + 1) & 1);
        __syncthreads();
    }
    lsum = xadd<32>(lsum);
}

__device__ __forceinline__ void diff32_item(const Params& p, char* lds, int l, int b, int h, int q0, int comp) {
    const int tid = TID(), wid = tid >> 6, lane = tid & 63, r32 = lane & 31, hh = lane >> 5;
    const bf16_t* DQ = WSP(bf16_t, OFF_SEG_DQKV); const bf16_t* DVT = WSP(bf16_t, OFF_DVT);
    const long qtok = (long)b * SEQ + q0 + wid * 32 + r32;
    f32x16 oacc[4]; float ls;
    diff32_pass(lds, DQ + qtok * 3 * MW + h * 128 + comp * 64, DQ + MW + h * 128 + comp * 64, DVT + ((long)b * MW + h * 128) * KEYS, b, oacc, ls);
    bf16_t* Yo = WSP(bf16_t, OFF_Y) + qtok * 4 * MW + (comp == 0 ? 2 * MW : 0) + h * 128;
    const float inv = 1.0f / ls;
#pragma unroll
    for (int dt = 0; dt < 4; ++dt)
#pragma unroll
        for (int q = 0; q < 4; ++q) { const int dv = dt * 32 + 8 * q + 4 * hh;
            st4bf(Yo + dv, (f32x4){oacc[dt][4 * q] * inv, oacc[dt][4 * q + 1] * inv, oacc[dt][4 * q + 2] * inv, oacc[dt][4 * q + 3] * inv}); }
}

constexpr int N32_VLD = 68;
constexpr int N32_KB = 64 * D32_KLD * 2, N32_VB = 64 * N32_VLD * 2, N32_STAGE = N32_KB + N32_VB, N32_RPB = 2 * N32_STAGE;
static_assert(R_ROWS % 4 == 0 && GW == 64 && N32_RPB + 16 * 128 * 4 <= 100 * 1024, "na32");
__device__ __forceinline__ void na32_item(const Params& p, char* lds, int l, int b, int h, int rq) {
    const int tid = TID(), wid = tid >> 6, lane = tid & 63, r32 = lane & 31, hh = lane >> 5;
    const bf16_t* NQ = WSP(bf16_t, OFF_SEG_NQKV); const bf16_t* NVT = WSP(bf16_t, OFF_NVT);
    float* rpb = (float*)(lds + N32_RPB);
    __syncthreads();
    for (int i = tid; i < 16 * 128; i += NTH) { const int dr = i >> 7, c = (i & 127) - 48;
        rpb[i] = dr == 15 ? NEG_BIG : ((c >= 0 && c < 31) ? GIN(p.na_rpb)[((long)(l * NH + h) * 15 + dr) * 31 + c] * LOG2E : 0.f); }
    constexpr int NCT = CTX / 64;
    const int r0 = rq * 4, qr = r0 + (wid >> 1), qc = (wid & 1) * 32 + r32;
    int rs0 = r0 - 4; rs0 = rs0 < 0 ? 0 : (rs0 > R_ROWS - 8 ? R_ROWS - 8 : rs0);
    int rsl = r0 - 1; rsl = rsl < 0 ? 0 : (rsl > R_ROWS - 8 ? R_ROWS - 8 : rsl);
    const int NT = NCT + (rsl + 8 - rs0);
    int rs = qr - 4; rs = rs < 0 ? 0 : (rs > R_ROWS - 8 ? R_ROWS - 8 : rs);
    int cs = qc - 8; cs = cs < 0 ? 0 : (cs > GW - 16 ? GW - 16 : cs);
    const long qtok = (long)b * SEQ + qr * 64 + qc;
    bf16x8 qf[4];
    { const bf16_t* qp = NQ + qtok * 3 * MW + h * 64; constexpr float sc = 0.125f * LOG2E;
#pragma unroll
        for (int ks = 0; ks < 4; ++ks) { const U4 r = *(const U4*)(qp + ks * 16 + hh * 8);
            qf[ks] = mk8u(pack2(bflo(r.x) * sc, bfhi(r.x) * sc), pack2(bflo(r.y) * sc, bfhi(r.y) * sc), pack2(bflo(r.z) * sc, bfhi(r.z) * sc), pack2(bflo(r.w) * sc, bfhi(r.w) * sc)); } }
    f32x16 oacc[2];
#pragma unroll
    for (int dt = 0; dt < 2; ++dt)
#pragma unroll
        for (int r = 0; r < 16; ++r) oacc[dt][r] = 0.f;
    float mrun = -64.0f, lsum = 0.f;
    f32x16 cplain, cm[2];
#pragma unroll
    for (int r = 0; r < 16; ++r) cplain[r] = -mrun;
#pragma unroll
    for (int kt = 0; kt < 2; ++kt)
#pragma unroll
        for (int r = 0; r < 16; ++r) { const int kc = kt * 32 + (r & 3) + 8 * (r >> 2) + 4 * hh; cm[kt][r] = (kc >= cs && kc < cs + 16) ? -mrun : NEG_BIG; }
    const int sr = tid >> 3, ss = tid & 7;
    const bf16_t* kbase = NQ + MW + h * 64; const bf16_t* vbase = NVT + ((long)b * MW + h * 64) * KEYS;
    U4 rk, rv;
    auto gload = [&](int t) { const int key = t < NCT ? SEQ + t * 64 : (rs0 + t - NCT) * 64; const long tok = bk_tok(b, key);
        rk = *(const U4*)(kbase + (tok + sr) * 3 * MW + ss * 8); rv = *(const U4*)(vbase + (long)sr * KEYS + key + ss * 8); };
    auto sstore = [&](int st) { bf16_t* sK = (bf16_t*)(lds + st * N32_STAGE); bf16_t* sV = (bf16_t*)(lds + st * N32_STAGE + N32_KB);
        *(U4*)(sK + sr * D32_KLD + ss * 8) = rk; bf16_t* d = sV + sr * N32_VLD + ss * 8; *(U2*)d = (U2){rv.x, rv.y}; *(U2*)(d + 4) = (U2){rv.z, rv.w}; };
    gload(0);
    __syncthreads();
    sstore(0);
    __syncthreads();
    for (int t = 0; t < NT; ++t) {
        const bool more = t + 1 < NT;
        if (more) gload(t + 1);
        const bf16_t* sK = (const bf16_t*)(lds + (t & 1) * N32_STAGE); const bf16_t* sV = (const bf16_t*)(lds + (t & 1) * N32_STAGE + N32_KB);
        f32x16 s[2];
        {
            bf16x8 kf[2][4];
#pragma unroll
            for (int kt = 0; kt < 2; ++kt)
#pragma unroll
                for (int ks = 0; ks < 4; ++ks) kf[kt][ks] = ld8(sK + (kt * 32 + r32) * D32_KLD + ks * 16 + hh * 8);
            SCHED_FENCE();
            if (t < NCT) {
#pragma unroll
                for (int kt = 0; kt < 2; ++kt) { s[kt] = MFMA32(kf[kt][0], qf[0], cplain);
#pragma unroll
                    for (int ks = 1; ks < 4; ++ks) s[kt] = MFMA32(kf[kt][ks], qf[ks], s[kt]); }
            } else {
                const int kr = rs0 + t - NCT; const int rsel = (kr >= rs && kr < rs + 8) ? kr - qr + 7 : 15;
                const float* bp = rpb + rsel * 128 + (4 * hh - qc + 63);
#pragma unroll
                for (int kt = 0; kt < 2; ++kt) { s[kt] = MFMA32(kf[kt][0], qf[0], cm[kt]);
#pragma unroll
                    for (int ks = 1; ks < 4; ++ks) s[kt] = MFMA32(kf[kt][ks], qf[ks], s[kt]); }
#pragma unroll
                for (int kt = 0; kt < 2; ++kt)
#pragma unroll
                    for (int r = 0; r < 16; ++r) s[kt][r] += bp[kt * 32 + (r & 3) + 8 * (r >> 2)];
            }
        }
        float mx = -3.0e38f;
#pragma unroll
        for (int kt = 0; kt < 2; ++kt)
#pragma unroll
            for (int r = 0; r < 16; ++r) mx = fmaxf(mx, s[kt][r]);
        mx = xmax<32>(mx);
        if (__ballot(mx > 6.0f) != 0ull) {
            const float d = fmaxf(mx, 0.f), alpha = fexp2(-d);
            mrun += d; lsum *= alpha;
#pragma unroll
            for (int r = 0; r < 16; ++r) cplain[r] = -mrun;
#pragma unroll
            for (int kt = 0; kt < 2; ++kt)
#pragma unroll
                for (int r = 0; r < 16; ++r) { cm[kt][r] -= d; s[kt][r] -= d; }
#pragma unroll
            for (int dt = 0; dt < 2; ++dt) oacc[dt] *= alpha;
        }
        float ps = 0.f;
#pragma unroll
        for (int kt = 0; kt < 2; ++kt)
#pragma unroll
            for (int r = 0; r < 16; ++r) { float pv = fexp2(s[kt][r]); s[kt][r] = pv; ps += pv; }
        lsum += ps;
        {
            bf16x8 va[2], vb[2];
#define N32_LDV(dst, kt, sx) _Pragma("unroll") for (int dt = 0; dt < 2; ++dt) { const bf16_t* vr = sV + (dt * 32 + r32) * N32_VLD + (kt) * 32 + (sx) * 16 + hh * 4; dst[dt] = mk8(*(const U2*)vr, *(const U2*)(vr + 8)); }
#define N32_PF(kt, sx) mk8u(pack2(s[kt][8 * (sx)], s[kt][8 * (sx) + 1]), pack2(s[kt][8 * (sx) + 2], s[kt][8 * (sx) + 3]), pack2(s[kt][8 * (sx) + 4], s[kt][8 * (sx) + 5]), pack2(s[kt][8 * (sx) + 6], s[kt][8 * (sx) + 7]))
#define N32_MMA(src, pf) _Pragma("unroll") for (int dt = 0; dt < 2; ++dt) oacc[dt] = MFMA32(src[dt], pf, oacc[dt]);
            N32_LDV(va, 0, 0) N32_LDV(vb, 0, 1)
            const bf16x8 p0 = N32_PF(0, 0), p1 = N32_PF(0, 1), p2 = N32_PF(1, 0), p3 = N32_PF(1, 1);
            SCHED_FENCE();
            N32_MMA(va, p0) N32_LDV(va, 1, 0)
            SCHED_FENCE();
            N32_MMA(vb, p1) N32_LDV(vb, 1, 1)
            SCHED_FENCE();
            N32_MMA(va, p2)
            N32_MMA(vb, p3)
#undef N32_LDV
#undef N32_PF
#undef N32_MMA
        }
        if (more) sstore((t + 1) & 1);
        __syncthreads();
    }
    lsum = xadd<32>(lsum);
    const int tid2 = TID(), lane2 = tid2 & 63, wid2 = tid2 >> 6;
    bf16_t* Yo = WSP(bf16_t, OFF_Y) + ((long)b * SEQ + (r0 + (wid2 >> 1)) * 64 + (wid2 & 1) * 32 + (lane2 & 31)) * 4 * MW + 3 * MW + h * 64;
    const float inv = 1.0f / lsum;
#pragma unroll
    for (int dt = 0; dt < 2; ++dt)
#pragma unroll
        for (int q = 0; q < 4; ++q) { const int dv = dt * 32 + 8 * q + 4 * (lane2 >> 5);
            st4bf(Yo + dv, (f32x4){oacc[dt][4 * q] * inv, oacc[dt][4 * q + 1] * inv, oacc[dt][4 * q + 2] * inv, oacc[dt][4 * q + 3] * inv}); }
}
static_assert(NTASK_GDN % 4 == 0, "gdn tasks");
__device__ __forceinline__ void gdn_decode(int chain, int n, int& b, int& h, int& dir, int& base, int& T, int& c) {
    dir = chain & 1; int bh = chain >> 1; h = bh % GH; b = bh / GH;
    if (n < NCH_CTX) { base = NLAT + b * CTX; T = CTX; c = n; } else { base = b * SEQ; T = SEQ; c = n - NCH_CTX; }
}
__device__ __forceinline__ int gdn_pos(int dir, int T, int c, int i) { int r = 64 * c + i; return dir ? T - 1 - r : r; }

constexpr int GP_K = 0, GP_V = 10240, GP_AB = 20480, GP_AD = 30720, GP_XT = GP_AD + 4 * 16 * 16 * 4, GP_R = GP_XT + 128 * 80 * 2, GP_F = GP_R + 16 * 132 * 4, GP_TASK = GP_F + 1024;
static_assert(2 * GP_TASK <= 160 * 1024 - 64 && NTASK_GDN % 2 == 0, "gdn prep lds");
__device__ __forceinline__ void gdn_chunk_prep2(const Params& p, char* lds, int l, int task0) {
    const int tid = TID(), wid = tid >> 6, lane = tid & 63, l15 = lane & 15, g = lane >> 4, tk = wid >> 2, w4 = wid & 3, t4 = tid & 255;
    const int task = task0 + tk, chain = task / NCH, n = task - chain * NCH;
    int b, h, dir, base, T, c; gdn_decode(chain, n, b, h, dir, base, T, c);
    char* L = lds + tk * GP_TASK;
    bf16_t* Kt = (bf16_t*)(L + GP_K); bf16_t* Vt = (bf16_t*)(L + GP_V); bf16_t* Ab = (bf16_t*)(L + GP_AB); float* Ad = (float*)(L + GP_AD); bf16_t* XT = (bf16_t*)(L + GP_XT); float* R = (float*)(L + GP_R);
    float* gcs = (float*)(L + GP_F); float* bet = gcs + 64; float* fac = gcs + 128;
    const bf16_t* GK = WSP(bf16_t, OFF_GK); const bf16_t* GV = WSP(bf16_t, OFF_GV); const float* GB = WSP(float, OFF_GB);
    __syncthreads();
#pragma unroll
    for (int q = 0; q < 2; ++q) { int pc = t4 + 256 * q, i = pc >> 3, s = pc & 7; long tok = base + gdn_pos(dir, T, c, i);
        *(U4*)(Kt + i * 80 + s * 8) = *(const U4*)(GK + tok * MW + h * 64 + s * 8);
        *(U4*)(Vt + i * 80 + s * 8) = *(const U4*)(GV + tok * MW + h * 64 + s * 8); }
    for (int i = t4; i < 128 * 80 / 8; i += 256) *(U4*)(XT + i * 8) = (U4){0u, 0u, 0u, 0u};
    if (w4 == 0) { long tok = base + gdn_pos(dir, T, c, lane); float gi = GB[tok * 4 * GH + dir * GH + h], be = GB[tok * 4 * GH + 2 * GH + dir * GH + h];
        float cs = gi;
        for (int o = 1; o < 64; o <<= 1) { float t = __shfl_up(cs, o); if (lane >= o) cs += t; }
        gcs[lane] = cs; bet[lane] = be; fac[lane] = be * __expf(cs); }
    __syncthreads();
    { const int mt = w4; const int i = mt * 16 + l15; const float bi = bet[i], gi = gcs[i];
        bf16x8 bfr[2];
#pragma unroll
        for (int ks = 0; ks < 2; ++ks) bfr[ks] = ld8(Kt + (mt * 16 + l15) * 80 + ks * 32 + g * 8);
        for (int nt = 0; nt <= mt; ++nt) { f32x4 acc = (f32x4){0.f, 0.f, 0.f, 0.f};
#pragma unroll
            for (int ks = 0; ks < 2; ++ks) acc = MFMA16(ld8(Kt + (nt * 16 + l15) * 80 + ks * 32 + g * 8), bfr[ks], acc);
            float v[4];
#pragma unroll
            for (int jj = 0; jj < 4; ++jj) { const int j = nt * 16 + g * 4 + jj; v[jj] = j < i ? bi * acc[jj] * __expf(gi - gcs[j]) : 0.f; }
            if (nt < mt) *(U2*)(Ab + i * 80 + nt * 16 + g * 4) = (U2){pack2(v[0], v[1]), pack2(v[2], v[3])};
            else { *(U2*)(Ab + i * 80 + nt * 16 + g * 4) = (U2){0u, 0u}; *(F4*)(Ad + (mt * 16 + l15) * 16 + g * 4) = (F4){v[0], v[1], v[2], v[3]}; } }
    }
    __syncthreads();
    const bool wcol = t4 < 64; const int cc = t4 & 63;
    const bf16_t* src = wcol ? Kt : Vt; const float* scl = wcol ? fac : bet;
    bf16_t* dst = WSP(bf16_t, OFF_WU) + ((long)task * 2 + (wcol ? 0 : 1)) * 4096 + cc;
#pragma unroll
    for (int I = 0; I < 4; ++I) {
        if (I > 0) {
#pragma unroll
            for (int q = 0; q < 2; ++q) { const int nt = w4 * 2 + q; f32x4 acc = (f32x4){0.f, 0.f, 0.f, 0.f};
                acc = MFMA16(ld8(Ab + (I * 16 + l15) * 80 + g * 8), ld8(XT + (nt * 16 + l15) * 80 + g * 8), acc);
                if (I == 3) acc = MFMA16(ld8(Ab + (I * 16 + l15) * 80 + 32 + g * 8), ld8(XT + (nt * 16 + l15) * 80 + 32 + g * 8), acc);
#pragma unroll
                for (int jj = 0; jj < 4; ++jj) R[(g * 4 + jj) * 132 + nt * 16 + l15] = acc[jj]; }
            __syncthreads();
        }
        if (t4 < 128) {
            float x[16];
#pragma unroll
            for (int ii = 0; ii < 16; ++ii) { float a = scl[I * 16 + ii] * bf2f(src[(I * 16 + ii) * 80 + cc]); if (I > 0) a -= R[ii * 132 + t4];
#pragma unroll
                for (int jj = 0; jj < ii; ++jj) a -= Ad[(I * 16 + ii) * 16 + jj] * x[jj];
                x[ii] = a; }
            *(U4*)(XT + t4 * 80 + I * 16) = (U4){pack2(x[0], x[1]), pack2(x[2], x[3]), pack2(x[4], x[5]), pack2(x[6], x[7])};
            *(U4*)(XT + t4 * 80 + I * 16 + 8) = (U4){pack2(x[8], x[9]), pack2(x[10], x[11]), pack2(x[12], x[13]), pack2(x[14], x[15])};
#pragma unroll
            for (int ii = 0; ii < 16; ++ii) dst[(I * 16 + ii) * 64] = f2bf(x[ii]);
        }
        __syncthreads();
    }
}

constexpr int GS_W = 0, GS_Q = 10240, GS_K = 20480, GS_KT = 30720, GS_GC = 40960, GS_STAGE = 40960 + 512;
constexpr int GS_ST = 2 * GS_STAGE, GS_VNT = GS_ST + 2 * 5120, GS_VNT2 = GS_VNT + 5120, GS_ATT = GS_VNT2 + 5120, GS_TOTAL = GS_ATT + 10240;
__device__ __forceinline__ void gdn_scan_item(const Params& p, char* lds, int l, int cb) {
    const int tid = TID(), wid = tid >> 6, lane = tid & 63, l15 = lane & 15, g = lane >> 4, mt = wid >> 1, nt = wid & 1;
    {
    const int chain = cb >> 1, half = cb & 1;
    const bf16_t* GQ = WSP(bf16_t, OFF_GQ); const bf16_t* GK = WSP(bf16_t, OFF_GK); const float* GB = WSP(float, OFF_GB); const bf16_t* WU = WSP(bf16_t, OFF_WU);
    const int sr = tid >> 3, ss = tid & 7;
    f32x4 sacc = (f32x4){0.f, 0.f, 0.f, 0.f};
    U4 rw, rq, rk; float ucur[4], unext[4]; float gnext = 0.f;
    auto load_chunk = [&](int n) {
        int b, h, dir, base, T, c; gdn_decode(chain, n, b, h, dir, base, T, c);
        const long task = (long)chain * NCH + n; const long tok = base + gdn_pos(dir, T, c, sr);
        rw = *(const U4*)(WU + (task * 2 + 0) * 4096 + sr * 64 + ss * 8);
        rq = *(const U4*)(GQ + tok * MW + h * 64 + ss * 8);
        rk = *(const U4*)(GK + tok * MW + h * 64 + ss * 8);
#pragma unroll
        for (int j = 0; j < 4; ++j) unext[j] = bf2f(WU[(task * 2 + 1) * 4096 + (mt * 16 + g * 4 + j) * 64 + half * 32 + nt * 16 + l15]);
        if (wid == 0) { const long tk = base + gdn_pos(dir, T, c, lane); gnext = GB[tk * 4 * GH + dir * GH + h]; }
    };
    auto store_chunk = [&](int st) {
        char* S = lds + st * GS_STAGE;
        *(U4*)((bf16_t*)(S + GS_W) + sr * 80 + ss * 8) = rw;
        *(U4*)((bf16_t*)(S + GS_Q) + sr * 80 + ss * 8) = rq;
        *(U4*)((bf16_t*)(S + GS_K) + sr * 80 + ss * 8) = rk;
        bf16_t* KT = (bf16_t*)(S + GS_KT);
        const u32 kw[4] = {rk.x, rk.y, rk.z, rk.w};
#pragma unroll
        for (int e = 0; e < 4; ++e) { KT[(ss * 8 + 2 * e) * 80 + sr] = (bf16_t)(kw[e] & 0xffffu); KT[(ss * 8 + 2 * e + 1) * 80 + sr] = (bf16_t)(kw[e] >> 16); }
        if (wid == 0) { float cs = gnext;
            for (int o = 1; o < 64; o <<= 1) { float t = __shfl_up(cs, o); if (lane >= o) cs += t; }
            ((float*)(S + GS_GC))[lane] = cs; }
    };
    __syncthreads();
    { bf16_t* ST0 = (bf16_t*)(lds + GS_ST); for (int i = tid; i < 32 * 80; i += NTH) ST0[i] = 0; }
    load_chunk(0); store_chunk(0);
#pragma unroll
    for (int j = 0; j < 4; ++j) ucur[j] = unext[j];
    __syncthreads();
    for (int n = 0; n < NCH; ++n) {
        const int st = n & 1;
        if (n + 1 < NCH) load_chunk(n + 1);
        const char* S = lds + st * GS_STAGE;
        const bf16_t* Wt = (const bf16_t*)(S + GS_W); const bf16_t* Qt = (const bf16_t*)(S + GS_Q); const bf16_t* Kt = (const bf16_t*)(S + GS_K); const bf16_t* KT = (const bf16_t*)(S + GS_KT);
        const float* gc = (const float*)(S + GS_GC);
        const bf16_t* STc = (const bf16_t*)(lds + GS_ST + st * 5120); bf16_t* STn = (bf16_t*)(lds + GS_ST + (st ^ 1) * 5120);
        bf16_t* VNT = (bf16_t*)(lds + GS_VNT); bf16_t* VNT2 = (bf16_t*)(lds + GS_VNT2); bf16_t* ATT = (bf16_t*)(lds + GS_ATT);
        const float gl = gc[63];
#pragma unroll
        for (int q = 0; q < 2; ++q) { const int tile = wid * 2 + q, it = tile >> 2, jt = tile & 3;
            f32x4 acc = (f32x4){0.f, 0.f, 0.f, 0.f};
            if (jt <= it) {
#pragma unroll
                for (int ks = 0; ks < 2; ++ks) acc = MFMA16(ld8(Kt + (jt * 16 + l15) * 80 + ks * 32 + g * 8), ld8(Qt + (it * 16 + l15) * 80 + ks * 32 + g * 8), acc);
            }
            const int i = it * 16 + l15; const float gi = gc[i]; float v[4];
#pragma unroll
            for (int j = 0; j < 4; ++j) { const int jp = jt * 16 + g * 4 + j; v[j] = jp <= i ? acc[j] * __expf(gi - gc[jp]) : 0.f; }
            U2 o; o.x = pack2(v[0], v[1]); o.y = pack2(v[2], v[3]); *(U2*)(ATT + i * 80 + jt * 16 + g * 4) = o; }
        {
            f32x4 acc = (f32x4){0.f, 0.f, 0.f, 0.f};
#pragma unroll
            for (int ks = 0; ks < 2; ++ks) acc = MFMA16(ld8(Wt + (mt * 16 + l15) * 80 + ks * 32 + g * 8), ld8(STc + (nt * 16 + l15) * 80 + ks * 32 + g * 8), acc);
            float vn[4], vn2[4];
#pragma unroll
            for (int j = 0; j < 4; ++j) { vn[j] = ucur[j] - acc[j]; vn2[j] = vn[j] * __expf(gl - gc[mt * 16 + g * 4 + j]); }
            U2 o; o.x = pack2(vn[0], vn[1]); o.y = pack2(vn[2], vn[3]); *(U2*)(VNT + (nt * 16 + l15) * 80 + mt * 16 + g * 4) = o;
            U2 o2; o2.x = pack2(vn2[0], vn2[1]); o2.y = pack2(vn2[2], vn2[3]); *(U2*)(VNT2 + (nt * 16 + l15) * 80 + mt * 16 + g * 4) = o2;
        }
        __syncthreads();
        {
            f32x4 a1 = (f32x4){0.f, 0.f, 0.f, 0.f}, a2 = (f32x4){0.f, 0.f, 0.f, 0.f};
#pragma unroll
            for (int ks = 0; ks < 2; ++ks) { a1 = MFMA16(ld8(Qt + (mt * 16 + l15) * 80 + ks * 32 + g * 8), ld8(STc + (nt * 16 + l15) * 80 + ks * 32 + g * 8), a1);
                a2 = MFMA16(ld8(ATT + (mt * 16 + l15) * 80 + ks * 32 + g * 8), ld8(VNT + (nt * 16 + l15) * 80 + ks * 32 + g * 8), a2); }
            int b, h, dir, base, T, c; gdn_decode(chain, n, b, h, dir, base, T, c);
            bf16_t* O = WSP(bf16_t, dir ? OFF_OB : OFF_OF);
#pragma unroll
            for (int j = 0; j < 4; ++j) { const int i = mt * 16 + g * 4 + j; const long tok = base + gdn_pos(dir, T, c, i);
                O[tok * MW + h * 64 + half * 32 + nt * 16 + l15] = f2bf(__expf(gc[i]) * a1[j] + a2[j]); }
        }
        {
            f32x4 acc = sacc * __expf(gl);
#pragma unroll
            for (int ks = 0; ks < 2; ++ks) acc = MFMA16(ld8(KT + (mt * 16 + l15) * 80 + ks * 32 + g * 8), ld8(VNT2 + (nt * 16 + l15) * 80 + ks * 32 + g * 8), acc);
            sacc = acc;
            U2 o; o.x = pack2(acc[0], acc[1]); o.y = pack2(acc[2], acc[3]); *(U2*)(STn + (nt * 16 + l15) * 80 + mt * 16 + g * 4) = o;
        }
        if (n + 1 < NCH) { store_chunk(st ^ 1);
#pragma unroll
            for (int j = 0; j < 4; ++j) ucur[j] = unext[j]; }
        __syncthreads();
    }
    }
}
__device__ __forceinline__ int hy_phys(int p) { return p + ((p >> 6) << 2); }
constexpr int HY_X = 0, HY_T1 = (int)HY_XN * 8, HY_T2 = HY_T1 + 128 * 8, HY_W3 = HY_T2 + 128 * 8, HY_RED = HY_W3 + 2 * 64 * 4, HY_TOTAL = HY_RED + 64 * 4;
static_assert(HY_TOTAL <= 160 * 1024 - 64, "hyena lds");
#ifdef CPU_EMU
__device__ __forceinline__ F2 cmul(F2 a, F2 b) { return (F2){a.x * b.x - a.y * b.y, a.x * b.y + a.y * b.x}; }
__device__ __forceinline__ F2 cmulc(F2 a, F2 b) { return (F2){a.x * b.x + a.y * b.y, a.y * b.x - a.x * b.y}; }
__device__ __forceinline__ F2 add_mi(F2 a, F2 d) { return (F2){a.x + d.y, a.y - d.x}; }
__device__ __forceinline__ F2 sub_mi(F2 a, F2 d) { return (F2){a.x - d.y, a.y + d.x}; }
#else
__device__ __forceinline__ F2 cmul(F2 a, F2 b) { F2 t, r;
    asm("v_pk_mul_f32 %0, %1, %2 op_sel:[1,1] op_sel_hi:[1,0] neg_lo:[0,1]" : "=v"(t) : "v"(a), "v"(b));
    asm("v_pk_fma_f32 %0, %1, %2, %3 op_sel_hi:[0,1,1]" : "=v"(r) : "v"(a), "v"(b), "v"(t));
    return r; }
__device__ __forceinline__ F2 cmulc(F2 a, F2 b) { F2 t, r;
    asm("v_pk_mul_f32 %0, %1, %2 op_sel:[1,1] op_sel_hi:[1,0]" : "=v"(t) : "v"(a), "v"(b));
    asm("v_pk_fma_f32 %0, %1, %2, %3 op_sel_hi:[0,1,1] neg_hi:[0,1,0]" : "=v"(r) : "v"(a), "v"(b), "v"(t));
    return r; }
__device__ __forceinline__ F2 add_mi(F2 a, F2 d) { F2 r; asm("v_pk_add_f32 %0, %1, %2 op_sel:[0,1] op_sel_hi:[1,0] neg_hi:[0,1]" : "=v"(r) : "v"(a), "v"(d)); return r; }
__device__ __forceinline__ F2 sub_mi(F2 a, F2 d) { F2 r; asm("v_pk_add_f32 %0, %1, %2 op_sel:[0,1] op_sel_hi:[1,0] neg_lo:[0,1]" : "=v"(r) : "v"(a), "v"(d)); return r; }
#endif
__device__ __forceinline__ F2 twid(const F2* T1, const F2* T2, int q) { return cmul(T1[q >> 7], T2[q & 127]); }

constexpr int ilog2c(int n) { return n <= 1 ? 0 : 1 + ilog2c(n >> 1); }
__device__ __forceinline__ void bf4_fwd(F2& x0, F2& x1, F2& x2, F2& x3, F2 w1, F2 w2) {
    const F2 a0 = x0 + x2, a2 = cmul(x0 - x2, w1), a1 = x1 + x3, d = cmul(x1 - x3, w1);
    x0 = a0 + a1; x1 = cmul(a0 - a1, w2); x2 = add_mi(a2, d); x3 = cmul(sub_mi(a2, d), w2); }
__device__ __forceinline__ void bf4_inv(F2& y0, F2& y1, F2& y2, F2& y3, F2 w1, F2 w2) {
    F2 t = cmulc(y1, w2); const F2 a0 = y0 + t, a1 = y0 - t; t = cmulc(y3, w2); const F2 a2 = y2 + t, a3 = y2 - t;
    t = cmulc(a2, w1); y0 = a0 + t; y2 = a0 - t; const F2 u = cmulc(a3, w1); y1 = sub_mi(a1, u); y3 = add_mi(a1, u); }
#define W16_1 ((F2){0.9238795325112867f, -0.3826834323650898f})
#define W16_2 ((F2){0.7071067811865476f, -0.7071067811865476f})
#define W16_3 ((F2){0.3826834323650898f, -0.9238795325112867f})
struct LdsLd { const F2* X; __device__ __forceinline__ F2 operator()(int p) const { return X[p]; } };
struct LdsSt { F2* X; __device__ __forceinline__ void operator()(int p, F2 v) const { X[p] = v; } };
template <int N, int M, bool INV, class LD, class ST>
__device__ __forceinline__ void fft_r16(const F2* T1, const F2* T2, int tid, LD& ld, ST& st) {
    constexpr int q16 = M / 16, sh = N / M, NB = N / 16;
#pragma unroll
    for (int it_ = 0; it_ < (NB + NTH - 1) / NTH; ++it_) { const int idx = tid + it_ * NTH; if (NB % NTH != 0 && idx >= NB) break;
        const int blk = idx / q16, j = idx - blk * q16, p0 = blk * M + j, pp0 = hy_phys(p0);
        auto el = [&](int k) { if constexpr (q16 % 64 == 0) return pp0 + k * (q16 / 64 * 68); else if constexpr (M <= 64) return pp0 + k * q16; else return hy_phys(p0 + k * q16); };
        F2 e[16];
#pragma unroll
        for (int k = 0; k < 16; ++k) e[k] = ld(el(k));
        const F2 wa0 = twid(T1, T2, j * sh);
        const F2 wa1 = cmul(wa0, W16_1), wa2 = cmul(wa0, W16_2), wa3 = cmul(wa0, W16_3);
        const F2 wa0s = cmul(wa0, wa0); const F2 wb = cmul(wa0s, wa0s), wbs = cmul(wb, wb);
        if (!INV) {
            bf4_fwd(e[0], e[4], e[8], e[12], wa0, wa0s); bf4_fwd(e[1], e[5], e[9], e[13], wa1, cmul(wa1, wa1));
            bf4_fwd(e[2], e[6], e[10], e[14], wa2, cmul(wa2, wa2)); bf4_fwd(e[3], e[7], e[11], e[15], wa3, cmul(wa3, wa3));
#pragma unroll
            for (int c = 0; c < 4; ++c) bf4_fwd(e[4 * c], e[4 * c + 1], e[4 * c + 2], e[4 * c + 3], wb, wbs);
        } else {
#pragma unroll
            for (int c = 0; c < 4; ++c) bf4_inv(e[4 * c], e[4 * c + 1], e[4 * c + 2], e[4 * c + 3], wb, wbs);
            bf4_inv(e[0], e[4], e[8], e[12], wa0, wa0s); bf4_inv(e[1], e[5], e[9], e[13], wa1, cmul(wa1, wa1));
            bf4_inv(e[2], e[6], e[10], e[14], wa2, cmul(wa2, wa2)); bf4_inv(e[3], e[7], e[11], e[15], wa3, cmul(wa3, wa3));
        }
#pragma unroll
        for (int k = 0; k < 16; ++k) st(el(k), e[k]);
    }
    __syncthreads();
}
template <int N, int M, bool INV, class LD, class ST>
__device__ __forceinline__ void fft_r4(const F2* T1, const F2* T2, int tid, LD& ld, ST& st) {
    constexpr int q4 = M / 4, sh = N / M, NB = N / 4;
#pragma unroll 4
    for (int it_ = 0; it_ < (NB + NTH - 1) / NTH; ++it_) { const int idx = tid + it_ * NTH; if (NB % NTH != 0 && idx >= NB) break;
        const int blk = idx / q4, j = idx - blk * q4, p0 = blk * M + j, pp0 = hy_phys(p0);
        auto el = [&](int k) { if constexpr (q4 % 64 == 0) return pp0 + k * (q4 / 64 * 68); else if constexpr (M <= 64) return pp0 + k * q4; else return hy_phys(p0 + k * q4); };
        F2 x0 = ld(el(0)), x1 = ld(el(1)), x2 = ld(el(2)), x3 = ld(el(3));
        const F2 w1 = twid(T1, T2, j * sh), w2 = cmul(w1, w1);
        if (!INV) bf4_fwd(x0, x1, x2, x3, w1, w2); else bf4_inv(x0, x1, x2, x3, w1, w2);
        st(el(0), x0); st(el(1), x1); st(el(2), x2); st(el(3), x3); }
    __syncthreads();
}
template <int N, class LD, class ST>
__device__ __forceinline__ void fft_r2(int tid, LD& ld, ST& st) {
#pragma unroll
    for (int it_ = 0; it_ < ((N >> 1) + NTH - 1) / NTH; ++it_) { const int idx = tid + it_ * NTH; if ((N >> 1) % NTH != 0 && idx >= (N >> 1)) break;
        const int pp = hy_phys(2 * idx); const F2 x0 = ld(pp), x1 = ld(pp + 1); st(pp, x0 + x1); st(pp + 1, x0 - x1); }
    __syncthreads();
}
template <int N, int M> struct FftFwd16 { template <class LD, class ST> static __device__ __forceinline__ void run(F2* X, const F2* T1, const F2* T2, int tid, LD& ld0, ST& stl) {
    LdsLd ldx{X}; LdsSt stx{X};
    if constexpr (M >= 16) {
        constexpr bool first = (M == N), last = (M / 16 <= 1);
        if constexpr (first && last) fft_r16<N, M, false>(T1, T2, tid, ld0, stl); else if constexpr (first) fft_r16<N, M, false>(T1, T2, tid, ld0, stx);
        else if constexpr (last) fft_r16<N, M, false>(T1, T2, tid, ldx, stl); else fft_r16<N, M, false>(T1, T2, tid, ldx, stx);
        if constexpr (!last) FftFwd16<N, M / 16>::run(X, T1, T2, tid, ld0, stl); }
    else if constexpr (M == 8) { fft_r4<N, 8, false>(T1, T2, tid, ldx, stx); fft_r2<N>(tid, ldx, stl); }
    else if constexpr (M == 4) { fft_r4<N, 4, false>(T1, T2, tid, ldx, stl); }
    else if constexpr (M == 2) { fft_r2<N>(tid, ldx, stl); } } };
template <int N, int M> struct FftInv16 { template <class LD, class ST> static __device__ __forceinline__ void run(F2* X, const F2* T1, const F2* T2, int tid, LD& ld0, ST& stl) {
    LdsLd ldx{X}; LdsSt stx{X};
    if constexpr (M >= 16) {
        constexpr bool last = (M == N), first = (M / 16 <= 1);
        if constexpr (!first) FftInv16<N, M / 16>::run(X, T1, T2, tid, ld0, stl);
        if constexpr (first && last) fft_r16<N, M, true>(T1, T2, tid, ld0, stl); else if constexpr (first) fft_r16<N, M, true>(T1, T2, tid, ld0, stx);
        else if constexpr (last) fft_r16<N, M, true>(T1, T2, tid, ldx, stl); else fft_r16<N, M, true>(T1, T2, tid, ldx, stx); }
    else if constexpr (M == 8) { fft_r2<N>(tid, ld0, stx); fft_r4<N, 8, true>(T1, T2, tid, ldx, stx); }
    else if constexpr (M == 4) { fft_r4<N, 4, true>(T1, T2, tid, ld0, stx); }
    else if constexpr (M == 2) { fft_r2<N>(tid, ld0, stx); } } };
template <int N, class LD, class ST> __device__ __forceinline__ void fft_fwd(F2* X, const F2* T1, const F2* T2, int tid, LD& ld0, ST& stl) { static_assert(N >= 32, "fft"); FftFwd16<N, N>::run(X, T1, T2, tid, ld0, stl); }
template <int N, class LD, class ST> __device__ __forceinline__ void fft_inv(F2* X, const F2* T1, const F2* T2, int tid, LD& ld0, ST& stl) { FftInv16<N, N>::run(X, T1, T2, tid, ld0, stl); }

template <bool ctxs>
__device__ __forceinline__ void hyena_item(const Params& p, char* lds, int l, int ch) {
    const int tid = TID(), bid = BID(), lane = tid & 63, wid = tid >> 6;
    constexpr int L = ctxs ? CTX : SEQ, N = 2 * L, k0 = ctxs ? SEQ : 0;
    F2* X = (F2*)(lds + HY_X); F2* T1 = (F2*)(lds + HY_T1); F2* T2 = (F2*)(lds + HY_T2); float* red = (float*)(lds + HY_RED);
    const bf16_t* HYT = WSP(bf16_t, OFF_HYT);
    F2* HF = WSP(F2, OFF_HF) + (long)bid * HY_XN; float* ZT = WSP(float, OFF_ZT) + (long)bid * 2 * SEQ; bf16_t* YAT = WSP(bf16_t, OFF_YAT);
    __syncthreads();
    if (tid < 128) { float s, c; float a = -6.283185307179586f * (float)(tid * 128) / (float)N; s = sinf(a); c = cosf(a); T1[tid] = (F2){c, s}; }
    else if (tid < 256) { int b_ = tid - 128; float s, c; float a = -6.283185307179586f * (float)b_ / (float)N; s = sinf(a); c = cosf(a); T2[b_] = (F2){c, s}; }
    __syncthreads();
    F4 cw[3];
#pragma unroll
    for (int sg = 0; sg < 3; ++sg) { const float* w = GIN(p.hy_conv) + ((long)l * 3 * MW + sg * MW + ch) * 3; cw[sg] = (F4){w[0], w[1], w[2], 0.f}; }
    auto conv8 = [&](int seg, int b, int t0, float (&o8)[8]) { const bf16_t* r = HYT + ((long)b * 3 * MW + seg * MW + ch) * KEYS + k0 + t0;
        const U4 c = *(const U4*)r; const float vm = t0 > 0 ? bf2f(r[-1]) : 0.f, vp = t0 + 8 < L ? bf2f(r[8]) : 0.f;
        const float v[10] = {vm, bflo(c.x), bfhi(c.x), bflo(c.y), bfhi(c.y), bflo(c.z), bfhi(c.z), bflo(c.w), bfhi(c.w), vp};
        const F4 w = seg == 0 ? cw[0] : (seg == 1 ? cw[1] : cw[2]);
#pragma unroll
        for (int j = 0; j < 8; ++j) o8[j] = v[j + 1] * w.y + v[j] * w.x + v[j + 2] * w.z; };
    constexpr int L8 = L / 8, NIT8 = (L8 + NTH - 1) / NTH;
    for (int o = 0; o < 2; ++o) {
        const bf16_t* tf = WSP(bf16_t, OFF_TAPS) + (long)(o * HYW + ch) * KEYS + k0; const bf16_t* tb = WSP(bf16_t, OFF_TAPS) + (long)(2 * HYW + o * HYW + ch) * KEYS + k0;
        const float sk = GIN(p.hy_skip)[((long)l * 2 + o) * HYW + ch];
        float nrm = 0.f;
#pragma unroll
        for (int it_ = 0; it_ < NIT8; ++it_) { const int i8 = tid + it_ * NTH; if (L8 % NTH != 0 && i8 >= L8) break; const int t0 = i8 * 8;
            const U4 fa = *(const U4*)(tf + t0), fb = *(const U4*)(tb + t0);
            const float af[8] = {bflo(fa.x), bfhi(fa.x), bflo(fa.y), bfhi(fa.y), bflo(fa.z), bfhi(fa.z), bflo(fa.w), bfhi(fa.w)};
            const float ab[8] = {bflo(fb.x), bfhi(fb.x), bflo(fb.y), bfhi(fb.y), bflo(fb.z), bfhi(fb.z), bflo(fb.w), bfhi(fb.w)};
#pragma unroll
            for (int j = 0; j < 4; ++j) *(F4*)(X + hy_phys(t0) + 2 * j) = (F4){af[2 * j], 0.f, af[2 * j + 1], 0.f};
#pragma unroll
            for (int j = 0; j < 8; ++j) { nrm += fabsf(af[j]);
                if (j == 0 && t0 == 0) X[hy_phys(L)] = (F2){0.f, 0.f}; else { X[hy_phys(N - t0 - j)] = (F2){ab[j], 0.f}; nrm += fabsf(ab[j]); } } }
        nrm = wave_sum(nrm);
        if (lane == 0) red[wid] = nrm;
        __syncthreads();
        auto st_hf = [&](int pp, F2 v) { HF[pp] = v; };
        { LdsLd ldx0{X}; fft_fwd<N>(X, T1, T2, tid, ldx0, st_hf); }
        auto zval8 = [&](int t0, float (&z0)[8], float (&z1)[8]) {
            if (o == 0) { conv8(0, 0, t0, z0); conv8(0, 1, t0, z1); }
            else { const F4 a0 = *(const F4*)(ZT + t0), a1 = *(const F4*)(ZT + t0 + 4), b0 = *(const F4*)(ZT + SEQ + t0), b1 = *(const F4*)(ZT + SEQ + t0 + 4);
                z0[0] = a0.x; z0[1] = a0.y; z0[2] = a0.z; z0[3] = a0.w; z0[4] = a1.x; z0[5] = a1.y; z0[6] = a1.z; z0[7] = a1.w;
                z1[0] = b0.x; z1[1] = b0.y; z1[2] = b0.z; z1[3] = b0.w; z1[4] = b1.x; z1[5] = b1.y; z1[6] = b1.z; z1[7] = b1.w; } };
        LdsSt stx{X}; LdsLd ldx{X};
#pragma unroll
        for (int it_ = 0; it_ < NIT8; ++it_) { const int i8 = tid + it_ * NTH; if (L8 % NTH != 0 && i8 >= L8) break; const int t0 = i8 * 8;
            float z0[8], z1[8]; zval8(t0, z0, z1);
#pragma unroll
            for (int j = 0; j < 4; ++j) { *(F4*)(X + hy_phys(t0) + 2 * j) = (F4){z0[2 * j], z1[2 * j], z0[2 * j + 1], z1[2 * j + 1]}; *(F4*)(X + hy_phys(L + t0) + 2 * j) = (F4){0.f, 0.f, 0.f, 0.f}; } }
        __syncthreads();
        fft_fwd<N>(X, T1, T2, tid, ldx, stx);
        float tot = 0.f;
#pragma unroll
        for (int w = 0; w < 8; ++w) tot += red[w];
        const float sc = 1.0f / (tot * (float)N);
        auto ld_mul = [&](int pp) -> F2 { return cmul(X[pp], HF[pp]); };
        fft_inv<N>(X, T1, T2, tid, ld_mul, stx);
#pragma unroll
        for (int it_ = 0; it_ < NIT8; ++it_) { const int i8 = tid + it_ * NTH; if (L8 % NTH != 0 && i8 >= L8) break; const int t0 = i8 * 8;
            float z0[8], z1[8], g0[8], g1[8], r0[8], r1[8]; zval8(t0, z0, z1); conv8(1 + o, 0, t0, g0); conv8(1 + o, 1, t0, g1);
#pragma unroll
            for (int j = 0; j < 4; ++j) { const F4 y = *(const F4*)(X + hy_phys(t0) + 2 * j);
                r0[2 * j] = g0[2 * j] * (y.x * sc + z0[2 * j] * sk); r1[2 * j] = g1[2 * j] * (y.y * sc + z1[2 * j] * sk);
                r0[2 * j + 1] = g0[2 * j + 1] * (y.z * sc + z0[2 * j + 1] * sk); r1[2 * j + 1] = g1[2 * j + 1] * (y.w * sc + z1[2 * j + 1] * sk); }
            if (o == 0) { *(F4*)(ZT + t0) = (F4){r0[0], r0[1], r0[2], r0[3]}; *(F4*)(ZT + t0 + 4) = (F4){r0[4], r0[5], r0[6], r0[7]};
                *(F4*)(ZT + SEQ + t0) = (F4){r1[0], r1[1], r1[2], r1[3]}; *(F4*)(ZT + SEQ + t0 + 4) = (F4){r1[4], r1[5], r1[6], r1[7]}; }
            else { *(U4*)(YAT + ((long)0 * MW + ch) * KEYS + k0 + t0) = (U4){pack2(r0[0], r0[1]), pack2(r0[2], r0[3]), pack2(r0[4], r0[5]), pack2(r0[6], r0[7])};
                *(U4*)(YAT + ((long)1 * MW + ch) * KEYS + k0 + t0) = (U4){pack2(r1[0], r1[1]), pack2(r1[2], r1[3]), pack2(r1[4], r1[5]), pack2(r1[6], r1[7])}; } }
        __syncthreads();
    }
}

__device__ __forceinline__ void phase_gdn_prep(const Params& p, char* lds, int l) {
    const int bid = BID(), G = gridDim.x;
    for (int rep_ = 0; rep_ < REP_GP; ++rep_) for (int it = bid; it < NTASK_GDN / 2; it += G) gdn_chunk_prep2(p, lds, l, it * 2);
}
__device__ __forceinline__ void phase_mixers(const Params& p, char* lds, int l, int qoff = 0, bool scans_only = false) {
    const int tid = TID();
    const bool ctx_out = l < DEPTH - 1;
    constexpr int NSCAN = BATCH * GH * 2 * 2, NQT_L = SEQ / 256, U_DL = BATCH * DH * NQT_L * 2, U_HY = MW, U_NA = BATCH * NH * (R_ROWS / 4);
    constexpr int NQC = CTX / 128, U_DC = BATCH * DH * NQC, U_NC = BATCH * NH * NQC, U_HC = MW;
    constexpr int U_CV8 = (U_CVT + 7) / 8, U_W3 = (4 * HYW * 128 + 8191) / 8192, U_H2 = (KEYS + 63) / 64;
    const int e0 = NSCAN * REP_GS, e1 = e0 + U_DL * REP_DIFF, e2 = e1 + U_HY * REP_HY, e3 = e2 + U_NA * REP_NA, e4 = e3 + (ctx_out ? U_DC : 0), e5 = e4 + (ctx_out ? U_NC : 0), e6 = e5 + (ctx_out ? U_HC : 0), e7 = e6 + (ctx_out ? U_CV8 : 0), e8 = e7 + (ctx_out ? U_W3 : 0), e9 = e8 + (ctx_out ? U_H2 : 0);
    u32* qctr = WSP(u32, OFF_CNT) + 64 + qoff + l;
    int* qs = (int*)(lds + LDS_BYTES - 16);
    for (;;) {
        __syncthreads();
        if (tid == 0) qs[0] = (int)atomicAdd(qctr, 1u);
        __syncthreads();
        const int u = qs[0];
        if (u >= (scans_only ? e0 : e9)) break;
        if (u < e0) gdn_scan_item(p, lds, l, u % NSCAN);
        else if (u < e1) { int v = (u - e0) % U_DL; const int comp = v & 1; v >>= 1; int b = v / (DH * NQT_L), r = v - b * DH * NQT_L, h = r / NQT_L, qt = r - h * NQT_L; diff32_item(p, lds, l, b, h, qt * 256, comp); }
        else if (u < e2) hyena_item<false>(p, lds, l, (u - e1) % U_HY);
        else if (u < e3) { int v = (u - e2) % U_NA; int b = v / (NH * (R_ROWS / 4)), r = v - b * NH * (R_ROWS / 4), h = r / (R_ROWS / 4), rq = r - h * (R_ROWS / 4); na32_item(p, lds, l, b, h, rq); }
        else if (u < e4) { int v = u - e3; int b = v / (DH * NQC), r = v - b * DH * NQC, h = r / NQC, q = r - h * NQC; diff_attn_item<1>(p, lds, l, b, h, q * 128, true); }
        else if (u < e5) { int v = u - e4; int b = v / (NH * NQC), r = v - b * NH * NQC, h = r / NQC, q = r - h * NQC; na_ctx_item(p, lds, b, h, q * 128); }
        else if (u < e6) hyena_item<true>(p, lds, l, u - e5);
        else if (u < e7) { const int c0 = (u - e6) * 8; for (int q = c0; q < c0 + 8 && q < U_CVT; ++q) cvt_unit(p, lds, l + 1, q); }
        else if (u < e8) w3t_chunk(p, l + 1, (u - e7) * 8192, 8192);
        else h2f_positions(p, l + 1, (u - e8) * 64, 8);
    }
}

__device__ __forceinline__ void phase_finish(const Params& p, char* lds, int l) {
    const int tid = TID(), bid = BID(), G = gridDim.x, lane = tid & 63, wid = tid >> 6;
    bf16_t* Y = WSP(bf16_t, OFF_Y);
    { const bf16_t* OFp = WSP(bf16_t, OFF_OF); const bf16_t* OBp = WSP(bf16_t, OFF_OB); const bf16_t* GZ = WSP(bf16_t, OFF_GZ); const float nw = GIN(p.gdn_norm)[l * 64 + lane];
        const long NR = (long)NTOK * GH, st8 = (long)G * 8;
        for (long i = (long)bid * 8 + wid; i < NR; i += 2 * st8) { const long i2 = i + st8; const bool two = i2 < NR;
            const long tokA = i / GH, tokB = two ? i2 / GH : tokA; const int hA = (int)(i - tokA * GH), hB = two ? (int)(i2 - tokB * GH) : hA;
            const long oA = tokA * MW + hA * 64 + lane, oB = tokB * MW + hB * 64 + lane;
            const float vA = bf2f(OFp[oA]) + bf2f(OBp[oA]), vB = bf2f(OFp[oB]) + bf2f(OBp[oB]);
            const float zA = bf2f(GZ[oA]), zB = bf2f(GZ[oB]);
            float sA = vA * vA, sB = vB * vB;
            sA = xadd<32>(sA); sB = xadd<32>(sB); sA = xadd<16>(sA); sB = xadd<16>(sB); sA = xadd<8>(sA); sB = xadd<8>(sB); sA = xadd<4>(sA); sB = xadd<4>(sB); sA = xadd<2>(sA); sB = xadd<2>(sB); sA = xadd<1>(sA); sB = xadd<1>(sB);
            Y[tokA * 4 * MW + MW + hA * 64 + lane] = f2bf(vA * rsqrtf(sA * (1.0f / 64.0f) + RMS_EPS) * nw * siluf(zA));
            if (two) Y[tokB * 4 * MW + MW + hB * 64 + lane] = f2bf(vB * rsqrtf(sB * (1.0f / 64.0f) + RMS_EPS) * nw * siluf(zB)); } }
    { const bf16_t* YAT = WSP(bf16_t, OFF_YAT); bf16_t* t = (bf16_t*)lds;
        constexpr int KT_ = KEYS / 64, CT_ = MW / 128;
        float lam, lam_init; diff_lambda(p, l, lam, lam_init);
        const float* nw = GIN(p.diff_norm) + l * 128;
        for (int u = bid; u < BATCH * CT_ * KT_; u += G) { int b = u / (CT_ * KT_), r = u - b * CT_ * KT_, ct = r / KT_, kt = r - ct * KT_;
            __syncthreads();
#pragma unroll
            for (int q = 0; q < 2; ++q) { int c = (tid >> 3) + 64 * q, s = tid & 7; *(U4*)(t + c * 72 + s * 8) = *(const U4*)(YAT + ((long)b * MW + ct * 128 + c) * KEYS + kt * 64 + s * 8); }
            if (kt * 64 < SEQ) {
                const int k = tid >> 3, sub = tid & 7; const long tok = bk_tok(b, kt * 64 + k); bf16_t* yr = Y + tok * 4 * MW;
                const U4 a0 = *(const U4*)(yr + 2 * MW + ct * 128 + sub * 16), a1 = *(const U4*)(yr + 2 * MW + ct * 128 + sub * 16 + 8), b0 = *(const U4*)(yr + ct * 128 + sub * 16), b1 = *(const U4*)(yr + ct * 128 + sub * 16 + 8);
                const u32 aw[8] = {a0.x, a0.y, a0.z, a0.w, a1.x, a1.y, a1.z, a1.w}, bw[8] = {b0.x, b0.y, b0.z, b0.w, b1.x, b1.y, b1.z, b1.w};
                float v[16]; float ss = 0.f;
#pragma unroll
                for (int e = 0; e < 8; ++e) { v[2 * e] = bflo(aw[e]) - lam * bflo(bw[e]); v[2 * e + 1] = bfhi(aw[e]) - lam * bfhi(bw[e]); ss += v[2 * e] * v[2 * e] + v[2 * e + 1] * v[2 * e + 1]; }
                ss = xadd<1>(ss); ss = xadd<2>(ss); ss = xadd<4>(ss);
                const float rr = rsqrtf(ss * (1.0f / 128.0f) + RMS_EPS) * (1.0f - lam_init);
                u32 o[8];
#pragma unroll
                for (int e = 0; e < 8; ++e) o[e] = pack2(v[2 * e] * rr * nw[sub * 16 + 2 * e], v[2 * e + 1] * rr * nw[sub * 16 + 2 * e + 1]);
                *(U4*)(yr + 2 * MW + ct * 128 + sub * 16) = (U4){o[0], o[1], o[2], o[3]}; *(U4*)(yr + 2 * MW + ct * 128 + sub * 16 + 8) = (U4){o[4], o[5], o[6], o[7]};
            }
            __syncthreads();
            { int k = tid >> 3; long tok = bk_tok(b, kt * 64 + k);
#pragma unroll
                for (int q = 0; q < 2; ++q) { const int c8 = (tid & 7) * 8 + 64 * q;
                    U4 o; o.x = (u32)t[(c8 + 0) * 72 + k] | ((u32)t[(c8 + 1) * 72 + k] << 16); o.y = (u32)t[(c8 + 2) * 72 + k] | ((u32)t[(c8 + 3) * 72 + k] << 16);
                    o.z = (u32)t[(c8 + 4) * 72 + k] | ((u32)t[(c8 + 5) * 72 + k] << 16); o.w = (u32)t[(c8 + 6) * 72 + k] | ((u32)t[(c8 + 7) * 72 + k] << 16);
                    *(U4*)(Y + tok * 4 * MW + ct * 128 + c8) = o; } } } }
}
__device__ __forceinline__ bool xcd_unit(int bid, int G, int i, int ntm, int ntn, int& tm, int& tn) {
    if ((G & 7) == 0) { const int x = bid & 7, v = i * (G >> 3) + (bid >> 3); tm = (v / ntn) * 8 + x; tn = v - (v / ntn) * ntn; return tm < ntm; }
    const int u = bid + i * G; tn = u / ntm; tm = u - tn * ntm; return u < ntm * ntn;
}
struct Merge1Prov {
    static constexpr int MT = 3, BM1 = 64 * MT, ntm = NTOK / BM1, ntn = D / G_BN;
    const bf16_t *Y, *BP, *GATE; bf16_t* MIXG; int bid, G; U2 tot[MT][4];
    __device__ __forceinline__ void tile(int i, int& row0, int& col0, int& br) const { int tm, tn; xcd_unit(bid, G, i >> 2, ntm, ntn, tm, tn); br = i & 3; row0 = tm * BM1; col0 = tn * G_BN; }
    __device__ __forceinline__ bool valid(int i) const { int tm, tn; return xcd_unit(bid, G, i >> 2, ntm, ntn, tm, tn); }
    __device__ __forceinline__ const bf16_t* arow(int i, int r) const { int row0, col0, br; tile(i, row0, col0, br); return Y + (long)(row0 + r) * 4 * MW + br * MW; }
    __device__ __forceinline__ const bf16_t* bbase(int i) const { int row0, col0, br; tile(i, row0, col0, br); return BP + (long)col0 * 4 * MW + br * MW; }
    U2 gpre[MT][4];
    __device__ __forceinline__ void pre(int i) { int row0, col0, br; tile(i, row0, col0, br);
        const int tid = TID(), wid = tid >> 6, lane = tid & 63, wm = wid >> 1, wn = wid & 1, l15 = lane & 15, g = lane >> 4;
#pragma unroll
        for (int m = 0; m < MT; ++m)
#pragma unroll
            for (int n = 0; n < 4; ++n) gpre[m][n] = *(const U2*)(GATE + ((((long)((row0 / BM1) * ntn + col0 / G_BN) * 4 + br) * 8 + wid) * 12 + (m * 4 + n)) * 256 + lane * 4);
        (void)wm; (void)wn; (void)l15; (void)g; }
    __device__ __forceinline__ void epi(int i, const f32x4 (&acc)[MT][4]) { int row0, col0, br; tile(i, row0, col0, br);
        const int tid = TID(), wid = tid >> 6, lane = tid & 63, wm = wid >> 1, wn = wid & 1, l15 = lane & 15, g = lane >> 4;
#pragma unroll
        for (int m = 0; m < MT; ++m) { const long row = row0 + wm * 16 * MT + m * 16 + l15;
#pragma unroll
            for (int n = 0; n < 4; ++n) { const U2 gv = gpre[m][n];
                const U2 tp = tot[m][n];
                f32x4 t = br == 0 ? (f32x4){0.f, 0.f, 0.f, 0.f} : (f32x4){bflo(tp.x), bfhi(tp.x), bflo(tp.y), bfhi(tp.y)};
                t[0] += sigmoidf(bflo(gv.x)) * acc[m][n][0]; t[1] += sigmoidf(bfhi(gv.x)) * acc[m][n][1]; t[2] += sigmoidf(bflo(gv.y)) * acc[m][n][2]; t[3] += sigmoidf(bfhi(gv.y)) * acc[m][n][3];
                const U2 o = (U2){pack2(t[0], t[1]), pack2(t[2], t[3])};
                tot[m][n] = o;
                if (br == 3) *(U2*)(MIXG + row * D + col0 + wn * 64 + n * 16 + g * 4) = o; } } }
};
#ifdef PROBE_G1
struct Merge1Dry : Merge1Prov { bool fire; __device__ __forceinline__ void epi(int i, const f32x4 (&acc)[MT][4]) { if (fire) Merge1Prov::epi(i, acc); }
#ifdef PROBE_G1NP
    __device__ __forceinline__ void pre(int i) { if (fire) Merge1Prov::pre(i); }
#endif
};
#endif
__device__ __forceinline__ void phase_merge1(const Params& p, char* lds, int l) {
    Merge1Prov pv; pv.Y = WSP(bf16_t, OFF_Y); pv.BP = WSP(bf16_t, off_bp(l)); pv.GATE = WSP(bf16_t, OFF_SEG_GATE); pv.MIXG = WSP(bf16_t, OFF_MIXG);
    pv.bid = BID(); pv.G = (int)gridDim.x;
    gemm_stream<Merge1Prov::MT>(lds, pv, 4 * MW, MW);
#ifdef PROBE_G1
    { Merge1Dry pd; pd.Y = pv.Y; pd.BP = pv.BP; pd.GATE = pv.GATE; pd.MIXG = pv.MIXG; pd.bid = pv.bid; pd.G = pv.G; pd.fire = p.stop_phase == 123456;
      for (int r_ = 0; r_ < 2; ++r_) gemm_stream<Merge1Prov::MT, Merge1Dry, PROBE_G1>(lds, pd, 4 * MW, MW); }
#endif
}
struct Merge2Prov {
    static constexpr int MT = 3, BM1 = 64 * MT, ntm = NTOK / BM1, ntn = D / G_BN;
    const bf16_t *MIXG, *WO; bf16_t* MIX; int bid, G;
    __device__ __forceinline__ void pre(int) const {}
    __device__ __forceinline__ void tile(int i, int& row0, int& col0) const { int tm, tn; xcd_unit(bid, G, i, ntm, ntn, tm, tn); row0 = tm * BM1; col0 = tn * G_BN; }
    __device__ __forceinline__ bool valid(int i) const { int tm, tn; return xcd_unit(bid, G, i, ntm, ntn, tm, tn); }
    __device__ __forceinline__ const bf16_t* arow(int i, int r) const { int row0, col0; tile(i, row0, col0); return MIXG + (long)(row0 + r) * D; }
    __device__ __forceinline__ const bf16_t* bbase(int i) const { int row0, col0; tile(i, row0, col0); return WO + (long)col0 * D; }
    __device__ __forceinline__ void epi(int i, const f32x4 (&acc)[MT][4]) const { int row0, col0; tile(i, row0, col0);
        const int tid = TID(), wid = tid >> 6, lane = tid & 63, wm = wid >> 1, wn = wid & 1, l15 = lane & 15, g = lane >> 4;
#pragma unroll
        for (int m = 0; m < MT; ++m) { const long row = row0 + wm * 16 * MT + m * 16 + l15;
#pragma unroll
            for (int n = 0; n < 4; ++n) st4bf(MIX + row * D + col0 + wn * 64 + n * 16 + g * 4, acc[m][n]); } }
};
#ifdef PROBE_G2
struct Merge2Dry : Merge2Prov { bool fire; __device__ __forceinline__ void epi(int i, const f32x4 (&acc)[MT][4]) const { if (fire) Merge2Prov::epi(i, acc); } };
#endif
__device__ __forceinline__ void phase_merge2(const Params& p, char* lds, int l) {
    Merge2Prov pv; pv.MIXG = WSP(bf16_t, OFF_MIXG); pv.WO = WSP(bf16_t, off_wo(l)); pv.MIX = WSP(bf16_t, OFF_MIX);
    pv.bid = BID(); pv.G = (int)gridDim.x;
    gemm_stream<Merge2Prov::MT>(lds, pv, D, D);
#ifdef PROBE_G2
    { Merge2Dry pd; pd.MIXG = pv.MIXG; pd.WO = pv.WO; pd.MIX = pv.MIX; pd.bid = pv.bid; pd.G = pv.G; pd.fire = p.stop_phase == 123456;
#ifdef PROBE_G2H
      for (int r_ = 0; r_ < 8; ++r_) gemm_stream<Merge2Prov::MT, Merge2Dry, PROBE_G2>(lds, pd, D, D / 2); }
#else
      for (int r_ = 0; r_ < 4; ++r_) gemm_stream<Merge2Prov::MT, Merge2Dry, PROBE_G2>(lds, pd, D, D); }
#endif
#endif
}
struct MoeMap { int cnt[NE], off[NE], tile0[NE + 1]; };
__device__ __forceinline__ void moe_map_load(const Params& p, int* sm  ) {
    const int tid = TID();
    __syncthreads();
    if (tid == 0) { const u32* CNT = WSP(u32, OFF_CNT); int o = 0, t = 0;
        for (int e = 0; e < NE; ++e) { int c = (int)CNT[e]; sm[e] = c; sm[NE + e] = o; sm[2 * NE + e] = t; o += c; t += (c + G_BM - 1) / G_BM; }
        sm[3 * NE] = t; }
    __syncthreads();
}
struct MoeProvBase {
    const int* sm; int bid, G, ntile, ntn;
    __device__ __forceinline__ void pre(int) const {}
    __device__ __forceinline__ bool valid(int i) const { int tg, tn; return xcd_unit(bid, G, i, ntile, ntn, tg, tn); }
    __device__ __forceinline__ void unit(int i, int& e, int& tn, int& r0, int& nrow, long& orow0) const { int tg; xcd_unit(bid, G, i, ntile, ntn, tg, tn);
        e = 0;
#pragma unroll
        for (int q = 1; q < NE; ++q) if (tg >= sm[2 * NE + q]) e = q;
        const int mt = tg - sm[2 * NE + e], cnt = sm[e]; r0 = mt * G_BM; nrow = cnt - r0 < G_BM ? cnt - r0 : G_BM; orow0 = (long)sm[NE + e] + r0; }
};
struct Moe1Prov : MoeProvBase {
    const bf16_t *H, *W13; bf16_t* HMID; const int* ELIST;
    __device__ __forceinline__ const bf16_t* arow(int i, int r) const { int e, tn, r0, nrow; long orow0; unit(i, e, tn, r0, nrow, orow0); const int rr = r < nrow ? r0 + r : r0; return H + (long)ELIST[(long)e * NTOK + rr] * D; }
    __device__ __forceinline__ const bf16_t* bbase(int i) const { int e, tn, r0, nrow; long orow0; unit(i, e, tn, r0, nrow, orow0); return W13 + ((long)e * 2 * EFF + tn * G_BN) * D; }
    __device__ __forceinline__ void epi(int i, const f32x4 (&acc)[4][4]) const { int e, tn, r0, nrow; long orow0; unit(i, e, tn, r0, nrow, orow0);
        const int tid = TID(), wid = tid >> 6, lane = tid & 63, wm = wid >> 1, wn = wid & 1, l15 = lane & 15, g = lane >> 4;
#pragma unroll
        for (int m = 0; m < 4; ++m) { const int r = wm * 64 + m * 16 + l15;
            if (r < nrow) {
#pragma unroll
                for (int n2 = 0; n2 < 2; ++n2) { f32x4 a = acc[m][2 * n2], b = acc[m][2 * n2 + 1], hmid;
#pragma unroll
                    for (int j = 0; j < 4; ++j) hmid[j] = siluf(a[j]) * b[j];
                    st4bf(HMID + (orow0 + r) * EFF + tn * (G_BN / 2) + wn * 32 + n2 * 16 + g * 4, hmid); } } } }
};
struct Moe2Prov : MoeProvBase {
    const bf16_t *HMID, *W2; bf16_t* YE;
    __device__ __forceinline__ const bf16_t* arow(int i, int r) const { int e, tn, r0, nrow; long orow0; unit(i, e, tn, r0, nrow, orow0); return HMID + (orow0 + r) * EFF; }
    __device__ __forceinline__ const bf16_t* bbase(int i) const { int e, tn, r0, nrow; long orow0; unit(i, e, tn, r0, nrow, orow0); return W2 + ((long)e * D + tn * G_BN) * EFF; }
    __device__ __forceinline__ void epi(int i, const f32x4 (&acc)[4][4]) const { int e, tn, r0, nrow; long orow0; unit(i, e, tn, r0, nrow, orow0);
        const int tid = TID(), wid = tid >> 6, lane = tid & 63, wm = wid >> 1, wn = wid & 1, l15 = lane & 15, g = lane >> 4;
#pragma unroll
        for (int m = 0; m < 4; ++m) { const int r = wm * 64 + m * 16 + l15;
            if (r < nrow) {
#pragma unroll
                for (int n = 0; n < 4; ++n) st4bf(YE + (orow0 + r) * D + tn * G_BN + wn * 64 + n * 16 + g * 4, acc[m][n]); } } }
};
#ifdef PROBE_M1
struct Moe1Dry : Moe1Prov { bool fire; __device__ __forceinline__ void epi(int i, const f32x4 (&acc)[4][4]) const { if (fire) Moe1Prov::epi(i, acc); } };
#endif
__device__ __forceinline__ void phase_moe1(const Params& p, char* lds, int l) {
    int* sm = (int*)(lds + G_LDS);
    moe_map_load(p, sm);
    Moe1Prov pv; pv.sm = sm; pv.bid = BID(); pv.G = (int)gridDim.x; pv.ntile = sm[3 * NE]; pv.ntn = 2 * EFF / G_BN;
    pv.H = WSP(bf16_t, OFF_H); pv.W13 = WSP(bf16_t, OFF_W13); pv.HMID = WSP(bf16_t, OFF_HMID); pv.ELIST = WSP(int, OFF_ELIST);
    gemm_stream<4>(lds, pv, D, D);
#ifdef PROBE_M1
    { Moe1Dry pd; pd.sm = pv.sm; pd.bid = pv.bid; pd.G = pv.G; pd.ntile = pv.ntile; pd.ntn = pv.ntn; pd.H = pv.H; pd.W13 = pv.W13; pd.HMID = pv.HMID; pd.ELIST = pv.ELIST; pd.fire = p.stop_phase == 123456;
      for (int r_ = 0; r_ < 2; ++r_) gemm_stream<4, Moe1Dry, PROBE_M1>(lds, pd, D, D); }
#endif
}
#ifdef PROBE_M2
struct Moe2Dry : Moe2Prov { bool fire; __device__ __forceinline__ void epi(int i, const f32x4 (&acc)[4][4]) const { if (fire) Moe2Prov::epi(i, acc); } };
#endif
__device__ __forceinline__ void phase_moe2(const Params& p, char* lds, int l) {
    int* sm = (int*)(lds + G_LDS);
    moe_map_load(p, sm);
    Moe2Prov pv; pv.sm = sm; pv.bid = BID(); pv.G = (int)gridDim.x; pv.ntile = sm[3 * NE]; pv.ntn = D / G_BN;
    pv.HMID = WSP(bf16_t, OFF_HMID); pv.W2 = WSP(bf16_t, OFF_W2); pv.YE = WSP(bf16_t, OFF_YE);
    gemm_stream<4>(lds, pv, EFF, EFF);
#ifdef PROBE_M2
    { Moe2Dry pd; pd.sm = pv.sm; pd.bid = pv.bid; pd.G = pv.G; pd.ntile = pv.ntile; pd.ntn = pv.ntn; pd.HMID = pv.HMID; pd.W2 = pv.W2; pd.YE = pv.YE; pd.fire = p.stop_phase == 123456;
      for (int r_ = 0; r_ < 2; ++r_) gemm_stream<4, Moe2Dry, PROBE_M2>(lds, pd, EFF, EFF); }
#endif
}
#ifdef PROBE_BAR
#define PHASE_END(id) do { GSYNC(); GSYNC(); if (p.stop_phase == (id)) return; } while (0)
#else
#define PHASE_END(id) do { GSYNC(); if (p.stop_phase == (id)) return; } while (0)
#endif

#if defined(CPU_EMU) || !defined(KARG_LAUNDER)
#define PP p_in
#else
__device__ __forceinline__ const Params& launder_params(const Params* q) { asm volatile("" : "+s"(q)); return *q; }
#define PP launder_params(kargs)
#endif
__global__ void __launch_bounds__(NTH, 2) fwd_kernel(Params p_in) {
#ifdef CPU_EMU
    char* lds = emu_lds();
    const Params& p = p_in;
#else
#ifdef KARG_LAUNDER
    const Params* kargs = (const Params*)__builtin_amdgcn_kernarg_segment_ptr();
    const Params& p = *kargs;
#else
    const Params& p = p_in;
#endif
    extern __shared__ __attribute__((aligned(16))) char lds_raw[];
    char* lds = lds_raw + 16;
    if (threadIdx.x == 0) *(uint4*)lds_raw = make_uint4(0u, 0u, 0u, 0u);
    __syncthreads();
    XcdBarrier xbar = xcd_barrier_post((unsigned*)(p.ws + OFF_BAR), (volatile LAS unsigned*)lds_raw);
#endif
#ifdef CPU_EMU
    if (threadIdx.x < 32) ((const float**)(lds + LDS_TBL_OFF))[threadIdx.x] = ((const float* const*)&p_in)[threadIdx.x];
#else
    if (threadIdx.x < 32) ((const float**)(lds + LDS_TBL_OFF))[threadIdx.x] = *(const float* const*)((const char*)__builtin_amdgcn_kernarg_segment_ptr() + threadIdx.x * 8);
#endif
    __syncthreads();
    phase_prologue(PP, lds);
    PHASE_END(1);
    for (int l = 0; l < DEPTH; ++l) {
        const int pb = 100 * (l + 1);
        if (l == 0) { phase_weights(PP, lds, l); PHASE_END(pb + 0); }
        if (l == 0) { phase_modulate0(PP, l); PHASE_END(pb + 1); }
        for (int rep_ = 0; rep_ < REP_IP; ++rep_) phase_inproj(PP, lds, l, 0);
        PHASE_END(pb + 2);
        phase_prep(PP, lds, l);
#ifdef PROBE_PREP
        phase_prep(PP, lds, l, false, PROBE_PREP & 1, PROBE_PREP & 2);
#endif
        PHASE_END(pb + 3);
        phase_gdn_prep(PP, lds, l);
        PHASE_END(pb + 4);
        phase_mixers(PP, lds, l);
#ifdef PROBE_P5
        GSYNC();
        phase_mixers(PP, lds, l, 16, PROBE_P5 == 2);
#endif
        PHASE_END(pb + 5);
        for (int rep_ = 0; rep_ < REP_FIN; ++rep_) phase_finish(PP, lds, l);
        PHASE_END(pb + 6);
        for (int rep_ = 0; rep_ < REP_IP; ++rep_) phase_inproj(PP, lds, l, 1);
        PHASE_END(pb + 7);
        for (int rep_ = 0; rep_ < REP_MG; ++rep_) phase_merge1(PP, lds, l);
        PHASE_END(pb + 8);
        for (int rep_ = 0; rep_ < REP_MG; ++rep_) phase_merge2(PP, lds, l);
        PHASE_END(pb + 9);
#ifdef PROBE_PM
        phase_post_mix(PP, lds, l, true);
#endif
        phase_post_mix(PP, lds, l);
        PHASE_END(pb + 10);
        for (int rep_ = 0; rep_ < REP_MOE; ++rep_) phase_moe1(PP, lds, l);
        PHASE_END(pb + 11);
        for (int rep_ = 0; rep_ < REP_MOE; ++rep_) phase_moe2(PP, lds, l);
        PHASE_END(pb + 12);
#ifdef PROBE_PE
        phase_post_moe(PP, l, true);
#endif
        phase_post_moe(PP, l);
        PHASE_END(pb + 13);
    }
}

extern "C" void kernel_launch(void* const* d_in, const int* in_sizes, int n_in, void* d_out, int out_size, void* d_ws, size_t ws_size, hipStream_t stream) {
    (void)in_sizes; (void)n_in; (void)out_size;
    if (ws_size < WS_NEED) return;
    Params p;
    memset(&p, 0, sizeof(p));
    const float** pp = (const float**)&p;
    for (int i = 0; i < 32; ++i) pp[i] = (const float*)d_in[i];
    p.out = (float*)d_out; p.ws = (char*)d_ws; p.stop_phase = -1;
#ifdef CPU_EMU
    { const char* sp = getenv("EMU_STOP"); if (sp) p.stop_phase = atoi(sp); }
    memset(d_ws, 0, SZ_BAR);
    int grid = 4; { const char* g = getenv("EMU_GRID"); if (g) grid = atoi(g); }
    emu_launch([](void* a) { fwd_kernel(*(Params*)a); }, &p, grid, NTH, LDS_BYTES);
#else
    static int grid = 0;
    if (!grid) {
        int dev = 0, cus = 0, per_cu = 0;
        (void)hipGetDevice(&dev);
        (void)hipDeviceGetAttribute(&cus, hipDeviceAttributeMultiprocessorCount, dev);
        (void)hipFuncSetAttribute((const void*)fwd_kernel, hipFuncAttributeMaxDynamicSharedMemorySize, LDS_BYTES + 16);
        (void)hipOccupancyMaxActiveBlocksPerMultiprocessor(&per_cu, (const void*)fwd_kernel, NTH, LDS_BYTES + 16);
        grid = per_cu >= 1 ? cus : 0;
        if (grid > GRID_MAX) grid = GRID_MAX;
    }
    if (!grid) return;
    (void)hipMemsetAsync(d_ws, 0, SZ_BAR, stream);
    hipLaunchKernelGGL(fwd_kernel, dim3(grid), dim3(NTH), LDS_BYTES + 16, stream, p);
#endif
}
```

```cpp
#ifdef CPU_EMU
#define SCHED_FENCE()
#define WAIT_LGKM()
#define WAIT_VM0()
#else
#include <hip/hip_runtime.h>
typedef short bf16x8 __attribute__((ext_vector_type(8)));
typedef float f32x4 __attribute__((ext_vector_type(4)));
#define SCHED_FENCE() __builtin_amdgcn_sched_barrier(0)
#define WAIT_LGKM() asm volatile("s_waitcnt lgkmcnt(0)" ::: "memory")
#define WAIT_VM0() asm volatile("s_waitcnt vmcnt(0)" ::: "memory")
#endif
#include <cstdint>
#include <cstddef>
#include <cstring>
#include <cstdlib>

#ifndef REP_DIFF
#define REP_DIFF 1
#endif
#ifndef REP_HY
#define REP_HY 1
#endif
#ifndef REP_NA
#define REP_NA 1
#endif
#ifndef REP_GP
#define REP_GP 1
#endif
#ifndef REP_GS
#define REP_GS 1
#endif
#ifndef REP_IP
#define REP_IP 1
#endif
#ifndef REP_W
#define REP_W 1
#endif
#ifndef REP_MG
#define REP_MG 1
#endif
#ifndef REP_MOE
#define REP_MOE 1
#endif
#ifndef REP_FIN
#define REP_FIN 1
#endif
typedef unsigned short bf16_t;
typedef unsigned int u32;
constexpr int LDS_BYTES = 160 * 1024 - 64;
typedef u32 U2 __attribute__((ext_vector_type(2)));
typedef u32 U4 __attribute__((ext_vector_type(4)));
typedef float F4 __attribute__((ext_vector_type(4)));
typedef float F2 __attribute__((ext_vector_type(2)));

#ifdef SMALL_DIMS
constexpr int D = 256, BATCH = 2, SEQ = 1024, DEPTH = 2, CTX = 128, GRID_MAX = 8;
#else
constexpr int D = 1024, BATCH = 2, SEQ = 8192, DEPTH = 4, CTX = 256, GRID_MAX = 256;
#endif
constexpr int NTH = 512;
constexpr int GW = 64, HD = 64;
constexpr int MW = D / 2;
constexpr int HYW = MW, HY_HID = 64, HY_BANDS = 16, HY_EMB = 33;
constexpr int GH = MW / 64, DH = MW / 128, NH = MW / 64;
constexpr int NE = 16, EFF = D / 2;
constexpr int NLAT = BATCH * SEQ, NCTX = BATCH * CTX, NTOK = NLAT + NCTX;
constexpr int KEYS = SEQ + CTX;
constexpr int IN_TOTAL = 13 * MW + 4 * GH + 4 * D;
constexpr int SRC_HY = 0, SRC_GQKV = 3 * MW, SRC_GZ = 6 * MW, SRC_GA = 7 * MW, SRC_DQKV = 7 * MW + 4 * GH, SRC_NQKV = 10 * MW + 4 * GH, SRC_GATE = 13 * MW + 4 * GH;
constexpr int GAB_W = ((13 * MW + 128) % 256 == 0) ? 128 : 256;
constexpr int MY_HY = 0, MY_GQKV = 3 * MW, MY_GZ = 6 * MW, MY_DQKV = 7 * MW, MY_NQKV = 10 * MW, MY_GAB = 13 * MW, MY_GATE = 13 * MW + GAB_W, NPROJ1 = 13 * MW + GAB_W, NPROJ = NPROJ1 + 4 * D;
constexpr float LN_EPS = 1e-5f, RMS_EPS = 1e-6f;
constexpr int NSLOT = 2 * NTOK;
constexpr int R_ROWS = SEQ / GW;
constexpr int NCH_LAT = SEQ / 64, NCH_CTX = CTX / 64, NCH = NCH_LAT + NCH_CTX;
constexpr int NTASK_GDN = BATCH * GH * 2 * NCH;
static_assert(KEYS % 192 == 0 && NTOK % 192 == 0 && NTOK % 256 == 0 && MW % 128 == 0 && SEQ % 256 == 0 && CTX % 64 == 0, "dims");

constexpr size_t al256(size_t x) { return (x + 255) & ~(size_t)255; }
constexpr size_t SZ_BAR = 16384;
constexpr size_t OFF_BAR = 0;
constexpr size_t OFF_CNT = OFF_BAR + SZ_BAR;
constexpr size_t OFF_MODP = OFF_CNT + 4096;
constexpr size_t OFF_MOD = OFF_MODP + al256((size_t)DEPTH * 8 * 3 * 6 * D * 4);
constexpr size_t OFF_XS = OFF_MOD + al256((size_t)DEPTH * 3 * 6 * D * 4);
constexpr size_t OFF_H = OFF_XS + (size_t)NTOK * D * 4;
constexpr size_t OFF_GZ = OFF_H + (size_t)NTOK * D * 2;
constexpr size_t OFF_GAB = OFF_GZ + (size_t)NTOK * MW * 2;
constexpr size_t OFF_GB = OFF_GAB + (size_t)NTOK * 32 * 4;
constexpr size_t OFF_Y = OFF_GB + (size_t)NTOK * 4 * GH * 4;
constexpr size_t OFF_WIN = OFF_Y + (size_t)NTOK * 4 * MW * 2;
constexpr size_t OFF_BP = OFF_WIN + (size_t)NPROJ * D * 2;
constexpr size_t OFF_WO = OFF_BP + (size_t)D * 4 * MW * 2;
constexpr size_t OFF_H2F = OFF_WO + (size_t)D * D * 2;
constexpr size_t OFF_H2B = OFF_H2F + al256((size_t)KEYS * 64 * 4);
constexpr size_t OFF_W3T = OFF_H2B + (size_t)KEYS * 128 * 2;
constexpr size_t OFF_RWT = OFF_W3T + (size_t)4 * HYW * 128 * 2;
constexpr size_t OFF_TOKE = OFF_RWT + (size_t)16 * D * 4;
constexpr size_t OFF_TOKR = OFF_TOKE + (size_t)NTOK * 2 * 4;
constexpr size_t OFF_TOKW = OFF_TOKR + (size_t)NTOK * 2 * 4;
constexpr size_t OFF_ELIST = OFF_TOKW + (size_t)NTOK * 2 * 4;
constexpr size_t OFF_RC = OFF_ELIST + (size_t)NE * NTOK * 4;
constexpr size_t OFF_DVT = OFF_RC;
constexpr size_t OFF_NVT = OFF_DVT + (size_t)BATCH * MW * KEYS * 2;
constexpr size_t OFF_GQ = OFF_NVT + (size_t)BATCH * MW * KEYS * 2;
constexpr size_t OFF_GK = OFF_GQ + (size_t)NTOK * MW * 2;
constexpr size_t OFF_GV = OFF_GK + (size_t)NTOK * MW * 2;
constexpr size_t OFF_RA = OFF_GV + (size_t)NTOK * MW * 2;
constexpr size_t SZ_SEG3 = (size_t)NTOK * 3 * MW * 2;
constexpr size_t OFF_SEG_HY = OFF_RA;
constexpr size_t OFF_SEG_GQKV = OFF_RA + SZ_SEG3;
constexpr size_t OFF_SEG_DQKV = OFF_RA + 2 * SZ_SEG3;
constexpr size_t OFF_SEG_NQKV = OFF_RA + 3 * SZ_SEG3;
constexpr size_t SZ_RA_W = (size_t)NTOK * 4 * D * 2 + (size_t)NE * 3 * EFF * D * 2;
constexpr size_t SZ_RA = 4 * SZ_SEG3 > SZ_RA_W ? 4 * SZ_SEG3 : SZ_RA_W;
constexpr size_t OFF_OF = OFF_RA;
constexpr size_t OFF_OB = OFF_OF + (size_t)NTOK * MW * 2;
constexpr size_t OFF_YAT = OFF_OB + (size_t)NTOK * MW * 2;
constexpr size_t OFF_HF = OFF_YAT + (size_t)BATCH * MW * KEYS * 2;
constexpr size_t HY_XN = 2 * SEQ + ((2 * SEQ) >> 6) * 4;
constexpr size_t OFF_SEG_GATE = OFF_RA;
constexpr size_t OFF_W13 = OFF_RA + (size_t)NTOK * 4 * D * 2;
constexpr size_t OFF_W2 = OFF_W13 + (size_t)NE * 2 * EFF * D * 2;
static_assert(OFF_HF + (size_t)GRID_MAX * HY_XN * 8 <= OFF_SEG_DQKV, "R1 overflow");
static_assert((size_t)NTOK * 4 * D * 2 <= SZ_RA, "gate overflow");
static_assert(OFF_W2 + (size_t)NE * D * EFF * 2 <= OFF_RA + SZ_RA, "expert weights overflow");
constexpr size_t OFF_RB = OFF_RA + SZ_RA;
constexpr size_t OFF_HYT = OFF_RB;
constexpr size_t OFF_WU = OFF_HYT + (size_t)BATCH * 3 * MW * KEYS * 2;
constexpr size_t OFF_TAPS = OFF_WU + (size_t)NTASK_GDN * 2 * 64 * 64 * 2;
constexpr size_t OFF_ZT = OFF_TAPS + (size_t)4 * HYW * KEYS * 2;
static_assert((size_t)GRID_MAX * 2 * SEQ * 4 <= (size_t)4 * HYW * KEYS * 2, "ZT overflow");
constexpr size_t OFF_MIXG = OFF_RB;
constexpr size_t OFF_MIX = OFF_MIXG + (size_t)NTOK * D * 2;
constexpr size_t OFF_HMID = OFF_MIX + (size_t)NTOK * D * 4;
constexpr size_t OFF_YE = OFF_HMID + (size_t)(NSLOT + 256) * EFF * 2;
constexpr size_t SZ_RB_LATE = OFF_YE + (size_t)(NSLOT + 256) * D * 2 - OFF_RB;
constexpr size_t SZ_RB_EARLY = OFF_TAPS + (size_t)4 * HYW * KEYS * 4 - OFF_RB;
constexpr size_t SZ_RB = SZ_RB_LATE > SZ_RB_EARLY ? SZ_RB_LATE : SZ_RB_EARLY;
constexpr size_t SZ_WSET = (size_t)NPROJ * D * 2 + (size_t)D * 4 * MW * 2 + (size_t)D * D * 2;
constexpr size_t OFF_WSET2 = OFF_RB + SZ_RB;
constexpr size_t WS_NEED = OFF_WSET2 + SZ_WSET;
__host__ __device__ constexpr size_t off_win(int l) { return (l & 1) ? OFF_WSET2 : OFF_WIN; }
__host__ __device__ constexpr size_t off_bp(int l) { return (l & 1) ? OFF_WSET2 + (size_t)NPROJ * D * 2 : OFF_BP; }
__host__ __device__ constexpr size_t off_wo(int l) { return (l & 1) ? OFF_WSET2 + (size_t)NPROJ * D * 2 + (size_t)D * 4 * MW * 2 : OFF_WO; }

struct Params {
    const float *x, *c, *ctx, *c_ctx, *w_mod, *b_mod, *w_in, *hy_conv, *hy_w1, *hy_b1, *hy_w2, *hy_b2, *hy_w3, *hy_freq, *hy_deltas, *hy_skip,
        *gdn_conv, *gdn_a_log, *gdn_dt_bias, *gdn_norm, *diff_lam, *diff_norm, *na_rpb, *branch_proj, *w_out, *ln_g, *ln_b, *router_w, *router_b,
        *exp_w1, *exp_w3, *exp_w2;
    float* out; char* ws; long long stop_phase;
};

#ifdef CPU_EMU
#define GPTR(T, ptr) ((T*)(ptr))
#else
#define GPTR(T, ptr) ((T*)(__attribute__((address_space(1))) T*)(ptr))
#endif
constexpr int LDS_TBL_OFF = LDS_BYTES - 16 - 256;
#ifdef CPU_EMU
__device__ __forceinline__ const float* gin_tbl(int idx) { return ((const float* const*)(emu_lds() + LDS_TBL_OFF))[idx]; }
#else
__device__ __forceinline__ const float* gin_tbl(int idx) { extern __shared__ __attribute__((aligned(16))) char lds_raw[]; return GPTR(const float, ((const float* const*)(lds_raw + 16 + LDS_TBL_OFF))[idx]); }
#endif
#define GIN(expr) gin_tbl((int)(((const char*)&(expr)) - ((const char*)&p)) >> 3)
#ifdef CPU_EMU
#define TID() ((int)threadIdx.x)
#define BID() ((int)blockIdx.x)
#else
__device__ __forceinline__ int TID() { int t = threadIdx.x; asm volatile("" : "+v"(t)); return t; }
__device__ __forceinline__ int BID() { int t = blockIdx.x; asm volatile("" : "+s"(t)); return t; }
#endif
__device__ __forceinline__ u32 f2u(float f) { union { float f; u32 u; } c; c.f = f; return c.u; }
__device__ __forceinline__ float u2f(u32 u) { union { float f; u32 u; } c; c.u = u; return c.f; }
#ifdef CPU_EMU
__device__ __forceinline__ bf16_t f2bf(float f) { u32 u = f2u(f); u += 0x7fffu + ((u >> 16) & 1u); return (bf16_t)(u >> 16); }
#else
typedef __bf16 hw_bf16x2 __attribute__((ext_vector_type(2)));
__device__ __forceinline__ bf16_t f2bf(float f) { const hw_bf16x2 r = __builtin_convertvector((F2){f, 0.f}, hw_bf16x2); u32 u; __builtin_memcpy(&u, &r, 4); return (bf16_t)(u & 0xffffu); }
#endif
__device__ __forceinline__ float bf2f(bf16_t h) { return u2f(((u32)h) << 16); }
#ifdef CPU_EMU
__device__ __forceinline__ u32 pack2(float lo, float hi) { return (u32)f2bf(lo) | ((u32)f2bf(hi) << 16); }
__device__ __forceinline__ float fexp2(float x) { return exp2f(x); }
#else
__device__ __forceinline__ u32 pack2(float lo, float hi) { const hw_bf16x2 r = __builtin_convertvector((F2){lo, hi}, hw_bf16x2); u32 u; __builtin_memcpy(&u, &r, 4); return u; }
__device__ __forceinline__ float fexp2(float x) { return __builtin_amdgcn_exp2f(x); }
#endif
__device__ __forceinline__ float bflo(u32 w) { return u2f(w << 16); }
__device__ __forceinline__ float bfhi(u32 w) { return u2f(w & 0xffff0000u); }
#ifdef CPU_EMU
__device__ __forceinline__ float sigmoidf(float x) { return 1.0f / (1.0f + expf(-x)); }
#else
__device__ __forceinline__ float sigmoidf(float x) { return __builtin_amdgcn_rcpf(1.0f + __builtin_amdgcn_exp2f(x * -1.4426950408889634f)); }
#endif
__device__ __forceinline__ float siluf(float x) { return x * sigmoidf(x); }
#ifdef CPU_EMU
template <int O> __device__ __forceinline__ float xadd(float v) { return v + __shfl_xor(v, O); }
template <int O> __device__ __forceinline__ float xmax(float v) { return fmaxf(v, __shfl_xor(v, O)); }
#else
template <int O> __device__ __forceinline__ float xadd(float v) {
    if constexpr (O == 32) { const auto r = __builtin_amdgcn_permlane32_swap(__float_as_uint(v), __float_as_uint(v), false, false); return __uint_as_float(r[0]) + __uint_as_float(r[1]); }
    else return v + __int_as_float(__builtin_amdgcn_ds_swizzle(__float_as_int(v), (O << 10) | 0x1f)); }
template <int O> __device__ __forceinline__ float xmax(float v) {
    if constexpr (O == 32) { const auto r = __builtin_amdgcn_permlane32_swap(__float_as_uint(v), __float_as_uint(v), false, false); return fmaxf(__uint_as_float(r[0]), __uint_as_float(r[1])); }
    else return fmaxf(v, __int_as_float(__builtin_amdgcn_ds_swizzle(__float_as_int(v), (O << 10) | 0x1f))); }
#endif
__device__ __forceinline__ float wave_sum(float v) { v = xadd<32>(v); v = xadd<16>(v); v = xadd<8>(v); v = xadd<4>(v); v = xadd<2>(v); v = xadd<1>(v); return v; }
__device__ __forceinline__ float wave_max(float v) { v = xmax<32>(v); v = xmax<16>(v); v = xmax<8>(v); v = xmax<4>(v); v = xmax<2>(v); v = xmax<1>(v); return v; }
__device__ __forceinline__ bf16x8 ld8(const bf16_t* p) { return *(const bf16x8*)p; }
__device__ __forceinline__ bf16x8 mk8(U2 a, U2 b) { union { struct { U2 a, b; } s; bf16x8 v; } c; c.s.a = a; c.s.b = b; return c.v; }
__device__ __forceinline__ bf16x8 mk8u(u32 a, u32 b, u32 c0, u32 d) { union { u32 u[4]; bf16x8 v; } c; c.u[0] = a; c.u[1] = b; c.u[2] = c0; c.u[3] = d; return c.v; }
#define MFMA16(a, b, c) __builtin_amdgcn_mfma_f32_16x16x32_bf16(a, b, c, 0, 0, 0)
__device__ __forceinline__ int mod_row(int tok) { return tok < NLAT ? tok / SEQ : 2; }
__device__ __forceinline__ void tok_bk(int tok, int& b, int& key) { if (tok < NLAT) { b = tok / SEQ; key = tok - b * SEQ; } else { int t = tok - NLAT; b = t / CTX; key = SEQ + t - b * CTX; } }
__device__ __forceinline__ int bk_tok(int b, int key) { return key < SEQ ? b * SEQ + key : NLAT + b * CTX + (key - SEQ); }
#ifdef CPU_EMU
struct XcdBarrier { int dummy; };
#define GSYNC() emu_grid_sync()
#else
#define XB_TMO      128
#define XB_XCNT(j)  (256  + 64 * (j))
#define XB_XSUB(j)  (1280 + 64 * (j))
#define XB_XGEN(j)  (2304 + 64 * (j))
#define XB_TOP      3328
#define XB_TOPGEN   3392
#define XCD_BAR_WORDS 3456
#define XB_SPIN_CAP (1u << 22)
#define LAS __attribute__((address_space(3)))
__device__ __forceinline__ unsigned xb_ld(unsigned* p)              { return __hip_atomic_load(p, __ATOMIC_RELAXED, __HIP_MEMORY_SCOPE_AGENT); }
__device__ __forceinline__ unsigned xb_add(unsigned* p, unsigned v) { return __hip_atomic_fetch_add(p, v, __ATOMIC_RELAXED, __HIP_MEMORY_SCOPE_AGENT); }
__device__ __forceinline__ unsigned xb_xcc_id() { return (unsigned)__builtin_amdgcn_s_getreg((3 << 11) | 20) & 0xFu; }
#define XB_SPIN(cond, bar) do { unsigned _sp = 0; while (cond) { __builtin_amdgcn_s_sleep(1); \
    if ((++_sp & 255u) == 0u) { if (xb_ld(&(bar)[XB_TMO])) break; if (_sp > XB_SPIN_CAP) { atomicAdd(&(bar)[XB_TMO], 1u); break; } } } } while (0)
struct XcdBarrier { unsigned* bar; unsigned x; volatile LAS unsigned* st; };
__device__ __forceinline__ XcdBarrier xcd_barrier_post(unsigned* bar, volatile LAS unsigned* st) {
    XcdBarrier b; b.bar = bar; b.x = xb_xcc_id(); b.st = st;
    if (threadIdx.x == 0) (void)xb_add(&bar[XB_XCNT(b.x)], 1u);
    return b;
}
__device__ __forceinline__ void xcd_barrier_complete(unsigned* bar, unsigned x, unsigned& nloc, unsigned& nx) {
    const unsigned G = gridDim.x * gridDim.y * gridDim.z;
    unsigned sum, cnt, mine, sp = 0u;
    for (;;) {
        sum = 0u; cnt = 0u; mine = 0u;
#pragma unroll
        for (unsigned j = 0; j < 16; ++j) { const unsigned c = xb_ld(&bar[XB_XCNT(j)]); sum += c; cnt += (c > 0u) ? 1u : 0u; mine = (j == x) ? c : mine; }
        if (sum == G) break;
        __builtin_amdgcn_s_sleep(1);
        if ((++sp & 255u) == 0u) { if (xb_ld(&bar[XB_TMO])) break; if (sp > XB_SPIN_CAP) { atomicAdd(&bar[XB_TMO], 1u); break; } }
    }
    nloc = mine > 0u ? mine : 1u; nx = cnt > 0u ? cnt : 1u;
}
__device__ __forceinline__ void xcd_barrier(const XcdBarrier& b) {
    asm volatile("s_waitcnt vmcnt(0)" ::: "memory");
    __syncthreads();
    if (threadIdx.x == 0) {
        unsigned* bar = b.bar;
        __builtin_amdgcn_s_waitcnt(0);
        unsigned nloc = b.st[0], nx = b.st[1];
        if (nloc == 0u) { xcd_barrier_complete(bar, b.x, nloc, nx); b.st[0] = nloc; b.st[1] = nx; }
        const unsigned old = xb_add(&bar[XB_XSUB(b.x)], 1u);
        const unsigned gen = old / nloc;
        if (old + 1u == (gen + 1u) * nloc) {
            __builtin_amdgcn_fence(__ATOMIC_RELEASE, "agent");
            asm volatile("s_waitcnt vmcnt(0)" ::: "memory");
            const unsigned og = xb_add(&bar[XB_TOP], 1u);
            const unsigned tg = og / nx;
            if (og + 1u == (tg + 1u) * nx) xb_add(&bar[XB_TOPGEN], 1u);
            else XB_SPIN(xb_ld(&bar[XB_TOPGEN]) == tg, bar);
            __builtin_amdgcn_fence(__ATOMIC_ACQUIRE, "agent");
            xb_add(&bar[XB_XGEN(b.x)], 1u);
            asm volatile("s_waitcnt vmcnt(0)" ::: "memory");
        } else {
            XB_SPIN(xb_ld(&bar[XB_XGEN(b.x)]) == gen, bar);
            __builtin_amdgcn_fence(__ATOMIC_ACQUIRE, "agent");
            asm volatile("s_waitcnt vmcnt(0)" ::: "memory");
        }
    }
    __syncthreads();
}
#define GSYNC() xcd_barrier(xbar)
#endif

constexpr int G_BM = 256, G_BN = 128, G_BK = 64, G_LD = 80;
constexpr int G_STAGE = (G_BM + G_BN) * G_LD * 2;
constexpr int G_LDS = 2 * G_STAGE;

template <int MT = 4, class ARow>
__device__ __forceinline__ void gemm_tile(char* lds, ARow arow  , const bf16_t* Bt, long ldb, int K, f32x4 (&acc)[MT][4]) {
    const int tid = TID(), wid = tid >> 6, lane = tid & 63, wm = wid >> 1, wn = wid & 1, l15 = lane & 15, g = lane >> 4;
#pragma unroll
    for (int m = 0; m < MT; ++m)
#pragma unroll
        for (int n = 0; n < 4; ++n) acc[m][n] = (f32x4){0.f, 0.f, 0.f, 0.f};
    const bf16_t* ap[MT]; const bf16_t* bp[2];
#pragma unroll
    for (int i = 0; i < MT; ++i) { int pc = tid + i * NTH; int r = pc >> 3, s = pc & 7; ap[i] = arow(r) + s * 8; }
#pragma unroll
    for (int i = 0; i < 2; ++i) { int pc = tid + i * NTH; int r = pc >> 3, s = pc & 7; bp[i] = Bt + (long)r * ldb + s * 8; }
    U4 ra[2][MT], rb[2][2];
    const int nk = K / G_BK;
#define GT_LOAD(set, kt) do { _Pragma("unroll") for (int i = 0; i < MT; ++i) ra[set][i] = *(const U4*)(ap[i] + (kt) * G_BK); _Pragma("unroll") for (int i = 0; i < 2; ++i) rb[set][i] = *(const U4*)(bp[i] + (kt) * G_BK); } while (0)
#define GT_STORE(set, st) do { bf16_t* dA = (bf16_t*)(lds + (st) * G_STAGE); bf16_t* dB = dA + G_BM * G_LD; \
        _Pragma("unroll") for (int i = 0; i < MT; ++i) { int pc = tid + i * NTH; int r = pc >> 3, s = pc & 7; *(U4*)(dA + r * G_LD + s * 8) = ra[set][i]; } \
        _Pragma("unroll") for (int i = 0; i < 2; ++i) { int pc = tid + i * NTH; int r = pc >> 3, s = pc & 7; *(U4*)(dB + r * G_LD + s * 8) = rb[set][i]; } } while (0)
#define GT_COMPUTE(st) do { const bf16_t* sA = (const bf16_t*)(lds + (st) * G_STAGE); const bf16_t* sB = sA + G_BM * G_LD; \
        _Pragma("unroll") for (int ks = 0; ks < 2; ++ks) { bf16x8 af[MT], bfr[4]; \
            _Pragma("unroll") for (int m = 0; m < MT; ++m) af[m] = ld8(sA + (wm * 16 * MT + m * 16 + l15) * G_LD + ks * 32 + g * 8); \
            _Pragma("unroll") for (int n = 0; n < 4; ++n) bfr[n] = ld8(sB + (wn * 64 + n * 16 + l15) * G_LD + ks * 32 + g * 8); \
            _Pragma("unroll") for (int m = 0; m < MT; ++m) _Pragma("unroll") for (int n = 0; n < 4; ++n) acc[m][n] = MFMA16(bfr[n], af[m], acc[m][n]); } } while (0)
    GT_LOAD(0, 0);
    GT_LOAD(1, 1);
    __syncthreads();
    GT_STORE(0, 0);
    if (nk > 2) GT_LOAD(0, 2);
    __syncthreads();
    for (int kt = 0; kt < nk; kt += 2) {
        GT_COMPUTE(0);
        GT_STORE(1, 1);
        if (kt + 3 < nk) GT_LOAD(1, kt + 3);
        __syncthreads();
        GT_COMPUTE(1);
        if (kt + 2 < nk) { GT_STORE(0, 0); if (kt + 4 < nk) GT_LOAD(0, kt + 4); }
        __syncthreads();
    }
#undef GT_LOAD
#undef GT_STORE
#undef GT_COMPUTE
}

template <int MT, class Prov, int MODE = 0>
__device__ __forceinline__ void gemm_stream(char* lds, Prov& pv, const long ldb, const int K) {
    const int tid = TID(), wid = tid >> 6, lane = tid & 63, wm = wid >> 1, wn = wid & 1, l15 = lane & 15, g = lane >> 4;
    if (!pv.valid(0)) return;
    const bf16_t* ap[MT]; const bf16_t* bp[2]; const bf16_t* apn[MT]; const bf16_t* bpn[2];
    U4 ra[2][MT], rb[2][2];
    const int nk = K / G_BK;
#define GS_PTRS(AP, BP, i) do { const int tq_ = TID(); _Pragma("unroll") for (int q_ = 0; q_ < MT; ++q_) { int pc = tq_ + q_ * NTH; AP[q_] = pv.arow(i, pc >> 3) + (pc & 7) * 8; } \
        const bf16_t* bb_ = pv.bbase(i); _Pragma("unroll") for (int q_ = 0; q_ < 2; ++q_) { int pc = tq_ + q_ * NTH; BP[q_] = bb_ + (long)(pc >> 3) * ldb + (pc & 7) * 8; } } while (0)
#define GS_LOAD(set, AP, BP, kt) do { _Pragma("unroll") for (int q_ = 0; q_ < MT; ++q_) ra[set][q_] = *(const U4*)(AP[q_] + (kt) * G_BK); _Pragma("unroll") for (int q_ = 0; q_ < 2; ++q_) rb[set][q_] = *(const U4*)(BP[q_] + (kt) * G_BK); } while (0)
#define GS_LOADV(set, v) do { if (MODE == 2 || MODE == 4) break; if ((v) < nk) GS_LOAD(set, ap, bp, (v)); else if (hn) GS_LOAD(set, apn, bpn, (v) - nk); } while (0)
#define GS_STORE(set, st) do { if (MODE == 4) break; bf16_t* dA = (bf16_t*)(lds + (st) * G_STAGE); bf16_t* dB = dA + G_BM * G_LD; \
        _Pragma("unroll") for (int q_ = 0; q_ < MT; ++q_) { int pc = tid + q_ * NTH; *(U4*)(dA + (pc >> 3) * G_LD + (pc & 7) * 8) = ra[set][q_]; } \
        _Pragma("unroll") for (int q_ = 0; q_ < 2; ++q_) { int pc = tid + q_ * NTH; *(U4*)(dB + (pc >> 3) * G_LD + (pc & 7) * 8) = rb[set][q_]; } } while (0)
#define GS_COMPUTE(st) do { if (MODE == 3) break; const bf16_t* sA = (const bf16_t*)(lds + (st) * G_STAGE); const bf16_t* sB = sA + G_BM * G_LD; \
        _Pragma("unroll") for (int ks = 0; ks < 2; ++ks) { bf16x8 af[MT], bfr[4];     \
            _Pragma("unroll") for (int n = 0; n < 4; ++n) bfr[n] = ld8(sB + (wn * 64 + n * 16 + l15) * G_LD + ks * 32 + g * 8); \
            _Pragma("unroll") for (int m = 0; m < MT; ++m) af[m] = ld8(sA + (wm * 16 * MT + m * 16 + l15) * G_LD + ks * 32 + g * 8); \
            SCHED_FENCE(); \
            _Pragma("unroll") for (int m = 0; m < MT; ++m) _Pragma("unroll") for (int n = 0; n < 4; ++n) acc[m][n] = MFMA16(bfr[n], af[m], acc[m][n]); \
            SCHED_FENCE(); } } while (0)
    GS_PTRS(ap, bp, 0);
    GS_LOAD(0, ap, bp, 0);
    GS_LOAD(1, ap, bp, 1);
    __syncthreads();
    for (int i = 0;; ++i) {
        const bool hn = pv.valid(i + 1);
        if (hn) GS_PTRS(apn, bpn, i + 1);
        f32x4 acc[MT][4];
#pragma unroll
        for (int m = 0; m < MT; ++m)
#pragma unroll
            for (int n = 0; n < 4; ++n) acc[m][n] = (f32x4){0.f, 0.f, 0.f, 0.f};
        pv.pre(i);
        GS_STORE(0, 0);
        GS_LOADV(0, 2);
        __syncthreads();
        for (int kt = 0; kt < nk; kt += 2) {
            GS_COMPUTE(0);
            GS_STORE(1, 1);
            GS_LOADV(1, kt + 3);
            __syncthreads();
            GS_COMPUTE(1);
            if (kt + 2 < nk) { GS_STORE(0, 0); GS_LOADV(0, kt + 4); }
            __syncthreads();
        }
        pv.epi(i, acc);
        if (!hn) break;
#pragma unroll
        for (int q_ = 0; q_ < MT; ++q_) ap[q_] = apn[q_];
        bp[0] = bpn[0]; bp[1] = bpn[1];
    }
#undef GS_PTRS
#undef GS_LOAD
#undef GS_LOADV
#undef GS_STORE
#undef GS_COMPUTE
}

template <class SrcFn>
__device__ __forceinline__ void cvt_tile(char* lds, SrcFn srcp, int k0, int n0, bf16_t* dst, long dst_ld) {
    float* t = (float*)lds;
    const int tid = TID();
    __syncthreads();
#pragma unroll
    for (int i = 0; i < 2; ++i) { int kk = (tid >> 4) + 32 * i, n4 = (tid & 15) * 4; const float* sp = srcp(k0 + kk, n0 + n4);
        F4 v = sp ? *(const F4*)sp : (F4){0.f, 0.f, 0.f, 0.f};
        t[kk * 65 + n4] = v.x; t[kk * 65 + n4 + 1] = v.y; t[kk * 65 + n4 + 2] = v.z; t[kk * 65 + n4 + 3] = v.w; }
    __syncthreads();
    { int n = tid >> 3, k8 = (tid & 7) * 8; U4 o;
        o.x = pack2(t[(k8 + 0) * 65 + n], t[(k8 + 1) * 65 + n]); o.y = pack2(t[(k8 + 2) * 65 + n], t[(k8 + 3) * 65 + n]);
        o.z = pack2(t[(k8 + 4) * 65 + n], t[(k8 + 5) * 65 + n]); o.w = pack2(t[(k8 + 6) * 65 + n], t[(k8 + 7) * 65 + n]);
        *(U4*)(dst + (long)(n0 + n) * dst_ld + k0 + k8) = o; }
}

__device__ __forceinline__ void tr_tile(char* lds, const bf16_t* src, long ld, int tok0, int col0, int ncols, int cdst0, bf16_t* dst) {
    bf16_t* t = (bf16_t*)lds;
    const int tid = TID();
    __syncthreads();
    { int r = tid >> 3, s = tid & 7; *(U4*)(t + r * 72 + s * 8) = *(const U4*)(src + (long)(tok0 + r) * ld + col0 + s * 8); }
    __syncthreads();
    { int c = tid >> 3, t8 = (tid & 7) * 8; int b, key; tok_bk(tok0, b, key);
        U4 o; o.x = (u32)t[(t8 + 0) * 72 + c] | ((u32)t[(t8 + 1) * 72 + c] << 16); o.y = (u32)t[(t8 + 2) * 72 + c] | ((u32)t[(t8 + 3) * 72 + c] << 16);
        o.z = (u32)t[(t8 + 4) * 72 + c] | ((u32)t[(t8 + 5) * 72 + c] << 16); o.w = (u32)t[(t8 + 6) * 72 + c] | ((u32)t[(t8 + 7) * 72 + c] << 16);
        *(U4*)(dst + ((long)b * ncols + cdst0 + c) * KEYS + key + t8) = o; }
}
namespace pg8 {
#ifdef CPU_EMU
#define PG8_LAS
#else
#define PG8_LAS __attribute__((address_space(3)))
#endif
typedef unsigned short bf16_t;
typedef unsigned u32x4 __attribute__((ext_vector_type(4)));
constexpr int BM = 256, BK = 64, HALF = 128, HTB = HALF * BK * 2  , STAGE_BYTES = 8 * HTB, NXCD = 8, WGM = 8;

__host__ __device__ __forceinline__ int lds_byte(int r, int c) { const int st = (r >> 4) * 2 + (c >> 5), rr = r & 15, cc = c & 31, ob = rr * 64 + cc * 2; return st * 1024 + (ob ^ (((ob >> 9) & 1) << 5)); }
__host__ __device__ __forceinline__ void stage_rc(int b, int& R, int& C) { const int st = b / 1024, sb = b % 1024, swz = sb ^ (((sb >> 9) & 1) << 5); R = (st >> 1) * 16 + swz / 64; C = (st & 1) * 32 + (swz % 64) / 2; }
__host__ __device__ __forceinline__ int perm32(int rho) { const int n = rho >> 4, i = rho & 15; return 8 * (i >> 2) + 4 * n + (i & 3); }

struct Unit { int pm, pn; };
struct Gemm { const bf16_t* A; const bf16_t* Bt; int M, N, K; };

struct StaticOrder {
    int nM, nN, nwg, G, c;
    __host__ __device__ void init(int M, int N, int G_, int c_) { nM = M / BM; nN = N / BM; nwg = nM * nN; G = G_; c = c_; }
    __host__ __device__ bool next(int i, Unit& u) const {
        const long L = (long)i * G + c; if (L >= nwg) return false;
        int wgid = (int)L; { const int q = nwg / NXCD, r = nwg % NXCD, xcd = wgid % NXCD, off = wgid / NXCD; wgid = (xcd < r ? xcd * (q + 1) : r * (q + 1) + (xcd - r) * q) + off; }
        const int nig = WGM * nN, gid = wgid / nig, fm = gid * WGM, gsz = (nM - fm) < WGM ? (nM - fm) : WGM;
        u.pm = fm + ((wgid % nig) % gsz); u.pn = (wgid % nig) / gsz; return true;
    }
    __device__ __forceinline__ void a_ready(const Unit&) const {}
    __device__ __forceinline__ void done(const Unit&) const {}
};
template <class Epi, class Sched, bool STAMP = false>
__device__ __forceinline__ void gemm_phase(PG8_LAS unsigned char* lds, const Gemm g, const Sched& S, const Epi& E, unsigned long long* stamps) {
    const int tid = TID(), wid = __builtin_amdgcn_readfirstlane(tid >> 6), lane = tid & 63, wr = wid >> 2, wc = wid & 3, fr = lane & 15, fq = lane >> 4;
    const int K = g.K, nt = K / BK;
    int ts_lo = 0, ts_hi = 0, nts = 0; const unsigned long long rt_entry = STAMP ? (unsigned long long)wall_clock64() : 0ull;
#define PG8_STAMP() do { if (STAMP && wid == 0 && nts < 64) { const unsigned long long _c = (unsigned long long)clock64(); \
        ts_lo = (lane == nts) ? (int)(unsigned)_c : ts_lo; ts_hi = (lane == nts) ? (int)(unsigned)(_c >> 32) : ts_hi; ++nts; } } while (0)
    PG8_STAMP();
    unsigned voffA[2], voffB[2];
#pragma unroll
    for (int i = 0; i < 2; ++i) { int R, C; stage_rc(tid * 16 + i * 8192, R, C); const int Rb = Epi::PERM ? ((R & ~31) + perm32(R & 31)) : R;
        voffA[i] = (unsigned)(R * K + C) * 2u; voffB[i] = (unsigned)(Rb * K + C) * 2u; }
    const size_t kstep = (size_t)(BK * 2);
    const size_t hstep = (size_t)HALF * K * 2;
    const size_t tstep = 2 * hstep;
    const unsigned ldsw = (unsigned)wid * 1024u;
    const int aoff = lds_byte(wr * 64 + fr, fq * 8), boff = lds_byte(wc * 32 + fr, fq * 8);
#define PG8_SA(b, h) (((b) * 2 + (h)) * HTB)
#define PG8_SB(b, h) ((4 + (b) * 2 + (h)) * HTB)
#define PG8_STAGE(bufoff, gbase, voff) do { _Pragma("unroll") for (int _i = 0; _i < 2; ++_i) \
        __builtin_amdgcn_global_load_lds((const unsigned*)((const char*)(gbase) + (voff)[_i]), (PG8_LAS unsigned*)(lds + (bufoff) + ldsw + _i * 8192), 16, 0, 0); } while (0)
#define PG8_LDA(dst, b, h) do { _Pragma("unroll") for (int m = 0; m < 4; ++m) _Pragma("unroll") for (int k = 0; k < 2; ++k) dst[m][k] = *(const PG8_LAS bf16x8*)(lds + PG8_SA(b, h) + aoff + m * 2048 + k * 1024); } while (0)
#define PG8_LDB(dst, b, h) do { _Pragma("unroll") for (int n = 0; n < 2; ++n) _Pragma("unroll") for (int k = 0; k < 2; ++k) dst[n][k] = *(const PG8_LAS bf16x8*)(lds + PG8_SB(b, h) + boff + n * 2048 + k * 1024); } while (0)
#define PG8_MMA(ai, bj, At, Bt) do { __builtin_amdgcn_s_setprio(1); _Pragma("unroll") for (int m = 0; m < 4; ++m) _Pragma("unroll") for (int n = 0; n < 2; ++n) _Pragma("unroll") for (int k = 0; k < 2; ++k) \
        acc[ai][bj][m][n] = __builtin_amdgcn_mfma_f32_16x16x32_bf16(Bt[n][k], At[m][k], acc[ai][bj][m][n], 0, 0, 0); __builtin_amdgcn_s_setprio(0); } while (0)
#ifdef CPU_EMU
#define PG8_WAIT_V(n)
#define PG8_WAIT_L(n)
#else
#define PG8_WAIT_V(n) asm volatile("s_waitcnt vmcnt(" #n ")" ::: "memory")
#define PG8_WAIT_L(n) asm volatile("s_waitcnt lgkmcnt(" #n ")" ::: "memory")
#endif
#define PG8_BAR __builtin_amdgcn_s_barrier()
#define PG8_SCHED __builtin_amdgcn_sched_barrier(0)
    Unit cur, nxt; int ui = 0;
    if (!S.next(0, cur)) return;
    f32x4 acc[2][2][4][2];
#pragma unroll
    for (int a = 0; a < 2; ++a)
#pragma unroll
        for (int b = 0; b < 2; ++b)
#pragma unroll
            for (int m = 0; m < 4; ++m)
#pragma unroll
                for (int n = 0; n < 2; ++n) acc[a][b][m][n] = (f32x4){0.f, 0.f, 0.f, 0.f};
    bf16x8 At[4][2], B0[2][2], B1[2][2];
    const char* cA = (const char*)g.A + (size_t)cur.pm * tstep; const char* cB = (const char*)g.Bt + (size_t)cur.pn * tstep;
    S.a_ready(cur);
    PG8_STAGE(PG8_SB(0, 0), cB, voffB); PG8_STAGE(PG8_SA(0, 0), cA, voffA); PG8_STAGE(PG8_SB(0, 1), cB + hstep, voffB); PG8_STAGE(PG8_SA(0, 1), cA + hstep, voffA);
    if (wr == 1) PG8_BAR;
    PG8_WAIT_V(4); PG8_BAR;
    PG8_STAGE(PG8_SB(1, 0), cB + kstep, voffB); PG8_STAGE(PG8_SA(1, 0), cA + kstep, voffA); PG8_STAGE(PG8_SB(1, 1), cB + hstep + kstep, voffB);
    PG8_WAIT_V(6); PG8_BAR;
    PG8_STAMP();
    for (;;) {
        const bool has_next = S.next(ui + 1, nxt);
        const char* nA = has_next ? (const char*)g.A + (size_t)nxt.pm * tstep : cA; const char* nB = has_next ? (const char*)g.Bt + (size_t)nxt.pn * tstep : cB;
        for (int t = 0; t < nt; t += 2) {
            const bool last = (t == nt - 2);
            const char* a1 = cA + (size_t)(t + 1) * kstep;
            const char* a2 = last ? nA : cA + (size_t)(t + 2) * kstep; const char* b2 = last ? nB : cB + (size_t)(t + 2) * kstep;
            const char* a3 = a2 + kstep; const char* b3 = b2 + kstep;
            if (last && has_next) S.a_ready(nxt);
            PG8_LDB(B0, 0, 0); PG8_SCHED; PG8_LDA(At, 0, 0); PG8_STAGE(PG8_SA(1, 1), a1 + hstep, voffA);
            PG8_WAIT_L(8); PG8_BAR; PG8_WAIT_L(0); PG8_MMA(0, 0, At, B0); PG8_BAR; PG8_SCHED;
            PG8_LDB(B1, 0, 1); PG8_STAGE(PG8_SB(0, 0), b2, voffB);
            PG8_BAR; PG8_WAIT_L(0); PG8_MMA(0, 1, At, B1); PG8_BAR;
            PG8_LDA(At, 0, 1); PG8_STAGE(PG8_SA(0, 0), a2, voffA);
            PG8_BAR; PG8_WAIT_L(0); PG8_MMA(1, 0, At, B0); PG8_BAR; PG8_SCHED;
            PG8_STAGE(PG8_SB(0, 1), b2 + hstep, voffB);
            PG8_WAIT_V(6); PG8_BAR; PG8_MMA(1, 1, At, B1); PG8_BAR;
            PG8_LDB(B0, 1, 0); PG8_SCHED; PG8_LDA(At, 1, 0); PG8_STAGE(PG8_SA(0, 1), a2 + hstep, voffA);
            PG8_WAIT_L(8); PG8_BAR; PG8_WAIT_L(0); PG8_MMA(0, 0, At, B0); PG8_BAR; PG8_SCHED;
            PG8_LDB(B1, 1, 1); PG8_STAGE(PG8_SB(1, 0), b3, voffB);
            PG8_BAR; PG8_WAIT_L(0); PG8_MMA(0, 1, At, B1); PG8_BAR;
            PG8_LDA(At, 1, 1); PG8_STAGE(PG8_SA(1, 0), a3, voffA);
            PG8_BAR; PG8_WAIT_L(0); PG8_MMA(1, 0, At, B0); PG8_BAR; PG8_SCHED;
            PG8_STAGE(PG8_SB(1, 1), b3 + hstep, voffB);
            PG8_WAIT_V(6); PG8_BAR; PG8_MMA(1, 1, At, B1); PG8_BAR;
        }
        PG8_STAMP();
        if constexpr (!Epi::AFTER_DRAIN) { E(acc, cur, wr, wc, fr, fq); S.done(cur); }
        PG8_STAMP();
        if (!has_next) break;
#pragma unroll
        for (int a = 0; a < 2; ++a)
#pragma unroll
            for (int b = 0; b < 2; ++b)
#pragma unroll
                for (int m = 0; m < 4; ++m)
#pragma unroll
                    for (int n = 0; n < 2; ++n) acc[a][b][m][n] = (f32x4){0.f, 0.f, 0.f, 0.f};
        cur = nxt; cA = nA; cB = nB; ++ui;
    }
    PG8_WAIT_V(0);
    if (wr == 0) PG8_BAR;
    PG8_BAR;
    if constexpr (Epi::AFTER_DRAIN) { E.fused(acc, cur, wr, wc, fr, fq, lds, wid, lane); S.done(cur); }
    PG8_STAMP();
    if (STAMP && wid == 0) { stamps[lane] = lane < nts ? (((unsigned long long)(unsigned)ts_hi << 32) | (unsigned)ts_lo) : 0ull;
        if (lane == 62) stamps[62] = rt_entry; if (lane == 63) stamps[63] = (unsigned long long)wall_clock64(); }
#undef PG8_STAMP
#undef PG8_SA
#undef PG8_SB
#undef PG8_STAGE
#undef PG8_LDA
#undef PG8_LDB
#undef PG8_MMA
#undef PG8_WAIT_V
#undef PG8_WAIT_L
#undef PG8_BAR
#undef PG8_SCHED
}


__device__ __forceinline__ unsigned cvt_pk_bf16(float lo, float hi) { return pack2(lo, hi); }
__device__ __forceinline__ long gate_idx(int row, int br, int col) {
    const int tm = row / 192, r = row - tm * 192, wm = r / 48, r2 = r - wm * 48, m = r2 >> 4, l15 = r2 & 15;
    const int tn = col >> 7, c = col & 127, wn = c >> 6, n = (c >> 4) & 3, g = (c >> 2) & 3;
    return ((((long)(tm * (D / 128) + tn) * 4 + br) * 8 + (wm * 2 + wn)) * 12 + (m * 4 + n)) * 256 + (g * 16 + l15) * 4;
}
struct EpiInproj {
    static constexpr bool PERM = true, AFTER_DRAIN = false;
    char* ws; int ncol0;
    static __device__ __forceinline__ void st_tr(bf16_t* dT, long key, const f32x4& v0, const f32x4& v1) {
        dT[key] = f2bf(v0[0]); dT[KEYS + key] = f2bf(v0[1]); dT[2 * KEYS + key] = f2bf(v0[2]); dT[3 * KEYS + key] = f2bf(v0[3]);
        dT[4 * KEYS + key] = f2bf(v1[0]); dT[5 * KEYS + key] = f2bf(v1[1]); dT[6 * KEYS + key] = f2bf(v1[2]); dT[7 * KEYS + key] = f2bf(v1[3]); }
    __device__ __forceinline__ void operator()(const f32x4 (&acc)[2][2][4][2], const Unit& u, int wr_, int wc_, int fr_, int fq_) const {
        const int tid = TID(), wid = tid >> 6, lane = tid & 63, wr = wid >> 2, wc = wid & 3, fr = lane & 15, fq = lane >> 4;
        (void)wr_; (void)wc_; (void)fr_; (void)fq_;
#pragma unroll
        for (int bj = 0; bj < 2; ++bj) {
            const int cw = ncol0 + u.pn * BM + bj * HALF;
            bf16_t* dst = nullptr; bf16_t* dT = nullptr; bf16_t* gatep = nullptr; int ld = 0, cl = 0, ncT = 0; bool gab = false;
            if (cw < MY_GQKV) { dT = GPTR(bf16_t, ws + OFF_HYT); ncT = 3 * MW; cl = cw - MY_HY; }
            else if (cw < MY_GZ) { dst = GPTR(bf16_t, ws + OFF_SEG_GQKV); ld = 3 * MW; cl = cw - MY_GQKV; }
            else if (cw < MY_DQKV) { dst = GPTR(bf16_t, ws + OFF_GZ); ld = MW; cl = cw - MY_GZ; }
            else if (cw < MY_NQKV) { cl = cw - MY_DQKV; if (cl < 2 * MW) { dst = GPTR(bf16_t, ws + OFF_SEG_DQKV); ld = 3 * MW; } else { dT = GPTR(bf16_t, ws + OFF_DVT); ncT = MW; cl -= 2 * MW; } }
            else if (cw < MY_GAB) { cl = cw - MY_NQKV; if (cl < 2 * MW) { dst = GPTR(bf16_t, ws + OFF_SEG_NQKV); ld = 3 * MW; } else { dT = GPTR(bf16_t, ws + OFF_NVT); ncT = MW; cl -= 2 * MW; } }
            else if (cw < MY_GATE) { gab = (cw == MY_GAB) && wc == 0; }
            else { gatep = GPTR(bf16_t, ws + OFF_SEG_GATE); cl = cw - MY_GATE; }
            if (dst) {
#pragma unroll
                for (int ai = 0; ai < 2; ++ai)
#pragma unroll
                    for (int m = 0; m < 4; ++m) { const long row = (long)u.pm * BM + ai * HALF + wr * 64 + m * 16 + fr;
                        const f32x4 v0 = acc[ai][bj][m][0], v1 = acc[ai][bj][m][1];
                        U4 w; w.x = pack2(v0[0], v0[1]); w.y = pack2(v0[2], v0[3]); w.z = pack2(v1[0], v1[1]); w.w = pack2(v1[2], v1[3]);
                        *(U4*)(dst + row * ld + cl + wc * 32 + 8 * fq) = w; }
            } else if (gatep) {
                const int gcol = cl + wc * 32 + 8 * fq, br = gcol / D, col = gcol - br * D;
#pragma unroll
                for (int ai = 0; ai < 2; ++ai)
#pragma unroll
                    for (int m = 0; m < 4; ++m) { const int row = u.pm * BM + ai * HALF + wr * 64 + m * 16 + fr;
                        const f32x4 v0 = acc[ai][bj][m][0], v1 = acc[ai][bj][m][1];
                        bf16_t* q = gatep + gate_idx(row, br, col);
                        *(U2*)q = (U2){pack2(v0[0], v0[1]), pack2(v0[2], v0[3])}; *(U2*)(q + 64) = (U2){pack2(v1[0], v1[1]), pack2(v1[2], v1[3])}; }
            } else if (dT) {
#pragma unroll
                for (int ai = 0; ai < 2; ++ai)
#pragma unroll
                    for (int m = 0; m < 4; ++m) { const int row = u.pm * BM + ai * HALF + wr * 64 + m * 16 + fr; int b, key; tok_bk(row, b, key);
                        st_tr(dT + ((long)b * ncT + cl + wc * 32 + 8 * fq) * KEYS, key, acc[ai][bj][m][0], acc[ai][bj][m][1]); }
            } else if (gab) {
                float* GAB = GPTR(float, ws + OFF_GAB);
#pragma unroll
                for (int ai = 0; ai < 2; ++ai)
#pragma unroll
                    for (int m = 0; m < 4; ++m) { const long row = (long)u.pm * BM + ai * HALF + wr * 64 + m * 16 + fr;
                        const f32x4 v0 = acc[ai][bj][m][0], v1 = acc[ai][bj][m][1];
                        *(F4*)(GAB + row * 32 + 8 * fq) = (F4){v0[0], v0[1], v0[2], v0[3]}; *(F4*)(GAB + row * 32 + 8 * fq + 4) = (F4){v1[0], v1[1], v1[2], v1[3]}; }
            }
        }
    }
};
}

#ifdef CPU_EMU
#define WSP(T, off) GPTR(T, p.ws + (off))
#else
typedef __attribute__((address_space(1))) char* gchar_p;
__device__ __forceinline__ gchar_p ws_opaque(char* w) { gchar_p g = (gchar_p)w; asm volatile("" : "+s"(g)); return g; }
#define WSP(T, off) ((T*)(__attribute__((address_space(1))) T*)(ws_opaque(p.ws) + (off)))
#endif
constexpr float DN_ALPHA_F =
#ifdef SMALL_DIMS
    1.4142135623730951f;
#else
    1.681792830507429f;
#endif

__device__ __forceinline__ void phase_prologue(const Params& p, char* lds) {
    const int tid = TID(), G = gridDim.x, bid = BID();
    { float* RWT = WSP(float, OFF_RWT); for (int i = bid * NTH + tid; i < D * 16; i += G * NTH) RWT[(i & 15) * D + (i >> 4)] = GIN(p.router_w)[i]; }
    float* sc = (float*)lds;
    for (int i = tid; i < 3 * D; i += NTH) { int r = i / D, k = i - r * D; float v = r < 2 ? GIN(p.c)[r * D + k] : GIN(p.c_ctx)[k]; sc[i] = siluf(v); }
    __syncthreads();
    float* MODP = WSP(float, OFF_MODP);
    constexpr int NCHK = 6 * D / NTH, KS = D / 8;
    for (int it = bid; it < DEPTH * 8 * NCHK; it += G) {
        int l = it / (8 * NCHK), rem = it - l * 8 * NCHK, s = rem / NCHK, ch = rem - s * NCHK;
        int n = ch * NTH + tid; const float* w = GIN(p.w_mod) + ((long)l * D + s * KS) * 6 * D + n;
        float a0 = 0.f, a1 = 0.f, a2 = 0.f;
#pragma unroll 8
        for (int k = 0; k < KS; ++k) { float wv = w[(long)k * 6 * D]; a0 += sc[s * KS + k] * wv; a1 += sc[D + s * KS + k] * wv; a2 += sc[2 * D + s * KS + k] * wv; }
        float* o = MODP + (((long)l * 8 + s) * 3) * 6 * D + n; o[0] = a0; o[6 * D] = a1; o[12 * D] = a2;
    }
}

constexpr int U_WIN = (NPROJ / 64) * (D / 64), U_BP = 4 * (MW / 64) * (D / 64), U_WO = (D / 64) * (D / 64), U_CVT = U_WIN + U_BP + U_WO;
__device__ __forceinline__ void cvt_unit(const Params& p, char* lds, int l, int u) {
    if (u < U_WIN) { int nt = u / (D / 64), kt = u - nt * (D / 64); const float* src = GIN(p.w_in) + (long)l * D * IN_TOTAL;
        auto sp = [&](int k, int n) -> const float* { int sc;
            if (n < MY_DQKV) sc = n; else if (n < MY_GAB) sc = n + 4 * GH; else if (n < MY_GATE) { int j = n - MY_GAB; if (j >= 4 * GH) return nullptr; sc = SRC_GA + j; } else sc = SRC_GATE + (n - MY_GATE);
            return src + (long)k * IN_TOTAL + sc; };
        cvt_tile(lds, sp, kt * 64, nt * 64, WSP(bf16_t, off_win(l)), D);
    } else if (u < U_WIN + U_BP) { int v = u - U_WIN; int m = v / ((MW / 64) * (D / 64)), r = v - m * ((MW / 64) * (D / 64)), nt = r / (MW / 64), kt = r - nt * (MW / 64);
        const float* src = GIN(p.branch_proj) + ((long)(l * 4 + m) * MW) * D;
        auto sp = [&](int k, int n) -> const float* { return src + (long)k * D + n; };
        cvt_tile(lds, sp, kt * 64, nt * 64, WSP(bf16_t, off_bp(l)) + m * MW, 4 * MW);
    } else { int v = u - U_WIN - U_BP; int nt = v / (D / 64), kt = v - nt * (D / 64); const float* src = GIN(p.w_out) + (long)l * D * D;
        auto sp = [&](int k, int n) -> const float* { return src + (long)k * D + n; };
        cvt_tile(lds, sp, kt * 64, nt * 64, WSP(bf16_t, off_wo(l)), D);
    }
}
__device__ __forceinline__ void w3t_chunk(const Params& p, int l, int i0, int n) {
    const int tid = TID(); bf16_t* W3T = WSP(bf16_t, OFF_W3T); const float* w3 = GIN(p.hy_w3) + (long)l * 64 * 4 * HYW;
    for (int i = i0 + tid; i < i0 + n; i += NTH) { const int col = i >> 7, k = i & 127; W3T[i] = k < 64 ? f2bf(w3[(long)k * 4 * HYW + col]) : (bf16_t)0; }
}
__device__ __forceinline__ void h2f_positions(const Params& p, int l, int pos0, int iters) {
    const int tid = TID(), lane = tid & 63, wid = tid >> 6;
    float* H2F = WSP(float, OFF_H2F); bf16_t* H2B = WSP(bf16_t, OFF_H2B);
    const float* w1 = GIN(p.hy_w1) + (long)l * HY_EMB * 64; const float* b1 = GIN(p.hy_b1) + l * 64; const float* w2 = GIN(p.hy_w2) + (long)l * 64 * 64; const float* b2 = GIN(p.hy_b2) + l * 64; const float fr = GIN(p.hy_freq)[l * 64 + lane];
    for (int it = 0; it < iters; ++it) { const int pos = pos0 + it * 8 + wid; if (pos >= KEYS) break;
        int L = pos < SEQ ? SEQ : CTX, t = pos < SEQ ? pos : pos - SEQ;
        float feat = 0.f;
        if (lane == 0) feat = (float)t / (float)(L - 1);
        else if (lane < 33) { int bi = (lane - 1) & 15; float band = 1e-4f + (float)bi * ((15.0f - 1e-4f) / 15.0f); float ang = 6.283185307179586f * (float)t / (float)L; float a = band * ang;
            feat = lane < 17 ? cosf(a) : -sinf(a); }
        float a1 = b1[lane];
        for (int e = 0; e < HY_EMB; ++e) a1 += __shfl(feat, e) * w1[e * 64 + lane];
        float h1 = sinf(fr * a1);
        float a2 = b2[lane];
        for (int i = 0; i < 64; ++i) a2 += __shfl(h1, i) * w2[i * 64 + lane];
        const float hv = sinf(fr * a2); H2F[(long)pos * 64 + lane] = hv; H2B[(long)pos * 128 + lane] = f2bf(hv); H2B[(long)pos * 128 + 64 + lane] = 0; }
}
__device__ __forceinline__ void phase_weights(const Params& p, char* lds, int l) {
    const int tid = TID(), G = gridDim.x, bid = BID();
    { const float* MODP = WSP(float, OFF_MODP); float* MOD = WSP(float, OFF_MOD);
        for (int i = bid * NTH + tid; i < DEPTH * 3 * 6 * D; i += G * NTH) { int ll = i / (18 * D), rem = i - ll * 18 * D, n = rem % (6 * D);
            float a = GIN(p.b_mod)[ll * 6 * D + n];
#pragma unroll
            for (int s = 0; s < 8; ++s) a += MODP[((long)ll * 8 + s) * 18 * D + rem];
            MOD[i] = a; } }
    if (bid == 0 && tid < 64) WSP(u32, OFF_CNT)[64 + tid] = 0u;
    for (int u = bid; u < U_CVT; u += G) cvt_unit(p, lds, l, u);
    for (int c = bid; c < (4 * HYW * 128 + 8191) / 8192; c += G) w3t_chunk(p, l, c * 8192, 8192);
    for (int c = bid; c < (KEYS + 63) / 64; c += G) h2f_positions(p, l, c * 64, 8);
}

__device__ __forceinline__ void phase_expert_weights(const Params& p, char* lds, int l, int bid, int G) {
    constexpr int U13 = (2 * EFF / 64) * (D / 64), U2_ = (D / 64) * (EFF / 64);
    for (int u = bid < 0 ? NE * (U13 + U2_) : bid; u < NE * (U13 + U2_); u += G) {
        int e = u / (U13 + U2_), v = u - e * (U13 + U2_);
        if (v < U13) { int nt = v / (D / 64), kt = v - nt * (D / 64);
            const float* s1 = GIN(p.exp_w1) + ((long)(l * NE + e) * D) * EFF; const float* s3 = GIN(p.exp_w3) + ((long)(l * NE + e) * D) * EFF;
            const long d13 = (long)((uintptr_t)s1 - (uintptr_t)s3);
            auto sp = [&](int k, int n) -> const float* { int grp = n >> 5, w = n & 31; return (const float*)((uintptr_t)s3 + (uintptr_t)(w < 16 ? d13 : 0L)) + (long)k * EFF + grp * 16 + (w & 15); };
            cvt_tile(lds, sp, kt * 64, nt * 64, WSP(bf16_t, OFF_W13) + (long)e * 2 * EFF * D, D);
        } else { int w = v - U13; int nt = w / (EFF / 64), kt = w - nt * (EFF / 64); const float* s2 = GIN(p.exp_w2) + ((long)(l * NE + e) * EFF) * D;
            auto sp = [&](int k, int n) -> const float* { return s2 + (long)k * D + n; };
            cvt_tile(lds, sp, kt * 64, nt * 64, WSP(bf16_t, OFF_W2) + (long)e * D * EFF, EFF);
        }
    }
}

constexpr int RV = D / 256;
__device__ __forceinline__ void row_stats(const F4 (&v)[RV], float& mean, float& rstd) {
    float s = 0.f;
#pragma unroll
    for (int i = 0; i < RV; ++i) s += (v[i].x + v[i].y) + (v[i].z + v[i].w);
    mean = wave_sum(s) * (1.0f / D);
    float q = 0.f;
#pragma unroll
    for (int i = 0; i < RV; ++i) { float a = v[i].x - mean, b = v[i].y - mean, c = v[i].z - mean, d = v[i].w - mean; q += (a * a + b * b) + (c * c + d * d); }
    rstd = rsqrtf(wave_sum(q) * (1.0f / D) + LN_EPS);
}
__device__ __forceinline__ void row_stats2(const F4 (&v)[2][RV], float (&mean)[2], float (&rstd)[2]) {
    float s0 = 0.f, s1 = 0.f;
#pragma unroll
    for (int i = 0; i < RV; ++i) { s0 += (v[0][i].x + v[0][i].y) + (v[0][i].z + v[0][i].w); s1 += (v[1][i].x + v[1][i].y) + (v[1][i].z + v[1][i].w); }
    s0 = xadd<32>(s0); s1 = xadd<32>(s1); s0 = xadd<16>(s0); s1 = xadd<16>(s1); s0 = xadd<8>(s0); s1 = xadd<8>(s1); s0 = xadd<4>(s0); s1 = xadd<4>(s1); s0 = xadd<2>(s0); s1 = xadd<2>(s1); s0 = xadd<1>(s0); s1 = xadd<1>(s1);
    mean[0] = s0 * (1.0f / D); mean[1] = s1 * (1.0f / D);
    float q0 = 0.f, q1 = 0.f;
#pragma unroll
    for (int i = 0; i < RV; ++i) { float a = v[0][i].x - mean[0], b = v[0][i].y - mean[0], c = v[0][i].z - mean[0], d = v[0][i].w - mean[0]; q0 += (a * a + b * b) + (c * c + d * d);
        a = v[1][i].x - mean[1]; b = v[1][i].y - mean[1]; c = v[1][i].z - mean[1]; d = v[1][i].w - mean[1]; q1 += (a * a + b * b) + (c * c + d * d); }
    q0 = xadd<32>(q0); q1 = xadd<32>(q1); q0 = xadd<16>(q0); q1 = xadd<16>(q1); q0 = xadd<8>(q0); q1 = xadd<8>(q1); q0 = xadd<4>(q0); q1 = xadd<4>(q1); q0 = xadd<2>(q0); q1 = xadd<2>(q1); q0 = xadd<1>(q0); q1 = xadd<1>(q1);
    rstd[0] = rsqrtf(q0 * (1.0f / D) + LN_EPS); rstd[1] = rsqrtf(q1 * (1.0f / D) + LN_EPS);
}
__device__ __forceinline__ void row_modulate_store(const F4 (&v)[RV], float mean, float rstd, const float* shift, const float* scale, bf16_t* dst, int lane, F4 (*keep)[RV] = nullptr) {
#pragma unroll
    for (int i = 0; i < RV; ++i) { int n = (i * 64 + lane) * 4; F4 sh = *(const F4*)(shift + n), sc = *(const F4*)(scale + n);
        F4 h; h.x = (v[i].x - mean) * rstd * (1.0f + sc.x) + sh.x; h.y = (v[i].y - mean) * rstd * (1.0f + sc.y) + sh.y; h.z = (v[i].z - mean) * rstd * (1.0f + sc.z) + sh.z; h.w = (v[i].w - mean) * rstd * (1.0f + sc.w) + sh.w;
        U2 o; o.x = pack2(h.x, h.y); o.y = pack2(h.z, h.w); *(U2*)(dst + n) = o; if (keep) (*keep)[i] = h; }
}

__device__ __forceinline__ const float* xs_row(const Params& p, int l, int row) {
    const uintptr_t a = (uintptr_t)(WSP(float, OFF_XS) + (long)row * D);
    const uintptr_t b = row < NLAT ? (uintptr_t)(GIN(p.x) + (long)row * D) : (uintptr_t)(GIN(p.ctx) + (long)(row - NLAT) * D);
    return (const float*)(l == 0 ? b : a);
}
__device__ __forceinline__ void phase_modulate0(const Params& p, int l) {
    const int tid = TID(), lane = tid & 63, wid = tid >> 6;
    const float* XS = WSP(float, OFF_XS); bf16_t* H = WSP(bf16_t, OFF_H); const float* MOD = WSP(float, OFF_MOD) + (long)l * 18 * D;
    for (int row = BID() * 8 + wid; row < NTOK; row += gridDim.x * 8) {
        F4 v[RV]; const float* xr = xs_row(p, l, row);
#pragma unroll
        for (int i = 0; i < RV; ++i) v[i] = *(const F4*)(xr + (i * 64 + lane) * 4);
        float mean, rstd; row_stats(v, mean, rstd);
        const float* m = MOD + mod_row(row) * 6 * D;
        row_modulate_store(v, mean, rstd, m, m + D, H + (long)row * D, lane);
    }
}

__device__ __forceinline__ void phase_post_mix(const Params& p, char* lds, int l, bool dry = false) {
    const int tid = TID(), lane = tid & 63, wid = tid >> 6;
    float* XS = WSP(float, OFF_XS); const bf16_t* MIX = WSP(bf16_t, OFF_MIX); bf16_t* H = WSP(bf16_t, OFF_H); const float* MOD = WSP(float, OFF_MOD) + (long)l * 18 * D;
    const float* lng = GIN(p.ln_g) + (long)(l * 2 + 0) * D; const float* lnb = GIN(p.ln_b) + (long)(l * 2 + 0) * D;
    u32* CNT = WSP(u32, OFF_CNT) + (dry ? 128 : 0); float* XSO = dry ? WSP(float, OFF_YE) : XS; int* TOKE = WSP(int, OFF_TOKE); int* TOKR = WSP(int, OFF_TOKR); float* TOKW = WSP(float, OFF_TOKW); int* ELIST = WSP(int, OFF_ELIST);
    const int nrows = (l == DEPTH - 1) ? NLAT : NTOK;
    float* rwT = (float*)lds; u32* lcnt = (u32*)(lds + 16 * D * 4); u32* lbase = lcnt + 16;
    __syncthreads();
    for (int i = tid; i < D * 16; i += NTH) rwT[(i & 15) * D + (i >> 4)] = GIN(p.router_w)[i];
    if (tid < 16) lcnt[tid] = 0u;
    __syncthreads();
    for (int row = BID() * 8 + wid; row < nrows; row += gridDim.x * 8) {
        const float* m = MOD + mod_row(row) * 6 * D; const float* xr = xs_row(p, l, row);
        F4 v[RV];
#pragma unroll
        for (int i = 0; i < RV; ++i) { int n = (i * 64 + lane) * 4; F4 x = *(const F4*)(xr + n), g2 = *(const F4*)(m + 2 * D + n); const U2 mxp = *(const U2*)(MIX + (long)row * D + n); const F4 mx = (F4){bflo(mxp.x), bfhi(mxp.x), bflo(mxp.y), bfhi(mxp.y)};
            v[i].x = fmaf(g2.x, mx.x, DN_ALPHA_F * x.x); v[i].y = fmaf(g2.y, mx.y, DN_ALPHA_F * x.y); v[i].z = fmaf(g2.z, mx.z, DN_ALPHA_F * x.z); v[i].w = fmaf(g2.w, mx.w, DN_ALPHA_F * x.w); }
        float mean, rstd; row_stats(v, mean, rstd);
#pragma unroll
        for (int i = 0; i < RV; ++i) { int n = (i * 64 + lane) * 4; F4 g = *(const F4*)(lng + n), b = *(const F4*)(lnb + n);
            v[i].x = (v[i].x - mean) * rstd * g.x + b.x; v[i].y = (v[i].y - mean) * rstd * g.y + b.y; v[i].z = (v[i].z - mean) * rstd * g.z + b.z; v[i].w = (v[i].w - mean) * rstd * g.w + b.w;
            *(F4*)(XSO + (long)row * D + n) = v[i]; }
        row_stats(v, mean, rstd);
        F4 h[RV];
        row_modulate_store(v, mean, rstd, m + 3 * D, m + 4 * D, H + (long)row * D, lane, &h);
        float lg[16];
#pragma unroll
        for (int e = 0; e < 16; ++e) lg[e] = 0.f;
        { const float* wp = rwT + lane * 4;
#pragma unroll
            for (int i = 0; i < RV; ++i)
#pragma unroll
                for (int eg = 0; eg < 4; ++eg) {
#pragma unroll
                    for (int e = eg * 4; e < eg * 4 + 4; ++e) { const F4 w = *(const F4*)(wp + e * D + i * 256); lg[e] += (h[i].x * w.x + h[i].y * w.y) + (h[i].z * w.z + h[i].w * w.w); }
#ifndef CPU_EMU
                    { int z; asm volatile("v_mov_b32 %0, 0" : "=v"(z) : "v"(lg[eg * 4 + 3])); wp += z; }
#endif
                } }
        float s[16], sel[16];
#pragma unroll
        for (int e = 0; e < 16; ++e) { lg[e] = wave_sum(lg[e]); s[e] = sigmoidf(lg[e]); sel[e] = s[e] + GIN(p.router_b)[e]; }
        float gs[4];
#pragma unroll
        for (int gq = 0; gq < 4; ++gq) { float a = sel[gq * 4], b = sel[gq * 4 + 1], c = sel[gq * 4 + 2], d = sel[gq * 4 + 3];
            float m1 = fmaxf(fmaxf(a, b), fmaxf(c, d)); float lo_ab = fminf(a, b), hi_ab = fmaxf(a, b), lo_cd = fminf(c, d), hi_cd = fmaxf(c, d);
            float m2 = fmaxf(fminf(hi_ab, hi_cd), fmaxf(lo_ab, lo_cd)); gs[gq] = m1 + m2; }
        int bg = 0; float bv = gs[0];
#pragma unroll
        for (int gq = 1; gq < 4; ++gq) if (gs[gq] > bv) { bv = gs[gq]; bg = gq; }
        float c0 = 0.f, c1 = 0.f, c2 = 0.f, c3 = 0.f, t0 = 0.f, t1 = 0.f, t2 = 0.f, t3 = 0.f;
#pragma unroll
        for (int gq = 0; gq < 4; ++gq) if (gq == bg) { c0 = sel[gq * 4]; c1 = sel[gq * 4 + 1]; c2 = sel[gq * 4 + 2]; c3 = sel[gq * 4 + 3]; t0 = s[gq * 4]; t1 = s[gq * 4 + 1]; t2 = s[gq * 4 + 2]; t3 = s[gq * 4 + 3]; }
        int i0 = 0; float v0 = c0, w0 = t0;
        if (c1 > v0) { v0 = c1; i0 = 1; w0 = t1; } if (c2 > v0) { v0 = c2; i0 = 2; w0 = t2; } if (c3 > v0) { v0 = c3; i0 = 3; w0 = t3; }
        int i1 = -1; float v1 = -3.0e38f, w1 = 0.f;
        if (i0 != 0 && c0 > v1) { v1 = c0; i1 = 0; w1 = t0; } if (i0 != 1 && c1 > v1) { v1 = c1; i1 = 1; w1 = t1; } if (i0 != 2 && c2 > v1) { v1 = c2; i1 = 2; w1 = t2; } if (i0 != 3 && c3 > v1) { v1 = c3; i1 = 3; w1 = t3; }
        if (lane == 0) { float ws = w0 + w1; int e0 = bg * 4 + i0, e1 = bg * 4 + i1;
            int r0 = (int)atomicAdd(&lcnt[e0], 1u), r1 = (int)atomicAdd(&lcnt[e1], 1u);
            TOKE[row * 2] = e0; TOKE[row * 2 + 1] = e1; TOKR[row * 2] = r0; TOKR[row * 2 + 1] = r1; TOKW[row * 2] = w0 / ws; TOKW[row * 2 + 1] = w1 / ws; }
    }
    __syncthreads();
    if (tid < 16) lbase[tid] = lcnt[tid] ? atomicAdd(&CNT[tid], lcnt[tid]) : 0u;
    __syncthreads();
    if (tid < 16) for (int row0 = BID() * 8; row0 < nrows; row0 += (int)gridDim.x * 8) { const int row = row0 + (tid >> 1), k = tid & 1;
        const int e = TOKE[row * 2 + k]; const int r = TOKR[row * 2 + k] + (int)lbase[e]; TOKR[row * 2 + k] = r; ELIST[(long)e * NTOK + r] = row; }
}

__device__ __forceinline__ void phase_post_moe(const Params& p, int l, bool dry = false) {
    const int tid = TID(), lane = tid & 63, wid = tid >> 6;
    float* XS = WSP(float, OFF_XS); bf16_t* H = WSP(bf16_t, OFF_H); const float* MOD = WSP(float, OFF_MOD) + (long)l * 18 * D;
    const bf16_t* YE = WSP(bf16_t, OFF_YE);
    const float* lng = GIN(p.ln_g) + (long)(l * 2 + 1) * D; const float* lnb = GIN(p.ln_b) + (long)(l * 2 + 1) * D;
    const u32* CNT = WSP(u32, OFF_CNT); const int* TOKE = WSP(int, OFF_TOKE); const int* TOKR = WSP(int, OFF_TOKR); const float* TOKW = WSP(float, OFF_TOKW);
    const bool last = (l == DEPTH - 1);
    const int nrows = last ? NLAT : NTOK;
    int eoff = 0;
    { int c = lane < 16 ? (int)CNT[lane] : 0; int incl = c;
        for (int o = 1; o < 16; o <<= 1) { int t = __shfl_up(incl, o); if (lane >= o) incl += t; }
        eoff = incl - c; }
    const int stride = (int)gridDim.x * 8;
    for (int row0 = BID() * 8 + wid; row0 < nrows; row0 += 2 * stride) {
        const bool two = row0 + stride < nrows;
        int rowv[2] = {row0, two ? row0 + stride : row0};
        F4 v[2][RV]; const float* mm[2];
#pragma unroll
        for (int q = 0; q < 2; ++q) { const int row = rowv[q]; mm[q] = MOD + mod_row(row) * 6 * D;
            const int e0 = TOKE[row * 2], e1 = TOKE[row * 2 + 1];
            const long p0 = (long)__shfl(eoff, e0) + TOKR[row * 2], p1 = (long)__shfl(eoff, e1) + TOKR[row * 2 + 1];
            const float w0 = TOKW[row * 2], w1 = TOKW[row * 2 + 1];
#pragma unroll
            for (int i = 0; i < RV; ++i) { int n = (i * 64 + lane) * 4; F4 x = *(const F4*)(XS + (long)row * D + n), g5 = *(const F4*)(mm[q] + 5 * D + n);
                U2 a = *(const U2*)(YE + p0 * D + n), b = *(const U2*)(YE + p1 * D + n);
                float y0 = w0 * bflo(a.x) + w1 * bflo(b.x), y1 = w0 * bfhi(a.x) + w1 * bfhi(b.x), y2 = w0 * bflo(a.y) + w1 * bflo(b.y), y3 = w0 * bfhi(a.y) + w1 * bfhi(b.y);
                v[q][i].x = fmaf(g5.x, y0, DN_ALPHA_F * x.x); v[q][i].y = fmaf(g5.y, y1, DN_ALPHA_F * x.y); v[q][i].z = fmaf(g5.z, y2, DN_ALPHA_F * x.z); v[q][i].w = fmaf(g5.w, y3, DN_ALPHA_F * x.w); } }
        float mean[2], rstd[2]; row_stats2(v, mean, rstd);
#pragma unroll
        for (int q = 0; q < 2; ++q) { if (q == 1 && !two) break; const int row = rowv[q];
            float* dst = dry ? WSP(float, OFF_MIX) + (long)row * D : (last ? GPTR(float, p.out) + (long)row * D : XS + (long)row * D);
#pragma unroll
            for (int i = 0; i < RV; ++i) { int n = (i * 64 + lane) * 4; F4 g = *(const F4*)(lng + n), b = *(const F4*)(lnb + n);
                v[q][i].x = (v[q][i].x - mean[q]) * rstd[q] * g.x + b.x; v[q][i].y = (v[q][i].y - mean[q]) * rstd[q] * g.y + b.y; v[q][i].z = (v[q][i].z - mean[q]) * rstd[q] * g.z + b.z; v[q][i].w = (v[q][i].w - mean[q]) * rstd[q] * g.w + b.w;
                *(F4*)(dst + n) = v[q][i]; } }
        if (!last) { row_stats2(v, mean, rstd);
#pragma unroll
            for (int q = 0; q < 2; ++q) { if (q == 1 && !two) break; const float* m2 = mm[q] + 18 * D; row_modulate_store(v[q], mean[q], rstd[q], m2, m2 + D, H + (long)rowv[q] * D, lane); } }
    }
}
__device__ __forceinline__ void st4bf(bf16_t* dst, f32x4 v) { U2 o; o.x = pack2(v[0], v[1]); o.y = pack2(v[2], v[3]); *(U2*)dst = o; }

__device__ __forceinline__ void phase_inproj(const Params& p, char* lds, int l, int part  ) {
    pg8::Gemm g; g.A = WSP(bf16_t, OFF_H); g.Bt = WSP(bf16_t, off_win(l)) + (long)(part == 0 ? 0 : NPROJ1) * D; g.M = NTOK; g.N = part == 0 ? NPROJ1 : 4 * D; g.K = D;
    pg8::StaticOrder S; S.init(g.M, g.N, (int)gridDim.x, BID());
    pg8::EpiInproj E; E.ws = p.ws; E.ncol0 = part == 0 ? 0 : NPROJ1;
    __syncthreads();
    pg8::gemm_phase<pg8::EpiInproj, pg8::StaticOrder, false>((PG8_LAS unsigned char*)lds, g, S, E, nullptr);
    __syncthreads();
    if (part == 1) {
        const int G = (int)gridDim.x, rem = S.nwg % G, c = BID();
        for (int rep_ = 0; rep_ < REP_W; ++rep_) phase_expert_weights(p, lds, l, rem == 0 ? c : c - rem, rem == 0 ? G : G - rem);
    }
}

__device__ __forceinline__ void phase_prep(const Params& p, char* lds, int l, bool do_rope = true, bool do_c = true, bool do_d = true) {
    const int tid = TID(), G = gridDim.x, bid = BID(), lane = tid & 63, wid = tid >> 6;
    if (bid == 0 && tid < 64) { WSP(u32, OFF_CNT)[tid] = 0u; WSP(u32, OFF_CNT)[128 + tid] = 0u; }
    if (do_rope) {
        bf16_t* DQ = WSP(bf16_t, OFF_SEG_DQKV);
        constexpr int NV = 4 * DH;
        for (long i = (long)bid * NTH + tid; i < (long)NLAT * 32; i += (long)G * NTH) {
            int tok = (int)(i >> 5), f2 = (int)(i & 31);
            int t = tok % SEQ; int axis = f2 >> 4, f = f2 & 15;
            float pos = axis == 0 ? (float)(t / GW) : (float)(t % GW);
            float inv = powf(10000.0f, -(float)f / 16.0f);
            float ang = pos * inv, sn = sinf(ang), cs = cosf(ang);
            bf16_t* base = DQ + (long)tok * 3 * MW + axis * 32 + f;
#pragma unroll
            for (int v = 0; v < NV; ++v) { bf16_t* q = base + v * 64; const float qs = v < 2 * DH ? 0.125f * 1.4426950408889634f : 1.0f;
                float x1 = bf2f(q[0]), x2 = bf2f(q[16]); q[0] = f2bf((x1 * cs - x2 * sn) * qs); q[16] = f2bf((x1 * sn + x2 * cs) * qs); }
        }
    }
    if (do_c) {
        const bf16_t* SG = WSP(bf16_t, OFF_SEG_GQKV); bf16_t* GQ = WSP(bf16_t, OFF_GQ); bf16_t* GK = WSP(bf16_t, OFF_GK); bf16_t* GV = WSP(bf16_t, OFF_GV);
        const float* cwp = GIN(p.gdn_conv) + (long)l * 3 * MW * 3;
        const int sub = tid & 7;
        for (long i = ((long)bid * NTH + tid) >> 3; i < (long)NTOK * GH; i += ((long)G * NTH) >> 3) {
            const int tok = (int)(i / GH), h = (int)(i - (long)tok * GH);
            int seq0, len; if (tok < NLAT) { seq0 = (tok / SEQ) * SEQ; len = SEQ; } else { seq0 = NLAT + ((tok - NLAT) / CTX) * CTX; len = CTX; }
            const int t = tok - seq0; const bool hasp = t > 0, hasn = t + 1 < len;
            float u[3][8];
#pragma unroll
            for (int part = 0; part < 3; ++part) { const int c = part * MW + h * 64 + sub * 8; const bf16_t* s = SG + (long)tok * 3 * MW + c;
                const U4 x1 = *(const U4*)s; const U4 x0 = hasp ? *(const U4*)(s - 3 * MW) : (U4){0u, 0u, 0u, 0u}; const U4 x2 = hasn ? *(const U4*)(s + 3 * MW) : (U4){0u, 0u, 0u, 0u};
                const u32 a0[4] = {x0.x, x0.y, x0.z, x0.w}, a1[4] = {x1.x, x1.y, x1.z, x1.w}, a2[4] = {x2.x, x2.y, x2.z, x2.w};
                float w[24];
#pragma unroll
                for (int q = 0; q < 6; ++q) { const F4 wv = *(const F4*)(cwp + c * 3 + q * 4); w[q * 4] = wv.x; w[q * 4 + 1] = wv.y; w[q * 4 + 2] = wv.z; w[q * 4 + 3] = wv.w; }
#pragma unroll
                for (int e = 0; e < 4; ++e) {
                    float lo = bflo(a0[e]) * w[(2 * e) * 3] + bflo(a1[e]) * w[(2 * e) * 3 + 1] + bflo(a2[e]) * w[(2 * e) * 3 + 2];
                    float hi = bfhi(a0[e]) * w[(2 * e + 1) * 3] + bfhi(a1[e]) * w[(2 * e + 1) * 3 + 1] + bfhi(a2[e]) * w[(2 * e + 1) * 3 + 2];
                    u[part][2 * e] = siluf(lo); u[part][2 * e + 1] = siluf(hi); } }
            float nq = 0.f, nk = 0.f;
#pragma unroll
            for (int e = 0; e < 8; ++e) { nq += u[0][e] * u[0][e]; nk += u[1][e] * u[1][e]; }
            nq = xadd<1>(nq); nq = xadd<2>(nq); nq = xadd<4>(nq);
            nk = xadd<1>(nk); nk = xadd<2>(nk); nk = xadd<4>(nk);
            const float rq = rsqrtf(nq + RMS_EPS) * 0.125f, rk = rsqrtf(nk + RMS_EPS);
            const long o = (long)tok * MW + h * 64 + sub * 8;
            *(U4*)(GQ + o) = (U4){pack2(u[0][0] * rq, u[0][1] * rq), pack2(u[0][2] * rq, u[0][3] * rq), pack2(u[0][4] * rq, u[0][5] * rq), pack2(u[0][6] * rq, u[0][7] * rq)};
            *(U4*)(GK + o) = (U4){pack2(u[1][0] * rk, u[1][1] * rk), pack2(u[1][2] * rk, u[1][3] * rk), pack2(u[1][4] * rk, u[1][5] * rk), pack2(u[1][6] * rk, u[1][7] * rk)};
            *(U4*)(GV + o) = (U4){pack2(u[2][0], u[2][1]), pack2(u[2][2], u[2][3]), pack2(u[2][4], u[2][5]), pack2(u[2][6], u[2][7])};
        }
        const float* GAB = WSP(float, OFF_GAB); float* GB = WSP(float, OFF_GB);
        for (long i = (long)bid * NTH + tid; i < (long)NTOK * 2 * GH; i += (long)G * NTH) {
            int tok = (int)(i / (2 * GH)), dh = (int)(i - (long)tok * 2 * GH);
            float a = GAB[(long)tok * 32 + dh], b = GAB[(long)tok * 32 + 2 * GH + dh];
            float xa = a + GIN(p.gdn_dt_bias)[l * 2 * GH + dh]; float sp = xa > 20.f ? xa : log1pf(__expf(xa));
            GB[(long)tok * 4 * GH + dh] = -__expf(GIN(p.gdn_a_log)[l * 2 * GH + dh]) * sp;
            GB[(long)tok * 4 * GH + 2 * GH + dh] = sigmoidf(b);
        }
    }
    if (do_d) {
        const bf16_t* H2B = WSP(bf16_t, OFF_H2B); const bf16_t* W3T = WSP(bf16_t, OFF_W3T); bf16_t* TAPS = WSP(bf16_t, OFF_TAPS);
        const int wid = tid >> 6, wm = wid >> 1, wn = wid & 1, l15 = lane & 15, g = lane >> 4;
        constexpr int MT = 3, ntm = KEYS / (64 * MT), ntn = 4 * HYW / G_BN;
        for (int u = bid; u < ntm * ntn; u += G) {
            const int tn = u / ntm, tm = u - tn * ntm, row0 = tm * 64 * MT, col0 = tn * G_BN;
            f32x4 acc[MT][4];
            gemm_tile<MT>(lds, [&](int r) { return H2B + (long)(row0 + r) * 128; }, W3T + (long)col0 * 128, 128, 128, acc);
#pragma unroll
            for (int n = 0; n < 4; ++n) { const int colb = col0 + wn * 64 + n * 16 + g * 4;
                const F4 dl4 = *(const F4*)(GIN(p.hy_deltas) + (long)l * 4 * HYW + colb); const float dl[4] = {fabsf(dl4.x), fabsf(dl4.y), fabsf(dl4.z), fabsf(dl4.w)};
#pragma unroll
                for (int m = 0; m < MT; ++m) { const int pos = row0 + wm * 16 * MT + m * 16 + l15; const bool ctxp = pos >= SEQ; const int L = ctxp ? CTX : SEQ, t = ctxp ? pos - SEQ : pos;
                    const float tl = (float)t * (1.0f / (float)(L - 1));
#pragma unroll
                    for (int j = 0; j < 4; ++j) TAPS[(long)(colb + j) * KEYS + pos] = f2bf(acc[m][n][j] * (__expf(-tl * dl[j]) + 0.05f)); } }
        }
    }
}
constexpr int A_LD = 72, AK_LD = 80;
template <int DV> struct AttnLds { static constexpr int K_BYTES = 64 * AK_LD * 2, V_BYTES = DV * A_LD * 2, STAGE = K_BYTES + V_BYTES, TOTAL = 2 * STAGE; };
constexpr float LOG2E = 1.4426950408889634f;
constexpr float NEG_BIG = -1.0e30f;

template <int NQT, int DV, class QRow, class KTile, class MaskFn>
__device__ __forceinline__ void attn_core(char* lds, QRow qrow  , KTile ktile  ,
                                          int ntiles, MaskFn mask  , f32x4 (&oacc)[DV / 16][NQT], float (&lsum)[NQT]) {
    const int tid = TID(), wid = tid >> 6, lane = tid & 63, l15 = lane & 15, g = lane >> 4;
    constexpr int NDT = DV / 16, NVL = DV / 64;
    typedef AttnLds<DV> L;
    bf16x8 qf[NQT][2];
#pragma unroll
    for (int qt = 0; qt < NQT; ++qt) { const bf16_t* q = qrow(wid * NQT * 16 + qt * 16 + l15);
#pragma unroll
        for (int ks = 0; ks < 2; ++ks) qf[qt][ks] = ld8(q + ks * 32 + g * 8); }
    float mrun[NQT];
#pragma unroll
    for (int qt = 0; qt < NQT; ++qt) { mrun[qt] = NEG_BIG; lsum[qt] = 0.f;
#pragma unroll
        for (int dt = 0; dt < NDT; ++dt) oacc[dt][qt] = (f32x4){0.f, 0.f, 0.f, 0.f}; }
    const int sr = tid >> 3, ss = tid & 7;
    U4 rk, rv[NVL];
    { const bf16_t *kp, *vp; long kld, vld; ktile(0, kp, kld, vp, vld);
        rk = *(const U4*)(kp + (long)sr * kld + ss * 8);
#pragma unroll
        for (int i = 0; i < NVL; ++i) rv[i] = *(const U4*)(vp + (long)(sr + 64 * i) * vld + ss * 8); }
    __syncthreads();
    { bf16_t* sK = (bf16_t*)lds; bf16_t* sV = (bf16_t*)(lds + L::K_BYTES);
        *(U4*)(sK + sr * AK_LD + ss * 8) = rk;
#pragma unroll
        for (int i = 0; i < NVL; ++i) *(U4*)(sV + (sr + 64 * i) * A_LD + ss * 8) = rv[i]; }
    __syncthreads();
    for (int t = 0; t < ntiles; ++t) {
        const bool more = t + 1 < ntiles;
        if (more) { const bf16_t *kp, *vp; long kld, vld; ktile(t + 1, kp, kld, vp, vld);
            rk = *(const U4*)(kp + (long)sr * kld + ss * 8);
#pragma unroll
            for (int i = 0; i < NVL; ++i) rv[i] = *(const U4*)(vp + (long)(sr + 64 * i) * vld + ss * 8); }
        const bf16_t* sK = (const bf16_t*)(lds + (t & 1) * L::STAGE); const bf16_t* sV = (const bf16_t*)(lds + (t & 1) * L::STAGE + L::K_BYTES);
        f32x4 s[4][NQT];
#pragma unroll
        for (int mt = 0; mt < 4; ++mt) {
#pragma unroll
            for (int qt = 0; qt < NQT; ++qt) s[mt][qt] = (f32x4){0.f, 0.f, 0.f, 0.f};
#pragma unroll
            for (int ks = 0; ks < 2; ++ks) { bf16x8 kf = ld8(sK + (mt * 16 + l15) * AK_LD + ks * 32 + g * 8);
#pragma unroll
                for (int qt = 0; qt < NQT; ++qt) s[mt][qt] = MFMA16(kf, qf[qt][ks], s[mt][qt]); }
        }
        bf16x8 pf[2][NQT];
#pragma unroll
        for (int qt = 0; qt < NQT; ++qt) {
            const int qi = wid * NQT * 16 + qt * 16 + l15;
            float mx = NEG_BIG;
#pragma unroll
            for (int mt = 0; mt < 4; ++mt)
#pragma unroll
                for (int j = 0; j < 4; ++j) { float v = mask(t, mt, j, qi, s[mt][qt][j] * (0.125f * LOG2E)); s[mt][qt][j] = v; mx = fmaxf(mx, v); }
            mx = xmax<16>(mx); mx = xmax<32>(mx);
            const float mnew = fmaxf(mrun[qt], mx), alpha = fexp2(mrun[qt] - mnew); mrun[qt] = mnew;
            float ps = 0.f;
#pragma unroll
            for (int mt = 0; mt < 4; ++mt)
#pragma unroll
                for (int j = 0; j < 4; ++j) { float pv = fexp2(s[mt][qt][j] - mnew); s[mt][qt][j] = pv; ps += pv; }
            lsum[qt] = lsum[qt] * alpha + ps;
#pragma unroll
            for (int dt = 0; dt < NDT; ++dt) oacc[dt][qt] *= alpha;
#pragma unroll
            for (int kb = 0; kb < 2; ++kb) pf[kb][qt] = mk8u(pack2(s[2 * kb][qt][0], s[2 * kb][qt][1]), pack2(s[2 * kb][qt][2], s[2 * kb][qt][3]),
                                                             pack2(s[2 * kb + 1][qt][0], s[2 * kb + 1][qt][1]), pack2(s[2 * kb + 1][qt][2], s[2 * kb + 1][qt][3]));
        }
#pragma unroll
        for (int dt = 0; dt < NDT; ++dt)
#pragma unroll
            for (int kb = 0; kb < 2; ++kb) { const bf16_t* vr = sV + (dt * 16 + l15) * A_LD + kb * 32 + g * 4;
                bf16x8 vf = mk8(*(const U2*)vr, *(const U2*)(vr + 16));
#pragma unroll
                for (int qt = 0; qt < NQT; ++qt) oacc[dt][qt] = MFMA16(vf, pf[kb][qt], oacc[dt][qt]);
                if (kb == 1 && (dt & 1)) SCHED_FENCE(); }
        if (more) { bf16_t* dK = (bf16_t*)(lds + ((t + 1) & 1) * L::STAGE); bf16_t* dV = (bf16_t*)(lds + ((t + 1) & 1) * L::STAGE + L::K_BYTES);
            *(U4*)(dK + sr * AK_LD + ss * 8) = rk;
#pragma unroll
            for (int i = 0; i < NVL; ++i) *(U4*)(dV + (sr + 64 * i) * A_LD + ss * 8) = rv[i]; }
        __syncthreads();
    }
#pragma unroll
    for (int qt = 0; qt < NQT; ++qt) { float l = lsum[qt]; l = xadd<16>(l); l = xadd<32>(l); lsum[qt] = l; }
}

struct NoMask { __device__ __forceinline__ float operator()(int, int, int, int, float s) const { return s; } };

__device__ __forceinline__ void diff_lambda(const Params& p, int l, float& lam, float& lam_init) {
    const int lane = TID() & 63; const float* dl = GIN(p.diff_lam) + (long)l * 4 * 64;
    const float a = wave_sum(dl[lane] * dl[64 + lane]), b = wave_sum(dl[128 + lane] * dl[192 + lane]);
    int ll = l;
#ifndef CPU_EMU
    asm volatile("" : "+s"(ll));
#endif
    lam_init = 0.8f - 0.6f * expf(-0.3f * (float)ll); lam = expf(a) - expf(b) + lam_init;
}
template <int NQT>
__device__ __forceinline__ void diff_attn_item(const Params& p, char* lds, int l, int b, int h, int q0, bool ctxq) {
    const int tid = TID(), wid = tid >> 6, lane = tid & 63, l15 = lane & 15, g = lane >> 4;
    const bf16_t* DQ = WSP(bf16_t, OFF_SEG_DQKV); const bf16_t* DVT = WSP(bf16_t, OFF_DVT); bf16_t* Y = WSP(bf16_t, OFF_Y);
    const int tok_q0 = ctxq ? NLAT + b * CTX + q0 : b * SEQ + q0;
    const int t_first = ctxq ? SEQ / 64 : 0, ntiles = ctxq ? CTX / 64 : KEYS / 64;
    f32x4 o1[8][NQT]; float l1[NQT];
    {
        auto qrow = [&](int i) { return DQ + (long)(tok_q0 + i) * 3 * MW + h * 128; };
        auto kt = [&](int t, const bf16_t*& kp, long& kld, const bf16_t*& vp, long& vld) { int tt = t_first + t; int tok = bk_tok(b, tt * 64);
            kp = DQ + (long)tok * 3 * MW + MW + h * 128; kld = 3 * MW; vp = DVT + ((long)b * MW + h * 128) * KEYS + tt * 64; vld = KEYS; };
        attn_core<NQT, 128>(lds, qrow, kt, ntiles, NoMask(), o1, l1);
    }
    U2 o1p[8][NQT];
#pragma unroll
    for (int qt = 0; qt < NQT; ++qt) { float inv = 1.0f / l1[qt];
#pragma unroll
        for (int dt = 0; dt < 8; ++dt) { f32x4 v = o1[dt][qt] * inv; o1p[dt][qt].x = pack2(v[0], v[1]); o1p[dt][qt].y = pack2(v[2], v[3]); } }
    f32x4 o2[8][NQT]; float l2[NQT];
    {
        auto qrow = [&](int i) { return DQ + (long)(tok_q0 + i) * 3 * MW + h * 128 + 64; };
        auto kt = [&](int t, const bf16_t*& kp, long& kld, const bf16_t*& vp, long& vld) { int tt = t_first + t; int tok = bk_tok(b, tt * 64);
            kp = DQ + (long)tok * 3 * MW + MW + h * 128 + 64; kld = 3 * MW; vp = DVT + ((long)b * MW + h * 128) * KEYS + tt * 64; vld = KEYS; };
        attn_core<NQT, 128>(lds, qrow, kt, ntiles, NoMask(), o2, l2);
    }
    const int tid2 = TID(), wid2 = tid2 >> 6, l15b = tid2 & 15, gb = (tid2 & 63) >> 4; bf16_t* Yo = WSP(bf16_t, OFF_Y);
    float lam, lam_init; diff_lambda(p, l, lam, lam_init);
    const float* nw = GIN(p.diff_norm) + l * 128;
#pragma unroll
    for (int qt = 0; qt < NQT; ++qt) { float inv = lam / l2[qt]; float ss = 0.f;
#pragma unroll
        for (int dt = 0; dt < 8; ++dt) { f32x4 a = (f32x4){bflo(o1p[dt][qt].x), bfhi(o1p[dt][qt].x), bflo(o1p[dt][qt].y), bfhi(o1p[dt][qt].y)}; o2[dt][qt] = a - o2[dt][qt] * inv;
#pragma unroll
            for (int j = 0; j < 4; ++j) ss += o2[dt][qt][j] * o2[dt][qt][j]; }
        ss = xadd<16>(ss); ss = xadd<32>(ss);
        const float r = rsqrtf(ss * (1.0f / 128.0f) + RMS_EPS) * (1.0f - lam_init);
        const long row = tok_q0 + wid2 * NQT * 16 + qt * 16 + l15b;
#pragma unroll
        for (int dt = 0; dt < 8; ++dt) { F4 w = *(const F4*)(nw + dt * 16 + gb * 4); f32x4 v = o2[dt][qt];
            v[0] *= r * w.x; v[1] *= r * w.y; v[2] *= r * w.z; v[3] *= r * w.w;
            st4bf(Yo + row * 4 * MW + 2 * MW + h * 128 + dt * 16 + gb * 4, v); }
    }
}

struct NaMask {
    const float* rpb;
    int qr, rs, rs0, nct;
    int cidx[16];
    __device__ __forceinline__ float operator()(int t, int mt, int j, int, float s) const {
        if (t < nct) return s;
        const int kr = rs0 + (t - nct), ci = cidx[mt * 4 + j];
        const bool ok = (kr >= rs) && (kr < rs + 8) && (ci >= 0);
        int dr = kr - qr + 7; dr = dr < 0 ? 0 : (dr > 14 ? 14 : dr);
        return ok ? s + rpb[dr * 31 + (ci < 0 ? 0 : ci)] : NEG_BIG;
    }
};
__device__ __forceinline__ void na_attn_item(const Params& p, char* lds, int l, int b, int h, int rp) {
    const int tid = TID(), wid = tid >> 6, lane = tid & 63, l15 = lane & 15, g = lane >> 4;
    const bf16_t* NQ = WSP(bf16_t, OFF_SEG_NQKV); const bf16_t* NVT = WSP(bf16_t, OFF_NVT); bf16_t* Y = WSP(bf16_t, OFF_Y);
    float* rpb = (float*)(lds + AttnLds<64>::TOTAL);
    __syncthreads();
    for (int i = tid; i < 15 * 31; i += NTH) rpb[i] = GIN(p.na_rpb)[((long)(l * NH + h) * 15) * 31 + i] * LOG2E;
    const int r0 = rp * 2; int rs0 = r0 - 4; rs0 = rs0 < 0 ? 0 : (rs0 > R_ROWS - 8 ? R_ROWS - 8 : rs0);
    int nwin = R_ROWS - rs0; nwin = nwin > 9 ? 9 : nwin;
    constexpr int NCT = CTX / 64;
    NaMask mk; mk.rpb = rpb; mk.rs0 = rs0; mk.nct = NCT;
    { const int qi = wid * 16 + l15, qc = qi & 63; mk.qr = r0 + (wid >> 2);
        int rs = mk.qr - 4; mk.rs = rs < 0 ? 0 : (rs > R_ROWS - 8 ? R_ROWS - 8 : rs);
        int cs = qc - 8; cs = cs < 0 ? 0 : (cs > GW - 16 ? GW - 16 : cs);
#pragma unroll
        for (int mt = 0; mt < 4; ++mt)
#pragma unroll
            for (int j = 0; j < 4; ++j) { const int kc = mt * 16 + g * 4 + j; int dc = kc - qc; dc = dc < -15 ? -15 : (dc > 15 ? 15 : dc); mk.cidx[mt * 4 + j] = (kc >= cs && kc < cs + 16) ? dc + 15 : -1; } }
    const int tok_q0 = b * SEQ + r0 * 64;
    auto qrow = [&](int i) { return NQ + (long)(tok_q0 + i) * 3 * MW + h * 64; };
    auto kt = [&](int t, const bf16_t*& kp, long& kld, const bf16_t*& vp, long& vld) { int key = t < NCT ? SEQ + t * 64 : (rs0 + t - NCT) * 64; int tok = bk_tok(b, key);
        kp = NQ + (long)tok * 3 * MW + MW + h * 64; kld = 3 * MW; vp = NVT + ((long)b * MW + h * 64) * KEYS + key; vld = KEYS; };
    f32x4 o[4][1]; float ls[1];
    attn_core<1, 64>(lds, qrow, kt, NCT + nwin, mk, o, ls);
    const float inv = 1.0f / ls[0]; const long row = tok_q0 + wid * 16 + l15;
#pragma unroll
    for (int dt = 0; dt < 4; ++dt) { f32x4 v = o[dt][0] * inv; st4bf(Y + row * 4 * MW + 3 * MW + h * 64 + dt * 16 + g * 4, v); }
}
__device__ __forceinline__ void na_ctx_item(const Params& p, char* lds, int b, int h, int q0) {
    const int tid = TID(), wid = tid >> 6, lane = tid & 63, l15 = lane & 15, g = lane >> 4;
    const bf16_t* NQ = WSP(bf16_t, OFF_SEG_NQKV); const bf16_t* NVT = WSP(bf16_t, OFF_NVT); bf16_t* Y = WSP(bf16_t, OFF_Y);
    const int tok_q0 = NLAT + b * CTX + q0;
    auto qrow = [&](int i) { return NQ + (long)(tok_q0 + i) * 3 * MW + h * 64; };
    auto kt = [&](int t, const bf16_t*& kp, long& kld, const bf16_t*& vp, long& vld) { int key = SEQ + t * 64; int tok = bk_tok(b, key);
        kp = NQ + (long)tok * 3 * MW + MW + h * 64; kld = 3 * MW; vp = NVT + ((long)b * MW + h * 64) * KEYS + key; vld = KEYS; };
    f32x4 o[4][1]; float ls[1];
    attn_core<1, 64>(lds, qrow, kt, CTX / 64, NoMask(), o, ls);
    const float inv = 1.0f / ls[0]; const long row = tok_q0 + wid * 16 + l15;
#pragma unroll
    for (int dt = 0; dt < 4; ++dt) { f32x4 v = o[dt][0] * inv; st4bf(Y + row * 4 * MW + 3 * MW + h * 64 + dt * 16 + g * 4, v); }
}

#define MFMA32(a, b, c) __builtin_amdgcn_mfma_f32_32x32x16_bf16(a, b, c, 0, 0, 0)
#ifndef CPU_EMU
typedef float f32x16 __attribute__((ext_vector_type(16)));
#endif
constexpr int D32_KT = 128;
constexpr int D32_KLD = 80, D32_VLD = D32_KT + 8;
constexpr int D32_KB = D32_KT * D32_KLD * 2, D32_VB = 128 * D32_VLD * 2, D32_STAGE = D32_KB + D32_VB, D32_TOTAL = 2 * D32_STAGE;
static_assert(D32_TOTAL <= 160 * 1024 - 64 && KEYS % D32_KT == 0, "diff32 lds");

__device__ __forceinline__ void diff32_pass(char* lds, const bf16_t* qp  , const bf16_t* kbase  ,
                                            const bf16_t* vbase  , int b, f32x16 (&oacc)[4], float& lsum) {
    const int tid = TID(), lane = tid & 63, r32 = lane & 31, hh = lane >> 5;
    bf16x8 qf[4];
#pragma unroll
    for (int ks = 0; ks < 4; ++ks) qf[ks] = ld8(qp + ks * 16 + hh * 8);
#pragma unroll
    for (int dt = 0; dt < 4; ++dt)
#pragma unroll
        for (int r = 0; r < 16; ++r) oacc[dt][r] = 0.f;
    float mrun = -64.0f; lsum = 0.f;
    f32x16 cinit;
#pragma unroll
    for (int r = 0; r < 16; ++r) cinit[r] = -mrun;
    const int sr = tid >> 3, ss = tid & 7, vr_ = tid >> 4, vs = tid & 15;
    U4 rk[2], rv[4];
    constexpr int NT = KEYS / D32_KT;
    auto gload = [&](int t) { const long tok = bk_tok(b, t * D32_KT);
#pragma unroll
        for (int i = 0; i < 2; ++i) rk[i] = *(const U4*)(kbase + (tok + sr + 64 * i) * 3 * MW + ss * 8);
#pragma unroll
        for (int i = 0; i < 4; ++i) rv[i] = *(const U4*)(vbase + (long)(vr_ + 32 * i) * KEYS + t * D32_KT + vs * 8); };
    auto sstore = [&](int st) { bf16_t* sK = (bf16_t*)(lds + st * D32_STAGE); bf16_t* sV = (bf16_t*)(lds + st * D32_STAGE + D32_KB);
#pragma unroll
        for (int i = 0; i < 2; ++i) *(U4*)(sK + (sr + 64 * i) * D32_KLD + ss * 8) = rk[i];
#pragma unroll
        for (int i = 0; i < 4; ++i) { bf16_t* d = sV + (vr_ + 32 * i) * D32_VLD + (vs >> 1) * 16 + (vs & 1) * 4; *(U2*)d = (U2){rv[i].x, rv[i].y}; *(U2*)(d + 8) = (U2){rv[i].z, rv[i].w}; } };
    gload(0);
    __syncthreads();
    sstore(0);
    __syncthreads();
    for (int t = 0; t < NT; ++t) {
        const bool more = t + 1 < NT;
        if (more) gload(t + 1);
#pragma unroll 1
        for (int sub = 0; sub < 2; ++sub) {
        const bf16_t* sK = (const bf16_t*)(lds + (t & 1) * D32_STAGE) + sub * 64 * D32_KLD; const bf16_t* sV = (const bf16_t*)(lds + (t & 1) * D32_STAGE + D32_KB) + sub * 64;
        f32x16 s[2];
        {
            bf16x8 kf[2][4];
#pragma unroll
            for (int kt = 0; kt < 2; ++kt)
#pragma unroll
                for (int ks = 0; ks < 4; ++ks) kf[kt][ks] = ld8(sK + (kt * 32 + r32) * D32_KLD + ks * 16 + hh * 8);
            SCHED_FENCE();
#pragma unroll
            for (int kt = 0; kt < 2; ++kt) {
                s[kt] = MFMA32(kf[kt][0], qf[0], cinit);
#pragma unroll
                for (int ks = 1; ks < 4; ++ks) s[kt] = MFMA32(kf[kt][ks], qf[ks], s[kt]);
            }
        }
        float mx = -3.0e38f;
#pragma unroll
        for (int kt = 0; kt < 2; ++kt)
#pragma unroll
            for (int r = 0; r < 16; ++r) mx = fmaxf(mx, s[kt][r]);
        mx = xmax<32>(mx);
        if (__ballot(mx > 6.0f) != 0ull) {
            const float d = fmaxf(mx, 0.f), alpha = fexp2(-d);
            mrun += d; lsum *= alpha;
#pragma unroll
            for (int r = 0; r < 16; ++r) cinit[r] = -mrun;
#pragma unroll
            for (int kt = 0; kt < 2; ++kt)
#pragma unroll
                for (int r = 0; r < 16; ++r) s[kt][r] -= d;
#pragma unroll
            for (int dt = 0; dt < 4; ++dt) oacc[dt] *= alpha;
        }
        float ps = 0.f;
#pragma unroll
        for (int kt = 0; kt < 2; ++kt)
#pragma unroll
            for (int r = 0; r < 16; ++r) { float pv = fexp2(s[kt][r]); s[kt][r] = pv; ps += pv; }
        lsum += ps;
        {
            bf16x8 va[4], vb[4];
#define D32_LDV(dst, kt, sx) _Pragma("unroll") for (int dt = 0; dt < 4; ++dt) { dst[dt] = ld8(sV + (dt * 32 + r32) * D32_VLD + (kt) * 32 + (sx) * 16 + hh * 8); }
#define D32_PF(kt, sx) mk8u(pack2(s[kt][8 * (sx)], s[kt][8 * (sx) + 1]), pack2(s[kt][8 * (sx) + 2], s[kt][8 * (sx) + 3]), pack2(s[kt][8 * (sx) + 4], s[kt][8 * (sx) + 5]), pack2(s[kt][8 * (sx) + 6], s[kt][8 * (sx) + 7]))
#define D32_MMA(src, pf) _Pragma("unroll") for (int dt = 0; dt < 4; ++dt) oacc[dt] = MFMA32(src[dt], pf, oacc[dt]);
            D32_LDV(va, 0, 0) D32_LDV(vb, 0, 1)
            const bf16x8 p0 = D32_PF(0, 0), p1 = D32_PF(0, 1), p2 = D32_PF(1, 0), p3 = D32_PF(1, 1);
            SCHED_FENCE();
            D32_MMA(va, p0) D32_LDV(va, 1, 0)
            SCHED_FENCE();
            D32_MMA(vb, p1) D32_LDV(vb, 1, 1)
            SCHED_FENCE();
            D32_MMA(va, p2)
            D32_MMA(vb, p3)
#undef D32_LDV
#undef D32_PF
#undef D32_MMA
        }
        }
        if (more) sstore((t + 1) & 1);
        __syncthreads();
    }
    lsum = xadd<32>(lsum);
}

__device__ __forceinline__ void diff32_item(const Params& p, char* lds, int l, int b, int h, int q0, int comp) {
    const int tid = TID(), wid = tid >> 6, lane = tid & 63, r32 = lane & 31, hh = lane >> 5;
    const bf16_t* DQ = WSP(bf16_t, OFF_SEG_DQKV); const bf16_t* DVT = WSP(bf16_t, OFF_DVT);
    const long qtok = (long)b * SEQ + q0 + wid * 32 + r32;
    f32x16 oacc[4]; float ls;
    diff32_pass(lds, DQ + qtok * 3 * MW + h * 128 + comp * 64, DQ + MW + h * 128 + comp * 64, DVT + ((long)b * MW + h * 128) * KEYS, b, oacc, ls);
    bf16_t* Yo = WSP(bf16_t, OFF_Y) + qtok * 4 * MW + (comp == 0 ? 2 * MW : 0) + h * 128;
    const float inv = 1.0f / ls;
#pragma unroll
    for (int dt = 0; dt < 4; ++dt)
#pragma unroll
        for (int q = 0; q < 4; ++q) { const int dv = dt * 32 + 8 * q + 4 * hh;
            st4bf(Yo + dv, (f32x4){oacc[dt][4 * q] * inv, oacc[dt][4 * q + 1] * inv, oacc[dt][4 * q + 2] * inv, oacc[dt][4 * q + 3] * inv}); }
}

constexpr int N32_VLD = 72;
constexpr int N32_KB = 64 * D32_KLD * 2, N32_VB = 64 * N32_VLD * 2, N32_STAGE = N32_KB + N32_VB, N32_RPB = 2 * N32_STAGE;
static_assert(R_ROWS % 4 == 0 && GW == 64 && N32_RPB + 16 * 128 * 4 <= 100 * 1024, "na32");
__device__ __forceinline__ void na32_item(const Params& p, char* lds, int l, int b, int h, int rq) {
    const int tid = TID(), wid = tid >> 6, lane = tid & 63, r32 = lane & 31, hh = lane >> 5;
    const bf16_t* NQ = WSP(bf16_t, OFF_SEG_NQKV); const bf16_t* NVT = WSP(bf16_t, OFF_NVT);
    float* rpb = (float*)(lds + N32_RPB);
    __syncthreads();
    for (int i = tid; i < 16 * 128; i += NTH) { const int dr = i >> 7, c = (i & 127) - 48;
        rpb[i] = dr == 15 ? NEG_BIG : ((c >= 0 && c < 31) ? GIN(p.na_rpb)[((long)(l * NH + h) * 15 + dr) * 31 + c] * LOG2E : 0.f); }
    constexpr int NCT = CTX / 64;
    const int r0 = rq * 4, qr = r0 + (wid >> 1), qc = (wid & 1) * 32 + r32;
    int rs0 = r0 - 4; rs0 = rs0 < 0 ? 0 : (rs0 > R_ROWS - 8 ? R_ROWS - 8 : rs0);
    int rsl = r0 - 1; rsl = rsl < 0 ? 0 : (rsl > R_ROWS - 8 ? R_ROWS - 8 : rsl);
    const int NT = NCT + (rsl + 8 - rs0);
    int rs = qr - 4; rs = rs < 0 ? 0 : (rs > R_ROWS - 8 ? R_ROWS - 8 : rs);
    int cs = qc - 8; cs = cs < 0 ? 0 : (cs > GW - 16 ? GW - 16 : cs);
    const long qtok = (long)b * SEQ + qr * 64 + qc;
    bf16x8 qf[4];
    { const bf16_t* qp = NQ + qtok * 3 * MW + h * 64; constexpr float sc = 0.125f * LOG2E;
#pragma unroll
        for (int ks = 0; ks < 4; ++ks) { const U4 r = *(const U4*)(qp + ks * 16 + hh * 8);
            qf[ks] = mk8u(pack2(bflo(r.x) * sc, bfhi(r.x) * sc), pack2(bflo(r.y) * sc, bfhi(r.y) * sc), pack2(bflo(r.z) * sc, bfhi(r.z) * sc), pack2(bflo(r.w) * sc, bfhi(r.w) * sc)); } }
    f32x16 oacc[2];
#pragma unroll
    for (int dt = 0; dt < 2; ++dt)
#pragma unroll
        for (int r = 0; r < 16; ++r) oacc[dt][r] = 0.f;
    float mrun = -64.0f, lsum = 0.f;
    f32x16 cplain, cm[2];
#pragma unroll
    for (int r = 0; r < 16; ++r) cplain[r] = -mrun;
#pragma unroll
    for (int kt = 0; kt < 2; ++kt)
#pragma unroll
        for (int r = 0; r < 16; ++r) { const int kc = kt * 32 + (r & 3) + 8 * (r >> 2) + 4 * hh; cm[kt][r] = (kc >= cs && kc < cs + 16) ? -mrun : NEG_BIG; }
    const int sr = tid >> 3, ss = tid & 7;
    const bf16_t* kbase = NQ + MW + h * 64; const bf16_t* vbase = NVT + ((long)b * MW + h * 64) * KEYS;
    U4 rk, rv;
    auto gload = [&](int t) { const int key = t < NCT ? SEQ + t * 64 : (rs0 + t - NCT) * 64; const long tok = bk_tok(b, key);
        rk = *(const U4*)(kbase + (tok + sr) * 3 * MW + ss * 8); rv = *(const U4*)(vbase + (long)sr * KEYS + key + ss * 8); };
    auto sstore = [&](int st) { bf16_t* sK = (bf16_t*)(lds + st * N32_STAGE); bf16_t* sV = (bf16_t*)(lds + st * N32_STAGE + N32_KB);
        *(U4*)(sK + sr * D32_KLD + ss * 8) = rk; bf16_t* d = sV + sr * N32_VLD + (ss >> 1) * 16 + (ss & 1) * 4; *(U2*)d = (U2){rv.x, rv.y}; *(U2*)(d + 8) = (U2){rv.z, rv.w}; };
    gload(0);
    __syncthreads();
    sstore(0);
    __syncthreads();
    for (int t = 0; t < NT; ++t) {
        const bool more = t + 1 < NT;
        if (more) gload(t + 1);
        const bf16_t* sK = (const bf16_t*)(lds + (t & 1) * N32_STAGE); const bf16_t* sV = (const bf16_t*)(lds + (t & 1) * N32_STAGE + N32_KB);
        f32x16 s[2];
        {
            bf16x8 kf[2][4];
#pragma unroll
            for (int kt = 0; kt < 2; ++kt)
#pragma unroll
                for (int ks = 0; ks < 4; ++ks) kf[kt][ks] = ld8(sK + (kt * 32 + r32) * D32_KLD + ks * 16 + hh * 8);
            SCHED_FENCE();
            if (t < NCT) {
#pragma unroll
                for (int kt = 0; kt < 2; ++kt) { s[kt] = MFMA32(kf[kt][0], qf[0], cplain);
#pragma unroll
                    for (int ks = 1; ks < 4; ++ks) s[kt] = MFMA32(kf[kt][ks], qf[ks], s[kt]); }
            } else {
                const int kr = rs0 + t - NCT; const int rsel = (kr >= rs && kr < rs + 8) ? kr - qr + 7 : 15;
                const float* bp = rpb + rsel * 128 + (4 * hh - qc + 63);
#pragma unroll
                for (int kt = 0; kt < 2; ++kt) { s[kt] = MFMA32(kf[kt][0], qf[0], cm[kt]);
#pragma unroll
                    for (int ks = 1; ks < 4; ++ks) s[kt] = MFMA32(kf[kt][ks], qf[ks], s[kt]); }
#pragma unroll
                for (int kt = 0; kt < 2; ++kt)
#pragma unroll
                    for (int r = 0; r < 16; ++r) s[kt][r] += bp[kt * 32 + (r & 3) + 8 * (r >> 2)];
            }
        }
        float mx = -3.0e38f;
#pragma unroll
        for (int kt = 0; kt < 2; ++kt)
#pragma unroll
            for (int r = 0; r < 16; ++r) mx = fmaxf(mx, s[kt][r]);
        mx = xmax<32>(mx);
        if (__ballot(mx > 6.0f) != 0ull) {
            const float d = fmaxf(mx, 0.f), alpha = fexp2(-d);
            mrun += d; lsum *= alpha;
#pragma unroll
            for (int r = 0; r < 16; ++r) cplain[r] = -mrun;
#pragma unroll
            for (int kt = 0; kt < 2; ++kt)
#pragma unroll
                for (int r = 0; r < 16; ++r) { cm[kt][r] -= d; s[kt][r] -= d; }
#pragma unroll
            for (int dt = 0; dt < 2; ++dt) oacc[dt] *= alpha;
        }
        float ps = 0.f;
#pragma unroll
        for (int kt = 0; kt < 2; ++kt)
#pragma unroll
            for (int r = 0; r < 16; ++r) { float pv = fexp2(s[kt][r]); s[kt][r] = pv; ps += pv; }
        lsum += ps;
        {
            bf16x8 va[2], vb[2];
#define N32_LDV(dst, kt, sx) _Pragma("unroll") for (int dt = 0; dt < 2; ++dt) { dst[dt] = ld8(sV + (dt * 32 + r32) * N32_VLD + (kt) * 32 + (sx) * 16 + hh * 8); }
#define N32_PF(kt, sx) mk8u(pack2(s[kt][8 * (sx)], s[kt][8 * (sx) + 1]), pack2(s[kt][8 * (sx) + 2], s[kt][8 * (sx) + 3]), pack2(s[kt][8 * (sx) + 4], s[kt][8 * (sx) + 5]), pack2(s[kt][8 * (sx) + 6], s[kt][8 * (sx) + 7]))
#define N32_MMA(src, pf) _Pragma("unroll") for (int dt = 0; dt < 2; ++dt) oacc[dt] = MFMA32(src[dt], pf, oacc[dt]);
            N32_LDV(va, 0, 0) N32_LDV(vb, 0, 1)
            const bf16x8 p0 = N32_PF(0, 0), p1 = N32_PF(0, 1), p2 = N32_PF(1, 0), p3 = N32_PF(1, 1);
            SCHED_FENCE();
            N32_MMA(va, p0) N32_LDV(va, 1, 0)
            SCHED_FENCE();
            N32_MMA(vb, p1) N32_LDV(vb, 1, 1)
            SCHED_FENCE();
            N32_MMA(va, p2)
            N32_MMA(vb, p3)
#undef N32_LDV
#undef N32_PF
#undef N32_MMA
        }
        if (more) sstore((t + 1) & 1);
        __syncthreads();
    }
    lsum = xadd<32>(lsum);
    const int tid2 = TID(), lane2 = tid2 & 63, wid2 = tid2 >> 6;
    bf16_t* Yo = WSP(bf16_t, OFF_Y) + ((long)b * SEQ + (r0 + (wid2 >> 1)) * 64 + (wid2 & 1) * 32 + (lane2 & 31)) * 4 * MW + 3 * MW + h * 64;
    const float inv = 1.0f / lsum;
#pragma unroll
    for (int dt = 0; dt < 2; ++dt)
#pragma unroll
        for (int q = 0; q < 4; ++q) { const int dv = dt * 32 + 8 * q + 4 * (lane2 >> 5);
            st4bf(Yo + dv, (f32x4){oacc[dt][4 * q] * inv, oacc[dt][4 * q + 1] * inv, oacc[dt][4 * q + 2] * inv, oacc[dt][4 * q + 3] * inv}); }
}
static_assert(NTASK_GDN % 4 == 0, "gdn tasks");
__device__ __forceinline__ void gdn_decode(int chain, int n, int& b, int& h, int& dir, int& base, int& T, int& c) {
    dir = chain & 1; int bh = chain >> 1; h = bh % GH; b = bh / GH;
    if (n < NCH_CTX) { base = NLAT + b * CTX; T = CTX; c = n; } else { base = b * SEQ; T = SEQ; c = n - NCH_CTX; }
}
__device__ __forceinline__ int gdn_pos(int dir, int T, int c, int i) { int r = 64 * c + i; return dir ? T - 1 - r : r; }

constexpr int GP_K = 0, GP_V = 10240, GP_AB = 20480, GP_AD = 30720, GP_XT = GP_AD + 4 * 16 * 16 * 4, GP_R = GP_XT + 128 * 80 * 2, GP_F = GP_R + 16 * 132 * 4, GP_TASK = GP_F + 1024;
static_assert(2 * GP_TASK <= 160 * 1024 - 64 && NTASK_GDN % 2 == 0, "gdn prep lds");
__device__ __forceinline__ void gdn_chunk_prep2(const Params& p, char* lds, int l, int task0) {
    const int tid = TID(), wid = tid >> 6, lane = tid & 63, l15 = lane & 15, g = lane >> 4, tk = wid >> 2, w4 = wid & 3, t4 = tid & 255;
    const int task = task0 + tk, chain = task / NCH, n = task - chain * NCH;
    int b, h, dir, base, T, c; gdn_decode(chain, n, b, h, dir, base, T, c);
    char* L = lds + tk * GP_TASK;
    bf16_t* Kt = (bf16_t*)(L + GP_K); bf16_t* Vt = (bf16_t*)(L + GP_V); bf16_t* Ab = (bf16_t*)(L + GP_AB); float* Ad = (float*)(L + GP_AD); bf16_t* XT = (bf16_t*)(L + GP_XT); float* R = (float*)(L + GP_R);
    float* gcs = (float*)(L + GP_F); float* bet = gcs + 64; float* fac = gcs + 128;
    const bf16_t* GK = WSP(bf16_t, OFF_GK); const bf16_t* GV = WSP(bf16_t, OFF_GV); const float* GB = WSP(float, OFF_GB);
    __syncthreads();
#pragma unroll
    for (int q = 0; q < 2; ++q) { int pc = t4 + 256 * q, i = pc >> 3, s = pc & 7; long tok = base + gdn_pos(dir, T, c, i);
        *(U4*)(Kt + i * 80 + s * 8) = *(const U4*)(GK + tok * MW + h * 64 + s * 8);
        *(U4*)(Vt + i * 80 + s * 8) = *(const U4*)(GV + tok * MW + h * 64 + s * 8); }
    for (int i = t4; i < 128 * 80 / 8; i += 256) *(U4*)(XT + i * 8) = (U4){0u, 0u, 0u, 0u};
    if (w4 == 0) { long tok = base + gdn_pos(dir, T, c, lane); float gi = GB[tok * 4 * GH + dir * GH + h], be = GB[tok * 4 * GH + 2 * GH + dir * GH + h];
        float cs = gi;
        for (int o = 1; o < 64; o <<= 1) { float t = __shfl_up(cs, o); if (lane >= o) cs += t; }
        gcs[lane] = cs; bet[lane] = be; fac[lane] = be * __expf(cs); }
    __syncthreads();
    { const int mt = w4; const int i = mt * 16 + l15; const float bi = bet[i], gi = gcs[i];
        bf16x8 bfr[2];
#pragma unroll
        for (int ks = 0; ks < 2; ++ks) bfr[ks] = ld8(Kt + (mt * 16 + l15) * 80 + ks * 32 + g * 8);
        for (int nt = 0; nt <= mt; ++nt) { f32x4 acc = (f32x4){0.f, 0.f, 0.f, 0.f};
#pragma unroll
            for (int ks = 0; ks < 2; ++ks) acc = MFMA16(ld8(Kt + (nt * 16 + l15) * 80 + ks * 32 + g * 8), bfr[ks], acc);
            float v[4];
#pragma unroll
            for (int jj = 0; jj < 4; ++jj) { const int j = nt * 16 + g * 4 + jj; v[jj] = j < i ? bi * acc[jj] * __expf(gi - gcs[j]) : 0.f; }
            if (nt < mt) *(U2*)(Ab + i * 80 + nt * 16 + g * 4) = (U2){pack2(v[0], v[1]), pack2(v[2], v[3])};
            else { *(U2*)(Ab + i * 80 + nt * 16 + g * 4) = (U2){0u, 0u}; *(F4*)(Ad + (mt * 16 + l15) * 16 + g * 4) = (F4){v[0], v[1], v[2], v[3]}; } }
    }
    __syncthreads();
    const bool wcol = t4 < 64; const int cc = t4 & 63;
    const bf16_t* src = wcol ? Kt : Vt; const float* scl = wcol ? fac : bet;
    bf16_t* dst = WSP(bf16_t, OFF_WU) + ((long)task * 2 + (wcol ? 0 : 1)) * 4096 + cc;
#pragma unroll
    for (int I = 0; I < 4; ++I) {
        if (I > 0) {
#pragma unroll
            for (int q = 0; q < 2; ++q) { const int nt = w4 * 2 + q; f32x4 acc = (f32x4){0.f, 0.f, 0.f, 0.f};
                acc = MFMA16(ld8(Ab + (I * 16 + l15) * 80 + g * 8), ld8(XT + (nt * 16 + l15) * 80 + g * 8), acc);
                if (I == 3) acc = MFMA16(ld8(Ab + (I * 16 + l15) * 80 + 32 + g * 8), ld8(XT + (nt * 16 + l15) * 80 + 32 + g * 8), acc);
#pragma unroll
                for (int jj = 0; jj < 4; ++jj) R[(g * 4 + jj) * 132 + nt * 16 + l15] = acc[jj]; }
            __syncthreads();
        }
        if (t4 < 128) {
            float x[16];
#pragma unroll
            for (int ii = 0; ii < 16; ++ii) { float a = scl[I * 16 + ii] * bf2f(src[(I * 16 + ii) * 80 + cc]); if (I > 0) a -= R[ii * 132 + t4];
#pragma unroll
                for (int jj = 0; jj < ii; ++jj) a -= Ad[(I * 16 + ii) * 16 + jj] * x[jj];
                x[ii] = a; }
            *(U4*)(XT + t4 * 80 + I * 16) = (U4){pack2(x[0], x[1]), pack2(x[2], x[3]), pack2(x[4], x[5]), pack2(x[6], x[7])};
            *(U4*)(XT + t4 * 80 + I * 16 + 8) = (U4){pack2(x[8], x[9]), pack2(x[10], x[11]), pack2(x[12], x[13]), pack2(x[14], x[15])};
#pragma unroll
            for (int ii = 0; ii < 16; ++ii) dst[(I * 16 + ii) * 64] = f2bf(x[ii]);
        }
        __syncthreads();
    }
}

constexpr int GS_W = 0, GS_Q = 10240, GS_K = 20480, GS_KT = 30720, GS_GC = 40960, GS_STAGE = 40960 + 512;
constexpr int GS_ST = 2 * GS_STAGE, GS_VNT = GS_ST + 2 * 5120, GS_VNT2 = GS_VNT + 5120, GS_ATT = GS_VNT2 + 5120, GS_TOTAL = GS_ATT + 10240;
__device__ __forceinline__ void gdn_scan_item(const Params& p, char* lds, int l, int cb) {
    const int tid = TID(), wid = tid >> 6, lane = tid & 63, l15 = lane & 15, g = lane >> 4, mt = wid >> 1, nt = wid & 1;
    {
    const int chain = cb >> 1, half = cb & 1;
    const bf16_t* GQ = WSP(bf16_t, OFF_GQ); const bf16_t* GK = WSP(bf16_t, OFF_GK); const float* GB = WSP(float, OFF_GB); const bf16_t* WU = WSP(bf16_t, OFF_WU);
    const int sr = tid >> 3, ss = tid & 7;
    f32x4 sacc = (f32x4){0.f, 0.f, 0.f, 0.f};
    U4 rw, rq, rk; float ucur[4], unext[4]; float gnext = 0.f;
    auto load_chunk = [&](int n) {
        int b, h, dir, base, T, c; gdn_decode(chain, n, b, h, dir, base, T, c);
        const long task = (long)chain * NCH + n; const long tok = base + gdn_pos(dir, T, c, sr);
        rw = *(const U4*)(WU + (task * 2 + 0) * 4096 + sr * 64 + ss * 8);
        rq = *(const U4*)(GQ + tok * MW + h * 64 + ss * 8);
        rk = *(const U4*)(GK + tok * MW + h * 64 + ss * 8);
#pragma unroll
        for (int j = 0; j < 4; ++j) unext[j] = bf2f(WU[(task * 2 + 1) * 4096 + (mt * 16 + g * 4 + j) * 64 + half * 32 + nt * 16 + l15]);
        if (wid == 0) { const long tk = base + gdn_pos(dir, T, c, lane); gnext = GB[tk * 4 * GH + dir * GH + h]; }
    };
    auto store_chunk = [&](int st) {
        char* S = lds + st * GS_STAGE;
        *(U4*)((bf16_t*)(S + GS_W) + sr * 80 + ss * 8) = rw;
        *(U4*)((bf16_t*)(S + GS_Q) + sr * 80 + ss * 8) = rq;
        *(U4*)((bf16_t*)(S + GS_K) + sr * 80 + ss * 8) = rk;
        bf16_t* KT = (bf16_t*)(S + GS_KT);
        const u32 kw[4] = {rk.x, rk.y, rk.z, rk.w};
#pragma unroll
        for (int e = 0; e < 4; ++e) { KT[(ss * 8 + 2 * e) * 80 + sr] = (bf16_t)(kw[e] & 0xffffu); KT[(ss * 8 + 2 * e + 1) * 80 + sr] = (bf16_t)(kw[e] >> 16); }
        if (wid == 0) { float cs = gnext;
            for (int o = 1; o < 64; o <<= 1) { float t = __shfl_up(cs, o); if (lane >= o) cs += t; }
            ((float*)(S + GS_GC))[lane] = cs; }
    };
    __syncthreads();
    { bf16_t* ST0 = (bf16_t*)(lds + GS_ST); for (int i = tid; i < 32 * 80; i += NTH) ST0[i] = 0; }
    load_chunk(0); store_chunk(0);
#pragma unroll
    for (int j = 0; j < 4; ++j) ucur[j] = unext[j];
    __syncthreads();
    for (int n = 0; n < NCH; ++n) {
        const int st = n & 1;
        if (n + 1 < NCH) load_chunk(n + 1);
        const char* S = lds + st * GS_STAGE;
        const bf16_t* Wt = (const bf16_t*)(S + GS_W); const bf16_t* Qt = (const bf16_t*)(S + GS_Q); const bf16_t* Kt = (const bf16_t*)(S + GS_K); const bf16_t* KT = (const bf16_t*)(S + GS_KT);
        const float* gc = (const float*)(S + GS_GC);
        const bf16_t* STc = (const bf16_t*)(lds + GS_ST + st * 5120); bf16_t* STn = (bf16_t*)(lds + GS_ST + (st ^ 1) * 5120);
        bf16_t* VNT = (bf16_t*)(lds + GS_VNT); bf16_t* VNT2 = (bf16_t*)(lds + GS_VNT2); bf16_t* ATT = (bf16_t*)(lds + GS_ATT);
        const float gl = gc[63];
#pragma unroll
        for (int q = 0; q < 2; ++q) { const int tile = wid * 2 + q, it = tile >> 2, jt = tile & 3;
            f32x4 acc = (f32x4){0.f, 0.f, 0.f, 0.f};
            if (jt <= it) {
#pragma unroll
                for (int ks = 0; ks < 2; ++ks) acc = MFMA16(ld8(Kt + (jt * 16 + l15) * 80 + ks * 32 + g * 8), ld8(Qt + (it * 16 + l15) * 80 + ks * 32 + g * 8), acc);
            }
            const int i = it * 16 + l15; const float gi = gc[i]; float v[4];
#pragma unroll
            for (int j = 0; j < 4; ++j) { const int jp = jt * 16 + g * 4 + j; v[j] = jp <= i ? acc[j] * __expf(gi - gc[jp]) : 0.f; }
            U2 o; o.x = pack2(v[0], v[1]); o.y = pack2(v[2], v[3]); *(U2*)(ATT + i * 80 + jt * 16 + g * 4) = o; }
        {
            f32x4 acc = (f32x4){0.f, 0.f, 0.f, 0.f};
#pragma unroll
            for (int ks = 0; ks < 2; ++ks) acc = MFMA16(ld8(Wt + (mt * 16 + l15) * 80 + ks * 32 + g * 8), ld8(STc + (nt * 16 + l15) * 80 + ks * 32 + g * 8), acc);
            float vn[4], vn2[4];
#pragma unroll
            for (int j = 0; j < 4; ++j) { vn[j] = ucur[j] - acc[j]; vn2[j] = vn[j] * __expf(gl - gc[mt * 16 + g * 4 + j]); }
            U2 o; o.x = pack2(vn[0], vn[1]); o.y = pack2(vn[2], vn[3]); *(U2*)(VNT + (nt * 16 + l15) * 80 + mt * 16 + g * 4) = o;
            U2 o2; o2.x = pack2(vn2[0], vn2[1]); o2.y = pack2(vn2[2], vn2[3]); *(U2*)(VNT2 + (nt * 16 + l15) * 80 + mt * 16 + g * 4) = o2;
        }
        __syncthreads();
        {
            f32x4 a1 = (f32x4){0.f, 0.f, 0.f, 0.f}, a2 = (f32x4){0.f, 0.f, 0.f, 0.f};
#pragma unroll
            for (int ks = 0; ks < 2; ++ks) { a1 = MFMA16(ld8(Qt + (mt * 16 + l15) * 80 + ks * 32 + g * 8), ld8(STc + (nt * 16 + l15) * 80 + ks * 32 + g * 8), a1);
                a2 = MFMA16(ld8(ATT + (mt * 16 + l15) * 80 + ks * 32 + g * 8), ld8(VNT + (nt * 16 + l15) * 80 + ks * 32 + g * 8), a2); }
            int b, h, dir, base, T, c; gdn_decode(chain, n, b, h, dir, base, T, c);
            bf16_t* O = WSP(bf16_t, dir ? OFF_OB : OFF_OF);
#pragma unroll
            for (int j = 0; j < 4; ++j) { const int i = mt * 16 + g * 4 + j; const long tok = base + gdn_pos(dir, T, c, i);
                O[tok * MW + h * 64 + half * 32 + nt * 16 + l15] = f2bf(__expf(gc[i]) * a1[j] + a2[j]); }
        }
        {
            f32x4 acc = sacc * __expf(gl);
#pragma unroll
            for (int ks = 0; ks < 2; ++ks) acc = MFMA16(ld8(KT + (mt * 16 + l15) * 80 + ks * 32 + g * 8), ld8(VNT2 + (nt * 16 + l15) * 80 + ks * 32 + g * 8), acc);
            sacc = acc;
            U2 o; o.x = pack2(acc[0], acc[1]); o.y = pack2(acc[2], acc[3]); *(U2*)(STn + (nt * 16 + l15) * 80 + mt * 16 + g * 4) = o;
        }
        if (n + 1 < NCH) { store_chunk(st ^ 1);
#pragma unroll
            for (int j = 0; j < 4; ++j) ucur[j] = unext[j]; }
        __syncthreads();
    }
    }
}
__device__ __forceinline__ int hy_phys(int p) { return p + ((p >> 6) << 2); }
constexpr int HY_X = 0, HY_T1 = (int)HY_XN * 8, HY_T2 = HY_T1 + 128 * 8, HY_W3 = HY_T2 + 128 * 8, HY_RED = HY_W3 + 2 * 64 * 4, HY_TOTAL = HY_RED + 64 * 4;
static_assert(HY_TOTAL <= 160 * 1024 - 64, "hyena lds");
#ifdef CPU_EMU
__device__ __forceinline__ F2 cmul(F2 a, F2 b) { return (F2){a.x * b.x - a.y * b.y, a.x * b.y + a.y * b.x}; }
__device__ __forceinline__ F2 cmulc(F2 a, F2 b) { return (F2){a.x * b.x + a.y * b.y, a.y * b.x - a.x * b.y}; }
__device__ __forceinline__ F2 add_mi(F2 a, F2 d) { return (F2){a.x + d.y, a.y - d.x}; }
__device__ __forceinline__ F2 sub_mi(F2 a, F2 d) { return (F2){a.x - d.y, a.y + d.x}; }
#else
__device__ __forceinline__ F2 cmul(F2 a, F2 b) { F2 t, r;
    asm("v_pk_mul_f32 %0, %1, %2 op_sel:[1,1] op_sel_hi:[1,0] neg_lo:[0,1]" : "=v"(t) : "v"(a), "v"(b));
    asm("v_pk_fma_f32 %0, %1, %2, %3 op_sel_hi:[0,1,1]" : "=v"(r) : "v"(a), "v"(b), "v"(t));
    return r; }
__device__ __forceinline__ F2 cmulc(F2 a, F2 b) { F2 t, r;
    asm("v_pk_mul_f32 %0, %1, %2 op_sel:[1,1] op_sel_hi:[1,0]" : "=v"(t) : "v"(a), "v"(b));
    asm("v_pk_fma_f32 %0, %1, %2, %3 op_sel_hi:[0,1,1] neg_hi:[0,1,0]" : "=v"(r) : "v"(a), "v"(b), "v"(t));
    return r; }
__device__ __forceinline__ F2 add_mi(F2 a, F2 d) { F2 r; asm("v_pk_add_f32 %0, %1, %2 op_sel:[0,1] op_sel_hi:[1,0] neg_hi:[0,1]" : "=v"(r) : "v"(a), "v"(d)); return r; }
__device__ __forceinline__ F2 sub_mi(F2 a, F2 d) { F2 r; asm("v_pk_add_f32 %0, %1, %2 op_sel:[0,1] op_sel_hi:[1,0] neg_lo:[0,1]" : "=v"(r) : "v"(a), "v"(d)); return r; }
#endif
__device__ __forceinline__ F2 twid(const F2* T1, const F2* T2, int q) { return cmul(T1[q >> 7], T2[q & 127]); }

constexpr int ilog2c(int n) { return n <= 1 ? 0 : 1 + ilog2c(n >> 1); }
__device__ __forceinline__ void bf4_fwd(F2& x0, F2& x1, F2& x2, F2& x3, F2 w1, F2 w2) {
    const F2 a0 = x0 + x2, a2 = cmul(x0 - x2, w1), a1 = x1 + x3, d = cmul(x1 - x3, w1);
    x0 = a0 + a1; x1 = cmul(a0 - a1, w2); x2 = add_mi(a2, d); x3 = cmul(sub_mi(a2, d), w2); }
__device__ __forceinline__ void bf4_inv(F2& y0, F2& y1, F2& y2, F2& y3, F2 w1, F2 w2) {
    F2 t = cmulc(y1, w2); const F2 a0 = y0 + t, a1 = y0 - t; t = cmulc(y3, w2); const F2 a2 = y2 + t, a3 = y2 - t;
    t = cmulc(a2, w1); y0 = a0 + t; y2 = a0 - t; const F2 u = cmulc(a3, w1); y1 = sub_mi(a1, u); y3 = add_mi(a1, u); }
#define W16_1 ((F2){0.9238795325112867f, -0.3826834323650898f})
#define W16_2 ((F2){0.7071067811865476f, -0.7071067811865476f})
#define W16_3 ((F2){0.3826834323650898f, -0.9238795325112867f})
struct LdsLd { const F2* X; __device__ __forceinline__ F2 operator()(int p) const { return X[p]; } };
struct LdsSt { F2* X; __device__ __forceinline__ void operator()(int p, F2 v) const { X[p] = v; } };
template <int N, int M, bool INV, class LD, class ST>
__device__ __forceinline__ void fft_r16(const F2* T1, const F2* T2, int tid, LD& ld, ST& st) {
    constexpr int q16 = M / 16, sh = N / M, NB = N / 16;
#pragma unroll
    for (int it_ = 0; it_ < (NB + NTH - 1) / NTH; ++it_) { const int idx = tid + it_ * NTH; if (NB % NTH != 0 && idx >= NB) break;
        const int blk = idx / q16, j = idx - blk * q16, p0 = blk * M + j, pp0 = hy_phys(p0);
        auto el = [&](int k) { if constexpr (q16 % 64 == 0) return pp0 + k * (q16 / 64 * 68); else if constexpr (M <= 64) return pp0 + k * q16; else return hy_phys(p0 + k * q16); };
        F2 e[16];
#pragma unroll
        for (int k = 0; k < 16; ++k) e[k] = ld(el(k));
        const F2 wa0 = twid(T1, T2, j * sh);
        const F2 wa1 = cmul(wa0, W16_1), wa2 = cmul(wa0, W16_2), wa3 = cmul(wa0, W16_3);
        const F2 wa0s = cmul(wa0, wa0); const F2 wb = cmul(wa0s, wa0s), wbs = cmul(wb, wb);
        if (!INV) {
            bf4_fwd(e[0], e[4], e[8], e[12], wa0, wa0s); bf4_fwd(e[1], e[5], e[9], e[13], wa1, cmul(wa1, wa1));
            bf4_fwd(e[2], e[6], e[10], e[14], wa2, cmul(wa2, wa2)); bf4_fwd(e[3], e[7], e[11], e[15], wa3, cmul(wa3, wa3));
#pragma unroll
            for (int c = 0; c < 4; ++c) bf4_fwd(e[4 * c], e[4 * c + 1], e[4 * c + 2], e[4 * c + 3], wb, wbs);
        } else {
#pragma unroll
            for (int c = 0; c < 4; ++c) bf4_inv(e[4 * c], e[4 * c + 1], e[4 * c + 2], e[4 * c + 3], wb, wbs);
            bf4_inv(e[0], e[4], e[8], e[12], wa0, wa0s); bf4_inv(e[1], e[5], e[9], e[13], wa1, cmul(wa1, wa1));
            bf4_inv(e[2], e[6], e[10], e[14], wa2, cmul(wa2, wa2)); bf4_inv(e[3], e[7], e[11], e[15], wa3, cmul(wa3, wa3));
        }
#pragma unroll
        for (int k = 0; k < 16; ++k) st(el(k), e[k]);
    }
    __syncthreads();
}
template <int N, int M, bool INV, class LD, class ST>
__device__ __forceinline__ void fft_r4(const F2* T1, const F2* T2, int tid, LD& ld, ST& st) {
    constexpr int q4 = M / 4, sh = N / M, NB = N / 4;
#pragma unroll 4
    for (int it_ = 0; it_ < (NB + NTH - 1) / NTH; ++it_) { const int idx = tid + it_ * NTH; if (NB % NTH != 0 && idx >= NB) break;
        const int blk = idx / q4, j = idx - blk * q4, p0 = blk * M + j, pp0 = hy_phys(p0);
        auto el = [&](int k) { if constexpr (q4 % 64 == 0) return pp0 + k * (q4 / 64 * 68); else if constexpr (M <= 64) return pp0 + k * q4; else return hy_phys(p0 + k * q4); };
        F2 x0 = ld(el(0)), x1 = ld(el(1)), x2 = ld(el(2)), x3 = ld(el(3));
        const F2 w1 = twid(T1, T2, j * sh), w2 = cmul(w1, w1);
        if (!INV) bf4_fwd(x0, x1, x2, x3, w1, w2); else bf4_inv(x0, x1, x2, x3, w1, w2);
        st(el(0), x0); st(el(1), x1); st(el(2), x2); st(el(3), x3); }
    __syncthreads();
}
template <int N, class LD, class ST>
__device__ __forceinline__ void fft_r2(int tid, LD& ld, ST& st) {
#pragma unroll
    for (int it_ = 0; it_ < ((N >> 1) + NTH - 1) / NTH; ++it_) { const int idx = tid + it_ * NTH; if ((N >> 1) % NTH != 0 && idx >= (N >> 1)) break;
        const int pp = hy_phys(2 * idx); const F2 x0 = ld(pp), x1 = ld(pp + 1); st(pp, x0 + x1); st(pp + 1, x0 - x1); }
    __syncthreads();
}
template <int N, int M> struct FftFwd16 { template <class LD, class ST> static __device__ __forceinline__ void run(F2* X, const F2* T1, const F2* T2, int tid, LD& ld0, ST& stl) {
    LdsLd ldx{X}; LdsSt stx{X};
    if constexpr (M >= 16) {
        constexpr bool first = (M == N), last = (M / 16 <= 1);
        if constexpr (first && last) fft_r16<N, M, false>(T1, T2, tid, ld0, stl); else if constexpr (first) fft_r16<N, M, false>(T1, T2, tid, ld0, stx);
        else if constexpr (last) fft_r16<N, M, false>(T1, T2, tid, ldx, stl); else fft_r16<N, M, false>(T1, T2, tid, ldx, stx);
        if constexpr (!last) FftFwd16<N, M / 16>::run(X, T1, T2, tid, ld0, stl); }
    else if constexpr (M == 8) { fft_r4<N, 8, false>(T1, T2, tid, ldx, stx); fft_r2<N>(tid, ldx, stl); }
    else if constexpr (M == 4) { fft_r4<N, 4, false>(T1, T2, tid, ldx, stl); }
    else if constexpr (M == 2) { fft_r2<N>(tid, ldx, stl); } } };
template <int N, int M> struct FftInv16 { template <class LD, class ST> static __device__ __forceinline__ void run(F2* X, const F2* T1, const F2* T2, int tid, LD& ld0, ST& stl) {
    LdsLd ldx{X}; LdsSt stx{X};
    if constexpr (M >= 16) {
        constexpr bool last = (M == N), first = (M / 16 <= 1);
        if constexpr (!first) FftInv16<N, M / 16>::run(X, T1, T2, tid, ld0, stl);
        if constexpr (first && last) fft_r16<N, M, true>(T1, T2, tid, ld0, stl); else if constexpr (first) fft_r16<N, M, true>(T1, T2, tid, ld0, stx);
        else if constexpr (last) fft_r16<N, M, true>(T1, T2, tid, ldx, stl); else fft_r16<N, M, true>(T1, T2, tid, ldx, stx); }
    else if constexpr (M == 8) { fft_r2<N>(tid, ld0, stx); fft_r4<N, 8, true>(T1, T2, tid, ldx, stx); }
    else if constexpr (M == 4) { fft_r4<N, 4, true>(T1, T2, tid, ld0, stx); }
    else if constexpr (M == 2) { fft_r2<N>(tid, ld0, stx); } } };
template <int N, class LD, class ST> __device__ __forceinline__ void fft_fwd(F2* X, const F2* T1, const F2* T2, int tid, LD& ld0, ST& stl) { static_assert(N >= 32, "fft"); FftFwd16<N, N>::run(X, T1, T2, tid, ld0, stl); }
template <int N, class LD, class ST> __device__ __forceinline__ void fft_inv(F2* X, const F2* T1, const F2* T2, int tid, LD& ld0, ST& stl) { FftInv16<N, N>::run(X, T1, T2, tid, ld0, stl); }

template <bool ctxs>
__device__ __forceinline__ void hyena_item(const Params& p, char* lds, int l, int ch) {
    const int tid = TID(), bid = BID(), lane = tid & 63, wid = tid >> 6;
    constexpr int L = ctxs ? CTX : SEQ, N = 2 * L, k0 = ctxs ? SEQ : 0;
    F2* X = (F2*)(lds + HY_X); F2* T1 = (F2*)(lds + HY_T1); F2* T2 = (F2*)(lds + HY_T2); float* red = (float*)(lds + HY_RED);
    const bf16_t* HYT = WSP(bf16_t, OFF_HYT);
    F2* HF = WSP(F2, OFF_HF) + (long)bid * HY_XN; float* ZT = WSP(float, OFF_ZT) + (long)bid * 2 * SEQ; bf16_t* YAT = WSP(bf16_t, OFF_YAT);
    __syncthreads();
    if (tid < 128) { float s, c; float a = -6.283185307179586f * (float)(tid * 128) / (float)N; s = sinf(a); c = cosf(a); T1[tid] = (F2){c, s}; }
    else if (tid < 256) { int b_ = tid - 128; float s, c; float a = -6.283185307179586f * (float)b_ / (float)N; s = sinf(a); c = cosf(a); T2[b_] = (F2){c, s}; }
    __syncthreads();
    F4 cw[3];
#pragma unroll
    for (int sg = 0; sg < 3; ++sg) { const float* w = GIN(p.hy_conv) + ((long)l * 3 * MW + sg * MW + ch) * 3; cw[sg] = (F4){w[0], w[1], w[2], 0.f}; }
    auto conv8 = [&](int seg, int b, int t0, float (&o8)[8]) { const bf16_t* r = HYT + ((long)b * 3 * MW + seg * MW + ch) * KEYS + k0 + t0;
        const U4 c = *(const U4*)r; const float vm = t0 > 0 ? bf2f(r[-1]) : 0.f, vp = t0 + 8 < L ? bf2f(r[8]) : 0.f;
        const float v[10] = {vm, bflo(c.x), bfhi(c.x), bflo(c.y), bfhi(c.y), bflo(c.z), bfhi(c.z), bflo(c.w), bfhi(c.w), vp};
        const F4 w = seg == 0 ? cw[0] : (seg == 1 ? cw[1] : cw[2]);
#pragma unroll
        for (int j = 0; j < 8; ++j) o8[j] = v[j + 1] * w.y + v[j] * w.x + v[j + 2] * w.z; };
    constexpr int L8 = L / 8, NIT8 = (L8 + NTH - 1) / NTH;
    for (int o = 0; o < 2; ++o) {
        const bf16_t* tf = WSP(bf16_t, OFF_TAPS) + (long)(o * HYW + ch) * KEYS + k0; const bf16_t* tb = WSP(bf16_t, OFF_TAPS) + (long)(2 * HYW + o * HYW + ch) * KEYS + k0;
        const float sk = GIN(p.hy_skip)[((long)l * 2 + o) * HYW + ch];
        float nrm = 0.f;
#pragma unroll
        for (int it_ = 0; it_ < NIT8; ++it_) { const int i8 = tid + it_ * NTH; if (L8 % NTH != 0 && i8 >= L8) break; const int t0 = i8 * 8;
            const U4 fa = *(const U4*)(tf + t0), fb = *(const U4*)(tb + t0);
            const float af[8] = {bflo(fa.x), bfhi(fa.x), bflo(fa.y), bfhi(fa.y), bflo(fa.z), bfhi(fa.z), bflo(fa.w), bfhi(fa.w)};
            const float ab[8] = {bflo(fb.x), bfhi(fb.x), bflo(fb.y), bfhi(fb.y), bflo(fb.z), bfhi(fb.z), bflo(fb.w), bfhi(fb.w)};
#pragma unroll
            for (int j = 0; j < 4; ++j) *(F4*)(X + hy_phys(t0) + 2 * j) = (F4){af[2 * j], 0.f, af[2 * j + 1], 0.f};
#pragma unroll
            for (int j = 0; j < 8; ++j) { nrm += fabsf(af[j]);
                if (j == 0 && t0 == 0) X[hy_phys(L)] = (F2){0.f, 0.f}; else { X[hy_phys(N - t0 - j)] = (F2){ab[j], 0.f}; nrm += fabsf(ab[j]); } } }
        nrm = wave_sum(nrm);
        if (lane == 0) red[wid] = nrm;
        __syncthreads();
        auto st_hf = [&](int pp, F2 v) { HF[pp] = v; };
        { LdsLd ldx0{X}; fft_fwd<N>(X, T1, T2, tid, ldx0, st_hf); }
        auto zval8 = [&](int t0, float (&z0)[8], float (&z1)[8]) {
            if (o == 0) { conv8(0, 0, t0, z0); conv8(0, 1, t0, z1); }
            else { const F4 a0 = *(const F4*)(ZT + t0), a1 = *(const F4*)(ZT + t0 + 4), b0 = *(const F4*)(ZT + SEQ + t0), b1 = *(const F4*)(ZT + SEQ + t0 + 4);
                z0[0] = a0.x; z0[1] = a0.y; z0[2] = a0.z; z0[3] = a0.w; z0[4] = a1.x; z0[5] = a1.y; z0[6] = a1.z; z0[7] = a1.w;
                z1[0] = b0.x; z1[1] = b0.y; z1[2] = b0.z; z1[3] = b0.w; z1[4] = b1.x; z1[5] = b1.y; z1[6] = b1.z; z1[7] = b1.w; } };
        LdsSt stx{X}; LdsLd ldx{X};
#pragma unroll
        for (int it_ = 0; it_ < NIT8; ++it_) { const int i8 = tid + it_ * NTH; if (L8 % NTH != 0 && i8 >= L8) break; const int t0 = i8 * 8;
            float z0[8], z1[8]; zval8(t0, z0, z1);
            float zr = 0.f;
#ifndef CPU_EMU
            asm volatile("v_mov_b32 %0, 0" : "=v"(zr));
#endif
#pragma unroll
            for (int j = 0; j < 4; ++j) { *(F4*)(X + hy_phys(t0) + 2 * j) = (F4){z0[2 * j], z1[2 * j], z0[2 * j + 1], z1[2 * j + 1]}; *(F4*)(X + hy_phys(L + t0) + 2 * j) = (F4){zr, zr, zr, zr}; } }
        __syncthreads();
        fft_fwd<N>(X, T1, T2, tid, ldx, stx);
        float tot = 0.f;
#pragma unroll
        for (int w = 0; w < 8; ++w) tot += red[w];
        const float sc = 1.0f / (tot * (float)N);
        auto ld_mul = [&](int pp) -> F2 { return cmul(X[pp], HF[pp]); };
        fft_inv<N>(X, T1, T2, tid, ld_mul, stx);
#pragma unroll
        for (int it_ = 0; it_ < NIT8; ++it_) { const int i8 = tid + it_ * NTH; if (L8 % NTH != 0 && i8 >= L8) break; const int t0 = i8 * 8;
            float z0[8], z1[8], g0[8], g1[8], r0[8], r1[8]; zval8(t0, z0, z1); conv8(1 + o, 0, t0, g0); conv8(1 + o, 1, t0, g1);
#pragma unroll
            for (int j = 0; j < 4; ++j) { const F4 y = *(const F4*)(X + hy_phys(t0) + 2 * j);
                r0[2 * j] = g0[2 * j] * (y.x * sc + z0[2 * j] * sk); r1[2 * j] = g1[2 * j] * (y.y * sc + z1[2 * j] * sk);
                r0[2 * j + 1] = g0[2 * j + 1] * (y.z * sc + z0[2 * j + 1] * sk); r1[2 * j + 1] = g1[2 * j + 1] * (y.w * sc + z1[2 * j + 1] * sk); }
            if (o == 0) { *(F4*)(ZT + t0) = (F4){r0[0], r0[1], r0[2], r0[3]}; *(F4*)(ZT + t0 + 4) = (F4){r0[4], r0[5], r0[6], r0[7]};
                *(F4*)(ZT + SEQ + t0) = (F4){r1[0], r1[1], r1[2], r1[3]}; *(F4*)(ZT + SEQ + t0 + 4) = (F4){r1[4], r1[5], r1[6], r1[7]}; }
            else { *(U4*)(YAT + ((long)0 * MW + ch) * KEYS + k0 + t0) = (U4){pack2(r0[0], r0[1]), pack2(r0[2], r0[3]), pack2(r0[4], r0[5]), pack2(r0[6], r0[7])};
                *(U4*)(YAT + ((long)1 * MW + ch) * KEYS + k0 + t0) = (U4){pack2(r1[0], r1[1]), pack2(r1[2], r1[3]), pack2(r1[4], r1[5]), pack2(r1[6], r1[7])}; } }
        __syncthreads();
    }
}

__device__ __forceinline__ void phase_gdn_prep(const Params& p, char* lds, int l) {
    const int bid = BID(), G = gridDim.x;
    for (int rep_ = 0; rep_ < REP_GP; ++rep_) for (int it = bid; it < NTASK_GDN / 2; it += G) gdn_chunk_prep2(p, lds, l, it * 2);
}
__device__ __forceinline__ void phase_mixers(const Params& p, char* lds, int l, int qoff = 0, bool scans_only = false) {
    const int tid = TID();
    const bool ctx_out = l < DEPTH - 1;
    constexpr int NSCAN = BATCH * GH * 2 * 2, NQT_L = SEQ / 256, U_DL = BATCH * DH * NQT_L * 2, U_HY = MW, U_NA = BATCH * NH * (R_ROWS / 4);
    constexpr int NQC = CTX / 128, U_DC = BATCH * DH * NQC, U_NC = BATCH * NH * NQC, U_HC = MW;
    constexpr int U_CV8 = (U_CVT + 7) / 8, U_W3 = (4 * HYW * 128 + 8191) / 8192, U_H2 = (KEYS + 63) / 64;
    const int e0 = NSCAN * REP_GS, e1 = e0 + U_DL * REP_DIFF, e2 = e1 + U_HY * REP_HY, e3 = e2 + U_NA * REP_NA, e4 = e3 + (ctx_out ? U_DC : 0), e5 = e4 + (ctx_out ? U_NC : 0), e6 = e5 + (ctx_out ? U_HC : 0), e7 = e6 + (ctx_out ? U_CV8 : 0), e8 = e7 + (ctx_out ? U_W3 : 0), e9 = e8 + (ctx_out ? U_H2 : 0);
    u32* qctr = WSP(u32, OFF_CNT) + 64 + qoff + l;
    int* qs = (int*)(lds + LDS_BYTES - 16);
    for (;;) {
        __syncthreads();
        if (tid == 0) qs[0] = (int)atomicAdd(qctr, 1u);
        __syncthreads();
        const int u = qs[0];
        if (u >= (scans_only ? e0 : e9)) break;
        if (u < e0) gdn_scan_item(p, lds, l, u % NSCAN);
        else if (u < e1) { int v = (u - e0) % U_DL; const int comp = v & 1; v >>= 1; int b = v / (DH * NQT_L), r = v - b * DH * NQT_L, h = r / NQT_L, qt = r - h * NQT_L; diff32_item(p, lds, l, b, h, qt * 256, comp); }
        else if (u < e2) hyena_item<false>(p, lds, l, (u - e1) % U_HY);
        else if (u < e3) { int v = (u - e2) % U_NA; int b = v / (NH * (R_ROWS / 4)), r = v - b * NH * (R_ROWS / 4), h = r / (R_ROWS / 4), rq = r - h * (R_ROWS / 4); na32_item(p, lds, l, b, h, rq); }
        else if (u < e4) { int v = u - e3; int b = v / (DH * NQC), r = v - b * DH * NQC, h = r / NQC, q = r - h * NQC; diff_attn_item<1>(p, lds, l, b, h, q * 128, true); }
        else if (u < e5) { int v = u - e4; int b = v / (NH * NQC), r = v - b * NH * NQC, h = r / NQC, q = r - h * NQC; na_ctx_item(p, lds, b, h, q * 128); }
        else if (u < e6) hyena_item<true>(p, lds, l, u - e5);
        else if (u < e7) { const int c0 = (u - e6) * 8; for (int q = c0; q < c0 + 8 && q < U_CVT; ++q) cvt_unit(p, lds, l + 1, q); }
        else if (u < e8) w3t_chunk(p, l + 1, (u - e7) * 8192, 8192);
        else h2f_positions(p, l + 1, (u - e8) * 64, 8);
    }
}

__device__ __forceinline__ void phase_finish(const Params& p, char* lds, int l) {
    const int tid = TID(), bid = BID(), G = gridDim.x, lane = tid & 63, wid = tid >> 6;
    bf16_t* Y = WSP(bf16_t, OFF_Y);
    { const bf16_t* OFp = WSP(bf16_t, OFF_OF); const bf16_t* OBp = WSP(bf16_t, OFF_OB); const bf16_t* GZ = WSP(bf16_t, OFF_GZ); const float nw = GIN(p.gdn_norm)[l * 64 + lane];
        const long NR = (long)NTOK * GH, st8 = (long)G * 8;
        for (long i = (long)bid * 8 + wid; i < NR; i += 2 * st8) { const long i2 = i + st8; const bool two = i2 < NR;
            const long tokA = i / GH, tokB = two ? i2 / GH : tokA; const int hA = (int)(i - tokA * GH), hB = two ? (int)(i2 - tokB * GH) : hA;
            const long oA = tokA * MW + hA * 64 + lane, oB = tokB * MW + hB * 64 + lane;
            const float vA = bf2f(OFp[oA]) + bf2f(OBp[oA]), vB = bf2f(OFp[oB]) + bf2f(OBp[oB]);
            const float zA = bf2f(GZ[oA]), zB = bf2f(GZ[oB]);
            float sA = vA * vA, sB = vB * vB;
            sA = xadd<32>(sA); sB = xadd<32>(sB); sA = xadd<16>(sA); sB = xadd<16>(sB); sA = xadd<8>(sA); sB = xadd<8>(sB); sA = xadd<4>(sA); sB = xadd<4>(sB); sA = xadd<2>(sA); sB = xadd<2>(sB); sA = xadd<1>(sA); sB = xadd<1>(sB);
            Y[tokA * 4 * MW + MW + hA * 64 + lane] = f2bf(vA * rsqrtf(sA * (1.0f / 64.0f) + RMS_EPS) * nw * siluf(zA));
            if (two) Y[tokB * 4 * MW + MW + hB * 64 + lane] = f2bf(vB * rsqrtf(sB * (1.0f / 64.0f) + RMS_EPS) * nw * siluf(zB)); } }
    { const bf16_t* YAT = WSP(bf16_t, OFF_YAT); bf16_t* t = (bf16_t*)lds;
        constexpr int KT_ = KEYS / 64, CT_ = MW / 128;
        float lam, lam_init; diff_lambda(p, l, lam, lam_init);
        const float* nw = GIN(p.diff_norm) + l * 128;
        for (int u = bid; u < BATCH * CT_ * KT_; u += G) { int b = u / (CT_ * KT_), r = u - b * CT_ * KT_, ct = r / KT_, kt = r - ct * KT_;
            __syncthreads();
#pragma unroll
            for (int q = 0; q < 2; ++q) { int c = (tid >> 3) + 64 * q, s = tid & 7; *(U4*)(t + c * 72 + s * 8) = *(const U4*)(YAT + ((long)b * MW + ct * 128 + c) * KEYS + kt * 64 + s * 8); }
            if (kt * 64 < SEQ) {
                const int k = tid >> 3, sub = tid & 7; const long tok = bk_tok(b, kt * 64 + k); bf16_t* yr = Y + tok * 4 * MW;
                const U4 a0 = *(const U4*)(yr + 2 * MW + ct * 128 + sub * 16), a1 = *(const U4*)(yr + 2 * MW + ct * 128 + sub * 16 + 8), b0 = *(const U4*)(yr + ct * 128 + sub * 16), b1 = *(const U4*)(yr + ct * 128 + sub * 16 + 8);
                const u32 aw[8] = {a0.x, a0.y, a0.z, a0.w, a1.x, a1.y, a1.z, a1.w}, bw[8] = {b0.x, b0.y, b0.z, b0.w, b1.x, b1.y, b1.z, b1.w};
                float v[16]; float ss = 0.f;
#pragma unroll
                for (int e = 0; e < 8; ++e) { v[2 * e] = bflo(aw[e]) - lam * bflo(bw[e]); v[2 * e + 1] = bfhi(aw[e]) - lam * bfhi(bw[e]); ss += v[2 * e] * v[2 * e] + v[2 * e + 1] * v[2 * e + 1]; }
                ss = xadd<1>(ss); ss = xadd<2>(ss); ss = xadd<4>(ss);
                const float rr = rsqrtf(ss * (1.0f / 128.0f) + RMS_EPS) * (1.0f - lam_init);
                u32 o[8];
#pragma unroll
                for (int e = 0; e < 8; ++e) o[e] = pack2(v[2 * e] * rr * nw[sub * 16 + 2 * e], v[2 * e + 1] * rr * nw[sub * 16 + 2 * e + 1]);
                *(U4*)(yr + 2 * MW + ct * 128 + sub * 16) = (U4){o[0], o[1], o[2], o[3]}; *(U4*)(yr + 2 * MW + ct * 128 + sub * 16 + 8) = (U4){o[4], o[5], o[6], o[7]};
            }
            __syncthreads();
            { int k = tid >> 3; long tok = bk_tok(b, kt * 64 + k);
#pragma unroll
                for (int q = 0; q < 2; ++q) { const int c8 = (tid & 7) * 8 + 64 * q;
                    U4 o; o.x = (u32)t[(c8 + 0) * 72 + k] | ((u32)t[(c8 + 1) * 72 + k] << 16); o.y = (u32)t[(c8 + 2) * 72 + k] | ((u32)t[(c8 + 3) * 72 + k] << 16);
                    o.z = (u32)t[(c8 + 4) * 72 + k] | ((u32)t[(c8 + 5) * 72 + k] << 16); o.w = (u32)t[(c8 + 6) * 72 + k] | ((u32)t[(c8 + 7) * 72 + k] << 16);
                    *(U4*)(Y + tok * 4 * MW + ct * 128 + c8) = o; } } } }
}
__device__ __forceinline__ bool xcd_unit(int bid, int G, int i, int ntm, int ntn, int& tm, int& tn) {
    if ((G & 7) == 0) { const int x = bid & 7, v = i * (G >> 3) + (bid >> 3); tm = (v / ntn) * 8 + x; tn = v - (v / ntn) * ntn; return tm < ntm; }
    const int u = bid + i * G; tn = u / ntm; tm = u - tn * ntm; return u < ntm * ntn;
}
struct Merge1Prov {
    static constexpr int MT = 3, BM1 = 64 * MT, ntm = NTOK / BM1, ntn = D / G_BN;
    const bf16_t *Y, *BP, *GATE; bf16_t* MIXG; int bid, G; U2 tot[MT][4];
    __device__ __forceinline__ void tile(int i, int& row0, int& col0, int& br) const { int tm, tn; xcd_unit(bid, G, i >> 2, ntm, ntn, tm, tn); br = i & 3; row0 = tm * BM1; col0 = tn * G_BN; }
    __device__ __forceinline__ bool valid(int i) const { int tm, tn; return xcd_unit(bid, G, i >> 2, ntm, ntn, tm, tn); }
    __device__ __forceinline__ const bf16_t* arow(int i, int r) const { int row0, col0, br; tile(i, row0, col0, br); return Y + (long)(row0 + r) * 4 * MW + br * MW; }
    __device__ __forceinline__ const bf16_t* bbase(int i) const { int row0, col0, br; tile(i, row0, col0, br); return BP + (long)col0 * 4 * MW + br * MW; }
    U2 gpre[MT][4];
    __device__ __forceinline__ void pre(int i) { int row0, col0, br; tile(i, row0, col0, br);
        const int tid = TID(), wid = tid >> 6, lane = tid & 63, wm = wid >> 1, wn = wid & 1, l15 = lane & 15, g = lane >> 4;
#pragma unroll
        for (int m = 0; m < MT; ++m)
#pragma unroll
            for (int n = 0; n < 4; ++n) gpre[m][n] = *(const U2*)(GATE + ((((long)((row0 / BM1) * ntn + col0 / G_BN) * 4 + br) * 8 + wid) * 12 + (m * 4 + n)) * 256 + lane * 4);
        (void)wm; (void)wn; (void)l15; (void)g; }
    __device__ __forceinline__ void epi(int i, const f32x4 (&acc)[MT][4]) { int row0, col0, br; tile(i, row0, col0, br);
        const int tid = TID(), wid = tid >> 6, lane = tid & 63, wm = wid >> 1, wn = wid & 1, l15 = lane & 15, g = lane >> 4;
#pragma unroll
        for (int m = 0; m < MT; ++m) { const long row = row0 + wm * 16 * MT + m * 16 + l15;
#pragma unroll
            for (int n = 0; n < 4; ++n) { const U2 gv = gpre[m][n];
                const U2 tp = tot[m][n];
                f32x4 t = br == 0 ? (f32x4){0.f, 0.f, 0.f, 0.f} : (f32x4){bflo(tp.x), bfhi(tp.x), bflo(tp.y), bfhi(tp.y)};
                t[0] += sigmoidf(bflo(gv.x)) * acc[m][n][0]; t[1] += sigmoidf(bfhi(gv.x)) * acc[m][n][1]; t[2] += sigmoidf(bflo(gv.y)) * acc[m][n][2]; t[3] += sigmoidf(bfhi(gv.y)) * acc[m][n][3];
                const U2 o = (U2){pack2(t[0], t[1]), pack2(t[2], t[3])};
                tot[m][n] = o;
                if (br == 3) *(U2*)(MIXG + row * D + col0 + wn * 64 + n * 16 + g * 4) = o; } } }
};
#ifdef PROBE_G1
struct Merge1Dry : Merge1Prov { bool fire; __device__ __forceinline__ void epi(int i, const f32x4 (&acc)[MT][4]) { if (fire) Merge1Prov::epi(i, acc); }
#ifdef PROBE_G1NP
    __device__ __forceinline__ void pre(int i) { if (fire) Merge1Prov::pre(i); }
#endif
};
#endif
__device__ __forceinline__ void phase_merge1(const Params& p, char* lds, int l) {
    Merge1Prov pv; pv.Y = WSP(bf16_t, OFF_Y); pv.BP = WSP(bf16_t, off_bp(l)); pv.GATE = WSP(bf16_t, OFF_SEG_GATE); pv.MIXG = WSP(bf16_t, OFF_MIXG);
    pv.bid = BID(); pv.G = (int)gridDim.x;
    gemm_stream<Merge1Prov::MT>(lds, pv, 4 * MW, MW);
#ifdef PROBE_G1
    { Merge1Dry pd; pd.Y = pv.Y; pd.BP = pv.BP; pd.GATE = pv.GATE; pd.MIXG = pv.MIXG; pd.bid = pv.bid; pd.G = pv.G; pd.fire = p.stop_phase == 123456;
      for (int r_ = 0; r_ < 2; ++r_) gemm_stream<Merge1Prov::MT, Merge1Dry, PROBE_G1>(lds, pd, 4 * MW, MW); }
#endif
}
struct Merge2Prov {
    static constexpr int MT = 3, BM1 = 64 * MT, ntm = NTOK / BM1, ntn = D / G_BN;
    const bf16_t *MIXG, *WO; bf16_t* MIX; int bid, G;
    __device__ __forceinline__ void pre(int) const {}
    __device__ __forceinline__ void tile(int i, int& row0, int& col0) const { int tm, tn; xcd_unit(bid, G, i, ntm, ntn, tm, tn); row0 = tm * BM1; col0 = tn * G_BN; }
    __device__ __forceinline__ bool valid(int i) const { int tm, tn; return xcd_unit(bid, G, i, ntm, ntn, tm, tn); }
    __device__ __forceinline__ const bf16_t* arow(int i, int r) const { int row0, col0; tile(i, row0, col0); return MIXG + (long)(row0 + r) * D; }
    __device__ __forceinline__ const bf16_t* bbase(int i) const { int row0, col0; tile(i, row0, col0); return WO + (long)col0 * D; }
    __device__ __forceinline__ void epi(int i, const f32x4 (&acc)[MT][4]) const { int row0, col0; tile(i, row0, col0);
        const int tid = TID(), wid = tid >> 6, lane = tid & 63, wm = wid >> 1, wn = wid & 1, l15 = lane & 15, g = lane >> 4;
#pragma unroll
        for (int m = 0; m < MT; ++m) { const long row = row0 + wm * 16 * MT + m * 16 + l15;
#pragma unroll
            for (int n = 0; n < 4; ++n) st4bf(MIX + row * D + col0 + wn * 64 + n * 16 + g * 4, acc[m][n]); } }
};
#ifdef PROBE_G2
struct Merge2Dry : Merge2Prov { bool fire; __device__ __forceinline__ void epi(int i, const f32x4 (&acc)[MT][4]) const { if (fire) Merge2Prov::epi(i, acc); } };
#endif
__device__ __forceinline__ void phase_merge2(const Params& p, char* lds, int l) {
    Merge2Prov pv; pv.MIXG = WSP(bf16_t, OFF_MIXG); pv.WO = WSP(bf16_t, off_wo(l)); pv.MIX = WSP(bf16_t, OFF_MIX);
    pv.bid = BID(); pv.G = (int)gridDim.x;
    gemm_stream<Merge2Prov::MT>(lds, pv, D, D);
#ifdef PROBE_G2
    { Merge2Dry pd; pd.MIXG = pv.MIXG; pd.WO = pv.WO; pd.MIX = pv.MIX; pd.bid = pv.bid; pd.G = pv.G; pd.fire = p.stop_phase == 123456;
#ifdef PROBE_G2H
      for (int r_ = 0; r_ < 8; ++r_) gemm_stream<Merge2Prov::MT, Merge2Dry, PROBE_G2>(lds, pd, D, D / 2); }
#else
      for (int r_ = 0; r_ < 4; ++r_) gemm_stream<Merge2Prov::MT, Merge2Dry, PROBE_G2>(lds, pd, D, D); }
#endif
#endif
}
struct MoeMap { int cnt[NE], off[NE], tile0[NE + 1]; };
__device__ __forceinline__ void moe_map_load(const Params& p, int* sm  ) {
    const int tid = TID();
    __syncthreads();
    if (tid == 0) { const u32* CNT = WSP(u32, OFF_CNT); int o = 0, t = 0;
        for (int e = 0; e < NE; ++e) { int c = (int)CNT[e]; sm[e] = c; sm[NE + e] = o; sm[2 * NE + e] = t; o += c; t += (c + G_BM - 1) / G_BM; }
        sm[3 * NE] = t; }
    __syncthreads();
}
struct MoeProvBase {
    const int* sm; int bid, G, ntile, ntn;
    __device__ __forceinline__ void pre(int) const {}
    __device__ __forceinline__ bool valid(int i) const { int tg, tn; return xcd_unit(bid, G, i, ntile, ntn, tg, tn); }
    __device__ __forceinline__ void unit(int i, int& e, int& tn, int& r0, int& nrow, long& orow0) const { int tg; xcd_unit(bid, G, i, ntile, ntn, tg, tn);
        e = 0;
#pragma unroll
        for (int q = 1; q < NE; ++q) if (tg >= sm[2 * NE + q]) e = q;
        const int mt = tg - sm[2 * NE + e], cnt = sm[e]; r0 = mt * G_BM; nrow = cnt - r0 < G_BM ? cnt - r0 : G_BM; orow0 = (long)sm[NE + e] + r0; }
};
struct Moe1Prov : MoeProvBase {
    const bf16_t *H, *W13; bf16_t* HMID; const int* ELIST;
    __device__ __forceinline__ const bf16_t* arow(int i, int r) const { int e, tn, r0, nrow; long orow0; unit(i, e, tn, r0, nrow, orow0); const int rr = r < nrow ? r0 + r : r0; return H + (long)ELIST[(long)e * NTOK + rr] * D; }
    __device__ __forceinline__ const bf16_t* bbase(int i) const { int e, tn, r0, nrow; long orow0; unit(i, e, tn, r0, nrow, orow0); return W13 + ((long)e * 2 * EFF + tn * G_BN) * D; }
    __device__ __forceinline__ void epi(int i, const f32x4 (&acc)[4][4]) const { int e, tn, r0, nrow; long orow0; unit(i, e, tn, r0, nrow, orow0);
        const int tid = TID(), wid = tid >> 6, lane = tid & 63, wm = wid >> 1, wn = wid & 1, l15 = lane & 15, g = lane >> 4;
#pragma unroll
        for (int m = 0; m < 4; ++m) { const int r = wm * 64 + m * 16 + l15;
            if (r < nrow) {
#pragma unroll
                for (int n2 = 0; n2 < 2; ++n2) { f32x4 a = acc[m][2 * n2], b = acc[m][2 * n2 + 1], hmid;
#pragma unroll
                    for (int j = 0; j < 4; ++j) hmid[j] = siluf(a[j]) * b[j];
                    st4bf(HMID + (orow0 + r) * EFF + tn * (G_BN / 2) + wn * 32 + n2 * 16 + g * 4, hmid); } } } }
};
struct Moe2Prov : MoeProvBase {
    const bf16_t *HMID, *W2; bf16_t* YE;
    __device__ __forceinline__ const bf16_t* arow(int i, int r) const { int e, tn, r0, nrow; long orow0; unit(i, e, tn, r0, nrow, orow0); return HMID + (orow0 + r) * EFF; }
    __device__ __forceinline__ const bf16_t* bbase(int i) const { int e, tn, r0, nrow; long orow0; unit(i, e, tn, r0, nrow, orow0); return W2 + ((long)e * D + tn * G_BN) * EFF; }
    __device__ __forceinline__ void epi(int i, const f32x4 (&acc)[4][4]) const { int e, tn, r0, nrow; long orow0; unit(i, e, tn, r0, nrow, orow0);
        const int tid = TID(), wid = tid >> 6, lane = tid & 63, wm = wid >> 1, wn = wid & 1, l15 = lane & 15, g = lane >> 4;
#pragma unroll
        for (int m = 0; m < 4; ++m) { const int r = wm * 64 + m * 16 + l15;
            if (r < nrow) {
#pragma unroll
                for (int n = 0; n < 4; ++n) st4bf(YE + (orow0 + r) * D + tn * G_BN + wn * 64 + n * 16 + g * 4, acc[m][n]); } } }
};
#ifdef PROBE_M1
struct Moe1Dry : Moe1Prov { bool fire; __device__ __forceinline__ void epi(int i, const f32x4 (&acc)[4][4]) const { if (fire) Moe1Prov::epi(i, acc); } };
#endif
__device__ __forceinline__ void phase_moe1(const Params& p, char* lds, int l) {
    int* sm = (int*)(lds + G_LDS);
    moe_map_load(p, sm);
    Moe1Prov pv; pv.sm = sm; pv.bid = BID(); pv.G = (int)gridDim.x; pv.ntile = sm[3 * NE]; pv.ntn = 2 * EFF / G_BN;
    pv.H = WSP(bf16_t, OFF_H); pv.W13 = WSP(bf16_t, OFF_W13); pv.HMID = WSP(bf16_t, OFF_HMID); pv.ELIST = WSP(int, OFF_ELIST);
    gemm_stream<4>(lds, pv, D, D);
#ifdef PROBE_M1
    { Moe1Dry pd; pd.sm = pv.sm; pd.bid = pv.bid; pd.G = pv.G; pd.ntile = pv.ntile; pd.ntn = pv.ntn; pd.H = pv.H; pd.W13 = pv.W13; pd.HMID = pv.HMID; pd.ELIST = pv.ELIST; pd.fire = p.stop_phase == 123456;
      for (int r_ = 0; r_ < 2; ++r_) gemm_stream<4, Moe1Dry, PROBE_M1>(lds, pd, D, D); }
#endif
}
#ifdef PROBE_M2
struct Moe2Dry : Moe2Prov { bool fire; __device__ __forceinline__ void epi(int i, const f32x4 (&acc)[4][4]) const { if (fire) Moe2Prov::epi(i, acc); } };
#endif
__device__ __forceinline__ void phase_moe2(const Params& p, char* lds, int l) {
    int* sm = (int*)(lds + G_LDS);
    moe_map_load(p, sm);
    Moe2Prov pv; pv.sm = sm; pv.bid = BID(); pv.G = (int)gridDim.x; pv.ntile = sm[3 * NE]; pv.ntn = D / G_BN;
    pv.HMID = WSP(bf16_t, OFF_HMID); pv.W2 = WSP(bf16_t, OFF_W2); pv.YE = WSP(bf16_t, OFF_YE);
    gemm_stream<4>(lds, pv, EFF, EFF);
#ifdef PROBE_M2
    { Moe2Dry pd; pd.sm = pv.sm; pd.bid = pv.bid; pd.G = pv.G; pd.ntile = pv.ntile; pd.ntn = pv.ntn; pd.HMID = pv.HMID; pd.W2 = pv.W2; pd.YE = pv.YE; pd.fire = p.stop_phase == 123456;
      for (int r_ = 0; r_ < 2; ++r_) gemm_stream<4, Moe2Dry, PROBE_M2>(lds, pd, EFF, EFF); }
#endif
}
#ifdef PROBE_BAR
#define PHASE_END(id) do { GSYNC(); GSYNC(); if (p.stop_phase == (id)) return; } while (0)
#else
#define PHASE_END(id) do { GSYNC(); if (p.stop_phase == (id)) return; } while (0)
#endif

#if defined(CPU_EMU) || !defined(KARG_LAUNDER)
#define PP p_in
#else
__device__ __forceinline__ const Params& launder_params(const Params* q) { asm volatile("" : "+s"(q)); return *q; }
#define PP launder_params(kargs)
#endif
__global__ void __launch_bounds__(NTH, 2) fwd_kernel(Params p_in) {
#ifdef CPU_EMU
    char* lds = emu_lds();
    const Params& p = p_in;
#else
#ifdef KARG_LAUNDER
    const Params* kargs = (const Params*)__builtin_amdgcn_kernarg_segment_ptr();
    const Params& p = *kargs;
#else
    const Params& p = p_in;
#endif
    extern __shared__ __attribute__((aligned(16))) char lds_raw[];
    char* lds = lds_raw + 16;
    if (threadIdx.x == 0) *(uint4*)lds_raw = make_uint4(0u, 0u, 0u, 0u);
    __syncthreads();
    XcdBarrier xbar = xcd_barrier_post((unsigned*)(p.ws + OFF_BAR), (volatile LAS unsigned*)lds_raw);
#endif
#ifdef CPU_EMU
    if (threadIdx.x < 32) ((const float**)(lds + LDS_TBL_OFF))[threadIdx.x] = ((const float* const*)&p_in)[threadIdx.x];
#else
    if (threadIdx.x < 32) ((const float**)(lds + LDS_TBL_OFF))[threadIdx.x] = *(const float* const*)((const char*)__builtin_amdgcn_kernarg_segment_ptr() + threadIdx.x * 8);
#endif
    __syncthreads();
    phase_prologue(PP, lds);
    PHASE_END(1);
    for (int l = 0; l < DEPTH; ++l) {
        const int pb = 100 * (l + 1);
        if (l == 0) { phase_weights(PP, lds, l); PHASE_END(pb + 0); }
        if (l == 0) { phase_modulate0(PP, l); PHASE_END(pb + 1); }
        for (int rep_ = 0; rep_ < REP_IP; ++rep_) phase_inproj(PP, lds, l, 0);
        PHASE_END(pb + 2);
        phase_prep(PP, lds, l);
#ifdef PROBE_PREP
        phase_prep(PP, lds, l, false, PROBE_PREP & 1, PROBE_PREP & 2);
#endif
        PHASE_END(pb + 3);
        phase_gdn_prep(PP, lds, l);
        PHASE_END(pb + 4);
        phase_mixers(PP, lds, l);
#ifdef PROBE_P5
        GSYNC();
        phase_mixers(PP, lds, l, 16, PROBE_P5 == 2);
#endif
        PHASE_END(pb + 5);
        for (int rep_ = 0; rep_ < REP_FIN; ++rep_) phase_finish(PP, lds, l);
        PHASE_END(pb + 6);
        for (int rep_ = 0; rep_ < REP_IP; ++rep_) phase_inproj(PP, lds, l, 1);
        PHASE_END(pb + 7);
        for (int rep_ = 0; rep_ < REP_MG; ++rep_) phase_merge1(PP, lds, l);
        PHASE_END(pb + 8);
        for (int rep_ = 0; rep_ < REP_MG; ++rep_) phase_merge2(PP, lds, l);
        PHASE_END(pb + 9);
#ifdef PROBE_PM
        phase_post_mix(PP, lds, l, true);
#endif
        phase_post_mix(PP, lds, l);
        PHASE_END(pb + 10);
        for (int rep_ = 0; rep_ < REP_MOE; ++rep_) phase_moe1(PP, lds, l);
        PHASE_END(pb + 11);
        for (int rep_ = 0; rep_ < REP_MOE; ++rep_) phase_moe2(PP, lds, l);
        PHASE_END(pb + 12);
#ifdef PROBE_PE
        phase_post_moe(PP, l, true);
#endif
        phase_post_moe(PP, l);
        PHASE_END(pb + 13);
    }
}

extern "C" void kernel_launch(void* const* d_in, const int* in_sizes, int n_in, void* d_out, int out_size, void* d_ws, size_t ws_size, hipStream_t stream) {
    (void)in_sizes; (void)n_in; (void)out_size;
    if (ws_size < WS_NEED) return;
    Params p;
    memset(&p, 0, sizeof(p));
    const float** pp = (const float**)&p;
    for (int i = 0; i < 32; ++i) pp[i] = (const float*)d_in[i];
    p.out = (float*)d_out; p.ws = (char*)d_ws; p.stop_phase = -1;
#ifdef CPU_EMU
    { const char* sp = getenv("EMU_STOP"); if (sp) p.stop_phase = atoi(sp); }
    memset(d_ws, 0, SZ_BAR);
    int grid = 4; { const char* g = getenv("EMU_GRID"); if (g) grid = atoi(g); }
    emu_launch([](void* a) { fwd_kernel(*(Params*)a); }, &p, grid, NTH, LDS_BYTES);
#else
    static int grid = 0;
    if (!grid) {
        int dev = 0, cus = 0, per_cu = 0;
        (void)hipGetDevice(&dev);
        (void)hipDeviceGetAttribute(&cus, hipDeviceAttributeMultiprocessorCount, dev);
        (void)hipFuncSetAttribute((const void*)fwd_kernel, hipFuncAttributeMaxDynamicSharedMemorySize, LDS_BYTES + 16);
        (void)hipOccupancyMaxActiveBlocksPerMultiprocessor(&per_cu, (const void*)fwd_kernel, NTH, LDS_BYTES + 16);
        grid = per_cu >= 1 ? cus : 0;
        if (grid > GRID_MAX) grid = GRID_MAX;
    }
    if (!grid) return;
    (void)hipMemsetAsync(d_ws, 0, SZ_BAR, stream);
    hipLaunchKernelGGL(fwd_kernel, dim3(grid), dim3(NTH), LDS_BYTES + 16, stream, p);
#endif
}
```

```cpp
#ifdef CPU_EMU
#define SCHED_FENCE()
#define WAIT_LGKM()
#define WAIT_VM0()
#else
#include <hip/hip_runtime.h>
typedef short bf16x8 __attribute__((ext_vector_type(8)));
typedef float f32x4 __attribute__((ext_vector_type(4)));
#define SCHED_FENCE() __builtin_amdgcn_sched_barrier(0)
#define WAIT_LGKM() asm volatile("s_waitcnt lgkmcnt(0)" ::: "memory")
#define WAIT_VM0() asm volatile("s_waitcnt vmcnt(0)" ::: "memory")
#endif
#include <cstdint>
#include <cstddef>
#include <cstring>
#include <cstdlib>

#ifndef REP_DIFF
#define REP_DIFF 1
#endif
#ifndef REP_HY
#define REP_HY 1
#endif
#ifndef REP_NA
#define REP_NA 1
#endif
#ifndef REP_GP
#define REP_GP 1
#endif
#ifndef REP_GS
#define REP_GS 1
#endif
#ifndef REP_IP
#define REP_IP 1
#endif
#ifndef REP_W
#define REP_W 1
#endif
#ifndef REP_MG
#define REP_MG 1
#endif
#ifndef REP_MOE
#define REP_MOE 1
#endif
#ifndef REP_FIN
#define REP_FIN 1
#endif
typedef unsigned short bf16_t;
typedef unsigned int u32;
constexpr int LDS_BYTES = 160 * 1024 - 64;
typedef u32 U2 __attribute__((ext_vector_type(2)));
typedef u32 U4 __attribute__((ext_vector_type(4)));
typedef float F4 __attribute__((ext_vector_type(4)));
typedef float F2 __attribute__((ext_vector_type(2)));

#ifdef SMALL_DIMS
constexpr int D = 256, BATCH = 2, SEQ = 1024, DEPTH = 2, CTX = 128, GRID_MAX = 8;
#else
constexpr int D = 1024, BATCH = 2, SEQ = 8192, DEPTH = 4, CTX = 256, GRID_MAX = 256;
#endif
constexpr int NTH = 512;
constexpr int GW = 64, HD = 64;
constexpr int MW = D / 2;
constexpr int HYW = MW, HY_HID = 64, HY_BANDS = 16, HY_EMB = 33;
constexpr int GH = MW / 64, DH = MW / 128, NH = MW / 64;
constexpr int NE = 16, EFF = D / 2;
constexpr int NLAT = BATCH * SEQ, NCTX = BATCH * CTX, NTOK = NLAT + NCTX;
constexpr int KEYS = SEQ + CTX;
constexpr int IN_TOTAL = 13 * MW + 4 * GH + 4 * D;
constexpr int SRC_HY = 0, SRC_GQKV = 3 * MW, SRC_GZ = 6 * MW, SRC_GA = 7 * MW, SRC_DQKV = 7 * MW + 4 * GH, SRC_NQKV = 10 * MW + 4 * GH, SRC_GATE = 13 * MW + 4 * GH;
constexpr int GAB_W = ((13 * MW + 128) % 256 == 0) ? 128 : 256;
constexpr int MY_HY = 0, MY_GQKV = 3 * MW, MY_GZ = 6 * MW, MY_DQKV = 7 * MW, MY_NQKV = 10 * MW, MY_GAB = 13 * MW, MY_GATE = 13 * MW + GAB_W, NPROJ1 = 13 * MW + GAB_W, NPROJ = NPROJ1 + 4 * D;
constexpr float LN_EPS = 1e-5f, RMS_EPS = 1e-6f;
constexpr int NSLOT = 2 * NTOK;
constexpr int R_ROWS = SEQ / GW;
constexpr int NCH_LAT = SEQ / 64, NCH_CTX = CTX / 64, NCH = NCH_LAT + NCH_CTX;
constexpr int NTASK_GDN = BATCH * GH * 2 * NCH;
static_assert(KEYS % 192 == 0 && NTOK % 192 == 0 && NTOK % 256 == 0 && MW % 128 == 0 && SEQ % 256 == 0 && CTX % 64 == 0, "dims");

constexpr size_t al256(size_t x) { return (x + 255) & ~(size_t)255; }
constexpr size_t SZ_BAR = 16384;
constexpr size_t OFF_BAR = 0;
constexpr size_t OFF_CNT = OFF_BAR + SZ_BAR;
constexpr size_t OFF_MODP = OFF_CNT + 4096;
constexpr size_t OFF_MOD = OFF_MODP + al256((size_t)DEPTH * 8 * 3 * 6 * D * 4);
constexpr size_t OFF_XS = OFF_MOD + al256((size_t)DEPTH * 3 * 6 * D * 4);
constexpr size_t OFF_H = OFF_XS + (size_t)NTOK * D * 4;
constexpr size_t OFF_GZ = OFF_H + (size_t)NTOK * D * 2;
constexpr size_t OFF_GAB = OFF_GZ + (size_t)NTOK * MW * 2;
constexpr size_t OFF_GB = OFF_GAB + (size_t)NTOK * 32 * 4;
constexpr size_t OFF_Y = OFF_GB + (size_t)NTOK * 4 * GH * 4;
constexpr size_t OFF_WIN = OFF_Y + (size_t)NTOK * 4 * MW * 2;
constexpr size_t OFF_BP = OFF_WIN + (size_t)NPROJ * D * 2;
constexpr size_t OFF_WO = OFF_BP + (size_t)D * 4 * MW * 2;
constexpr size_t OFF_H2F = OFF_WO + (size_t)D * D * 2;
constexpr size_t OFF_H2B = OFF_H2F + al256((size_t)KEYS * 64 * 4);
constexpr size_t OFF_W3T = OFF_H2B + (size_t)KEYS * 128 * 2;
constexpr size_t OFF_RWT = OFF_W3T + (size_t)4 * HYW * 128 * 2;
constexpr size_t OFF_TOKE = OFF_RWT + (size_t)16 * D * 4;
constexpr size_t OFF_TOKR = OFF_TOKE + (size_t)NTOK * 2 * 4;
constexpr size_t OFF_TOKW = OFF_TOKR + (size_t)NTOK * 2 * 4;
constexpr size_t OFF_ELIST = OFF_TOKW + (size_t)NTOK * 2 * 4;
constexpr size_t OFF_RC = OFF_ELIST + (size_t)NE * NTOK * 4;
constexpr size_t OFF_DVT = OFF_RC;
constexpr size_t OFF_NVT = OFF_DVT + (size_t)BATCH * MW * KEYS * 2;
constexpr size_t OFF_GQ = OFF_NVT + (size_t)BATCH * MW * KEYS * 2;
constexpr size_t OFF_GK = OFF_GQ + (size_t)NTOK * MW * 2;
constexpr size_t OFF_GV = OFF_GK + (size_t)NTOK * MW * 2;
constexpr size_t OFF_RA = OFF_GV + (size_t)NTOK * MW * 2;
constexpr size_t SZ_SEG3 = (size_t)NTOK * 3 * MW * 2;
constexpr size_t OFF_SEG_HY = OFF_RA;
constexpr size_t OFF_SEG_GQKV = OFF_RA + SZ_SEG3;
constexpr size_t OFF_SEG_DQKV = OFF_RA + 2 * SZ_SEG3;
constexpr size_t OFF_SEG_NQKV = OFF_RA + 3 * SZ_SEG3;
constexpr size_t SZ_RA_W = (size_t)NTOK * 4 * D * 2 + (size_t)NE * 3 * EFF * D * 2;
constexpr size_t SZ_RA = 4 * SZ_SEG3 > SZ_RA_W ? 4 * SZ_SEG3 : SZ_RA_W;
constexpr size_t OFF_OF = OFF_RA;
constexpr size_t OFF_OB = OFF_OF + (size_t)NTOK * MW * 2;
constexpr size_t OFF_YAT = OFF_OB + (size_t)NTOK * MW * 2;
constexpr size_t OFF_HF = OFF_YAT + (size_t)BATCH * MW * KEYS * 2;
constexpr size_t HY_XN = 2 * SEQ + ((2 * SEQ) >> 6) * 4;
constexpr size_t OFF_SEG_GATE = OFF_RA;
constexpr size_t OFF_W13 = OFF_RA + (size_t)NTOK * 4 * D * 2;
constexpr size_t OFF_W2 = OFF_W13 + (size_t)NE * 2 * EFF * D * 2;
static_assert(OFF_HF + (size_t)GRID_MAX * HY_XN * 8 <= OFF_SEG_DQKV, "R1 overflow");
static_assert((size_t)NTOK * 4 * D * 2 <= SZ_RA, "gate overflow");
static_assert(OFF_W2 + (size_t)NE * D * EFF * 2 <= OFF_RA + SZ_RA, "expert weights overflow");
constexpr size_t OFF_RB = OFF_RA + SZ_RA;
constexpr size_t OFF_HYT = OFF_RB;
constexpr size_t OFF_WU = OFF_HYT + (size_t)BATCH * 3 * MW * KEYS * 2;
constexpr size_t OFF_TAPS = OFF_WU + (size_t)NTASK_GDN * 2 * 64 * 64 * 2;
constexpr size_t OFF_ZT = OFF_TAPS + (size_t)4 * HYW * KEYS * 2;
static_assert((size_t)GRID_MAX * 2 * SEQ * 4 <= (size_t)4 * HYW * KEYS * 2, "ZT overflow");
constexpr size_t OFF_MIXG = OFF_RB;
constexpr size_t OFF_MIX = OFF_MIXG + (size_t)NTOK * D * 2;
constexpr size_t OFF_HMID = OFF_MIX + (size_t)NTOK * D * 4;
constexpr size_t OFF_YE = OFF_HMID + (size_t)(NSLOT + 256) * EFF * 2;
constexpr size_t SZ_RB_LATE = OFF_YE + (size_t)(NSLOT + 256) * D * 2 - OFF_RB;
constexpr size_t SZ_RB_EARLY = OFF_TAPS + (size_t)4 * HYW * KEYS * 4 - OFF_RB;
constexpr size_t SZ_RB = SZ_RB_LATE > SZ_RB_EARLY ? SZ_RB_LATE : SZ_RB_EARLY;
constexpr size_t SZ_WSET = (size_t)NPROJ * D * 2 + (size_t)D * 4 * MW * 2 + (size_t)D * D * 2;
constexpr size_t OFF_WSET2 = OFF_RB + SZ_RB;
constexpr size_t WS_NEED = OFF_WSET2 + SZ_WSET;
__host__ __device__ constexpr size_t off_win(int l) { return (l & 1) ? OFF_WSET2 : OFF_WIN; }
__host__ __device__ constexpr size_t off_bp(int l) { return (l & 1) ? OFF_WSET2 + (size_t)NPROJ * D * 2 : OFF_BP; }
__host__ __device__ constexpr size_t off_wo(int l) { return (l & 1) ? OFF_WSET2 + (size_t)NPROJ * D * 2 + (size_t)D * 4 * MW * 2 : OFF_WO; }

struct Params {
    const float *x, *c, *ctx, *c_ctx, *w_mod, *b_mod, *w_in, *hy_conv, *hy_w1, *hy_b1, *hy_w2, *hy_b2, *hy_w3, *hy_freq, *hy_deltas, *hy_skip,
        *gdn_conv, *gdn_a_log, *gdn_dt_bias, *gdn_norm, *diff_lam, *diff_norm, *na_rpb, *branch_proj, *w_out, *ln_g, *ln_b, *router_w, *router_b,
        *exp_w1, *exp_w3, *exp_w2;
    float* out; char* ws; long long stop_phase;
};

#ifdef CPU_EMU
#define GPTR(T, ptr) ((T*)(ptr))
#else
#define GPTR(T, ptr) ((T*)(__attribute__((address_space(1))) T*)(ptr))
#endif
constexpr int LDS_TBL_OFF = LDS_BYTES - 16 - 256;
#ifdef CPU_EMU
__device__ __forceinline__ const float* gin_tbl(int idx) { return ((const float* const*)(emu_lds() + LDS_TBL_OFF))[idx]; }
#else
__device__ __forceinline__ const float* gin_tbl(int idx) { extern __shared__ __attribute__((aligned(16))) char lds_raw[]; return GPTR(const float, ((const float* const*)(lds_raw + 16 + LDS_TBL_OFF))[idx]); }
#endif
#define GIN(expr) gin_tbl((int)(((const char*)&(expr)) - ((const char*)&p)) >> 3)
#ifdef CPU_EMU
#define TID() ((int)threadIdx.x)
#define BID() ((int)blockIdx.x)
#else
__device__ __forceinline__ int TID() { int t = threadIdx.x; asm volatile("" : "+v"(t)); return t; }
__device__ __forceinline__ int BID() { int t = blockIdx.x; asm volatile("" : "+s"(t)); return t; }
#endif
__device__ __forceinline__ u32 f2u(float f) { union { float f; u32 u; } c; c.f = f; return c.u; }
__device__ __forceinline__ float u2f(u32 u) { union { float f; u32 u; } c; c.u = u; return c.f; }
#ifdef CPU_EMU
__device__ __forceinline__ bf16_t f2bf(float f) { u32 u = f2u(f); u += 0x7fffu + ((u >> 16) & 1u); return (bf16_t)(u >> 16); }
#else
typedef __bf16 hw_bf16x2 __attribute__((ext_vector_type(2)));
__device__ __forceinline__ bf16_t f2bf(float f) { const hw_bf16x2 r = __builtin_convertvector((F2){f, 0.f}, hw_bf16x2); u32 u; __builtin_memcpy(&u, &r, 4); return (bf16_t)(u & 0xffffu); }
#endif
__device__ __forceinline__ float bf2f(bf16_t h) { return u2f(((u32)h) << 16); }
#ifdef CPU_EMU
__device__ __forceinline__ u32 pack2(float lo, float hi) { return (u32)f2bf(lo) | ((u32)f2bf(hi) << 16); }
__device__ __forceinline__ float fexp2(float x) { return exp2f(x); }
#else
__device__ __forceinline__ u32 pack2(float lo, float hi) { const hw_bf16x2 r = __builtin_convertvector((F2){lo, hi}, hw_bf16x2); u32 u; __builtin_memcpy(&u, &r, 4); return u; }
__device__ __forceinline__ float fexp2(float x) { return __builtin_amdgcn_exp2f(x); }
#endif
__device__ __forceinline__ float bflo(u32 w) { return u2f(w << 16); }
__device__ __forceinline__ float bfhi(u32 w) { return u2f(w & 0xffff0000u); }
#ifdef CPU_EMU
__device__ __forceinline__ float sigmoidf(float x) { return 1.0f / (1.0f + expf(-x)); }
#else
__device__ __forceinline__ float sigmoidf(float x) { return __builtin_amdgcn_rcpf(1.0f + __builtin_amdgcn_exp2f(x * -1.4426950408889634f)); }
#endif
__device__ __forceinline__ float siluf(float x) { return x * sigmoidf(x); }
#ifdef CPU_EMU
template <int O> __device__ __forceinline__ float xadd(float v) { return v + __shfl_xor(v, O); }
template <int O> __device__ __forceinline__ float xmax(float v) { return fmaxf(v, __shfl_xor(v, O)); }
#else
template <int O> __device__ __forceinline__ float xadd(float v) {
    if constexpr (O == 32) { const auto r = __builtin_amdgcn_permlane32_swap(__float_as_uint(v), __float_as_uint(v), false, false); return __uint_as_float(r[0]) + __uint_as_float(r[1]); }
    else return v + __int_as_float(__builtin_amdgcn_ds_swizzle(__float_as_int(v), (O << 10) | 0x1f)); }
template <int O> __device__ __forceinline__ float xmax(float v) {
    if constexpr (O == 32) { const auto r = __builtin_amdgcn_permlane32_swap(__float_as_uint(v), __float_as_uint(v), false, false); return fmaxf(__uint_as_float(r[0]), __uint_as_float(r[1])); }
    else return fmaxf(v, __int_as_float(__builtin_amdgcn_ds_swizzle(__float_as_int(v), (O << 10) | 0x1f))); }
#endif
__device__ __forceinline__ float wave_sum(float v) { v = xadd<32>(v); v = xadd<16>(v); v = xadd<8>(v); v = xadd<4>(v); v = xadd<2>(v); v = xadd<1>(v); return v; }
__device__ __forceinline__ float wave_max(float v) { v = xmax<32>(v); v = xmax<16>(v); v = xmax<8>(v); v = xmax<4>(v); v = xmax<2>(v); v = xmax<1>(v); return v; }
__device__ __forceinline__ bf16x8 ld8(const bf16_t* p) { return *(const bf16x8*)p; }
__device__ __forceinline__ bf16x8 mk8(U2 a, U2 b) { union { struct { U2 a, b; } s; bf16x8 v; } c; c.s.a = a; c.s.b = b; return c.v; }
__device__ __forceinline__ bf16x8 mk8u(u32 a, u32 b, u32 c0, u32 d) { union { u32 u[4]; bf16x8 v; } c; c.u[0] = a; c.u[1] = b; c.u[2] = c0; c.u[3] = d; return c.v; }
#define MFMA16(a, b, c) __builtin_amdgcn_mfma_f32_16x16x32_bf16(a, b, c, 0, 0, 0)
__device__ __forceinline__ int mod_row(int tok) { return tok < NLAT ? tok / SEQ : 2; }
__device__ __forceinline__ void tok_bk(int tok, int& b, int& key) { if (tok < NLAT) { b = tok / SEQ; key = tok - b * SEQ; } else { int t = tok - NLAT; b = t / CTX; key = SEQ + t - b * CTX; } }
__device__ __forceinline__ int bk_tok(int b, int key) { return key < SEQ ? b * SEQ + key : NLAT + b * CTX + (key - SEQ); }
#ifdef CPU_EMU
struct XcdBarrier { int dummy; };
#define GSYNC() emu_grid_sync()
#else
#define XB_TMO      128
#define XB_XCNT(j)  (256  + 64 * (j))
#define XB_XSUB(j)  (1280 + 64 * (j))
#define XB_XGEN(j)  (2304 + 64 * (j))
#define XB_TOP      3328
#define XB_TOPGEN   3392
#define XCD_BAR_WORDS 3456
#define XB_SPIN_CAP (1u << 22)
#define LAS __attribute__((address_space(3)))
__device__ __forceinline__ unsigned xb_ld(unsigned* p)              { return __hip_atomic_load(p, __ATOMIC_RELAXED, __HIP_MEMORY_SCOPE_AGENT); }
__device__ __forceinline__ unsigned xb_add(unsigned* p, unsigned v) { return __hip_atomic_fetch_add(p, v, __ATOMIC_RELAXED, __HIP_MEMORY_SCOPE_AGENT); }
__device__ __forceinline__ unsigned xb_xcc_id() { return (unsigned)__builtin_amdgcn_s_getreg((3 << 11) | 20) & 0xFu; }
#define XB_SPIN(cond, bar) do { unsigned _sp = 0; while (cond) { __builtin_amdgcn_s_sleep(1); \
    if ((++_sp & 255u) == 0u) { if (xb_ld(&(bar)[XB_TMO])) break; if (_sp > XB_SPIN_CAP) { atomicAdd(&(bar)[XB_TMO], 1u); break; } } } } while (0)
struct XcdBarrier { unsigned* bar; unsigned x; volatile LAS unsigned* st; };
__device__ __forceinline__ XcdBarrier xcd_barrier_post(unsigned* bar, volatile LAS unsigned* st) {
    XcdBarrier b; b.bar = bar; b.x = xb_xcc_id(); b.st = st;
    if (threadIdx.x == 0) (void)xb_add(&bar[XB_XCNT(b.x)], 1u);
    return b;
}
__device__ __forceinline__ void xcd_barrier_complete(unsigned* bar, unsigned x, unsigned& nloc, unsigned& nx) {
    const unsigned G = gridDim.x * gridDim.y * gridDim.z;
    unsigned sum, cnt, mine, sp = 0u;
    for (;;) {
        sum = 0u; cnt = 0u; mine = 0u;
#pragma unroll
        for (unsigned j = 0; j < 16; ++j) { const unsigned c = xb_ld(&bar[XB_XCNT(j)]); sum += c; cnt += (c > 0u) ? 1u : 0u; mine = (j == x) ? c : mine; }
        if (sum == G) break;
        __builtin_amdgcn_s_sleep(1);
        if ((++sp & 255u) == 0u) { if (xb_ld(&bar[XB_TMO])) break; if (sp > XB_SPIN_CAP) { atomicAdd(&bar[XB_TMO], 1u); break; } }
    }
    nloc = mine > 0u ? mine : 1u; nx = cnt > 0u ? cnt : 1u;
}
__device__ __forceinline__ void xcd_barrier(const XcdBarrier& b) {
    asm volatile("s_waitcnt vmcnt(0)" ::: "memory");
    __syncthreads();
    if (threadIdx.x == 0) {
        unsigned* bar = b.bar;
        __builtin_amdgcn_s_waitcnt(0);
        unsigned nloc = b.st[0], nx = b.st[1];
        if (nloc == 0u) { xcd_barrier_complete(bar, b.x, nloc, nx); b.st[0] = nloc; b.st[1] = nx; }
        const unsigned old = xb_add(&bar[XB_XSUB(b.x)], 1u);
        const unsigned gen = old / nloc;
        if (old + 1u == (gen + 1u) * nloc) {
            __builtin_amdgcn_fence(__ATOMIC_RELEASE, "agent");
            asm volatile("s_waitcnt vmcnt(0)" ::: "memory");
            const unsigned og = xb_add(&bar[XB_TOP], 1u);
            const unsigned tg = og / nx;
            if (og + 1u == (tg + 1u) * nx) xb_add(&bar[XB_TOPGEN], 1u);
            else XB_SPIN(xb_ld(&bar[XB_TOPGEN]) == tg, bar);
            __builtin_amdgcn_fence(__ATOMIC_ACQUIRE, "agent");
            xb_add(&bar[XB_XGEN(b.x)], 1u);
            asm volatile("s_waitcnt vmcnt(0)" ::: "memory");
        } else {
            XB_SPIN(xb_ld(&bar[XB_XGEN(b.x)]) == gen, bar);
            __builtin_amdgcn_fence(__ATOMIC_ACQUIRE, "agent");
            asm volatile("s_waitcnt vmcnt(0)" ::: "memory");
        }
    }
    __syncthreads();
}
#define GSYNC() xcd_barrier(xbar)
#endif

constexpr int G_BM = 256, G_BN = 128, G_BK = 64, G_LD = 80;
constexpr int G_STAGE = (G_BM + G_BN) * G_LD * 2;
constexpr int G_LDS = 2 * G_STAGE;

template <int MT = 4, class ARow>
__device__ __forceinline__ void gemm_tile(char* lds, ARow arow  , const bf16_t* Bt, long ldb, int K, f32x4 (&acc)[MT][4]) {
    const int tid = TID(), wid = tid >> 6, lane = tid & 63, wm = wid >> 1, wn = wid & 1, l15 = lane & 15, g = lane >> 4;
#pragma unroll
    for (int m = 0; m < MT; ++m)
#pragma unroll
        for (int n = 0; n < 4; ++n) acc[m][n] = (f32x4){0.f, 0.f, 0.f, 0.f};
    const bf16_t* ap[MT]; const bf16_t* bp[2];
#pragma unroll
    for (int i = 0; i < MT; ++i) { int pc = tid + i * NTH; int r = pc >> 3, s = pc & 7; ap[i] = arow(r) + s * 8; }
#pragma unroll
    for (int i = 0; i < 2; ++i) { int pc = tid + i * NTH; int r = pc >> 3, s = pc & 7; bp[i] = Bt + (long)r * ldb + s * 8; }
    U4 ra[2][MT], rb[2][2];
    const int nk = K / G_BK;
#define GT_LOAD(set, kt) do { _Pragma("unroll") for (int i = 0; i < MT; ++i) ra[set][i] = *(const U4*)(ap[i] + (kt) * G_BK); _Pragma("unroll") for (int i = 0; i < 2; ++i) rb[set][i] = *(const U4*)(bp[i] + (kt) * G_BK); } while (0)
#define GT_STORE(set, st) do { bf16_t* dA = (bf16_t*)(lds + (st) * G_STAGE); bf16_t* dB = dA + G_BM * G_LD; \
        _Pragma("unroll") for (int i = 0; i < MT; ++i) { int pc = tid + i * NTH; int r = pc >> 3, s = pc & 7; *(U4*)(dA + r * G_LD + s * 8) = ra[set][i]; } \
        _Pragma("unroll") for (int i = 0; i < 2; ++i) { int pc = tid + i * NTH; int r = pc >> 3, s = pc & 7; *(U4*)(dB + r * G_LD + s * 8) = rb[set][i]; } } while (0)
#define GT_COMPUTE(st) do { const bf16_t* sA = (const bf16_t*)(lds + (st) * G_STAGE); const bf16_t* sB = sA + G_BM * G_LD; \
        _Pragma("unroll") for (int ks = 0; ks < 2; ++ks) { bf16x8 af[MT], bfr[4]; \
            _Pragma("unroll") for (int m = 0; m < MT; ++m) af[m] = ld8(sA + (wm * 16 * MT + m * 16 + l15) * G_LD + ks * 32 + g * 8); \
            _Pragma("unroll") for (int n = 0; n < 4; ++n) bfr[n] = ld8(sB + (wn * 64 + n * 16 + l15) * G_LD + ks * 32 + g * 8); \
            _Pragma("unroll") for (int m = 0; m < MT; ++m) _Pragma("unroll") for (int n = 0; n < 4; ++n) acc[m][n] = MFMA16(bfr[n], af[m], acc[m][n]); } } while (0)
    GT_LOAD(0, 0);
    GT_LOAD(1, 1);
    __syncthreads();
    GT_STORE(0, 0);
    if (nk > 2) GT_LOAD(0, 2);
    __syncthreads();
    for (int kt = 0; kt < nk; kt += 2) {
        GT_COMPUTE(0);
        GT_STORE(1, 1);
        if (kt + 3 < nk) GT_LOAD(1, kt + 3);
        __syncthreads();
        GT_COMPUTE(1);
        if (kt + 2 < nk) { GT_STORE(0, 0); if (kt + 4 < nk) GT_LOAD(0, kt + 4); }
        __syncthreads();
    }
#undef GT_LOAD
#undef GT_STORE
#undef GT_COMPUTE
}

template <int MT, class Prov, int MODE = 0>
__device__ __forceinline__ void gemm_stream(char* lds, Prov& pv, const long ldb, const int K) {
    const int tid = TID(), wid = tid >> 6, lane = tid & 63, wm = wid >> 1, wn = wid & 1, l15 = lane & 15, g = lane >> 4;
    if (!pv.valid(0)) return;
    const bf16_t* ap[MT]; const bf16_t* bp[2]; const bf16_t* apn[MT]; const bf16_t* bpn[2];
    U4 ra[2][MT], rb[2][2];
    const int nk = K / G_BK;
#define GS_PTRS(AP, BP, i) do { const int tq_ = TID(); _Pragma("unroll") for (int q_ = 0; q_ < MT; ++q_) { int pc = tq_ + q_ * NTH; AP[q_] = pv.arow(i, pc >> 3) + (pc & 7) * 8; } \
        const bf16_t* bb_ = pv.bbase(i); _Pragma("unroll") for (int q_ = 0; q_ < 2; ++q_) { int pc = tq_ + q_ * NTH; BP[q_] = bb_ + (long)(pc >> 3) * ldb + (pc & 7) * 8; } } while (0)
#define GS_LOAD(set, AP, BP, kt) do { _Pragma("unroll") for (int q_ = 0; q_ < MT; ++q_) ra[set][q_] = *(const U4*)(AP[q_] + (kt) * G_BK); _Pragma("unroll") for (int q_ = 0; q_ < 2; ++q_) rb[set][q_] = *(const U4*)(BP[q_] + (kt) * G_BK); } while (0)
#define GS_LOADV(set, v) do { if (MODE == 2 || MODE == 4) break; if ((v) < nk) GS_LOAD(set, ap, bp, (v)); else if (hn) GS_LOAD(set, apn, bpn, (v) - nk); } while (0)
#define GS_STORE(set, st) do { if (MODE == 4) break; bf16_t* dA = (bf16_t*)(lds + (st) * G_STAGE); bf16_t* dB = dA + G_BM * G_LD; \
        _Pragma("unroll") for (int q_ = 0; q_ < MT; ++q_) { int pc = tid + q_ * NTH; *(U4*)(dA + (pc >> 3) * G_LD + (pc & 7) * 8) = ra[set][q_]; } \
        _Pragma("unroll") for (int q_ = 0; q_ < 2; ++q_) { int pc = tid + q_ * NTH; *(U4*)(dB + (pc >> 3) * G_LD + (pc & 7) * 8) = rb[set][q_]; } } while (0)
#define GS_COMPUTE(st) do { if (MODE == 3) break; const bf16_t* sA = (const bf16_t*)(lds + (st) * G_STAGE); const bf16_t* sB = sA + G_BM * G_LD; \
        _Pragma("unroll") for (int ks = 0; ks < 2; ++ks) { bf16x8 af[MT], bfr[4];     \
            _Pragma("unroll") for (int n = 0; n < 4; ++n) bfr[n] = ld8(sB + (wn * 64 + n * 16 + l15) * G_LD + ks * 32 + g * 8); \
            _Pragma("unroll") for (int m = 0; m < MT; ++m) af[m] = ld8(sA + (wm * 16 * MT + m * 16 + l15) * G_LD + ks * 32 + g * 8); \
            SCHED_FENCE(); \
            _Pragma("unroll") for (int m = 0; m < MT; ++m) _Pragma("unroll") for (int n = 0; n < 4; ++n) acc[m][n] = MFMA16(bfr[n], af[m], acc[m][n]); \
            SCHED_FENCE(); } } while (0)
    GS_PTRS(ap, bp, 0);
    GS_LOAD(0, ap, bp, 0);
    GS_LOAD(1, ap, bp, 1);
    __syncthreads();
    for (int i = 0;; ++i) {
        const bool hn = pv.valid(i + 1);
        if (hn) GS_PTRS(apn, bpn, i + 1);
        f32x4 acc[MT][4];
#pragma unroll
        for (int m = 0; m < MT; ++m)
#pragma unroll
            for (int n = 0; n < 4; ++n) acc[m][n] = (f32x4){0.f, 0.f, 0.f, 0.f};
        pv.pre(i);
        GS_STORE(0, 0);
        GS_LOADV(0, 2);
        __syncthreads();
        for (int kt = 0; kt < nk; kt += 2) {
            GS_COMPUTE(0);
            GS_STORE(1, 1);
            GS_LOADV(1, kt + 3);
            __syncthreads();
            GS_COMPUTE(1);
            if (kt + 2 < nk) { GS_STORE(0, 0); GS_LOADV(0, kt + 4); }
            __syncthreads();
        }
        pv.epi(i, acc);
        if (!hn) break;
#pragma unroll
        for (int q_ = 0; q_ < MT; ++q_) ap[q_] = apn[q_];
        bp[0] = bpn[0]; bp[1] = bpn[1];
    }
#undef GS_PTRS
#undef GS_LOAD
#undef GS_LOADV
#undef GS_STORE
#undef GS_COMPUTE
}

template <class SrcFn>
__device__ __forceinline__ void cvt_tile(char* lds, SrcFn srcp, int k0, int n0, bf16_t* dst, long dst_ld) {
    float* t = (float*)lds;
    const int tid = TID();
    __syncthreads();
#pragma unroll
    for (int i = 0; i < 2; ++i) { int kk = (tid >> 4) + 32 * i, n4 = (tid & 15) * 4; const float* sp = srcp(k0 + kk, n0 + n4);
        F4 v = sp ? *(const F4*)sp : (F4){0.f, 0.f, 0.f, 0.f};
        t[kk * 65 + n4] = v.x; t[kk * 65 + n4 + 1] = v.y; t[kk * 65 + n4 + 2] = v.z; t[kk * 65 + n4 + 3] = v.w; }
    __syncthreads();
    { int n = tid >> 3, k8 = (tid & 7) * 8; U4 o;
        o.x = pack2(t[(k8 + 0) * 65 + n], t[(k8 + 1) * 65 + n]); o.y = pack2(t[(k8 + 2) * 65 + n], t[(k8 + 3) * 65 + n]);
        o.z = pack2(t[(k8 + 4) * 65 + n], t[(k8 + 5) * 65 + n]); o.w = pack2(t[(k8 + 6) * 65 + n], t[(k8 + 7) * 65 + n]);
        *(U4*)(dst + (long)(n0 + n) * dst_ld + k0 + k8) = o; }
}

__device__ __forceinline__ void tr_tile(char* lds, const bf16_t* src, long ld, int tok0, int col0, int ncols, int cdst0, bf16_t* dst) {
    bf16_t* t = (bf16_t*)lds;
    const int tid = TID();
    __syncthreads();
    { int r = tid >> 3, s = tid & 7; *(U4*)(t + r * 72 + s * 8) = *(const U4*)(src + (long)(tok0 + r) * ld + col0 + s * 8); }
    __syncthreads();
    { int c = tid >> 3, t8 = (tid & 7) * 8; int b, key; tok_bk(tok0, b, key);
        U4 o; o.x = (u32)t[(t8 + 0) * 72 + c] | ((u32)t[(t8 + 1) * 72 + c] << 16); o.y = (u32)t[(t8 + 2) * 72 + c] | ((u32)t[(t8 + 3) * 72 + c] << 16);
        o.z = (u32)t[(t8 + 4) * 72 + c] | ((u32)t[(t8 + 5) * 72 + c] << 16); o.w = (u32)t[(t8 + 6) * 72 + c] | ((u32)t[(t8 + 7) * 72 + c] << 16);
        *(U4*)(dst + ((long)b * ncols + cdst0 + c) * KEYS + key + t8) = o; }
}
namespace pg8 {
#ifdef CPU_EMU
#define PG8_LAS
#else
#define PG8_LAS __attribute__((address_space(3)))
#endif
typedef unsigned short bf16_t;
typedef unsigned u32x4 __attribute__((ext_vector_type(4)));
constexpr int BM = 256, BK = 64, HALF = 128, HTB = HALF * BK * 2  , STAGE_BYTES = 8 * HTB, NXCD = 8, WGM = 8;

__host__ __device__ __forceinline__ int lds_byte(int r, int c) { const int st = (r >> 4) * 2 + (c >> 5), rr = r & 15, cc = c & 31, ob = rr * 64 + cc * 2; return st * 1024 + (ob ^ (((ob >> 9) & 1) << 5)); }
__host__ __device__ __forceinline__ void stage_rc(int b, int& R, int& C) { const int st = b / 1024, sb = b % 1024, swz = sb ^ (((sb >> 9) & 1) << 5); R = (st >> 1) * 16 + swz / 64; C = (st & 1) * 32 + (swz % 64) / 2; }
__host__ __device__ __forceinline__ int perm32(int rho) { const int n = rho >> 4, i = rho & 15; return 8 * (i >> 2) + 4 * n + (i & 3); }

struct Unit { int pm, pn; };
struct Gemm { const bf16_t* A; const bf16_t* Bt; int M, N, K; };

struct StaticOrder {
    int nM, nN, nwg, G, c;
    __host__ __device__ void init(int M, int N, int G_, int c_) { nM = M / BM; nN = N / BM; nwg = nM * nN; G = G_; c = c_; }
    __host__ __device__ bool next(int i, Unit& u) const {
        const long L = (long)i * G + c; if (L >= nwg) return false;
        int wgid = (int)L; { const int q = nwg / NXCD, r = nwg % NXCD, xcd = wgid % NXCD, off = wgid / NXCD; wgid = (xcd < r ? xcd * (q + 1) : r * (q + 1) + (xcd - r) * q) + off; }
        const int nig = WGM * nN, gid = wgid / nig, fm = gid * WGM, gsz = (nM - fm) < WGM ? (nM - fm) : WGM;
        u.pm = fm + ((wgid % nig) % gsz); u.pn = (wgid % nig) / gsz; return true;
    }
    __device__ __forceinline__ void a_ready(const Unit&) const {}
    __device__ __forceinline__ void done(const Unit&) const {}
};
template <class Epi, class Sched, bool STAMP = false>
__device__ __forceinline__ void gemm_phase(PG8_LAS unsigned char* lds, const Gemm g, const Sched& S, const Epi& E, unsigned long long* stamps) {
    const int tid = TID(), wid = __builtin_amdgcn_readfirstlane(tid >> 6), lane = tid & 63, wr = wid >> 2, wc = wid & 3, fr = lane & 15, fq = lane >> 4;
    const int K = g.K, nt = K / BK;
    int ts_lo = 0, ts_hi = 0, nts = 0; const unsigned long long rt_entry = STAMP ? (unsigned long long)wall_clock64() : 0ull;
#define PG8_STAMP() do { if (STAMP && wid == 0 && nts < 64) { const unsigned long long _c = (unsigned long long)clock64(); \
        ts_lo = (lane == nts) ? (int)(unsigned)_c : ts_lo; ts_hi = (lane == nts) ? (int)(unsigned)(_c >> 32) : ts_hi; ++nts; } } while (0)
    PG8_STAMP();
    unsigned voffA[2], voffB[2];
#pragma unroll
    for (int i = 0; i < 2; ++i) { int R, C; stage_rc(tid * 16 + i * 8192, R, C); const int Rb = Epi::PERM ? ((R & ~31) + perm32(R & 31)) : R;
        voffA[i] = (unsigned)(R * K + C) * 2u; voffB[i] = (unsigned)(Rb * K + C) * 2u; }
    const size_t kstep = (size_t)(BK * 2);
    const size_t hstep = (size_t)HALF * K * 2;
    const size_t tstep = 2 * hstep;
    const unsigned ldsw = (unsigned)wid * 1024u;
    const int aoff = lds_byte(wr * 64 + fr, fq * 8), boff = lds_byte(wc * 32 + fr, fq * 8);
#define PG8_SA(b, h) (((b) * 2 + (h)) * HTB)
#define PG8_SB(b, h) ((4 + (b) * 2 + (h)) * HTB)
#define PG8_STAGE(bufoff, gbase, voff) do { _Pragma("unroll") for (int _i = 0; _i < 2; ++_i) \
        __builtin_amdgcn_global_load_lds((const unsigned*)((const char*)(gbase) + (voff)[_i]), (PG8_LAS unsigned*)(lds + (bufoff) + ldsw + _i * 8192), 16, 0, 0); } while (0)
#define PG8_LDA(dst, b, h) do { _Pragma("unroll") for (int m = 0; m < 4; ++m) _Pragma("unroll") for (int k = 0; k < 2; ++k) dst[m][k] = *(const PG8_LAS bf16x8*)(lds + PG8_SA(b, h) + aoff + m * 2048 + k * 1024); } while (0)
#define PG8_LDB(dst, b, h) do { _Pragma("unroll") for (int n = 0; n < 2; ++n) _Pragma("unroll") for (int k = 0; k < 2; ++k) dst[n][k] = *(const PG8_LAS bf16x8*)(lds + PG8_SB(b, h) + boff + n * 2048 + k * 1024); } while (0)
#define PG8_MMA(ai, bj, At, Bt) do { __builtin_amdgcn_s_setprio(1); _Pragma("unroll") for (int m = 0; m < 4; ++m) _Pragma("unroll") for (int n = 0; n < 2; ++n) _Pragma("unroll") for (int k = 0; k < 2; ++k) \
        acc[ai][bj][m][n] = __builtin_amdgcn_mfma_f32_16x16x32_bf16(Bt[n][k], At[m][k], acc[ai][bj][m][n], 0, 0, 0); __builtin_amdgcn_s_setprio(0); } while (0)
#ifdef CPU_EMU
#define PG8_WAIT_V(n)
#define PG8_WAIT_L(n)
#else
#define PG8_WAIT_V(n) asm volatile("s_waitcnt vmcnt(" #n ")" ::: "memory")
#define PG8_WAIT_L(n) asm volatile("s_waitcnt lgkmcnt(" #n ")" ::: "memory")
#endif
#define PG8_BAR __builtin_amdgcn_s_barrier()
#define PG8_SCHED __builtin_amdgcn_sched_barrier(0)
    Unit cur, nxt; int ui = 0;
    if (!S.next(0, cur)) return;
    f32x4 acc[2][2][4][2];
#pragma unroll
    for (int a = 0; a < 2; ++a)
#pragma unroll
        for (int b = 0; b < 2; ++b)
#pragma unroll
            for (int m = 0; m < 4; ++m)
#pragma unroll
                for (int n = 0; n < 2; ++n) acc[a][b][m][n] = (f32x4){0.f, 0.f, 0.f, 0.f};
    bf16x8 At[4][2], B0[2][2], B1[2][2];
    const char* cA = (const char*)g.A + (size_t)cur.pm * tstep; const char* cB = (const char*)g.Bt + (size_t)cur.pn * tstep;
    S.a_ready(cur);
    PG8_STAGE(PG8_SB(0, 0), cB, voffB); PG8_STAGE(PG8_SA(0, 0), cA, voffA); PG8_STAGE(PG8_SB(0, 1), cB + hstep, voffB); PG8_STAGE(PG8_SA(0, 1), cA + hstep, voffA);
    if (wr == 1) PG8_BAR;
    PG8_WAIT_V(4); PG8_BAR;
    PG8_STAGE(PG8_SB(1, 0), cB + kstep, voffB); PG8_STAGE(PG8_SA(1, 0), cA + kstep, voffA); PG8_STAGE(PG8_SB(1, 1), cB + hstep + kstep, voffB);
    PG8_WAIT_V(6); PG8_BAR;
    PG8_STAMP();
    for (;;) {
        const bool has_next = S.next(ui + 1, nxt);
        const char* nA = has_next ? (const char*)g.A + (size_t)nxt.pm * tstep : cA; const char* nB = has_next ? (const char*)g.Bt + (size_t)nxt.pn * tstep : cB;
        for (int t = 0; t < nt; t += 2) {
            const bool last = (t == nt - 2);
            const char* a1 = cA + (size_t)(t + 1) * kstep;
            const char* a2 = last ? nA : cA + (size_t)(t + 2) * kstep; const char* b2 = last ? nB : cB + (size_t)(t + 2) * kstep;
            const char* a3 = a2 + kstep; const char* b3 = b2 + kstep;
            if (last && has_next) S.a_ready(nxt);
            PG8_LDB(B0, 0, 0); PG8_SCHED; PG8_LDA(At, 0, 0); PG8_STAGE(PG8_SA(1, 1), a1 + hstep, voffA);
            PG8_WAIT_L(8); PG8_BAR; PG8_WAIT_L(0); PG8_MMA(0, 0, At, B0); PG8_BAR; PG8_SCHED;
            PG8_LDB(B1, 0, 1); PG8_STAGE(PG8_SB(0, 0), b2, voffB);
            PG8_BAR; PG8_WAIT_L(0); PG8_MMA(0, 1, At, B1); PG8_BAR;
            PG8_LDA(At, 0, 1); PG8_STAGE(PG8_SA(0, 0), a2, voffA);
            PG8_BAR; PG8_WAIT_L(0); PG8_MMA(1, 0, At, B0); PG8_BAR; PG8_SCHED;
            PG8_STAGE(PG8_SB(0, 1), b2 + hstep, voffB);
            PG8_WAIT_V(6); PG8_BAR; PG8_MMA(1, 1, At, B1); PG8_BAR;
            PG8_LDB(B0, 1, 0); PG8_SCHED; PG8_LDA(At, 1, 0); PG8_STAGE(PG8_SA(0, 1), a2 + hstep, voffA);
            PG8_WAIT_L(8); PG8_BAR; PG8_WAIT_L(0); PG8_MMA(0, 0, At, B0); PG8_BAR; PG8_SCHED;
            PG8_LDB(B1, 1, 1); PG8_STAGE(PG8_SB(1, 0), b3, voffB);
            PG8_BAR; PG8_WAIT_L(0); PG8_MMA(0, 1, At, B1); PG8_BAR;
            PG8_LDA(At, 1, 1); PG8_STAGE(PG8_SA(1, 0), a3, voffA);
            PG8_BAR; PG8_WAIT_L(0); PG8_MMA(1, 0, At, B0); PG8_BAR; PG8_SCHED;
            PG8_STAGE(PG8_SB(1, 1), b3 + hstep, voffB);
            PG8_WAIT_V(6); PG8_BAR; PG8_MMA(1, 1, At, B1); PG8_BAR;
        }
        PG8_STAMP();
        if constexpr (!Epi::AFTER_DRAIN) { E(acc, cur, wr, wc, fr, fq); S.done(cur); }
        PG8_STAMP();
        if (!has_next) break;
#pragma unroll
        for (int a = 0; a < 2; ++a)
#pragma unroll
            for (int b = 0; b < 2; ++b)
#pragma unroll
                for (int m = 0; m < 4; ++m)
#pragma unroll
                    for (int n = 0; n < 2; ++n) acc[a][b][m][n] = (f32x4){0.f, 0.f, 0.f, 0.f};
        cur = nxt; cA = nA; cB = nB; ++ui;
    }
    PG8_WAIT_V(0);
    if (wr == 0) PG8_BAR;
    PG8_BAR;
    if constexpr (Epi::AFTER_DRAIN) { E.fused(acc, cur, wr, wc, fr, fq, lds, wid, lane); S.done(cur); }
    PG8_STAMP();
    if (STAMP && wid == 0) { stamps[lane] = lane < nts ? (((unsigned long long)(unsigned)ts_hi << 32) | (unsigned)ts_lo) : 0ull;
        if (lane == 62) stamps[62] = rt_entry; if (lane == 63) stamps[63] = (unsigned long long)wall_clock64(); }
#undef PG8_STAMP
#undef PG8_SA
#undef PG8_SB
#undef PG8_STAGE
#undef PG8_LDA
#undef PG8_LDB
#undef PG8_MMA
#undef PG8_WAIT_V
#undef PG8_WAIT_L
#undef PG8_BAR
#undef PG8_SCHED
}


__device__ __forceinline__ unsigned cvt_pk_bf16(float lo, float hi) { return pack2(lo, hi); }
__device__ __forceinline__ long gate_idx(int row, int br, int col) {
    const int tm = row / 192, r = row - tm * 192, wm = r / 48, r2 = r - wm * 48, m = r2 >> 4, l15 = r2 & 15;
    const int tn = col >> 7, c = col & 127, wn = c >> 6, n = (c >> 4) & 3, g = (c >> 2) & 3;
    return ((((long)(tm * (D / 128) + tn) * 4 + br) * 8 + (wm * 2 + wn)) * 12 + (m * 4 + n)) * 256 + (g * 16 + l15) * 4;
}
struct EpiInproj {
    static constexpr bool PERM = true, AFTER_DRAIN = false;
    char* ws; int ncol0;
    static __device__ __forceinline__ void st_tr(bf16_t* dT, long key, const f32x4& v0, const f32x4& v1) {
        dT[key] = f2bf(v0[0]); dT[KEYS + key] = f2bf(v0[1]); dT[2 * KEYS + key] = f2bf(v0[2]); dT[3 * KEYS + key] = f2bf(v0[3]);
        dT[4 * KEYS + key] = f2bf(v1[0]); dT[5 * KEYS + key] = f2bf(v1[1]); dT[6 * KEYS + key] = f2bf(v1[2]); dT[7 * KEYS + key] = f2bf(v1[3]); }
    __device__ __forceinline__ void operator()(const f32x4 (&acc)[2][2][4][2], const Unit& u, int wr_, int wc_, int fr_, int fq_) const {
        const int tid = TID(), wid = tid >> 6, lane = tid & 63, wr = wid >> 2, wc = wid & 3, fr = lane & 15, fq = lane >> 4;
        (void)wr_; (void)wc_; (void)fr_; (void)fq_;
#pragma unroll
        for (int bj = 0; bj < 2; ++bj) {
            const int cw = ncol0 + u.pn * BM + bj * HALF;
            bf16_t* dst = nullptr; bf16_t* dT = nullptr; bf16_t* gatep = nullptr; int ld = 0, cl = 0, ncT = 0; bool gab = false;
            if (cw < MY_GQKV) { dT = GPTR(bf16_t, ws + OFF_HYT); ncT = 3 * MW; cl = cw - MY_HY; }
            else if (cw < MY_GZ) { dst = GPTR(bf16_t, ws + OFF_SEG_GQKV); ld = 3 * MW; cl = cw - MY_GQKV; }
            else if (cw < MY_DQKV) { dst = GPTR(bf16_t, ws + OFF_GZ); ld = MW; cl = cw - MY_GZ; }
            else if (cw < MY_NQKV) { cl = cw - MY_DQKV; if (cl < 2 * MW) { dst = GPTR(bf16_t, ws + OFF_SEG_DQKV); ld = 3 * MW; } else { dT = GPTR(bf16_t, ws + OFF_DVT); ncT = MW; cl -= 2 * MW; } }
            else if (cw < MY_GAB) { cl = cw - MY_NQKV; if (cl < 2 * MW) { dst = GPTR(bf16_t, ws + OFF_SEG_NQKV); ld = 3 * MW; } else { dT = GPTR(bf16_t, ws + OFF_NVT); ncT = MW; cl -= 2 * MW; } }
            else if (cw < MY_GATE) { gab = (cw == MY_GAB) && wc == 0; }
            else { gatep = GPTR(bf16_t, ws + OFF_SEG_GATE); cl = cw - MY_GATE; }
            if (dst) {
#pragma unroll
                for (int ai = 0; ai < 2; ++ai)
#pragma unroll
                    for (int m = 0; m < 4; ++m) { const long row = (long)u.pm * BM + ai * HALF + wr * 64 + m * 16 + fr;
                        const f32x4 v0 = acc[ai][bj][m][0], v1 = acc[ai][bj][m][1];
                        U4 w; w.x = pack2(v0[0], v0[1]); w.y = pack2(v0[2], v0[3]); w.z = pack2(v1[0], v1[1]); w.w = pack2(v1[2], v1[3]);
                        *(U4*)(dst + row * ld + cl + wc * 32 + 8 * fq) = w; }
            } else if (gatep) {
                const int gcol = cl + wc * 32 + 8 * fq, br = gcol / D, col = gcol - br * D;
#pragma unroll
                for (int ai = 0; ai < 2; ++ai)
#pragma unroll
                    for (int m = 0; m < 4; ++m) { const int row = u.pm * BM + ai * HALF + wr * 64 + m * 16 + fr;
                        const f32x4 v0 = acc[ai][bj][m][0], v1 = acc[ai][bj][m][1];
                        bf16_t* q = gatep + gate_idx(row, br, col);
                        *(U2*)q = (U2){pack2(v0[0], v0[1]), pack2(v0[2], v0[3])}; *(U2*)(q + 64) = (U2){pack2(v1[0], v1[1]), pack2(v1[2], v1[3])}; }
            } else if (dT) {
#pragma unroll
                for (int ai = 0; ai < 2; ++ai)
#pragma unroll
                    for (int m = 0; m < 4; ++m) { const int row = u.pm * BM + ai * HALF + wr * 64 + m * 16 + fr; int b, key; tok_bk(row, b, key);
                        st_tr(dT + ((long)b * ncT + cl + wc * 32 + 8 * fq) * KEYS, key, acc[ai][bj][m][0], acc[ai][bj][m][1]); }
            } else if (gab) {
                float* GAB = GPTR(float, ws + OFF_GAB);
#pragma unroll
                for (int ai = 0; ai < 2; ++ai)
#pragma unroll
                    for (int m = 0; m < 4; ++m) { const long row = (long)u.pm * BM + ai * HALF + wr * 64 + m * 16 + fr;
                        const f32x4 v0 = acc[ai][bj][m][0], v1 = acc[ai][bj][m][1];
                        *(F4*)(GAB + row * 32 + 8 * fq) = (F4){v0[0], v0[1], v0[2], v0[3]}; *(F4*)(GAB + row * 32 + 8 * fq + 4) = (F4){v1[0], v1[1], v1[2], v1[3]}; }
            }
        }
    }
};
}

#ifdef CPU_EMU
#define WSP(T, off) GPTR(T, p.ws + (off))
#else
typedef __attribute__((address_space(1))) char* gchar_p;
__device__ __forceinline__ gchar_p ws_opaque(char* w) { gchar_p g = (gchar_p)w; asm volatile("" : "+s"(g)); return g; }
#define WSP(T, off) ((T*)(__attribute__((address_space(1))) T*)(ws_opaque(p.ws) + (off)))
#endif
constexpr float DN_ALPHA_F =
#ifdef SMALL_DIMS
    1.4142135623730951f;
#else
    1.681792830507429f;
#endif

__device__ __forceinline__ void phase_prologue(const Params& p, char* lds) {
    const int tid = TID(), G = gridDim.x, bid = BID();
    { float* RWT = WSP(float, OFF_RWT); for (int i = bid * NTH + tid; i < D * 16; i += G * NTH) RWT[(i & 15) * D + (i >> 4)] = GIN(p.router_w)[i]; }
    float* sc = (float*)lds;
    for (int i = tid; i < 3 * D; i += NTH) { int r = i / D, k = i - r * D; float v = r < 2 ? GIN(p.c)[r * D + k] : GIN(p.c_ctx)[k]; sc[i] = siluf(v); }
    __syncthreads();
    float* MODP = WSP(float, OFF_MODP);
    constexpr int NCHK = 6 * D / NTH, KS = D / 8;
    for (int it = bid; it < DEPTH * 8 * NCHK; it += G) {
        int l = it / (8 * NCHK), rem = it - l * 8 * NCHK, s = rem / NCHK, ch = rem - s * NCHK;
        int n = ch * NTH + tid; const float* w = GIN(p.w_mod) + ((long)l * D + s * KS) * 6 * D + n;
        float a0 = 0.f, a1 = 0.f, a2 = 0.f;
#pragma unroll 8
        for (int k = 0; k < KS; ++k) { float wv = w[(long)k * 6 * D]; a0 += sc[s * KS + k] * wv; a1 += sc[D + s * KS + k] * wv; a2 += sc[2 * D + s * KS + k] * wv; }
        float* o = MODP + (((long)l * 8 + s) * 3) * 6 * D + n; o[0] = a0; o[6 * D] = a1; o[12 * D] = a2;
    }
}

constexpr int U_WIN = (NPROJ / 64) * (D / 64), U_BP = 4 * (MW / 64) * (D / 64), U_WO = (D / 64) * (D / 64), U_CVT = U_WIN + U_BP + U_WO;
__device__ __forceinline__ void cvt_unit(const Params& p, char* lds, int l, int u) {
    if (u < U_WIN) { int nt = u / (D / 64), kt = u - nt * (D / 64); const float* src = GIN(p.w_in) + (long)l * D * IN_TOTAL;
        auto sp = [&](int k, int n) -> const float* { int sc;
            if (n < MY_DQKV) sc = n; else if (n < MY_GAB) sc = n + 4 * GH; else if (n < MY_GATE) { int j = n - MY_GAB; if (j >= 4 * GH) return nullptr; sc = SRC_GA + j; } else sc = SRC_GATE + (n - MY_GATE);
            return src + (long)k * IN_TOTAL + sc; };
        cvt_tile(lds, sp, kt * 64, nt * 64, WSP(bf16_t, off_win(l)), D);
    } else if (u < U_WIN + U_BP) { int v = u - U_WIN; int m = v / ((MW / 64) * (D / 64)), r = v - m * ((MW / 64) * (D / 64)), nt = r / (MW / 64), kt = r - nt * (MW / 64);
        const float* src = GIN(p.branch_proj) + ((long)(l * 4 + m) * MW) * D;
        auto sp = [&](int k, int n) -> const float* { return src + (long)k * D + n; };
        cvt_tile(lds, sp, kt * 64, nt * 64, WSP(bf16_t, off_bp(l)) + m * MW, 4 * MW);
    } else { int v = u - U_WIN - U_BP; int nt = v / (D / 64), kt = v - nt * (D / 64); const float* src = GIN(p.w_out) + (long)l * D * D;
        auto sp = [&](int k, int n) -> const float* { return src + (long)k * D + n; };
        cvt_tile(lds, sp, kt * 64, nt * 64, WSP(bf16_t, off_wo(l)), D);
    }
}
__device__ __forceinline__ void w3t_chunk(const Params& p, int l, int i0, int n) {
    const int tid = TID(); bf16_t* W3T = WSP(bf16_t, OFF_W3T); const float* w3 = GIN(p.hy_w3) + (long)l * 64 * 4 * HYW;
    for (int i = i0 + tid; i < i0 + n; i += NTH) { const int col = i >> 7, k = i & 127; W3T[i] = k < 64 ? f2bf(w3[(long)k * 4 * HYW + col]) : (bf16_t)0; }
}
__device__ __forceinline__ void h2f_positions(const Params& p, int l, int pos0, int iters) {
    const int tid = TID(), lane = tid & 63, wid = tid >> 6;
    float* H2F = WSP(float, OFF_H2F); bf16_t* H2B = WSP(bf16_t, OFF_H2B);
    const float* w1 = GIN(p.hy_w1) + (long)l * HY_EMB * 64; const float* b1 = GIN(p.hy_b1) + l * 64; const float* w2 = GIN(p.hy_w2) + (long)l * 64 * 64; const float* b2 = GIN(p.hy_b2) + l * 64; const float fr = GIN(p.hy_freq)[l * 64 + lane];
    for (int it = 0; it < iters; ++it) { const int pos = pos0 + it * 8 + wid; if (pos >= KEYS) break;
        int L = pos < SEQ ? SEQ : CTX, t = pos < SEQ ? pos : pos - SEQ;
        float feat = 0.f;
        if (lane == 0) feat = (float)t / (float)(L - 1);
        else if (lane < 33) { int bi = (lane - 1) & 15; float band = 1e-4f + (float)bi * ((15.0f - 1e-4f) / 15.0f); float ang = 6.283185307179586f * (float)t / (float)L; float a = band * ang;
            feat = lane < 17 ? cosf(a) : -sinf(a); }
        float a1 = b1[lane];
        for (int e = 0; e < HY_EMB; ++e) a1 += __shfl(feat, e) * w1[e * 64 + lane];
        float h1 = sinf(fr * a1);
        float a2 = b2[lane];
        for (int i = 0; i < 64; ++i) a2 += __shfl(h1, i) * w2[i * 64 + lane];
        const float hv = sinf(fr * a2); H2F[(long)pos * 64 + lane] = hv; H2B[(long)pos * 128 + lane] = f2bf(hv); H2B[(long)pos * 128 + 64 + lane] = 0; }
}
__device__ __forceinline__ void phase_weights(const Params& p, char* lds, int l) {
    const int tid = TID(), G = gridDim.x, bid = BID();
    { const float* MODP = WSP(float, OFF_MODP); float* MOD = WSP(float, OFF_MOD);
        for (int i = bid * NTH + tid; i < DEPTH * 3 * 6 * D; i += G * NTH) { int ll = i / (18 * D), rem = i - ll * 18 * D, n = rem % (6 * D);
            float a = GIN(p.b_mod)[ll * 6 * D + n];
#pragma unroll
            for (int s = 0; s < 8; ++s) a += MODP[((long)ll * 8 + s) * 18 * D + rem];
            MOD[i] = a; } }
    if (bid == 0 && tid < 64) WSP(u32, OFF_CNT)[64 + tid] = 0u;
    for (int u = bid; u < U_CVT; u += G) cvt_unit(p, lds, l, u);
    for (int c = bid; c < (4 * HYW * 128 + 8191) / 8192; c += G) w3t_chunk(p, l, c * 8192, 8192);
    for (int c = bid; c < (KEYS + 63) / 64; c += G) h2f_positions(p, l, c * 64, 8);
}

__device__ __forceinline__ void phase_expert_weights(const Params& p, char* lds, int l, int bid, int G) {
    constexpr int U13 = (2 * EFF / 64) * (D / 64), U2_ = (D / 64) * (EFF / 64);
    for (int u = bid < 0 ? NE * (U13 + U2_) : bid; u < NE * (U13 + U2_); u += G) {
        int e = u / (U13 + U2_), v = u - e * (U13 + U2_);
        if (v < U13) { int nt = v / (D / 64), kt = v - nt * (D / 64);
            const float* s1 = GIN(p.exp_w1) + ((long)(l * NE + e) * D) * EFF; const float* s3 = GIN(p.exp_w3) + ((long)(l * NE + e) * D) * EFF;
            const long d13 = (long)((uintptr_t)s1 - (uintptr_t)s3);
            auto sp = [&](int k, int n) -> const float* { int grp = n >> 5, w = n & 31; return (const float*)((uintptr_t)s3 + (uintptr_t)(w < 16 ? d13 : 0L)) + (long)k * EFF + grp * 16 + (w & 15); };
            cvt_tile(lds, sp, kt * 64, nt * 64, WSP(bf16_t, OFF_W13) + (long)e * 2 * EFF * D, D);
        } else { int w = v - U13; int nt = w / (EFF / 64), kt = w - nt * (EFF / 64); const float* s2 = GIN(p.exp_w2) + ((long)(l * NE + e) * EFF) * D;
            auto sp = [&](int k, int n) -> const float* { return s2 + (long)k * D + n; };
            cvt_tile(lds, sp, kt * 64, nt * 64, WSP(bf16_t, OFF_W2) + (long)e * D * EFF, EFF);
        }
    }
}

constexpr int RV = D / 256;
__device__ __forceinline__ void row_stats(const F4 (&v)[RV], float& mean, float& rstd) {
    float s = 0.f;
#pragma unroll
    for (int i = 0; i < RV; ++i) s += (v[i].x + v[i].y) + (v[i].z + v[i].w);
    mean = wave_sum(s) * (1.0f / D);
    float q = 0.f;
#pragma unroll
    for (int i = 0; i < RV; ++i) { float a = v[i].x - mean, b = v[i].y - mean, c = v[i].z - mean, d = v[i].w - mean; q += (a * a + b * b) + (c * c + d * d); }
    rstd = rsqrtf(wave_sum(q) * (1.0f / D) + LN_EPS);
}
__device__ __forceinline__ void row_stats2(const F4 (&v)[2][RV], float (&mean)[2], float (&rstd)[2]) {
    float s0 = 0.f, s1 = 0.f;
#pragma unroll
    for (int i = 0; i < RV; ++i) { s0 += (v[0][i].x + v[0][i].y) + (v[0][i].z + v[0][i].w); s1 += (v[1][i].x + v[1][i].y) + (v[1][i].z + v[1][i].w); }
    s0 = xadd<32>(s0); s1 = xadd<32>(s1); s0 = xadd<16>(s0); s1 = xadd<16>(s1); s0 = xadd<8>(s0); s1 = xadd<8>(s1); s0 = xadd<4>(s0); s1 = xadd<4>(s1); s0 = xadd<2>(s0); s1 = xadd<2>(s1); s0 = xadd<1>(s0); s1 = xadd<1>(s1);
    mean[0] = s0 * (1.0f / D); mean[1] = s1 * (1.0f / D);
    float q0 = 0.f, q1 = 0.f;
#pragma unroll
    for (int i = 0; i < RV; ++i) { float a = v[0][i].x - mean[0], b = v[0][i].y - mean[0], c = v[0][i].z - mean[0], d = v[0][i].w - mean[0]; q0 += (a * a + b * b) + (c * c + d * d);
        a = v[1][i].x - mean[1]; b = v[1][i].y - mean[1]; c = v[1][i].z - mean[1]; d = v[1][i].w - mean[1]; q1 += (a * a + b * b) + (c * c + d * d); }
    q0 = xadd<32>(q0); q1 = xadd<32>(q1); q0 = xadd<16>(q0); q1 = xadd<16>(q1); q0 = xadd<8>(q0); q1 = xadd<8>(q1); q0 = xadd<4>(q0); q1 = xadd<4>(q1); q0 = xadd<2>(q0); q1 = xadd<2>(q1); q0 = xadd<1>(q0); q1 = xadd<1>(q1);
    rstd[0] = rsqrtf(q0 * (1.0f / D) + LN_EPS); rstd[1] = rsqrtf(q1 * (1.0f / D) + LN_EPS);
}
__device__ __forceinline__ void row_modulate_store(const F4 (&v)[RV], float mean, float rstd, const float* shift, const float* scale, bf16_t* dst, int lane, F4 (*keep)[RV] = nullptr) {
#pragma unroll
    for (int i = 0; i < RV; ++i) { int n = (i * 64 + lane) * 4; F4 sh = *(const F4*)(shift + n), sc = *(const F4*)(scale + n);
        F4 h; h.x = (v[i].x - mean) * rstd * (1.0f + sc.x) + sh.x; h.y = (v[i].y - mean) * rstd * (1.0f + sc.y) + sh.y; h.z = (v[i].z - mean) * rstd * (1.0f + sc.z) + sh.z; h.w = (v[i].w - mean) * rstd * (1.0f + sc.w) + sh.w;
        U2 o; o.x = pack2(h.x, h.y); o.y = pack2(h.z, h.w); *(U2*)(dst + n) = o; if (keep) (*keep)[i] = h; }
}

__device__ __forceinline__ const float* xs_row(const Params& p, int l, int row) {
    const uintptr_t a = (uintptr_t)(WSP(float, OFF_XS) + (long)row * D);
    const uintptr_t b = row < NLAT ? (uintptr_t)(GIN(p.x) + (long)row * D) : (uintptr_t)(GIN(p.ctx) + (long)(row - NLAT) * D);
    return (const float*)(l == 0 ? b : a);
}
__device__ __forceinline__ void phase_modulate0(const Params& p, int l) {
    const int tid = TID(), lane = tid & 63, wid = tid >> 6;
    const float* XS = WSP(float, OFF_XS); bf16_t* H = WSP(bf16_t, OFF_H); const float* MOD = WSP(float, OFF_MOD) + (long)l * 18 * D;
    for (int row = BID() * 8 + wid; row < NTOK; row += gridDim.x * 8) {
        F4 v[RV]; const float* xr = xs_row(p, l, row);
#pragma unroll
        for (int i = 0; i < RV; ++i) v[i] = *(const F4*)(xr + (i * 64 + lane) * 4);
        float mean, rstd; row_stats(v, mean, rstd);
        const float* m = MOD + mod_row(row) * 6 * D;
        row_modulate_store(v, mean, rstd, m, m + D, H + (long)row * D, lane);
    }
}

__device__ __forceinline__ void phase_post_mix(const Params& p, char* lds, int l, bool dry = false) {
    const int tid = TID(), lane = tid & 63, wid = tid >> 6;
    float* XS = WSP(float, OFF_XS); const bf16_t* MIX = WSP(bf16_t, OFF_MIX); bf16_t* H = WSP(bf16_t, OFF_H); const float* MOD = WSP(float, OFF_MOD) + (long)l * 18 * D;
    const float* lng = GIN(p.ln_g) + (long)(l * 2 + 0) * D; const float* lnb = GIN(p.ln_b) + (long)(l * 2 + 0) * D;
    u32* CNT = WSP(u32, OFF_CNT) + (dry ? 128 : 0); float* XSO = dry ? WSP(float, OFF_YE) : XS; int* TOKE = WSP(int, OFF_TOKE); int* TOKR = WSP(int, OFF_TOKR); float* TOKW = WSP(float, OFF_TOKW); int* ELIST = WSP(int, OFF_ELIST);
    const int nrows = (l == DEPTH - 1) ? NLAT : NTOK;
    float* rwT = (float*)lds; u32* lcnt = (u32*)(lds + 16 * D * 4); u32* lbase = lcnt + 16;
    __syncthreads();
    for (int i = tid; i < D * 16; i += NTH) rwT[(i & 15) * D + (i >> 4)] = GIN(p.router_w)[i];
    if (tid < 16) lcnt[tid] = 0u;
    __syncthreads();
    for (int row = BID() * 8 + wid; row < nrows; row += gridDim.x * 8) {
        const float* m = MOD + mod_row(row) * 6 * D; const float* xr = xs_row(p, l, row);
        F4 v[RV];
#pragma unroll
        for (int i = 0; i < RV; ++i) { int n = (i * 64 + lane) * 4; F4 x = *(const F4*)(xr + n), g2 = *(const F4*)(m + 2 * D + n); const U2 mxp = *(const U2*)(MIX + (long)row * D + n); const F4 mx = (F4){bflo(mxp.x), bfhi(mxp.x), bflo(mxp.y), bfhi(mxp.y)};
            v[i].x = fmaf(g2.x, mx.x, DN_ALPHA_F * x.x); v[i].y = fmaf(g2.y, mx.y, DN_ALPHA_F * x.y); v[i].z = fmaf(g2.z, mx.z, DN_ALPHA_F * x.z); v[i].w = fmaf(g2.w, mx.w, DN_ALPHA_F * x.w); }
        float mean, rstd; row_stats(v, mean, rstd);
#pragma unroll
        for (int i = 0; i < RV; ++i) { int n = (i * 64 + lane) * 4; F4 g = *(const F4*)(lng + n), b = *(const F4*)(lnb + n);
            v[i].x = (v[i].x - mean) * rstd * g.x + b.x; v[i].y = (v[i].y - mean) * rstd * g.y + b.y; v[i].z = (v[i].z - mean) * rstd * g.z + b.z; v[i].w = (v[i].w - mean) * rstd * g.w + b.w;
            *(F4*)(XSO + (long)row * D + n) = v[i]; }
        row_stats(v, mean, rstd);
        F4 h[RV];
        row_modulate_store(v, mean, rstd, m + 3 * D, m + 4 * D, H + (long)row * D, lane, &h);
        float lg[16];
#pragma unroll
        for (int e = 0; e < 16; ++e) lg[e] = 0.f;
        { const float* wp = rwT + lane * 4;
#pragma unroll
            for (int i = 0; i < RV; ++i)
#pragma unroll
                for (int eg = 0; eg < 4; ++eg) {
#pragma unroll
                    for (int e = eg * 4; e < eg * 4 + 4; ++e) { const F4 w = *(const F4*)(wp + e * D + i * 256); lg[e] += (h[i].x * w.x + h[i].y * w.y) + (h[i].z * w.z + h[i].w * w.w); }
#ifndef CPU_EMU
                    { int z; asm volatile("v_mov_b32 %0, 0" : "=v"(z) : "v"(lg[eg * 4 + 3])); wp += z; }
#endif
                } }
        float s[16], sel[16];
#pragma unroll
        for (int e = 0; e < 16; ++e) { lg[e] = wave_sum(lg[e]); s[e] = sigmoidf(lg[e]); sel[e] = s[e] + GIN(p.router_b)[e]; }
        float gs[4];
#pragma unroll
        for (int gq = 0; gq < 4; ++gq) { float a = sel[gq * 4], b = sel[gq * 4 + 1], c = sel[gq * 4 + 2], d = sel[gq * 4 + 3];
            float m1 = fmaxf(fmaxf(a, b), fmaxf(c, d)); float lo_ab = fminf(a, b), hi_ab = fmaxf(a, b), lo_cd = fminf(c, d), hi_cd = fmaxf(c, d);
            float m2 = fmaxf(fminf(hi_ab, hi_cd), fmaxf(lo_ab, lo_cd)); gs[gq] = m1 + m2; }
        int bg = 0; float bv = gs[0];
#pragma unroll
        for (int gq = 1; gq < 4; ++gq) if (gs[gq] > bv) { bv = gs[gq]; bg = gq; }
        float c0 = 0.f, c1 = 0.f, c2 = 0.f, c3 = 0.f, t0 = 0.f, t1 = 0.f, t2 = 0.f, t3 = 0.f;
#pragma unroll
        for (int gq = 0; gq < 4; ++gq) if (gq == bg) { c0 = sel[gq * 4]; c1 = sel[gq * 4 + 1]; c2 = sel[gq * 4 + 2]; c3 = sel[gq * 4 + 3]; t0 = s[gq * 4]; t1 = s[gq * 4 + 1]; t2 = s[gq * 4 + 2]; t3 = s[gq * 4 + 3]; }
        int i0 = 0; float v0 = c0, w0 = t0;
        if (c1 > v0) { v0 = c1; i0 = 1; w0 = t1; } if (c2 > v0) { v0 = c2; i0 = 2; w0 = t2; } if (c3 > v0) { v0 = c3; i0 = 3; w0 = t3; }
        int i1 = -1; float v1 = -3.0e38f, w1 = 0.f;
        if (i0 != 0 && c0 > v1) { v1 = c0; i1 = 0; w1 = t0; } if (i0 != 1 && c1 > v1) { v1 = c1; i1 = 1; w1 = t1; } if (i0 != 2 && c2 > v1) { v1 = c2; i1 = 2; w1 = t2; } if (i0 != 3 && c3 > v1) { v1 = c3; i1 = 3; w1 = t3; }
        if (lane == 0) { float ws = w0 + w1; int e0 = bg * 4 + i0, e1 = bg * 4 + i1;
            int r0 = (int)atomicAdd(&lcnt[e0], 1u), r1 = (int)atomicAdd(&lcnt[e1], 1u);
            TOKE[row * 2] = e0; TOKE[row * 2 + 1] = e1; TOKR[row * 2] = r0; TOKR[row * 2 + 1] = r1; TOKW[row * 2] = w0 / ws; TOKW[row * 2 + 1] = w1 / ws; }
    }
    __syncthreads();
    if (tid < 16) lbase[tid] = lcnt[tid] ? atomicAdd(&CNT[tid], lcnt[tid]) : 0u;
    __syncthreads();
    if (tid < 16) for (int row0 = BID() * 8; row0 < nrows; row0 += (int)gridDim.x * 8) { const int row = row0 + (tid >> 1), k = tid & 1;
        const int e = TOKE[row * 2 + k]; const int r = TOKR[row * 2 + k] + (int)lbase[e]; TOKR[row * 2 + k] = r; ELIST[(long)e * NTOK + r] = row; }
}

__device__ __forceinline__ void phase_post_moe(const Params& p, int l, bool dry = false) {
    const int tid = TID(), lane = tid & 63, wid = tid >> 6;
    float* XS = WSP(float, OFF_XS); bf16_t* H = WSP(bf16_t, OFF_H); const float* MOD = WSP(float, OFF_MOD) + (long)l * 18 * D;
    const bf16_t* YE = WSP(bf16_t, OFF_YE);
    const float* lng = GIN(p.ln_g) + (long)(l * 2 + 1) * D; const float* lnb = GIN(p.ln_b) + (long)(l * 2 + 1) * D;
    const u32* CNT = WSP(u32, OFF_CNT); const int* TOKE = WSP(int, OFF_TOKE); const int* TOKR = WSP(int, OFF_TOKR); const float* TOKW = WSP(float, OFF_TOKW);
    const bool last = (l == DEPTH - 1);
    const int nrows = last ? NLAT : NTOK;
    int eoff = 0;
    { int c = lane < 16 ? (int)CNT[lane] : 0; int incl = c;
        for (int o = 1; o < 16; o <<= 1) { int t = __shfl_up(incl, o); if (lane >= o) incl += t; }
        eoff = incl - c; }
    const int stride = (int)gridDim.x * 8;
    for (int row0 = BID() * 8 + wid; row0 < nrows; row0 += 2 * stride) {
        const bool two = row0 + stride < nrows;
        int rowv[2] = {row0, two ? row0 + stride : row0};
        F4 v[2][RV]; const float* mm[2];
#pragma unroll
        for (int q = 0; q < 2; ++q) { const int row = rowv[q]; mm[q] = MOD + mod_row(row) * 6 * D;
            const int e0 = TOKE[row * 2], e1 = TOKE[row * 2 + 1];
            const long p0 = (long)__shfl(eoff, e0) + TOKR[row * 2], p1 = (long)__shfl(eoff, e1) + TOKR[row * 2 + 1];
            const float w0 = TOKW[row * 2], w1 = TOKW[row * 2 + 1];
#pragma unroll
            for (int i = 0; i < RV; ++i) { int n = (i * 64 + lane) * 4; F4 x = *(const F4*)(XS + (long)row * D + n), g5 = *(const F4*)(mm[q] + 5 * D + n);
                U2 a = *(const U2*)(YE + p0 * D + n), b = *(const U2*)(YE + p1 * D + n);
                float y0 = w0 * bflo(a.x) + w1 * bflo(b.x), y1 = w0 * bfhi(a.x) + w1 * bfhi(b.x), y2 = w0 * bflo(a.y) + w1 * bflo(b.y), y3 = w0 * bfhi(a.y) + w1 * bfhi(b.y);
                v[q][i].x = fmaf(g5.x, y0, DN_ALPHA_F * x.x); v[q][i].y = fmaf(g5.y, y1, DN_ALPHA_F * x.y); v[q][i].z = fmaf(g5.z, y2, DN_ALPHA_F * x.z); v[q][i].w = fmaf(g5.w, y3, DN_ALPHA_F * x.w); } }
        float mean[2], rstd[2]; row_stats2(v, mean, rstd);
#pragma unroll
        for (int q = 0; q < 2; ++q) { if (q == 1 && !two) break; const int row = rowv[q];
            float* dst = dry ? WSP(float, OFF_MIX) + (long)row * D : (last ? GPTR(float, p.out) + (long)row * D : XS + (long)row * D);
#pragma unroll
            for (int i = 0; i < RV; ++i) { int n = (i * 64 + lane) * 4; F4 g = *(const F4*)(lng + n), b = *(const F4*)(lnb + n);
                v[q][i].x = (v[q][i].x - mean[q]) * rstd[q] * g.x + b.x; v[q][i].y = (v[q][i].y - mean[q]) * rstd[q] * g.y + b.y; v[q][i].z = (v[q][i].z - mean[q]) * rstd[q] * g.z + b.z; v[q][i].w = (v[q][i].w - mean[q]) * rstd[q] * g.w + b.w;
                *(F4*)(dst + n) = v[q][i]; } }
        if (!last) { row_stats2(v, mean, rstd);
#pragma unroll
            for (int q = 0; q < 2; ++q) { if (q == 1 && !two) break; const float* m2 = mm[q] + 18 * D; row_modulate_store(v[q], mean[q], rstd[q], m2, m2 + D, H + (long)rowv[q] * D, lane); } }
    }
}
__device__ __forceinline__ void st4bf(bf16_t* dst, f32x4 v) { U2 o; o.x = pack2(v[0], v[1]); o.y = pack2(v[2], v[3]); *(U2*)dst = o; }

__device__ __forceinline__ void phase_inproj(const Params& p, char* lds, int l, int part  ) {
    pg8::Gemm g; g.A = WSP(bf16_t, OFF_H); g.Bt = WSP(bf16_t, off_win(l)) + (long)(part == 0 ? 0 : NPROJ1) * D; g.M = NTOK; g.N = part == 0 ? NPROJ1 : 4 * D; g.K = D;
    pg8::StaticOrder S; S.init(g.M, g.N, (int)gridDim.x, BID());
    pg8::EpiInproj E; E.ws = p.ws; E.ncol0 = part == 0 ? 0 : NPROJ1;
    __syncthreads();
    pg8::gemm_phase<pg8::EpiInproj, pg8::StaticOrder, false>((PG8_LAS unsigned char*)lds, g, S, E, nullptr);
    __syncthreads();
    if (part == 1) {
        const int G = (int)gridDim.x, rem = S.nwg % G, c = BID();
        for (int rep_ = 0; rep_ < REP_W; ++rep_) phase_expert_weights(p, lds, l, rem == 0 ? c : c - rem, rem == 0 ? G : G - rem);
    }
}

__device__ __forceinline__ void phase_prep(const Params& p, char* lds, int l, bool do_rope = true, bool do_c = true, bool do_d = true) {
    const int tid = TID(), G = gridDim.x, bid = BID(), lane = tid & 63, wid = tid >> 6;
    if (bid == 0 && tid < 64) { WSP(u32, OFF_CNT)[tid] = 0u; WSP(u32, OFF_CNT)[128 + tid] = 0u; }
    if (do_rope) {
        bf16_t* DQ = WSP(bf16_t, OFF_SEG_DQKV);
        constexpr int NV = 4 * DH;
        for (long i = (long)bid * NTH + tid; i < (long)NLAT * 32; i += (long)G * NTH) {
            int tok = (int)(i >> 5), f2 = (int)(i & 31);
            int t = tok % SEQ; int axis = f2 >> 4, f = f2 & 15;
            float pos = axis == 0 ? (float)(t / GW) : (float)(t % GW);
            float inv = powf(10000.0f, -(float)f / 16.0f);
            float ang = pos * inv, sn = sinf(ang), cs = cosf(ang);
            bf16_t* base = DQ + (long)tok * 3 * MW + axis * 32 + f;
#pragma unroll
            for (int v = 0; v < NV; ++v) { bf16_t* q = base + v * 64; const float qs = v < 2 * DH ? 0.125f * 1.4426950408889634f : 1.0f;
                float x1 = bf2f(q[0]), x2 = bf2f(q[16]); q[0] = f2bf((x1 * cs - x2 * sn) * qs); q[16] = f2bf((x1 * sn + x2 * cs) * qs); }
        }
    }
    if (do_c) {
        const bf16_t* SG = WSP(bf16_t, OFF_SEG_GQKV); bf16_t* GQ = WSP(bf16_t, OFF_GQ); bf16_t* GK = WSP(bf16_t, OFF_GK); bf16_t* GV = WSP(bf16_t, OFF_GV);
        const float* cwp = GIN(p.gdn_conv) + (long)l * 3 * MW * 3;
        const int sub = tid & 7;
        for (long i = ((long)bid * NTH + tid) >> 3; i < (long)NTOK * GH; i += ((long)G * NTH) >> 3) {
            const int tok = (int)(i / GH), h = (int)(i - (long)tok * GH);
            int seq0, len; if (tok < NLAT) { seq0 = (tok / SEQ) * SEQ; len = SEQ; } else { seq0 = NLAT + ((tok - NLAT) / CTX) * CTX; len = CTX; }
            const int t = tok - seq0; const bool hasp = t > 0, hasn = t + 1 < len;
            float u[3][8];
#pragma unroll
            for (int part = 0; part < 3; ++part) { const int c = part * MW + h * 64 + sub * 8; const bf16_t* s = SG + (long)tok * 3 * MW + c;
                const U4 x1 = *(const U4*)s; const U4 x0 = hasp ? *(const U4*)(s - 3 * MW) : (U4){0u, 0u, 0u, 0u}; const U4 x2 = hasn ? *(const U4*)(s + 3 * MW) : (U4){0u, 0u, 0u, 0u};
                const u32 a0[4] = {x0.x, x0.y, x0.z, x0.w}, a1[4] = {x1.x, x1.y, x1.z, x1.w}, a2[4] = {x2.x, x2.y, x2.z, x2.w};
                float w[24];
#pragma unroll
                for (int q = 0; q < 6; ++q) { const F4 wv = *(const F4*)(cwp + c * 3 + q * 4); w[q * 4] = wv.x; w[q * 4 + 1] = wv.y; w[q * 4 + 2] = wv.z; w[q * 4 + 3] = wv.w; }
#pragma unroll
                for (int e = 0; e < 4; ++e) {
                    float lo = bflo(a0[e]) * w[(2 * e) * 3] + bflo(a1[e]) * w[(2 * e) * 3 + 1] + bflo(a2[e]) * w[(2 * e) * 3 + 2];
                    float hi = bfhi(a0[e]) * w[(2 * e + 1) * 3] + bfhi(a1[e]) * w[(2 * e + 1) * 3 + 1] + bfhi(a2[e]) * w[(2 * e + 1) * 3 + 2];
                    u[part][2 * e] = siluf(lo); u[part][2 * e + 1] = siluf(hi); } }
            float nq = 0.f, nk = 0.f;
#pragma unroll
            for (int e = 0; e < 8; ++e) { nq += u[0][e] * u[0][e]; nk += u[1][e] * u[1][e]; }
            nq = xadd<1>(nq); nq = xadd<2>(nq); nq = xadd<4>(nq);
            nk = xadd<1>(nk); nk = xadd<2>(nk); nk = xadd<4>(nk);
            const float rq = rsqrtf(nq + RMS_EPS) * 0.125f, rk = rsqrtf(nk + RMS_EPS);
            const long o = (long)tok * MW + h * 64 + sub * 8;
            *(U4*)(GQ + o) = (U4){pack2(u[0][0] * rq, u[0][1] * rq), pack2(u[0][2] * rq, u[0][3] * rq), pack2(u[0][4] * rq, u[0][5] * rq), pack2(u[0][6] * rq, u[0][7] * rq)};
            *(U4*)(GK + o) = (U4){pack2(u[1][0] * rk, u[1][1] * rk), pack2(u[1][2] * rk, u[1][3] * rk), pack2(u[1][4] * rk, u[1][5] * rk), pack2(u[1][6] * rk, u[1][7] * rk)};
            *(U4*)(GV + o) = (U4){pack2(u[2][0], u[2][1]), pack2(u[2][2], u[2][3]), pack2(u[2][4], u[2][5]), pack2(u[2][6], u[2][7])};
        }
        const float* GAB = WSP(float, OFF_GAB); float* GB = WSP(float, OFF_GB);
        for (long i = (long)bid * NTH + tid; i < (long)NTOK * 2 * GH; i += (long)G * NTH) {
            int tok = (int)(i / (2 * GH)), dh = (int)(i - (long)tok * 2 * GH);
            float a = GAB[(long)tok * 32 + dh], b = GAB[(long)tok * 32 + 2 * GH + dh];
            float xa = a + GIN(p.gdn_dt_bias)[l * 2 * GH + dh]; float sp = xa > 20.f ? xa : log1pf(__expf(xa));
            GB[(long)tok * 4 * GH + dh] = -__expf(GIN(p.gdn_a_log)[l * 2 * GH + dh]) * sp;
            GB[(long)tok * 4 * GH + 2 * GH + dh] = sigmoidf(b);
        }
    }
    if (do_d) {
        const bf16_t* H2B = WSP(bf16_t, OFF_H2B); const bf16_t* W3T = WSP(bf16_t, OFF_W3T); bf16_t* TAPS = WSP(bf16_t, OFF_TAPS);
        const int wid = tid >> 6, wm = wid >> 1, wn = wid & 1, l15 = lane & 15, g = lane >> 4;
        constexpr int MT = 3, ntm = KEYS / (64 * MT), ntn = 4 * HYW / G_BN;
        for (int u = bid; u < ntm * ntn; u += G) {
            const int tn = u / ntm, tm = u - tn * ntm, row0 = tm * 64 * MT, col0 = tn * G_BN;
            f32x4 acc[MT][4];
            gemm_tile<MT>(lds, [&](int r) { return H2B + (long)(row0 + r) * 128; }, W3T + (long)col0 * 128, 128, 128, acc);
#pragma unroll
            for (int n = 0; n < 4; ++n) { const int colb = col0 + wn * 64 + n * 16 + g * 4;
                const F4 dl4 = *(const F4*)(GIN(p.hy_deltas) + (long)l * 4 * HYW + colb); const float dl[4] = {fabsf(dl4.x), fabsf(dl4.y), fabsf(dl4.z), fabsf(dl4.w)};
#pragma unroll
                for (int m = 0; m < MT; ++m) { const int pos = row0 + wm * 16 * MT + m * 16 + l15; const bool ctxp = pos >= SEQ; const int L = ctxp ? CTX : SEQ, t = ctxp ? pos - SEQ : pos;
                    const float tl = (float)t * (1.0f / (float)(L - 1));
#pragma unroll
                    for (int j = 0; j < 4; ++j) TAPS[(long)(colb + j) * KEYS + pos] = f2bf(acc[m][n][j] * (__expf(-tl * dl[j]) + 0.05f)); } }
        }
    }
}
constexpr int A_LD = 72, AK_LD = 80;
template <int DV> struct AttnLds { static constexpr int K_BYTES = 64 * AK_LD * 2, V_BYTES = DV * A_LD * 2, STAGE = K_BYTES + V_BYTES, TOTAL = 2 * STAGE; };
constexpr float LOG2E = 1.4426950408889634f;
constexpr float NEG_BIG = -1.0e30f;

template <int NQT, int DV, class QRow, class KTile, class MaskFn>
__device__ __forceinline__ void attn_core(char* lds, QRow qrow  , KTile ktile  ,
                                          int ntiles, MaskFn mask  , f32x4 (&oacc)[DV / 16][NQT], float (&lsum)[NQT]) {
    const int tid = TID(), wid = tid >> 6, lane = tid & 63, l15 = lane & 15, g = lane >> 4;
    constexpr int NDT = DV / 16, NVL = DV / 64;
    typedef AttnLds<DV> L;
    bf16x8 qf[NQT][2];
#pragma unroll
    for (int qt = 0; qt < NQT; ++qt) { const bf16_t* q = qrow(wid * NQT * 16 + qt * 16 + l15);
#pragma unroll
        for (int ks = 0; ks < 2; ++ks) qf[qt][ks] = ld8(q + ks * 32 + g * 8); }
    float mrun[NQT];
#pragma unroll
    for (int qt = 0; qt < NQT; ++qt) { mrun[qt] = NEG_BIG; lsum[qt] = 0.f;
#pragma unroll
        for (int dt = 0; dt < NDT; ++dt) oacc[dt][qt] = (f32x4){0.f, 0.f, 0.f, 0.f}; }
    const int sr = tid >> 3, ss = tid & 7;
    U4 rk, rv[NVL];
    { const bf16_t *kp, *vp; long kld, vld; ktile(0, kp, kld, vp, vld);
        rk = *(const U4*)(kp + (long)sr * kld + ss * 8);
#pragma unroll
        for (int i = 0; i < NVL; ++i) rv[i] = *(const U4*)(vp + (long)(sr + 64 * i) * vld + ss * 8); }
    __syncthreads();
    { bf16_t* sK = (bf16_t*)lds; bf16_t* sV = (bf16_t*)(lds + L::K_BYTES);
        *(U4*)(sK + sr * AK_LD + ss * 8) = rk;
#pragma unroll
        for (int i = 0; i < NVL; ++i) *(U4*)(sV + (sr + 64 * i) * A_LD + ss * 8) = rv[i]; }
    __syncthreads();
    for (int t = 0; t < ntiles; ++t) {
        const bool more = t + 1 < ntiles;
        if (more) { const bf16_t *kp, *vp; long kld, vld; ktile(t + 1, kp, kld, vp, vld);
            rk = *(const U4*)(kp + (long)sr * kld + ss * 8);
#pragma unroll
            for (int i = 0; i < NVL; ++i) rv[i] = *(const U4*)(vp + (long)(sr + 64 * i) * vld + ss * 8); }
        const bf16_t* sK = (const bf16_t*)(lds + (t & 1) * L::STAGE); const bf16_t* sV = (const bf16_t*)(lds + (t & 1) * L::STAGE + L::K_BYTES);
        f32x4 s[4][NQT];
#pragma unroll
        for (int mt = 0; mt < 4; ++mt) {
#pragma unroll
            for (int qt = 0; qt < NQT; ++qt) s[mt][qt] = (f32x4){0.f, 0.f, 0.f, 0.f};
#pragma unroll
            for (int ks = 0; ks < 2; ++ks) { bf16x8 kf = ld8(sK + (mt * 16 + l15) * AK_LD + ks * 32 + g * 8);
#pragma unroll
                for (int qt = 0; qt < NQT; ++qt) s[mt][qt] = MFMA16(kf, qf[qt][ks], s[mt][qt]); }
        }
        bf16x8 pf[2][NQT];
#pragma unroll
        for (int qt = 0; qt < NQT; ++qt) {
            const int qi = wid * NQT * 16 + qt * 16 + l15;
            float mx = NEG_BIG;
#pragma unroll
            for (int mt = 0; mt < 4; ++mt)
#pragma unroll
                for (int j = 0; j < 4; ++j) { float v = mask(t, mt, j, qi, s[mt][qt][j] * (0.125f * LOG2E)); s[mt][qt][j] = v; mx = fmaxf(mx, v); }
            mx = xmax<16>(mx); mx = xmax<32>(mx);
            const float mnew = fmaxf(mrun[qt], mx), alpha = fexp2(mrun[qt] - mnew); mrun[qt] = mnew;
            float ps = 0.f;
#pragma unroll
            for (int mt = 0; mt < 4; ++mt)
#pragma unroll
                for (int j = 0; j < 4; ++j) { float pv = fexp2(s[mt][qt][j] - mnew); s[mt][qt][j] = pv; ps += pv; }
            lsum[qt] = lsum[qt] * alpha + ps;
#pragma unroll
            for (int dt = 0; dt < NDT; ++dt) oacc[dt][qt] *= alpha;
#pragma unroll
            for (int kb = 0; kb < 2; ++kb) pf[kb][qt] = mk8u(pack2(s[2 * kb][qt][0], s[2 * kb][qt][1]), pack2(s[2 * kb][qt][2], s[2 * kb][qt][3]),
                                                             pack2(s[2 * kb + 1][qt][0], s[2 * kb + 1][qt][1]), pack2(s[2 * kb + 1][qt][2], s[2 * kb + 1][qt][3]));
        }
#pragma unroll
        for (int dt = 0; dt < NDT; ++dt)
#pragma unroll
            for (int kb = 0; kb < 2; ++kb) { const bf16_t* vr = sV + (dt * 16 + l15) * A_LD + kb * 32 + g * 4;
                bf16x8 vf = mk8(*(const U2*)vr, *(const U2*)(vr + 16));
#pragma unroll
                for (int qt = 0; qt < NQT; ++qt) oacc[dt][qt] = MFMA16(vf, pf[kb][qt], oacc[dt][qt]);
                if (kb == 1 && (dt & 1)) SCHED_FENCE(); }
        if (more) { bf16_t* dK = (bf16_t*)(lds + ((t + 1) & 1) * L::STAGE); bf16_t* dV = (bf16_t*)(lds + ((t + 1) & 1) * L::STAGE + L::K_BYTES);
            *(U4*)(dK + sr * AK_LD + ss * 8) = rk;
#pragma unroll
            for (int i = 0; i < NVL; ++i) *(U4*)(dV + (sr + 64 * i) * A_LD + ss * 8) = rv[i]; }
        __syncthreads();
    }
#pragma unroll
    for (int qt = 0; qt < NQT; ++qt) { float l = lsum[qt]; l = xadd<16>(l); l = xadd<32>(l); lsum[qt] = l; }
}

struct NoMask { __device__ __forceinline__ float operator()(int, int, int, int, float s) const { return s; } };

__device__ __forceinline__ void diff_lambda(const Params& p, int l, float& lam, float& lam_init) {
    const int lane = TID() & 63; const float* dl = GIN(p.diff_lam) + (long)l * 4 * 64;
    const float a = wave_sum(dl[lane] * dl[64 + lane]), b = wave_sum(dl[128 + lane] * dl[192 + lane]);
    int ll = l;
#ifndef CPU_EMU
    asm volatile("" : "+s"(ll));
#endif
    lam_init = 0.8f - 0.6f * expf(-0.3f * (float)ll); lam = expf(a) - expf(b) + lam_init;
}
template <int NQT>
__device__ __forceinline__ void diff_attn_item(const Params& p, char* lds, int l, int b, int h, int q0, bool ctxq) {
    const int tid = TID(), wid = tid >> 6, lane = tid & 63, l15 = lane & 15, g = lane >> 4;
    const bf16_t* DQ = WSP(bf16_t, OFF_SEG_DQKV); const bf16_t* DVT = WSP(bf16_t, OFF_DVT); bf16_t* Y = WSP(bf16_t, OFF_Y);
    const int tok_q0 = ctxq ? NLAT + b * CTX + q0 : b * SEQ + q0;
    const int t_first = ctxq ? SEQ / 64 : 0, ntiles = ctxq ? CTX / 64 : KEYS / 64;
    f32x4 o1[8][NQT]; float l1[NQT];
    {
        auto qrow = [&](int i) { return DQ + (long)(tok_q0 + i) * 3 * MW + h * 128; };
        auto kt = [&](int t, const bf16_t*& kp, long& kld, const bf16_t*& vp, long& vld) { int tt = t_first + t; int tok = bk_tok(b, tt * 64);
            kp = DQ + (long)tok * 3 * MW + MW + h * 128; kld = 3 * MW; vp = DVT + ((long)b * MW + h * 128) * KEYS + tt * 64; vld = KEYS; };
        attn_core<NQT, 128>(lds, qrow, kt, ntiles, NoMask(), o1, l1);
    }
    U2 o1p[8][NQT];
#pragma unroll
    for (int qt = 0; qt < NQT; ++qt) { float inv = 1.0f / l1[qt];
#pragma unroll
        for (int dt = 0; dt < 8; ++dt) { f32x4 v = o1[dt][qt] * inv; o1p[dt][qt].x = pack2(v[0], v[1]); o1p[dt][qt].y = pack2(v[2], v[3]); } }
    f32x4 o2[8][NQT]; float l2[NQT];
    {
        auto qrow = [&](int i) { return DQ + (long)(tok_q0 + i) * 3 * MW + h * 128 + 64; };
        auto kt = [&](int t, const bf16_t*& kp, long& kld, const bf16_t*& vp, long& vld) { int tt = t_first + t; int tok = bk_tok(b, tt * 64);
            kp = DQ + (long)tok * 3 * MW + MW + h * 128 + 64; kld = 3 * MW; vp = DVT + ((long)b * MW + h * 128) * KEYS + tt * 64; vld = KEYS; };
        attn_core<NQT, 128>(lds, qrow, kt, ntiles, NoMask(), o2, l2);
    }
    const int tid2 = TID(), wid2 = tid2 >> 6, l15b = tid2 & 15, gb = (tid2 & 63) >> 4; bf16_t* Yo = WSP(bf16_t, OFF_Y);
    float lam, lam_init; diff_lambda(p, l, lam, lam_init);
    const float* nw = GIN(p.diff_norm) + l * 128;
#pragma unroll
    for (int qt = 0; qt < NQT; ++qt) { float inv = lam / l2[qt]; float ss = 0.f;
#pragma unroll
        for (int dt = 0; dt < 8; ++dt) { f32x4 a = (f32x4){bflo(o1p[dt][qt].x), bfhi(o1p[dt][qt].x), bflo(o1p[dt][qt].y), bfhi(o1p[dt][qt].y)}; o2[dt][qt] = a - o2[dt][qt] * inv;
#pragma unroll
            for (int j = 0; j < 4; ++j) ss += o2[dt][qt][j] * o2[dt][qt][j]; }
        ss = xadd<16>(ss); ss = xadd<32>(ss);
        const float r = rsqrtf(ss * (1.0f / 128.0f) + RMS_EPS) * (1.0f - lam_init);
        const long row = tok_q0 + wid2 * NQT * 16 + qt * 16 + l15b;
#pragma unroll
        for (int dt = 0; dt < 8; ++dt) { F4 w = *(const F4*)(nw + dt * 16 + gb * 4); f32x4 v = o2[dt][qt];
            v[0] *= r * w.x; v[1] *= r * w.y; v[2] *= r * w.z; v[3] *= r * w.w;
            st4bf(Yo + row * 4 * MW + 2 * MW + h * 128 + dt * 16 + gb * 4, v); }
    }
}

struct NaMask {
    const float* rpb;
    int qr, rs, rs0, nct;
    int cidx[16];
    __device__ __forceinline__ float operator()(int t, int mt, int j, int, float s) const {
        if (t < nct) return s;
        const int kr = rs0 + (t - nct), ci = cidx[mt * 4 + j];
        const bool ok = (kr >= rs) && (kr < rs + 8) && (ci >= 0);
        int dr = kr - qr + 7; dr = dr < 0 ? 0 : (dr > 14 ? 14 : dr);
        return ok ? s + rpb[dr * 31 + (ci < 0 ? 0 : ci)] : NEG_BIG;
    }
};
__device__ __forceinline__ void na_attn_item(const Params& p, char* lds, int l, int b, int h, int rp) {
    const int tid = TID(), wid = tid >> 6, lane = tid & 63, l15 = lane & 15, g = lane >> 4;
    const bf16_t* NQ = WSP(bf16_t, OFF_SEG_NQKV); const bf16_t* NVT = WSP(bf16_t, OFF_NVT); bf16_t* Y = WSP(bf16_t, OFF_Y);
    float* rpb = (float*)(lds + AttnLds<64>::TOTAL);
    __syncthreads();
    for (int i = tid; i < 15 * 31; i += NTH) rpb[i] = GIN(p.na_rpb)[((long)(l * NH + h) * 15) * 31 + i] * LOG2E;
    const int r0 = rp * 2; int rs0 = r0 - 4; rs0 = rs0 < 0 ? 0 : (rs0 > R_ROWS - 8 ? R_ROWS - 8 : rs0);
    int nwin = R_ROWS - rs0; nwin = nwin > 9 ? 9 : nwin;
    constexpr int NCT = CTX / 64;
    NaMask mk; mk.rpb = rpb; mk.rs0 = rs0; mk.nct = NCT;
    { const int qi = wid * 16 + l15, qc = qi & 63; mk.qr = r0 + (wid >> 2);
        int rs = mk.qr - 4; mk.rs = rs < 0 ? 0 : (rs > R_ROWS - 8 ? R_ROWS - 8 : rs);
        int cs = qc - 8; cs = cs < 0 ? 0 : (cs > GW - 16 ? GW - 16 : cs);
#pragma unroll
        for (int mt = 0; mt < 4; ++mt)
#pragma unroll
            for (int j = 0; j < 4; ++j) { const int kc = mt * 16 + g * 4 + j; int dc = kc - qc; dc = dc < -15 ? -15 : (dc > 15 ? 15 : dc); mk.cidx[mt * 4 + j] = (kc >= cs && kc < cs + 16) ? dc + 15 : -1; } }
    const int tok_q0 = b * SEQ + r0 * 64;
    auto qrow = [&](int i) { return NQ + (long)(tok_q0 + i) * 3 * MW + h * 64; };
    auto kt = [&](int t, const bf16_t*& kp, long& kld, const bf16_t*& vp, long& vld) { int key = t < NCT ? SEQ + t * 64 : (rs0 + t - NCT) * 64; int tok = bk_tok(b, key);
        kp = NQ + (long)tok * 3 * MW + MW + h * 64; kld = 3 * MW; vp = NVT + ((long)b * MW + h * 64) * KEYS + key; vld = KEYS; };
    f32x4 o[4][1]; float ls[1];
    attn_core<1, 64>(lds, qrow, kt, NCT + nwin, mk, o, ls);
    const float inv = 1.0f / ls[0]; const long row = tok_q0 + wid * 16 + l15;
#pragma unroll
    for (int dt = 0; dt < 4; ++dt) { f32x4 v = o[dt][0] * inv; st4bf(Y + row * 4 * MW + 3 * MW + h * 64 + dt * 16 + g * 4, v); }
}
__device__ __forceinline__ void na_ctx_item(const Params& p, char* lds, int b, int h, int q0) {
    const int tid = TID(), wid = tid >> 6, lane = tid & 63, l15 = lane & 15, g = lane >> 4;
    const bf16_t* NQ = WSP(bf16_t, OFF_SEG_NQKV); const bf16_t* NVT = WSP(bf16_t, OFF_NVT); bf16_t* Y = WSP(bf16_t, OFF_Y);
    const int tok_q0 = NLAT + b * CTX + q0;
    auto qrow = [&](int i) { return NQ + (long)(tok_q0 + i) * 3 * MW + h * 64; };
    auto kt = [&](int t, const bf16_t*& kp, long& kld, const bf16_t*& vp, long& vld) { int key = SEQ + t * 64; int tok = bk_tok(b, key);
        kp = NQ + (long)tok * 3 * MW + MW + h * 64; kld = 3 * MW; vp = NVT + ((long)b * MW + h * 64) * KEYS + key; vld = KEYS; };
    f32x4 o[4][1]; float ls[1];
    attn_core<1, 64>(lds, qrow, kt, CTX / 64, NoMask(), o, ls);
    const float inv = 1.0f / ls[0]; const long row = tok_q0 + wid * 16 + l15;
#pragma unroll
    for (int dt = 0; dt < 4; ++dt) { f32x4 v = o[dt][0] * inv; st4bf(Y + row * 4 * MW + 3 * MW + h * 64 + dt * 16 + g * 4, v); }
}

#define MFMA32(a, b, c) __builtin_amdgcn_mfma_f32_32x32x16_bf16(a, b, c, 0, 0, 0)
#ifndef CPU_EMU
typedef float f32x16 __attribute__((ext_vector_type(16)));
#endif
constexpr int D32_KT = 128;
constexpr int D32_KLD = 80, D32_VLD = D32_KT + 8;
constexpr int D32_KB = D32_KT * D32_KLD * 2, D32_VB = 128 * D32_VLD * 2, D32_STAGE = D32_KB + D32_VB, D32_TOTAL = 2 * D32_STAGE;
static_assert(D32_TOTAL <= 160 * 1024 - 64 && KEYS % D32_KT == 0, "diff32 lds");

__device__ __forceinline__ void diff32_pass(char* lds, const bf16_t* qp  , const bf16_t* kbase  ,
                                            const bf16_t* vbase  , int b, f32x16 (&oacc)[4], float& lsum) {
    const int tid = TID(), lane = tid & 63, r32 = lane & 31, hh = lane >> 5;
    bf16x8 qf[4];
#pragma unroll
    for (int ks = 0; ks < 4; ++ks) qf[ks] = ld8(qp + ks * 16 + hh * 8);
#pragma unroll
    for (int dt = 0; dt < 4; ++dt)
#pragma unroll
        for (int r = 0; r < 16; ++r) oacc[dt][r] = 0.f;
    float mrun = -64.0f; lsum = 0.f;
    f32x16 cinit;
#pragma unroll
    for (int r = 0; r < 16; ++r) cinit[r] = -mrun;
    const int sr = tid >> 3, ss = tid & 7, vr_ = tid >> 4, vs = tid & 15;
    U4 rk[2], rv[4];
    constexpr int NT = KEYS / D32_KT;
    auto gload = [&](int t) { const long tok = bk_tok(b, t * D32_KT);
#pragma unroll
        for (int i = 0; i < 2; ++i) rk[i] = *(const U4*)(kbase + (tok + sr + 64 * i) * 3 * MW + ss * 8);
#pragma unroll
        for (int i = 0; i < 4; ++i) rv[i] = *(const U4*)(vbase + (long)(vr_ + 32 * i) * KEYS + t * D32_KT + vs * 8); };
    auto sstore = [&](int st) { bf16_t* sK = (bf16_t*)(lds + st * D32_STAGE); bf16_t* sV = (bf16_t*)(lds + st * D32_STAGE + D32_KB);
#pragma unroll
        for (int i = 0; i < 2; ++i) *(U4*)(sK + (sr + 64 * i) * D32_KLD + ss * 8) = rk[i];
#pragma unroll
        for (int i = 0; i < 4; ++i) { bf16_t* d = sV + (vr_ + 32 * i) * D32_VLD + (vs >> 1) * 16 + (vs & 1) * 4; *(U2*)d = (U2){rv[i].x, rv[i].y}; *(U2*)(d + 8) = (U2){rv[i].z, rv[i].w}; } };
    gload(0);
    __syncthreads();
    sstore(0);
    __syncthreads();
    for (int t = 0; t < NT; ++t) {
        const bool more = t + 1 < NT;
        if (more) gload(t + 1);
#pragma unroll 1
        for (int sub = 0; sub < 2; ++sub) {
        const bf16_t* sK = (const bf16_t*)(lds + (t & 1) * D32_STAGE) + sub * 64 * D32_KLD; const bf16_t* sV = (const bf16_t*)(lds + (t & 1) * D32_STAGE + D32_KB) + sub * 64;
        f32x16 s[2];
        {
            bf16x8 kf[2][4];
#pragma unroll
            for (int kt = 0; kt < 2; ++kt)
#pragma unroll
                for (int ks = 0; ks < 4; ++ks) kf[kt][ks] = ld8(sK + (kt * 32 + r32) * D32_KLD + ks * 16 + hh * 8);
            SCHED_FENCE();
#pragma unroll
            for (int kt = 0; kt < 2; ++kt) {
                s[kt] = MFMA32(kf[kt][0], qf[0], cinit);
#pragma unroll
                for (int ks = 1; ks < 4; ++ks) s[kt] = MFMA32(kf[kt][ks], qf[ks], s[kt]);
            }
        }
        float mx = -3.0e38f;
#pragma unroll
        for (int kt = 0; kt < 2; ++kt)
#pragma unroll
            for (int r = 0; r < 16; ++r) mx = fmaxf(mx, s[kt][r]);
        mx = xmax<32>(mx);
        if (__ballot(mx > 6.0f) != 0ull) {
            const float d = fmaxf(mx, 0.f), alpha = fexp2(-d);
            mrun += d; lsum *= alpha;
#pragma unroll
            for (int r = 0; r < 16; ++r) cinit[r] = -mrun;
#pragma unroll
            for (int kt = 0; kt < 2; ++kt)
#pragma unroll
                for (int r = 0; r < 16; ++r) s[kt][r] -= d;
#pragma unroll
            for (int dt = 0; dt < 4; ++dt) oacc[dt] *= alpha;
        }
        float ps = 0.f;
#pragma unroll
        for (int kt = 0; kt < 2; ++kt)
#pragma unroll
            for (int r = 0; r < 16; ++r) { float pv = fexp2(s[kt][r]); s[kt][r] = pv; ps += pv; }
        lsum += ps;
        {
            bf16x8 va[4], vb[4];
#define D32_LDV(dst, kt, sx) _Pragma("unroll") for (int dt = 0; dt < 4; ++dt) { dst[dt] = ld8(sV + (dt * 32 + r32) * D32_VLD + (kt) * 32 + (sx) * 16 + hh * 8); }
#define D32_PF(kt, sx) mk8u(pack2(s[kt][8 * (sx)], s[kt][8 * (sx) + 1]), pack2(s[kt][8 * (sx) + 2], s[kt][8 * (sx) + 3]), pack2(s[kt][8 * (sx) + 4], s[kt][8 * (sx) + 5]), pack2(s[kt][8 * (sx) + 6], s[kt][8 * (sx) + 7]))
#define D32_MMA(src, pf) _Pragma("unroll") for (int dt = 0; dt < 4; ++dt) oacc[dt] = MFMA32(src[dt], pf, oacc[dt]);
            D32_LDV(va, 0, 0) D32_LDV(vb, 0, 1)
            const bf16x8 p0 = D32_PF(0, 0), p1 = D32_PF(0, 1), p2 = D32_PF(1, 0), p3 = D32_PF(1, 1);
            SCHED_FENCE();
            D32_MMA(va, p0) D32_LDV(va, 1, 0)
            SCHED_FENCE();
            D32_MMA(vb, p1) D32_LDV(vb, 1, 1)
            SCHED_FENCE();
            D32_MMA(va, p2)
            D32_MMA(vb, p3)
#undef D32_LDV
#undef D32_PF
#undef D32_MMA
        }
        }
        if (more) sstore((t + 1) & 1);
        __syncthreads();
    }
    lsum = xadd<32>(lsum);
}

__device__ __forceinline__ void diff32_item(const Params& p, char* lds, int l, int b, int h, int q0, int comp) {
    const int tid = TID(), wid = tid >> 6, lane = tid & 63, r32 = lane & 31, hh = lane >> 5;
    const bf16_t* DQ = WSP(bf16_t, OFF_SEG_DQKV); const bf16_t* DVT = WSP(bf16_t, OFF_DVT);
    const long qtok = (long)b * SEQ + q0 + wid * 32 + r32;
    f32x16 oacc[4]; float ls;
    diff32_pass(lds, DQ + qtok * 3 * MW + h * 128 + comp * 64, DQ + MW + h * 128 + comp * 64, DVT + ((long)b * MW + h * 128) * KEYS, b, oacc, ls);
    bf16_t* Yo = WSP(bf16_t, OFF_Y) + qtok * 4 * MW + (comp == 0 ? 2 * MW : 0) + h * 128;
    const float inv = 1.0f / ls;
#pragma unroll
    for (int dt = 0; dt < 4; ++dt)
#pragma unroll
        for (int q = 0; q < 4; ++q) { const int dv = dt * 32 + 8 * q + 4 * hh;
            st4bf(Yo + dv, (f32x4){oacc[dt][4 * q] * inv, oacc[dt][4 * q + 1] * inv, oacc[dt][4 * q + 2] * inv, oacc[dt][4 * q + 3] * inv}); }
}

constexpr int N32_VLD = 72;
constexpr int N32_KB = 64 * D32_KLD * 2, N32_VB = 64 * N32_VLD * 2, N32_STAGE = N32_KB + N32_VB, N32_RPB = 2 * N32_STAGE;
static_assert(R_ROWS % 4 == 0 && GW == 64 && N32_RPB + 16 * 128 * 4 <= 100 * 1024, "na32");
__device__ __forceinline__ void na32_item(const Params& p, char* lds, int l, int b, int h, int rq) {
    const int tid = TID(), wid = tid >> 6, lane = tid & 63, r32 = lane & 31, hh = lane >> 5;
    const bf16_t* NQ = WSP(bf16_t, OFF_SEG_NQKV); const bf16_t* NVT = WSP(bf16_t, OFF_NVT);
    float* rpb = (float*)(lds + N32_RPB);
    __syncthreads();
    for (int i = tid; i < 16 * 128; i += NTH) { const int dr = i >> 7, c = (i & 127) - 48;
        rpb[i] = dr == 15 ? NEG_BIG : ((c >= 0 && c < 31) ? GIN(p.na_rpb)[((long)(l * NH + h) * 15 + dr) * 31 + c] * LOG2E : 0.f); }
    constexpr int NCT = CTX / 64;
    const int r0 = rq * 4, qr = r0 + (wid >> 1), qc = (wid & 1) * 32 + r32;
    int rs0 = r0 - 4; rs0 = rs0 < 0 ? 0 : (rs0 > R_ROWS - 8 ? R_ROWS - 8 : rs0);
    int rsl = r0 - 1; rsl = rsl < 0 ? 0 : (rsl > R_ROWS - 8 ? R_ROWS - 8 : rsl);
    const int NT = NCT + (rsl + 8 - rs0);
    int rs = qr - 4; rs = rs < 0 ? 0 : (rs > R_ROWS - 8 ? R_ROWS - 8 : rs);
    int cs = qc - 8; cs = cs < 0 ? 0 : (cs > GW - 16 ? GW - 16 : cs);
    const long qtok = (long)b * SEQ + qr * 64 + qc;
    bf16x8 qf[4];
    { const bf16_t* qp = NQ + qtok * 3 * MW + h * 64; constexpr float sc = 0.125f * LOG2E;
#pragma unroll
        for (int ks = 0; ks < 4; ++ks) { const U4 r = *(const U4*)(qp + ks * 16 + hh * 8);
            qf[ks] = mk8u(pack2(bflo(r.x) * sc, bfhi(r.x) * sc), pack2(bflo(r.y) * sc, bfhi(r.y) * sc), pack2(bflo(r.z) * sc, bfhi(r.z) * sc), pack2(bflo(r.w) * sc, bfhi(r.w) * sc)); } }
    f32x16 oacc[2];
#pragma unroll
    for (int dt = 0; dt < 2; ++dt)
#pragma unroll
        for (int r = 0; r < 16; ++r) oacc[dt][r] = 0.f;
    float mrun = -64.0f, lsum = 0.f;
    f32x16 cplain, cm[2];
#pragma unroll
    for (int r = 0; r < 16; ++r) cplain[r] = -mrun;
#pragma unroll
    for (int kt = 0; kt < 2; ++kt)
#pragma unroll
        for (int r = 0; r < 16; ++r) { const int kc = kt * 32 + (r & 3) + 8 * (r >> 2) + 4 * hh; cm[kt][r] = (kc >= cs && kc < cs + 16) ? -mrun : NEG_BIG; }
    const int sr = tid >> 3, ss = tid & 7;
    const bf16_t* kbase = NQ + MW + h * 64; const bf16_t* vbase = NVT + ((long)b * MW + h * 64) * KEYS;
    U4 rk, rv;
    auto gload = [&](int t) { const int key = t < NCT ? SEQ + t * 64 : (rs0 + t - NCT) * 64; const long tok = bk_tok(b, key);
        rk = *(const U4*)(kbase + (tok + sr) * 3 * MW + ss * 8); rv = *(const U4*)(vbase + (long)sr * KEYS + key + ss * 8); };
    auto sstore = [&](int st) { bf16_t* sK = (bf16_t*)(lds + st * N32_STAGE); bf16_t* sV = (bf16_t*)(lds + st * N32_STAGE + N32_KB);
        *(U4*)(sK + sr * D32_KLD + ss * 8) = rk; bf16_t* d = sV + sr * N32_VLD + (ss >> 1) * 16 + (ss & 1) * 4; *(U2*)d = (U2){rv.x, rv.y}; *(U2*)(d + 8) = (U2){rv.z, rv.w}; };
    gload(0);
    __syncthreads();
    sstore(0);
    __syncthreads();
    for (int t = 0; t < NT; ++t) {
        const bool more = t + 1 < NT;
        if (more) gload(t + 1);
        const bf16_t* sK = (const bf16_t*)(lds + (t & 1) * N32_STAGE); const bf16_t* sV = (const bf16_t*)(lds + (t & 1) * N32_STAGE + N32_KB);
        f32x16 s[2];
        {
            bf16x8 kf[2][4];
#pragma unroll
            for (int kt = 0; kt < 2; ++kt)
#pragma unroll
                for (int ks = 0; ks < 4; ++ks) kf[kt][ks] = ld8(sK + (kt * 32 + r32) * D32_KLD + ks * 16 + hh * 8);
            SCHED_FENCE();
            if (t < NCT) {
#pragma unroll
                for (int kt = 0; kt < 2; ++kt) { s[kt] = MFMA32(kf[kt][0], qf[0], cplain);
#pragma unroll
                    for (int ks = 1; ks < 4; ++ks) s[kt] = MFMA32(kf[kt][ks], qf[ks], s[kt]); }
            } else {
                const int kr = rs0 + t - NCT; const int rsel = (kr >= rs && kr < rs + 8) ? kr - qr + 7 : 15;
                const float* bp = rpb + rsel * 128 + (4 * hh - qc + 63);
#pragma unroll
                for (int kt = 0; kt < 2; ++kt) { s[kt] = MFMA32(kf[kt][0], qf[0], cm[kt]);
#pragma unroll
                    for (int ks = 1; ks < 4; ++ks) s[kt] = MFMA32(kf[kt][ks], qf[ks], s[kt]); }
#pragma unroll
                for (int kt = 0; kt < 2; ++kt)
#pragma unroll
                    for (int r = 0; r < 16; ++r) s[kt][r] += bp[kt * 32 + (r & 3) + 8 * (r >> 2)];
            }
        }
        float mx = -3.0e38f;
#pragma unroll
        for (int kt = 0; kt < 2; ++kt)
#pragma unroll
            for (int r = 0; r < 16; ++r) mx = fmaxf(mx, s[kt][r]);
        mx = xmax<32>(mx);
        if (__ballot(mx > 6.0f) != 0ull) {
            const float d = fmaxf(mx, 0.f), alpha = fexp2(-d);
            mrun += d; lsum *= alpha;
#pragma unroll
            for (int r = 0; r < 16; ++r) cplain[r] = -mrun;
#pragma unroll
            for (int kt = 0; kt < 2; ++kt)
#pragma unroll
                for (int r = 0; r < 16; ++r) { cm[kt][r] -= d; s[kt][r] -= d; }
#pragma unroll
            for (int dt = 0; dt < 2; ++dt) oacc[dt] *= alpha;
        }
        float ps = 0.f;
#pragma unroll
        for (int kt = 0; kt < 2; ++kt)
#pragma unroll
            for (int r = 0; r < 16; ++r) { float pv = fexp2(s[kt][r]); s[kt][r] = pv; ps += pv; }
        lsum += ps;
        {
            bf16x8 va[2], vb[2];
#define N32_LDV(dst, kt, sx) _Pragma("unroll") for (int dt = 0; dt < 2; ++dt) { dst[dt] = ld8(sV + (dt * 32 + r32) * N32_VLD + (kt) * 32 + (sx) * 16 + hh * 8); }
#define N32_PF(kt, sx) mk8u(pack2(s[kt][8 * (sx)], s[kt][8 * (sx) + 1]), pack2(s[kt][8 * (sx) + 2], s[kt][8 * (sx) + 3]), pack2(s[kt][8 * (sx) + 4], s[kt][8 * (sx) + 5]), pack2(s[kt][8 * (sx) + 6], s[kt][8 * (sx) + 7]))
#define N32_MMA(src, pf) _Pragma("unroll") for (int dt = 0; dt < 2; ++dt) oacc[dt] = MFMA32(src[dt], pf, oacc[dt]);
            N32_LDV(va, 0, 0) N32_LDV(vb, 0, 1)
            const bf16x8 p0 = N32_PF(0, 0), p1 = N32_PF(0, 1), p2 = N32_PF(1, 0), p3 = N32_PF(1, 1);
            SCHED_FENCE();
            N32_MMA(va, p0) N32_LDV(va, 1, 0)
            SCHED_FENCE();
            N32_MMA(vb, p1) N32_LDV(vb, 1, 1)
            SCHED_FENCE();
            N32_MMA(va, p2)
            N32_MMA(vb, p3)
#undef N32_LDV
#undef N32_PF
#undef N32_MMA
        }
        if (more) sstore((t + 1) & 1);
        __syncthreads();
    }
    lsum = xadd<32>(lsum);
    const int tid2 = TID(), lane2 = tid2 & 63, wid2 = tid2 >> 6;
    bf16_t* Yo = WSP(bf16_t, OFF_Y) + ((long)b * SEQ + (r0 + (wid2 >> 1)) * 64 + (wid2 & 1) * 32 + (lane2 & 31)) * 4 * MW + 3 * MW + h * 64;
    const float inv = 1.0f / lsum;
#pragma unroll
    for (int dt = 0; dt < 2; ++dt)
#pragma unroll
        for (int q = 0; q < 4; ++q) { const int dv = dt * 32 + 8 * q + 4 * (lane2 >> 5);
            st4bf(Yo + dv, (f32x4){oacc[dt][4 * q] * inv, oacc[dt][4 * q + 1] * inv, oacc[dt][4 * q + 2] * inv, oacc[dt][4 * q + 3] * inv}); }
}
static_assert(NTASK_GDN % 4 == 0, "gdn tasks");
__device__ __forceinline__ void gdn_decode(int chain, int n, int& b, int& h, int& dir, int& base, int& T, int& c) {
    dir = chain & 1; int bh = chain >> 1; h = bh % GH; b = bh / GH;
    if (n < NCH_CTX) { base = NLAT + b * CTX; T = CTX; c = n; } else { base = b * SEQ; T = SEQ; c = n - NCH_CTX; }
}
__device__ __forceinline__ int gdn_pos(int dir, int T, int c, int i) { int r = 64 * c + i; return dir ? T - 1 - r : r; }

constexpr int GP_K = 0, GP_V = 10240, GP_AB = 20480, GP_AD = 30720, GP_XT = GP_AD + 4 * 16 * 16 * 4, GP_R = GP_XT + 128 * 80 * 2, GP_F = GP_R + 16 * 132 * 4, GP_TASK = GP_F + 1024;
static_assert(2 * GP_TASK <= 160 * 1024 - 64 && NTASK_GDN % 2 == 0, "gdn prep lds");
__device__ __forceinline__ void gdn_chunk_prep2(const Params& p, char* lds, int l, int task0) {
    const int tid = TID(), wid = tid >> 6, lane = tid & 63, l15 = lane & 15, g = lane >> 4, tk = wid >> 2, w4 = wid & 3, t4 = tid & 255;
    const int task = task0 + tk, chain = task / NCH, n = task - chain * NCH;
    int b, h, dir, base, T, c; gdn_decode(chain, n, b, h, dir, base, T, c);
    char* L = lds + tk * GP_TASK;
    bf16_t* Kt = (bf16_t*)(L + GP_K); bf16_t* Vt = (bf16_t*)(L + GP_V); bf16_t* Ab = (bf16_t*)(L + GP_AB); float* Ad = (float*)(L + GP_AD); bf16_t* XT = (bf16_t*)(L + GP_XT); float* R = (float*)(L + GP_R);
    float* gcs = (float*)(L + GP_F); float* bet = gcs + 64; float* fac = gcs + 128;
    const bf16_t* GK = WSP(bf16_t, OFF_GK); const bf16_t* GV = WSP(bf16_t, OFF_GV); const float* GB = WSP(float, OFF_GB);
    __syncthreads();
#pragma unroll
    for (int q = 0; q < 2; ++q) { int pc = t4 + 256 * q, i = pc >> 3, s = pc & 7; long tok = base + gdn_pos(dir, T, c, i);
        *(U4*)(Kt + i * 80 + s * 8) = *(const U4*)(GK + tok * MW + h * 64 + s * 8);
        *(U4*)(Vt + i * 80 + s * 8) = *(const U4*)(GV + tok * MW + h * 64 + s * 8); }
    for (int i = t4; i < 128 * 80 / 8; i += 256) *(U4*)(XT + i * 8) = (U4){0u, 0u, 0u, 0u};
    if (w4 == 0) { long tok = base + gdn_pos(dir, T, c, lane); float gi = GB[tok * 4 * GH + dir * GH + h], be = GB[tok * 4 * GH + 2 * GH + dir * GH + h];
        float cs = gi;
        for (int o = 1; o < 64; o <<= 1) { float t = __shfl_up(cs, o); if (lane >= o) cs += t; }
        gcs[lane] = cs; bet[lane] = be; fac[lane] = be * __expf(cs); }
    __syncthreads();
    { const int mt = w4; const int i = mt * 16 + l15; const float bi = bet[i], gi = gcs[i];
        bf16x8 bfr[2];
#pragma unroll
        for (int ks = 0; ks < 2; ++ks) bfr[ks] = ld8(Kt + (mt * 16 + l15) * 80 + ks * 32 + g * 8);
        for (int nt = 0; nt <= mt; ++nt) { f32x4 acc = (f32x4){0.f, 0.f, 0.f, 0.f};
#pragma unroll
            for (int ks = 0; ks < 2; ++ks) acc = MFMA16(ld8(Kt + (nt * 16 + l15) * 80 + ks * 32 + g * 8), bfr[ks], acc);
            float v[4];
#pragma unroll
            for (int jj = 0; jj < 4; ++jj) { const int j = nt * 16 + g * 4 + jj; v[jj] = j < i ? bi * acc[jj] * __expf(gi - gcs[j]) : 0.f; }
            if (nt < mt) *(U2*)(Ab + i * 80 + nt * 16 + g * 4) = (U2){pack2(v[0], v[1]), pack2(v[2], v[3])};
            else { *(U2*)(Ab + i * 80 + nt * 16 + g * 4) = (U2){0u, 0u}; *(F4*)(Ad + (mt * 16 + l15) * 16 + g * 4) = (F4){v[0], v[1], v[2], v[3]}; } }
    }
    __syncthreads();
    const bool wcol = t4 < 64; const int cc = t4 & 63;
    const bf16_t* src = wcol ? Kt : Vt; const float* scl = wcol ? fac : bet;
    bf16_t* dst = WSP(bf16_t, OFF_WU) + ((long)task * 2 + (wcol ? 0 : 1)) * 4096 + cc;
#pragma unroll
    for (int I = 0; I < 4; ++I) {
        if (I > 0) {
#pragma unroll
            for (int q = 0; q < 2; ++q) { const int nt = w4 * 2 + q; f32x4 acc = (f32x4){0.f, 0.f, 0.f, 0.f};
                acc = MFMA16(ld8(Ab + (I * 16 + l15) * 80 + g * 8), ld8(XT + (nt * 16 + l15) * 80 + g * 8), acc);
                if (I == 3) acc = MFMA16(ld8(Ab + (I * 16 + l15) * 80 + 32 + g * 8), ld8(XT + (nt * 16 + l15) * 80 + 32 + g * 8), acc);
#pragma unroll
                for (int jj = 0; jj < 4; ++jj) R[(g * 4 + jj) * 132 + nt * 16 + l15] = acc[jj]; }
            __syncthreads();
        }
        if (t4 < 128) {
            float x[16];
#pragma unroll
            for (int ii = 0; ii < 16; ++ii) { float a = scl[I * 16 + ii] * bf2f(src[(I * 16 + ii) * 80 + cc]); if (I > 0) a -= R[ii * 132 + t4];
#pragma unroll
                for (int jj = 0; jj < ii; ++jj) a -= Ad[(I * 16 + ii) * 16 + jj] * x[jj];
                x[ii] = a; }
            *(U4*)(XT + t4 * 80 + I * 16) = (U4){pack2(x[0], x[1]), pack2(x[2], x[3]), pack2(x[4], x[5]), pack2(x[6], x[7])};
            *(U4*)(XT + t4 * 80 + I * 16 + 8) = (U4){pack2(x[8], x[9]), pack2(x[10], x[11]), pack2(x[12], x[13]), pack2(x[14], x[15])};
#pragma unroll
            for (int ii = 0; ii < 16; ++ii) dst[(I * 16 + ii) * 64] = f2bf(x[ii]);
        }
        __syncthreads();
    }
}

constexpr int GS_W = 0, GS_Q = 10240, GS_K = 20480, GS_KT = 30720, GS_GC = 40960, GS_STAGE = 40960 + 512;
constexpr int GS_ST = 2 * GS_STAGE, GS_VNT = GS_ST + 2 * 5120, GS_VNT2 = GS_VNT + 5120, GS_ATT = GS_VNT2 + 5120, GS_TOTAL = GS_ATT + 10240;
__device__ __forceinline__ void gdn_scan_item(const Params& p, char* lds, int l, int cb) {
    const int tid = TID(), wid = tid >> 6, lane = tid & 63, l15 = lane & 15, g = lane >> 4, mt = wid >> 1, nt = wid & 1;
    {
    const int chain = cb >> 1, half = cb & 1;
    const bf16_t* GQ = WSP(bf16_t, OFF_GQ); const bf16_t* GK = WSP(bf16_t, OFF_GK); const float* GB = WSP(float, OFF_GB); const bf16_t* WU = WSP(bf16_t, OFF_WU);
    const int sr = tid >> 3, ss = tid & 7;
    f32x4 sacc = (f32x4){0.f, 0.f, 0.f, 0.f};
    U4 rw, rq, rk; float ucur[4], unext[4]; float gnext = 0.f;
    auto load_chunk = [&](int n) {
        int b, h, dir, base, T, c; gdn_decode(chain, n, b, h, dir, base, T, c);
        const long task = (long)chain * NCH + n; const long tok = base + gdn_pos(dir, T, c, sr);
        rw = *(const U4*)(WU + (task * 2 + 0) * 4096 + sr * 64 + ss * 8);
        rq = *(const U4*)(GQ + tok * MW + h * 64 + ss * 8);
        rk = *(const U4*)(GK + tok * MW + h * 64 + ss * 8);
#pragma unroll
        for (int j = 0; j < 4; ++j) unext[j] = bf2f(WU[(task * 2 + 1) * 4096 + (mt * 16 + g * 4 + j) * 64 + half * 32 + nt * 16 + l15]);
        if (wid == 0) { const long tk = base + gdn_pos(dir, T, c, lane); gnext = GB[tk * 4 * GH + dir * GH + h]; }
    };
    auto store_chunk = [&](int st) {
        char* S = lds + st * GS_STAGE;
        *(U4*)((bf16_t*)(S + GS_W) + sr * 80 + ss * 8) = rw;
        *(U4*)((bf16_t*)(S + GS_Q) + sr * 80 + ss * 8) = rq;
        *(U4*)((bf16_t*)(S + GS_K) + sr * 80 + ss * 8) = rk;
        bf16_t* KT = (bf16_t*)(S + GS_KT);
        const u32 kw[4] = {rk.x, rk.y, rk.z, rk.w};
#pragma unroll
        for (int e = 0; e < 4; ++e) { KT[(ss * 8 + 2 * e) * 80 + sr] = (bf16_t)(kw[e] & 0xffffu); KT[(ss * 8 + 2 * e + 1) * 80 + sr] = (bf16_t)(kw[e] >> 16); }
        if (wid == 0) { float cs = gnext;
            for (int o = 1; o < 64; o <<= 1) { float t = __shfl_up(cs, o); if (lane >= o) cs += t; }
            ((float*)(S + GS_GC))[lane] = cs; }
    };
    __syncthreads();
    { bf16_t* ST0 = (bf16_t*)(lds + GS_ST); for (int i = tid; i < 32 * 80; i += NTH) ST0[i] = 0; }
    load_chunk(0); store_chunk(0);
#pragma unroll
    for (int j = 0; j < 4; ++j) ucur[j] = unext[j];
    __syncthreads();
    for (int n = 0; n < NCH; ++n) {
        const int st = n & 1;
        if (n + 1 < NCH) load_chunk(n + 1);
        const char* S = lds + st * GS_STAGE;
        const bf16_t* Wt = (const bf16_t*)(S + GS_W); const bf16_t* Qt = (const bf16_t*)(S + GS_Q); const bf16_t* Kt = (const bf16_t*)(S + GS_K); const bf16_t* KT = (const bf16_t*)(S + GS_KT);
        const float* gc = (const float*)(S + GS_GC);
        const bf16_t* STc = (const bf16_t*)(lds + GS_ST + st * 5120); bf16_t* STn = (bf16_t*)(lds + GS_ST + (st ^ 1) * 5120);
        bf16_t* VNT = (bf16_t*)(lds + GS_VNT); bf16_t* VNT2 = (bf16_t*)(lds + GS_VNT2); bf16_t* ATT = (bf16_t*)(lds + GS_ATT);
        const float gl = gc[63];
#pragma unroll
        for (int q = 0; q < 2; ++q) { const int tile = wid * 2 + q, it = tile >> 2, jt = tile & 3;
            f32x4 acc = (f32x4){0.f, 0.f, 0.f, 0.f};
            if (jt <= it) {
#pragma unroll
                for (int ks = 0; ks < 2; ++ks) acc = MFMA16(ld8(Kt + (jt * 16 + l15) * 80 + ks * 32 + g * 8), ld8(Qt + (it * 16 + l15) * 80 + ks * 32 + g * 8), acc);
            }
            const int i = it * 16 + l15; const float gi = gc[i]; float v[4];
#pragma unroll
            for (int j = 0; j < 4; ++j) { const int jp = jt * 16 + g * 4 + j; v[j] = jp <= i ? acc[j] * __expf(gi - gc[jp]) : 0.f; }
            U2 o; o.x = pack2(v[0], v[1]); o.y = pack2(v[2], v[3]); *(U2*)(ATT + i * 80 + jt * 16 + g * 4) = o; }
        {
            f32x4 acc = (f32x4){0.f, 0.f, 0.f, 0.f};
#pragma unroll
            for (int ks = 0; ks < 2; ++ks) acc = MFMA16(ld8(Wt + (mt * 16 + l15) * 80 + ks * 32 + g * 8), ld8(STc + (nt * 16 + l15) * 80 + ks * 32 + g * 8), acc);
            float vn[4], vn2[4];
#pragma unroll
            for (int j = 0; j < 4; ++j) { vn[j] = ucur[j] - acc[j]; vn2[j] = vn[j] * __expf(gl - gc[mt * 16 + g * 4 + j]); }
            U2 o; o.x = pack2(vn[0], vn[1]); o.y = pack2(vn[2], vn[3]); *(U2*)(VNT + (nt * 16 + l15) * 80 + mt * 16 + g * 4) = o;
            U2 o2; o2.x = pack2(vn2[0], vn2[1]); o2.y = pack2(vn2[2], vn2[3]); *(U2*)(VNT2 + (nt * 16 + l15) * 80 + mt * 16 + g * 4) = o2;
        }
        __syncthreads();
        {
            f32x4 a1 = (f32x4){0.f, 0.f, 0.f, 0.f}, a2 = (f32x4){0.f, 0.f, 0.f, 0.f};
#pragma unroll
            for (int ks = 0; ks < 2; ++ks) { a1 = MFMA16(ld8(Qt + (mt * 16 + l15) * 80 + ks * 32 + g * 8), ld8(STc + (nt * 16 + l15) * 80 + ks * 32 + g * 8), a1);
                a2 = MFMA16(ld8(ATT + (mt * 16 + l15) * 80 + ks * 32 + g * 8), ld8(VNT + (nt * 16 + l15) * 80 + ks * 32 + g * 8), a2); }
            int b, h, dir, base, T, c; gdn_decode(chain, n, b, h, dir, base, T, c);
            bf16_t* O = WSP(bf16_t, dir ? OFF_OB : OFF_OF);
#pragma unroll
            for (int j = 0; j < 4; ++j) { const int i = mt * 16 + g * 4 + j; const long tok = base + gdn_pos(dir, T, c, i);
                O[tok * MW + h * 64 + half * 32 + nt * 16 + l15] = f2bf(__expf(gc[i]) * a1[j] + a2[j]); }
        }
        {
            f32x4 acc = sacc * __expf(gl);
#pragma unroll
            for (int ks = 0; ks < 2; ++ks) acc = MFMA16(ld8(KT + (mt * 16 + l15) * 80 + ks * 32 + g * 8), ld8(VNT2 + (nt * 16 + l15) * 80 + ks * 32 + g * 8), acc);
            sacc = acc;
            U2 o; o.x = pack2(acc[0], acc[1]); o.y = pack2(acc[2], acc[3]); *(U2*)(STn + (nt * 16 + l15) * 80 + mt * 16 + g * 4) = o;
        }
        if (n + 1 < NCH) { store_chunk(st ^ 1);
#pragma unroll
            for (int j = 0; j < 4; ++j) ucur[j] = unext[j]; }
        __syncthreads();
    }
    }
}
__device__ __forceinline__ int hy_phys(int p) { return p + ((p >> 6) << 2); }
constexpr int HY_X = 0, HY_T1 = (int)HY_XN * 8, HY_T2 = HY_T1 + 128 * 8, HY_W3 = HY_T2 + 128 * 8, HY_RED = HY_W3 + 2 * 64 * 4, HY_TOTAL = HY_RED + 64 * 4;
static_assert(HY_TOTAL <= 160 * 1024 - 64, "hyena lds");
#ifdef CPU_EMU
__device__ __forceinline__ F2 cmul(F2 a, F2 b) { return (F2){a.x * b.x - a.y * b.y, a.x * b.y + a.y * b.x}; }
__device__ __forceinline__ F2 cmulc(F2 a, F2 b) { return (F2){a.x * b.x + a.y * b.y, a.y * b.x - a.x * b.y}; }
__device__ __forceinline__ F2 add_mi(F2 a, F2 d) { return (F2){a.x + d.y, a.y - d.x}; }
__device__ __forceinline__ F2 sub_mi(F2 a, F2 d) { return (F2){a.x - d.y, a.y + d.x}; }
#else
__device__ __forceinline__ F2 cmul(F2 a, F2 b) { F2 t, r;
    asm("v_pk_mul_f32 %0, %1, %2 op_sel:[1,1] op_sel_hi:[1,0] neg_lo:[0,1]" : "=v"(t) : "v"(a), "v"(b));
    asm("v_pk_fma_f32 %0, %1, %2, %3 op_sel_hi:[0,1,1]" : "=v"(r) : "v"(a), "v"(b), "v"(t));
    return r; }
__device__ __forceinline__ F2 cmulc(F2 a, F2 b) { F2 t, r;
    asm("v_pk_mul_f32 %0, %1, %2 op_sel:[1,1] op_sel_hi:[1,0]" : "=v"(t) : "v"(a), "v"(b));
    asm("v_pk_fma_f32 %0, %1, %2, %3 op_sel_hi:[0,1,1] neg_hi:[0,1,0]" : "=v"(r) : "v"(a), "v"(b), "v"(t));
    return r; }
__device__ __forceinline__ F2 add_mi(F2 a, F2 d) { F2 r; asm("v_pk_add_f32 %0, %1, %2 op_sel:[0,1] op_sel_hi:[1,0] neg_hi:[0,1]" : "=v"(r) : "v"(a), "v"(d)); return r; }
__device__ __forceinline__ F2 sub_mi(F2 a, F2 d) { F2 r; asm("v_pk_add_f32 %0, %1, %2 op_sel:[0,1] op_sel_hi:[1,0] neg_lo:[0,1]" : "=v"(r) : "v"(a), "v"(d)); return r; }
#endif
__device__ __forceinline__ F2 twid(const F2* T1, const F2* T2, int q) { return cmul(T1[q >> 7], T2[q & 127]); }

constexpr int ilog2c(int n) { return n <= 1 ? 0 : 1 + ilog2c(n >> 1); }
__device__ __forceinline__ void bf4_fwd(F2& x0, F2& x1, F2& x2, F2& x3, F2 w1, F2 w2) {
    const F2 a0 = x0 + x2, a2 = cmul(x0 - x2, w1), a1 = x1 + x3, d = cmul(x1 - x3, w1);
    x0 = a0 + a1; x1 = cmul(a0 - a1, w2); x2 = add_mi(a2, d); x3 = cmul(sub_mi(a2, d), w2); }
__device__ __forceinline__ void bf4_inv(F2& y0, F2& y1, F2& y2, F2& y3, F2 w1, F2 w2) {
    F2 t = cmulc(y1, w2); const F2 a0 = y0 + t, a1 = y0 - t; t = cmulc(y3, w2); const F2 a2 = y2 + t, a3 = y2 - t;
    t = cmulc(a2, w1); y0 = a0 + t; y2 = a0 - t; const F2 u = cmulc(a3, w1); y1 = sub_mi(a1, u); y3 = add_mi(a1, u); }
#define W16_1 ((F2){0.9238795325112867f, -0.3826834323650898f})
#define W16_2 ((F2){0.7071067811865476f, -0.7071067811865476f})
#define W16_3 ((F2){0.3826834323650898f, -0.9238795325112867f})
struct LdsLd { static constexpr bool REGS = false; const F2* X; __device__ __forceinline__ F2 operator()(int p, int = 0) const { return X[p]; } };
struct LdsSt { static constexpr bool REGS = false; F2* X; __device__ __forceinline__ void operator()(int p, F2 v, int = 0) const { X[p] = v; } };
struct HfGlbSt { static constexpr bool REGS = false; F2* HF; __device__ __forceinline__ void operator()(int p, F2 v, int = 0) const { HF[p] = v; } };
struct HfGlbLd { static constexpr bool REGS = false; const F2* X; const F2* HF; __device__ __forceinline__ F2 operator()(int p, int = 0) const { return cmul(X[p], HF[p]); } };
struct HfRegSt { static constexpr bool REGS = true; F2 (&h)[16]; F2* HF; __device__ __forceinline__ void operator()(int p, F2 v, int slot) const { if (slot < 16) h[slot] = v; else HF[p] = v; } };
struct HfRegLd { static constexpr bool REGS = true; const F2* X; const F2 (&h)[16]; const F2* HF; __device__ __forceinline__ F2 operator()(int p, int slot) const { return cmul(X[p], slot < 16 ? h[slot] : HF[p]); } };
template <int N, int M, bool INV, class LD, class ST>
__device__ __forceinline__ void fft_r16(const F2* T1, const F2* T2, int tid, LD& ld, ST& st) {
    constexpr int q16 = M / 16, sh = N / M, NB = N / 16;
#pragma unroll
    for (int it_ = 0; it_ < (NB + NTH - 1) / NTH; ++it_) { const int idx = tid + it_ * NTH; if (NB % NTH != 0 && idx >= NB) break;
        const int blk = idx / q16, j = idx - blk * q16, p0 = blk * M + j, pp0 = hy_phys(p0);
        auto el = [&](int k) { if constexpr (q16 % 64 == 0) return pp0 + k * (q16 / 64 * 68); else if constexpr (M <= 64) return pp0 + k * q16; else return hy_phys(p0 + k * q16); };
        F2 e[16];
#pragma unroll
        for (int k = 0; k < 16; ++k) e[k] = ld(el(k));
        const F2 wa0 = twid(T1, T2, j * sh);
        const F2 wa1 = cmul(wa0, W16_1), wa2 = cmul(wa0, W16_2), wa3 = cmul(wa0, W16_3);
        const F2 wa0s = cmul(wa0, wa0); const F2 wb = cmul(wa0s, wa0s), wbs = cmul(wb, wb);
        if (!INV) {
            bf4_fwd(e[0], e[4], e[8], e[12], wa0, wa0s); bf4_fwd(e[1], e[5], e[9], e[13], wa1, cmul(wa1, wa1));
            bf4_fwd(e[2], e[6], e[10], e[14], wa2, cmul(wa2, wa2)); bf4_fwd(e[3], e[7], e[11], e[15], wa3, cmul(wa3, wa3));
#pragma unroll
            for (int c = 0; c < 4; ++c) bf4_fwd(e[4 * c], e[4 * c + 1], e[4 * c + 2], e[4 * c + 3], wb, wbs);
        } else {
#pragma unroll
            for (int c = 0; c < 4; ++c) bf4_inv(e[4 * c], e[4 * c + 1], e[4 * c + 2], e[4 * c + 3], wb, wbs);
            bf4_inv(e[0], e[4], e[8], e[12], wa0, wa0s); bf4_inv(e[1], e[5], e[9], e[13], wa1, cmul(wa1, wa1));
            bf4_inv(e[2], e[6], e[10], e[14], wa2, cmul(wa2, wa2)); bf4_inv(e[3], e[7], e[11], e[15], wa3, cmul(wa3, wa3));
        }
#pragma unroll
        for (int k = 0; k < 16; ++k) st(el(k), e[k]);
    }
    __syncthreads();
}
template <int N, int M, bool INV, class LD, class ST>
__device__ __forceinline__ void fft_r4(const F2* T1, const F2* T2, int tid, LD& ld, ST& st) {
    constexpr int q4 = M / 4, sh = N / M, NB = N / 4, NI = (NB + NTH - 1) / NTH;
    auto body = [&](int it_) { const int idx = tid + it_ * NTH;
        const int blk = idx / q4, j = idx - blk * q4, p0 = blk * M + j, pp0 = hy_phys(p0);
        auto el = [&](int k) { if constexpr (q4 % 64 == 0) return pp0 + k * (q4 / 64 * 68); else if constexpr (M <= 64) return pp0 + k * q4; else return hy_phys(p0 + k * q4); };
        F2 x0 = ld(el(0), it_ * 4), x1 = ld(el(1), it_ * 4 + 1), x2 = ld(el(2), it_ * 4 + 2), x3 = ld(el(3), it_ * 4 + 3);
        const F2 w1 = twid(T1, T2, j * sh), w2 = cmul(w1, w1);
        if (!INV) bf4_fwd(x0, x1, x2, x3, w1, w2); else bf4_inv(x0, x1, x2, x3, w1, w2);
        st(el(0), x0, it_ * 4); st(el(1), x1, it_ * 4 + 1); st(el(2), x2, it_ * 4 + 2); st(el(3), x3, it_ * 4 + 3); };
    if constexpr (LD::REGS || ST::REGS) { static_assert(NI * 4 == 32 && NB % NTH == 0, "register-resident hook: 32 slots");
#pragma unroll
        for (int it_ = 0; it_ < NI; ++it_) { body(it_); SCHED_FENCE(); }
    } else {
#pragma unroll 4
        for (int it_ = 0; it_ < NI; ++it_) { if (NB % NTH != 0 && tid + it_ * NTH >= NB) break; body(it_); }
    }
    __syncthreads();
}
template <int N, class LD, class ST>
__device__ __forceinline__ void fft_r2(int tid, LD& ld, ST& st) {
#pragma unroll
    for (int it_ = 0; it_ < ((N >> 1) + NTH - 1) / NTH; ++it_) { const int idx = tid + it_ * NTH; if ((N >> 1) % NTH != 0 && idx >= (N >> 1)) break;
        const int pp = hy_phys(2 * idx); const F2 x0 = ld(pp), x1 = ld(pp + 1); st(pp, x0 + x1); st(pp + 1, x0 - x1); }
    __syncthreads();
}
template <int N, int M> struct FftFwd16 { template <class LD, class ST> static __device__ __forceinline__ void run(F2* X, const F2* T1, const F2* T2, int tid, LD& ld0, ST& stl) {
    LdsLd ldx{X}; LdsSt stx{X};
    if constexpr (M >= 16) {
        constexpr bool first = (M == N), last = (M / 16 <= 1);
        if constexpr (first && last) fft_r16<N, M, false>(T1, T2, tid, ld0, stl); else if constexpr (first) fft_r16<N, M, false>(T1, T2, tid, ld0, stx);
        else if constexpr (last) fft_r16<N, M, false>(T1, T2, tid, ldx, stl); else fft_r16<N, M, false>(T1, T2, tid, ldx, stx);
        if constexpr (!last) FftFwd16<N, M / 16>::run(X, T1, T2, tid, ld0, stl); }
    else if constexpr (M == 8) { fft_r4<N, 8, false>(T1, T2, tid, ldx, stx); fft_r2<N>(tid, ldx, stl); }
    else if constexpr (M == 4) { fft_r4<N, 4, false>(T1, T2, tid, ldx, stl); }
    else if constexpr (M == 2) { fft_r2<N>(tid, ldx, stl); } } };
template <int N, int M> struct FftInv16 { template <class LD, class ST> static __device__ __forceinline__ void run(F2* X, const F2* T1, const F2* T2, int tid, LD& ld0, ST& stl) {
    LdsLd ldx{X}; LdsSt stx{X};
    if constexpr (M >= 16) {
        constexpr bool last = (M == N), first = (M / 16 <= 1);
        if constexpr (!first) FftInv16<N, M / 16>::run(X, T1, T2, tid, ld0, stl);
        if constexpr (first && last) fft_r16<N, M, true>(T1, T2, tid, ld0, stl); else if constexpr (first) fft_r16<N, M, true>(T1, T2, tid, ld0, stx);
        else if constexpr (last) fft_r16<N, M, true>(T1, T2, tid, ldx, stl); else fft_r16<N, M, true>(T1, T2, tid, ldx, stx); }
    else if constexpr (M == 8) { fft_r2<N>(tid, ld0, stx); fft_r4<N, 8, true>(T1, T2, tid, ldx, stx); }
    else if constexpr (M == 4) { fft_r4<N, 4, true>(T1, T2, tid, ld0, stx); }
    else if constexpr (M == 2) { fft_r2<N>(tid, ld0, stx); } } };
template <int N, class LD, class ST> __device__ __forceinline__ void fft_fwd(F2* X, const F2* T1, const F2* T2, int tid, LD& ld0, ST& stl) { static_assert(N >= 32, "fft"); FftFwd16<N, N>::run(X, T1, T2, tid, ld0, stl); }
template <int N, class LD, class ST> __device__ __forceinline__ void fft_inv(F2* X, const F2* T1, const F2* T2, int tid, LD& ld0, ST& stl) { FftInv16<N, N>::run(X, T1, T2, tid, ld0, stl); }

template <bool ctxs>
__device__ __forceinline__ void hyena_item(const Params& p, char* lds, int l, int ch) {
    const int tid = TID(), bid = BID(), lane = tid & 63, wid = tid >> 6;
    constexpr int L = ctxs ? CTX : SEQ, N = 2 * L, k0 = ctxs ? SEQ : 0;
    F2* X = (F2*)(lds + HY_X); F2* T1 = (F2*)(lds + HY_T1); F2* T2 = (F2*)(lds + HY_T2); float* red = (float*)(lds + HY_RED);
    const bf16_t* HYT = WSP(bf16_t, OFF_HYT);
    F2* HF = WSP(F2, OFF_HF) + (long)bid * HY_XN; float* ZT = WSP(float, OFF_ZT) + (long)bid * 2 * SEQ; bf16_t* YAT = WSP(bf16_t, OFF_YAT);
    __syncthreads();
    if (tid < 128) { float s, c; float a = -6.283185307179586f * (float)(tid * 128) / (float)N; s = sinf(a); c = cosf(a); T1[tid] = (F2){c, s}; }
    else if (tid < 256) { int b_ = tid - 128; float s, c; float a = -6.283185307179586f * (float)b_ / (float)N; s = sinf(a); c = cosf(a); T2[b_] = (F2){c, s}; }
    __syncthreads();
    const float* cwp = GIN(p.hy_conv) + ((long)l * 3 * MW + ch) * 3;
    auto conv8 = [&](int seg, int b, int t0, float (&o8)[8]) { const bf16_t* r = HYT + ((long)b * 3 * MW + seg * MW + ch) * KEYS + k0 + t0;
        const U4 c = *(const U4*)r; const float vm = t0 > 0 ? bf2f(r[-1]) : 0.f, vp = t0 + 8 < L ? bf2f(r[8]) : 0.f;
        const float v[10] = {vm, bflo(c.x), bfhi(c.x), bflo(c.y), bfhi(c.y), bflo(c.z), bfhi(c.z), bflo(c.w), bfhi(c.w), vp};
        const float* wq = cwp + (long)seg * MW * 3; const F4 w = (F4){wq[0], wq[1], wq[2], 0.f};
#pragma unroll
        for (int j = 0; j < 8; ++j) o8[j] = v[j + 1] * w.y + v[j] * w.x + v[j + 2] * w.z; };
    constexpr int L8 = L / 8, NIT8 = (L8 + NTH - 1) / NTH;
    for (int o = 0; o < 2; ++o) {
        const bf16_t* tf = WSP(bf16_t, OFF_TAPS) + (long)(o * HYW + ch) * KEYS + k0; const bf16_t* tb = WSP(bf16_t, OFF_TAPS) + (long)(2 * HYW + o * HYW + ch) * KEYS + k0;
        const float sk = GIN(p.hy_skip)[((long)l * 2 + o) * HYW + ch];
        float nrm = 0.f;
#pragma unroll
        for (int it_ = 0; it_ < NIT8; ++it_) { const int i8 = tid + it_ * NTH; if (L8 % NTH != 0 && i8 >= L8) break; const int t0 = i8 * 8;
            const U4 fa = *(const U4*)(tf + t0), fb = *(const U4*)(tb + t0);
            const float af[8] = {bflo(fa.x), bfhi(fa.x), bflo(fa.y), bfhi(fa.y), bflo(fa.z), bfhi(fa.z), bflo(fa.w), bfhi(fa.w)};
            const float ab[8] = {bflo(fb.x), bfhi(fb.x), bflo(fb.y), bfhi(fb.y), bflo(fb.z), bfhi(fb.z), bflo(fb.w), bfhi(fb.w)};
#pragma unroll
            for (int j = 0; j < 4; ++j) *(F4*)(X + hy_phys(t0) + 2 * j) = (F4){af[2 * j], 0.f, af[2 * j + 1], 0.f};
#pragma unroll
            for (int j = 0; j < 8; ++j) { nrm += fabsf(af[j]);
                if (j == 0 && t0 == 0) X[hy_phys(L)] = (F2){0.f, 0.f}; else { X[hy_phys(N - t0 - j)] = (F2){ab[j], 0.f}; nrm += fabsf(ab[j]); } } }
        nrm = wave_sum(nrm);
        if (lane == 0) red[wid] = nrm;
        __syncthreads();
        constexpr bool HREG = (N == 16384);
        F2 hreg[16];
        if constexpr (HREG) { LdsLd ldx0{X}; HfRegSt sth{hreg, HF}; fft_fwd<N>(X, T1, T2, tid, ldx0, sth); }
        else { LdsLd ldx0{X}; HfGlbSt sth{HF}; fft_fwd<N>(X, T1, T2, tid, ldx0, sth); }
        auto zval8 = [&](int t0, float (&z0)[8], float (&z1)[8]) {
            if (o == 0) { conv8(0, 0, t0, z0); conv8(0, 1, t0, z1); }
            else { const F4 a0 = *(const F4*)(ZT + t0), a1 = *(const F4*)(ZT + t0 + 4), b0 = *(const F4*)(ZT + SEQ + t0), b1 = *(const F4*)(ZT + SEQ + t0 + 4);
                z0[0] = a0.x; z0[1] = a0.y; z0[2] = a0.z; z0[3] = a0.w; z0[4] = a1.x; z0[5] = a1.y; z0[6] = a1.z; z0[7] = a1.w;
                z1[0] = b0.x; z1[1] = b0.y; z1[2] = b0.z; z1[3] = b0.w; z1[4] = b1.x; z1[5] = b1.y; z1[6] = b1.z; z1[7] = b1.w; } };
        LdsSt stx{X}; LdsLd ldx{X};
#pragma unroll
        for (int it_ = 0; it_ < NIT8; ++it_) { const int i8 = tid + it_ * NTH; if (L8 % NTH != 0 && i8 >= L8) break; const int t0 = i8 * 8;
            float z0[8], z1[8]; zval8(t0, z0, z1);
            float zr = 0.f;
#ifndef CPU_EMU
            asm volatile("v_mov_b32 %0, 0" : "=v"(zr));
#endif
#pragma unroll
            for (int j = 0; j < 4; ++j) { *(F4*)(X + hy_phys(t0) + 2 * j) = (F4){z0[2 * j], z1[2 * j], z0[2 * j + 1], z1[2 * j + 1]}; *(F4*)(X + hy_phys(L + t0) + 2 * j) = (F4){zr, zr, zr, zr}; } }
        __syncthreads();
        fft_fwd<N>(X, T1, T2, tid, ldx, stx);
        float tot = 0.f;
#pragma unroll
        for (int w = 0; w < 8; ++w) tot += red[w];
        const float sc = 1.0f / (tot * (float)N);
        if constexpr (HREG) { HfRegLd ldm{X, hreg, HF}; fft_inv<N>(X, T1, T2, tid, ldm, stx); }
        else { HfGlbLd ldm{X, HF}; fft_inv<N>(X, T1, T2, tid, ldm, stx); }
#pragma unroll
        for (int it_ = 0; it_ < NIT8; ++it_) { const int i8 = tid + it_ * NTH; if (L8 % NTH != 0 && i8 >= L8) break; const int t0 = i8 * 8;
            float z0[8], z1[8], g0[8], g1[8], r0[8], r1[8]; zval8(t0, z0, z1); conv8(1 + o, 0, t0, g0); conv8(1 + o, 1, t0, g1);
#pragma unroll
            for (int j = 0; j < 4; ++j) { const F4 y = *(const F4*)(X + hy_phys(t0) + 2 * j);
                r0[2 * j] = g0[2 * j] * (y.x * sc + z0[2 * j] * sk); r1[2 * j] = g1[2 * j] * (y.y * sc + z1[2 * j] * sk);
                r0[2 * j + 1] = g0[2 * j + 1] * (y.z * sc + z0[2 * j + 1] * sk); r1[2 * j + 1] = g1[2 * j + 1] * (y.w * sc + z1[2 * j + 1] * sk); }
            if (o == 0) { *(F4*)(ZT + t0) = (F4){r0[0], r0[1], r0[2], r0[3]}; *(F4*)(ZT + t0 + 4) = (F4){r0[4], r0[5], r0[6], r0[7]};
                *(F4*)(ZT + SEQ + t0) = (F4){r1[0], r1[1], r1[2], r1[3]}; *(F4*)(ZT + SEQ + t0 + 4) = (F4){r1[4], r1[5], r1[6], r1[7]}; }
            else { *(U4*)(YAT + ((long)0 * MW + ch) * KEYS + k0 + t0) = (U4){pack2(r0[0], r0[1]), pack2(r0[2], r0[3]), pack2(r0[4], r0[5]), pack2(r0[6], r0[7])};
                *(U4*)(YAT + ((long)1 * MW + ch) * KEYS + k0 + t0) = (U4){pack2(r1[0], r1[1]), pack2(r1[2], r1[3]), pack2(r1[4], r1[5]), pack2(r1[6], r1[7])}; } }
        __syncthreads();
    }
}

__device__ __forceinline__ void phase_gdn_prep(const Params& p, char* lds, int l) {
    const int bid = BID(), G = gridDim.x;
    for (int rep_ = 0; rep_ < REP_GP; ++rep_) for (int it = bid; it < NTASK_GDN / 2; it += G) gdn_chunk_prep2(p, lds, l, it * 2);
}
__device__ __forceinline__ void phase_mixers(const Params& p, char* lds, int l, int qoff = 0, bool scans_only = false) {
    const int tid = TID();
    const bool ctx_out = l < DEPTH - 1;
    constexpr int NSCAN = BATCH * GH * 2 * 2, NQT_L = SEQ / 256, U_DL = BATCH * DH * NQT_L * 2, U_HY = MW, U_NA = BATCH * NH * (R_ROWS / 4);
    constexpr int NQC = CTX / 128, U_DC = BATCH * DH * NQC, U_NC = BATCH * NH * NQC, U_HC = MW;
    constexpr int U_CV8 = (U_CVT + 7) / 8, U_W3 = (4 * HYW * 128 + 8191) / 8192, U_H2 = (KEYS + 63) / 64;
    const int e0 = NSCAN * REP_GS, e1 = e0 + U_DL * REP_DIFF, e2 = e1 + U_HY * REP_HY, e3 = e2 + U_NA * REP_NA, e4 = e3 + (ctx_out ? U_DC : 0), e5 = e4 + (ctx_out ? U_NC : 0), e6 = e5 + (ctx_out ? U_HC : 0), e7 = e6 + (ctx_out ? U_CV8 : 0), e8 = e7 + (ctx_out ? U_W3 : 0), e9 = e8 + (ctx_out ? U_H2 : 0);
    u32* qctr = WSP(u32, OFF_CNT) + 64 + qoff + l;
    int* qs = (int*)(lds + LDS_BYTES - 16);
    for (;;) {
        __syncthreads();
        if (tid == 0) qs[0] = (int)atomicAdd(qctr, 1u);
        __syncthreads();
        const int u = qs[0];
        if (u >= (scans_only ? e0 : e9)) break;
        if (u < e0) gdn_scan_item(p, lds, l, u % NSCAN);
        else if (u < e1) { int v = (u - e0) % U_DL; const int comp = v & 1; v >>= 1; int b = v / (DH * NQT_L), r = v - b * DH * NQT_L, h = r / NQT_L, qt = r - h * NQT_L; diff32_item(p, lds, l, b, h, qt * 256, comp); }
        else if (u < e2) hyena_item<false>(p, lds, l, (u - e1) % U_HY);
        else if (u < e3) { int v = (u - e2) % U_NA; int b = v / (NH * (R_ROWS / 4)), r = v - b * NH * (R_ROWS / 4), h = r / (R_ROWS / 4), rq = r - h * (R_ROWS / 4); na32_item(p, lds, l, b, h, rq); }
        else if (u < e4) { int v = u - e3; int b = v / (DH * NQC), r = v - b * DH * NQC, h = r / NQC, q = r - h * NQC; diff_attn_item<1>(p, lds, l, b, h, q * 128, true); }
        else if (u < e5) { int v = u - e4; int b = v / (NH * NQC), r = v - b * NH * NQC, h = r / NQC, q = r - h * NQC; na_ctx_item(p, lds, b, h, q * 128); }
        else if (u < e6) hyena_item<true>(p, lds, l, u - e5);
        else if (u < e7) { const int c0 = (u - e6) * 8; for (int q = c0; q < c0 + 8 && q < U_CVT; ++q) cvt_unit(p, lds, l + 1, q); }
        else if (u < e8) w3t_chunk(p, l + 1, (u - e7) * 8192, 8192);
        else h2f_positions(p, l + 1, (u - e8) * 64, 8);
    }
}

__device__ __forceinline__ void phase_finish(const Params& p, char* lds, int l) {
    const int tid = TID(), bid = BID(), G = gridDim.x, lane = tid & 63, wid = tid >> 6;
    bf16_t* Y = WSP(bf16_t, OFF_Y);
    { const bf16_t* OFp = WSP(bf16_t, OFF_OF); const bf16_t* OBp = WSP(bf16_t, OFF_OB); const bf16_t* GZ = WSP(bf16_t, OFF_GZ); const float nw = GIN(p.gdn_norm)[l * 64 + lane];
        const long NR = (long)NTOK * GH, st8 = (long)G * 8;
        for (long i = (long)bid * 8 + wid; i < NR; i += 2 * st8) { const long i2 = i + st8; const bool two = i2 < NR;
            const long tokA = i / GH, tokB = two ? i2 / GH : tokA; const int hA = (int)(i - tokA * GH), hB = two ? (int)(i2 - tokB * GH) : hA;
            const long oA = tokA * MW + hA * 64 + lane, oB = tokB * MW + hB * 64 + lane;
            const float vA = bf2f(OFp[oA]) + bf2f(OBp[oA]), vB = bf2f(OFp[oB]) + bf2f(OBp[oB]);
            const float zA = bf2f(GZ[oA]), zB = bf2f(GZ[oB]);
            float sA = vA * vA, sB = vB * vB;
            sA = xadd<32>(sA); sB = xadd<32>(sB); sA = xadd<16>(sA); sB = xadd<16>(sB); sA = xadd<8>(sA); sB = xadd<8>(sB); sA = xadd<4>(sA); sB = xadd<4>(sB); sA = xadd<2>(sA); sB = xadd<2>(sB); sA = xadd<1>(sA); sB = xadd<1>(sB);
            Y[tokA * 4 * MW + MW + hA * 64 + lane] = f2bf(vA * rsqrtf(sA * (1.0f / 64.0f) + RMS_EPS) * nw * siluf(zA));
            if (two) Y[tokB * 4 * MW + MW + hB * 64 + lane] = f2bf(vB * rsqrtf(sB * (1.0f / 64.0f) + RMS_EPS) * nw * siluf(zB)); } }
    { const bf16_t* YAT = WSP(bf16_t, OFF_YAT); bf16_t* t = (bf16_t*)lds;
        constexpr int KT_ = KEYS / 64, CT_ = MW / 128;
        float lam, lam_init; diff_lambda(p, l, lam, lam_init);
        const float* nw = GIN(p.diff_norm) + l * 128;
        for (int u = bid; u < BATCH * CT_ * KT_; u += G) { int b = u / (CT_ * KT_), r = u - b * CT_ * KT_, ct = r / KT_, kt = r - ct * KT_;
            __syncthreads();
#pragma unroll
            for (int q = 0; q < 2; ++q) { int c = (tid >> 3) + 64 * q, s = tid & 7; *(U4*)(t + c * 72 + s * 8) = *(const U4*)(YAT + ((long)b * MW + ct * 128 + c) * KEYS + kt * 64 + s * 8); }
            if (kt * 64 < SEQ) {
                const int k = tid >> 3, sub = tid & 7; const long tok = bk_tok(b, kt * 64 + k); bf16_t* yr = Y + tok * 4 * MW;
                const U4 a0 = *(const U4*)(yr + 2 * MW + ct * 128 + sub * 16), a1 = *(const U4*)(yr + 2 * MW + ct * 128 + sub * 16 + 8), b0 = *(const U4*)(yr + ct * 128 + sub * 16), b1 = *(const U4*)(yr + ct * 128 + sub * 16 + 8);
                const u32 aw[8] = {a0.x, a0.y, a0.z, a0.w, a1.x, a1.y, a1.z, a1.w}, bw[8] = {b0.x, b0.y, b0.z, b0.w, b1.x, b1.y, b1.z, b1.w};
                float v[16]; float ss = 0.f;
#pragma unroll
                for (int e = 0; e < 8; ++e) { v[2 * e] = bflo(aw[e]) - lam * bflo(bw[e]); v[2 * e + 1] = bfhi(aw[e]) - lam * bfhi(bw[e]); ss += v[2 * e] * v[2 * e] + v[2 * e + 1] * v[2 * e + 1]; }
                ss = xadd<1>(ss); ss = xadd<2>(ss); ss = xadd<4>(ss);
                const float rr = rsqrtf(ss * (1.0f / 128.0f) + RMS_EPS) * (1.0f - lam_init);
                u32 o[8];
#pragma unroll
                for (int e = 0; e < 8; ++e) o[e] = pack2(v[2 * e] * rr * nw[sub * 16 + 2 * e], v[2 * e + 1] * rr * nw[sub * 16 + 2 * e + 1]);
                *(U4*)(yr + 2 * MW + ct * 128 + sub * 16) = (U4){o[0], o[1], o[2], o[3]}; *(U4*)(yr + 2 * MW + ct * 128 + sub * 16 + 8) = (U4){o[4], o[5], o[6], o[7]};
            }
            __syncthreads();
            { int k = tid >> 3; long tok = bk_tok(b, kt * 64 + k);
#pragma unroll
                for (int q = 0; q < 2; ++q) { const int c8 = (tid & 7) * 8 + 64 * q;
                    U4 o; o.x = (u32)t[(c8 + 0) * 72 + k] | ((u32)t[(c8 + 1) * 72 + k] << 16); o.y = (u32)t[(c8 + 2) * 72 + k] | ((u32)t[(c8 + 3) * 72 + k] << 16);
                    o.z = (u32)t[(c8 + 4) * 72 + k] | ((u32)t[(c8 + 5) * 72 + k] << 16); o.w = (u32)t[(c8 + 6) * 72 + k] | ((u32)t[(c8 + 7) * 72 + k] << 16);
                    *(U4*)(Y + tok * 4 * MW + ct * 128 + c8) = o; } } } }
}
__device__ __forceinline__ bool xcd_unit(int bid, int G, int i, int ntm, int ntn, int& tm, int& tn) {
    if ((G & 7) == 0) { const int x = bid & 7, v = i * (G >> 3) + (bid >> 3); tm = (v / ntn) * 8 + x; tn = v - (v / ntn) * ntn; return tm < ntm; }
    const int u = bid + i * G; tn = u / ntm; tm = u - tn * ntm; return u < ntm * ntn;
}
struct Merge1Prov {
    static constexpr int MT = 3, BM1 = 64 * MT, ntm = NTOK / BM1, ntn = D / G_BN;
    const bf16_t *Y, *BP, *GATE; bf16_t* MIXG; int bid, G; U2 tot[MT][4];
    __device__ __forceinline__ void tile(int i, int& row0, int& col0, int& br) const { int tm, tn; xcd_unit(bid, G, i >> 2, ntm, ntn, tm, tn); br = i & 3; row0 = tm * BM1; col0 = tn * G_BN; }
    __device__ __forceinline__ bool valid(int i) const { int tm, tn; return xcd_unit(bid, G, i >> 2, ntm, ntn, tm, tn); }
    __device__ __forceinline__ const bf16_t* arow(int i, int r) const { int row0, col0, br; tile(i, row0, col0, br); return Y + (long)(row0 + r) * 4 * MW + br * MW; }
    __device__ __forceinline__ const bf16_t* bbase(int i) const { int row0, col0, br; tile(i, row0, col0, br); return BP + (long)col0 * 4 * MW + br * MW; }
    U2 gpre[MT][4];
    __device__ __forceinline__ void pre(int i) { int row0, col0, br; tile(i, row0, col0, br);
        const int tid = TID(), wid = tid >> 6, lane = tid & 63, wm = wid >> 1, wn = wid & 1, l15 = lane & 15, g = lane >> 4;
#pragma unroll
        for (int m = 0; m < MT; ++m)
#pragma unroll
            for (int n = 0; n < 4; ++n) gpre[m][n] = *(const U2*)(GATE + ((((long)((row0 / BM1) * ntn + col0 / G_BN) * 4 + br) * 8 + wid) * 12 + (m * 4 + n)) * 256 + lane * 4);
        (void)wm; (void)wn; (void)l15; (void)g; }
    __device__ __forceinline__ void epi(int i, const f32x4 (&acc)[MT][4]) { int row0, col0, br; tile(i, row0, col0, br);
        const int tid = TID(), wid = tid >> 6, lane = tid & 63, wm = wid >> 1, wn = wid & 1, l15 = lane & 15, g = lane >> 4;
#pragma unroll
        for (int m = 0; m < MT; ++m) { const long row = row0 + wm * 16 * MT + m * 16 + l15;
#pragma unroll
            for (int n = 0; n < 4; ++n) { const U2 gv = gpre[m][n];
                const U2 tp = tot[m][n];
                f32x4 t = br == 0 ? (f32x4){0.f, 0.f, 0.f, 0.f} : (f32x4){bflo(tp.x), bfhi(tp.x), bflo(tp.y), bfhi(tp.y)};
                t[0] += sigmoidf(bflo(gv.x)) * acc[m][n][0]; t[1] += sigmoidf(bfhi(gv.x)) * acc[m][n][1]; t[2] += sigmoidf(bflo(gv.y)) * acc[m][n][2]; t[3] += sigmoidf(bfhi(gv.y)) * acc[m][n][3];
                const U2 o = (U2){pack2(t[0], t[1]), pack2(t[2], t[3])};
                tot[m][n] = o;
                if (br == 3) *(U2*)(MIXG + row * D + col0 + wn * 64 + n * 16 + g * 4) = o; } } }
};
#ifdef PROBE_G1
struct Merge1Dry : Merge1Prov { bool fire; __device__ __forceinline__ void epi(int i, const f32x4 (&acc)[MT][4]) { if (fire) Merge1Prov::epi(i, acc); }
#ifdef PROBE_G1NP
    __device__ __forceinline__ void pre(int i) { if (fire) Merge1Prov::pre(i); }
#endif
};
#endif
__device__ __forceinline__ void phase_merge1(const Params& p, char* lds, int l) {
    Merge1Prov pv; pv.Y = WSP(bf16_t, OFF_Y); pv.BP = WSP(bf16_t, off_bp(l)); pv.GATE = WSP(bf16_t, OFF_SEG_GATE); pv.MIXG = WSP(bf16_t, OFF_MIXG);
    pv.bid = BID(); pv.G = (int)gridDim.x;
    gemm_stream<Merge1Prov::MT>(lds, pv, 4 * MW, MW);
#ifdef PROBE_G1
    { Merge1Dry pd; pd.Y = pv.Y; pd.BP = pv.BP; pd.GATE = pv.GATE; pd.MIXG = pv.MIXG; pd.bid = pv.bid; pd.G = pv.G; pd.fire = p.stop_phase == 123456;
      for (int r_ = 0; r_ < 2; ++r_) gemm_stream<Merge1Prov::MT, Merge1Dry, PROBE_G1>(lds, pd, 4 * MW, MW); }
#endif
}
struct Merge2Prov {
    static constexpr int MT = 3, BM1 = 64 * MT, ntm = NTOK / BM1, ntn = D / G_BN;
    const bf16_t *MIXG, *WO; bf16_t* MIX; int bid, G;
    __device__ __forceinline__ void pre(int) const {}
    __device__ __forceinline__ void tile(int i, int& row0, int& col0) const { int tm, tn; xcd_unit(bid, G, i, ntm, ntn, tm, tn); row0 = tm * BM1; col0 = tn * G_BN; }
    __device__ __forceinline__ bool valid(int i) const { int tm, tn; return xcd_unit(bid, G, i, ntm, ntn, tm, tn); }
    __device__ __forceinline__ const bf16_t* arow(int i, int r) const { int row0, col0; tile(i, row0, col0); return MIXG + (long)(row0 + r) * D; }
    __device__ __forceinline__ const bf16_t* bbase(int i) const { int row0, col0; tile(i, row0, col0); return WO + (long)col0 * D; }
    __device__ __forceinline__ void epi(int i, const f32x4 (&acc)[MT][4]) const { int row0, col0; tile(i, row0, col0);
        const int tid = TID(), wid = tid >> 6, lane = tid & 63, wm = wid >> 1, wn = wid & 1, l15 = lane & 15, g = lane >> 4;
#pragma unroll
        for (int m = 0; m < MT; ++m) { const long row = row0 + wm * 16 * MT + m * 16 + l15;
#pragma unroll
            for (int n = 0; n < 4; ++n) st4bf(MIX + row * D + col0 + wn * 64 + n * 16 + g * 4, acc[m][n]); } }
};
#ifdef PROBE_G2
struct Merge2Dry : Merge2Prov { bool fire; __device__ __forceinline__ void epi(int i, const f32x4 (&acc)[MT][4]) const { if (fire) Merge2Prov::epi(i, acc); } };
#endif
__device__ __forceinline__ void phase_merge2(const Params& p, char* lds, int l) {
    Merge2Prov pv; pv.MIXG = WSP(bf16_t, OFF_MIXG); pv.WO = WSP(bf16_t, off_wo(l)); pv.MIX = WSP(bf16_t, OFF_MIX);
    pv.bid = BID(); pv.G = (int)gridDim.x;
    gemm_stream<Merge2Prov::MT>(lds, pv, D, D);
#ifdef PROBE_G2
    { Merge2Dry pd; pd.MIXG = pv.MIXG; pd.WO = pv.WO; pd.MIX = pv.MIX; pd.bid = pv.bid; pd.G = pv.G; pd.fire = p.stop_phase == 123456;
#ifdef PROBE_G2H
      for (int r_ = 0; r_ < 8; ++r_) gemm_stream<Merge2Prov::MT, Merge2Dry, PROBE_G2>(lds, pd, D, D / 2); }
#else
      for (int r_ = 0; r_ < 4; ++r_) gemm_stream<Merge2Prov::MT, Merge2Dry, PROBE_G2>(lds, pd, D, D); }
#endif
#endif
}
struct MoeMap { int cnt[NE], off[NE], tile0[NE + 1]; };
__device__ __forceinline__ void moe_map_load(const Params& p, int* sm  ) {
    const int tid = TID();
    __syncthreads();
    if (tid == 0) { const u32* CNT = WSP(u32, OFF_CNT); int o = 0, t = 0;
        for (int e = 0; e < NE; ++e) { int c = (int)CNT[e]; sm[e] = c; sm[NE + e] = o; sm[2 * NE + e] = t; o += c; t += (c + G_BM - 1) / G_BM; }
        sm[3 * NE] = t; }
    __syncthreads();
}
struct MoeProvBase {
    const int* sm; int bid, G, ntile, ntn;
    __device__ __forceinline__ void pre(int) const {}
    __device__ __forceinline__ bool valid(int i) const { int tg, tn; return xcd_unit(bid, G, i, ntile, ntn, tg, tn); }
    __device__ __forceinline__ void unit(int i, int& e, int& tn, int& r0, int& nrow, long& orow0) const { int tg; xcd_unit(bid, G, i, ntile, ntn, tg, tn);
        e = 0;
#pragma unroll
        for (int q = 1; q < NE; ++q) if (tg >= sm[2 * NE + q]) e = q;
        const int mt = tg - sm[2 * NE + e], cnt = sm[e]; r0 = mt * G_BM; nrow = cnt - r0 < G_BM ? cnt - r0 : G_BM; orow0 = (long)sm[NE + e] + r0; }
};
struct Moe1Prov : MoeProvBase {
    const bf16_t *H, *W13; bf16_t* HMID; const int* ELIST;
    __device__ __forceinline__ const bf16_t* arow(int i, int r) const { int e, tn, r0, nrow; long orow0; unit(i, e, tn, r0, nrow, orow0); const int rr = r < nrow ? r0 + r : r0; return H + (long)ELIST[(long)e * NTOK + rr] * D; }
    __device__ __forceinline__ const bf16_t* bbase(int i) const { int e, tn, r0, nrow; long orow0; unit(i, e, tn, r0, nrow, orow0); return W13 + ((long)e * 2 * EFF + tn * G_BN) * D; }
    __device__ __forceinline__ void epi(int i, const f32x4 (&acc)[4][4]) const { int e, tn, r0, nrow; long orow0; unit(i, e, tn, r0, nrow, orow0);
        const int tid = TID(), wid = tid >> 6, lane = tid & 63, wm = wid >> 1, wn = wid & 1, l15 = lane & 15, g = lane >> 4;
#pragma unroll
        for (int m = 0; m < 4; ++m) { const int r = wm * 64 + m * 16 + l15;
            if (r < nrow) {
#pragma unroll
                for (int n2 = 0; n2 < 2; ++n2) { f32x4 a = acc[m][2 * n2], b = acc[m][2 * n2 + 1], hmid;
#pragma unroll
                    for (int j = 0; j < 4; ++j) hmid[j] = siluf(a[j]) * b[j];
                    st4bf(HMID + (orow0 + r) * EFF + tn * (G_BN / 2) + wn * 32 + n2 * 16 + g * 4, hmid); } } } }
};
struct Moe2Prov : MoeProvBase {
    const bf16_t *HMID, *W2; bf16_t* YE;
    __device__ __forceinline__ const bf16_t* arow(int i, int r) const { int e, tn, r0, nrow; long orow0; unit(i, e, tn, r0, nrow, orow0); return HMID + (orow0 + r) * EFF; }
    __device__ __forceinline__ const bf16_t* bbase(int i) const { int e, tn, r0, nrow; long orow0; unit(i, e, tn, r0, nrow, orow0); return W2 + ((long)e * D + tn * G_BN) * EFF; }
    __device__ __forceinline__ void epi(int i, const f32x4 (&acc)[4][4]) const { int e, tn, r0, nrow; long orow0; unit(i, e, tn, r0, nrow, orow0);
        const int tid = TID(), wid = tid >> 6, lane = tid & 63, wm = wid >> 1, wn = wid & 1, l15 = lane & 15, g = lane >> 4;
#pragma unroll
        for (int m = 0; m < 4; ++m) { const int r = wm * 64 + m * 16 + l15;
            if (r < nrow) {
#pragma unroll
                for (int n = 0; n < 4; ++n) st4bf(YE + (orow0 + r) * D + tn * G_BN + wn * 64 + n * 16 + g * 4, acc[m][n]); } } }
};
#ifdef PROBE_M1
struct Moe1Dry : Moe1Prov { bool fire; __device__ __forceinline__ void epi(int i, const f32x4 (&acc)[4][4]) const { if (fire) Moe1Prov::epi(i, acc); } };
#endif
__device__ __forceinline__ void phase_moe1(const Params& p, char* lds, int l) {
    int* sm = (int*)(lds + G_LDS);
    moe_map_load(p, sm);
    Moe1Prov pv; pv.sm = sm; pv.bid = BID(); pv.G = (int)gridDim.x; pv.ntile = sm[3 * NE]; pv.ntn = 2 * EFF / G_BN;
    pv.H = WSP(bf16_t, OFF_H); pv.W13 = WSP(bf16_t, OFF_W13); pv.HMID = WSP(bf16_t, OFF_HMID); pv.ELIST = WSP(int, OFF_ELIST);
    gemm_stream<4>(lds, pv, D, D);
#ifdef PROBE_M1
    { Moe1Dry pd; pd.sm = pv.sm; pd.bid = pv.bid; pd.G = pv.G; pd.ntile = pv.ntile; pd.ntn = pv.ntn; pd.H = pv.H; pd.W13 = pv.W13; pd.HMID = pv.HMID; pd.ELIST = pv.ELIST; pd.fire = p.stop_phase == 123456;
      for (int r_ = 0; r_ < 2; ++r_) gemm_stream<4, Moe1Dry, PROBE_M1>(lds, pd, D, D); }
#endif
}
#ifdef PROBE_M2
struct Moe2Dry : Moe2Prov { bool fire; __device__ __forceinline__ void epi(int i, const f32x4 (&acc)[4][4]) const { if (fire) Moe2Prov::epi(i, acc); } };
#endif
__device__ __forceinline__ void phase_moe2(const Params& p, char* lds, int l) {
    int* sm = (int*)(lds + G_LDS);
    moe_map_load(p, sm);
    Moe2Prov pv; pv.sm = sm; pv.bid = BID(); pv.G = (int)gridDim.x; pv.ntile = sm[3 * NE]; pv.ntn = D / G_BN;
    pv.HMID = WSP(bf16_t, OFF_HMID); pv.W2 = WSP(bf16_t, OFF_W2); pv.YE = WSP(bf16_t, OFF_YE);
    gemm_stream<4>(lds, pv, EFF, EFF);
#ifdef PROBE_M2
    { Moe2Dry pd; pd.sm = pv.sm; pd.bid = pv.bid; pd.G = pv.G; pd.ntile = pv.ntile; pd.ntn = pv.ntn; pd.HMID = pv.HMID; pd.W2 = pv.W2; pd.YE = pv.YE; pd.fire = p.stop_phase == 123456;
      for (int r_ = 0; r_ < 2; ++r_) gemm_stream<4, Moe2Dry, PROBE_M2>(lds, pd, EFF, EFF); }
#endif
}
#ifdef PROBE_BAR
#define PHASE_END(id) do { GSYNC(); GSYNC(); if (p.stop_phase == (id)) return; } while (0)
#else
#define PHASE_END(id) do { GSYNC(); if (p.stop_phase == (id)) return; } while (0)
#endif

#if defined(CPU_EMU) || !defined(KARG_LAUNDER)
#define PP p_in
#else
__device__ __forceinline__ const Params& launder_params(const Params* q) { asm volatile("" : "+s"(q)); return *q; }
#define PP launder_params(kargs)
#endif
__global__ void __launch_bounds__(NTH, 2) fwd_kernel(Params p_in) {
#ifdef CPU_EMU
    char* lds = emu_lds();
    const Params& p = p_in;
#else
#ifdef KARG_LAUNDER
    const Params* kargs = (const Params*)__builtin_amdgcn_kernarg_segment_ptr();
    const Params& p = *kargs;
#else
    const Params& p = p_in;
#endif
    extern __shared__ __attribute__((aligned(16))) char lds_raw[];
    char* lds = lds_raw + 16;
    if (threadIdx.x == 0) *(uint4*)lds_raw = make_uint4(0u, 0u, 0u, 0u);
    __syncthreads();
    XcdBarrier xbar = xcd_barrier_post((unsigned*)(p.ws + OFF_BAR), (volatile LAS unsigned*)lds_raw);
#endif
#ifdef CPU_EMU
    if (threadIdx.x < 32) ((const float**)(lds + LDS_TBL_OFF))[threadIdx.x] = ((const float* const*)&p_in)[threadIdx.x];
#else
    if (threadIdx.x < 32) ((const float**)(lds + LDS_TBL_OFF))[threadIdx.x] = *(const float* const*)((const char*)__builtin_amdgcn_kernarg_segment_ptr() + threadIdx.x * 8);
#endif
    __syncthreads();
    phase_prologue(PP, lds);
    PHASE_END(1);
    for (int l = 0; l < DEPTH; ++l) {
        const int pb = 100 * (l + 1);
        if (l == 0) { phase_weights(PP, lds, l); PHASE_END(pb + 0); }
        if (l == 0) { phase_modulate0(PP, l); PHASE_END(pb + 1); }
        for (int rep_ = 0; rep_ < REP_IP; ++rep_) phase_inproj(PP, lds, l, 0);
        PHASE_END(pb + 2);
        phase_prep(PP, lds, l);
#ifdef PROBE_PREP
        phase_prep(PP, lds, l, false, PROBE_PREP & 1, PROBE_PREP & 2);
#endif
        PHASE_END(pb + 3);
        phase_gdn_prep(PP, lds, l);
        PHASE_END(pb + 4);
        phase_mixers(PP, lds, l);
#ifdef PROBE_P5
        GSYNC();
        phase_mixers(PP, lds, l, 16, PROBE_P5 == 2);
#endif
        PHASE_END(pb + 5);
        for (int rep_ = 0; rep_ < REP_FIN; ++rep_) phase_finish(PP, lds, l);
        PHASE_END(pb + 6);
        for (int rep_ = 0; rep_ < REP_IP; ++rep_) phase_inproj(PP, lds, l, 1);
        PHASE_END(pb + 7);
        for (int rep_ = 0; rep_ < REP_MG; ++rep_) phase_merge1(PP, lds, l);
        PHASE_END(pb + 8);
        for (int rep_ = 0; rep_ < REP_MG; ++rep_) phase_merge2(PP, lds, l);
        PHASE_END(pb + 9);
#ifdef PROBE_PM
        phase_post_mix(PP, lds, l, true);
#endif
        phase_post_mix(PP, lds, l);
        PHASE_END(pb + 10);
        for (int rep_ = 0; rep_ < REP_MOE; ++rep_) phase_moe1(PP, lds, l);
        PHASE_END(pb + 11);
        for (int rep_ = 0; rep_ < REP_MOE; ++rep_) phase_moe2(PP, lds, l);
        PHASE_END(pb + 12);
#ifdef PROBE_PE
        phase_post_moe(PP, l, true);
#endif
        phase_post_moe(PP, l);
        PHASE_END(pb + 13);
    }
}

extern "C" void kernel_launch(void* const* d_in, const int* in_sizes, int n_in, void* d_out, int out_size, void* d_ws, size_t ws_size, hipStream_t stream) {
    (void)in_sizes; (void)n_in; (void)out_size;
    if (ws_size < WS_NEED) return;
    Params p;
    memset(&p, 0, sizeof(p));
    const float** pp = (const float**)&p;
    for (int i = 0; i < 32; ++i) pp[i] = (const float*)d_in[i];
    p.out = (float*)d_out; p.ws = (char*)d_ws; p.stop_phase = -1;
#ifdef CPU_EMU
    { const char* sp = getenv("EMU_STOP"); if (sp) p.stop_phase = atoi(sp); }
    memset(d_ws, 0, SZ_BAR);
    int grid = 4; { const char* g = getenv("EMU_GRID"); if (g) grid = atoi(g); }
    emu_launch([](void* a) { fwd_kernel(*(Params*)a); }, &p, grid, NTH, LDS_BYTES);
#else
    static int grid = 0;
    if (!grid) {
        int dev = 0, cus = 0, per_cu = 0;
        (void)hipGetDevice(&dev);
        (void)hipDeviceGetAttribute(&cus, hipDeviceAttributeMultiprocessorCount, dev);
        (void)hipFuncSetAttribute((const void*)fwd_kernel, hipFuncAttributeMaxDynamicSharedMemorySize, LDS_BYTES + 16);
        (void)hipOccupancyMaxActiveBlocksPerMultiprocessor(&per_cu, (const void*)fwd_kernel, NTH, LDS_BYTES + 16);
        grid = per_cu >= 1 ? cus : 0;
        if (grid > GRID_MAX) grid = GRID_MAX;
    }
    if (!grid) return;
    (void)hipMemsetAsync(d_ws, 0, SZ_BAR, stream);
    hipLaunchKernelGGL(fwd_kernel, dim3(grid), dim3(NTH), LDS_BYTES + 16, stream, p);
#endif
}
```

```cpp
#ifdef CPU_EMU
#define SCHED_FENCE()
#define WAIT_LGKM()
#define WAIT_VM0()
#else
#include <hip/hip_runtime.h>
typedef short bf16x8 __attribute__((ext_vector_type(8)));
typedef float f32x4 __attribute__((ext_vector_type(4)));
#define SCHED_FENCE() __builtin_amdgcn_sched_barrier(0)
#define WAIT_LGKM() asm volatile("s_waitcnt lgkmcnt(0)" ::: "memory")
#define WAIT_VM0() asm volatile("s_waitcnt vmcnt(0)" ::: "memory")
#endif
#include <cstdint>
#include <cstddef>
#include <cstring>
#include <cstdlib>

#ifndef REP_DIFF
#define REP_DIFF 1
#endif
#ifndef REP_HY
#define REP_HY 1
#endif
#ifndef REP_NA
#define REP_NA 1
#endif
#ifndef REP_GP
#define REP_GP 1
#endif
#ifndef REP_GS
#define REP_GS 1
#endif
#ifndef REP_IP
#define REP_IP 1
#endif
#ifndef REP_W
#define REP_W 1
#endif
#ifndef REP_MG
#define REP_MG 1
#endif
#ifndef REP_MOE
#define REP_MOE 1
#endif
#ifndef REP_FIN
#define REP_FIN 1
#endif
typedef unsigned short bf16_t;
typedef unsigned int u32;
constexpr int LDS_BYTES = 160 * 1024 - 64;
typedef u32 U2 __attribute__((ext_vector_type(2)));
typedef u32 U4 __attribute__((ext_vector_type(4)));
typedef float F4 __attribute__((ext_vector_type(4)));
typedef float F2 __attribute__((ext_vector_type(2)));

#ifdef SMALL_DIMS
constexpr int D = 256, BATCH = 2, SEQ = 1024, DEPTH = 2, CTX = 128, GRID_MAX = 8;
#else
constexpr int D = 1024, BATCH = 2, SEQ = 8192, DEPTH = 4, CTX = 256, GRID_MAX = 256;
#endif
constexpr int NTH = 512;
constexpr int GW = 64, HD = 64;
constexpr int MW = D / 2;
constexpr int HYW = MW, HY_HID = 64, HY_BANDS = 16, HY_EMB = 33;
constexpr int GH = MW / 64, DH = MW / 128, NH = MW / 64;
constexpr int NE = 16, EFF = D / 2;
constexpr int NLAT = BATCH * SEQ, NCTX = BATCH * CTX, NTOK = NLAT + NCTX;
constexpr int KEYS = SEQ + CTX;
constexpr int IN_TOTAL = 13 * MW + 4 * GH + 4 * D;
constexpr int SRC_HY = 0, SRC_GQKV = 3 * MW, SRC_GZ = 6 * MW, SRC_GA = 7 * MW, SRC_DQKV = 7 * MW + 4 * GH, SRC_NQKV = 10 * MW + 4 * GH, SRC_GATE = 13 * MW + 4 * GH;
constexpr int GAB_W = ((13 * MW + 128) % 256 == 0) ? 128 : 256;
constexpr int MY_HY = 0, MY_GQKV = 3 * MW, MY_GZ = 6 * MW, MY_DQKV = 7 * MW, MY_NQKV = 10 * MW, MY_GAB = 13 * MW, MY_GATE = 13 * MW + GAB_W, NPROJ1 = 13 * MW + GAB_W, NPROJ = NPROJ1 + 4 * D;
constexpr float LN_EPS = 1e-5f, RMS_EPS = 1e-6f;
constexpr int NSLOT = 2 * NTOK;
constexpr int R_ROWS = SEQ / GW;
constexpr int NCH_LAT = SEQ / 64, NCH_CTX = CTX / 64, NCH = NCH_LAT + NCH_CTX;
constexpr int NTASK_GDN = BATCH * GH * 2 * NCH;
static_assert(KEYS % 192 == 0 && NTOK % 192 == 0 && NTOK % 256 == 0 && MW % 128 == 0 && SEQ % 256 == 0 && CTX % 64 == 0, "dims");

constexpr size_t al256(size_t x) { return (x + 255) & ~(size_t)255; }
constexpr size_t SZ_BAR = 16384;
constexpr size_t OFF_BAR = 0;
constexpr size_t OFF_CNT = OFF_BAR + SZ_BAR;
constexpr size_t OFF_MODP = OFF_CNT + 4096;
constexpr size_t OFF_MOD = OFF_MODP + al256((size_t)DEPTH * 8 * 3 * 6 * D * 4);
constexpr size_t OFF_XS = OFF_MOD + al256((size_t)DEPTH * 3 * 6 * D * 4);
constexpr size_t OFF_H = OFF_XS + (size_t)NTOK * D * 4;
constexpr size_t OFF_GZ = OFF_H + (size_t)NTOK * D * 2;
constexpr size_t OFF_GAB = OFF_GZ + (size_t)NTOK * MW * 2;
constexpr size_t OFF_GB = OFF_GAB + (size_t)NTOK * 32 * 4;
constexpr size_t OFF_Y = OFF_GB + (size_t)NTOK * 4 * GH * 4;
constexpr size_t OFF_WIN = OFF_Y + (size_t)NTOK * 4 * MW * 2;
constexpr size_t OFF_BP = OFF_WIN + (size_t)NPROJ * D * 2;
constexpr size_t OFF_WO = OFF_BP + (size_t)D * 4 * MW * 2;
constexpr size_t OFF_H2F = OFF_WO + (size_t)D * D * 2;
constexpr size_t OFF_H2B = OFF_H2F + al256((size_t)KEYS * 64 * 4);
constexpr size_t OFF_W3T = OFF_H2B + (size_t)KEYS * 128 * 2;
constexpr size_t OFF_RWT = OFF_W3T + (size_t)4 * HYW * 128 * 2;
constexpr size_t OFF_TOKE = OFF_RWT + (size_t)16 * D * 4;
constexpr size_t OFF_TOKR = OFF_TOKE + (size_t)NTOK * 2 * 4;
constexpr size_t OFF_TOKW = OFF_TOKR + (size_t)NTOK * 2 * 4;
constexpr size_t OFF_ELIST = OFF_TOKW + (size_t)NTOK * 2 * 4;
constexpr size_t OFF_RC = OFF_ELIST + (size_t)NE * NTOK * 4;
constexpr size_t OFF_DVT = OFF_RC;
constexpr size_t OFF_NVT = OFF_DVT + (size_t)BATCH * MW * KEYS * 2;
constexpr size_t OFF_GQ = OFF_NVT + (size_t)BATCH * MW * KEYS * 2;
constexpr size_t OFF_GK = OFF_GQ + (size_t)NTOK * MW * 2;
constexpr size_t OFF_GV = OFF_GK + (size_t)NTOK * MW * 2;
constexpr size_t OFF_RA = OFF_GV + (size_t)NTOK * MW * 2;
constexpr size_t SZ_SEG3 = (size_t)NTOK * 3 * MW * 2;
constexpr size_t OFF_SEG_HY = OFF_RA;
constexpr size_t OFF_SEG_GQKV = OFF_RA + SZ_SEG3;
constexpr size_t OFF_SEG_DQKV = OFF_RA + 2 * SZ_SEG3;
constexpr size_t OFF_SEG_NQKV = OFF_RA + 3 * SZ_SEG3;
constexpr size_t SZ_RA_W = (size_t)NTOK * 4 * D * 2 + (size_t)NE * 3 * EFF * D * 2;
constexpr size_t SZ_RA = 4 * SZ_SEG3 > SZ_RA_W ? 4 * SZ_SEG3 : SZ_RA_W;
constexpr size_t OFF_OF = OFF_RA;
constexpr size_t OFF_OB = OFF_OF + (size_t)NTOK * MW * 2;
constexpr size_t OFF_YAT = OFF_OB + (size_t)NTOK * MW * 2;
constexpr size_t OFF_HF = OFF_YAT + (size_t)BATCH * MW * KEYS * 2;
constexpr size_t HY_XN = 2 * SEQ + ((2 * SEQ) >> 6) * 4;
constexpr size_t OFF_SEG_GATE = OFF_RA;
constexpr size_t OFF_W13 = OFF_RA + (size_t)NTOK * 4 * D * 2;
constexpr size_t OFF_W2 = OFF_W13 + (size_t)NE * 2 * EFF * D * 2;
static_assert(OFF_HF + (size_t)GRID_MAX * HY_XN * 8 <= OFF_SEG_DQKV, "R1 overflow");
static_assert((size_t)NTOK * 4 * D * 2 <= SZ_RA, "gate overflow");
static_assert(OFF_W2 + (size_t)NE * D * EFF * 2 <= OFF_RA + SZ_RA, "expert weights overflow");
constexpr size_t OFF_RB = OFF_RA + SZ_RA;
constexpr size_t OFF_HYT = OFF_RB;
constexpr size_t OFF_WU = OFF_HYT + (size_t)BATCH * 3 * MW * KEYS * 2;
constexpr size_t OFF_TAPS = OFF_WU + (size_t)NTASK_GDN * 2 * 64 * 64 * 2;
constexpr size_t OFF_ZT = OFF_TAPS + (size_t)4 * HYW * KEYS * 2;
static_assert((size_t)GRID_MAX * 2 * SEQ * 4 <= (size_t)4 * HYW * KEYS * 2, "ZT overflow");
constexpr size_t OFF_MIXG = OFF_RB;
constexpr size_t OFF_MIX = OFF_MIXG + (size_t)NTOK * D * 2;
constexpr size_t OFF_HMID = OFF_MIX + (size_t)NTOK * D * 4;
constexpr size_t OFF_YE = OFF_HMID + (size_t)(NSLOT + 256) * EFF * 2;
constexpr size_t SZ_RB_LATE = OFF_YE + (size_t)(NSLOT + 256) * D * 2 - OFF_RB;
constexpr size_t SZ_RB_EARLY = OFF_TAPS + (size_t)4 * HYW * KEYS * 4 - OFF_RB;
constexpr size_t SZ_RB = SZ_RB_LATE > SZ_RB_EARLY ? SZ_RB_LATE : SZ_RB_EARLY;
constexpr size_t SZ_WSET = (size_t)NPROJ * D * 2 + (size_t)D * 4 * MW * 2 + (size_t)D * D * 2;
constexpr size_t OFF_WSET2 = OFF_RB + SZ_RB;
constexpr size_t WS_NEED = OFF_WSET2 + SZ_WSET;
__host__ __device__ constexpr size_t off_win(int l) { return (l & 1) ? OFF_WSET2 : OFF_WIN; }
__host__ __device__ constexpr size_t off_bp(int l) { return (l & 1) ? OFF_WSET2 + (size_t)NPROJ * D * 2 : OFF_BP; }
__host__ __device__ constexpr size_t off_wo(int l) { return (l & 1) ? OFF_WSET2 + (size_t)NPROJ * D * 2 + (size_t)D * 4 * MW * 2 : OFF_WO; }

struct Params {
    const float *x, *c, *ctx, *c_ctx, *w_mod, *b_mod, *w_in, *hy_conv, *hy_w1, *hy_b1, *hy_w2, *hy_b2, *hy_w3, *hy_freq, *hy_deltas, *hy_skip,
        *gdn_conv, *gdn_a_log, *gdn_dt_bias, *gdn_norm, *diff_lam, *diff_norm, *na_rpb, *branch_proj, *w_out, *ln_g, *ln_b, *router_w, *router_b,
        *exp_w1, *exp_w3, *exp_w2;
    float* out; char* ws; long long stop_phase;
};

#ifdef CPU_EMU
#define GPTR(T, ptr) ((T*)(ptr))
#else
#define GPTR(T, ptr) ((T*)(__attribute__((address_space(1))) T*)(ptr))
#endif
constexpr int LDS_TBL_OFF = LDS_BYTES - 16 - 256;
#ifdef CPU_EMU
__device__ __forceinline__ const float* gin_tbl(int idx) { return ((const float* const*)(emu_lds() + LDS_TBL_OFF))[idx]; }
#else
__device__ __forceinline__ const float* gin_tbl(int idx) { extern __shared__ __attribute__((aligned(16))) char lds_raw[]; return GPTR(const float, ((const float* const*)(lds_raw + 16 + LDS_TBL_OFF))[idx]); }
#endif
#define GIN(expr) gin_tbl((int)(((const char*)&(expr)) - ((const char*)&p)) >> 3)
#ifdef CPU_EMU
#define TID() ((int)threadIdx.x)
#define BID() ((int)blockIdx.x)
#else
__device__ __forceinline__ int TID() { int t = threadIdx.x; asm volatile("" : "+v"(t)); return t; }
__device__ __forceinline__ int BID() { int t = blockIdx.x; asm volatile("" : "+s"(t)); return t; }
#endif
__device__ __forceinline__ u32 f2u(float f) { union { float f; u32 u; } c; c.f = f; return c.u; }
__device__ __forceinline__ float u2f(u32 u) { union { float f; u32 u; } c; c.u = u; return c.f; }
#ifdef CPU_EMU
__device__ __forceinline__ bf16_t f2bf(float f) { u32 u = f2u(f); u += 0x7fffu + ((u >> 16) & 1u); return (bf16_t)(u >> 16); }
#else
typedef __bf16 hw_bf16x2 __attribute__((ext_vector_type(2)));
__device__ __forceinline__ bf16_t f2bf(float f) { const hw_bf16x2 r = __builtin_convertvector((F2){f, 0.f}, hw_bf16x2); u32 u; __builtin_memcpy(&u, &r, 4); return (bf16_t)(u & 0xffffu); }
#endif
__device__ __forceinline__ float bf2f(bf16_t h) { return u2f(((u32)h) << 16); }
#ifdef CPU_EMU
__device__ __forceinline__ u32 pack2(float lo, float hi) { return (u32)f2bf(lo) | ((u32)f2bf(hi) << 16); }
__device__ __forceinline__ float fexp2(float x) { return exp2f(x); }
#else
__device__ __forceinline__ u32 pack2(float lo, float hi) { const hw_bf16x2 r = __builtin_convertvector((F2){lo, hi}, hw_bf16x2); u32 u; __builtin_memcpy(&u, &r, 4); return u; }
__device__ __forceinline__ float fexp2(float x) { return __builtin_amdgcn_exp2f(x); }
#endif
__device__ __forceinline__ float bflo(u32 w) { return u2f(w << 16); }
__device__ __forceinline__ float bfhi(u32 w) { return u2f(w & 0xffff0000u); }
#ifdef CPU_EMU
__device__ __forceinline__ float sigmoidf(float x) { return 1.0f / (1.0f + expf(-x)); }
#else
__device__ __forceinline__ float sigmoidf(float x) { return __builtin_amdgcn_rcpf(1.0f + __builtin_amdgcn_exp2f(x * -1.4426950408889634f)); }
#endif
__device__ __forceinline__ float siluf(float x) { return x * sigmoidf(x); }
#ifdef CPU_EMU
template <int O> __device__ __forceinline__ float xadd(float v) { return v + __shfl_xor(v, O); }
template <int O> __device__ __forceinline__ float xmax(float v) { return fmaxf(v, __shfl_xor(v, O)); }
#else
template <int O> __device__ __forceinline__ float xadd(float v) {
    if constexpr (O == 32) { const auto r = __builtin_amdgcn_permlane32_swap(__float_as_uint(v), __float_as_uint(v), false, false); return __uint_as_float(r[0]) + __uint_as_float(r[1]); }
    else return v + __int_as_float(__builtin_amdgcn_ds_swizzle(__float_as_int(v), (O << 10) | 0x1f)); }
template <int O> __device__ __forceinline__ float xmax(float v) {
    if constexpr (O == 32) { const auto r = __builtin_amdgcn_permlane32_swap(__float_as_uint(v), __float_as_uint(v), false, false); return fmaxf(__uint_as_float(r[0]), __uint_as_float(r[1])); }
    else return fmaxf(v, __int_as_float(__builtin_amdgcn_ds_swizzle(__float_as_int(v), (O << 10) | 0x1f))); }
#endif
__device__ __forceinline__ float wave_sum(float v) { v = xadd<32>(v); v = xadd<16>(v); v = xadd<8>(v); v = xadd<4>(v); v = xadd<2>(v); v = xadd<1>(v); return v; }
__device__ __forceinline__ float wave_max(float v) { v = xmax<32>(v); v = xmax<16>(v); v = xmax<8>(v); v = xmax<4>(v); v = xmax<2>(v); v = xmax<1>(v); return v; }
__device__ __forceinline__ bf16x8 ld8(const bf16_t* p) { return *(const bf16x8*)p; }
__device__ __forceinline__ bf16x8 mk8(U2 a, U2 b) { union { struct { U2 a, b; } s; bf16x8 v; } c; c.s.a = a; c.s.b = b; return c.v; }
__device__ __forceinline__ bf16x8 mk8u(u32 a, u32 b, u32 c0, u32 d) { union { u32 u[4]; bf16x8 v; } c; c.u[0] = a; c.u[1] = b; c.u[2] = c0; c.u[3] = d; return c.v; }
#define MFMA16(a, b, c) __builtin_amdgcn_mfma_f32_16x16x32_bf16(a, b, c, 0, 0, 0)
__device__ __forceinline__ int mod_row(int tok) { return tok < NLAT ? tok / SEQ : 2; }
__device__ __forceinline__ void tok_bk(int tok, int& b, int& key) { if (tok < NLAT) { b = tok / SEQ; key = tok - b * SEQ; } else { int t = tok - NLAT; b = t / CTX; key = SEQ + t - b * CTX; } }
__device__ __forceinline__ int bk_tok(int b, int key) { return key < SEQ ? b * SEQ + key : NLAT + b * CTX + (key - SEQ); }
#ifdef CPU_EMU
struct XcdBarrier { int dummy; };
#define GSYNC() emu_grid_sync()
#else
#define XB_TMO      128
#define XB_XCNT(j)  (256  + 64 * (j))
#define XB_XSUB(j)  (1280 + 64 * (j))
#define XB_XGEN(j)  (2304 + 64 * (j))
#define XB_TOP      3328
#define XB_TOPGEN   3392
#define XCD_BAR_WORDS 3456
#define XB_SPIN_CAP (1u << 22)
#define LAS __attribute__((address_space(3)))
__device__ __forceinline__ unsigned xb_ld(unsigned* p)              { return __hip_atomic_load(p, __ATOMIC_RELAXED, __HIP_MEMORY_SCOPE_AGENT); }
__device__ __forceinline__ unsigned xb_add(unsigned* p, unsigned v) { return __hip_atomic_fetch_add(p, v, __ATOMIC_RELAXED, __HIP_MEMORY_SCOPE_AGENT); }
__device__ __forceinline__ unsigned xb_xcc_id() { return (unsigned)__builtin_amdgcn_s_getreg((3 << 11) | 20) & 0xFu; }
#define XB_SPIN(cond, bar) do { unsigned _sp = 0; while (cond) { __builtin_amdgcn_s_sleep(1); \
    if ((++_sp & 255u) == 0u) { if (xb_ld(&(bar)[XB_TMO])) break; if (_sp > XB_SPIN_CAP) { atomicAdd(&(bar)[XB_TMO], 1u); break; } } } } while (0)
struct XcdBarrier { unsigned* bar; unsigned x; volatile LAS unsigned* st; };
__device__ __forceinline__ XcdBarrier xcd_barrier_post(unsigned* bar, volatile LAS unsigned* st) {
    XcdBarrier b; b.bar = bar; b.x = xb_xcc_id(); b.st = st;
    if (threadIdx.x == 0) (void)xb_add(&bar[XB_XCNT(b.x)], 1u);
    return b;
}
__device__ __forceinline__ void xcd_barrier_complete(unsigned* bar, unsigned x, unsigned& nloc, unsigned& nx) {
    const unsigned G = gridDim.x * gridDim.y * gridDim.z;
    unsigned sum, cnt, mine, sp = 0u;
    for (;;) {
        sum = 0u; cnt = 0u; mine = 0u;
#pragma unroll
        for (unsigned j = 0; j < 16; ++j) { const unsigned c = xb_ld(&bar[XB_XCNT(j)]); sum += c; cnt += (c > 0u) ? 1u : 0u; mine = (j == x) ? c : mine; }
        if (sum == G) break;
        __builtin_amdgcn_s_sleep(1);
        if ((++sp & 255u) == 0u) { if (xb_ld(&bar[XB_TMO])) break; if (sp > XB_SPIN_CAP) { atomicAdd(&bar[XB_TMO], 1u); break; } }
    }
    nloc = mine > 0u ? mine : 1u; nx = cnt > 0u ? cnt : 1u;
}
__device__ __forceinline__ void xcd_barrier(const XcdBarrier& b) {
    asm volatile("s_waitcnt vmcnt(0)" ::: "memory");
    __syncthreads();
    if (threadIdx.x == 0) {
        unsigned* bar = b.bar;
        __builtin_amdgcn_s_waitcnt(0);
        unsigned nloc = b.st[0], nx = b.st[1];
        if (nloc == 0u) { xcd_barrier_complete(bar, b.x, nloc, nx); b.st[0] = nloc; b.st[1] = nx; }
        const unsigned old = xb_add(&bar[XB_XSUB(b.x)], 1u);
        const unsigned gen = old / nloc;
        if (old + 1u == (gen + 1u) * nloc) {
            __builtin_amdgcn_fence(__ATOMIC_RELEASE, "agent");
            asm volatile("s_waitcnt vmcnt(0)" ::: "memory");
            const unsigned og = xb_add(&bar[XB_TOP], 1u);
            const unsigned tg = og / nx;
            if (og + 1u == (tg + 1u) * nx) xb_add(&bar[XB_TOPGEN], 1u);
            else XB_SPIN(xb_ld(&bar[XB_TOPGEN]) == tg, bar);
            __builtin_amdgcn_fence(__ATOMIC_ACQUIRE, "agent");
            xb_add(&bar[XB_XGEN(b.x)], 1u);
            asm volatile("s_waitcnt vmcnt(0)" ::: "memory");
        } else {
            XB_SPIN(xb_ld(&bar[XB_XGEN(b.x)]) == gen, bar);
            __builtin_amdgcn_fence(__ATOMIC_ACQUIRE, "agent");
            asm volatile("s_waitcnt vmcnt(0)" ::: "memory");
        }
    }
    __syncthreads();
}
#define GSYNC() xcd_barrier(xbar)
#endif

constexpr int G_BM = 256, G_BN = 128, G_BK = 64, G_LD = 80;
constexpr int G_STAGE = (G_BM + G_BN) * G_LD * 2;
constexpr int G_LDS = 2 * G_STAGE;

template <int MT = 4, class ARow>
__device__ __forceinline__ void gemm_tile(char* lds, ARow arow  , const bf16_t* Bt, long ldb, int K, f32x4 (&acc)[MT][4]) {
    const int tid = TID(), wid = tid >> 6, lane = tid & 63, wm = wid >> 1, wn = wid & 1, l15 = lane & 15, g = lane >> 4;
#pragma unroll
    for (int m = 0; m < MT; ++m)
#pragma unroll
        for (int n = 0; n < 4; ++n) acc[m][n] = (f32x4){0.f, 0.f, 0.f, 0.f};
    const bf16_t* ap[MT]; const bf16_t* bp[2];
#pragma unroll
    for (int i = 0; i < MT; ++i) { int pc = tid + i * NTH; int r = pc >> 3, s = pc & 7; ap[i] = arow(r) + s * 8; }
#pragma unroll
    for (int i = 0; i < 2; ++i) { int pc = tid + i * NTH; int r = pc >> 3, s = pc & 7; bp[i] = Bt + (long)r * ldb + s * 8; }
    U4 ra[2][MT], rb[2][2];
    const int nk = K / G_BK;
#define GT_LOAD(set, kt) do { _Pragma("unroll") for (int i = 0; i < MT; ++i) ra[set][i] = *(const U4*)(ap[i] + (kt) * G_BK); _Pragma("unroll") for (int i = 0; i < 2; ++i) rb[set][i] = *(const U4*)(bp[i] + (kt) * G_BK); } while (0)
#define GT_STORE(set, st) do { bf16_t* dA = (bf16_t*)(lds + (st) * G_STAGE); bf16_t* dB = dA + G_BM * G_LD; \
        _Pragma("unroll") for (int i = 0; i < MT; ++i) { int pc = tid + i * NTH; int r = pc >> 3, s = pc & 7; *(U4*)(dA + r * G_LD + s * 8) = ra[set][i]; } \
        _Pragma("unroll") for (int i = 0; i < 2; ++i) { int pc = tid + i * NTH; int r = pc >> 3, s = pc & 7; *(U4*)(dB + r * G_LD + s * 8) = rb[set][i]; } } while (0)
#define GT_COMPUTE(st) do { const bf16_t* sA = (const bf16_t*)(lds + (st) * G_STAGE); const bf16_t* sB = sA + G_BM * G_LD; \
        _Pragma("unroll") for (int ks = 0; ks < 2; ++ks) { bf16x8 af[MT], bfr[4]; \
            _Pragma("unroll") for (int m = 0; m < MT; ++m) af[m] = ld8(sA + (wm * 16 * MT + m * 16 + l15) * G_LD + ks * 32 + g * 8); \
            _Pragma("unroll") for (int n = 0; n < 4; ++n) bfr[n] = ld8(sB + (wn * 64 + n * 16 + l15) * G_LD + ks * 32 + g * 8); \
            _Pragma("unroll") for (int m = 0; m < MT; ++m) _Pragma("unroll") for (int n = 0; n < 4; ++n) acc[m][n] = MFMA16(bfr[n], af[m], acc[m][n]); } } while (0)
    GT_LOAD(0, 0);
    GT_LOAD(1, 1);
    __syncthreads();
    GT_STORE(0, 0);
    if (nk > 2) GT_LOAD(0, 2);
    __syncthreads();
    for (int kt = 0; kt < nk; kt += 2) {
        GT_COMPUTE(0);
        GT_STORE(1, 1);
        if (kt + 3 < nk) GT_LOAD(1, kt + 3);
        __syncthreads();
        GT_COMPUTE(1);
        if (kt + 2 < nk) { GT_STORE(0, 0); if (kt + 4 < nk) GT_LOAD(0, kt + 4); }
        __syncthreads();
    }
#undef GT_LOAD
#undef GT_STORE
#undef GT_COMPUTE
}

template <int MT, class Prov, int MODE = 0>
__device__ __forceinline__ void gemm_stream(char* lds, Prov& pv, const long ldb, const int K) {
    const int tid = TID(), wid = tid >> 6, lane = tid & 63, wm = wid >> 1, wn = wid & 1, l15 = lane & 15, g = lane >> 4;
    if (!pv.valid(0)) return;
    const bf16_t* ap[MT]; const bf16_t* bp[2]; const bf16_t* apn[MT]; const bf16_t* bpn[2];
    U4 ra[2][MT], rb[2][2];
    const int nk = K / G_BK;
#define GS_PTRS(AP, BP, i) do { const int tq_ = TID(); _Pragma("unroll") for (int q_ = 0; q_ < MT; ++q_) { int pc = tq_ + q_ * NTH; AP[q_] = pv.arow(i, pc >> 3) + (pc & 7) * 8; } \
        const bf16_t* bb_ = pv.bbase(i); _Pragma("unroll") for (int q_ = 0; q_ < 2; ++q_) { int pc = tq_ + q_ * NTH; BP[q_] = bb_ + (long)(pc >> 3) * ldb + (pc & 7) * 8; } } while (0)
#define GS_LOAD(set, AP, BP, kt) do { _Pragma("unroll") for (int q_ = 0; q_ < MT; ++q_) ra[set][q_] = *(const U4*)(AP[q_] + (kt) * G_BK); _Pragma("unroll") for (int q_ = 0; q_ < 2; ++q_) rb[set][q_] = *(const U4*)(BP[q_] + (kt) * G_BK); } while (0)
#define GS_LOADV(set, v) do { if (MODE == 2 || MODE == 4) break; if ((v) < nk) GS_LOAD(set, ap, bp, (v)); else if (hn) GS_LOAD(set, apn, bpn, (v) - nk); } while (0)
#define GS_STORE(set, st) do { if (MODE == 4) break; bf16_t* dA = (bf16_t*)(lds + (st) * G_STAGE); bf16_t* dB = dA + G_BM * G_LD; \
        _Pragma("unroll") for (int q_ = 0; q_ < MT; ++q_) { int pc = tid + q_ * NTH; *(U4*)(dA + (pc >> 3) * G_LD + (pc & 7) * 8) = ra[set][q_]; } \
        _Pragma("unroll") for (int q_ = 0; q_ < 2; ++q_) { int pc = tid + q_ * NTH; *(U4*)(dB + (pc >> 3) * G_LD + (pc & 7) * 8) = rb[set][q_]; } } while (0)
#define GS_COMPUTE(st) do { if (MODE == 3) break; const bf16_t* sA = (const bf16_t*)(lds + (st) * G_STAGE); const bf16_t* sB = sA + G_BM * G_LD; \
        _Pragma("unroll") for (int ks = 0; ks < 2; ++ks) { bf16x8 af[MT], bfr[4];     \
            _Pragma("unroll") for (int n = 0; n < 4; ++n) bfr[n] = ld8(sB + (wn * 64 + n * 16 + l15) * G_LD + ks * 32 + g * 8); \
            _Pragma("unroll") for (int m = 0; m < MT; ++m) af[m] = ld8(sA + (wm * 16 * MT + m * 16 + l15) * G_LD + ks * 32 + g * 8); \
            SCHED_FENCE(); \
            _Pragma("unroll") for (int m = 0; m < MT; ++m) _Pragma("unroll") for (int n = 0; n < 4; ++n) acc[m][n] = MFMA16(bfr[n], af[m], acc[m][n]); \
            SCHED_FENCE(); } } while (0)
    GS_PTRS(ap, bp, 0);
    GS_LOAD(0, ap, bp, 0);
    GS_LOAD(1, ap, bp, 1);
    __syncthreads();
    for (int i = 0;; ++i) {
        const bool hn = pv.valid(i + 1);
        if (hn) GS_PTRS(apn, bpn, i + 1);
        f32x4 acc[MT][4];
#pragma unroll
        for (int m = 0; m < MT; ++m)
#pragma unroll
            for (int n = 0; n < 4; ++n) acc[m][n] = (f32x4){0.f, 0.f, 0.f, 0.f};
        pv.pre(i);
        GS_STORE(0, 0);
        GS_LOADV(0, 2);
        __syncthreads();
        for (int kt = 0; kt < nk; kt += 2) {
            GS_COMPUTE(0);
            GS_STORE(1, 1);
            GS_LOADV(1, kt + 3);
            __syncthreads();
            GS_COMPUTE(1);
            if (kt + 2 < nk) { GS_STORE(0, 0); GS_LOADV(0, kt + 4); }
            __syncthreads();
        }
        pv.epi(i, acc);
        if (!hn) break;
#pragma unroll
        for (int q_ = 0; q_ < MT; ++q_) ap[q_] = apn[q_];
        bp[0] = bpn[0]; bp[1] = bpn[1];
    }
#undef GS_PTRS
#undef GS_LOAD
#undef GS_LOADV
#undef GS_STORE
#undef GS_COMPUTE
}

template <class SrcFn>
__device__ __forceinline__ void cvt_tile(char* lds, SrcFn srcp, int k0, int n0, bf16_t* dst, long dst_ld) {
    float* t = (float*)lds;
    const int tid = TID();
    __syncthreads();
#pragma unroll
    for (int i = 0; i < 2; ++i) { int kk = (tid >> 4) + 32 * i, n4 = (tid & 15) * 4; const float* sp = srcp(k0 + kk, n0 + n4);
        F4 v = sp ? *(const F4*)sp : (F4){0.f, 0.f, 0.f, 0.f};
        t[kk * 65 + n4] = v.x; t[kk * 65 + n4 + 1] = v.y; t[kk * 65 + n4 + 2] = v.z; t[kk * 65 + n4 + 3] = v.w; }
    __syncthreads();
    { int n = tid >> 3, k8 = (tid & 7) * 8; U4 o;
        o.x = pack2(t[(k8 + 0) * 65 + n], t[(k8 + 1) * 65 + n]); o.y = pack2(t[(k8 + 2) * 65 + n], t[(k8 + 3) * 65 + n]);
        o.z = pack2(t[(k8 + 4) * 65 + n], t[(k8 + 5) * 65 + n]); o.w = pack2(t[(k8 + 6) * 65 + n], t[(k8 + 7) * 65 + n]);
        *(U4*)(dst + (long)(n0 + n) * dst_ld + k0 + k8) = o; }
}

__device__ __forceinline__ void tr_tile(char* lds, const bf16_t* src, long ld, int tok0, int col0, int ncols, int cdst0, bf16_t* dst) {
    bf16_t* t = (bf16_t*)lds;
    const int tid = TID();
    __syncthreads();
    { int r = tid >> 3, s = tid & 7; *(U4*)(t + r * 72 + s * 8) = *(const U4*)(src + (long)(tok0 + r) * ld + col0 + s * 8); }
    __syncthreads();
    { int c = tid >> 3, t8 = (tid & 7) * 8; int b, key; tok_bk(tok0, b, key);
        U4 o; o.x = (u32)t[(t8 + 0) * 72 + c] | ((u32)t[(t8 + 1) * 72 + c] << 16); o.y = (u32)t[(t8 + 2) * 72 + c] | ((u32)t[(t8 + 3) * 72 + c] << 16);
        o.z = (u32)t[(t8 + 4) * 72 + c] | ((u32)t[(t8 + 5) * 72 + c] << 16); o.w = (u32)t[(t8 + 6) * 72 + c] | ((u32)t[(t8 + 7) * 72 + c] << 16);
        *(U4*)(dst + ((long)b * ncols + cdst0 + c) * KEYS + key + t8) = o; }
}
namespace pg8 {
#ifdef CPU_EMU
#define PG8_LAS
#else
#define PG8_LAS __attribute__((address_space(3)))
#endif
typedef unsigned short bf16_t;
typedef unsigned u32x4 __attribute__((ext_vector_type(4)));
constexpr int BM = 256, BK = 64, HALF = 128, HTB = HALF * BK * 2  , STAGE_BYTES = 8 * HTB, NXCD = 8, WGM = 8;

__host__ __device__ __forceinline__ int lds_byte(int r, int c) { const int st = (r >> 4) * 2 + (c >> 5), rr = r & 15, cc = c & 31, ob = rr * 64 + cc * 2; return st * 1024 + (ob ^ (((ob >> 9) & 1) << 5)); }
__host__ __device__ __forceinline__ void stage_rc(int b, int& R, int& C) { const int st = b / 1024, sb = b % 1024, swz = sb ^ (((sb >> 9) & 1) << 5); R = (st >> 1) * 16 + swz / 64; C = (st & 1) * 32 + (swz % 64) / 2; }
__host__ __device__ __forceinline__ int perm32(int rho) { const int n = rho >> 4, i = rho & 15; return 8 * (i >> 2) + 4 * n + (i & 3); }

struct Unit { int pm, pn; };
struct Gemm { const bf16_t* A; const bf16_t* Bt; int M, N, K; };

struct StaticOrder {
    int nM, nN, nwg, G, c;
    __host__ __device__ void init(int M, int N, int G_, int c_) { nM = M / BM; nN = N / BM; nwg = nM * nN; G = G_; c = c_; }
    __host__ __device__ bool next(int i, Unit& u) const {
        const long L = (long)i * G + c; if (L >= nwg) return false;
        int wgid = (int)L; { const int q = nwg / NXCD, r = nwg % NXCD, xcd = wgid % NXCD, off = wgid / NXCD; wgid = (xcd < r ? xcd * (q + 1) : r * (q + 1) + (xcd - r) * q) + off; }
        const int nig = WGM * nN, gid = wgid / nig, fm = gid * WGM, gsz = (nM - fm) < WGM ? (nM - fm) : WGM;
        u.pm = fm + ((wgid % nig) % gsz); u.pn = (wgid % nig) / gsz; return true;
    }
    __device__ __forceinline__ void a_ready(const Unit&) const {}
    __device__ __forceinline__ void done(const Unit&) const {}
};
template <class Epi, class Sched, bool STAMP = false>
__device__ __forceinline__ void gemm_phase(PG8_LAS unsigned char* lds, const Gemm g, const Sched& S, const Epi& E, unsigned long long* stamps) {
    const int tid = TID(), wid = __builtin_amdgcn_readfirstlane(tid >> 6), lane = tid & 63, wr = wid >> 2, wc = wid & 3, fr = lane & 15, fq = lane >> 4;
    const int K = g.K, nt = K / BK;
    int ts_lo = 0, ts_hi = 0, nts = 0; const unsigned long long rt_entry = STAMP ? (unsigned long long)wall_clock64() : 0ull;
#define PG8_STAMP() do { if (STAMP && wid == 0 && nts < 64) { const unsigned long long _c = (unsigned long long)clock64(); \
        ts_lo = (lane == nts) ? (int)(unsigned)_c : ts_lo; ts_hi = (lane == nts) ? (int)(unsigned)(_c >> 32) : ts_hi; ++nts; } } while (0)
    PG8_STAMP();
    unsigned voffA[2], voffB[2];
#pragma unroll
    for (int i = 0; i < 2; ++i) { int R, C; stage_rc(tid * 16 + i * 8192, R, C); const int Rb = Epi::PERM ? ((R & ~31) + perm32(R & 31)) : R;
        voffA[i] = (unsigned)(R * K + C) * 2u; voffB[i] = (unsigned)(Rb * K + C) * 2u; }
    const size_t kstep = (size_t)(BK * 2);
    const size_t hstep = (size_t)HALF * K * 2;
    const size_t tstep = 2 * hstep;
    const unsigned ldsw = (unsigned)wid * 1024u;
    const int aoff = lds_byte(wr * 64 + fr, fq * 8), boff = lds_byte(wc * 32 + fr, fq * 8);
#define PG8_SA(b, h) (((b) * 2 + (h)) * HTB)
#define PG8_SB(b, h) ((4 + (b) * 2 + (h)) * HTB)
#define PG8_STAGE(bufoff, gbase, voff) do { _Pragma("unroll") for (int _i = 0; _i < 2; ++_i) \
        __builtin_amdgcn_global_load_lds((const unsigned*)((const char*)(gbase) + (voff)[_i]), (PG8_LAS unsigned*)(lds + (bufoff) + ldsw + _i * 8192), 16, 0, 0); } while (0)
#define PG8_LDA(dst, b, h) do { _Pragma("unroll") for (int m = 0; m < 4; ++m) _Pragma("unroll") for (int k = 0; k < 2; ++k) dst[m][k] = *(const PG8_LAS bf16x8*)(lds + PG8_SA(b, h) + aoff + m * 2048 + k * 1024); } while (0)
#define PG8_LDB(dst, b, h) do { _Pragma("unroll") for (int n = 0; n < 2; ++n) _Pragma("unroll") for (int k = 0; k < 2; ++k) dst[n][k] = *(const PG8_LAS bf16x8*)(lds + PG8_SB(b, h) + boff + n * 2048 + k * 1024); } while (0)
#define PG8_MMA(ai, bj, At, Bt) do { __builtin_amdgcn_s_setprio(1); _Pragma("unroll") for (int m = 0; m < 4; ++m) _Pragma("unroll") for (int n = 0; n < 2; ++n) _Pragma("unroll") for (int k = 0; k < 2; ++k) \
        acc[ai][bj][m][n] = __builtin_amdgcn_mfma_f32_16x16x32_bf16(Bt[n][k], At[m][k], acc[ai][bj][m][n], 0, 0, 0); __builtin_amdgcn_s_setprio(0); } while (0)
#ifdef CPU_EMU
#define PG8_WAIT_V(n)
#define PG8_WAIT_L(n)
#else
#define PG8_WAIT_V(n) asm volatile("s_waitcnt vmcnt(" #n ")" ::: "memory")
#define PG8_WAIT_L(n) asm volatile("s_waitcnt lgkmcnt(" #n ")" ::: "memory")
#endif
#define PG8_BAR __builtin_amdgcn_s_barrier()
#define PG8_SCHED __builtin_amdgcn_sched_barrier(0)
    Unit cur, nxt; int ui = 0;
    if (!S.next(0, cur)) return;
    f32x4 acc[2][2][4][2];
#pragma unroll
    for (int a = 0; a < 2; ++a)
#pragma unroll
        for (int b = 0; b < 2; ++b)
#pragma unroll
            for (int m = 0; m < 4; ++m)
#pragma unroll
                for (int n = 0; n < 2; ++n) acc[a][b][m][n] = (f32x4){0.f, 0.f, 0.f, 0.f};
    bf16x8 At[4][2], B0[2][2], B1[2][2];
    const char* cA = (const char*)g.A + (size_t)cur.pm * tstep; const char* cB = (const char*)g.Bt + (size_t)cur.pn * tstep;
    S.a_ready(cur);
    PG8_STAGE(PG8_SB(0, 0), cB, voffB); PG8_STAGE(PG8_SA(0, 0), cA, voffA); PG8_STAGE(PG8_SB(0, 1), cB + hstep, voffB); PG8_STAGE(PG8_SA(0, 1), cA + hstep, voffA);
    if (wr == 1) PG8_BAR;
    PG8_WAIT_V(4); PG8_BAR;
    PG8_STAGE(PG8_SB(1, 0), cB + kstep, voffB); PG8_STAGE(PG8_SA(1, 0), cA + kstep, voffA); PG8_STAGE(PG8_SB(1, 1), cB + hstep + kstep, voffB);
    PG8_WAIT_V(6); PG8_BAR;
    PG8_STAMP();
    for (;;) {
        const bool has_next = S.next(ui + 1, nxt);
        const char* nA = has_next ? (const char*)g.A + (size_t)nxt.pm * tstep : cA; const char* nB = has_next ? (const char*)g.Bt + (size_t)nxt.pn * tstep : cB;
        for (int t = 0; t < nt; t += 2) {
            const bool last = (t == nt - 2);
            const char* a1 = cA + (size_t)(t + 1) * kstep;
            const char* a2 = last ? nA : cA + (size_t)(t + 2) * kstep; const char* b2 = last ? nB : cB + (size_t)(t + 2) * kstep;
            const char* a3 = a2 + kstep; const char* b3 = b2 + kstep;
            if (last && has_next) S.a_ready(nxt);
            PG8_LDB(B0, 0, 0); PG8_SCHED; PG8_LDA(At, 0, 0); PG8_STAGE(PG8_SA(1, 1), a1 + hstep, voffA);
            PG8_WAIT_L(8); PG8_BAR; PG8_WAIT_L(0); PG8_MMA(0, 0, At, B0); PG8_BAR; PG8_SCHED;
            PG8_LDB(B1, 0, 1); PG8_STAGE(PG8_SB(0, 0), b2, voffB);
            PG8_BAR; PG8_WAIT_L(0); PG8_MMA(0, 1, At, B1); PG8_BAR;
            PG8_LDA(At, 0, 1); PG8_STAGE(PG8_SA(0, 0), a2, voffA);
            PG8_BAR; PG8_WAIT_L(0); PG8_MMA(1, 0, At, B0); PG8_BAR; PG8_SCHED;
            PG8_STAGE(PG8_SB(0, 1), b2 + hstep, voffB);
            PG8_WAIT_V(6); PG8_BAR; PG8_MMA(1, 1, At, B1); PG8_BAR;
            PG8_LDB(B0, 1, 0); PG8_SCHED; PG8_LDA(At, 1, 0); PG8_STAGE(PG8_SA(0, 1), a2 + hstep, voffA);
            PG8_WAIT_L(8); PG8_BAR; PG8_WAIT_L(0); PG8_MMA(0, 0, At, B0); PG8_BAR; PG8_SCHED;
            PG8_LDB(B1, 1, 1); PG8_STAGE(PG8_SB(1, 0), b3, voffB);
            PG8_BAR; PG8_WAIT_L(0); PG8_MMA(0, 1, At, B1); PG8_BAR;
            PG8_LDA(At, 1, 1); PG8_STAGE(PG8_SA(1, 0), a3, voffA);
            PG8_BAR; PG8_WAIT_L(0); PG8_MMA(1, 0, At, B0); PG8_BAR; PG8_SCHED;
            PG8_STAGE(PG8_SB(1, 1), b3 + hstep, voffB);
            PG8_WAIT_V(6); PG8_BAR; PG8_MMA(1, 1, At, B1); PG8_BAR;
        }
        PG8_STAMP();
        if constexpr (!Epi::AFTER_DRAIN) { E(acc, cur, wr, wc, fr, fq); S.done(cur); }
        PG8_STAMP();
        if (!has_next) break;
#pragma unroll
        for (int a = 0; a < 2; ++a)
#pragma unroll
            for (int b = 0; b < 2; ++b)
#pragma unroll
                for (int m = 0; m < 4; ++m)
#pragma unroll
                    for (int n = 0; n < 2; ++n) acc[a][b][m][n] = (f32x4){0.f, 0.f, 0.f, 0.f};
        cur = nxt; cA = nA; cB = nB; ++ui;
    }
    PG8_WAIT_V(0);
    if (wr == 0) PG8_BAR;
    PG8_BAR;
    if constexpr (Epi::AFTER_DRAIN) { E.fused(acc, cur, wr, wc, fr, fq, lds, wid, lane); S.done(cur); }
    PG8_STAMP();
    if (STAMP && wid == 0) { stamps[lane] = lane < nts ? (((unsigned long long)(unsigned)ts_hi << 32) | (unsigned)ts_lo) : 0ull;
        if (lane == 62) stamps[62] = rt_entry; if (lane == 63) stamps[63] = (unsigned long long)wall_clock64(); }
#undef PG8_STAMP
#undef PG8_SA
#undef PG8_SB
#undef PG8_STAGE
#undef PG8_LDA
#undef PG8_LDB
#undef PG8_MMA
#undef PG8_WAIT_V
#undef PG8_WAIT_L
#undef PG8_BAR
#undef PG8_SCHED
}


__device__ __forceinline__ unsigned cvt_pk_bf16(float lo, float hi) { return pack2(lo, hi); }
__device__ __forceinline__ long gate_idx(int row, int br, int col) {
    const int tm = row / 192, r = row - tm * 192, wm = r / 48, r2 = r - wm * 48, m = r2 >> 4, l15 = r2 & 15;
    const int tn = col >> 7, c = col & 127, wn = c >> 6, n = (c >> 4) & 3, g = (c >> 2) & 3;
    return ((((long)(tm * (D / 128) + tn) * 4 + br) * 8 + (wm * 2 + wn)) * 12 + (m * 4 + n)) * 256 + (g * 16 + l15) * 4;
}
struct EpiInproj {
    static constexpr bool PERM = true, AFTER_DRAIN = false;
    char* ws; int ncol0;
    static __device__ __forceinline__ void st_tr(bf16_t* dT, long key, const f32x4& v0, const f32x4& v1) {
        dT[key] = f2bf(v0[0]); dT[KEYS + key] = f2bf(v0[1]); dT[2 * KEYS + key] = f2bf(v0[2]); dT[3 * KEYS + key] = f2bf(v0[3]);
        dT[4 * KEYS + key] = f2bf(v1[0]); dT[5 * KEYS + key] = f2bf(v1[1]); dT[6 * KEYS + key] = f2bf(v1[2]); dT[7 * KEYS + key] = f2bf(v1[3]); }
    __device__ __forceinline__ void operator()(const f32x4 (&acc)[2][2][4][2], const Unit& u, int wr_, int wc_, int fr_, int fq_) const {
        const int tid = TID(), wid = tid >> 6, lane = tid & 63, wr = wid >> 2, wc = wid & 3, fr = lane & 15, fq = lane >> 4;
        (void)wr_; (void)wc_; (void)fr_; (void)fq_;
#pragma unroll
        for (int bj = 0; bj < 2; ++bj) {
            const int cw = ncol0 + u.pn * BM + bj * HALF;
            bf16_t* dst = nullptr; bf16_t* dT = nullptr; bf16_t* gatep = nullptr; int ld = 0, cl = 0, ncT = 0; bool gab = false;
            if (cw < MY_GQKV) { dT = GPTR(bf16_t, ws + OFF_HYT); ncT = 3 * MW; cl = cw - MY_HY; }
            else if (cw < MY_GZ) { dst = GPTR(bf16_t, ws + OFF_SEG_GQKV); ld = 3 * MW; cl = cw - MY_GQKV; }
            else if (cw < MY_DQKV) { dst = GPTR(bf16_t, ws + OFF_GZ); ld = MW; cl = cw - MY_GZ; }
            else if (cw < MY_NQKV) { cl = cw - MY_DQKV; if (cl < 2 * MW) { dst = GPTR(bf16_t, ws + OFF_SEG_DQKV); ld = 3 * MW; } else { dT = GPTR(bf16_t, ws + OFF_DVT); ncT = MW; cl -= 2 * MW; } }
            else if (cw < MY_GAB) { cl = cw - MY_NQKV; if (cl < 2 * MW) { dst = GPTR(bf16_t, ws + OFF_SEG_NQKV); ld = 3 * MW; } else { dT = GPTR(bf16_t, ws + OFF_NVT); ncT = MW; cl -= 2 * MW; } }
            else if (cw < MY_GATE) { gab = (cw == MY_GAB) && wc == 0; }
            else { gatep = GPTR(bf16_t, ws + OFF_SEG_GATE); cl = cw - MY_GATE; }
            if (dst) {
#pragma unroll
                for (int ai = 0; ai < 2; ++ai)
#pragma unroll
                    for (int m = 0; m < 4; ++m) { const long row = (long)u.pm * BM + ai * HALF + wr * 64 + m * 16 + fr;
                        const f32x4 v0 = acc[ai][bj][m][0], v1 = acc[ai][bj][m][1];
                        U4 w; w.x = pack2(v0[0], v0[1]); w.y = pack2(v0[2], v0[3]); w.z = pack2(v1[0], v1[1]); w.w = pack2(v1[2], v1[3]);
                        *(U4*)(dst + row * ld + cl + wc * 32 + 8 * fq) = w; }
            } else if (gatep) {
                const int gcol = cl + wc * 32 + 8 * fq, br = gcol / D, col = gcol - br * D;
#pragma unroll
                for (int ai = 0; ai < 2; ++ai)
#pragma unroll
                    for (int m = 0; m < 4; ++m) { const int row = u.pm * BM + ai * HALF + wr * 64 + m * 16 + fr;
                        const f32x4 v0 = acc[ai][bj][m][0], v1 = acc[ai][bj][m][1];
                        bf16_t* q = gatep + gate_idx(row, br, col);
                        *(U2*)q = (U2){pack2(v0[0], v0[1]), pack2(v0[2], v0[3])}; *(U2*)(q + 64) = (U2){pack2(v1[0], v1[1]), pack2(v1[2], v1[3])}; }
            } else if (dT) {
#pragma unroll
                for (int ai = 0; ai < 2; ++ai)
#pragma unroll
                    for (int m = 0; m < 4; ++m) { const int row = u.pm * BM + ai * HALF + wr * 64 + m * 16 + fr; int b, key; tok_bk(row, b, key);
                        st_tr(dT + ((long)b * ncT + cl + wc * 32 + 8 * fq) * KEYS, key, acc[ai][bj][m][0], acc[ai][bj][m][1]); }
            } else if (gab) {
                float* GAB = GPTR(float, ws + OFF_GAB);
#pragma unroll
                for (int ai = 0; ai < 2; ++ai)
#pragma unroll
                    for (int m = 0; m < 4; ++m) { const long row = (long)u.pm * BM + ai * HALF + wr * 64 + m * 16 + fr;
                        const f32x4 v0 = acc[ai][bj][m][0], v1 = acc[ai][bj][m][1];
                        *(F4*)(GAB + row * 32 + 8 * fq) = (F4){v0[0], v0[1], v0[2], v0[3]}; *(F4*)(GAB + row * 32 + 8 * fq + 4) = (F4){v1[0], v1[1], v1[2], v1[3]}; }
            }
        }
    }
};
}

#ifdef CPU_EMU
#define WSP(T, off) GPTR(T, p.ws + (off))
#else
typedef __attribute__((address_space(1))) char* gchar_p;
__device__ __forceinline__ gchar_p ws_opaque(char* w) { gchar_p g = (gchar_p)w; asm volatile("" : "+s"(g)); return g; }
#define WSP(T, off) ((T*)(__attribute__((address_space(1))) T*)(ws_opaque(p.ws) + (off)))
#endif
constexpr float DN_ALPHA_F =
#ifdef SMALL_DIMS
    1.4142135623730951f;
#else
    1.681792830507429f;
#endif

__device__ __forceinline__ void phase_prologue(const Params& p, char* lds) {
    const int tid = TID(), G = gridDim.x, bid = BID();
    { float* RWT = WSP(float, OFF_RWT); for (int i = bid * NTH + tid; i < D * 16; i += G * NTH) RWT[(i & 15) * D + (i >> 4)] = GIN(p.router_w)[i]; }
    float* sc = (float*)lds;
    for (int i = tid; i < 3 * D; i += NTH) { int r = i / D, k = i - r * D; float v = r < 2 ? GIN(p.c)[r * D + k] : GIN(p.c_ctx)[k]; sc[i] = siluf(v); }
    __syncthreads();
    float* MODP = WSP(float, OFF_MODP);
    constexpr int NCHK = 6 * D / NTH, KS = D / 8;
    for (int it = bid; it < DEPTH * 8 * NCHK; it += G) {
        int l = it / (8 * NCHK), rem = it - l * 8 * NCHK, s = rem / NCHK, ch = rem - s * NCHK;
        int n = ch * NTH + tid; const float* w = GIN(p.w_mod) + ((long)l * D + s * KS) * 6 * D + n;
        float a0 = 0.f, a1 = 0.f, a2 = 0.f;
#pragma unroll 8
        for (int k = 0; k < KS; ++k) { float wv = w[(long)k * 6 * D]; a0 += sc[s * KS + k] * wv; a1 += sc[D + s * KS + k] * wv; a2 += sc[2 * D + s * KS + k] * wv; }
        float* o = MODP + (((long)l * 8 + s) * 3) * 6 * D + n; o[0] = a0; o[6 * D] = a1; o[12 * D] = a2;
    }
}

constexpr int U_WIN = (NPROJ / 64) * (D / 64), U_BP = 4 * (MW / 64) * (D / 64), U_WO = (D / 64) * (D / 64), U_CVT = U_WIN + U_BP + U_WO;
__device__ __forceinline__ void cvt_unit(const Params& p, char* lds, int l, int u) {
    if (u < U_WIN) { int nt = u / (D / 64), kt = u - nt * (D / 64); const float* src = GIN(p.w_in) + (long)l * D * IN_TOTAL;
        auto sp = [&](int k, int n) -> const float* { int sc;
            if (n < MY_DQKV) sc = n; else if (n < MY_GAB) sc = n + 4 * GH; else if (n < MY_GATE) { int j = n - MY_GAB; if (j >= 4 * GH) return nullptr; sc = SRC_GA + j; } else sc = SRC_GATE + (n - MY_GATE);
            return src + (long)k * IN_TOTAL + sc; };
        cvt_tile(lds, sp, kt * 64, nt * 64, WSP(bf16_t, off_win(l)), D);
    } else if (u < U_WIN + U_BP) { int v = u - U_WIN; int m = v / ((MW / 64) * (D / 64)), r = v - m * ((MW / 64) * (D / 64)), nt = r / (MW / 64), kt = r - nt * (MW / 64);
        const float* src = GIN(p.branch_proj) + ((long)(l * 4 + m) * MW) * D;
        auto sp = [&](int k, int n) -> const float* { return src + (long)k * D + n; };
        cvt_tile(lds, sp, kt * 64, nt * 64, WSP(bf16_t, off_bp(l)) + m * MW, 4 * MW);
    } else { int v = u - U_WIN - U_BP; int nt = v / (D / 64), kt = v - nt * (D / 64); const float* src = GIN(p.w_out) + (long)l * D * D;
        auto sp = [&](int k, int n) -> const float* { return src + (long)k * D + n; };
        cvt_tile(lds, sp, kt * 64, nt * 64, WSP(bf16_t, off_wo(l)), D);
    }
}
__device__ __forceinline__ void w3t_chunk(const Params& p, int l, int i0, int n) {
    const int tid = TID(); bf16_t* W3T = WSP(bf16_t, OFF_W3T); const float* w3 = GIN(p.hy_w3) + (long)l * 64 * 4 * HYW;
    for (int i = i0 + tid; i < i0 + n; i += NTH) { const int col = i >> 7, k = i & 127; W3T[i] = k < 64 ? f2bf(w3[(long)k * 4 * HYW + col]) : (bf16_t)0; }
}
__device__ __forceinline__ void h2f_positions(const Params& p, int l, int pos0, int iters) {
    const int tid = TID(), lane = tid & 63, wid = tid >> 6;
    float* H2F = WSP(float, OFF_H2F); bf16_t* H2B = WSP(bf16_t, OFF_H2B);
    const float* w1 = GIN(p.hy_w1) + (long)l * HY_EMB * 64; const float* b1 = GIN(p.hy_b1) + l * 64; const float* w2 = GIN(p.hy_w2) + (long)l * 64 * 64; const float* b2 = GIN(p.hy_b2) + l * 64; const float fr = GIN(p.hy_freq)[l * 64 + lane];
    for (int it = 0; it < iters; ++it) { const int pos = pos0 + it * 8 + wid; if (pos >= KEYS) break;
        int L = pos < SEQ ? SEQ : CTX, t = pos < SEQ ? pos : pos - SEQ;
        float feat = 0.f;
        if (lane == 0) feat = (float)t / (float)(L - 1);
        else if (lane < 33) { int bi = (lane - 1) & 15; float band = 1e-4f + (float)bi * ((15.0f - 1e-4f) / 15.0f); float ang = 6.283185307179586f * (float)t / (float)L; float a = band * ang;
            feat = lane < 17 ? cosf(a) : -sinf(a); }
        float a1 = b1[lane];
        for (int e = 0; e < HY_EMB; ++e) a1 += __shfl(feat, e) * w1[e * 64 + lane];
        float h1 = sinf(fr * a1);
        float a2 = b2[lane];
        for (int i = 0; i < 64; ++i) a2 += __shfl(h1, i) * w2[i * 64 + lane];
        const float hv = sinf(fr * a2); H2F[(long)pos * 64 + lane] = hv; H2B[(long)pos * 128 + lane] = f2bf(hv); H2B[(long)pos * 128 + 64 + lane] = 0; }
}
__device__ __forceinline__ void phase_weights(const Params& p, char* lds, int l) {
    const int tid = TID(), G = gridDim.x, bid = BID();
    { const float* MODP = WSP(float, OFF_MODP); float* MOD = WSP(float, OFF_MOD);
        for (int i = bid * NTH + tid; i < DEPTH * 3 * 6 * D; i += G * NTH) { int ll = i / (18 * D), rem = i - ll * 18 * D, n = rem % (6 * D);
            float a = GIN(p.b_mod)[ll * 6 * D + n];
#pragma unroll
            for (int s = 0; s < 8; ++s) a += MODP[((long)ll * 8 + s) * 18 * D + rem];
            MOD[i] = a; } }
    if (bid == 0 && tid < 64) WSP(u32, OFF_CNT)[64 + tid] = 0u;
    for (int u = bid; u < U_CVT; u += G) cvt_unit(p, lds, l, u);
    for (int c = bid; c < (4 * HYW * 128 + 8191) / 8192; c += G) w3t_chunk(p, l, c * 8192, 8192);
    for (int c = bid; c < (KEYS + 63) / 64; c += G) h2f_positions(p, l, c * 64, 8);
}

__device__ __forceinline__ void phase_expert_weights(const Params& p, char* lds, int l, int bid, int G) {
    constexpr int U13 = (2 * EFF / 64) * (D / 64), U2_ = (D / 64) * (EFF / 64);
    for (int u = bid < 0 ? NE * (U13 + U2_) : bid; u < NE * (U13 + U2_); u += G) {
        int e = u / (U13 + U2_), v = u - e * (U13 + U2_);
        if (v < U13) { int nt = v / (D / 64), kt = v - nt * (D / 64);
            const float* s1 = GIN(p.exp_w1) + ((long)(l * NE + e) * D) * EFF; const float* s3 = GIN(p.exp_w3) + ((long)(l * NE + e) * D) * EFF;
            const long d13 = (long)((uintptr_t)s1 - (uintptr_t)s3);
            auto sp = [&](int k, int n) -> const float* { int grp = n >> 5, w = n & 31; return (const float*)((uintptr_t)s3 + (uintptr_t)(w < 16 ? d13 : 0L)) + (long)k * EFF + grp * 16 + (w & 15); };
            cvt_tile(lds, sp, kt * 64, nt * 64, WSP(bf16_t, OFF_W13) + (long)e * 2 * EFF * D, D);
        } else { int w = v - U13; int nt = w / (EFF / 64), kt = w - nt * (EFF / 64); const float* s2 = GIN(p.exp_w2) + ((long)(l * NE + e) * EFF) * D;
            auto sp = [&](int k, int n) -> const float* { return s2 + (long)k * D + n; };
            cvt_tile(lds, sp, kt * 64, nt * 64, WSP(bf16_t, OFF_W2) + (long)e * D * EFF, EFF);
        }
    }
}

constexpr int RV = D / 256;
__device__ __forceinline__ void row_stats(const F4 (&v)[RV], float& mean, float& rstd) {
    float s = 0.f;
#pragma unroll
    for (int i = 0; i < RV; ++i) s += (v[i].x + v[i].y) + (v[i].z + v[i].w);
    mean = wave_sum(s) * (1.0f / D);
    float q = 0.f;
#pragma unroll
    for (int i = 0; i < RV; ++i) { float a = v[i].x - mean, b = v[i].y - mean, c = v[i].z - mean, d = v[i].w - mean; q += (a * a + b * b) + (c * c + d * d); }
    rstd = rsqrtf(wave_sum(q) * (1.0f / D) + LN_EPS);
}
__device__ __forceinline__ void row_stats2(const F4 (&v)[2][RV], float (&mean)[2], float (&rstd)[2]) {
    float s0 = 0.f, s1 = 0.f;
#pragma unroll
    for (int i = 0; i < RV; ++i) { s0 += (v[0][i].x + v[0][i].y) + (v[0][i].z + v[0][i].w); s1 += (v[1][i].x + v[1][i].y) + (v[1][i].z + v[1][i].w); }
    s0 = xadd<32>(s0); s1 = xadd<32>(s1); s0 = xadd<16>(s0); s1 = xadd<16>(s1); s0 = xadd<8>(s0); s1 = xadd<8>(s1); s0 = xadd<4>(s0); s1 = xadd<4>(s1); s0 = xadd<2>(s0); s1 = xadd<2>(s1); s0 = xadd<1>(s0); s1 = xadd<1>(s1);
    mean[0] = s0 * (1.0f / D); mean[1] = s1 * (1.0f / D);
    float q0 = 0.f, q1 = 0.f;
#pragma unroll
    for (int i = 0; i < RV; ++i) { float a = v[0][i].x - mean[0], b = v[0][i].y - mean[0], c = v[0][i].z - mean[0], d = v[0][i].w - mean[0]; q0 += (a * a + b * b) + (c * c + d * d);
        a = v[1][i].x - mean[1]; b = v[1][i].y - mean[1]; c = v[1][i].z - mean[1]; d = v[1][i].w - mean[1]; q1 += (a * a + b * b) + (c * c + d * d); }
    q0 = xadd<32>(q0); q1 = xadd<32>(q1); q0 = xadd<16>(q0); q1 = xadd<16>(q1); q0 = xadd<8>(q0); q1 = xadd<8>(q1); q0 = xadd<4>(q0); q1 = xadd<4>(q1); q0 = xadd<2>(q0); q1 = xadd<2>(q1); q0 = xadd<1>(q0); q1 = xadd<1>(q1);
    rstd[0] = rsqrtf(q0 * (1.0f / D) + LN_EPS); rstd[1] = rsqrtf(q1 * (1.0f / D) + LN_EPS);
}
__device__ __forceinline__ void row_modulate_store(const F4 (&v)[RV], float mean, float rstd, const float* shift, const float* scale, bf16_t* dst, int lane, F4 (*keep)[RV] = nullptr) {
#pragma unroll
    for (int i = 0; i < RV; ++i) { int n = (i * 64 + lane) * 4; F4 sh = *(const F4*)(shift + n), sc = *(const F4*)(scale + n);
        F4 h; h.x = (v[i].x - mean) * rstd * (1.0f + sc.x) + sh.x; h.y = (v[i].y - mean) * rstd * (1.0f + sc.y) + sh.y; h.z = (v[i].z - mean) * rstd * (1.0f + sc.z) + sh.z; h.w = (v[i].w - mean) * rstd * (1.0f + sc.w) + sh.w;
        U2 o; o.x = pack2(h.x, h.y); o.y = pack2(h.z, h.w); *(U2*)(dst + n) = o; if (keep) (*keep)[i] = h; }
}

__device__ __forceinline__ const float* xs_row(const Params& p, int l, int row) {
    const uintptr_t a = (uintptr_t)(WSP(float, OFF_XS) + (long)row * D);
    const uintptr_t b = row < NLAT ? (uintptr_t)(GIN(p.x) + (long)row * D) : (uintptr_t)(GIN(p.ctx) + (long)(row - NLAT) * D);
    return (const float*)(l == 0 ? b : a);
}
__device__ __forceinline__ void phase_modulate0(const Params& p, int l) {
    const int tid = TID(), lane = tid & 63, wid = tid >> 6;
    const float* XS = WSP(float, OFF_XS); bf16_t* H = WSP(bf16_t, OFF_H); const float* MOD = WSP(float, OFF_MOD) + (long)l * 18 * D;
    for (int row = BID() * 8 + wid; row < NTOK; row += gridDim.x * 8) {
        F4 v[RV]; const float* xr = xs_row(p, l, row);
#pragma unroll
        for (int i = 0; i < RV; ++i) v[i] = *(const F4*)(xr + (i * 64 + lane) * 4);
        float mean, rstd; row_stats(v, mean, rstd);
        const float* m = MOD + mod_row(row) * 6 * D;
        row_modulate_store(v, mean, rstd, m, m + D, H + (long)row * D, lane);
    }
}

__device__ __forceinline__ void phase_post_mix(const Params& p, char* lds, int l, bool dry = false) {
    const int tid = TID(), lane = tid & 63, wid = tid >> 6;
    float* XS = WSP(float, OFF_XS); const bf16_t* MIX = WSP(bf16_t, OFF_MIX); bf16_t* H = WSP(bf16_t, OFF_H); const float* MOD = WSP(float, OFF_MOD) + (long)l * 18 * D;
    const float* lng = GIN(p.ln_g) + (long)(l * 2 + 0) * D; const float* lnb = GIN(p.ln_b) + (long)(l * 2 + 0) * D;
    u32* CNT = WSP(u32, OFF_CNT) + (dry ? 128 : 0); float* XSO = dry ? WSP(float, OFF_YE) : XS; int* TOKE = WSP(int, OFF_TOKE); int* TOKR = WSP(int, OFF_TOKR); float* TOKW = WSP(float, OFF_TOKW); int* ELIST = WSP(int, OFF_ELIST);
    const int nrows = (l == DEPTH - 1) ? NLAT : NTOK;
    float* rwT = (float*)lds; u32* lcnt = (u32*)(lds + 16 * D * 4); u32* lbase = lcnt + 16;
    __syncthreads();
    for (int i = tid; i < D * 16; i += NTH) rwT[(i & 15) * D + (i >> 4)] = GIN(p.router_w)[i];
    if (tid < 16) lcnt[tid] = 0u;
    __syncthreads();
    for (int row = BID() * 8 + wid; row < nrows; row += gridDim.x * 8) {
        const float* m = MOD + mod_row(row) * 6 * D; const float* xr = xs_row(p, l, row);
        F4 v[RV];
#pragma unroll
        for (int i = 0; i < RV; ++i) { int n = (i * 64 + lane) * 4; F4 x = *(const F4*)(xr + n), g2 = *(const F4*)(m + 2 * D + n); const U2 mxp = *(const U2*)(MIX + (long)row * D + n); const F4 mx = (F4){bflo(mxp.x), bfhi(mxp.x), bflo(mxp.y), bfhi(mxp.y)};
            v[i].x = fmaf(g2.x, mx.x, DN_ALPHA_F * x.x); v[i].y = fmaf(g2.y, mx.y, DN_ALPHA_F * x.y); v[i].z = fmaf(g2.z, mx.z, DN_ALPHA_F * x.z); v[i].w = fmaf(g2.w, mx.w, DN_ALPHA_F * x.w); }
        float mean, rstd; row_stats(v, mean, rstd);
#pragma unroll
        for (int i = 0; i < RV; ++i) { int n = (i * 64 + lane) * 4; F4 g = *(const F4*)(lng + n), b = *(const F4*)(lnb + n);
            v[i].x = (v[i].x - mean) * rstd * g.x + b.x; v[i].y = (v[i].y - mean) * rstd * g.y + b.y; v[i].z = (v[i].z - mean) * rstd * g.z + b.z; v[i].w = (v[i].w - mean) * rstd * g.w + b.w;
            *(F4*)(XSO + (long)row * D + n) = v[i]; }
        row_stats(v, mean, rstd);
        F4 h[RV];
        row_modulate_store(v, mean, rstd, m + 3 * D, m + 4 * D, H + (long)row * D, lane, &h);
        float lg[16];
#pragma unroll
        for (int e = 0; e < 16; ++e) lg[e] = 0.f;
        { const float* wp = rwT + lane * 4;
#pragma unroll
            for (int i = 0; i < RV; ++i)
#pragma unroll
                for (int eg = 0; eg < 4; ++eg) {
#pragma unroll
                    for (int e = eg * 4; e < eg * 4 + 4; ++e) { const F4 w = *(const F4*)(wp + e * D + i * 256); lg[e] += (h[i].x * w.x + h[i].y * w.y) + (h[i].z * w.z + h[i].w * w.w); }
#ifndef CPU_EMU
                    { int z; asm volatile("v_mov_b32 %0, 0" : "=v"(z) : "v"(lg[eg * 4 + 3])); wp += z; }
#endif
                } }
        float s[16], sel[16];
#pragma unroll
        for (int e = 0; e < 16; ++e) { lg[e] = wave_sum(lg[e]); s[e] = sigmoidf(lg[e]); sel[e] = s[e] + GIN(p.router_b)[e]; }
        float gs[4];
#pragma unroll
        for (int gq = 0; gq < 4; ++gq) { float a = sel[gq * 4], b = sel[gq * 4 + 1], c = sel[gq * 4 + 2], d = sel[gq * 4 + 3];
            float m1 = fmaxf(fmaxf(a, b), fmaxf(c, d)); float lo_ab = fminf(a, b), hi_ab = fmaxf(a, b), lo_cd = fminf(c, d), hi_cd = fmaxf(c, d);
            float m2 = fmaxf(fminf(hi_ab, hi_cd), fmaxf(lo_ab, lo_cd)); gs[gq] = m1 + m2; }
        int bg = 0; float bv = gs[0];
#pragma unroll
        for (int gq = 1; gq < 4; ++gq) if (gs[gq] > bv) { bv = gs[gq]; bg = gq; }
        float c0 = 0.f, c1 = 0.f, c2 = 0.f, c3 = 0.f, t0 = 0.f, t1 = 0.f, t2 = 0.f, t3 = 0.f;
#pragma unroll
        for (int gq = 0; gq < 4; ++gq) if (gq == bg) { c0 = sel[gq * 4]; c1 = sel[gq * 4 + 1]; c2 = sel[gq * 4 + 2]; c3 = sel[gq * 4 + 3]; t0 = s[gq * 4]; t1 = s[gq * 4 + 1]; t2 = s[gq * 4 + 2]; t3 = s[gq * 4 + 3]; }
        int i0 = 0; float v0 = c0, w0 = t0;
        if (c1 > v0) { v0 = c1; i0 = 1; w0 = t1; } if (c2 > v0) { v0 = c2; i0 = 2; w0 = t2; } if (c3 > v0) { v0 = c3; i0 = 3; w0 = t3; }
        int i1 = -1; float v1 = -3.0e38f, w1 = 0.f;
        if (i0 != 0 && c0 > v1) { v1 = c0; i1 = 0; w1 = t0; } if (i0 != 1 && c1 > v1) { v1 = c1; i1 = 1; w1 = t1; } if (i0 != 2 && c2 > v1) { v1 = c2; i1 = 2; w1 = t2; } if (i0 != 3 && c3 > v1) { v1 = c3; i1 = 3; w1 = t3; }
        if (lane == 0) { float ws = w0 + w1; int e0 = bg * 4 + i0, e1 = bg * 4 + i1;
            int r0 = (int)atomicAdd(&lcnt[e0], 1u), r1 = (int)atomicAdd(&lcnt[e1], 1u);
            TOKE[row * 2] = e0; TOKE[row * 2 + 1] = e1; TOKR[row * 2] = r0; TOKR[row * 2 + 1] = r1; TOKW[row * 2] = w0 / ws; TOKW[row * 2 + 1] = w1 / ws; }
    }
    __syncthreads();
    if (tid < 16) lbase[tid] = lcnt[tid] ? atomicAdd(&CNT[tid], lcnt[tid]) : 0u;
    __syncthreads();
    if (tid < 16) for (int row0 = BID() * 8; row0 < nrows; row0 += (int)gridDim.x * 8) { const int row = row0 + (tid >> 1), k = tid & 1;
        const int e = TOKE[row * 2 + k]; const int r = TOKR[row * 2 + k] + (int)lbase[e]; TOKR[row * 2 + k] = r; ELIST[(long)e * NTOK + r] = row; }
}

__device__ __forceinline__ void phase_post_moe(const Params& p, int l, bool dry = false) {
    const int tid = TID(), lane = tid & 63, wid = tid >> 6;
    float* XS = WSP(float, OFF_XS); bf16_t* H = WSP(bf16_t, OFF_H); const float* MOD = WSP(float, OFF_MOD) + (long)l * 18 * D;
    const bf16_t* YE = WSP(bf16_t, OFF_YE);
    const float* lng = GIN(p.ln_g) + (long)(l * 2 + 1) * D; const float* lnb = GIN(p.ln_b) + (long)(l * 2 + 1) * D;
    const u32* CNT = WSP(u32, OFF_CNT); const int* TOKE = WSP(int, OFF_TOKE); const int* TOKR = WSP(int, OFF_TOKR); const float* TOKW = WSP(float, OFF_TOKW);
    const bool last = (l == DEPTH - 1);
    const int nrows = last ? NLAT : NTOK;
    int eoff = 0;
    { int c = lane < 16 ? (int)CNT[lane] : 0; int incl = c;
        for (int o = 1; o < 16; o <<= 1) { int t = __shfl_up(incl, o); if (lane >= o) incl += t; }
        eoff = incl - c; }
    const int stride = (int)gridDim.x * 8;
    for (int row0 = BID() * 8 + wid; row0 < nrows; row0 += 2 * stride) {
        const bool two = row0 + stride < nrows;
        int rowv[2] = {row0, two ? row0 + stride : row0};
        F4 v[2][RV]; const float* mm[2];
#pragma unroll
        for (int q = 0; q < 2; ++q) { const int row = rowv[q]; mm[q] = MOD + mod_row(row) * 6 * D;
            const int e0 = TOKE[row * 2], e1 = TOKE[row * 2 + 1];
            const long p0 = (long)__shfl(eoff, e0) + TOKR[row * 2], p1 = (long)__shfl(eoff, e1) + TOKR[row * 2 + 1];
            const float w0 = TOKW[row * 2], w1 = TOKW[row * 2 + 1];
#pragma unroll
            for (int i = 0; i < RV; ++i) { int n = (i * 64 + lane) * 4; F4 x = *(const F4*)(XS + (long)row * D + n), g5 = *(const F4*)(mm[q] + 5 * D + n);
                U2 a = *(const U2*)(YE + p0 * D + n), b = *(const U2*)(YE + p1 * D + n);
                float y0 = w0 * bflo(a.x) + w1 * bflo(b.x), y1 = w0 * bfhi(a.x) + w1 * bfhi(b.x), y2 = w0 * bflo(a.y) + w1 * bflo(b.y), y3 = w0 * bfhi(a.y) + w1 * bfhi(b.y);
                v[q][i].x = fmaf(g5.x, y0, DN_ALPHA_F * x.x); v[q][i].y = fmaf(g5.y, y1, DN_ALPHA_F * x.y); v[q][i].z = fmaf(g5.z, y2, DN_ALPHA_F * x.z); v[q][i].w = fmaf(g5.w, y3, DN_ALPHA_F * x.w); } }
        float mean[2], rstd[2]; row_stats2(v, mean, rstd);
#pragma unroll
        for (int q = 0; q < 2; ++q) { if (q == 1 && !two) break; const int row = rowv[q];
            float* dst = dry ? WSP(float, OFF_MIX) + (long)row * D : (last ? GPTR(float, p.out) + (long)row * D : XS + (long)row * D);
#pragma unroll
            for (int i = 0; i < RV; ++i) { int n = (i * 64 + lane) * 4; F4 g = *(const F4*)(lng + n), b = *(const F4*)(lnb + n);
                v[q][i].x = (v[q][i].x - mean[q]) * rstd[q] * g.x + b.x; v[q][i].y = (v[q][i].y - mean[q]) * rstd[q] * g.y + b.y; v[q][i].z = (v[q][i].z - mean[q]) * rstd[q] * g.z + b.z; v[q][i].w = (v[q][i].w - mean[q]) * rstd[q] * g.w + b.w;
                *(F4*)(dst + n) = v[q][i]; } }
        if (!last) { row_stats2(v, mean, rstd);
#pragma unroll
            for (int q = 0; q < 2; ++q) { if (q == 1 && !two) break; const float* m2 = mm[q] + 18 * D; row_modulate_store(v[q], mean[q], rstd[q], m2, m2 + D, H + (long)rowv[q] * D, lane); } }
    }
}
__device__ __forceinline__ void st4bf(bf16_t* dst, f32x4 v) { U2 o; o.x = pack2(v[0], v[1]); o.y = pack2(v[2], v[3]); *(U2*)dst = o; }

__device__ __forceinline__ void phase_inproj(const Params& p, char* lds, int l, int part  ) {
    pg8::Gemm g; g.A = WSP(bf16_t, OFF_H); g.Bt = WSP(bf16_t, off_win(l)) + (long)(part == 0 ? 0 : NPROJ1) * D; g.M = NTOK; g.N = part == 0 ? NPROJ1 : 4 * D; g.K = D;
    pg8::StaticOrder S; S.init(g.M, g.N, (int)gridDim.x, BID());
    pg8::EpiInproj E; E.ws = p.ws; E.ncol0 = part == 0 ? 0 : NPROJ1;
    __syncthreads();
    pg8::gemm_phase<pg8::EpiInproj, pg8::StaticOrder, false>((PG8_LAS unsigned char*)lds, g, S, E, nullptr);
    __syncthreads();
    if (part == 1) {
        const int G = (int)gridDim.x, rem = S.nwg % G, c = BID();
        for (int rep_ = 0; rep_ < REP_W; ++rep_) phase_expert_weights(p, lds, l, rem == 0 ? c : c - rem, rem == 0 ? G : G - rem);
    }
}

__device__ __forceinline__ void phase_prep(const Params& p, char* lds, int l, bool do_rope = true, bool do_c = true, bool do_d = true) {
    const int tid = TID(), G = gridDim.x, bid = BID(), lane = tid & 63, wid = tid >> 6;
    if (bid == 0 && tid < 64) { WSP(u32, OFF_CNT)[tid] = 0u; WSP(u32, OFF_CNT)[128 + tid] = 0u; }
    if (do_rope) {
        bf16_t* DQ = WSP(bf16_t, OFF_SEG_DQKV);
        constexpr int NV = 4 * DH;
        for (long i = (long)bid * NTH + tid; i < (long)NLAT * 32; i += (long)G * NTH) {
            int tok = (int)(i >> 5), f2 = (int)(i & 31);
            int t = tok % SEQ; int axis = f2 >> 4, f = f2 & 15;
            float pos = axis == 0 ? (float)(t / GW) : (float)(t % GW);
            float inv = powf(10000.0f, -(float)f / 16.0f);
            float ang = pos * inv, sn = sinf(ang), cs = cosf(ang);
            bf16_t* base = DQ + (long)tok * 3 * MW + axis * 32 + f;
#pragma unroll
            for (int v = 0; v < NV; ++v) { bf16_t* q = base + v * 64; const float qs = v < 2 * DH ? 0.125f * 1.4426950408889634f : 1.0f;
                float x1 = bf2f(q[0]), x2 = bf2f(q[16]); q[0] = f2bf((x1 * cs - x2 * sn) * qs); q[16] = f2bf((x1 * sn + x2 * cs) * qs); }
        }
    }
    if (do_c) {
        const bf16_t* SG = WSP(bf16_t, OFF_SEG_GQKV); bf16_t* GQ = WSP(bf16_t, OFF_GQ); bf16_t* GK = WSP(bf16_t, OFF_GK); bf16_t* GV = WSP(bf16_t, OFF_GV);
        const float* cwp = GIN(p.gdn_conv) + (long)l * 3 * MW * 3;
        const int sub = tid & 7;
        for (long i = ((long)bid * NTH + tid) >> 3; i < (long)NTOK * GH; i += ((long)G * NTH) >> 3) {
            const int tok = (int)(i / GH), h = (int)(i - (long)tok * GH);
            int seq0, len; if (tok < NLAT) { seq0 = (tok / SEQ) * SEQ; len = SEQ; } else { seq0 = NLAT + ((tok - NLAT) / CTX) * CTX; len = CTX; }
            const int t = tok - seq0; const bool hasp = t > 0, hasn = t + 1 < len;
            float u[3][8];
#pragma unroll
            for (int part = 0; part < 3; ++part) { const int c = part * MW + h * 64 + sub * 8; const bf16_t* s = SG + (long)tok * 3 * MW + c;
                const U4 x1 = *(const U4*)s; const U4 x0 = hasp ? *(const U4*)(s - 3 * MW) : (U4){0u, 0u, 0u, 0u}; const U4 x2 = hasn ? *(const U4*)(s + 3 * MW) : (U4){0u, 0u, 0u, 0u};
                const u32 a0[4] = {x0.x, x0.y, x0.z, x0.w}, a1[4] = {x1.x, x1.y, x1.z, x1.w}, a2[4] = {x2.x, x2.y, x2.z, x2.w};
                float w[24];
#pragma unroll
                for (int q = 0; q < 6; ++q) { const F4 wv = *(const F4*)(cwp + c * 3 + q * 4); w[q * 4] = wv.x; w[q * 4 + 1] = wv.y; w[q * 4 + 2] = wv.z; w[q * 4 + 3] = wv.w; }
#pragma unroll
                for (int e = 0; e < 4; ++e) {
                    float lo = bflo(a0[e]) * w[(2 * e) * 3] + bflo(a1[e]) * w[(2 * e) * 3 + 1] + bflo(a2[e]) * w[(2 * e) * 3 + 2];
                    float hi = bfhi(a0[e]) * w[(2 * e + 1) * 3] + bfhi(a1[e]) * w[(2 * e + 1) * 3 + 1] + bfhi(a2[e]) * w[(2 * e + 1) * 3 + 2];
                    u[part][2 * e] = siluf(lo); u[part][2 * e + 1] = siluf(hi); } }
            float nq = 0.f, nk = 0.f;
#pragma unroll
            for (int e = 0; e < 8; ++e) { nq += u[0][e] * u[0][e]; nk += u[1][e] * u[1][e]; }
            nq = xadd<1>(nq); nq = xadd<2>(nq); nq = xadd<4>(nq);
            nk = xadd<1>(nk); nk = xadd<2>(nk); nk = xadd<4>(nk);
            const float rq = rsqrtf(nq + RMS_EPS) * 0.125f, rk = rsqrtf(nk + RMS_EPS);
            const long o = (long)tok * MW + h * 64 + sub * 8;
            *(U4*)(GQ + o) = (U4){pack2(u[0][0] * rq, u[0][1] * rq), pack2(u[0][2] * rq, u[0][3] * rq), pack2(u[0][4] * rq, u[0][5] * rq), pack2(u[0][6] * rq, u[0][7] * rq)};
            *(U4*)(GK + o) = (U4){pack2(u[1][0] * rk, u[1][1] * rk), pack2(u[1][2] * rk, u[1][3] * rk), pack2(u[1][4] * rk, u[1][5] * rk), pack2(u[1][6] * rk, u[1][7] * rk)};
            *(U4*)(GV + o) = (U4){pack2(u[2][0], u[2][1]), pack2(u[2][2], u[2][3]), pack2(u[2][4], u[2][5]), pack2(u[2][6], u[2][7])};
        }
        const float* GAB = WSP(float, OFF_GAB); float* GB = WSP(float, OFF_GB);
        for (long i = (long)bid * NTH + tid; i < (long)NTOK * 2 * GH; i += (long)G * NTH) {
            int tok = (int)(i / (2 * GH)), dh = (int)(i - (long)tok * 2 * GH);
            float a = GAB[(long)tok * 32 + dh], b = GAB[(long)tok * 32 + 2 * GH + dh];
            float xa = a + GIN(p.gdn_dt_bias)[l * 2 * GH + dh]; float sp = xa > 20.f ? xa : log1pf(__expf(xa));
            GB[(long)tok * 4 * GH + dh] = -__expf(GIN(p.gdn_a_log)[l * 2 * GH + dh]) * sp;
            GB[(long)tok * 4 * GH + 2 * GH + dh] = sigmoidf(b);
        }
    }
    if (do_d) {
        const bf16_t* H2B = WSP(bf16_t, OFF_H2B); const bf16_t* W3T = WSP(bf16_t, OFF_W3T); bf16_t* TAPS = WSP(bf16_t, OFF_TAPS);
        const int wid = tid >> 6, wm = wid >> 1, wn = wid & 1, l15 = lane & 15, g = lane >> 4;
        constexpr int MT = 3, ntm = KEYS / (64 * MT), ntn = 4 * HYW / G_BN;
        for (int u = bid; u < ntm * ntn; u += G) {
            const int tn = u / ntm, tm = u - tn * ntm, row0 = tm * 64 * MT, col0 = tn * G_BN;
            f32x4 acc[MT][4];
            gemm_tile<MT>(lds, [&](int r) { return H2B + (long)(row0 + r) * 128; }, W3T + (long)col0 * 128, 128, 128, acc);
#pragma unroll
            for (int n = 0; n < 4; ++n) { const int colb = col0 + wn * 64 + n * 16 + g * 4;
                const F4 dl4 = *(const F4*)(GIN(p.hy_deltas) + (long)l * 4 * HYW + colb); const float dl[4] = {fabsf(dl4.x), fabsf(dl4.y), fabsf(dl4.z), fabsf(dl4.w)};
#pragma unroll
                for (int m = 0; m < MT; ++m) { const int pos = row0 + wm * 16 * MT + m * 16 + l15; const bool ctxp = pos >= SEQ; const int L = ctxp ? CTX : SEQ, t = ctxp ? pos - SEQ : pos;
                    const float tl = (float)t * (1.0f / (float)(L - 1));
#pragma unroll
                    for (int j = 0; j < 4; ++j) TAPS[(long)(colb + j) * KEYS + pos] = f2bf(acc[m][n][j] * (__expf(-tl * dl[j]) + 0.05f)); } }
        }
    }
}
constexpr int A_LD = 72, AK_LD = 80;
template <int DV> struct AttnLds { static constexpr int K_BYTES = 64 * AK_LD * 2, V_BYTES = DV * A_LD * 2, STAGE = K_BYTES + V_BYTES, TOTAL = 2 * STAGE; };
constexpr float LOG2E = 1.4426950408889634f;
constexpr float NEG_BIG = -1.0e30f;

template <int NQT, int DV, class QRow, class KTile, class MaskFn>
__device__ __forceinline__ void attn_core(char* lds, QRow qrow  , KTile ktile  ,
                                          int ntiles, MaskFn mask  , f32x4 (&oacc)[DV / 16][NQT], float (&lsum)[NQT]) {
    const int tid = TID(), wid = tid >> 6, lane = tid & 63, l15 = lane & 15, g = lane >> 4;
    constexpr int NDT = DV / 16, NVL = DV / 64;
    typedef AttnLds<DV> L;
    bf16x8 qf[NQT][2];
#pragma unroll
    for (int qt = 0; qt < NQT; ++qt) { const bf16_t* q = qrow(wid * NQT * 16 + qt * 16 + l15);
#pragma unroll
        for (int ks = 0; ks < 2; ++ks) qf[qt][ks] = ld8(q + ks * 32 + g * 8); }
    float mrun[NQT];
#pragma unroll
    for (int qt = 0; qt < NQT; ++qt) { mrun[qt] = NEG_BIG; lsum[qt] = 0.f;
#pragma unroll
        for (int dt = 0; dt < NDT; ++dt) oacc[dt][qt] = (f32x4){0.f, 0.f, 0.f, 0.f}; }
    const int sr = tid >> 3, ss = tid & 7;
    U4 rk, rv[NVL];
    { const bf16_t *kp, *vp; long kld, vld; ktile(0, kp, kld, vp, vld);
        rk = *(const U4*)(kp + (long)sr * kld + ss * 8);
#pragma unroll
        for (int i = 0; i < NVL; ++i) rv[i] = *(const U4*)(vp + (long)(sr + 64 * i) * vld + ss * 8); }
    __syncthreads();
    { bf16_t* sK = (bf16_t*)lds; bf16_t* sV = (bf16_t*)(lds + L::K_BYTES);
        *(U4*)(sK + sr * AK_LD + ss * 8) = rk;
#pragma unroll
        for (int i = 0; i < NVL; ++i) *(U4*)(sV + (sr + 64 * i) * A_LD + ss * 8) = rv[i]; }
    __syncthreads();
    for (int t = 0; t < ntiles; ++t) {
        const bool more = t + 1 < ntiles;
        if (more) { const bf16_t *kp, *vp; long kld, vld; ktile(t + 1, kp, kld, vp, vld);
            rk = *(const U4*)(kp + (long)sr * kld + ss * 8);
#pragma unroll
            for (int i = 0; i < NVL; ++i) rv[i] = *(const U4*)(vp + (long)(sr + 64 * i) * vld + ss * 8); }
        const bf16_t* sK = (const bf16_t*)(lds + (t & 1) * L::STAGE); const bf16_t* sV = (const bf16_t*)(lds + (t & 1) * L::STAGE + L::K_BYTES);
        f32x4 s[4][NQT];
#pragma unroll
        for (int mt = 0; mt < 4; ++mt) {
#pragma unroll
            for (int qt = 0; qt < NQT; ++qt) s[mt][qt] = (f32x4){0.f, 0.f, 0.f, 0.f};
#pragma unroll
            for (int ks = 0; ks < 2; ++ks) { bf16x8 kf = ld8(sK + (mt * 16 + l15) * AK_LD + ks * 32 + g * 8);
#pragma unroll
                for (int qt = 0; qt < NQT; ++qt) s[mt][qt] = MFMA16(kf, qf[qt][ks], s[mt][qt]); }
        }
        bf16x8 pf[2][NQT];
#pragma unroll
        for (int qt = 0; qt < NQT; ++qt) {
            const int qi = wid * NQT * 16 + qt * 16 + l15;
            float mx = NEG_BIG;
#pragma unroll
            for (int mt = 0; mt < 4; ++mt)
#pragma unroll
                for (int j = 0; j < 4; ++j) { float v = mask(t, mt, j, qi, s[mt][qt][j] * (0.125f * LOG2E)); s[mt][qt][j] = v; mx = fmaxf(mx, v); }
            mx = xmax<16>(mx); mx = xmax<32>(mx);
            const float mnew = fmaxf(mrun[qt], mx), alpha = fexp2(mrun[qt] - mnew); mrun[qt] = mnew;
            float ps = 0.f;
#pragma unroll
            for (int mt = 0; mt < 4; ++mt)
#pragma unroll
                for (int j = 0; j < 4; ++j) { float pv = fexp2(s[mt][qt][j] - mnew); s[mt][qt][j] = pv; ps += pv; }
            lsum[qt] = lsum[qt] * alpha + ps;
#pragma unroll
            for (int dt = 0; dt < NDT; ++dt) oacc[dt][qt] *= alpha;
#pragma unroll
            for (int kb = 0; kb < 2; ++kb) pf[kb][qt] = mk8u(pack2(s[2 * kb][qt][0], s[2 * kb][qt][1]), pack2(s[2 * kb][qt][2], s[2 * kb][qt][3]),
                                                             pack2(s[2 * kb + 1][qt][0], s[2 * kb + 1][qt][1]), pack2(s[2 * kb + 1][qt][2], s[2 * kb + 1][qt][3]));
        }
#pragma unroll
        for (int dt = 0; dt < NDT; ++dt)
#pragma unroll
            for (int kb = 0; kb < 2; ++kb) { const bf16_t* vr = sV + (dt * 16 + l15) * A_LD + kb * 32 + g * 4;
                bf16x8 vf = mk8(*(const U2*)vr, *(const U2*)(vr + 16));
#pragma unroll
                for (int qt = 0; qt < NQT; ++qt) oacc[dt][qt] = MFMA16(vf, pf[kb][qt], oacc[dt][qt]);
                if (kb == 1 && (dt & 1)) SCHED_FENCE(); }
        if (more) { bf16_t* dK = (bf16_t*)(lds + ((t + 1) & 1) * L::STAGE); bf16_t* dV = (bf16_t*)(lds + ((t + 1) & 1) * L::STAGE + L::K_BYTES);
            *(U4*)(dK + sr * AK_LD + ss * 8) = rk;
#pragma unroll
            for (int i = 0; i < NVL; ++i) *(U4*)(dV + (sr + 64 * i) * A_LD + ss * 8) = rv[i]; }
        __syncthreads();
    }
#pragma unroll
    for (int qt = 0; qt < NQT; ++qt) { float l = lsum[qt]; l = xadd<16>(l); l = xadd<32>(l); lsum[qt] = l; }
}

struct NoMask { __device__ __forceinline__ float operator()(int, int, int, int, float s) const { return s; } };

__device__ __forceinline__ void diff_lambda(const Params& p, int l, float& lam, float& lam_init) {
    const int lane = TID() & 63; const float* dl = GIN(p.diff_lam) + (long)l * 4 * 64;
    const float a = wave_sum(dl[lane] * dl[64 + lane]), b = wave_sum(dl[128 + lane] * dl[192 + lane]);
    int ll = l;
#ifndef CPU_EMU
    asm volatile("" : "+s"(ll));
#endif
    lam_init = 0.8f - 0.6f * expf(-0.3f * (float)ll); lam = expf(a) - expf(b) + lam_init;
}
template <int NQT>
__device__ __forceinline__ void diff_attn_item(const Params& p, char* lds, int l, int b, int h, int q0, bool ctxq) {
    const int tid = TID(), wid = tid >> 6, lane = tid & 63, l15 = lane & 15, g = lane >> 4;
    const bf16_t* DQ = WSP(bf16_t, OFF_SEG_DQKV); const bf16_t* DVT = WSP(bf16_t, OFF_DVT); bf16_t* Y = WSP(bf16_t, OFF_Y);
    const int tok_q0 = ctxq ? NLAT + b * CTX + q0 : b * SEQ + q0;
    const int t_first = ctxq ? SEQ / 64 : 0, ntiles = ctxq ? CTX / 64 : KEYS / 64;
    f32x4 o1[8][NQT]; float l1[NQT];
    {
        auto qrow = [&](int i) { return DQ + (long)(tok_q0 + i) * 3 * MW + h * 128; };
        auto kt = [&](int t, const bf16_t*& kp, long& kld, const bf16_t*& vp, long& vld) { int tt = t_first + t; int tok = bk_tok(b, tt * 64);
            kp = DQ + (long)tok * 3 * MW + MW + h * 128; kld = 3 * MW; vp = DVT + ((long)b * MW + h * 128) * KEYS + tt * 64; vld = KEYS; };
        attn_core<NQT, 128>(lds, qrow, kt, ntiles, NoMask(), o1, l1);
    }
    U2 o1p[8][NQT];
#pragma unroll
    for (int qt = 0; qt < NQT; ++qt) { float inv = 1.0f / l1[qt];
#pragma unroll
        for (int dt = 0; dt < 8; ++dt) { f32x4 v = o1[dt][qt] * inv; o1p[dt][qt].x = pack2(v[0], v[1]); o1p[dt][qt].y = pack2(v[2], v[3]); } }
    f32x4 o2[8][NQT]; float l2[NQT];
    {
        auto qrow = [&](int i) { return DQ + (long)(tok_q0 + i) * 3 * MW + h * 128 + 64; };
        auto kt = [&](int t, const bf16_t*& kp, long& kld, const bf16_t*& vp, long& vld) { int tt = t_first + t; int tok = bk_tok(b, tt * 64);
            kp = DQ + (long)tok * 3 * MW + MW + h * 128 + 64; kld = 3 * MW; vp = DVT + ((long)b * MW + h * 128) * KEYS + tt * 64; vld = KEYS; };
        attn_core<NQT, 128>(lds, qrow, kt, ntiles, NoMask(), o2, l2);
    }
    const int tid2 = TID(), wid2 = tid2 >> 6, l15b = tid2 & 15, gb = (tid2 & 63) >> 4; bf16_t* Yo = WSP(bf16_t, OFF_Y);
    float lam, lam_init; diff_lambda(p, l, lam, lam_init);
    const float* nw = GIN(p.diff_norm) + l * 128;
#pragma unroll
    for (int qt = 0; qt < NQT; ++qt) { float inv = lam / l2[qt]; float ss = 0.f;
#pragma unroll
        for (int dt = 0; dt < 8; ++dt) { f32x4 a = (f32x4){bflo(o1p[dt][qt].x), bfhi(o1p[dt][qt].x), bflo(o1p[dt][qt].y), bfhi(o1p[dt][qt].y)}; o2[dt][qt] = a - o2[dt][qt] * inv;
#pragma unroll
            for (int j = 0; j < 4; ++j) ss += o2[dt][qt][j] * o2[dt][qt][j]; }
        ss = xadd<16>(ss); ss = xadd<32>(ss);
        const float r = rsqrtf(ss * (1.0f / 128.0f) + RMS_EPS) * (1.0f - lam_init);
        const long row = tok_q0 + wid2 * NQT * 16 + qt * 16 + l15b;
#pragma unroll
        for (int dt = 0; dt < 8; ++dt) { F4 w = *(const F4*)(nw + dt * 16 + gb * 4); f32x4 v = o2[dt][qt];
            v[0] *= r * w.x; v[1] *= r * w.y; v[2] *= r * w.z; v[3] *= r * w.w;
            st4bf(Yo + row * 4 * MW + 2 * MW + h * 128 + dt * 16 + gb * 4, v); }
    }
}

struct NaMask {
    const float* rpb;
    int qr, rs, rs0, nct;
    int cidx[16];
    __device__ __forceinline__ float operator()(int t, int mt, int j, int, float s) const {
        if (t < nct) return s;
        const int kr = rs0 + (t - nct), ci = cidx[mt * 4 + j];
        const bool ok = (kr >= rs) && (kr < rs + 8) && (ci >= 0);
        int dr = kr - qr + 7; dr = dr < 0 ? 0 : (dr > 14 ? 14 : dr);
        return ok ? s + rpb[dr * 31 + (ci < 0 ? 0 : ci)] : NEG_BIG;
    }
};
__device__ __forceinline__ void na_attn_item(const Params& p, char* lds, int l, int b, int h, int rp) {
    const int tid = TID(), wid = tid >> 6, lane = tid & 63, l15 = lane & 15, g = lane >> 4;
    const bf16_t* NQ = WSP(bf16_t, OFF_SEG_NQKV); const bf16_t* NVT = WSP(bf16_t, OFF_NVT); bf16_t* Y = WSP(bf16_t, OFF_Y);
    float* rpb = (float*)(lds + AttnLds<64>::TOTAL);
    __syncthreads();
    for (int i = tid; i < 15 * 31; i += NTH) rpb[i] = GIN(p.na_rpb)[((long)(l * NH + h) * 15) * 31 + i] * LOG2E;
    const int r0 = rp * 2; int rs0 = r0 - 4; rs0 = rs0 < 0 ? 0 : (rs0 > R_ROWS - 8 ? R_ROWS - 8 : rs0);
    int nwin = R_ROWS - rs0; nwin = nwin > 9 ? 9 : nwin;
    constexpr int NCT = CTX / 64;
    NaMask mk; mk.rpb = rpb; mk.rs0 = rs0; mk.nct = NCT;
    { const int qi = wid * 16 + l15, qc = qi & 63; mk.qr = r0 + (wid >> 2);
        int rs = mk.qr - 4; mk.rs = rs < 0 ? 0 : (rs > R_ROWS - 8 ? R_ROWS - 8 : rs);
        int cs = qc - 8; cs = cs < 0 ? 0 : (cs > GW - 16 ? GW - 16 : cs);
#pragma unroll
        for (int mt = 0; mt < 4; ++mt)
#pragma unroll
            for (int j = 0; j < 4; ++j) { const int kc = mt * 16 + g * 4 + j; int dc = kc - qc; dc = dc < -15 ? -15 : (dc > 15 ? 15 : dc); mk.cidx[mt * 4 + j] = (kc >= cs && kc < cs + 16) ? dc + 15 : -1; } }
    const int tok_q0 = b * SEQ + r0 * 64;
    auto qrow = [&](int i) { return NQ + (long)(tok_q0 + i) * 3 * MW + h * 64; };
    auto kt = [&](int t, const bf16_t*& kp, long& kld, const bf16_t*& vp, long& vld) { int key = t < NCT ? SEQ + t * 64 : (rs0 + t - NCT) * 64; int tok = bk_tok(b, key);
        kp = NQ + (long)tok * 3 * MW + MW + h * 64; kld = 3 * MW; vp = NVT + ((long)b * MW + h * 64) * KEYS + key; vld = KEYS; };
    f32x4 o[4][1]; float ls[1];
    attn_core<1, 64>(lds, qrow, kt, NCT + nwin, mk, o, ls);
    const float inv = 1.0f / ls[0]; const long row = tok_q0 + wid * 16 + l15;
#pragma unroll
    for (int dt = 0; dt < 4; ++dt) { f32x4 v = o[dt][0] * inv; st4bf(Y + row * 4 * MW + 3 * MW + h * 64 + dt * 16 + g * 4, v); }
}
__device__ __forceinline__ void na_ctx_item(const Params& p, char* lds, int b, int h, int q0) {
    const int tid = TID(), wid = tid >> 6, lane = tid & 63, l15 = lane & 15, g = lane >> 4;
    const bf16_t* NQ = WSP(bf16_t, OFF_SEG_NQKV); const bf16_t* NVT = WSP(bf16_t, OFF_NVT); bf16_t* Y = WSP(bf16_t, OFF_Y);
    const int tok_q0 = NLAT + b * CTX + q0;
    auto qrow = [&](int i) { return NQ + (long)(tok_q0 + i) * 3 * MW + h * 64; };
    auto kt = [&](int t, const bf16_t*& kp, long& kld, const bf16_t*& vp, long& vld) { int key = SEQ + t * 64; int tok = bk_tok(b, key);
        kp = NQ + (long)tok * 3 * MW + MW + h * 64; kld = 3 * MW; vp = NVT + ((long)b * MW + h * 64) * KEYS + key; vld = KEYS; };
    f32x4 o[4][1]; float ls[1];
    attn_core<1, 64>(lds, qrow, kt, CTX / 64, NoMask(), o, ls);
    const float inv = 1.0f / ls[0]; const long row = tok_q0 + wid * 16 + l15;
#pragma unroll
    for (int dt = 0; dt < 4; ++dt) { f32x4 v = o[dt][0] * inv; st4bf(Y + row * 4 * MW + 3 * MW + h * 64 + dt * 16 + g * 4, v); }
}

#define MFMA32(a, b, c) __builtin_amdgcn_mfma_f32_32x32x16_bf16(a, b, c, 0, 0, 0)
#ifndef CPU_EMU
typedef float f32x16 __attribute__((ext_vector_type(16)));
#endif
constexpr int D32_KT = 128;
constexpr int D32_KLD = 80, D32_VLD = D32_KT + 8;
constexpr int D32_KB = D32_KT * D32_KLD * 2, D32_VB = 128 * D32_VLD * 2, D32_STAGE = D32_KB + D32_VB, D32_TOTAL = 2 * D32_STAGE;
static_assert(D32_TOTAL <= 160 * 1024 - 64 && KEYS % D32_KT == 0, "diff32 lds");

__device__ __forceinline__ void diff32_pass(char* lds, const bf16_t* qp  , const bf16_t* kbase  ,
                                            const bf16_t* vbase  , int b, f32x16 (&oacc)[4], float& lsum) {
    const int tid = TID(), lane = tid & 63, r32 = lane & 31, hh = lane >> 5;
    bf16x8 qf[4];
#pragma unroll
    for (int ks = 0; ks < 4; ++ks) qf[ks] = ld8(qp + ks * 16 + hh * 8);
#pragma unroll
    for (int dt = 0; dt < 4; ++dt)
#pragma unroll
        for (int r = 0; r < 16; ++r) oacc[dt][r] = 0.f;
    float mrun = -64.0f; lsum = 0.f;
    f32x16 cinit;
#pragma unroll
    for (int r = 0; r < 16; ++r) cinit[r] = -mrun;
    const int sr = tid >> 3, ss = tid & 7, vr_ = tid >> 4, vs = tid & 15;
    U4 rk[2], rv[4];
    constexpr int NT = KEYS / D32_KT;
    auto gload = [&](int t) { const long tok = bk_tok(b, t * D32_KT);
#pragma unroll
        for (int i = 0; i < 2; ++i) rk[i] = *(const U4*)(kbase + (tok + sr + 64 * i) * 3 * MW + ss * 8);
#pragma unroll
        for (int i = 0; i < 4; ++i) rv[i] = *(const U4*)(vbase + (long)(vr_ + 32 * i) * KEYS + t * D32_KT + vs * 8); };
    auto sstore = [&](int st) { bf16_t* sK = (bf16_t*)(lds + st * D32_STAGE); bf16_t* sV = (bf16_t*)(lds + st * D32_STAGE + D32_KB);
#pragma unroll
        for (int i = 0; i < 2; ++i) *(U4*)(sK + (sr + 64 * i) * D32_KLD + ss * 8) = rk[i];
#pragma unroll
        for (int i = 0; i < 4; ++i) { bf16_t* d = sV + (vr_ + 32 * i) * D32_VLD + (vs >> 1) * 16 + (vs & 1) * 4; *(U2*)d = (U2){rv[i].x, rv[i].y}; *(U2*)(d + 8) = (U2){rv[i].z, rv[i].w}; } };
    gload(0);
    __syncthreads();
    sstore(0);
    __syncthreads();
    for (int t = 0; t < NT; ++t) {
        const bool more = t + 1 < NT;
        if (more) gload(t + 1);
#pragma unroll 1
        for (int sub = 0; sub < 2; ++sub) {
        const bf16_t* sK = (const bf16_t*)(lds + (t & 1) * D32_STAGE) + sub * 64 * D32_KLD; const bf16_t* sV = (const bf16_t*)(lds + (t & 1) * D32_STAGE + D32_KB) + sub * 64;
        f32x16 s[2];
        {
            bf16x8 kf[2][4];
#pragma unroll
            for (int kt = 0; kt < 2; ++kt)
#pragma unroll
                for (int ks = 0; ks < 4; ++ks) kf[kt][ks] = ld8(sK + (kt * 32 + r32) * D32_KLD + ks * 16 + hh * 8);
            SCHED_FENCE();
#pragma unroll
            for (int kt = 0; kt < 2; ++kt) {
                s[kt] = MFMA32(kf[kt][0], qf[0], cinit);
#pragma unroll
                for (int ks = 1; ks < 4; ++ks) s[kt] = MFMA32(kf[kt][ks], qf[ks], s[kt]);
            }
        }
        float mx = -3.0e38f;
#pragma unroll
        for (int kt = 0; kt < 2; ++kt)
#pragma unroll
            for (int r = 0; r < 16; ++r) mx = fmaxf(mx, s[kt][r]);
        mx = xmax<32>(mx);
        if (__ballot(mx > 6.0f) != 0ull) {
            const float d = fmaxf(mx, 0.f), alpha = fexp2(-d);
            mrun += d; lsum *= alpha;
#pragma unroll
            for (int r = 0; r < 16; ++r) cinit[r] = -mrun;
#pragma unroll
            for (int kt = 0; kt < 2; ++kt)
#pragma unroll
                for (int r = 0; r < 16; ++r) s[kt][r] -= d;
#pragma unroll
            for (int dt = 0; dt < 4; ++dt) oacc[dt] *= alpha;
        }
        float ps = 0.f;
#pragma unroll
        for (int kt = 0; kt < 2; ++kt)
#pragma unroll
            for (int r = 0; r < 16; ++r) { float pv = fexp2(s[kt][r]); s[kt][r] = pv; ps += pv; }
        lsum += ps;
        {
            bf16x8 va[4], vb[4];
#define D32_LDV(dst, kt, sx) _Pragma("unroll") for (int dt = 0; dt < 4; ++dt) { dst[dt] = ld8(sV + (dt * 32 + r32) * D32_VLD + (kt) * 32 + (sx) * 16 + hh * 8); }
#define D32_PF(kt, sx) mk8u(pack2(s[kt][8 * (sx)], s[kt][8 * (sx) + 1]), pack2(s[kt][8 * (sx) + 2], s[kt][8 * (sx) + 3]), pack2(s[kt][8 * (sx) + 4], s[kt][8 * (sx) + 5]), pack2(s[kt][8 * (sx) + 6], s[kt][8 * (sx) + 7]))
#define D32_MMA(src, pf) _Pragma("unroll") for (int dt = 0; dt < 4; ++dt) oacc[dt] = MFMA32(src[dt], pf, oacc[dt]);
            D32_LDV(va, 0, 0) D32_LDV(vb, 0, 1)
            const bf16x8 p0 = D32_PF(0, 0), p1 = D32_PF(0, 1), p2 = D32_PF(1, 0), p3 = D32_PF(1, 1);
            SCHED_FENCE();
            D32_MMA(va, p0) D32_LDV(va, 1, 0)
            SCHED_FENCE();
            D32_MMA(vb, p1) D32_LDV(vb, 1, 1)
            SCHED_FENCE();
            D32_MMA(va, p2)
            D32_MMA(vb, p3)
#undef D32_LDV
#undef D32_PF
#undef D32_MMA
        }
        }
        if (more) sstore((t + 1) & 1);
        __syncthreads();
    }
    lsum = xadd<32>(lsum);
}

__device__ __forceinline__ void diff32_item(const Params& p, char* lds, int l, int b, int h, int q0, int comp) {
    const int tid = TID(), wid = tid >> 6, lane = tid & 63, r32 = lane & 31, hh = lane >> 5;
    const bf16_t* DQ = WSP(bf16_t, OFF_SEG_DQKV); const bf16_t* DVT = WSP(bf16_t, OFF_DVT);
    const long qtok = (long)b * SEQ + q0 + wid * 32 + r32;
    f32x16 oacc[4]; float ls;
    diff32_pass(lds, DQ + qtok * 3 * MW + h * 128 + comp * 64, DQ + MW + h * 128 + comp * 64, DVT + ((long)b * MW + h * 128) * KEYS, b, oacc, ls);
    bf16_t* Yo = WSP(bf16_t, OFF_Y) + qtok * 4 * MW + (comp == 0 ? 2 * MW : 0) + h * 128;
    const float inv = 1.0f / ls;
#pragma unroll
    for (int dt = 0; dt < 4; ++dt)
#pragma unroll
        for (int q = 0; q < 4; ++q) { const int dv = dt * 32 + 8 * q + 4 * hh;
            st4bf(Yo + dv, (f32x4){oacc[dt][4 * q] * inv, oacc[dt][4 * q + 1] * inv, oacc[dt][4 * q + 2] * inv, oacc[dt][4 * q + 3] * inv}); }
}

constexpr int N32_VLD = 72;
constexpr int N32_KB = 64 * D32_KLD * 2, N32_VB = 64 * N32_VLD * 2, N32_STAGE = N32_KB + N32_VB, N32_RPB = 2 * N32_STAGE;
static_assert(R_ROWS % 4 == 0 && GW == 64 && N32_RPB + 16 * 128 * 4 <= 100 * 1024, "na32");
__device__ __forceinline__ void na32_item(const Params& p, char* lds, int l, int b, int h, int rq) {
    const int tid = TID(), wid = tid >> 6, lane = tid & 63, r32 = lane & 31, hh = lane >> 5;
    const bf16_t* NQ = WSP(bf16_t, OFF_SEG_NQKV); const bf16_t* NVT = WSP(bf16_t, OFF_NVT);
    float* rpb = (float*)(lds + N32_RPB);
    __syncthreads();
    for (int i = tid; i < 16 * 128; i += NTH) { const int dr = i >> 7, c = (i & 127) - 48;
        rpb[i] = dr == 15 ? NEG_BIG : ((c >= 0 && c < 31) ? GIN(p.na_rpb)[((long)(l * NH + h) * 15 + dr) * 31 + c] * LOG2E : 0.f); }
    constexpr int NCT = CTX / 64;
    const int r0 = rq * 4, qr = r0 + (wid >> 1), qc = (wid & 1) * 32 + r32;
    int rs0 = r0 - 4; rs0 = rs0 < 0 ? 0 : (rs0 > R_ROWS - 8 ? R_ROWS - 8 : rs0);
    int rsl = r0 - 1; rsl = rsl < 0 ? 0 : (rsl > R_ROWS - 8 ? R_ROWS - 8 : rsl);
    const int NT = NCT + (rsl + 8 - rs0);
    int rs = qr - 4; rs = rs < 0 ? 0 : (rs > R_ROWS - 8 ? R_ROWS - 8 : rs);
    int cs = qc - 8; cs = cs < 0 ? 0 : (cs > GW - 16 ? GW - 16 : cs);
    const long qtok = (long)b * SEQ + qr * 64 + qc;
    bf16x8 qf[4];
    { const bf16_t* qp = NQ + qtok * 3 * MW + h * 64; constexpr float sc = 0.125f * LOG2E;
#pragma unroll
        for (int ks = 0; ks < 4; ++ks) { const U4 r = *(const U4*)(qp + ks * 16 + hh * 8);
            qf[ks] = mk8u(pack2(bflo(r.x) * sc, bfhi(r.x) * sc), pack2(bflo(r.y) * sc, bfhi(r.y) * sc), pack2(bflo(r.z) * sc, bfhi(r.z) * sc), pack2(bflo(r.w) * sc, bfhi(r.w) * sc)); } }
    f32x16 oacc[2];
#pragma unroll
    for (int dt = 0; dt < 2; ++dt)
#pragma unroll
        for (int r = 0; r < 16; ++r) oacc[dt][r] = 0.f;
    float mrun = -64.0f, lsum = 0.f;
    f32x16 cplain, cm[2];
#pragma unroll
    for (int r = 0; r < 16; ++r) cplain[r] = -mrun;
#pragma unroll
    for (int kt = 0; kt < 2; ++kt)
#pragma unroll
        for (int r = 0; r < 16; ++r) { const int kc = kt * 32 + (r & 3) + 8 * (r >> 2) + 4 * hh; cm[kt][r] = (kc >= cs && kc < cs + 16) ? -mrun : NEG_BIG; }
    const int sr = tid >> 3, ss = tid & 7;
    const bf16_t* kbase = NQ + MW + h * 64; const bf16_t* vbase = NVT + ((long)b * MW + h * 64) * KEYS;
    U4 rk, rv;
    auto gload = [&](int t) { const int key = t < NCT ? SEQ + t * 64 : (rs0 + t - NCT) * 64; const long tok = bk_tok(b, key);
        rk = *(const U4*)(kbase + (tok + sr) * 3 * MW + ss * 8); rv = *(const U4*)(vbase + (long)sr * KEYS + key + ss * 8); };
    auto sstore = [&](int st) { bf16_t* sK = (bf16_t*)(lds + st * N32_STAGE); bf16_t* sV = (bf16_t*)(lds + st * N32_STAGE + N32_KB);
        *(U4*)(sK + sr * D32_KLD + ss * 8) = rk; bf16_t* d = sV + sr * N32_VLD + (ss >> 1) * 16 + (ss & 1) * 4; *(U2*)d = (U2){rv.x, rv.y}; *(U2*)(d + 8) = (U2){rv.z, rv.w}; };
    gload(0);
    __syncthreads();
    sstore(0);
    __syncthreads();
    for (int t = 0; t < NT; ++t) {
        const bool more = t + 1 < NT;
        if (more) gload(t + 1);
        const bf16_t* sK = (const bf16_t*)(lds + (t & 1) * N32_STAGE); const bf16_t* sV = (const bf16_t*)(lds + (t & 1) * N32_STAGE + N32_KB);
        f32x16 s[2];
        {
            bf16x8 kf[2][4];
#pragma unroll
            for (int kt = 0; kt < 2; ++kt)
#pragma unroll
                for (int ks = 0; ks < 4; ++ks) kf[kt][ks] = ld8(sK + (kt * 32 + r32) * D32_KLD + ks * 16 + hh * 8);
            SCHED_FENCE();
            if (t < NCT) {
#pragma unroll
                for (int kt = 0; kt < 2; ++kt) { s[kt] = MFMA32(kf[kt][0], qf[0], cplain);
#pragma unroll
                    for (int ks = 1; ks < 4; ++ks) s[kt] = MFMA32(kf[kt][ks], qf[ks], s[kt]); }
            } else {
                const int kr = rs0 + t - NCT; const int rsel = (kr >= rs && kr < rs + 8) ? kr - qr + 7 : 15;
                const float* bp = rpb + rsel * 128 + (4 * hh - qc + 63);
#pragma unroll
                for (int kt = 0; kt < 2; ++kt) { s[kt] = MFMA32(kf[kt][0], qf[0], cm[kt]);
#pragma unroll
                    for (int ks = 1; ks < 4; ++ks) s[kt] = MFMA32(kf[kt][ks], qf[ks], s[kt]); }
#pragma unroll
                for (int kt = 0; kt < 2; ++kt)
#pragma unroll
                    for (int r = 0; r < 16; ++r) s[kt][r] += bp[kt * 32 + (r & 3) + 8 * (r >> 2)];
            }
        }
        float mx = -3.0e38f;
#pragma unroll
        for (int kt = 0; kt < 2; ++kt)
#pragma unroll
            for (int r = 0; r < 16; ++r) mx = fmaxf(mx, s[kt][r]);
        mx = xmax<32>(mx);
        if (__ballot(mx > 6.0f) != 0ull) {
            const float d = fmaxf(mx, 0.f), alpha = fexp2(-d);
            mrun += d; lsum *= alpha;
#pragma unroll
            for (int r = 0; r < 16; ++r) cplain[r] = -mrun;
#pragma unroll
            for (int kt = 0; kt < 2; ++kt)
#pragma unroll
                for (int r = 0; r < 16; ++r) { cm[kt][r] -= d; s[kt][r] -= d; }
#pragma unroll
            for (int dt = 0; dt < 2; ++dt) oacc[dt] *= alpha;
        }
        float ps = 0.f;
#pragma unroll
        for (int kt = 0; kt < 2; ++kt)
#pragma unroll
            for (int r = 0; r < 16; ++r) { float pv = fexp2(s[kt][r]); s[kt][r] = pv; ps += pv; }
        lsum += ps;
        {
            bf16x8 va[2], vb[2];
#define N32_LDV(dst, kt, sx) _Pragma("unroll") for (int dt = 0; dt < 2; ++dt) { dst[dt] = ld8(sV + (dt * 32 + r32) * N32_VLD + (kt) * 32 + (sx) * 16 + hh * 8); }
#define N32_PF(kt, sx) mk8u(pack2(s[kt][8 * (sx)], s[kt][8 * (sx) + 1]), pack2(s[kt][8 * (sx) + 2], s[kt][8 * (sx) + 3]), pack2(s[kt][8 * (sx) + 4], s[kt][8 * (sx) + 5]), pack2(s[kt][8 * (sx) + 6], s[kt][8 * (sx) + 7]))
#define N32_MMA(src, pf) _Pragma("unroll") for (int dt = 0; dt < 2; ++dt) oacc[dt] = MFMA32(src[dt], pf, oacc[dt]);
            N32_LDV(va, 0, 0) N32_LDV(vb, 0, 1)
            const bf16x8 p0 = N32_PF(0, 0), p1 = N32_PF(0, 1), p2 = N32_PF(1, 0), p3 = N32_PF(1, 1);
            SCHED_FENCE();
            N32_MMA(va, p0) N32_LDV(va, 1, 0)
            SCHED_FENCE();
            N32_MMA(vb, p1) N32_LDV(vb, 1, 1)
            SCHED_FENCE();
            N32_MMA(va, p2)
            N32_MMA(vb, p3)
#undef N32_LDV
#undef N32_PF
#undef N32_MMA
        }
        if (more) sstore((t + 1) & 1);
        __syncthreads();
    }
    lsum = xadd<32>(lsum);
    const int tid2 = TID(), lane2 = tid2 & 63, wid2 = tid2 >> 6;
    bf16_t* Yo = WSP(bf16_t, OFF_Y) + ((long)b * SEQ + (r0 + (wid2 >> 1)) * 64 + (wid2 & 1) * 32 + (lane2 & 31)) * 4 * MW + 3 * MW + h * 64;
    const float inv = 1.0f / lsum;
#pragma unroll
    for (int dt = 0; dt < 2; ++dt)
#pragma unroll
        for (int q = 0; q < 4; ++q) { const int dv = dt * 32 + 8 * q + 4 * (lane2 >> 5);
            st4bf(Yo + dv, (f32x4){oacc[dt][4 * q] * inv, oacc[dt][4 * q + 1] * inv, oacc[dt][4 * q + 2] * inv, oacc[dt][4 * q + 3] * inv}); }
}
static_assert(NTASK_GDN % 4 == 0, "gdn tasks");
__device__ __forceinline__ void gdn_decode(int chain, int n, int& b, int& h, int& dir, int& base, int& T, int& c) {
    dir = chain & 1; int bh = chain >> 1; h = bh % GH; b = bh / GH;
    if (n < NCH_CTX) { base = NLAT + b * CTX; T = CTX; c = n; } else { base = b * SEQ; T = SEQ; c = n - NCH_CTX; }
}
__device__ __forceinline__ int gdn_pos(int dir, int T, int c, int i) { int r = 64 * c + i; return dir ? T - 1 - r : r; }

constexpr int GP_K = 0, GP_V = 10240, GP_AB = 20480, GP_AD = 30720, GP_XT = GP_AD + 4 * 16 * 16 * 4, GP_R = GP_XT + 128 * 80 * 2, GP_F = GP_R + 16 * 132 * 4, GP_TASK = GP_F + 1024;
static_assert(2 * GP_TASK <= 160 * 1024 - 64 && NTASK_GDN % 2 == 0, "gdn prep lds");
__device__ __forceinline__ void gdn_chunk_prep2(const Params& p, char* lds, int l, int task0) {
    const int tid = TID(), wid = tid >> 6, lane = tid & 63, l15 = lane & 15, g = lane >> 4, tk = wid >> 2, w4 = wid & 3, t4 = tid & 255;
    const int task = task0 + tk, chain = task / NCH, n = task - chain * NCH;
    int b, h, dir, base, T, c; gdn_decode(chain, n, b, h, dir, base, T, c);
    char* L = lds + tk * GP_TASK;
    bf16_t* Kt = (bf16_t*)(L + GP_K); bf16_t* Vt = (bf16_t*)(L + GP_V); bf16_t* Ab = (bf16_t*)(L + GP_AB); float* Ad = (float*)(L + GP_AD); bf16_t* XT = (bf16_t*)(L + GP_XT); float* R = (float*)(L + GP_R);
    float* gcs = (float*)(L + GP_F); float* bet = gcs + 64; float* fac = gcs + 128;
    const bf16_t* GK = WSP(bf16_t, OFF_GK); const bf16_t* GV = WSP(bf16_t, OFF_GV); const float* GB = WSP(float, OFF_GB);
    __syncthreads();
#pragma unroll
    for (int q = 0; q < 2; ++q) { int pc = t4 + 256 * q, i = pc >> 3, s = pc & 7; long tok = base + gdn_pos(dir, T, c, i);
        *(U4*)(Kt + i * 80 + s * 8) = *(const U4*)(GK + tok * MW + h * 64 + s * 8);
        *(U4*)(Vt + i * 80 + s * 8) = *(const U4*)(GV + tok * MW + h * 64 + s * 8); }
    for (int i = t4; i < 128 * 80 / 8; i += 256) *(U4*)(XT + i * 8) = (U4){0u, 0u, 0u, 0u};
    if (w4 == 0) { long tok = base + gdn_pos(dir, T, c, lane); float gi = GB[tok * 4 * GH + dir * GH + h], be = GB[tok * 4 * GH + 2 * GH + dir * GH + h];
        float cs = gi;
        for (int o = 1; o < 64; o <<= 1) { float t = __shfl_up(cs, o); if (lane >= o) cs += t; }
        gcs[lane] = cs; bet[lane] = be; fac[lane] = be * __expf(cs); }
    __syncthreads();
    { const int mt = w4; const int i = mt * 16 + l15; const float bi = bet[i], gi = gcs[i];
        bf16x8 bfr[2];
#pragma unroll
        for (int ks = 0; ks < 2; ++ks) bfr[ks] = ld8(Kt + (mt * 16 + l15) * 80 + ks * 32 + g * 8);
        for (int nt = 0; nt <= mt; ++nt) { f32x4 acc = (f32x4){0.f, 0.f, 0.f, 0.f};
#pragma unroll
            for (int ks = 0; ks < 2; ++ks) acc = MFMA16(ld8(Kt + (nt * 16 + l15) * 80 + ks * 32 + g * 8), bfr[ks], acc);
            float v[4];
#pragma unroll
            for (int jj = 0; jj < 4; ++jj) { const int j = nt * 16 + g * 4 + jj; v[jj] = j < i ? bi * acc[jj] * __expf(gi - gcs[j]) : 0.f; }
            if (nt < mt) *(U2*)(Ab + i * 80 + nt * 16 + g * 4) = (U2){pack2(v[0], v[1]), pack2(v[2], v[3])};
            else { *(U2*)(Ab + i * 80 + nt * 16 + g * 4) = (U2){0u, 0u}; *(F4*)(Ad + (mt * 16 + l15) * 16 + g * 4) = (F4){v[0], v[1], v[2], v[3]}; } }
    }
    __syncthreads();
    const bool wcol = t4 < 64; const int cc = t4 & 63;
    const bf16_t* src = wcol ? Kt : Vt; const float* scl = wcol ? fac : bet;
    bf16_t* dst = WSP(bf16_t, OFF_WU) + ((long)task * 2 + (wcol ? 0 : 1)) * 4096 + cc;
#pragma unroll
    for (int I = 0; I < 4; ++I) {
        if (I > 0) {
#pragma unroll
            for (int q = 0; q < 2; ++q) { const int nt = w4 * 2 + q; f32x4 acc = (f32x4){0.f, 0.f, 0.f, 0.f};
                acc = MFMA16(ld8(Ab + (I * 16 + l15) * 80 + g * 8), ld8(XT + (nt * 16 + l15) * 80 + g * 8), acc);
                if (I == 3) acc = MFMA16(ld8(Ab + (I * 16 + l15) * 80 + 32 + g * 8), ld8(XT + (nt * 16 + l15) * 80 + 32 + g * 8), acc);
#pragma unroll
                for (int jj = 0; jj < 4; ++jj) R[(g * 4 + jj) * 132 + nt * 16 + l15] = acc[jj]; }
            __syncthreads();
        }
        if (t4 < 128) {
            float x[16];
#pragma unroll
            for (int ii = 0; ii < 16; ++ii) { float a = scl[I * 16 + ii] * bf2f(src[(I * 16 + ii) * 80 + cc]); if (I > 0) a -= R[ii * 132 + t4];
#pragma unroll
                for (int jj = 0; jj < ii; ++jj) a -= Ad[(I * 16 + ii) * 16 + jj] * x[jj];
                x[ii] = a; }
            *(U4*)(XT + t4 * 80 + I * 16) = (U4){pack2(x[0], x[1]), pack2(x[2], x[3]), pack2(x[4], x[5]), pack2(x[6], x[7])};
            *(U4*)(XT + t4 * 80 + I * 16 + 8) = (U4){pack2(x[8], x[9]), pack2(x[10], x[11]), pack2(x[12], x[13]), pack2(x[14], x[15])};
#pragma unroll
            for (int ii = 0; ii < 16; ++ii) dst[(I * 16 + ii) * 64] = f2bf(x[ii]);
        }
        __syncthreads();
    }
}

constexpr int GS_W = 0, GS_Q = 10240, GS_K = 20480, GS_KT = 30720, GS_GC = 40960, GS_STAGE = 40960 + 512;
constexpr int GS_ST = 2 * GS_STAGE, GS_VNT = GS_ST + 2 * 5120, GS_VNT2 = GS_VNT + 5120, GS_ATT = GS_VNT2 + 5120, GS_TOTAL = GS_ATT + 10240;
__device__ __forceinline__ void gdn_scan_item(const Params& p, char* lds, int l, int cb) {
    const int tid = TID(), wid = tid >> 6, lane = tid & 63, l15 = lane & 15, g = lane >> 4, mt = wid >> 1, nt = wid & 1;
    {
    const int chain = cb >> 1, half = cb & 1;
    const bf16_t* GQ = WSP(bf16_t, OFF_GQ); const bf16_t* GK = WSP(bf16_t, OFF_GK); const float* GB = WSP(float, OFF_GB); const bf16_t* WU = WSP(bf16_t, OFF_WU);
    const int sr = tid >> 3, ss = tid & 7;
    f32x4 sacc = (f32x4){0.f, 0.f, 0.f, 0.f};
    U4 rw, rq, rk; float ucur[4], unext[4]; float gnext = 0.f;
    auto load_chunk = [&](int n) {
        int b, h, dir, base, T, c; gdn_decode(chain, n, b, h, dir, base, T, c);
        const long task = (long)chain * NCH + n; const long tok = base + gdn_pos(dir, T, c, sr);
        rw = *(const U4*)(WU + (task * 2 + 0) * 4096 + sr * 64 + ss * 8);
        rq = *(const U4*)(GQ + tok * MW + h * 64 + ss * 8);
        rk = *(const U4*)(GK + tok * MW + h * 64 + ss * 8);
#pragma unroll
        for (int j = 0; j < 4; ++j) unext[j] = bf2f(WU[(task * 2 + 1) * 4096 + (mt * 16 + g * 4 + j) * 64 + half * 32 + nt * 16 + l15]);
        if (wid == 0) { const long tk = base + gdn_pos(dir, T, c, lane); gnext = GB[tk * 4 * GH + dir * GH + h]; }
    };
    auto store_chunk = [&](int st) {
        char* S = lds + st * GS_STAGE;
        *(U4*)((bf16_t*)(S + GS_W) + sr * 80 + ss * 8) = rw;
        *(U4*)((bf16_t*)(S + GS_Q) + sr * 80 + ss * 8) = rq;
        *(U4*)((bf16_t*)(S + GS_K) + sr * 80 + ss * 8) = rk;
        bf16_t* KT = (bf16_t*)(S + GS_KT);
        const u32 kw[4] = {rk.x, rk.y, rk.z, rk.w};
#pragma unroll
        for (int e = 0; e < 4; ++e) { KT[(ss * 8 + 2 * e) * 80 + sr] = (bf16_t)(kw[e] & 0xffffu); KT[(ss * 8 + 2 * e + 1) * 80 + sr] = (bf16_t)(kw[e] >> 16); }
        if (wid == 0) { float cs = gnext;
            for (int o = 1; o < 64; o <<= 1) { float t = __shfl_up(cs, o); if (lane >= o) cs += t; }
            ((float*)(S + GS_GC))[lane] = cs; }
    };
    __syncthreads();
    { bf16_t* ST0 = (bf16_t*)(lds + GS_ST); for (int i = tid; i < 32 * 80; i += NTH) ST0[i] = 0; }
    load_chunk(0); store_chunk(0);
#pragma unroll
    for (int j = 0; j < 4; ++j) ucur[j] = unext[j];
    __syncthreads();
    for (int n = 0; n < NCH; ++n) {
        const int st = n & 1;
        if (n + 1 < NCH) load_chunk(n + 1);
        const char* S = lds + st * GS_STAGE;
        const bf16_t* Wt = (const bf16_t*)(S + GS_W); const bf16_t* Qt = (const bf16_t*)(S + GS_Q); const bf16_t* Kt = (const bf16_t*)(S + GS_K); const bf16_t* KT = (const bf16_t*)(S + GS_KT);
        const float* gc = (const float*)(S + GS_GC);
        const bf16_t* STc = (const bf16_t*)(lds + GS_ST + st * 5120); bf16_t* STn = (bf16_t*)(lds + GS_ST + (st ^ 1) * 5120);
        bf16_t* VNT = (bf16_t*)(lds + GS_VNT); bf16_t* VNT2 = (bf16_t*)(lds + GS_VNT2); bf16_t* ATT = (bf16_t*)(lds + GS_ATT);
        const float gl = gc[63];
#pragma unroll
        for (int q = 0; q < 2; ++q) { const int tile = wid * 2 + q, it = tile >> 2, jt = tile & 3;
            f32x4 acc = (f32x4){0.f, 0.f, 0.f, 0.f};
            if (jt <= it) {
#pragma unroll
                for (int ks = 0; ks < 2; ++ks) acc = MFMA16(ld8(Kt + (jt * 16 + l15) * 80 + ks * 32 + g * 8), ld8(Qt + (it * 16 + l15) * 80 + ks * 32 + g * 8), acc);
            }
            const int i = it * 16 + l15; const float gi = gc[i]; float v[4];
#pragma unroll
            for (int j = 0; j < 4; ++j) { const int jp = jt * 16 + g * 4 + j; v[j] = jp <= i ? acc[j] * __expf(gi - gc[jp]) : 0.f; }
            U2 o; o.x = pack2(v[0], v[1]); o.y = pack2(v[2], v[3]); *(U2*)(ATT + i * 80 + jt * 16 + g * 4) = o; }
        {
            f32x4 acc = (f32x4){0.f, 0.f, 0.f, 0.f};
#pragma unroll
            for (int ks = 0; ks < 2; ++ks) acc = MFMA16(ld8(Wt + (mt * 16 + l15) * 80 + ks * 32 + g * 8), ld8(STc + (nt * 16 + l15) * 80 + ks * 32 + g * 8), acc);
            float vn[4], vn2[4];
#pragma unroll
            for (int j = 0; j < 4; ++j) { vn[j] = ucur[j] - acc[j]; vn2[j] = vn[j] * __expf(gl - gc[mt * 16 + g * 4 + j]); }
            U2 o; o.x = pack2(vn[0], vn[1]); o.y = pack2(vn[2], vn[3]); *(U2*)(VNT + (nt * 16 + l15) * 80 + mt * 16 + g * 4) = o;
            U2 o2; o2.x = pack2(vn2[0], vn2[1]); o2.y = pack2(vn2[2], vn2[3]); *(U2*)(VNT2 + (nt * 16 + l15) * 80 + mt * 16 + g * 4) = o2;
        }
        __syncthreads();
        {
            f32x4 a1 = (f32x4){0.f, 0.f, 0.f, 0.f}, a2 = (f32x4){0.f, 0.f, 0.f, 0.f};
#pragma unroll
            for (int ks = 0; ks < 2; ++ks) { a1 = MFMA16(ld8(Qt + (mt * 16 + l15) * 80 + ks * 32 + g * 8), ld8(STc + (nt * 16 + l15) * 80 + ks * 32 + g * 8), a1);
                a2 = MFMA16(ld8(ATT + (mt * 16 + l15) * 80 + ks * 32 + g * 8), ld8(VNT + (nt * 16 + l15) * 80 + ks * 32 + g * 8), a2); }
            int b, h, dir, base, T, c; gdn_decode(chain, n, b, h, dir, base, T, c);
            bf16_t* O = WSP(bf16_t, dir ? OFF_OB : OFF_OF);
#pragma unroll
            for (int j = 0; j < 4; ++j) { const int i = mt * 16 + g * 4 + j; const long tok = base + gdn_pos(dir, T, c, i);
                O[tok * MW + h * 64 + half * 32 + nt * 16 + l15] = f2bf(__expf(gc[i]) * a1[j] + a2[j]); }
        }
        {
            f32x4 acc = sacc * __expf(gl);
#pragma unroll
            for (int ks = 0; ks < 2; ++ks) acc = MFMA16(ld8(KT + (mt * 16 + l15) * 80 + ks * 32 + g * 8), ld8(VNT2 + (nt * 16 + l15) * 80 + ks * 32 + g * 8), acc);
            sacc = acc;
            U2 o; o.x = pack2(acc[0], acc[1]); o.y = pack2(acc[2], acc[3]); *(U2*)(STn + (nt * 16 + l15) * 80 + mt * 16 + g * 4) = o;
        }
        if (n + 1 < NCH) { store_chunk(st ^ 1);
#pragma unroll
            for (int j = 0; j < 4; ++j) ucur[j] = unext[j]; }
        __syncthreads();
    }
    }
}
__device__ __forceinline__ int hy_phys(int p) { return p + ((p >> 6) << 2); }
constexpr int HY_X = 0, HY_T1 = (int)HY_XN * 8, HY_T2 = HY_T1 + 128 * 8, HY_W3 = HY_T2 + 128 * 8, HY_RED = HY_W3 + 2 * 64 * 4, HY_TOTAL = HY_RED + 64 * 4;
static_assert(HY_TOTAL <= 160 * 1024 - 64, "hyena lds");
#ifdef CPU_EMU
__device__ __forceinline__ F2 cmul(F2 a, F2 b) { return (F2){a.x * b.x - a.y * b.y, a.x * b.y + a.y * b.x}; }
__device__ __forceinline__ F2 cmulc(F2 a, F2 b) { return (F2){a.x * b.x + a.y * b.y, a.y * b.x - a.x * b.y}; }
__device__ __forceinline__ F2 add_mi(F2 a, F2 d) { return (F2){a.x + d.y, a.y - d.x}; }
__device__ __forceinline__ F2 sub_mi(F2 a, F2 d) { return (F2){a.x - d.y, a.y + d.x}; }
#else
__device__ __forceinline__ F2 cmul(F2 a, F2 b) { F2 t, r;
    asm("v_pk_mul_f32 %0, %1, %2 op_sel:[1,1] op_sel_hi:[1,0] neg_lo:[0,1]" : "=v"(t) : "v"(a), "v"(b));
    asm("v_pk_fma_f32 %0, %1, %2, %3 op_sel_hi:[0,1,1]" : "=v"(r) : "v"(a), "v"(b), "v"(t));
    return r; }
__device__ __forceinline__ F2 cmulc(F2 a, F2 b) { F2 t, r;
    asm("v_pk_mul_f32 %0, %1, %2 op_sel:[1,1] op_sel_hi:[1,0]" : "=v"(t) : "v"(a), "v"(b));
    asm("v_pk_fma_f32 %0, %1, %2, %3 op_sel_hi:[0,1,1] neg_hi:[0,1,0]" : "=v"(r) : "v"(a), "v"(b), "v"(t));
    return r; }
__device__ __forceinline__ F2 add_mi(F2 a, F2 d) { F2 r; asm("v_pk_add_f32 %0, %1, %2 op_sel:[0,1] op_sel_hi:[1,0] neg_hi:[0,1]" : "=v"(r) : "v"(a), "v"(d)); return r; }
__device__ __forceinline__ F2 sub_mi(F2 a, F2 d) { F2 r; asm("v_pk_add_f32 %0, %1, %2 op_sel:[0,1] op_sel_hi:[1,0] neg_lo:[0,1]" : "=v"(r) : "v"(a), "v"(d)); return r; }
#endif
__device__ __forceinline__ F2 twid(const F2* T1, const F2* T2, int q) { return cmul(T1[q >> 7], T2[q & 127]); }

constexpr int ilog2c(int n) { return n <= 1 ? 0 : 1 + ilog2c(n >> 1); }
__device__ __forceinline__ void bf4_fwd(F2& x0, F2& x1, F2& x2, F2& x3, F2 w1, F2 w2) {
    const F2 a0 = x0 + x2, a2 = cmul(x0 - x2, w1), a1 = x1 + x3, d = cmul(x1 - x3, w1);
    x0 = a0 + a1; x1 = cmul(a0 - a1, w2); x2 = add_mi(a2, d); x3 = cmul(sub_mi(a2, d), w2); }
__device__ __forceinline__ void bf4_inv(F2& y0, F2& y1, F2& y2, F2& y3, F2 w1, F2 w2) {
    F2 t = cmulc(y1, w2); const F2 a0 = y0 + t, a1 = y0 - t; t = cmulc(y3, w2); const F2 a2 = y2 + t, a3 = y2 - t;
    t = cmulc(a2, w1); y0 = a0 + t; y2 = a0 - t; const F2 u = cmulc(a3, w1); y1 = sub_mi(a1, u); y3 = add_mi(a1, u); }
#define W16_1 ((F2){0.9238795325112867f, -0.3826834323650898f})
#define W16_2 ((F2){0.7071067811865476f, -0.7071067811865476f})
#define W16_3 ((F2){0.3826834323650898f, -0.9238795325112867f})
struct LdsLd { static constexpr bool REGS = false; const F2* X; __device__ __forceinline__ F2 operator()(int p, int = 0) const { return X[p]; } };
struct LdsSt { static constexpr bool REGS = false; F2* X; __device__ __forceinline__ void operator()(int p, F2 v, int = 0) const { X[p] = v; } };
struct HfGlbSt { static constexpr bool REGS = false; F2* HF; __device__ __forceinline__ void operator()(int p, F2 v, int = 0) const { HF[p] = v; } };
struct HfGlbLd { static constexpr bool REGS = false; const F2* X; const F2* HF; __device__ __forceinline__ F2 operator()(int p, int = 0) const { return cmul(X[p], HF[p]); } };
struct HfRegSt { static constexpr bool REGS = true; F2 (&h)[20]; F2* HF; __device__ __forceinline__ void operator()(int p, F2 v, int slot) const { if (slot < 20) h[slot] = v; else HF[p] = v; } };
struct HfRegLd { static constexpr bool REGS = true; const F2* X; const F2 (&h)[20]; const F2* HF; __device__ __forceinline__ F2 operator()(int p, int slot) const { return cmul(X[p], slot < 20 ? h[slot] : HF[p]); } };
template <int N, int M, bool INV, class LD, class ST>
__device__ __forceinline__ void fft_r16(const F2* T1, const F2* T2, int tid, LD& ld, ST& st) {
    constexpr int q16 = M / 16, sh = N / M, NB = N / 16;
#pragma unroll
    for (int it_ = 0; it_ < (NB + NTH - 1) / NTH; ++it_) { const int idx = tid + it_ * NTH; if (NB % NTH != 0 && idx >= NB) break;
        const int blk = idx / q16, j = idx - blk * q16, p0 = blk * M + j, pp0 = hy_phys(p0);
        auto el = [&](int k) { if constexpr (q16 % 64 == 0) return pp0 + k * (q16 / 64 * 68); else if constexpr (M <= 64) return pp0 + k * q16; else return hy_phys(p0 + k * q16); };
        F2 e[16];
#pragma unroll
        for (int k = 0; k < 16; ++k) e[k] = ld(el(k));
        const F2 wa0 = twid(T1, T2, j * sh);
        const F2 wa1 = cmul(wa0, W16_1), wa2 = cmul(wa0, W16_2), wa3 = cmul(wa0, W16_3);
        const F2 wa0s = cmul(wa0, wa0); const F2 wb = cmul(wa0s, wa0s), wbs = cmul(wb, wb);
        if (!INV) {
            bf4_fwd(e[0], e[4], e[8], e[12], wa0, wa0s); bf4_fwd(e[1], e[5], e[9], e[13], wa1, cmul(wa1, wa1));
            bf4_fwd(e[2], e[6], e[10], e[14], wa2, cmul(wa2, wa2)); bf4_fwd(e[3], e[7], e[11], e[15], wa3, cmul(wa3, wa3));
#pragma unroll
            for (int c = 0; c < 4; ++c) bf4_fwd(e[4 * c], e[4 * c + 1], e[4 * c + 2], e[4 * c + 3], wb, wbs);
        } else {
#pragma unroll
            for (int c = 0; c < 4; ++c) bf4_inv(e[4 * c], e[4 * c + 1], e[4 * c + 2], e[4 * c + 3], wb, wbs);
            bf4_inv(e[0], e[4], e[8], e[12], wa0, wa0s); bf4_inv(e[1], e[5], e[9], e[13], wa1, cmul(wa1, wa1));
            bf4_inv(e[2], e[6], e[10], e[14], wa2, cmul(wa2, wa2)); bf4_inv(e[3], e[7], e[11], e[15], wa3, cmul(wa3, wa3));
        }
#pragma unroll
        for (int k = 0; k < 16; ++k) st(el(k), e[k]);
    }
    __syncthreads();
}
template <int N, int M, bool INV, class LD, class ST>
__device__ __forceinline__ void fft_r4(const F2* T1, const F2* T2, int tid, LD& ld, ST& st) {
    constexpr int q4 = M / 4, sh = N / M, NB = N / 4, NI = (NB + NTH - 1) / NTH;
    auto body = [&](int it_) { const int idx = tid + it_ * NTH;
        const int blk = idx / q4, j = idx - blk * q4, p0 = blk * M + j, pp0 = hy_phys(p0);
        auto el = [&](int k) { if constexpr (q4 % 64 == 0) return pp0 + k * (q4 / 64 * 68); else if constexpr (M <= 64) return pp0 + k * q4; else return hy_phys(p0 + k * q4); };
        F2 x0 = ld(el(0), it_ * 4), x1 = ld(el(1), it_ * 4 + 1), x2 = ld(el(2), it_ * 4 + 2), x3 = ld(el(3), it_ * 4 + 3);
        const F2 w1 = twid(T1, T2, j * sh), w2 = cmul(w1, w1);
        if (!INV) bf4_fwd(x0, x1, x2, x3, w1, w2); else bf4_inv(x0, x1, x2, x3, w1, w2);
        st(el(0), x0, it_ * 4); st(el(1), x1, it_ * 4 + 1); st(el(2), x2, it_ * 4 + 2); st(el(3), x3, it_ * 4 + 3); };
    if constexpr (LD::REGS || ST::REGS) { static_assert(NI * 4 == 32 && NB % NTH == 0, "register-resident hook: 32 slots");
#pragma unroll
        for (int it_ = 0; it_ < NI; ++it_) { body(it_); SCHED_FENCE(); }
    } else {
#pragma unroll
        for (int it_ = 0; it_ < NI; ++it_) { if (NB % NTH != 0 && tid + it_ * NTH >= NB) break; body(it_); }
    }
    __syncthreads();
}
template <int N, class LD, class ST>
__device__ __forceinline__ void fft_r2(int tid, LD& ld, ST& st) {
#pragma unroll
    for (int it_ = 0; it_ < ((N >> 1) + NTH - 1) / NTH; ++it_) { const int idx = tid + it_ * NTH; if ((N >> 1) % NTH != 0 && idx >= (N >> 1)) break;
        const int pp = hy_phys(2 * idx); const F2 x0 = ld(pp), x1 = ld(pp + 1); st(pp, x0 + x1); st(pp + 1, x0 - x1); }
    __syncthreads();
}
template <int N, int M> struct FftFwd16 { template <class LD, class ST> static __device__ __forceinline__ void run(F2* X, const F2* T1, const F2* T2, int tid, LD& ld0, ST& stl) {
    LdsLd ldx{X}; LdsSt stx{X};
    if constexpr (M >= 16) {
        constexpr bool first = (M == N), last = (M / 16 <= 1);
        if constexpr (first && last) fft_r16<N, M, false>(T1, T2, tid, ld0, stl); else if constexpr (first) fft_r16<N, M, false>(T1, T2, tid, ld0, stx);
        else if constexpr (last) fft_r16<N, M, false>(T1, T2, tid, ldx, stl); else fft_r16<N, M, false>(T1, T2, tid, ldx, stx);
        if constexpr (!last) FftFwd16<N, M / 16>::run(X, T1, T2, tid, ld0, stl); }
    else if constexpr (M == 8) { fft_r4<N, 8, false>(T1, T2, tid, ldx, stx); fft_r2<N>(tid, ldx, stl); }
    else if constexpr (M == 4) { fft_r4<N, 4, false>(T1, T2, tid, ldx, stl); }
    else if constexpr (M == 2) { fft_r2<N>(tid, ldx, stl); } } };
template <int N, int M> struct FftInv16 { template <class LD, class ST> static __device__ __forceinline__ void run(F2* X, const F2* T1, const F2* T2, int tid, LD& ld0, ST& stl) {
    LdsLd ldx{X}; LdsSt stx{X};
    if constexpr (M >= 16) {
        constexpr bool last = (M == N), first = (M / 16 <= 1);
        if constexpr (!first) FftInv16<N, M / 16>::run(X, T1, T2, tid, ld0, stl);
        if constexpr (first && last) fft_r16<N, M, true>(T1, T2, tid, ld0, stl); else if constexpr (first) fft_r16<N, M, true>(T1, T2, tid, ld0, stx);
        else if constexpr (last) fft_r16<N, M, true>(T1, T2, tid, ldx, stl); else fft_r16<N, M, true>(T1, T2, tid, ldx, stx); }
    else if constexpr (M == 8) { fft_r2<N>(tid, ld0, stx); fft_r4<N, 8, true>(T1, T2, tid, ldx, stx); }
    else if constexpr (M == 4) { fft_r4<N, 4, true>(T1, T2, tid, ld0, stx); }
    else if constexpr (M == 2) { fft_r2<N>(tid, ld0, stx); } } };
template <int N, class LD, class ST> __device__ __forceinline__ void fft_fwd(F2* X, const F2* T1, const F2* T2, int tid, LD& ld0, ST& stl) { static_assert(N >= 32, "fft"); FftFwd16<N, N>::run(X, T1, T2, tid, ld0, stl); }
template <int N, class LD, class ST> __device__ __forceinline__ void fft_inv(F2* X, const F2* T1, const F2* T2, int tid, LD& ld0, ST& stl) { FftInv16<N, N>::run(X, T1, T2, tid, ld0, stl); }

template <bool ctxs>
__device__ __forceinline__ void hyena_item(const Params& p, char* lds, int l, int ch) {
    const int tid = TID(), bid = BID(), lane = tid & 63, wid = tid >> 6;
    constexpr int L = ctxs ? CTX : SEQ, N = 2 * L, k0 = ctxs ? SEQ : 0;
    F2* X = (F2*)(lds + HY_X); F2* T1 = (F2*)(lds + HY_T1); F2* T2 = (F2*)(lds + HY_T2); float* red = (float*)(lds + HY_RED);
    const bf16_t* HYT = WSP(bf16_t, OFF_HYT);
    F2* HF = WSP(F2, OFF_HF) + (long)bid * HY_XN; float* ZT = WSP(float, OFF_ZT) + (long)bid * 2 * SEQ; bf16_t* YAT = WSP(bf16_t, OFF_YAT);
    __syncthreads();
    if (tid < 128) { float s, c; float a = -6.283185307179586f * (float)(tid * 128) / (float)N; s = sinf(a); c = cosf(a); T1[tid] = (F2){c, s}; }
    else if (tid < 256) { int b_ = tid - 128; float s, c; float a = -6.283185307179586f * (float)b_ / (float)N; s = sinf(a); c = cosf(a); T2[b_] = (F2){c, s}; }
    __syncthreads();
    const float* cwp = GIN(p.hy_conv) + ((long)l * 3 * MW + ch) * 3;
    auto conv8 = [&](int seg, int b, int t0, float (&o8)[8]) { const bf16_t* r = HYT + ((long)b * 3 * MW + seg * MW + ch) * KEYS + k0 + t0;
        const U4 c = *(const U4*)r; const float vm = t0 > 0 ? bf2f(r[-1]) : 0.f, vp = t0 + 8 < L ? bf2f(r[8]) : 0.f;
        const float v[10] = {vm, bflo(c.x), bfhi(c.x), bflo(c.y), bfhi(c.y), bflo(c.z), bfhi(c.z), bflo(c.w), bfhi(c.w), vp};
        const float* wq = cwp + (long)seg * MW * 3; const F4 w = (F4){wq[0], wq[1], wq[2], 0.f};
#pragma unroll
        for (int j = 0; j < 8; ++j) o8[j] = v[j + 1] * w.y + v[j] * w.x + v[j + 2] * w.z; };
    constexpr int L8 = L / 8, NIT8 = (L8 + NTH - 1) / NTH;
    for (int o = 0; o < 2; ++o) {
        const bf16_t* tf = WSP(bf16_t, OFF_TAPS) + (long)(o * HYW + ch) * KEYS + k0; const bf16_t* tb = WSP(bf16_t, OFF_TAPS) + (long)(2 * HYW + o * HYW + ch) * KEYS + k0;
        const float sk = GIN(p.hy_skip)[((long)l * 2 + o) * HYW + ch];
        float nrm = 0.f;
#pragma unroll
        for (int it_ = 0; it_ < NIT8; ++it_) { const int i8 = tid + it_ * NTH; if (L8 % NTH != 0 && i8 >= L8) break; const int t0 = i8 * 8;
            const U4 fa = *(const U4*)(tf + t0), fb = *(const U4*)(tb + t0);
            const float af[8] = {bflo(fa.x), bfhi(fa.x), bflo(fa.y), bfhi(fa.y), bflo(fa.z), bfhi(fa.z), bflo(fa.w), bfhi(fa.w)};
            const float ab[8] = {bflo(fb.x), bfhi(fb.x), bflo(fb.y), bfhi(fb.y), bflo(fb.z), bfhi(fb.z), bflo(fb.w), bfhi(fb.w)};
#pragma unroll
            for (int j = 0; j < 4; ++j) *(F4*)(X + hy_phys(t0) + 2 * j) = (F4){af[2 * j], 0.f, af[2 * j + 1], 0.f};
#pragma unroll
            for (int j = 0; j < 8; ++j) { nrm += fabsf(af[j]);
                if (j == 0 && t0 == 0) X[hy_phys(L)] = (F2){0.f, 0.f}; else { X[hy_phys(N - t0 - j)] = (F2){ab[j], 0.f}; nrm += fabsf(ab[j]); } } }
        nrm = wave_sum(nrm);
        if (lane == 0) red[wid] = nrm;
        __syncthreads();
        constexpr bool HREG = (N == 16384);
        F2 hreg[20];
        if constexpr (HREG) { LdsLd ldx0{X}; HfRegSt sth{hreg, HF}; fft_fwd<N>(X, T1, T2, tid, ldx0, sth); }
        else { LdsLd ldx0{X}; HfGlbSt sth{HF}; fft_fwd<N>(X, T1, T2, tid, ldx0, sth); }
        auto zval8 = [&](int t0, float (&z0)[8], float (&z1)[8]) {
            if (o == 0) { conv8(0, 0, t0, z0); conv8(0, 1, t0, z1); }
            else { const F4 a0 = *(const F4*)(ZT + t0), a1 = *(const F4*)(ZT + t0 + 4), b0 = *(const F4*)(ZT + SEQ + t0), b1 = *(const F4*)(ZT + SEQ + t0 + 4);
                z0[0] = a0.x; z0[1] = a0.y; z0[2] = a0.z; z0[3] = a0.w; z0[4] = a1.x; z0[5] = a1.y; z0[6] = a1.z; z0[7] = a1.w;
                z1[0] = b0.x; z1[1] = b0.y; z1[2] = b0.z; z1[3] = b0.w; z1[4] = b1.x; z1[5] = b1.y; z1[6] = b1.z; z1[7] = b1.w; } };
        LdsSt stx{X}; LdsLd ldx{X};
#pragma unroll
        for (int it_ = 0; it_ < NIT8; ++it_) { const int i8 = tid + it_ * NTH; if (L8 % NTH != 0 && i8 >= L8) break; const int t0 = i8 * 8;
            float z0[8], z1[8]; zval8(t0, z0, z1);
            float zr = 0.f;
#ifndef CPU_EMU
            asm volatile("v_mov_b32 %0, 0" : "=v"(zr));
#endif
#pragma unroll
            for (int j = 0; j < 4; ++j) { *(F4*)(X + hy_phys(t0) + 2 * j) = (F4){z0[2 * j], z1[2 * j], z0[2 * j + 1], z1[2 * j + 1]}; *(F4*)(X + hy_phys(L + t0) + 2 * j) = (F4){zr, zr, zr, zr}; } }
        __syncthreads();
        fft_fwd<N>(X, T1, T2, tid, ldx, stx);
        float tot = 0.f;
#pragma unroll
        for (int w = 0; w < 8; ++w) tot += red[w];
        const float sc = 1.0f / (tot * (float)N);
        if constexpr (HREG) { HfRegLd ldm{X, hreg, HF}; fft_inv<N>(X, T1, T2, tid, ldm, stx); }
        else { HfGlbLd ldm{X, HF}; fft_inv<N>(X, T1, T2, tid, ldm, stx); }
#pragma unroll
        for (int it_ = 0; it_ < NIT8; ++it_) { const int i8 = tid + it_ * NTH; if (L8 % NTH != 0 && i8 >= L8) break; const int t0 = i8 * 8;
            float z0[8], z1[8], g0[8], g1[8], r0[8], r1[8]; zval8(t0, z0, z1); conv8(1 + o, 0, t0, g0); conv8(1 + o, 1, t0, g1);
#pragma unroll
            for (int j = 0; j < 4; ++j) { const F4 y = *(const F4*)(X + hy_phys(t0) + 2 * j);
                r0[2 * j] = g0[2 * j] * (y.x * sc + z0[2 * j] * sk); r1[2 * j] = g1[2 * j] * (y.y * sc + z1[2 * j] * sk);
                r0[2 * j + 1] = g0[2 * j + 1] * (y.z * sc + z0[2 * j + 1] * sk); r1[2 * j + 1] = g1[2 * j + 1] * (y.w * sc + z1[2 * j + 1] * sk); }
            if (o == 0) { *(F4*)(ZT + t0) = (F4){r0[0], r0[1], r0[2], r0[3]}; *(F4*)(ZT + t0 + 4) = (F4){r0[4], r0[5], r0[6], r0[7]};
                *(F4*)(ZT + SEQ + t0) = (F4){r1[0], r1[1], r1[2], r1[3]}; *(F4*)(ZT + SEQ + t0 + 4) = (F4){r1[4], r1[5], r1[6], r1[7]}; }
            else { *(U4*)(YAT + ((long)0 * MW + ch) * KEYS + k0 + t0) = (U4){pack2(r0[0], r0[1]), pack2(r0[2], r0[3]), pack2(r0[4], r0[5]), pack2(r0[6], r0[7])};
                *(U4*)(YAT + ((long)1 * MW + ch) * KEYS + k0 + t0) = (U4){pack2(r1[0], r1[1]), pack2(r1[2], r1[3]), pack2(r1[4], r1[5]), pack2(r1[6], r1[7])}; } }
        __syncthreads();
    }
}

__device__ __forceinline__ void phase_gdn_prep(const Params& p, char* lds, int l) {
    const int bid = BID(), G = gridDim.x;
    for (int rep_ = 0; rep_ < REP_GP; ++rep_) for (int it = bid; it < NTASK_GDN / 2; it += G) gdn_chunk_prep2(p, lds, l, it * 2);
}
__device__ __forceinline__ void phase_mixers(const Params& p, char* lds, int l, int qoff = 0, bool scans_only = false) {
    const int tid = TID();
    const bool ctx_out = l < DEPTH - 1;
    constexpr int NSCAN = BATCH * GH * 2 * 2, NQT_L = SEQ / 256, U_DL = BATCH * DH * NQT_L * 2, U_HY = MW, U_NA = BATCH * NH * (R_ROWS / 4);
    constexpr int NQC = CTX / 128, U_DC = BATCH * DH * NQC, U_NC = BATCH * NH * NQC, U_HC = MW;
    constexpr int U_CV8 = (U_CVT + 7) / 8, U_W3 = (4 * HYW * 128 + 8191) / 8192, U_H2 = (KEYS + 63) / 64;
    const int e0 = NSCAN * REP_GS, e1 = e0 + U_DL * REP_DIFF, e2 = e1 + U_HY * REP_HY, e3 = e2 + U_NA * REP_NA, e4 = e3 + (ctx_out ? U_DC : 0), e5 = e4 + (ctx_out ? U_NC : 0), e6 = e5 + (ctx_out ? U_HC : 0), e7 = e6 + (ctx_out ? U_CV8 : 0), e8 = e7 + (ctx_out ? U_W3 : 0), e9 = e8 + (ctx_out ? U_H2 : 0);
    u32* qctr = WSP(u32, OFF_CNT) + 64 + qoff + l;
    int* qs = (int*)(lds + LDS_BYTES - 16);
    for (;;) {
        __syncthreads();
        if (tid == 0) qs[0] = (int)atomicAdd(qctr, 1u);
        __syncthreads();
        const int u = qs[0];
        if (u >= (scans_only ? e0 : e9)) break;
        if (u < e0) gdn_scan_item(p, lds, l, u % NSCAN);
        else if (u < e1) { int v = (u - e0) % U_DL; const int comp = v & 1; v >>= 1; int b = v / (DH * NQT_L), r = v - b * DH * NQT_L, h = r / NQT_L, qt = r - h * NQT_L; diff32_item(p, lds, l, b, h, qt * 256, comp); }
        else if (u < e2) hyena_item<false>(p, lds, l, (u - e1) % U_HY);
        else if (u < e3) { int v = (u - e2) % U_NA; int b = v / (NH * (R_ROWS / 4)), r = v - b * NH * (R_ROWS / 4), h = r / (R_ROWS / 4), rq = r - h * (R_ROWS / 4); na32_item(p, lds, l, b, h, rq); }
        else if (u < e4) { int v = u - e3; int b = v / (DH * NQC), r = v - b * DH * NQC, h = r / NQC, q = r - h * NQC; diff_attn_item<1>(p, lds, l, b, h, q * 128, true); }
        else if (u < e5) { int v = u - e4; int b = v / (NH * NQC), r = v - b * NH * NQC, h = r / NQC, q = r - h * NQC; na_ctx_item(p, lds, b, h, q * 128); }
        else if (u < e6) hyena_item<true>(p, lds, l, u - e5);
        else if (u < e7) { const int c0 = (u - e6) * 8; for (int q = c0; q < c0 + 8 && q < U_CVT; ++q) cvt_unit(p, lds, l + 1, q); }
        else if (u < e8) w3t_chunk(p, l + 1, (u - e7) * 8192, 8192);
        else h2f_positions(p, l + 1, (u - e8) * 64, 8);
    }
}

__device__ __forceinline__ void phase_finish(const Params& p, char* lds, int l) {
    const int tid = TID(), bid = BID(), G = gridDim.x, lane = tid & 63, wid = tid >> 6;
    bf16_t* Y = WSP(bf16_t, OFF_Y);
    { const bf16_t* OFp = WSP(bf16_t, OFF_OF); const bf16_t* OBp = WSP(bf16_t, OFF_OB); const bf16_t* GZ = WSP(bf16_t, OFF_GZ); const float nw = GIN(p.gdn_norm)[l * 64 + lane];
        const long NR = (long)NTOK * GH, st8 = (long)G * 8;
        for (long i = (long)bid * 8 + wid; i < NR; i += 2 * st8) { const long i2 = i + st8; const bool two = i2 < NR;
            const long tokA = i / GH, tokB = two ? i2 / GH : tokA; const int hA = (int)(i - tokA * GH), hB = two ? (int)(i2 - tokB * GH) : hA;
            const long oA = tokA * MW + hA * 64 + lane, oB = tokB * MW + hB * 64 + lane;
            const float vA = bf2f(OFp[oA]) + bf2f(OBp[oA]), vB = bf2f(OFp[oB]) + bf2f(OBp[oB]);
            const float zA = bf2f(GZ[oA]), zB = bf2f(GZ[oB]);
            float sA = vA * vA, sB = vB * vB;
            sA = xadd<32>(sA); sB = xadd<32>(sB); sA = xadd<16>(sA); sB = xadd<16>(sB); sA = xadd<8>(sA); sB = xadd<8>(sB); sA = xadd<4>(sA); sB = xadd<4>(sB); sA = xadd<2>(sA); sB = xadd<2>(sB); sA = xadd<1>(sA); sB = xadd<1>(sB);
            Y[tokA * 4 * MW + MW + hA * 64 + lane] = f2bf(vA * rsqrtf(sA * (1.0f / 64.0f) + RMS_EPS) * nw * siluf(zA));
            if (two) Y[tokB * 4 * MW + MW + hB * 64 + lane] = f2bf(vB * rsqrtf(sB * (1.0f / 64.0f) + RMS_EPS) * nw * siluf(zB)); } }
    { const bf16_t* YAT = WSP(bf16_t, OFF_YAT); bf16_t* t = (bf16_t*)lds;
        constexpr int KT_ = KEYS / 64, CT_ = MW / 128;
        float lam, lam_init; diff_lambda(p, l, lam, lam_init);
        const float* nw = GIN(p.diff_norm) + l * 128;
        for (int u = bid; u < BATCH * CT_ * KT_; u += G) { int b = u / (CT_ * KT_), r = u - b * CT_ * KT_, ct = r / KT_, kt = r - ct * KT_;
            __syncthreads();
#pragma unroll
            for (int q = 0; q < 2; ++q) { int c = (tid >> 3) + 64 * q, s = tid & 7; *(U4*)(t + c * 72 + s * 8) = *(const U4*)(YAT + ((long)b * MW + ct * 128 + c) * KEYS + kt * 64 + s * 8); }
            if (kt * 64 < SEQ) {
                const int k = tid >> 3, sub = tid & 7; const long tok = bk_tok(b, kt * 64 + k); bf16_t* yr = Y + tok * 4 * MW;
                const U4 a0 = *(const U4*)(yr + 2 * MW + ct * 128 + sub * 16), a1 = *(const U4*)(yr + 2 * MW + ct * 128 + sub * 16 + 8), b0 = *(const U4*)(yr + ct * 128 + sub * 16), b1 = *(const U4*)(yr + ct * 128 + sub * 16 + 8);
                const u32 aw[8] = {a0.x, a0.y, a0.z, a0.w, a1.x, a1.y, a1.z, a1.w}, bw[8] = {b0.x, b0.y, b0.z, b0.w, b1.x, b1.y, b1.z, b1.w};
                float v[16]; float ss = 0.f;
#pragma unroll
                for (int e = 0; e < 8; ++e) { v[2 * e] = bflo(aw[e]) - lam * bflo(bw[e]); v[2 * e + 1] = bfhi(aw[e]) - lam * bfhi(bw[e]); ss += v[2 * e] * v[2 * e] + v[2 * e + 1] * v[2 * e + 1]; }
                ss = xadd<1>(ss); ss = xadd<2>(ss); ss = xadd<4>(ss);
                const float rr = rsqrtf(ss * (1.0f / 128.0f) + RMS_EPS) * (1.0f - lam_init);
                u32 o[8];
#pragma unroll
                for (int e = 0; e < 8; ++e) o[e] = pack2(v[2 * e] * rr * nw[sub * 16 + 2 * e], v[2 * e + 1] * rr * nw[sub * 16 + 2 * e + 1]);
                *(U4*)(yr + 2 * MW + ct * 128 + sub * 16) = (U4){o[0], o[1], o[2], o[3]}; *(U4*)(yr + 2 * MW + ct * 128 + sub * 16 + 8) = (U4){o[4], o[5], o[6], o[7]};
            }
            __syncthreads();
            { int k = tid >> 3; long tok = bk_tok(b, kt * 64 + k);
#pragma unroll
                for (int q = 0; q < 2; ++q) { const int c8 = (tid & 7) * 8 + 64 * q;
                    U4 o; o.x = (u32)t[(c8 + 0) * 72 + k] | ((u32)t[(c8 + 1) * 72 + k] << 16); o.y = (u32)t[(c8 + 2) * 72 + k] | ((u32)t[(c8 + 3) * 72 + k] << 16);
                    o.z = (u32)t[(c8 + 4) * 72 + k] | ((u32)t[(c8 + 5) * 72 + k] << 16); o.w = (u32)t[(c8 + 6) * 72 + k] | ((u32)t[(c8 + 7) * 72 + k] << 16);
                    *(U4*)(Y + tok * 4 * MW + ct * 128 + c8) = o; } } } }
}
__device__ __forceinline__ bool xcd_unit(int bid, int G, int i, int ntm, int ntn, int& tm, int& tn) {
    if ((G & 7) == 0) { const int x = bid & 7, v = i * (G >> 3) + (bid >> 3); tm = (v / ntn) * 8 + x; tn = v - (v / ntn) * ntn; return tm < ntm; }
    const int u = bid + i * G; tn = u / ntm; tm = u - tn * ntm; return u < ntm * ntn;
}
struct Merge1Prov {
    static constexpr int MT = 3, BM1 = 64 * MT, ntm = NTOK / BM1, ntn = D / G_BN;
    const bf16_t *Y, *BP, *GATE; bf16_t* MIXG; int bid, G; U2 tot[MT][4];
    __device__ __forceinline__ void tile(int i, int& row0, int& col0, int& br) const { int tm, tn; xcd_unit(bid, G, i >> 2, ntm, ntn, tm, tn); br = i & 3; row0 = tm * BM1; col0 = tn * G_BN; }
    __device__ __forceinline__ bool valid(int i) const { int tm, tn; return xcd_unit(bid, G, i >> 2, ntm, ntn, tm, tn); }
    __device__ __forceinline__ const bf16_t* arow(int i, int r) const { int row0, col0, br; tile(i, row0, col0, br); return Y + (long)(row0 + r) * 4 * MW + br * MW; }
    __device__ __forceinline__ const bf16_t* bbase(int i) const { int row0, col0, br; tile(i, row0, col0, br); return BP + (long)col0 * 4 * MW + br * MW; }
    U2 gpre[MT][4];
    __device__ __forceinline__ void pre(int i) { int row0, col0, br; tile(i, row0, col0, br);
        const int tid = TID(), wid = tid >> 6, lane = tid & 63, wm = wid >> 1, wn = wid & 1, l15 = lane & 15, g = lane >> 4;
#pragma unroll
        for (int m = 0; m < MT; ++m)
#pragma unroll
            for (int n = 0; n < 4; ++n) gpre[m][n] = *(const U2*)(GATE + ((((long)((row0 / BM1) * ntn + col0 / G_BN) * 4 + br) * 8 + wid) * 12 + (m * 4 + n)) * 256 + lane * 4);
        (void)wm; (void)wn; (void)l15; (void)g; }
    __device__ __forceinline__ void epi(int i, const f32x4 (&acc)[MT][4]) { int row0, col0, br; tile(i, row0, col0, br);
        const int tid = TID(), wid = tid >> 6, lane = tid & 63, wm = wid >> 1, wn = wid & 1, l15 = lane & 15, g = lane >> 4;
#pragma unroll
        for (int m = 0; m < MT; ++m) { const long row = row0 + wm * 16 * MT + m * 16 + l15;
#pragma unroll
            for (int n = 0; n < 4; ++n) { const U2 gv = gpre[m][n];
                const U2 tp = tot[m][n];
                f32x4 t = br == 0 ? (f32x4){0.f, 0.f, 0.f, 0.f} : (f32x4){bflo(tp.x), bfhi(tp.x), bflo(tp.y), bfhi(tp.y)};
                t[0] += sigmoidf(bflo(gv.x)) * acc[m][n][0]; t[1] += sigmoidf(bfhi(gv.x)) * acc[m][n][1]; t[2] += sigmoidf(bflo(gv.y)) * acc[m][n][2]; t[3] += sigmoidf(bfhi(gv.y)) * acc[m][n][3];
                const U2 o = (U2){pack2(t[0], t[1]), pack2(t[2], t[3])};
                tot[m][n] = o;
                if (br == 3) *(U2*)(MIXG + row * D + col0 + wn * 64 + n * 16 + g * 4) = o; } } }
};
#ifdef PROBE_G1
struct Merge1Dry : Merge1Prov { bool fire; __device__ __forceinline__ void epi(int i, const f32x4 (&acc)[MT][4]) { if (fire) Merge1Prov::epi(i, acc); }
#ifdef PROBE_G1NP
    __device__ __forceinline__ void pre(int i) { if (fire) Merge1Prov::pre(i); }
#endif
};
#endif
__device__ __forceinline__ void phase_merge1(const Params& p, char* lds, int l) {
    Merge1Prov pv; pv.Y = WSP(bf16_t, OFF_Y); pv.BP = WSP(bf16_t, off_bp(l)); pv.GATE = WSP(bf16_t, OFF_SEG_GATE); pv.MIXG = WSP(bf16_t, OFF_MIXG);
    pv.bid = BID(); pv.G = (int)gridDim.x;
    gemm_stream<Merge1Prov::MT>(lds, pv, 4 * MW, MW);
#ifdef PROBE_G1
    { Merge1Dry pd; pd.Y = pv.Y; pd.BP = pv.BP; pd.GATE = pv.GATE; pd.MIXG = pv.MIXG; pd.bid = pv.bid; pd.G = pv.G; pd.fire = p.stop_phase == 123456;
      for (int r_ = 0; r_ < 2; ++r_) gemm_stream<Merge1Prov::MT, Merge1Dry, PROBE_G1>(lds, pd, 4 * MW, MW); }
#endif
}
struct Merge2Prov {
    static constexpr int MT = 3, BM1 = 64 * MT, ntm = NTOK / BM1, ntn = D / G_BN;
    const bf16_t *MIXG, *WO; bf16_t* MIX; int bid, G;
    __device__ __forceinline__ void pre(int) const {}
    __device__ __forceinline__ void tile(int i, int& row0, int& col0) const { int tm, tn; xcd_unit(bid, G, i, ntm, ntn, tm, tn); row0 = tm * BM1; col0 = tn * G_BN; }
    __device__ __forceinline__ bool valid(int i) const { int tm, tn; return xcd_unit(bid, G, i, ntm, ntn, tm, tn); }
    __device__ __forceinline__ const bf16_t* arow(int i, int r) const { int row0, col0; tile(i, row0, col0); return MIXG + (long)(row0 + r) * D; }
    __device__ __forceinline__ const bf16_t* bbase(int i) const { int row0, col0; tile(i, row0, col0); return WO + (long)col0 * D; }
    __device__ __forceinline__ void epi(int i, const f32x4 (&acc)[MT][4]) const { int row0, col0; tile(i, row0, col0);
        const int tid = TID(), wid = tid >> 6, lane = tid & 63, wm = wid >> 1, wn = wid & 1, l15 = lane & 15, g = lane >> 4;
#pragma unroll
        for (int m = 0; m < MT; ++m) { const long row = row0 + wm * 16 * MT + m * 16 + l15;
#pragma unroll
            for (int n = 0; n < 4; ++n) st4bf(MIX + row * D + col0 + wn * 64 + n * 16 + g * 4, acc[m][n]); } }
};
#ifdef PROBE_G2
struct Merge2Dry : Merge2Prov { bool fire; __device__ __forceinline__ void epi(int i, const f32x4 (&acc)[MT][4]) const { if (fire) Merge2Prov::epi(i, acc); } };
#endif
__device__ __forceinline__ void phase_merge2(const Params& p, char* lds, int l) {
    Merge2Prov pv; pv.MIXG = WSP(bf16_t, OFF_MIXG); pv.WO = WSP(bf16_t, off_wo(l)); pv.MIX = WSP(bf16_t, OFF_MIX);
    pv.bid = BID(); pv.G = (int)gridDim.x;
    gemm_stream<Merge2Prov::MT>(lds, pv, D, D);
#ifdef PROBE_G2
    { Merge2Dry pd; pd.MIXG = pv.MIXG; pd.WO = pv.WO; pd.MIX = pv.MIX; pd.bid = pv.bid; pd.G = pv.G; pd.fire = p.stop_phase == 123456;
#ifdef PROBE_G2H
      for (int r_ = 0; r_ < 8; ++r_) gemm_stream<Merge2Prov::MT, Merge2Dry, PROBE_G2>(lds, pd, D, D / 2); }
#else
      for (int r_ = 0; r_ < 4; ++r_) gemm_stream<Merge2Prov::MT, Merge2Dry, PROBE_G2>(lds, pd, D, D); }
#endif
#endif
}
struct MoeMap { int cnt[NE], off[NE], tile0[NE + 1]; };
__device__ __forceinline__ void moe_map_load(const Params& p, int* sm  ) {
    const int tid = TID();
    __syncthreads();
    if (tid == 0) { const u32* CNT = WSP(u32, OFF_CNT); int o = 0, t = 0;
        for (int e = 0; e < NE; ++e) { int c = (int)CNT[e]; sm[e] = c; sm[NE + e] = o; sm[2 * NE + e] = t; o += c; t += (c + G_BM - 1) / G_BM; }
        sm[3 * NE] = t; }
    __syncthreads();
}
struct MoeProvBase {
    const int* sm; int bid, G, ntile, ntn;
    __device__ __forceinline__ void pre(int) const {}
    __device__ __forceinline__ bool valid(int i) const { int tg, tn; return xcd_unit(bid, G, i, ntile, ntn, tg, tn); }
    __device__ __forceinline__ void unit(int i, int& e, int& tn, int& r0, int& nrow, long& orow0) const { int tg; xcd_unit(bid, G, i, ntile, ntn, tg, tn);
        e = 0;
#pragma unroll
        for (int q = 1; q < NE; ++q) if (tg >= sm[2 * NE + q]) e = q;
        const int mt = tg - sm[2 * NE + e], cnt = sm[e]; r0 = mt * G_BM; nrow = cnt - r0 < G_BM ? cnt - r0 : G_BM; orow0 = (long)sm[NE + e] + r0; }
};
struct Moe1Prov : MoeProvBase {
    const bf16_t *H, *W13; bf16_t* HMID; const int* ELIST;
    __device__ __forceinline__ const bf16_t* arow(int i, int r) const { int e, tn, r0, nrow; long orow0; unit(i, e, tn, r0, nrow, orow0); const int rr = r < nrow ? r0 + r : r0; return H + (long)ELIST[(long)e * NTOK + rr] * D; }
    __device__ __forceinline__ const bf16_t* bbase(int i) const { int e, tn, r0, nrow; long orow0; unit(i, e, tn, r0, nrow, orow0); return W13 + ((long)e * 2 * EFF + tn * G_BN) * D; }
    __device__ __forceinline__ void epi(int i, const f32x4 (&acc)[4][4]) const { int e, tn, r0, nrow; long orow0; unit(i, e, tn, r0, nrow, orow0);
        const int tid = TID(), wid = tid >> 6, lane = tid & 63, wm = wid >> 1, wn = wid & 1, l15 = lane & 15, g = lane >> 4;
#pragma unroll
        for (int m = 0; m < 4; ++m) { const int r = wm * 64 + m * 16 + l15;
            if (r < nrow) {
#pragma unroll
                for (int n2 = 0; n2 < 2; ++n2) { f32x4 a = acc[m][2 * n2], b = acc[m][2 * n2 + 1], hmid;
#pragma unroll
                    for (int j = 0; j < 4; ++j) hmid[j] = siluf(a[j]) * b[j];
                    st4bf(HMID + (orow0 + r) * EFF + tn * (G_BN / 2) + wn * 32 + n2 * 16 + g * 4, hmid); } } } }
};
struct Moe2Prov : MoeProvBase {
    const bf16_t *HMID, *W2; bf16_t* YE;
    __device__ __forceinline__ const bf16_t* arow(int i, int r) const { int e, tn, r0, nrow; long orow0; unit(i, e, tn, r0, nrow, orow0); return HMID + (orow0 + r) * EFF; }
    __device__ __forceinline__ const bf16_t* bbase(int i) const { int e, tn, r0, nrow; long orow0; unit(i, e, tn, r0, nrow, orow0); return W2 + ((long)e * D + tn * G_BN) * EFF; }
    __device__ __forceinline__ void epi(int i, const f32x4 (&acc)[4][4]) const { int e, tn, r0, nrow; long orow0; unit(i, e, tn, r0, nrow, orow0);
        const int tid = TID(), wid = tid >> 6, lane = tid & 63, wm = wid >> 1, wn = wid & 1, l15 = lane & 15, g = lane >> 4;
#pragma unroll
        for (int m = 0; m < 4; ++m) { const int r = wm * 64 + m * 16 + l15;
            if (r < nrow) {
#pragma unroll
                for (int n = 0; n < 4; ++n) st4bf(YE + (orow0 + r) * D + tn * G_BN + wn * 64 + n * 16 + g * 4, acc[m][n]); } } }
};
#ifdef PROBE_M1
struct Moe1Dry : Moe1Prov { bool fire; __device__ __forceinline__ void epi(int i, const f32x4 (&acc)[4][4]) const { if (fire) Moe1Prov::epi(i, acc); } };
#endif
__device__ __forceinline__ void phase_moe1(const Params& p, char* lds, int l) {
    int* sm = (int*)(lds + G_LDS);
    moe_map_load(p, sm);
    Moe1Prov pv; pv.sm = sm; pv.bid = BID(); pv.G = (int)gridDim.x; pv.ntile = sm[3 * NE]; pv.ntn = 2 * EFF / G_BN;
    pv.H = WSP(bf16_t, OFF_H); pv.W13 = WSP(bf16_t, OFF_W13); pv.HMID = WSP(bf16_t, OFF_HMID); pv.ELIST = WSP(int, OFF_ELIST);
    gemm_stream<4>(lds, pv, D, D);
#ifdef PROBE_M1
    { Moe1Dry pd; pd.sm = pv.sm; pd.bid = pv.bid; pd.G = pv.G; pd.ntile = pv.ntile; pd.ntn = pv.ntn; pd.H = pv.H; pd.W13 = pv.W13; pd.HMID = pv.HMID; pd.ELIST = pv.ELIST; pd.fire = p.stop_phase == 123456;
      for (int r_ = 0; r_ < 2; ++r_) gemm_stream<4, Moe1Dry, PROBE_M1>(lds, pd, D, D); }
#endif
}
#ifdef PROBE_M2
struct Moe2Dry : Moe2Prov { bool fire; __device__ __forceinline__ void epi(int i, const f32x4 (&acc)[4][4]) const { if (fire) Moe2Prov::epi(i, acc); } };
#endif
__device__ __forceinline__ void phase_moe2(const Params& p, char* lds, int l) {
    int* sm = (int*)(lds + G_LDS);
    moe_map_load(p, sm);
    Moe2Prov pv; pv.sm = sm; pv.bid = BID(); pv.G = (int)gridDim.x; pv.ntile = sm[3 * NE]; pv.ntn = D / G_BN;
    pv.HMID = WSP(bf16_t, OFF_HMID); pv.W2 = WSP(bf16_t, OFF_W2); pv.YE = WSP(bf16_t, OFF_YE);
    gemm_stream<4>(lds, pv, EFF, EFF);
#ifdef PROBE_M2
    { Moe2Dry pd; pd.sm = pv.sm; pd.bid = pv.bid; pd.G = pv.G; pd.ntile = pv.ntile; pd.ntn = pv.ntn; pd.HMID = pv.HMID; pd.W2 = pv.W2; pd.YE = pv.YE; pd.fire = p.stop_phase == 123456;
      for (int r_ = 0; r_ < 2; ++r_) gemm_stream<4, Moe2Dry, PROBE_M2>(lds, pd, EFF, EFF); }
#endif
}
#ifdef PROBE_BAR
#define PHASE_END(id) do { GSYNC(); GSYNC(); if (p.stop_phase == (id)) return; } while (0)
#else
#define PHASE_END(id) do { GSYNC(); if (p.stop_phase == (id)) return; } while (0)
#endif

#if defined(CPU_EMU) || !defined(KARG_LAUNDER)
#define PP p_in
#else
__device__ __forceinline__ const Params& launder_params(const Params* q) { asm volatile("" : "+s"(q)); return *q; }
#define PP launder_params(kargs)
#endif
__global__ void __launch_bounds__(NTH, 2) fwd_kernel(Params p_in) {
#ifdef CPU_EMU
    char* lds = emu_lds();
    const Params& p = p_in;
#else
#ifdef KARG_LAUNDER
    const Params* kargs = (const Params*)__builtin_amdgcn_kernarg_segment_ptr();
    const Params& p = *kargs;
#else
    const Params& p = p_in;
#endif
    extern __shared__ __attribute__((aligned(16))) char lds_raw[];
    char* lds = lds_raw + 16;
    if (threadIdx.x == 0) *(uint4*)lds_raw = make_uint4(0u, 0u, 0u, 0u);
    __syncthreads();
    XcdBarrier xbar = xcd_barrier_post((unsigned*)(p.ws + OFF_BAR), (volatile LAS unsigned*)lds_raw);
#endif
#ifdef CPU_EMU
    if (threadIdx.x < 32) ((const float**)(lds + LDS_TBL_OFF))[threadIdx.x] = ((const float* const*)&p_in)[threadIdx.x];
#else
    if (threadIdx.x < 32) ((const float**)(lds + LDS_TBL_OFF))[threadIdx.x] = *(const float* const*)((const char*)__builtin_amdgcn_kernarg_segment_ptr() + threadIdx.x * 8);
#endif
    __syncthreads();
    phase_prologue(PP, lds);
    PHASE_END(1);
    for (int l = 0; l < DEPTH; ++l) {
        const int pb = 100 * (l + 1);
        if (l == 0) { phase_weights(PP, lds, l); PHASE_END(pb + 0); }
        if (l == 0) { phase_modulate0(PP, l); PHASE_END(pb + 1); }
        for (int rep_ = 0; rep_ < REP_IP; ++rep_) phase_inproj(PP, lds, l, 0);
        PHASE_END(pb + 2);
        phase_prep(PP, lds, l);
#ifdef PROBE_PREP
        phase_prep(PP, lds, l, false, PROBE_PREP & 1, PROBE_PREP & 2);
#endif
        PHASE_END(pb + 3);
        phase_gdn_prep(PP, lds, l);
        PHASE_END(pb + 4);
        phase_mixers(PP, lds, l);
#ifdef PROBE_P5
        GSYNC();
        phase_mixers(PP, lds, l, 16, PROBE_P5 == 2);
#endif
        PHASE_END(pb + 5);
        for (int rep_ = 0; rep_ < REP_FIN; ++rep_) phase_finish(PP, lds, l);
        PHASE_END(pb + 6);
        for (int rep_ = 0; rep_ < REP_IP; ++rep_) phase_inproj(PP, lds, l, 1);
        PHASE_END(pb + 7);
        for (int rep_ = 0; rep_ < REP_MG; ++rep_) phase_merge1(PP, lds, l);
        PHASE_END(pb + 8);
        for (int rep_ = 0; rep_ < REP_MG; ++rep_) phase_merge2(PP, lds, l);
        PHASE_END(pb + 9);
#ifdef PROBE_PM
        phase_post_mix(PP, lds, l, true);
#endif
        phase_post_mix(PP, lds, l);
        PHASE_END(pb + 10);
        for (int rep_ = 0; rep_ < REP_MOE; ++rep_) phase_moe1(PP, lds, l);
        PHASE_END(pb + 11);
        for (int rep_ = 0; rep_ < REP_MOE; ++rep_) phase_moe2(PP, lds, l);
        PHASE_END(pb + 12);
#ifdef PROBE_PE
        phase_post_moe(PP, l, true);
#endif
        phase_post_moe(PP, l);
        PHASE_END(pb + 13);
    }
}

extern "C" void kernel_launch(void* const* d_in, const int* in_sizes, int n_in, void* d_out, int out_size, void* d_ws, size_t ws_size, hipStream_t stream) {
    (void)in_sizes; (void)n_in; (void)out_size;
    if (ws_size < WS_NEED) return;
    Params p;
    memset(&p, 0, sizeof(p));
    const float** pp = (const float**)&p;
    for (int i = 0; i < 32; ++i) pp[i] = (const float*)d_in[i];
    p.out = (float*)d_out; p.ws = (char*)d_ws; p.stop_phase = -1;
#ifdef CPU_EMU
    { const char* sp = getenv("EMU_STOP"); if (sp) p.stop_phase = atoi(sp); }
    memset(d_ws, 0, SZ_BAR);
    int grid = 4; { const char* g = getenv("EMU_GRID"); if (g) grid = atoi(g); }
    emu_launch([](void* a) { fwd_kernel(*(Params*)a); }, &p, grid, NTH, LDS_BYTES);
#else
    static int grid = 0;
    if (!grid) {
        int dev = 0, cus = 0, per_cu = 0;
        (void)hipGetDevice(&dev);
        (void)hipDeviceGetAttribute(&cus, hipDeviceAttributeMultiprocessorCount, dev);
        (void)hipFuncSetAttribute((const void*)fwd_kernel, hipFuncAttributeMaxDynamicSharedMemorySize, LDS_BYTES + 16);
        (void)hipOccupancyMaxActiveBlocksPerMultiprocessor(&per_cu, (const void*)fwd_kernel, NTH, LDS_BYTES + 16);
        grid = per_cu >= 1 ? cus : 0;
        if (grid > GRID_MAX) grid = GRID_MAX;
    }
    if (!grid) return;
    (void)hipMemsetAsync(d_ws, 0, SZ_BAR, stream);
    hipLaunchKernelGGL(fwd_kernel, dim3(grid), dim3(NTH), LDS_BYTES + 16, stream, p);
#endif
}
```

```cpp
#ifdef CPU_EMU
#define SCHED_FENCE()
#define WAIT_LGKM()
#define WAIT_VM0()
#else
#include <hip/hip_runtime.h>
typedef short bf16x8 __attribute__((ext_vector_type(8)));
typedef float f32x4 __attribute__((ext_vector_type(4)));
#define SCHED_FENCE() __builtin_amdgcn_sched_barrier(0)
#define WAIT_LGKM() asm volatile("s_waitcnt lgkmcnt(0)" ::: "memory")
#define WAIT_VM0() asm volatile("s_waitcnt vmcnt(0)" ::: "memory")
#endif
#include <cstdint>
#include <cstddef>
#include <cstring>
#include <cstdlib>

#ifndef REP_DIFF
#define REP_DIFF 1
#endif
#ifndef REP_HY
#define REP_HY 1
#endif
#ifndef REP_NA
#define REP_NA 1
#endif
#ifndef REP_GP
#define REP_GP 1
#endif
#ifndef REP_GS
#define REP_GS 1
#endif
#ifndef REP_IP
#define REP_IP 1
#endif
#ifndef REP_W
#define REP_W 1
#endif
#ifndef REP_MG
#define REP_MG 1
#endif
#ifndef REP_MOE
#define REP_MOE 1
#endif
#ifndef REP_FIN
#define REP_FIN 1
#endif
typedef unsigned short bf16_t;
typedef unsigned int u32;
constexpr int LDS_BYTES = 160 * 1024 - 64;
typedef u32 U2 __attribute__((ext_vector_type(2)));
typedef u32 U4 __attribute__((ext_vector_type(4)));
typedef float F4 __attribute__((ext_vector_type(4)));
typedef float F2 __attribute__((ext_vector_type(2)));

#ifdef SMALL_DIMS
constexpr int D = 256, BATCH = 2, SEQ = 1024, DEPTH = 2, CTX = 128, GRID_MAX = 8;
#else
constexpr int D = 1024, BATCH = 2, SEQ = 8192, DEPTH = 4, CTX = 256, GRID_MAX = 256;
#endif
constexpr int NTH = 512;
constexpr int GW = 64, HD = 64;
constexpr int MW = D / 2;
constexpr int HYW = MW, HY_HID = 64, HY_BANDS = 16, HY_EMB = 33;
constexpr int GH = MW / 64, DH = MW / 128, NH = MW / 64;
constexpr int NE = 16, EFF = D / 2;
constexpr int NLAT = BATCH * SEQ, NCTX = BATCH * CTX, NTOK = NLAT + NCTX;
constexpr int KEYS = SEQ + CTX;
constexpr int IN_TOTAL = 13 * MW + 4 * GH + 4 * D;
constexpr int SRC_HY = 0, SRC_GQKV = 3 * MW, SRC_GZ = 6 * MW, SRC_GA = 7 * MW, SRC_DQKV = 7 * MW + 4 * GH, SRC_NQKV = 10 * MW + 4 * GH, SRC_GATE = 13 * MW + 4 * GH;
constexpr int GAB_W = ((13 * MW + 128) % 256 == 0) ? 128 : 256;
constexpr int MY_HY = 0, MY_GQKV = 3 * MW, MY_GZ = 6 * MW, MY_DQKV = 7 * MW, MY_NQKV = 10 * MW, MY_GAB = 13 * MW, MY_GATE = 13 * MW + GAB_W, NPROJ1 = 13 * MW + GAB_W, NPROJ = NPROJ1 + 4 * D;
constexpr float LN_EPS = 1e-5f, RMS_EPS = 1e-6f;
constexpr int NSLOT = 2 * NTOK;
constexpr int R_ROWS = SEQ / GW;
constexpr int NCH_LAT = SEQ / 64, NCH_CTX = CTX / 64, NCH = NCH_LAT + NCH_CTX;
constexpr int NTASK_GDN = BATCH * GH * 2 * NCH;
static_assert(KEYS % 192 == 0 && NTOK % 192 == 0 && NTOK % 256 == 0 && MW % 128 == 0 && SEQ % 256 == 0 && CTX % 64 == 0, "dims");

constexpr size_t al256(size_t x) { return (x + 255) & ~(size_t)255; }
constexpr size_t SZ_BAR = 16384;
constexpr size_t OFF_BAR = 0;
constexpr size_t OFF_CNT = OFF_BAR + SZ_BAR;
constexpr size_t OFF_MODP = OFF_CNT + 4096;
constexpr size_t OFF_MOD = OFF_MODP + al256((size_t)DEPTH * 8 * 3 * 6 * D * 4);
constexpr size_t OFF_XS = OFF_MOD + al256((size_t)DEPTH * 3 * 6 * D * 4);
constexpr size_t OFF_H = OFF_XS + (size_t)NTOK * D * 4;
constexpr size_t OFF_GZ = OFF_H + (size_t)NTOK * D * 2;
constexpr size_t OFF_GAB = OFF_GZ + (size_t)NTOK * MW * 2;
constexpr size_t OFF_GB = OFF_GAB + (size_t)NTOK * 32 * 4;
constexpr size_t OFF_Y = OFF_GB + (size_t)NTOK * 4 * GH * 4;
constexpr size_t OFF_WIN = OFF_Y + (size_t)NTOK * 4 * MW * 2;
constexpr size_t OFF_BP = OFF_WIN + (size_t)NPROJ * D * 2;
constexpr size_t OFF_WO = OFF_BP + (size_t)D * 4 * MW * 2;
constexpr size_t OFF_H2F = OFF_WO + (size_t)D * D * 2;
constexpr size_t OFF_H2B = OFF_H2F + al256((size_t)KEYS * 64 * 4);
constexpr size_t OFF_W3T = OFF_H2B + (size_t)KEYS * 128 * 2;
constexpr size_t OFF_RWT = OFF_W3T + (size_t)4 * HYW * 128 * 2;
constexpr size_t OFF_TOKE = OFF_RWT + (size_t)16 * D * 4;
constexpr size_t OFF_TOKR = OFF_TOKE + (size_t)NTOK * 2 * 4;
constexpr size_t OFF_TOKW = OFF_TOKR + (size_t)NTOK * 2 * 4;
constexpr size_t OFF_ELIST = OFF_TOKW + (size_t)NTOK * 2 * 4;
constexpr size_t OFF_RC = OFF_ELIST + (size_t)NE * NTOK * 4;
constexpr size_t OFF_DVT = OFF_RC;
constexpr size_t OFF_NVT = OFF_DVT + (size_t)BATCH * MW * KEYS * 2;
constexpr size_t OFF_GQ = OFF_NVT + (size_t)BATCH * MW * KEYS * 2;
constexpr size_t OFF_GK = OFF_GQ + (size_t)NTOK * MW * 2;
constexpr size_t OFF_GV = OFF_GK + (size_t)NTOK * MW * 2;
constexpr size_t OFF_RA = OFF_GV + (size_t)NTOK * MW * 2;
constexpr size_t SZ_SEG3 = (size_t)NTOK * 3 * MW * 2;
constexpr size_t OFF_SEG_HY = OFF_RA;
constexpr size_t OFF_SEG_GQKV = OFF_RA + SZ_SEG3;
constexpr size_t OFF_SEG_DQKV = OFF_RA + 2 * SZ_SEG3;
constexpr size_t OFF_SEG_NQKV = OFF_RA + 3 * SZ_SEG3;
constexpr size_t SZ_RA_W = (size_t)NTOK * 4 * D * 2 + (size_t)NE * 3 * EFF * D * 2;
constexpr size_t SZ_RA = 4 * SZ_SEG3 > SZ_RA_W ? 4 * SZ_SEG3 : SZ_RA_W;
constexpr size_t OFF_OF = OFF_RA;
constexpr size_t OFF_OB = OFF_OF + (size_t)NTOK * MW * 2;
constexpr size_t OFF_YAT = OFF_OB + (size_t)NTOK * MW * 2;
constexpr size_t OFF_HF = OFF_YAT + (size_t)BATCH * MW * KEYS * 2;
constexpr size_t HY_XN = 2 * SEQ + ((2 * SEQ) >> 6) * 4;
constexpr size_t OFF_SEG_GATE = OFF_RA;
constexpr size_t OFF_W13 = OFF_RA + (size_t)NTOK * 4 * D * 2;
constexpr size_t OFF_W2 = OFF_W13 + (size_t)NE * 2 * EFF * D * 2;
static_assert(OFF_HF + (size_t)GRID_MAX * HY_XN * 8 <= OFF_SEG_DQKV, "R1 overflow");
static_assert((size_t)NTOK * 4 * D * 2 <= SZ_RA, "gate overflow");
static_assert(OFF_W2 + (size_t)NE * D * EFF * 2 <= OFF_RA + SZ_RA, "expert weights overflow");
constexpr size_t OFF_RB = OFF_RA + SZ_RA;
constexpr size_t OFF_HYT = OFF_RB;
constexpr size_t OFF_WU = OFF_HYT + (size_t)BATCH * 3 * MW * KEYS * 2;
constexpr size_t OFF_TAPS = OFF_WU + (size_t)NTASK_GDN * 2 * 64 * 64 * 2;
constexpr size_t OFF_ZT = OFF_TAPS + (size_t)4 * HYW * KEYS * 2;
static_assert((size_t)GRID_MAX * 2 * SEQ * 4 <= (size_t)4 * HYW * KEYS * 2, "ZT overflow");
constexpr size_t OFF_MIXG = OFF_RB;
constexpr size_t OFF_MIX = OFF_MIXG + (size_t)NTOK * D * 2;
constexpr size_t OFF_HMID = OFF_MIX + (size_t)NTOK * D * 4;
constexpr size_t OFF_YE = OFF_HMID + (size_t)(NSLOT + 256) * EFF * 2;
constexpr size_t SZ_RB_LATE = OFF_YE + (size_t)(NSLOT + 256) * D * 2 - OFF_RB;
constexpr size_t SZ_RB_EARLY = OFF_TAPS + (size_t)4 * HYW * KEYS * 4 - OFF_RB;
constexpr size_t SZ_RB = SZ_RB_LATE > SZ_RB_EARLY ? SZ_RB_LATE : SZ_RB_EARLY;
constexpr size_t SZ_WSET = (size_t)NPROJ * D * 2 + (size_t)D * 4 * MW * 2 + (size_t)D * D * 2;
constexpr size_t OFF_WSET2 = OFF_RB + SZ_RB;
constexpr size_t WS_NEED = OFF_WSET2 + SZ_WSET;
__host__ __device__ constexpr size_t off_win(int l) { return (l & 1) ? OFF_WSET2 : OFF_WIN; }
__host__ __device__ constexpr size_t off_bp(int l) { return (l & 1) ? OFF_WSET2 + (size_t)NPROJ * D * 2 : OFF_BP; }
__host__ __device__ constexpr size_t off_wo(int l) { return (l & 1) ? OFF_WSET2 + (size_t)NPROJ * D * 2 + (size_t)D * 4 * MW * 2 : OFF_WO; }

struct Params {
    const float *x, *c, *ctx, *c_ctx, *w_mod, *b_mod, *w_in, *hy_conv, *hy_w1, *hy_b1, *hy_w2, *hy_b2, *hy_w3, *hy_freq, *hy_deltas, *hy_skip,
        *gdn_conv, *gdn_a_log, *gdn_dt_bias, *gdn_norm, *diff_lam, *diff_norm, *na_rpb, *branch_proj, *w_out, *ln_g, *ln_b, *router_w, *router_b,
        *exp_w1, *exp_w3, *exp_w2;
    float* out; char* ws; long long stop_phase;
};

#ifdef CPU_EMU
#define GPTR(T, ptr) ((T*)(ptr))
#else
#define GPTR(T, ptr) ((T*)(__attribute__((address_space(1))) T*)(ptr))
#endif
constexpr int LDS_TBL_OFF = LDS_BYTES - 16 - 256;
#ifdef CPU_EMU
__device__ __forceinline__ const float* gin_tbl(int idx) { return ((const float* const*)(emu_lds() + LDS_TBL_OFF))[idx]; }
#else
__device__ __forceinline__ const float* gin_tbl(int idx) { extern __shared__ __attribute__((aligned(16))) char lds_raw[]; return GPTR(const float, ((const float* const*)(lds_raw + 16 + LDS_TBL_OFF))[idx]); }
#endif
#define GIN(expr) gin_tbl((int)(((const char*)&(expr)) - ((const char*)&p)) >> 3)
#ifdef CPU_EMU
#define TID() ((int)threadIdx.x)
#define BID() ((int)blockIdx.x)
#else
__device__ __forceinline__ int TID() { int t = threadIdx.x; asm volatile("" : "+v"(t)); return t; }
__device__ __forceinline__ int BID() { int t = blockIdx.x; asm volatile("" : "+s"(t)); return t; }
#endif
__device__ __forceinline__ u32 f2u(float f) { union { float f; u32 u; } c; c.f = f; return c.u; }
__device__ __forceinline__ float u2f(u32 u) { union { float f; u32 u; } c; c.u = u; return c.f; }
#ifdef CPU_EMU
__device__ __forceinline__ bf16_t f2bf(float f) { u32 u = f2u(f); u += 0x7fffu + ((u >> 16) & 1u); return (bf16_t)(u >> 16); }
#else
typedef __bf16 hw_bf16x2 __attribute__((ext_vector_type(2)));
__device__ __forceinline__ bf16_t f2bf(float f) { const hw_bf16x2 r = __builtin_convertvector((F2){f, 0.f}, hw_bf16x2); u32 u; __builtin_memcpy(&u, &r, 4); return (bf16_t)(u & 0xffffu); }
#endif
__device__ __forceinline__ float bf2f(bf16_t h) { return u2f(((u32)h) << 16); }
#ifdef CPU_EMU
__device__ __forceinline__ u32 pack2(float lo, float hi) { return (u32)f2bf(lo) | ((u32)f2bf(hi) << 16); }
__device__ __forceinline__ float fexp2(float x) { return exp2f(x); }
#else
__device__ __forceinline__ u32 pack2(float lo, float hi) { const hw_bf16x2 r = __builtin_convertvector((F2){lo, hi}, hw_bf16x2); u32 u; __builtin_memcpy(&u, &r, 4); return u; }
__device__ __forceinline__ float fexp2(float x) { return __builtin_amdgcn_exp2f(x); }
#endif
__device__ __forceinline__ float bflo(u32 w) { return u2f(w << 16); }
__device__ __forceinline__ float bfhi(u32 w) { return u2f(w & 0xffff0000u); }
#ifdef CPU_EMU
__device__ __forceinline__ float sigmoidf(float x) { return 1.0f / (1.0f + expf(-x)); }
#else
__device__ __forceinline__ float sigmoidf(float x) { return __builtin_amdgcn_rcpf(1.0f + __builtin_amdgcn_exp2f(x * -1.4426950408889634f)); }
#endif
__device__ __forceinline__ float siluf(float x) { return x * sigmoidf(x); }
#ifdef CPU_EMU
template <int O> __device__ __forceinline__ float xadd(float v) { return v + __shfl_xor(v, O); }
template <int O> __device__ __forceinline__ float xmax(float v) { return fmaxf(v, __shfl_xor(v, O)); }
#else
template <int O> __device__ __forceinline__ float xadd(float v) {
    if constexpr (O == 32) { const auto r = __builtin_amdgcn_permlane32_swap(__float_as_uint(v), __float_as_uint(v), false, false); return __uint_as_float(r[0]) + __uint_as_float(r[1]); }
    else return v + __int_as_float(__builtin_amdgcn_ds_swizzle(__float_as_int(v), (O << 10) | 0x1f)); }
template <int O> __device__ __forceinline__ float xmax(float v) {
    if constexpr (O == 32) { const auto r = __builtin_amdgcn_permlane32_swap(__float_as_uint(v), __float_as_uint(v), false, false); return fmaxf(__uint_as_float(r[0]), __uint_as_float(r[1])); }
    else return fmaxf(v, __int_as_float(__builtin_amdgcn_ds_swizzle(__float_as_int(v), (O << 10) | 0x1f))); }
#endif
__device__ __forceinline__ float wave_sum(float v) { v = xadd<32>(v); v = xadd<16>(v); v = xadd<8>(v); v = xadd<4>(v); v = xadd<2>(v); v = xadd<1>(v); return v; }
__device__ __forceinline__ float wave_max(float v) { v = xmax<32>(v); v = xmax<16>(v); v = xmax<8>(v); v = xmax<4>(v); v = xmax<2>(v); v = xmax<1>(v); return v; }
__device__ __forceinline__ bf16x8 ld8(const bf16_t* p) { return *(const bf16x8*)p; }
__device__ __forceinline__ bf16x8 mk8(U2 a, U2 b) { union { struct { U2 a, b; } s; bf16x8 v; } c; c.s.a = a; c.s.b = b; return c.v; }
__device__ __forceinline__ bf16x8 mk8u(u32 a, u32 b, u32 c0, u32 d) { union { u32 u[4]; bf16x8 v; } c; c.u[0] = a; c.u[1] = b; c.u[2] = c0; c.u[3] = d; return c.v; }
#define MFMA16(a, b, c) __builtin_amdgcn_mfma_f32_16x16x32_bf16(a, b, c, 0, 0, 0)
__device__ __forceinline__ int mod_row(int tok) { return tok < NLAT ? tok / SEQ : 2; }
__device__ __forceinline__ void tok_bk(int tok, int& b, int& key) { if (tok < NLAT) { b = tok / SEQ; key = tok - b * SEQ; } else { int t = tok - NLAT; b = t / CTX; key = SEQ + t - b * CTX; } }
__device__ __forceinline__ int bk_tok(int b, int key) { return key < SEQ ? b * SEQ + key : NLAT + b * CTX + (key - SEQ); }
#ifdef CPU_EMU
struct XcdBarrier { int dummy; };
#define GSYNC() emu_grid_sync()
#else
#define XB_TMO      128
#define XB_XCNT(j)  (256  + 64 * (j))
#define XB_XSUB(j)  (1280 + 64 * (j))
#define XB_XGEN(j)  (2304 + 64 * (j))
#define XB_TOP      3328
#define XB_TOPGEN   3392
#define XCD_BAR_WORDS 3456
#define XB_SPIN_CAP (1u << 22)
#define LAS __attribute__((address_space(3)))
__device__ __forceinline__ unsigned xb_ld(unsigned* p)              { return __hip_atomic_load(p, __ATOMIC_RELAXED, __HIP_MEMORY_SCOPE_AGENT); }
__device__ __forceinline__ unsigned xb_add(unsigned* p, unsigned v) { return __hip_atomic_fetch_add(p, v, __ATOMIC_RELAXED, __HIP_MEMORY_SCOPE_AGENT); }
__device__ __forceinline__ unsigned xb_xcc_id() { return (unsigned)__builtin_amdgcn_s_getreg((3 << 11) | 20) & 0xFu; }
#define XB_SPIN(cond, bar) do { unsigned _sp = 0; while (cond) { __builtin_amdgcn_s_sleep(1); \
    if ((++_sp & 255u) == 0u) { if (xb_ld(&(bar)[XB_TMO])) break; if (_sp > XB_SPIN_CAP) { atomicAdd(&(bar)[XB_TMO], 1u); break; } } } } while (0)
struct XcdBarrier { unsigned* bar; unsigned x; volatile LAS unsigned* st; };
__device__ __forceinline__ XcdBarrier xcd_barrier_post(unsigned* bar, volatile LAS unsigned* st) {
    XcdBarrier b; b.bar = bar; b.x = xb_xcc_id(); b.st = st;
    if (threadIdx.x == 0) (void)xb_add(&bar[XB_XCNT(b.x)], 1u);
    return b;
}
__device__ __forceinline__ void xcd_barrier_complete(unsigned* bar, unsigned x, unsigned& nloc, unsigned& nx) {
    const unsigned G = gridDim.x * gridDim.y * gridDim.z;
    unsigned sum, cnt, mine, sp = 0u;
    for (;;) {
        sum = 0u; cnt = 0u; mine = 0u;
#pragma unroll
        for (unsigned j = 0; j < 16; ++j) { const unsigned c = xb_ld(&bar[XB_XCNT(j)]); sum += c; cnt += (c > 0u) ? 1u : 0u; mine = (j == x) ? c : mine; }
        if (sum == G) break;
        __builtin_amdgcn_s_sleep(1);
        if ((++sp & 255u) == 0u) { if (xb_ld(&bar[XB_TMO])) break; if (sp > XB_SPIN_CAP) { atomicAdd(&bar[XB_TMO], 1u); break; } }
    }
    nloc = mine > 0u ? mine : 1u; nx = cnt > 0u ? cnt : 1u;
}
__device__ __forceinline__ void xcd_barrier(const XcdBarrier& b) {
    asm volatile("s_waitcnt vmcnt(0)" ::: "memory");
    __syncthreads();
    if (threadIdx.x == 0) {
        unsigned* bar = b.bar;
        __builtin_amdgcn_s_waitcnt(0);
        unsigned nloc = b.st[0], nx = b.st[1];
        if (nloc == 0u) { xcd_barrier_complete(bar, b.x, nloc, nx); b.st[0] = nloc; b.st[1] = nx; }
        const unsigned old = xb_add(&bar[XB_XSUB(b.x)], 1u);
        const unsigned gen = old / nloc;
        if (old + 1u == (gen + 1u) * nloc) {
            __builtin_amdgcn_fence(__ATOMIC_RELEASE, "agent");
            asm volatile("s_waitcnt vmcnt(0)" ::: "memory");
            const unsigned og = xb_add(&bar[XB_TOP], 1u);
            const unsigned tg = og / nx;
            if (og + 1u == (tg + 1u) * nx) xb_add(&bar[XB_TOPGEN], 1u);
            else XB_SPIN(xb_ld(&bar[XB_TOPGEN]) == tg, bar);
            __builtin_amdgcn_fence(__ATOMIC_ACQUIRE, "agent");
            xb_add(&bar[XB_XGEN(b.x)], 1u);
            asm volatile("s_waitcnt vmcnt(0)" ::: "memory");
        } else {
            XB_SPIN(xb_ld(&bar[XB_XGEN(b.x)]) == gen, bar);
            __builtin_amdgcn_fence(__ATOMIC_ACQUIRE, "agent");
            asm volatile("s_waitcnt vmcnt(0)" ::: "memory");
        }
    }
    __syncthreads();
}
#define GSYNC() xcd_barrier(xbar)
#endif

constexpr int G_BM = 256, G_BN = 128, G_BK = 64, G_LD = 80;
constexpr int G_STAGE = (G_BM + G_BN) * G_LD * 2;
constexpr int G_LDS = 2 * G_STAGE;

template <int MT = 4, class ARow>
__device__ __forceinline__ void gemm_tile(char* lds, ARow arow  , const bf16_t* Bt, long ldb, int K, f32x4 (&acc)[MT][4]) {
    const int tid = TID(), wid = tid >> 6, lane = tid & 63, wm = wid >> 1, wn = wid & 1, l15 = lane & 15, g = lane >> 4;
#pragma unroll
    for (int m = 0; m < MT; ++m)
#pragma unroll
        for (int n = 0; n < 4; ++n) acc[m][n] = (f32x4){0.f, 0.f, 0.f, 0.f};
    const bf16_t* ap[MT]; const bf16_t* bp[2];
#pragma unroll
    for (int i = 0; i < MT; ++i) { int pc = tid + i * NTH; int r = pc >> 3, s = pc & 7; ap[i] = arow(r) + s * 8; }
#pragma unroll
    for (int i = 0; i < 2; ++i) { int pc = tid + i * NTH; int r = pc >> 3, s = pc & 7; bp[i] = Bt + (long)r * ldb + s * 8; }
    U4 ra[2][MT], rb[2][2];
    const int nk = K / G_BK;
#define GT_LOAD(set, kt) do { _Pragma("unroll") for (int i = 0; i < MT; ++i) ra[set][i] = *(const U4*)(ap[i] + (kt) * G_BK); _Pragma("unroll") for (int i = 0; i < 2; ++i) rb[set][i] = *(const U4*)(bp[i] + (kt) * G_BK); } while (0)
#define GT_STORE(set, st) do { bf16_t* dA = (bf16_t*)(lds + (st) * G_STAGE); bf16_t* dB = dA + G_BM * G_LD; \
        _Pragma("unroll") for (int i = 0; i < MT; ++i) { int pc = tid + i * NTH; int r = pc >> 3, s = pc & 7; *(U4*)(dA + r * G_LD + s * 8) = ra[set][i]; } \
        _Pragma("unroll") for (int i = 0; i < 2; ++i) { int pc = tid + i * NTH; int r = pc >> 3, s = pc & 7; *(U4*)(dB + r * G_LD + s * 8) = rb[set][i]; } } while (0)
#define GT_COMPUTE(st) do { const bf16_t* sA = (const bf16_t*)(lds + (st) * G_STAGE); const bf16_t* sB = sA + G_BM * G_LD; \
        _Pragma("unroll") for (int ks = 0; ks < 2; ++ks) { bf16x8 af[MT], bfr[4]; \
            _Pragma("unroll") for (int m = 0; m < MT; ++m) af[m] = ld8(sA + (wm * 16 * MT + m * 16 + l15) * G_LD + ks * 32 + g * 8); \
            _Pragma("unroll") for (int n = 0; n < 4; ++n) bfr[n] = ld8(sB + (wn * 64 + n * 16 + l15) * G_LD + ks * 32 + g * 8); \
            _Pragma("unroll") for (int m = 0; m < MT; ++m) _Pragma("unroll") for (int n = 0; n < 4; ++n) acc[m][n] = MFMA16(bfr[n], af[m], acc[m][n]); } } while (0)
    GT_LOAD(0, 0);
    GT_LOAD(1, 1);
    __syncthreads();
    GT_STORE(0, 0);
    if (nk > 2) GT_LOAD(0, 2);
    __syncthreads();
    for (int kt = 0; kt < nk; kt += 2) {
        GT_COMPUTE(0);
        GT_STORE(1, 1);
        if (kt + 3 < nk) GT_LOAD(1, kt + 3);
        __syncthreads();
        GT_COMPUTE(1);
        if (kt + 2 < nk) { GT_STORE(0, 0); if (kt + 4 < nk) GT_LOAD(0, kt + 4); }
        __syncthreads();
    }
#undef GT_LOAD
#undef GT_STORE
#undef GT_COMPUTE
}

template <int MT, class Prov, int MODE = 0>
__device__ __forceinline__ void gemm_stream(char* lds, Prov& pv, const long ldb, const int K) {
    const int tid = TID(), wid = tid >> 6, lane = tid & 63, wm = wid >> 1, wn = wid & 1, l15 = lane & 15, g = lane >> 4;
    if (!pv.valid(0)) return;
    const bf16_t* ap[MT]; const bf16_t* bp[2]; const bf16_t* apn[MT]; const bf16_t* bpn[2];
    U4 ra[2][MT], rb[2][2];
    const int nk = K / G_BK;
#define GS_PTRS(AP, BP, i) do { const int tq_ = TID(); _Pragma("unroll") for (int q_ = 0; q_ < MT; ++q_) { int pc = tq_ + q_ * NTH; AP[q_] = pv.arow(i, pc >> 3) + (pc & 7) * 8; } \
        const bf16_t* bb_ = pv.bbase(i); _Pragma("unroll") for (int q_ = 0; q_ < 2; ++q_) { int pc = tq_ + q_ * NTH; BP[q_] = bb_ + (long)(pc >> 3) * ldb + (pc & 7) * 8; } } while (0)
#define GS_LOAD(set, AP, BP, kt) do { _Pragma("unroll") for (int q_ = 0; q_ < MT; ++q_) ra[set][q_] = *(const U4*)(AP[q_] + (kt) * G_BK); _Pragma("unroll") for (int q_ = 0; q_ < 2; ++q_) rb[set][q_] = *(const U4*)(BP[q_] + (kt) * G_BK); } while (0)
#define GS_LOADV(set, v) do { if (MODE == 2 || MODE == 4) break; if ((v) < nk) GS_LOAD(set, ap, bp, (v)); else if (hn) GS_LOAD(set, apn, bpn, (v) - nk); } while (0)
#define GS_STORE(set, st) do { if (MODE == 4) break; bf16_t* dA = (bf16_t*)(lds + (st) * G_STAGE); bf16_t* dB = dA + G_BM * G_LD; \
        _Pragma("unroll") for (int q_ = 0; q_ < MT; ++q_) { int pc = tid + q_ * NTH; *(U4*)(dA + (pc >> 3) * G_LD + (pc & 7) * 8) = ra[set][q_]; } \
        _Pragma("unroll") for (int q_ = 0; q_ < 2; ++q_) { int pc = tid + q_ * NTH; *(U4*)(dB + (pc >> 3) * G_LD + (pc & 7) * 8) = rb[set][q_]; } } while (0)
#define GS_COMPUTE(st) do { if (MODE == 3) break; const bf16_t* sA = (const bf16_t*)(lds + (st) * G_STAGE); const bf16_t* sB = sA + G_BM * G_LD; \
        _Pragma("unroll") for (int ks = 0; ks < 2; ++ks) { bf16x8 af[MT], bfr[4];     \
            _Pragma("unroll") for (int n = 0; n < 4; ++n) bfr[n] = ld8(sB + (wn * 64 + n * 16 + l15) * G_LD + ks * 32 + g * 8); \
            _Pragma("unroll") for (int m = 0; m < MT; ++m) af[m] = ld8(sA + (wm * 16 * MT + m * 16 + l15) * G_LD + ks * 32 + g * 8); \
            SCHED_FENCE(); \
            _Pragma("unroll") for (int m = 0; m < MT; ++m) _Pragma("unroll") for (int n = 0; n < 4; ++n) acc[m][n] = MFMA16(bfr[n], af[m], acc[m][n]); \
            SCHED_FENCE(); } } while (0)
    GS_PTRS(ap, bp, 0);
    GS_LOAD(0, ap, bp, 0);
    GS_LOAD(1, ap, bp, 1);
    __syncthreads();
    for (int i = 0;; ++i) {
        const bool hn = pv.valid(i + 1);
        if (hn) GS_PTRS(apn, bpn, i + 1);
        f32x4 acc[MT][4];
#pragma unroll
        for (int m = 0; m < MT; ++m)
#pragma unroll
            for (int n = 0; n < 4; ++n) acc[m][n] = (f32x4){0.f, 0.f, 0.f, 0.f};
        pv.pre(i);
        GS_STORE(0, 0);
        GS_LOADV(0, 2);
        __syncthreads();
        for (int kt = 0; kt < nk; kt += 2) {
            GS_COMPUTE(0);
            GS_STORE(1, 1);
            GS_LOADV(1, kt + 3);
            __syncthreads();
            GS_COMPUTE(1);
            if (kt + 2 < nk) { GS_STORE(0, 0); GS_LOADV(0, kt + 4); }
            __syncthreads();
        }
        pv.epi(i, acc);
        if (!hn) break;
#pragma unroll
        for (int q_ = 0; q_ < MT; ++q_) ap[q_] = apn[q_];
        bp[0] = bpn[0]; bp[1] = bpn[1];
    }
#undef GS_PTRS
#undef GS_LOAD
#undef GS_LOADV
#undef GS_STORE
#undef GS_COMPUTE
}

template <class SrcFn>
__device__ __forceinline__ void cvt_tile(char* lds, SrcFn srcp, int k0, int n0, bf16_t* dst, long dst_ld) {
    float* t = (float*)lds;
    const int tid = TID();
    __syncthreads();
#pragma unroll
    for (int i = 0; i < 2; ++i) { int kk = (tid >> 4) + 32 * i, n4 = (tid & 15) * 4; const float* sp = srcp(k0 + kk, n0 + n4);
        F4 v = sp ? *(const F4*)sp : (F4){0.f, 0.f, 0.f, 0.f};
        t[kk * 65 + n4] = v.x; t[kk * 65 + n4 + 1] = v.y; t[kk * 65 + n4 + 2] = v.z; t[kk * 65 + n4 + 3] = v.w; }
    __syncthreads();
    { int n = tid >> 3, k8 = (tid & 7) * 8; U4 o;
        o.x = pack2(t[(k8 + 0) * 65 + n], t[(k8 + 1) * 65 + n]); o.y = pack2(t[(k8 + 2) * 65 + n], t[(k8 + 3) * 65 + n]);
        o.z = pack2(t[(k8 + 4) * 65 + n], t[(k8 + 5) * 65 + n]); o.w = pack2(t[(k8 + 6) * 65 + n], t[(k8 + 7) * 65 + n]);
        *(U4*)(dst + (long)(n0 + n) * dst_ld + k0 + k8) = o; }
}

__device__ __forceinline__ void tr_tile(char* lds, const bf16_t* src, long ld, int tok0, int col0, int ncols, int cdst0, bf16_t* dst) {
    bf16_t* t = (bf16_t*)lds;
    const int tid = TID();
    __syncthreads();
    { int r = tid >> 3, s = tid & 7; *(U4*)(t + r * 72 + s * 8) = *(const U4*)(src + (long)(tok0 + r) * ld + col0 + s * 8); }
    __syncthreads();
    { int c = tid >> 3, t8 = (tid & 7) * 8; int b, key; tok_bk(tok0, b, key);
        U4 o; o.x = (u32)t[(t8 + 0) * 72 + c] | ((u32)t[(t8 + 1) * 72 + c] << 16); o.y = (u32)t[(t8 + 2) * 72 + c] | ((u32)t[(t8 + 3) * 72 + c] << 16);
        o.z = (u32)t[(t8 + 4) * 72 + c] | ((u32)t[(t8 + 5) * 72 + c] << 16); o.w = (u32)t[(t8 + 6) * 72 + c] | ((u32)t[(t8 + 7) * 72 + c] << 16);
        *(U4*)(dst + ((long)b * ncols + cdst0 + c) * KEYS + key + t8) = o; }
}
namespace pg8 {
#ifdef CPU_EMU
#define PG8_LAS
#else
#define PG8_LAS __attribute__((address_space(3)))
#endif
typedef unsigned short bf16_t;
typedef unsigned u32x4 __attribute__((ext_vector_type(4)));
constexpr int BM = 256, BK = 64, HALF = 128, HTB = HALF * BK * 2  , STAGE_BYTES = 8 * HTB, NXCD = 8, WGM = 8;

__host__ __device__ __forceinline__ int lds_byte(int r, int c) { const int st = (r >> 4) * 2 + (c >> 5), rr = r & 15, cc = c & 31, ob = rr * 64 + cc * 2; return st * 1024 + (ob ^ (((ob >> 9) & 1) << 5)); }
__host__ __device__ __forceinline__ void stage_rc(int b, int& R, int& C) { const int st = b / 1024, sb = b % 1024, swz = sb ^ (((sb >> 9) & 1) << 5); R = (st >> 1) * 16 + swz / 64; C = (st & 1) * 32 + (swz % 64) / 2; }
__host__ __device__ __forceinline__ int perm32(int rho) { const int n = rho >> 4, i = rho & 15; return 8 * (i >> 2) + 4 * n + (i & 3); }

struct Unit { int pm, pn; };
struct Gemm { const bf16_t* A; const bf16_t* Bt; int M, N, K; };

struct StaticOrder {
    int nM, nN, nwg, G, c;
    __host__ __device__ void init(int M, int N, int G_, int c_) { nM = M / BM; nN = N / BM; nwg = nM * nN; G = G_; c = c_; }
    __host__ __device__ bool next(int i, Unit& u) const {
        const long L = (long)i * G + c; if (L >= nwg) return false;
        int wgid = (int)L; { const int q = nwg / NXCD, r = nwg % NXCD, xcd = wgid % NXCD, off = wgid / NXCD; wgid = (xcd < r ? xcd * (q + 1) : r * (q + 1) + (xcd - r) * q) + off; }
        const int nig = WGM * nN, gid = wgid / nig, fm = gid * WGM, gsz = (nM - fm) < WGM ? (nM - fm) : WGM;
        u.pm = fm + ((wgid % nig) % gsz); u.pn = (wgid % nig) / gsz; return true;
    }
    __device__ __forceinline__ void a_ready(const Unit&) const {}
    __device__ __forceinline__ void done(const Unit&) const {}
};
template <class Epi, class Sched, bool STAMP = false>
__device__ __forceinline__ void gemm_phase(PG8_LAS unsigned char* lds, const Gemm g, const Sched& S, const Epi& E, unsigned long long* stamps) {
    const int tid = TID(), wid = __builtin_amdgcn_readfirstlane(tid >> 6), lane = tid & 63, wr = wid >> 2, wc = wid & 3, fr = lane & 15, fq = lane >> 4;
    const int K = g.K, nt = K / BK;
    int ts_lo = 0, ts_hi = 0, nts = 0; const unsigned long long rt_entry = STAMP ? (unsigned long long)wall_clock64() : 0ull;
#define PG8_STAMP() do { if (STAMP && wid == 0 && nts < 64) { const unsigned long long _c = (unsigned long long)clock64(); \
        ts_lo = (lane == nts) ? (int)(unsigned)_c : ts_lo; ts_hi = (lane == nts) ? (int)(unsigned)(_c >> 32) : ts_hi; ++nts; } } while (0)
    PG8_STAMP();
    unsigned voffA[2], voffB[2];
#pragma unroll
    for (int i = 0; i < 2; ++i) { int R, C; stage_rc(tid * 16 + i * 8192, R, C); const int Rb = Epi::PERM ? ((R & ~31) + perm32(R & 31)) : R;
        voffA[i] = (unsigned)(R * K + C) * 2u; voffB[i] = (unsigned)(Rb * K + C) * 2u; }
    const size_t kstep = (size_t)(BK * 2);
    const size_t hstep = (size_t)HALF * K * 2;
    const size_t tstep = 2 * hstep;
    const unsigned ldsw = (unsigned)wid * 1024u;
    const int aoff = lds_byte(wr * 64 + fr, fq * 8), boff = lds_byte(wc * 32 + fr, fq * 8);
#define PG8_SA(b, h) (((b) * 2 + (h)) * HTB)
#define PG8_SB(b, h) ((4 + (b) * 2 + (h)) * HTB)
#define PG8_STAGE(bufoff, gbase, voff) do { _Pragma("unroll") for (int _i = 0; _i < 2; ++_i) \
        __builtin_amdgcn_global_load_lds((const unsigned*)((const char*)(gbase) + (voff)[_i]), (PG8_LAS unsigned*)(lds + (bufoff) + ldsw + _i * 8192), 16, 0, 0); } while (0)
#define PG8_LDA(dst, b, h) do { _Pragma("unroll") for (int m = 0; m < 4; ++m) _Pragma("unroll") for (int k = 0; k < 2; ++k) dst[m][k] = *(const PG8_LAS bf16x8*)(lds + PG8_SA(b, h) + aoff + m * 2048 + k * 1024); } while (0)
#define PG8_LDB(dst, b, h) do { _Pragma("unroll") for (int n = 0; n < 2; ++n) _Pragma("unroll") for (int k = 0; k < 2; ++k) dst[n][k] = *(const PG8_LAS bf16x8*)(lds + PG8_SB(b, h) + boff + n * 2048 + k * 1024); } while (0)
#define PG8_MMA(ai, bj, At, Bt) do { __builtin_amdgcn_s_setprio(1); _Pragma("unroll") for (int m = 0; m < 4; ++m) _Pragma("unroll") for (int n = 0; n < 2; ++n) _Pragma("unroll") for (int k = 0; k < 2; ++k) \
        acc[ai][bj][m][n] = __builtin_amdgcn_mfma_f32_16x16x32_bf16(Bt[n][k], At[m][k], acc[ai][bj][m][n], 0, 0, 0); __builtin_amdgcn_s_setprio(0); } while (0)
#ifdef CPU_EMU
#define PG8_WAIT_V(n)
#define PG8_WAIT_L(n)
#else
#define PG8_WAIT_V(n) asm volatile("s_waitcnt vmcnt(" #n ")" ::: "memory")
#define PG8_WAIT_L(n) asm volatile("s_waitcnt lgkmcnt(" #n ")" ::: "memory")
#endif
#define PG8_BAR __builtin_amdgcn_s_barrier()
#define PG8_SCHED __builtin_amdgcn_sched_barrier(0)
    Unit cur, nxt; int ui = 0;
    if (!S.next(0, cur)) return;
    f32x4 acc[2][2][4][2];
#pragma unroll
    for (int a = 0; a < 2; ++a)
#pragma unroll
        for (int b = 0; b < 2; ++b)
#pragma unroll
            for (int m = 0; m < 4; ++m)
#pragma unroll
                for (int n = 0; n < 2; ++n) acc[a][b][m][n] = (f32x4){0.f, 0.f, 0.f, 0.f};
    bf16x8 At[4][2], B0[2][2], B1[2][2];
    const char* cA = (const char*)g.A + (size_t)cur.pm * tstep; const char* cB = (const char*)g.Bt + (size_t)cur.pn * tstep;
    S.a_ready(cur);
    PG8_STAGE(PG8_SB(0, 0), cB, voffB); PG8_STAGE(PG8_SA(0, 0), cA, voffA); PG8_STAGE(PG8_SB(0, 1), cB + hstep, voffB); PG8_STAGE(PG8_SA(0, 1), cA + hstep, voffA);
    if (wr == 1) PG8_BAR;
    PG8_WAIT_V(4); PG8_BAR;
    PG8_STAGE(PG8_SB(1, 0), cB + kstep, voffB); PG8_STAGE(PG8_SA(1, 0), cA + kstep, voffA); PG8_STAGE(PG8_SB(1, 1), cB + hstep + kstep, voffB);
    PG8_WAIT_V(6); PG8_BAR;
    PG8_STAMP();
    for (;;) {
        const bool has_next = S.next(ui + 1, nxt);
        const char* nA = has_next ? (const char*)g.A + (size_t)nxt.pm * tstep : cA; const char* nB = has_next ? (const char*)g.Bt + (size_t)nxt.pn * tstep : cB;
        for (int t = 0; t < nt; t += 2) {
            const bool last = (t == nt - 2);
            const char* a1 = cA + (size_t)(t + 1) * kstep;
            const char* a2 = last ? nA : cA + (size_t)(t + 2) * kstep; const char* b2 = last ? nB : cB + (size_t)(t + 2) * kstep;
            const char* a3 = a2 + kstep; const char* b3 = b2 + kstep;
            if (last && has_next) S.a_ready(nxt);
            PG8_LDB(B0, 0, 0); PG8_SCHED; PG8_LDA(At, 0, 0); PG8_STAGE(PG8_SA(1, 1), a1 + hstep, voffA);
            PG8_WAIT_L(8); PG8_BAR; PG8_WAIT_L(0); PG8_MMA(0, 0, At, B0); PG8_BAR; PG8_SCHED;
            PG8_LDB(B1, 0, 1); PG8_STAGE(PG8_SB(0, 0), b2, voffB);
            PG8_BAR; PG8_WAIT_L(0); PG8_MMA(0, 1, At, B1); PG8_BAR;
            PG8_LDA(At, 0, 1); PG8_STAGE(PG8_SA(0, 0), a2, voffA);
            PG8_BAR; PG8_WAIT_L(0); PG8_MMA(1, 0, At, B0); PG8_BAR; PG8_SCHED;
            PG8_STAGE(PG8_SB(0, 1), b2 + hstep, voffB);
            PG8_WAIT_V(6); PG8_BAR; PG8_MMA(1, 1, At, B1); PG8_BAR;
            PG8_LDB(B0, 1, 0); PG8_SCHED; PG8_LDA(At, 1, 0); PG8_STAGE(PG8_SA(0, 1), a2 + hstep, voffA);
            PG8_WAIT_L(8); PG8_BAR; PG8_WAIT_L(0); PG8_MMA(0, 0, At, B0); PG8_BAR; PG8_SCHED;
            PG8_LDB(B1, 1, 1); PG8_STAGE(PG8_SB(1, 0), b3, voffB);
            PG8_BAR; PG8_WAIT_L(0); PG8_MMA(0, 1, At, B1); PG8_BAR;
            PG8_LDA(At, 1, 1); PG8_STAGE(PG8_SA(1, 0), a3, voffA);
            PG8_BAR; PG8_WAIT_L(0); PG8_MMA(1, 0, At, B0); PG8_BAR; PG8_SCHED;
            PG8_STAGE(PG8_SB(1, 1), b3 + hstep, voffB);
            PG8_WAIT_V(6); PG8_BAR; PG8_MMA(1, 1, At, B1); PG8_BAR;
        }
        PG8_STAMP();
        if constexpr (!Epi::AFTER_DRAIN) { E(acc, cur, wr, wc, fr, fq); S.done(cur); }
        PG8_STAMP();
        if (!has_next) break;
#pragma unroll
        for (int a = 0; a < 2; ++a)
#pragma unroll
            for (int b = 0; b < 2; ++b)
#pragma unroll
                for (int m = 0; m < 4; ++m)
#pragma unroll
                    for (int n = 0; n < 2; ++n) acc[a][b][m][n] = (f32x4){0.f, 0.f, 0.f, 0.f};
        cur = nxt; cA = nA; cB = nB; ++ui;
    }
    PG8_WAIT_V(0);
    if (wr == 0) PG8_BAR;
    PG8_BAR;
    if constexpr (Epi::AFTER_DRAIN) { E.fused(acc, cur, wr, wc, fr, fq, lds, wid, lane); S.done(cur); }
    PG8_STAMP();
    if (STAMP && wid == 0) { stamps[lane] = lane < nts ? (((unsigned long long)(unsigned)ts_hi << 32) | (unsigned)ts_lo) : 0ull;
        if (lane == 62) stamps[62] = rt_entry; if (lane == 63) stamps[63] = (unsigned long long)wall_clock64(); }
#undef PG8_STAMP
#undef PG8_SA
#undef PG8_SB
#undef PG8_STAGE
#undef PG8_LDA
#undef PG8_LDB
#undef PG8_MMA
#undef PG8_WAIT_V
#undef PG8_WAIT_L
#undef PG8_BAR
#undef PG8_SCHED
}


__device__ __forceinline__ unsigned cvt_pk_bf16(float lo, float hi) { return pack2(lo, hi); }
__device__ __forceinline__ long gate_idx(int row, int br, int col) {
    const int tm = row / 192, r = row - tm * 192, wm = r / 48, r2 = r - wm * 48, m = r2 >> 4, l15 = r2 & 15;
    const int tn = col >> 7, c = col & 127, wn = c >> 6, n = (c >> 4) & 3, g = (c >> 2) & 3;
    return ((((long)(tm * (D / 128) + tn) * 4 + br) * 8 + (wm * 2 + wn)) * 12 + (m * 4 + n)) * 256 + (g * 16 + l15) * 4;
}
#ifdef CPU_EMU
#define PG8_WAVE_SYNC() __syncthreads()
#else
#define PG8_WAVE_SYNC() __builtin_amdgcn_wave_barrier()
#endif
struct EpiInproj {
    static constexpr bool PERM = true, AFTER_DRAIN = false;
    char* ws; char* stg; int ncol0;
    static __device__ __forceinline__ void st_tr(bf16_t* dT, long key, const f32x4& v0, const f32x4& v1) {
        dT[key] = f2bf(v0[0]); dT[KEYS + key] = f2bf(v0[1]); dT[2 * KEYS + key] = f2bf(v0[2]); dT[3 * KEYS + key] = f2bf(v0[3]);
        dT[4 * KEYS + key] = f2bf(v1[0]); dT[5 * KEYS + key] = f2bf(v1[1]); dT[6 * KEYS + key] = f2bf(v1[2]); dT[7 * KEYS + key] = f2bf(v1[3]); }
    __device__ __forceinline__ void operator()(const f32x4 (&acc)[2][2][4][2], const Unit& u, int wr_, int wc_, int fr_, int fq_) const {
        const int tid = TID(), wid = tid >> 6, lane = tid & 63, wr = wid >> 2, wc = wid & 3, fr = lane & 15, fq = lane >> 4;
        (void)wr_; (void)wc_; (void)fr_; (void)fq_;
#pragma unroll
        for (int bj = 0; bj < 2; ++bj) {
            const int cw = ncol0 + u.pn * BM + bj * HALF;
            bf16_t* dst = nullptr; bf16_t* dT = nullptr; bf16_t* gatep = nullptr; int ld = 0, cl = 0, ncT = 0; bool gab = false;
            if (cw < MY_GQKV) { dT = GPTR(bf16_t, ws + OFF_HYT); ncT = 3 * MW; cl = cw - MY_HY; }
            else if (cw < MY_GZ) { dst = GPTR(bf16_t, ws + OFF_SEG_GQKV); ld = 3 * MW; cl = cw - MY_GQKV; }
            else if (cw < MY_DQKV) { dst = GPTR(bf16_t, ws + OFF_GZ); ld = MW; cl = cw - MY_GZ; }
            else if (cw < MY_NQKV) { cl = cw - MY_DQKV; if (cl < 2 * MW) { dst = GPTR(bf16_t, ws + OFF_SEG_DQKV); ld = 3 * MW; } else { dT = GPTR(bf16_t, ws + OFF_DVT); ncT = MW; cl -= 2 * MW; } }
            else if (cw < MY_GAB) { cl = cw - MY_NQKV; if (cl < 2 * MW) { dst = GPTR(bf16_t, ws + OFF_SEG_NQKV); ld = 3 * MW; } else { dT = GPTR(bf16_t, ws + OFF_NVT); ncT = MW; cl -= 2 * MW; } }
            else if (cw < MY_GATE) { gab = (cw == MY_GAB) && wc == 0; }
            else { gatep = GPTR(bf16_t, ws + OFF_SEG_GATE); cl = cw - MY_GATE; }
            if (dst) {
#pragma unroll
                for (int ai = 0; ai < 2; ++ai)
#pragma unroll
                    for (int m = 0; m < 4; ++m) { const long row = (long)u.pm * BM + ai * HALF + wr * 64 + m * 16 + fr;
                        const f32x4 v0 = acc[ai][bj][m][0], v1 = acc[ai][bj][m][1];
                        U4 w; w.x = pack2(v0[0], v0[1]); w.y = pack2(v0[2], v0[3]); w.z = pack2(v1[0], v1[1]); w.w = pack2(v1[2], v1[3]);
                        *(U4*)(dst + row * ld + cl + wc * 32 + 8 * fq) = w; }
            } else if (gatep) {
                const int gcol = cl + wc * 32 + 8 * fq, br = gcol / D, col = gcol - br * D;
#pragma unroll
                for (int ai = 0; ai < 2; ++ai)
#pragma unroll
                    for (int m = 0; m < 4; ++m) { const int row = u.pm * BM + ai * HALF + wr * 64 + m * 16 + fr;
                        const f32x4 v0 = acc[ai][bj][m][0], v1 = acc[ai][bj][m][1];
                        bf16_t* q = gatep + gate_idx(row, br, col);
                        *(U2*)q = (U2){pack2(v0[0], v0[1]), pack2(v0[2], v0[3])}; *(U2*)(q + 64) = (U2){pack2(v1[0], v1[1]), pack2(v1[2], v1[3])}; }
            } else if (dT) {
                bf16_t* T = (bf16_t*)(stg + wid * (16 * 72 * 2));
#pragma unroll
                for (int ai = 0; ai < 2; ++ai) { int b, key0; tok_bk(u.pm * BM + ai * HALF + wr * 64, b, key0);
#pragma unroll
                    for (int n = 0; n < 2; ++n) {
#pragma unroll
                        for (int m = 0; m < 4; ++m)
#pragma unroll
                            for (int j = 0; j < 4; ++j) T[(4 * fq + j) * 72 + m * 16 + fr] = f2bf(acc[ai][bj][m][n][j]);
                        PG8_WAVE_SYNC();
                        { const int ci = lane >> 2, part = lane & 3; const U4 o0 = *(const U4*)(T + ci * 72 + part * 16), o1 = *(const U4*)(T + ci * 72 + part * 16 + 8);
                            bf16_t* q = dT + ((long)b * ncT + cl + wc * 32 + 8 * (ci >> 2) + 4 * n + (ci & 3)) * KEYS + key0 + part * 16;
                            *(U4*)q = o0; *(U4*)(q + 8) = o1; }
                        PG8_WAVE_SYNC(); } }
            } else if (gab) {
                float* GAB = GPTR(float, ws + OFF_GAB);
#pragma unroll
                for (int ai = 0; ai < 2; ++ai)
#pragma unroll
                    for (int m = 0; m < 4; ++m) { const long row = (long)u.pm * BM + ai * HALF + wr * 64 + m * 16 + fr;
                        const f32x4 v0 = acc[ai][bj][m][0], v1 = acc[ai][bj][m][1];
                        *(F4*)(GAB + row * 32 + 8 * fq) = (F4){v0[0], v0[1], v0[2], v0[3]}; *(F4*)(GAB + row * 32 + 8 * fq + 4) = (F4){v1[0], v1[1], v1[2], v1[3]}; }
            }
        }
    }
};
}

#ifdef CPU_EMU
#define WSP(T, off) GPTR(T, p.ws + (off))
#else
typedef __attribute__((address_space(1))) char* gchar_p;
__device__ __forceinline__ gchar_p ws_opaque(char* w) { gchar_p g = (gchar_p)w; asm volatile("" : "+s"(g)); return g; }
#define WSP(T, off) ((T*)(__attribute__((address_space(1))) T*)(ws_opaque(p.ws) + (off)))
#endif
constexpr float DN_ALPHA_F =
#ifdef SMALL_DIMS
    1.4142135623730951f;
#else
    1.681792830507429f;
#endif

__device__ __forceinline__ void phase_prologue(const Params& p, char* lds) {
    const int tid = TID(), G = gridDim.x, bid = BID();
    { float* RWT = WSP(float, OFF_RWT); for (int i = bid * NTH + tid; i < D * 16; i += G * NTH) RWT[(i & 15) * D + (i >> 4)] = GIN(p.router_w)[i]; }
    float* sc = (float*)lds;
    for (int i = tid; i < 3 * D; i += NTH) { int r = i / D, k = i - r * D; float v = r < 2 ? GIN(p.c)[r * D + k] : GIN(p.c_ctx)[k]; sc[i] = siluf(v); }
    __syncthreads();
    float* MODP = WSP(float, OFF_MODP);
    constexpr int NCHK = 6 * D / NTH, KS = D / 8;
    for (int it = bid; it < DEPTH * 8 * NCHK; it += G) {
        int l = it / (8 * NCHK), rem = it - l * 8 * NCHK, s = rem / NCHK, ch = rem - s * NCHK;
        int n = ch * NTH + tid; const float* w = GIN(p.w_mod) + ((long)l * D + s * KS) * 6 * D + n;
        float a0 = 0.f, a1 = 0.f, a2 = 0.f;
#pragma unroll 8
        for (int k = 0; k < KS; ++k) { float wv = w[(long)k * 6 * D]; a0 += sc[s * KS + k] * wv; a1 += sc[D + s * KS + k] * wv; a2 += sc[2 * D + s * KS + k] * wv; }
        float* o = MODP + (((long)l * 8 + s) * 3) * 6 * D + n; o[0] = a0; o[6 * D] = a1; o[12 * D] = a2;
    }
}

constexpr int U_WIN = (NPROJ / 64) * (D / 64), U_BP = 4 * (MW / 64) * (D / 64), U_WO = (D / 64) * (D / 64), U_CVT = U_WIN + U_BP + U_WO;
__device__ __forceinline__ void cvt_unit(const Params& p, char* lds, int l, int u) {
    if (u < U_WIN) { int nt = u / (D / 64), kt = u - nt * (D / 64); const float* src = GIN(p.w_in) + (long)l * D * IN_TOTAL;
        auto sp = [&](int k, int n) -> const float* { int sc;
            if (n < MY_DQKV) sc = n; else if (n < MY_GAB) sc = n + 4 * GH; else if (n < MY_GATE) { int j = n - MY_GAB; if (j >= 4 * GH) return nullptr; sc = SRC_GA + j; } else sc = SRC_GATE + (n - MY_GATE);
            return src + (long)k * IN_TOTAL + sc; };
        cvt_tile(lds, sp, kt * 64, nt * 64, WSP(bf16_t, off_win(l)), D);
    } else if (u < U_WIN + U_BP) { int v = u - U_WIN; int m = v / ((MW / 64) * (D / 64)), r = v - m * ((MW / 64) * (D / 64)), nt = r / (MW / 64), kt = r - nt * (MW / 64);
        const float* src = GIN(p.branch_proj) + ((long)(l * 4 + m) * MW) * D;
        auto sp = [&](int k, int n) -> const float* { return src + (long)k * D + n; };
        cvt_tile(lds, sp, kt * 64, nt * 64, WSP(bf16_t, off_bp(l)) + m * MW, 4 * MW);
    } else { int v = u - U_WIN - U_BP; int nt = v / (D / 64), kt = v - nt * (D / 64); const float* src = GIN(p.w_out) + (long)l * D * D;
        auto sp = [&](int k, int n) -> const float* { return src + (long)k * D + n; };
        cvt_tile(lds, sp, kt * 64, nt * 64, WSP(bf16_t, off_wo(l)), D);
    }
}
__device__ __forceinline__ void w3t_chunk(const Params& p, int l, int i0, int n) {
    const int tid = TID(); bf16_t* W3T = WSP(bf16_t, OFF_W3T); const float* w3 = GIN(p.hy_w3) + (long)l * 64 * 4 * HYW;
    for (int i = i0 + tid; i < i0 + n; i += NTH) { const int col = i >> 7, k = i & 127; W3T[i] = k < 64 ? f2bf(w3[(long)k * 4 * HYW + col]) : (bf16_t)0; }
}
__device__ __forceinline__ void h2f_positions(const Params& p, int l, int pos0, int iters) {
    const int tid = TID(), lane = tid & 63, wid = tid >> 6;
    float* H2F = WSP(float, OFF_H2F); bf16_t* H2B = WSP(bf16_t, OFF_H2B);
    const float* w1 = GIN(p.hy_w1) + (long)l * HY_EMB * 64; const float* b1 = GIN(p.hy_b1) + l * 64; const float* w2 = GIN(p.hy_w2) + (long)l * 64 * 64; const float* b2 = GIN(p.hy_b2) + l * 64; const float fr = GIN(p.hy_freq)[l * 64 + lane];
    for (int it = 0; it < iters; ++it) { const int pos = pos0 + it * 8 + wid; if (pos >= KEYS) break;
        int L = pos < SEQ ? SEQ : CTX, t = pos < SEQ ? pos : pos - SEQ;
        float feat = 0.f;
        if (lane == 0) feat = (float)t / (float)(L - 1);
        else if (lane < 33) { int bi = (lane - 1) & 15; float band = 1e-4f + (float)bi * ((15.0f - 1e-4f) / 15.0f); float ang = 6.283185307179586f * (float)t / (float)L; float a = band * ang;
            feat = lane < 17 ? cosf(a) : -sinf(a); }
        float a1 = b1[lane];
        for (int e = 0; e < HY_EMB; ++e) a1 += __shfl(feat, e) * w1[e * 64 + lane];
        float h1 = sinf(fr * a1);
        float a2 = b2[lane];
        for (int i = 0; i < 64; ++i) a2 += __shfl(h1, i) * w2[i * 64 + lane];
        const float hv = sinf(fr * a2); H2F[(long)pos * 64 + lane] = hv; H2B[(long)pos * 128 + lane] = f2bf(hv); H2B[(long)pos * 128 + 64 + lane] = 0; }
}
__device__ __forceinline__ void phase_weights(const Params& p, char* lds, int l) {
    const int tid = TID(), G = gridDim.x, bid = BID();
    { const float* MODP = WSP(float, OFF_MODP); float* MOD = WSP(float, OFF_MOD);
        for (int i = bid * NTH + tid; i < DEPTH * 3 * 6 * D; i += G * NTH) { int ll = i / (18 * D), rem = i - ll * 18 * D, n = rem % (6 * D);
            float a = GIN(p.b_mod)[ll * 6 * D + n];
#pragma unroll
            for (int s = 0; s < 8; ++s) a += MODP[((long)ll * 8 + s) * 18 * D + rem];
            MOD[i] = a; } }
    if (bid == 0 && tid < 64) WSP(u32, OFF_CNT)[64 + tid] = 0u;
    for (int u = bid; u < U_CVT; u += G) cvt_unit(p, lds, l, u);
    for (int c = bid; c < (4 * HYW * 128 + 8191) / 8192; c += G) w3t_chunk(p, l, c * 8192, 8192);
    for (int c = bid; c < (KEYS + 63) / 64; c += G) h2f_positions(p, l, c * 64, 8);
}

__device__ __forceinline__ void phase_expert_weights(const Params& p, char* lds, int l, int bid, int G) {
    constexpr int U13 = (2 * EFF / 64) * (D / 64), U2_ = (D / 64) * (EFF / 64);
    for (int u = bid < 0 ? NE * (U13 + U2_) : bid; u < NE * (U13 + U2_); u += G) {
        int e = u / (U13 + U2_), v = u - e * (U13 + U2_);
        if (v < U13) { int nt = v / (D / 64), kt = v - nt * (D / 64);
            const float* s1 = GIN(p.exp_w1) + ((long)(l * NE + e) * D) * EFF; const float* s3 = GIN(p.exp_w3) + ((long)(l * NE + e) * D) * EFF;
            const long d13 = (long)((uintptr_t)s1 - (uintptr_t)s3);
            auto sp = [&](int k, int n) -> const float* { int grp = n >> 5, w = n & 31; return (const float*)((uintptr_t)s3 + (uintptr_t)(w < 16 ? d13 : 0L)) + (long)k * EFF + grp * 16 + (w & 15); };
            cvt_tile(lds, sp, kt * 64, nt * 64, WSP(bf16_t, OFF_W13) + (long)e * 2 * EFF * D, D);
        } else { int w = v - U13; int nt = w / (EFF / 64), kt = w - nt * (EFF / 64); const float* s2 = GIN(p.exp_w2) + ((long)(l * NE + e) * EFF) * D;
            auto sp = [&](int k, int n) -> const float* { return s2 + (long)k * D + n; };
            cvt_tile(lds, sp, kt * 64, nt * 64, WSP(bf16_t, OFF_W2) + (long)e * D * EFF, EFF);
        }
    }
}

constexpr int RV = D / 256;
__device__ __forceinline__ void row_stats(const F4 (&v)[RV], float& mean, float& rstd) {
    float s = 0.f;
#pragma unroll
    for (int i = 0; i < RV; ++i) s += (v[i].x + v[i].y) + (v[i].z + v[i].w);
    mean = wave_sum(s) * (1.0f / D);
    float q = 0.f;
#pragma unroll
    for (int i = 0; i < RV; ++i) { float a = v[i].x - mean, b = v[i].y - mean, c = v[i].z - mean, d = v[i].w - mean; q += (a * a + b * b) + (c * c + d * d); }
    rstd = rsqrtf(wave_sum(q) * (1.0f / D) + LN_EPS);
}
__device__ __forceinline__ void row_stats2(const F4 (&v)[2][RV], float (&mean)[2], float (&rstd)[2]) {
    float s0 = 0.f, s1 = 0.f;
#pragma unroll
    for (int i = 0; i < RV; ++i) { s0 += (v[0][i].x + v[0][i].y) + (v[0][i].z + v[0][i].w); s1 += (v[1][i].x + v[1][i].y) + (v[1][i].z + v[1][i].w); }
    s0 = xadd<32>(s0); s1 = xadd<32>(s1); s0 = xadd<16>(s0); s1 = xadd<16>(s1); s0 = xadd<8>(s0); s1 = xadd<8>(s1); s0 = xadd<4>(s0); s1 = xadd<4>(s1); s0 = xadd<2>(s0); s1 = xadd<2>(s1); s0 = xadd<1>(s0); s1 = xadd<1>(s1);
    mean[0] = s0 * (1.0f / D); mean[1] = s1 * (1.0f / D);
    float q0 = 0.f, q1 = 0.f;
#pragma unroll
    for (int i = 0; i < RV; ++i) { float a = v[0][i].x - mean[0], b = v[0][i].y - mean[0], c = v[0][i].z - mean[0], d = v[0][i].w - mean[0]; q0 += (a * a + b * b) + (c * c + d * d);
        a = v[1][i].x - mean[1]; b = v[1][i].y - mean[1]; c = v[1][i].z - mean[1]; d = v[1][i].w - mean[1]; q1 += (a * a + b * b) + (c * c + d * d); }
    q0 = xadd<32>(q0); q1 = xadd<32>(q1); q0 = xadd<16>(q0); q1 = xadd<16>(q1); q0 = xadd<8>(q0); q1 = xadd<8>(q1); q0 = xadd<4>(q0); q1 = xadd<4>(q1); q0 = xadd<2>(q0); q1 = xadd<2>(q1); q0 = xadd<1>(q0); q1 = xadd<1>(q1);
    rstd[0] = rsqrtf(q0 * (1.0f / D) + LN_EPS); rstd[1] = rsqrtf(q1 * (1.0f / D) + LN_EPS);
}
__device__ __forceinline__ void row_modulate_store(const F4 (&v)[RV], float mean, float rstd, const float* shift, const float* scale, bf16_t* dst, int lane, F4 (*keep)[RV] = nullptr) {
#pragma unroll
    for (int i = 0; i < RV; ++i) { int n = (i * 64 + lane) * 4; F4 sh = *(const F4*)(shift + n), sc = *(const F4*)(scale + n);
        F4 h; h.x = (v[i].x - mean) * rstd * (1.0f + sc.x) + sh.x; h.y = (v[i].y - mean) * rstd * (1.0f + sc.y) + sh.y; h.z = (v[i].z - mean) * rstd * (1.0f + sc.z) + sh.z; h.w = (v[i].w - mean) * rstd * (1.0f + sc.w) + sh.w;
        U2 o; o.x = pack2(h.x, h.y); o.y = pack2(h.z, h.w); *(U2*)(dst + n) = o; if (keep) (*keep)[i] = h; }
}

__device__ __forceinline__ const float* xs_row(const Params& p, int l, int row) {
    const uintptr_t a = (uintptr_t)(WSP(float, OFF_XS) + (long)row * D);
    const uintptr_t b = row < NLAT ? (uintptr_t)(GIN(p.x) + (long)row * D) : (uintptr_t)(GIN(p.ctx) + (long)(row - NLAT) * D);
    return (const float*)(l == 0 ? b : a);
}
__device__ __forceinline__ void phase_modulate0(const Params& p, int l) {
    const int tid = TID(), lane = tid & 63, wid = tid >> 6;
    const float* XS = WSP(float, OFF_XS); bf16_t* H = WSP(bf16_t, OFF_H); const float* MOD = WSP(float, OFF_MOD) + (long)l * 18 * D;
    for (int row = BID() * 8 + wid; row < NTOK; row += gridDim.x * 8) {
        F4 v[RV]; const float* xr = xs_row(p, l, row);
#pragma unroll
        for (int i = 0; i < RV; ++i) v[i] = *(const F4*)(xr + (i * 64 + lane) * 4);
        float mean, rstd; row_stats(v, mean, rstd);
        const float* m = MOD + mod_row(row) * 6 * D;
        row_modulate_store(v, mean, rstd, m, m + D, H + (long)row * D, lane);
    }
}

__device__ __forceinline__ void phase_post_mix(const Params& p, char* lds, int l, bool dry = false) {
    const int tid = TID(), lane = tid & 63, wid = tid >> 6;
    float* XS = WSP(float, OFF_XS); const bf16_t* MIX = WSP(bf16_t, OFF_MIX); bf16_t* H = WSP(bf16_t, OFF_H); const float* MOD = WSP(float, OFF_MOD) + (long)l * 18 * D;
    const float* lng = GIN(p.ln_g) + (long)(l * 2 + 0) * D; const float* lnb = GIN(p.ln_b) + (long)(l * 2 + 0) * D;
    u32* CNT = WSP(u32, OFF_CNT) + (dry ? 128 : 0); float* XSO = dry ? WSP(float, OFF_YE) : XS; int* TOKE = WSP(int, OFF_TOKE); int* TOKR = WSP(int, OFF_TOKR); float* TOKW = WSP(float, OFF_TOKW); int* ELIST = WSP(int, OFF_ELIST);
    const int nrows = (l == DEPTH - 1) ? NLAT : NTOK;
    float* rwT = (float*)lds; u32* lcnt = (u32*)(lds + 16 * D * 4); u32* lbase = lcnt + 16;
    __syncthreads();
    for (int i = tid; i < D * 16; i += NTH) rwT[(i & 15) * D + (i >> 4)] = GIN(p.router_w)[i];
    if (tid < 16) lcnt[tid] = 0u;
    __syncthreads();
    for (int row = BID() * 8 + wid; row < nrows; row += gridDim.x * 8) {
        const float* m = MOD + mod_row(row) * 6 * D; const float* xr = xs_row(p, l, row);
        F4 v[RV];
#pragma unroll
        for (int i = 0; i < RV; ++i) { int n = (i * 64 + lane) * 4; F4 x = *(const F4*)(xr + n), g2 = *(const F4*)(m + 2 * D + n); const U2 mxp = *(const U2*)(MIX + (long)row * D + n); const F4 mx = (F4){bflo(mxp.x), bfhi(mxp.x), bflo(mxp.y), bfhi(mxp.y)};
            v[i].x = fmaf(g2.x, mx.x, DN_ALPHA_F * x.x); v[i].y = fmaf(g2.y, mx.y, DN_ALPHA_F * x.y); v[i].z = fmaf(g2.z, mx.z, DN_ALPHA_F * x.z); v[i].w = fmaf(g2.w, mx.w, DN_ALPHA_F * x.w); }
        float mean, rstd; row_stats(v, mean, rstd);
#pragma unroll
        for (int i = 0; i < RV; ++i) { int n = (i * 64 + lane) * 4; F4 g = *(const F4*)(lng + n), b = *(const F4*)(lnb + n);
            v[i].x = (v[i].x - mean) * rstd * g.x + b.x; v[i].y = (v[i].y - mean) * rstd * g.y + b.y; v[i].z = (v[i].z - mean) * rstd * g.z + b.z; v[i].w = (v[i].w - mean) * rstd * g.w + b.w;
            *(F4*)(XSO + (long)row * D + n) = v[i]; }
        row_stats(v, mean, rstd);
        F4 h[RV];
        row_modulate_store(v, mean, rstd, m + 3 * D, m + 4 * D, H + (long)row * D, lane, &h);
        float lg[16];
#pragma unroll
        for (int e = 0; e < 16; ++e) lg[e] = 0.f;
        { const float* wp = rwT + lane * 4;
#pragma unroll
            for (int i = 0; i < RV; ++i)
#pragma unroll
                for (int eg = 0; eg < 4; ++eg) {
#pragma unroll
                    for (int e = eg * 4; e < eg * 4 + 4; ++e) { const F4 w = *(const F4*)(wp + e * D + i * 256); lg[e] += (h[i].x * w.x + h[i].y * w.y) + (h[i].z * w.z + h[i].w * w.w); }
#ifndef CPU_EMU
                    { int z; asm volatile("v_mov_b32 %0, 0" : "=v"(z) : "v"(lg[eg * 4 + 3])); wp += z; }
#endif
                } }
        float s[16], sel[16];
#pragma unroll
        for (int e = 0; e < 16; ++e) { lg[e] = wave_sum(lg[e]); s[e] = sigmoidf(lg[e]); sel[e] = s[e] + GIN(p.router_b)[e]; }
        float gs[4];
#pragma unroll
        for (int gq = 0; gq < 4; ++gq) { float a = sel[gq * 4], b = sel[gq * 4 + 1], c = sel[gq * 4 + 2], d = sel[gq * 4 + 3];
            float m1 = fmaxf(fmaxf(a, b), fmaxf(c, d)); float lo_ab = fminf(a, b), hi_ab = fmaxf(a, b), lo_cd = fminf(c, d), hi_cd = fmaxf(c, d);
            float m2 = fmaxf(fminf(hi_ab, hi_cd), fmaxf(lo_ab, lo_cd)); gs[gq] = m1 + m2; }
        int bg = 0; float bv = gs[0];
#pragma unroll
        for (int gq = 1; gq < 4; ++gq) if (gs[gq] > bv) { bv = gs[gq]; bg = gq; }
        float c0 = 0.f, c1 = 0.f, c2 = 0.f, c3 = 0.f, t0 = 0.f, t1 = 0.f, t2 = 0.f, t3 = 0.f;
#pragma unroll
        for (int gq = 0; gq < 4; ++gq) if (gq == bg) { c0 = sel[gq * 4]; c1 = sel[gq * 4 + 1]; c2 = sel[gq * 4 + 2]; c3 = sel[gq * 4 + 3]; t0 = s[gq * 4]; t1 = s[gq * 4 + 1]; t2 = s[gq * 4 + 2]; t3 = s[gq * 4 + 3]; }
        int i0 = 0; float v0 = c0, w0 = t0;
        if (c1 > v0) { v0 = c1; i0 = 1; w0 = t1; } if (c2 > v0) { v0 = c2; i0 = 2; w0 = t2; } if (c3 > v0) { v0 = c3; i0 = 3; w0 = t3; }
        int i1 = -1; float v1 = -3.0e38f, w1 = 0.f;
        if (i0 != 0 && c0 > v1) { v1 = c0; i1 = 0; w1 = t0; } if (i0 != 1 && c1 > v1) { v1 = c1; i1 = 1; w1 = t1; } if (i0 != 2 && c2 > v1) { v1 = c2; i1 = 2; w1 = t2; } if (i0 != 3 && c3 > v1) { v1 = c3; i1 = 3; w1 = t3; }
        if (lane == 0) { float ws = w0 + w1; int e0 = bg * 4 + i0, e1 = bg * 4 + i1;
            int r0 = (int)atomicAdd(&lcnt[e0], 1u), r1 = (int)atomicAdd(&lcnt[e1], 1u);
            TOKE[row * 2] = e0; TOKE[row * 2 + 1] = e1; TOKR[row * 2] = r0; TOKR[row * 2 + 1] = r1; TOKW[row * 2] = w0 / ws; TOKW[row * 2 + 1] = w1 / ws; }
    }
    __syncthreads();
    if (tid < 16) lbase[tid] = lcnt[tid] ? atomicAdd(&CNT[tid], lcnt[tid]) : 0u;
    __syncthreads();
    if (tid < 16) for (int row0 = BID() * 8; row0 < nrows; row0 += (int)gridDim.x * 8) { const int row = row0 + (tid >> 1), k = tid & 1;
        const int e = TOKE[row * 2 + k]; const int r = TOKR[row * 2 + k] + (int)lbase[e]; TOKR[row * 2 + k] = r; ELIST[(long)e * NTOK + r] = row; }
}

__device__ __forceinline__ void phase_post_moe(const Params& p, int l, bool dry = false) {
    const int tid = TID(), lane = tid & 63, wid = tid >> 6;
    float* XS = WSP(float, OFF_XS); bf16_t* H = WSP(bf16_t, OFF_H); const float* MOD = WSP(float, OFF_MOD) + (long)l * 18 * D;
    const bf16_t* YE = WSP(bf16_t, OFF_YE);
    const float* lng = GIN(p.ln_g) + (long)(l * 2 + 1) * D; const float* lnb = GIN(p.ln_b) + (long)(l * 2 + 1) * D;
    const u32* CNT = WSP(u32, OFF_CNT); const int* TOKE = WSP(int, OFF_TOKE); const int* TOKR = WSP(int, OFF_TOKR); const float* TOKW = WSP(float, OFF_TOKW);
    const bool last = (l == DEPTH - 1);
    const int nrows = last ? NLAT : NTOK;
    int eoff = 0;
    { int c = lane < 16 ? (int)CNT[lane] : 0; int incl = c;
        for (int o = 1; o < 16; o <<= 1) { int t = __shfl_up(incl, o); if (lane >= o) incl += t; }
        eoff = incl - c; }
    const int stride = (int)gridDim.x * 8;
    for (int row0 = BID() * 8 + wid; row0 < nrows; row0 += 2 * stride) {
        const bool two = row0 + stride < nrows;
        int rowv[2] = {row0, two ? row0 + stride : row0};
        F4 v[2][RV]; const float* mm[2];
#pragma unroll
        for (int q = 0; q < 2; ++q) { const int row = rowv[q]; mm[q] = MOD + mod_row(row) * 6 * D;
            const int e0 = TOKE[row * 2], e1 = TOKE[row * 2 + 1];
            const long p0 = (long)__shfl(eoff, e0) + TOKR[row * 2], p1 = (long)__shfl(eoff, e1) + TOKR[row * 2 + 1];
            const float w0 = TOKW[row * 2], w1 = TOKW[row * 2 + 1];
#pragma unroll
            for (int i = 0; i < RV; ++i) { int n = (i * 64 + lane) * 4; F4 x = *(const F4*)(XS + (long)row * D + n), g5 = *(const F4*)(mm[q] + 5 * D + n);
                U2 a = *(const U2*)(YE + p0 * D + n), b = *(const U2*)(YE + p1 * D + n);
                float y0 = w0 * bflo(a.x) + w1 * bflo(b.x), y1 = w0 * bfhi(a.x) + w1 * bfhi(b.x), y2 = w0 * bflo(a.y) + w1 * bflo(b.y), y3 = w0 * bfhi(a.y) + w1 * bfhi(b.y);
                v[q][i].x = fmaf(g5.x, y0, DN_ALPHA_F * x.x); v[q][i].y = fmaf(g5.y, y1, DN_ALPHA_F * x.y); v[q][i].z = fmaf(g5.z, y2, DN_ALPHA_F * x.z); v[q][i].w = fmaf(g5.w, y3, DN_ALPHA_F * x.w); } }
        float mean[2], rstd[2]; row_stats2(v, mean, rstd);
#pragma unroll
        for (int q = 0; q < 2; ++q) { if (q == 1 && !two) break; const int row = rowv[q];
            float* dst = dry ? WSP(float, OFF_MIX) + (long)row * D : (last ? GPTR(float, p.out) + (long)row * D : XS + (long)row * D);
#pragma unroll
            for (int i = 0; i < RV; ++i) { int n = (i * 64 + lane) * 4; F4 g = *(const F4*)(lng + n), b = *(const F4*)(lnb + n);
                v[q][i].x = (v[q][i].x - mean[q]) * rstd[q] * g.x + b.x; v[q][i].y = (v[q][i].y - mean[q]) * rstd[q] * g.y + b.y; v[q][i].z = (v[q][i].z - mean[q]) * rstd[q] * g.z + b.z; v[q][i].w = (v[q][i].w - mean[q]) * rstd[q] * g.w + b.w;
                *(F4*)(dst + n) = v[q][i]; } }
        if (!last) { row_stats2(v, mean, rstd);
#pragma unroll
            for (int q = 0; q < 2; ++q) { if (q == 1 && !two) break; const float* m2 = mm[q] + 18 * D; row_modulate_store(v[q], mean[q], rstd[q], m2, m2 + D, H + (long)rowv[q] * D, lane); } }
    }
}
__device__ __forceinline__ void st4bf(bf16_t* dst, f32x4 v) { U2 o; o.x = pack2(v[0], v[1]); o.y = pack2(v[2], v[3]); *(U2*)dst = o; }

__device__ __forceinline__ void phase_inproj(const Params& p, char* lds, int l, int part  ) {
    pg8::Gemm g; g.A = WSP(bf16_t, OFF_H); g.Bt = WSP(bf16_t, off_win(l)) + (long)(part == 0 ? 0 : NPROJ1) * D; g.M = NTOK; g.N = part == 0 ? NPROJ1 : 4 * D; g.K = D;
    pg8::StaticOrder S; S.init(g.M, g.N, (int)gridDim.x, BID());
    pg8::EpiInproj E; E.ws = p.ws; E.stg = lds + 131072; E.ncol0 = part == 0 ? 0 : NPROJ1;
    __syncthreads();
    pg8::gemm_phase<pg8::EpiInproj, pg8::StaticOrder, false>((PG8_LAS unsigned char*)lds, g, S, E, nullptr);
    __syncthreads();
    if (part == 1) {
        const int G = (int)gridDim.x, rem = S.nwg % G, c = BID();
        for (int rep_ = 0; rep_ < REP_W; ++rep_) phase_expert_weights(p, lds, l, rem == 0 ? c : c - rem, rem == 0 ? G : G - rem);
    }
}

__device__ __forceinline__ void phase_prep(const Params& p, char* lds, int l, bool do_rope = true, bool do_c = true, bool do_d = true) {
    const int tid = TID(), G = gridDim.x, bid = BID(), lane = tid & 63, wid = tid >> 6;
    if (bid == 0 && tid < 64) { WSP(u32, OFF_CNT)[tid] = 0u; WSP(u32, OFF_CNT)[128 + tid] = 0u; }
    if (do_rope) {
        bf16_t* DQ = WSP(bf16_t, OFF_SEG_DQKV);
        constexpr int NV = 4 * DH;
        for (long i = (long)bid * NTH + tid; i < (long)NLAT * 32; i += (long)G * NTH) {
            int tok = (int)(i >> 5), f2 = (int)(i & 31);
            int t = tok % SEQ; int axis = f2 >> 4, f = f2 & 15;
            float pos = axis == 0 ? (float)(t / GW) : (float)(t % GW);
            float inv = powf(10000.0f, -(float)f / 16.0f);
            float ang = pos * inv, sn = sinf(ang), cs = cosf(ang);
            bf16_t* base = DQ + (long)tok * 3 * MW + axis * 32 + f;
#pragma unroll
            for (int v = 0; v < NV; ++v) { bf16_t* q = base + v * 64; const float qs = v < 2 * DH ? 0.125f * 1.4426950408889634f : 1.0f;
                float x1 = bf2f(q[0]), x2 = bf2f(q[16]); q[0] = f2bf((x1 * cs - x2 * sn) * qs); q[16] = f2bf((x1 * sn + x2 * cs) * qs); }
        }
    }
    if (do_c) {
        const bf16_t* SG = WSP(bf16_t, OFF_SEG_GQKV); bf16_t* GQ = WSP(bf16_t, OFF_GQ); bf16_t* GK = WSP(bf16_t, OFF_GK); bf16_t* GV = WSP(bf16_t, OFF_GV);
        const float* cwp = GIN(p.gdn_conv) + (long)l * 3 * MW * 3;
        const int sub = tid & 7;
        for (long i = ((long)bid * NTH + tid) >> 3; i < (long)NTOK * GH; i += ((long)G * NTH) >> 3) {
            const int tok = (int)(i / GH), h = (int)(i - (long)tok * GH);
            int seq0, len; if (tok < NLAT) { seq0 = (tok / SEQ) * SEQ; len = SEQ; } else { seq0 = NLAT + ((tok - NLAT) / CTX) * CTX; len = CTX; }
            const int t = tok - seq0; const bool hasp = t > 0, hasn = t + 1 < len;
            float u[3][8];
#pragma unroll
            for (int part = 0; part < 3; ++part) { const int c = part * MW + h * 64 + sub * 8; const bf16_t* s = SG + (long)tok * 3 * MW + c;
                const U4 x1 = *(const U4*)s; const U4 x0 = hasp ? *(const U4*)(s - 3 * MW) : (U4){0u, 0u, 0u, 0u}; const U4 x2 = hasn ? *(const U4*)(s + 3 * MW) : (U4){0u, 0u, 0u, 0u};
                const u32 a0[4] = {x0.x, x0.y, x0.z, x0.w}, a1[4] = {x1.x, x1.y, x1.z, x1.w}, a2[4] = {x2.x, x2.y, x2.z, x2.w};
                float w[24];
#pragma unroll
                for (int q = 0; q < 6; ++q) { const F4 wv = *(const F4*)(cwp + c * 3 + q * 4); w[q * 4] = wv.x; w[q * 4 + 1] = wv.y; w[q * 4 + 2] = wv.z; w[q * 4 + 3] = wv.w; }
#pragma unroll
                for (int e = 0; e < 4; ++e) {
                    float lo = bflo(a0[e]) * w[(2 * e) * 3] + bflo(a1[e]) * w[(2 * e) * 3 + 1] + bflo(a2[e]) * w[(2 * e) * 3 + 2];
                    float hi = bfhi(a0[e]) * w[(2 * e + 1) * 3] + bfhi(a1[e]) * w[(2 * e + 1) * 3 + 1] + bfhi(a2[e]) * w[(2 * e + 1) * 3 + 2];
                    u[part][2 * e] = siluf(lo); u[part][2 * e + 1] = siluf(hi); } }
            float nq = 0.f, nk = 0.f;
#pragma unroll
            for (int e = 0; e < 8; ++e) { nq += u[0][e] * u[0][e]; nk += u[1][e] * u[1][e]; }
            nq = xadd<1>(nq); nq = xadd<2>(nq); nq = xadd<4>(nq);
            nk = xadd<1>(nk); nk = xadd<2>(nk); nk = xadd<4>(nk);
            const float rq = rsqrtf(nq + RMS_EPS) * 0.125f, rk = rsqrtf(nk + RMS_EPS);
            const long o = (long)tok * MW + h * 64 + sub * 8;
            *(U4*)(GQ + o) = (U4){pack2(u[0][0] * rq, u[0][1] * rq), pack2(u[0][2] * rq, u[0][3] * rq), pack2(u[0][4] * rq, u[0][5] * rq), pack2(u[0][6] * rq, u[0][7] * rq)};
            *(U4*)(GK + o) = (U4){pack2(u[1][0] * rk, u[1][1] * rk), pack2(u[1][2] * rk, u[1][3] * rk), pack2(u[1][4] * rk, u[1][5] * rk), pack2(u[1][6] * rk, u[1][7] * rk)};
            *(U4*)(GV + o) = (U4){pack2(u[2][0], u[2][1]), pack2(u[2][2], u[2][3]), pack2(u[2][4], u[2][5]), pack2(u[2][6], u[2][7])};
        }
        const float* GAB = WSP(float, OFF_GAB); float* GB = WSP(float, OFF_GB);
        for (long i = (long)bid * NTH + tid; i < (long)NTOK * 2 * GH; i += (long)G * NTH) {
            int tok = (int)(i / (2 * GH)), dh = (int)(i - (long)tok * 2 * GH);
            float a = GAB[(long)tok * 32 + dh], b = GAB[(long)tok * 32 + 2 * GH + dh];
            float xa = a + GIN(p.gdn_dt_bias)[l * 2 * GH + dh]; float sp = xa > 20.f ? xa : log1pf(__expf(xa));
            GB[(long)tok * 4 * GH + dh] = -__expf(GIN(p.gdn_a_log)[l * 2 * GH + dh]) * sp;
            GB[(long)tok * 4 * GH + 2 * GH + dh] = sigmoidf(b);
        }
    }
    if (do_d) {
        const bf16_t* H2B = WSP(bf16_t, OFF_H2B); const bf16_t* W3T = WSP(bf16_t, OFF_W3T); bf16_t* TAPS = WSP(bf16_t, OFF_TAPS);
        const int wid = tid >> 6, wm = wid >> 1, wn = wid & 1, l15 = lane & 15, g = lane >> 4;
        constexpr int MT = 3, ntm = KEYS / (64 * MT), ntn = 4 * HYW / G_BN;
        for (int u = bid; u < ntm * ntn; u += G) {
            const int tn = u / ntm, tm = u - tn * ntm, row0 = tm * 64 * MT, col0 = tn * G_BN;
            f32x4 acc[MT][4];
            gemm_tile<MT>(lds, [&](int r) { return H2B + (long)(row0 + r) * 128; }, W3T + (long)col0 * 128, 128, 128, acc);
#pragma unroll
            for (int n = 0; n < 4; ++n) { const int colb = col0 + wn * 64 + n * 16 + g * 4;
                const F4 dl4 = *(const F4*)(GIN(p.hy_deltas) + (long)l * 4 * HYW + colb); const float dl[4] = {fabsf(dl4.x), fabsf(dl4.y), fabsf(dl4.z), fabsf(dl4.w)};
#pragma unroll
                for (int m = 0; m < MT; ++m) { const int pos = row0 + wm * 16 * MT + m * 16 + l15; const bool ctxp = pos >= SEQ; const int L = ctxp ? CTX : SEQ, t = ctxp ? pos - SEQ : pos;
                    const float tl = (float)t * (1.0f / (float)(L - 1));
#pragma unroll
                    for (int j = 0; j < 4; ++j) TAPS[(long)(colb + j) * KEYS + pos] = f2bf(acc[m][n][j] * (__expf(-tl * dl[j]) + 0.05f)); } }
        }
    }
}
constexpr int A_LD = 72, AK_LD = 80;
template <int DV> struct AttnLds { static constexpr int K_BYTES = 64 * AK_LD * 2, V_BYTES = DV * A_LD * 2, STAGE = K_BYTES + V_BYTES, TOTAL = 2 * STAGE; };
constexpr float LOG2E = 1.4426950408889634f;
constexpr float NEG_BIG = -1.0e30f;

template <int NQT, int DV, class QRow, class KTile, class MaskFn>
__device__ __forceinline__ void attn_core(char* lds, QRow qrow  , KTile ktile  ,
                                          int ntiles, MaskFn mask  , f32x4 (&oacc)[DV / 16][NQT], float (&lsum)[NQT]) {
    const int tid = TID(), wid = tid >> 6, lane = tid & 63, l15 = lane & 15, g = lane >> 4;
    constexpr int NDT = DV / 16, NVL = DV / 64;
    typedef AttnLds<DV> L;
    bf16x8 qf[NQT][2];
#pragma unroll
    for (int qt = 0; qt < NQT; ++qt) { const bf16_t* q = qrow(wid * NQT * 16 + qt * 16 + l15);
#pragma unroll
        for (int ks = 0; ks < 2; ++ks) qf[qt][ks] = ld8(q + ks * 32 + g * 8); }
    float mrun[NQT];
#pragma unroll
    for (int qt = 0; qt < NQT; ++qt) { mrun[qt] = NEG_BIG; lsum[qt] = 0.f;
#pragma unroll
        for (int dt = 0; dt < NDT; ++dt) oacc[dt][qt] = (f32x4){0.f, 0.f, 0.f, 0.f}; }
    const int sr = tid >> 3, ss = tid & 7;
    U4 rk, rv[NVL];
    { const bf16_t *kp, *vp; long kld, vld; ktile(0, kp, kld, vp, vld);
        rk = *(const U4*)(kp + (long)sr * kld + ss * 8);
#pragma unroll
        for (int i = 0; i < NVL; ++i) rv[i] = *(const U4*)(vp + (long)(sr + 64 * i) * vld + ss * 8); }
    __syncthreads();
    { bf16_t* sK = (bf16_t*)lds; bf16_t* sV = (bf16_t*)(lds + L::K_BYTES);
        *(U4*)(sK + sr * AK_LD + ss * 8) = rk;
#pragma unroll
        for (int i = 0; i < NVL; ++i) *(U4*)(sV + (sr + 64 * i) * A_LD + ss * 8) = rv[i]; }
    __syncthreads();
    for (int t = 0; t < ntiles; ++t) {
        const bool more = t + 1 < ntiles;
        if (more) { const bf16_t *kp, *vp; long kld, vld; ktile(t + 1, kp, kld, vp, vld);
            rk = *(const U4*)(kp + (long)sr * kld + ss * 8);
#pragma unroll
            for (int i = 0; i < NVL; ++i) rv[i] = *(const U4*)(vp + (long)(sr + 64 * i) * vld + ss * 8); }
        const bf16_t* sK = (const bf16_t*)(lds + (t & 1) * L::STAGE); const bf16_t* sV = (const bf16_t*)(lds + (t & 1) * L::STAGE + L::K_BYTES);
        f32x4 s[4][NQT];
#pragma unroll
        for (int mt = 0; mt < 4; ++mt) {
#pragma unroll
            for (int qt = 0; qt < NQT; ++qt) s[mt][qt] = (f32x4){0.f, 0.f, 0.f, 0.f};
#pragma unroll
            for (int ks = 0; ks < 2; ++ks) { bf16x8 kf = ld8(sK + (mt * 16 + l15) * AK_LD + ks * 32 + g * 8);
#pragma unroll
                for (int qt = 0; qt < NQT; ++qt) s[mt][qt] = MFMA16(kf, qf[qt][ks], s[mt][qt]); }
        }
        bf16x8 pf[2][NQT];
#pragma unroll
        for (int qt = 0; qt < NQT; ++qt) {
            const int qi = wid * NQT * 16 + qt * 16 + l15;
            float mx = NEG_BIG;
#pragma unroll
            for (int mt = 0; mt < 4; ++mt)
#pragma unroll
                for (int j = 0; j < 4; ++j) { float v = mask(t, mt, j, qi, s[mt][qt][j] * (0.125f * LOG2E)); s[mt][qt][j] = v; mx = fmaxf(mx, v); }
            mx = xmax<16>(mx); mx = xmax<32>(mx);
            const float mnew = fmaxf(mrun[qt], mx), alpha = fexp2(mrun[qt] - mnew); mrun[qt] = mnew;
            float ps = 0.f;
#pragma unroll
            for (int mt = 0; mt < 4; ++mt)
#pragma unroll
                for (int j = 0; j < 4; ++j) { float pv = fexp2(s[mt][qt][j] - mnew); s[mt][qt][j] = pv; ps += pv; }
            lsum[qt] = lsum[qt] * alpha + ps;
#pragma unroll
            for (int dt = 0; dt < NDT; ++dt) oacc[dt][qt] *= alpha;
#pragma unroll
            for (int kb = 0; kb < 2; ++kb) pf[kb][qt] = mk8u(pack2(s[2 * kb][qt][0], s[2 * kb][qt][1]), pack2(s[2 * kb][qt][2], s[2 * kb][qt][3]),
                                                             pack2(s[2 * kb + 1][qt][0], s[2 * kb + 1][qt][1]), pack2(s[2 * kb + 1][qt][2], s[2 * kb + 1][qt][3]));
        }
#pragma unroll
        for (int dt = 0; dt < NDT; ++dt)
#pragma unroll
            for (int kb = 0; kb < 2; ++kb) { const bf16_t* vr = sV + (dt * 16 + l15) * A_LD + kb * 32 + g * 4;
                bf16x8 vf = mk8(*(const U2*)vr, *(const U2*)(vr + 16));
#pragma unroll
                for (int qt = 0; qt < NQT; ++qt) oacc[dt][qt] = MFMA16(vf, pf[kb][qt], oacc[dt][qt]);
                if (kb == 1 && (dt & 1)) SCHED_FENCE(); }
        if (more) { bf16_t* dK = (bf16_t*)(lds + ((t + 1) & 1) * L::STAGE); bf16_t* dV = (bf16_t*)(lds + ((t + 1) & 1) * L::STAGE + L::K_BYTES);
            *(U4*)(dK + sr * AK_LD + ss * 8) = rk;
#pragma unroll
            for (int i = 0; i < NVL; ++i) *(U4*)(dV + (sr + 64 * i) * A_LD + ss * 8) = rv[i]; }
        __syncthreads();
    }
#pragma unroll
    for (int qt = 0; qt < NQT; ++qt) { float l = lsum[qt]; l = xadd<16>(l); l = xadd<32>(l); lsum[qt] = l; }
}

struct NoMask { __device__ __forceinline__ float operator()(int, int, int, int, float s) const { return s; } };

__device__ __forceinline__ void diff_lambda(const Params& p, int l, float& lam, float& lam_init) {
    const int lane = TID() & 63; const float* dl = GIN(p.diff_lam) + (long)l * 4 * 64;
    const float a = wave_sum(dl[lane] * dl[64 + lane]), b = wave_sum(dl[128 + lane] * dl[192 + lane]);
    int ll = l;
#ifndef CPU_EMU
    asm volatile("" : "+s"(ll));
#endif
    lam_init = 0.8f - 0.6f * expf(-0.3f * (float)ll); lam = expf(a) - expf(b) + lam_init;
}
template <int NQT>
__device__ __forceinline__ void diff_attn_item(const Params& p, char* lds, int l, int b, int h, int q0, bool ctxq) {
    const int tid = TID(), wid = tid >> 6, lane = tid & 63, l15 = lane & 15, g = lane >> 4;
    const bf16_t* DQ = WSP(bf16_t, OFF_SEG_DQKV); const bf16_t* DVT = WSP(bf16_t, OFF_DVT); bf16_t* Y = WSP(bf16_t, OFF_Y);
    const int tok_q0 = ctxq ? NLAT + b * CTX + q0 : b * SEQ + q0;
    const int t_first = ctxq ? SEQ / 64 : 0, ntiles = ctxq ? CTX / 64 : KEYS / 64;
    f32x4 o1[8][NQT]; float l1[NQT];
    {
        auto qrow = [&](int i) { return DQ + (long)(tok_q0 + i) * 3 * MW + h * 128; };
        auto kt = [&](int t, const bf16_t*& kp, long& kld, const bf16_t*& vp, long& vld) { int tt = t_first + t; int tok = bk_tok(b, tt * 64);
            kp = DQ + (long)tok * 3 * MW + MW + h * 128; kld = 3 * MW; vp = DVT + ((long)b * MW + h * 128) * KEYS + tt * 64; vld = KEYS; };
        attn_core<NQT, 128>(lds, qrow, kt, ntiles, NoMask(), o1, l1);
    }
    U2 o1p[8][NQT];
#pragma unroll
    for (int qt = 0; qt < NQT; ++qt) { float inv = 1.0f / l1[qt];
#pragma unroll
        for (int dt = 0; dt < 8; ++dt) { f32x4 v = o1[dt][qt] * inv; o1p[dt][qt].x = pack2(v[0], v[1]); o1p[dt][qt].y = pack2(v[2], v[3]); } }
    f32x4 o2[8][NQT]; float l2[NQT];
    {
        auto qrow = [&](int i) { return DQ + (long)(tok_q0 + i) * 3 * MW + h * 128 + 64; };
        auto kt = [&](int t, const bf16_t*& kp, long& kld, const bf16_t*& vp, long& vld) { int tt = t_first + t; int tok = bk_tok(b, tt * 64);
            kp = DQ + (long)tok * 3 * MW + MW + h * 128 + 64; kld = 3 * MW; vp = DVT + ((long)b * MW + h * 128) * KEYS + tt * 64; vld = KEYS; };
        attn_core<NQT, 128>(lds, qrow, kt, ntiles, NoMask(), o2, l2);
    }
    const int tid2 = TID(), wid2 = tid2 >> 6, l15b = tid2 & 15, gb = (tid2 & 63) >> 4; bf16_t* Yo = WSP(bf16_t, OFF_Y);
    float lam, lam_init; diff_lambda(p, l, lam, lam_init);
    const float* nw = GIN(p.diff_norm) + l * 128;
#pragma unroll
    for (int qt = 0; qt < NQT; ++qt) { float inv = lam / l2[qt]; float ss = 0.f;
#pragma unroll
        for (int dt = 0; dt < 8; ++dt) { f32x4 a = (f32x4){bflo(o1p[dt][qt].x), bfhi(o1p[dt][qt].x), bflo(o1p[dt][qt].y), bfhi(o1p[dt][qt].y)}; o2[dt][qt] = a - o2[dt][qt] * inv;
#pragma unroll
            for (int j = 0; j < 4; ++j) ss += o2[dt][qt][j] * o2[dt][qt][j]; }
        ss = xadd<16>(ss); ss = xadd<32>(ss);
        const float r = rsqrtf(ss * (1.0f / 128.0f) + RMS_EPS) * (1.0f - lam_init);
        const long row = tok_q0 + wid2 * NQT * 16 + qt * 16 + l15b;
#pragma unroll
        for (int dt = 0; dt < 8; ++dt) { F4 w = *(const F4*)(nw + dt * 16 + gb * 4); f32x4 v = o2[dt][qt];
            v[0] *= r * w.x; v[1] *= r * w.y; v[2] *= r * w.z; v[3] *= r * w.w;
            st4bf(Yo + row * 4 * MW + 2 * MW + h * 128 + dt * 16 + gb * 4, v); }
    }
}

struct NaMask {
    const float* rpb;
    int qr, rs, rs0, nct;
    int cidx[16];
    __device__ __forceinline__ float operator()(int t, int mt, int j, int, float s) const {
        if (t < nct) return s;
        const int kr = rs0 + (t - nct), ci = cidx[mt * 4 + j];
        const bool ok = (kr >= rs) && (kr < rs + 8) && (ci >= 0);
        int dr = kr - qr + 7; dr = dr < 0 ? 0 : (dr > 14 ? 14 : dr);
        return ok ? s + rpb[dr * 31 + (ci < 0 ? 0 : ci)] : NEG_BIG;
    }
};
__device__ __forceinline__ void na_attn_item(const Params& p, char* lds, int l, int b, int h, int rp) {
    const int tid = TID(), wid = tid >> 6, lane = tid & 63, l15 = lane & 15, g = lane >> 4;
    const bf16_t* NQ = WSP(bf16_t, OFF_SEG_NQKV); const bf16_t* NVT = WSP(bf16_t, OFF_NVT); bf16_t* Y = WSP(bf16_t, OFF_Y);
    float* rpb = (float*)(lds + AttnLds<64>::TOTAL);
    __syncthreads();
    for (int i = tid; i < 15 * 31; i += NTH) rpb[i] = GIN(p.na_rpb)[((long)(l * NH + h) * 15) * 31 + i] * LOG2E;
    const int r0 = rp * 2; int rs0 = r0 - 4; rs0 = rs0 < 0 ? 0 : (rs0 > R_ROWS - 8 ? R_ROWS - 8 : rs0);
    int nwin = R_ROWS - rs0; nwin = nwin > 9 ? 9 : nwin;
    constexpr int NCT = CTX / 64;
    NaMask mk; mk.rpb = rpb; mk.rs0 = rs0; mk.nct = NCT;
    { const int qi = wid * 16 + l15, qc = qi & 63; mk.qr = r0 + (wid >> 2);
        int rs = mk.qr - 4; mk.rs = rs < 0 ? 0 : (rs > R_ROWS - 8 ? R_ROWS - 8 : rs);
        int cs = qc - 8; cs = cs < 0 ? 0 : (cs > GW - 16 ? GW - 16 : cs);
#pragma unroll
        for (int mt = 0; mt < 4; ++mt)
#pragma unroll
            for (int j = 0; j < 4; ++j) { const int kc = mt * 16 + g * 4 + j; int dc = kc - qc; dc = dc < -15 ? -15 : (dc > 15 ? 15 : dc); mk.cidx[mt * 4 + j] = (kc >= cs && kc < cs + 16) ? dc + 15 : -1; } }
    const int tok_q0 = b * SEQ + r0 * 64;
    auto qrow = [&](int i) { return NQ + (long)(tok_q0 + i) * 3 * MW + h * 64; };
    auto kt = [&](int t, const bf16_t*& kp, long& kld, const bf16_t*& vp, long& vld) { int key = t < NCT ? SEQ + t * 64 : (rs0 + t - NCT) * 64; int tok = bk_tok(b, key);
        kp = NQ + (long)tok * 3 * MW + MW + h * 64; kld = 3 * MW; vp = NVT + ((long)b * MW + h * 64) * KEYS + key; vld = KEYS; };
    f32x4 o[4][1]; float ls[1];
    attn_core<1, 64>(lds, qrow, kt, NCT + nwin, mk, o, ls);
    const float inv = 1.0f / ls[0]; const long row = tok_q0 + wid * 16 + l15;
#pragma unroll
    for (int dt = 0; dt < 4; ++dt) { f32x4 v = o[dt][0] * inv; st4bf(Y + row * 4 * MW + 3 * MW + h * 64 + dt * 16 + g * 4, v); }
}
__device__ __forceinline__ void na_ctx_item(const Params& p, char* lds, int b, int h, int q0) {
    const int tid = TID(), wid = tid >> 6, lane = tid & 63, l15 = lane & 15, g = lane >> 4;
    const bf16_t* NQ = WSP(bf16_t, OFF_SEG_NQKV); const bf16_t* NVT = WSP(bf16_t, OFF_NVT); bf16_t* Y = WSP(bf16_t, OFF_Y);
    const int tok_q0 = NLAT + b * CTX + q0;
    auto qrow = [&](int i) { return NQ + (long)(tok_q0 + i) * 3 * MW + h * 64; };
    auto kt = [&](int t, const bf16_t*& kp, long& kld, const bf16_t*& vp, long& vld) { int key = SEQ + t * 64; int tok = bk_tok(b, key);
        kp = NQ + (long)tok * 3 * MW + MW + h * 64; kld = 3 * MW; vp = NVT + ((long)b * MW + h * 64) * KEYS + key; vld = KEYS; };
    f32x4 o[4][1]; float ls[1];
    attn_core<1, 64>(lds, qrow, kt, CTX / 64, NoMask(), o, ls);
    const float inv = 1.0f / ls[0]; const long row = tok_q0 + wid * 16 + l15;
#pragma unroll
    for (int dt = 0; dt < 4; ++dt) { f32x4 v = o[dt][0] * inv; st4bf(Y + row * 4 * MW + 3 * MW + h * 64 + dt * 16 + g * 4, v); }
}

#define MFMA32(a, b, c) __builtin_amdgcn_mfma_f32_32x32x16_bf16(a, b, c, 0, 0, 0)
#ifndef CPU_EMU
typedef float f32x16 __attribute__((ext_vector_type(16)));
#endif
constexpr int D32_KT = 128;
constexpr int D32_KLD = 80, D32_VLD = D32_KT + 8;
constexpr int D32_KB = D32_KT * D32_KLD * 2, D32_VB = 128 * D32_VLD * 2, D32_STAGE = D32_KB + D32_VB, D32_TOTAL = 2 * D32_STAGE;
static_assert(D32_TOTAL <= 160 * 1024 - 64 && KEYS % D32_KT == 0, "diff32 lds");

__device__ __forceinline__ void diff32_pass(char* lds, const bf16_t* qp  , const bf16_t* kbase  ,
                                            const bf16_t* vbase  , int b, f32x16 (&oacc)[4], float& lsum) {
    const int tid = TID(), lane = tid & 63, r32 = lane & 31, hh = lane >> 5;
    bf16x8 qf[4];
#pragma unroll
    for (int ks = 0; ks < 4; ++ks) qf[ks] = ld8(qp + ks * 16 + hh * 8);
#pragma unroll
    for (int dt = 0; dt < 4; ++dt)
#pragma unroll
        for (int r = 0; r < 16; ++r) oacc[dt][r] = 0.f;
    float mrun = -64.0f; lsum = 0.f;
    f32x16 cinit;
#pragma unroll
    for (int r = 0; r < 16; ++r) cinit[r] = -mrun;
    const int sr = tid >> 3, ss = tid & 7, vr_ = tid >> 4, vs = tid & 15;
    U4 rk[2], rv[4];
    constexpr int NT = KEYS / D32_KT;
    auto gload = [&](int t) { const long tok = bk_tok(b, t * D32_KT);
#pragma unroll
        for (int i = 0; i < 2; ++i) rk[i] = *(const U4*)(kbase + (tok + sr + 64 * i) * 3 * MW + ss * 8);
#pragma unroll
        for (int i = 0; i < 4; ++i) rv[i] = *(const U4*)(vbase + (long)(vr_ + 32 * i) * KEYS + t * D32_KT + vs * 8); };
    auto sstore = [&](int st) { bf16_t* sK = (bf16_t*)(lds + st * D32_STAGE); bf16_t* sV = (bf16_t*)(lds + st * D32_STAGE + D32_KB);
#pragma unroll
        for (int i = 0; i < 2; ++i) *(U4*)(sK + (sr + 64 * i) * D32_KLD + ss * 8) = rk[i];
#pragma unroll
        for (int i = 0; i < 4; ++i) { bf16_t* d = sV + (vr_ + 32 * i) * D32_VLD + (vs >> 1) * 16 + (vs & 1) * 4; *(U2*)d = (U2){rv[i].x, rv[i].y}; *(U2*)(d + 8) = (U2){rv[i].z, rv[i].w}; } };
    gload(0);
    __syncthreads();
    sstore(0);
    __syncthreads();
    for (int t = 0; t < NT; ++t) {
        const bool more = t + 1 < NT;
        if (more) gload(t + 1);
#pragma unroll 1
        for (int sub = 0; sub < 2; ++sub) {
        const bf16_t* sK = (const bf16_t*)(lds + (t & 1) * D32_STAGE) + sub * 64 * D32_KLD; const bf16_t* sV = (const bf16_t*)(lds + (t & 1) * D32_STAGE + D32_KB) + sub * 64;
        f32x16 s[2];
        {
            bf16x8 kf[2][4];
#pragma unroll
            for (int kt = 0; kt < 2; ++kt)
#pragma unroll
                for (int ks = 0; ks < 4; ++ks) kf[kt][ks] = ld8(sK + (kt * 32 + r32) * D32_KLD + ks * 16 + hh * 8);
            SCHED_FENCE();
#pragma unroll
            for (int kt = 0; kt < 2; ++kt) {
                s[kt] = MFMA32(kf[kt][0], qf[0], cinit);
#pragma unroll
                for (int ks = 1; ks < 4; ++ks) s[kt] = MFMA32(kf[kt][ks], qf[ks], s[kt]);
            }
        }
        float mx = -3.0e38f;
#pragma unroll
        for (int kt = 0; kt < 2; ++kt)
#pragma unroll
            for (int r = 0; r < 16; ++r) mx = fmaxf(mx, s[kt][r]);
        mx = xmax<32>(mx);
        if (__ballot(mx > 6.0f) != 0ull) {
            const float d = fmaxf(mx, 0.f), alpha = fexp2(-d);
            mrun += d; lsum *= alpha;
#pragma unroll
            for (int r = 0; r < 16; ++r) cinit[r] = -mrun;
#pragma unroll
            for (int kt = 0; kt < 2; ++kt)
#pragma unroll
                for (int r = 0; r < 16; ++r) s[kt][r] -= d;
#pragma unroll
            for (int dt = 0; dt < 4; ++dt) oacc[dt] *= alpha;
        }
        float ps = 0.f;
#pragma unroll
        for (int kt = 0; kt < 2; ++kt)
#pragma unroll
            for (int r = 0; r < 16; ++r) { float pv = fexp2(s[kt][r]); s[kt][r] = pv; ps += pv; }
        lsum += ps;
        {
            bf16x8 va[4], vb[4];
#define D32_LDV(dst, kt, sx) _Pragma("unroll") for (int dt = 0; dt < 4; ++dt) { dst[dt] = ld8(sV + (dt * 32 + r32) * D32_VLD + (kt) * 32 + (sx) * 16 + hh * 8); }
#define D32_PF(kt, sx) mk8u(pack2(s[kt][8 * (sx)], s[kt][8 * (sx) + 1]), pack2(s[kt][8 * (sx) + 2], s[kt][8 * (sx) + 3]), pack2(s[kt][8 * (sx) + 4], s[kt][8 * (sx) + 5]), pack2(s[kt][8 * (sx) + 6], s[kt][8 * (sx) + 7]))
#define D32_MMA(src, pf) _Pragma("unroll") for (int dt = 0; dt < 4; ++dt) oacc[dt] = MFMA32(src[dt], pf, oacc[dt]);
            D32_LDV(va, 0, 0) D32_LDV(vb, 0, 1)
            const bf16x8 p0 = D32_PF(0, 0), p1 = D32_PF(0, 1), p2 = D32_PF(1, 0), p3 = D32_PF(1, 1);
            SCHED_FENCE();
            D32_MMA(va, p0) D32_LDV(va, 1, 0)
            SCHED_FENCE();
            D32_MMA(vb, p1) D32_LDV(vb, 1, 1)
            SCHED_FENCE();
            D32_MMA(va, p2)
            D32_MMA(vb, p3)
#undef D32_LDV
#undef D32_PF
#undef D32_MMA
        }
        }
        if (more) sstore((t + 1) & 1);
        __syncthreads();
    }
    lsum = xadd<32>(lsum);
}

__device__ __forceinline__ void diff32_item(const Params& p, char* lds, int l, int b, int h, int q0, int comp) {
    const int tid = TID(), wid = tid >> 6, lane = tid & 63, r32 = lane & 31, hh = lane >> 5;
    const bf16_t* DQ = WSP(bf16_t, OFF_SEG_DQKV); const bf16_t* DVT = WSP(bf16_t, OFF_DVT);
    const long qtok = (long)b * SEQ + q0 + wid * 32 + r32;
    f32x16 oacc[4]; float ls;
    diff32_pass(lds, DQ + qtok * 3 * MW + h * 128 + comp * 64, DQ + MW + h * 128 + comp * 64, DVT + ((long)b * MW + h * 128) * KEYS, b, oacc, ls);
    bf16_t* Yo = WSP(bf16_t, OFF_Y) + qtok * 4 * MW + (comp == 0 ? 2 * MW : 0) + h * 128;
    const float inv = 1.0f / ls;
#pragma unroll
    for (int dt = 0; dt < 4; ++dt)
#pragma unroll
        for (int q = 0; q < 4; ++q) { const int dv = dt * 32 + 8 * q + 4 * hh;
            st4bf(Yo + dv, (f32x4){oacc[dt][4 * q] * inv, oacc[dt][4 * q + 1] * inv, oacc[dt][4 * q + 2] * inv, oacc[dt][4 * q + 3] * inv}); }
}

constexpr int N32_VLD = 72;
constexpr int N32_KB = 64 * D32_KLD * 2, N32_VB = 64 * N32_VLD * 2, N32_STAGE = N32_KB + N32_VB, N32_RPB = 2 * N32_STAGE;
static_assert(R_ROWS % 4 == 0 && GW == 64 && N32_RPB + 16 * 128 * 4 <= 100 * 1024, "na32");
__device__ __forceinline__ void na32_item(const Params& p, char* lds, int l, int b, int h, int rq) {
    const int tid = TID(), wid = tid >> 6, lane = tid & 63, r32 = lane & 31, hh = lane >> 5;
    const bf16_t* NQ = WSP(bf16_t, OFF_SEG_NQKV); const bf16_t* NVT = WSP(bf16_t, OFF_NVT);
    float* rpb = (float*)(lds + N32_RPB);
    __syncthreads();
    for (int i = tid; i < 16 * 128; i += NTH) { const int dr = i >> 7, c = (i & 127) - 48;
        rpb[i] = dr == 15 ? NEG_BIG : ((c >= 0 && c < 31) ? GIN(p.na_rpb)[((long)(l * NH + h) * 15 + dr) * 31 + c] * LOG2E : 0.f); }
    constexpr int NCT = CTX / 64;
    const int r0 = rq * 4, qr = r0 + (wid >> 1), qc = (wid & 1) * 32 + r32;
    int rs0 = r0 - 4; rs0 = rs0 < 0 ? 0 : (rs0 > R_ROWS - 8 ? R_ROWS - 8 : rs0);
    int rsl = r0 - 1; rsl = rsl < 0 ? 0 : (rsl > R_ROWS - 8 ? R_ROWS - 8 : rsl);
    const int NT = NCT + (rsl + 8 - rs0);
    int rs = qr - 4; rs = rs < 0 ? 0 : (rs > R_ROWS - 8 ? R_ROWS - 8 : rs);
    int cs = qc - 8; cs = cs < 0 ? 0 : (cs > GW - 16 ? GW - 16 : cs);
    const long qtok = (long)b * SEQ + qr * 64 + qc;
    bf16x8 qf[4];
    { const bf16_t* qp = NQ + qtok * 3 * MW + h * 64; constexpr float sc = 0.125f * LOG2E;
#pragma unroll
        for (int ks = 0; ks < 4; ++ks) { const U4 r = *(const U4*)(qp + ks * 16 + hh * 8);
            qf[ks] = mk8u(pack2(bflo(r.x) * sc, bfhi(r.x) * sc), pack2(bflo(r.y) * sc, bfhi(r.y) * sc), pack2(bflo(r.z) * sc, bfhi(r.z) * sc), pack2(bflo(r.w) * sc, bfhi(r.w) * sc)); } }
    f32x16 oacc[2];
#pragma unroll
    for (int dt = 0; dt < 2; ++dt)
#pragma unroll
        for (int r = 0; r < 16; ++r) oacc[dt][r] = 0.f;
    float mrun = -64.0f, lsum = 0.f;
    f32x16 cplain, cm[2];
#pragma unroll
    for (int r = 0; r < 16; ++r) cplain[r] = -mrun;
#pragma unroll
    for (int kt = 0; kt < 2; ++kt)
#pragma unroll
        for (int r = 0; r < 16; ++r) { const int kc = kt * 32 + (r & 3) + 8 * (r >> 2) + 4 * hh; cm[kt][r] = (kc >= cs && kc < cs + 16) ? -mrun : NEG_BIG; }
    const int sr = tid >> 3, ss = tid & 7;
    const bf16_t* kbase = NQ + MW + h * 64; const bf16_t* vbase = NVT + ((long)b * MW + h * 64) * KEYS;
    U4 rk, rv;
    auto gload = [&](int t) { const int key = t < NCT ? SEQ + t * 64 : (rs0 + t - NCT) * 64; const long tok = bk_tok(b, key);
        rk = *(const U4*)(kbase + (tok + sr) * 3 * MW + ss * 8); rv = *(const U4*)(vbase + (long)sr * KEYS + key + ss * 8); };
    auto sstore = [&](int st) { bf16_t* sK = (bf16_t*)(lds + st * N32_STAGE); bf16_t* sV = (bf16_t*)(lds + st * N32_STAGE + N32_KB);
        *(U4*)(sK + sr * D32_KLD + ss * 8) = rk; bf16_t* d = sV + sr * N32_VLD + (ss >> 1) * 16 + (ss & 1) * 4; *(U2*)d = (U2){rv.x, rv.y}; *(U2*)(d + 8) = (U2){rv.z, rv.w}; };
    gload(0);
    __syncthreads();
    sstore(0);
    __syncthreads();
    for (int t = 0; t < NT; ++t) {
        const bool more = t + 1 < NT;
        if (more) gload(t + 1);
        const bf16_t* sK = (const bf16_t*)(lds + (t & 1) * N32_STAGE); const bf16_t* sV = (const bf16_t*)(lds + (t & 1) * N32_STAGE + N32_KB);
        f32x16 s[2];
        {
            bf16x8 kf[2][4];
#pragma unroll
            for (int kt = 0; kt < 2; ++kt)
#pragma unroll
                for (int ks = 0; ks < 4; ++ks) kf[kt][ks] = ld8(sK + (kt * 32 + r32) * D32_KLD + ks * 16 + hh * 8);
            SCHED_FENCE();
            if (t < NCT) {
#pragma unroll
                for (int kt = 0; kt < 2; ++kt) { s[kt] = MFMA32(kf[kt][0], qf[0], cplain);
#pragma unroll
                    for (int ks = 1; ks < 4; ++ks) s[kt] = MFMA32(kf[kt][ks], qf[ks], s[kt]); }
            } else {
                const int kr = rs0 + t - NCT; const int rsel = (kr >= rs && kr < rs + 8) ? kr - qr + 7 : 15;
                const float* bp = rpb + rsel * 128 + (4 * hh - qc + 63);
#pragma unroll
                for (int kt = 0; kt < 2; ++kt) { s[kt] = MFMA32(kf[kt][0], qf[0], cm[kt]);
#pragma unroll
                    for (int ks = 1; ks < 4; ++ks) s[kt] = MFMA32(kf[kt][ks], qf[ks], s[kt]); }
#pragma unroll
                for (int kt = 0; kt < 2; ++kt)
#pragma unroll
                    for (int r = 0; r < 16; ++r) s[kt][r] += bp[kt * 32 + (r & 3) + 8 * (r >> 2)];
            }
        }
        float mx = -3.0e38f;
#pragma unroll
        for (int kt = 0; kt < 2; ++kt)
#pragma unroll
            for (int r = 0; r < 16; ++r) mx = fmaxf(mx, s[kt][r]);
        mx = xmax<32>(mx);
        if (__ballot(mx > 6.0f) != 0ull) {
            const float d = fmaxf(mx, 0.f), alpha = fexp2(-d);
            mrun += d; lsum *= alpha;
#pragma unroll
            for (int r = 0; r < 16; ++r) cplain[r] = -mrun;
#pragma unroll
            for (int kt = 0; kt < 2; ++kt)
#pragma unroll
                for (int r = 0; r < 16; ++r) { cm[kt][r] -= d; s[kt][r] -= d; }
#pragma unroll
            for (int dt = 0; dt < 2; ++dt) oacc[dt] *= alpha;
        }
        float ps = 0.f;
#pragma unroll
        for (int kt = 0; kt < 2; ++kt)
#pragma unroll
            for (int r = 0; r < 16; ++r) { float pv = fexp2(s[kt][r]); s[kt][r] = pv; ps += pv; }
        lsum += ps;
        {
            bf16x8 va[2], vb[2];
#define N32_LDV(dst, kt, sx) _Pragma("unroll") for (int dt = 0; dt < 2; ++dt) { dst[dt] = ld8(sV + (dt * 32 + r32) * N32_VLD + (kt) * 32 + (sx) * 16 + hh * 8); }
#define N32_PF(kt, sx) mk8u(pack2(s[kt][8 * (sx)], s[kt][8 * (sx) + 1]), pack2(s[kt][8 * (sx) + 2], s[kt][8 * (sx) + 3]), pack2(s[kt][8 * (sx) + 4], s[kt][8 * (sx) + 5]), pack2(s[kt][8 * (sx) + 6], s[kt][8 * (sx) + 7]))
#define N32_MMA(src, pf) _Pragma("unroll") for (int dt = 0; dt < 2; ++dt) oacc[dt] = MFMA32(src[dt], pf, oacc[dt]);
            N32_LDV(va, 0, 0) N32_LDV(vb, 0, 1)
            const bf16x8 p0 = N32_PF(0, 0), p1 = N32_PF(0, 1), p2 = N32_PF(1, 0), p3 = N32_PF(1, 1);
            SCHED_FENCE();
            N32_MMA(va, p0) N32_LDV(va, 1, 0)
            SCHED_FENCE();
            N32_MMA(vb, p1) N32_LDV(vb, 1, 1)
            SCHED_FENCE();
            N32_MMA(va, p2)
            N32_MMA(vb, p3)
#undef N32_LDV
#undef N32_PF
#undef N32_MMA
        }
        if (more) sstore((t + 1) & 1);
        __syncthreads();
    }
    lsum = xadd<32>(lsum);
    const int tid2 = TID(), lane2 = tid2 & 63, wid2 = tid2 >> 6;
    bf16_t* Yo = WSP(bf16_t, OFF_Y) + ((long)b * SEQ + (r0 + (wid2 >> 1)) * 64 + (wid2 & 1) * 32 + (lane2 & 31)) * 4 * MW + 3 * MW + h * 64;
    const float inv = 1.0f / lsum;
#pragma unroll
    for (int dt = 0; dt < 2; ++dt)
#pragma unroll
        for (int q = 0; q < 4; ++q) { const int dv = dt * 32 + 8 * q + 4 * (lane2 >> 5);
            st4bf(Yo + dv, (f32x4){oacc[dt][4 * q] * inv, oacc[dt][4 * q + 1] * inv, oacc[dt][4 * q + 2] * inv, oacc[dt][4 * q + 3] * inv}); }
}
static_assert(NTASK_GDN % 4 == 0, "gdn tasks");
__device__ __forceinline__ void gdn_decode(int chain, int n, int& b, int& h, int& dir, int& base, int& T, int& c) {
    dir = chain & 1; int bh = chain >> 1; h = bh % GH; b = bh / GH;
    if (n < NCH_CTX) { base = NLAT + b * CTX; T = CTX; c = n; } else { base = b * SEQ; T = SEQ; c = n - NCH_CTX; }
}
__device__ __forceinline__ int gdn_pos(int dir, int T, int c, int i) { int r = 64 * c + i; return dir ? T - 1 - r : r; }

constexpr int GP_K = 0, GP_V = 10240, GP_AB = 20480, GP_AD = 30720, GP_XT = GP_AD + 4 * 16 * 16 * 4, GP_R = GP_XT + 128 * 80 * 2, GP_F = GP_R + 16 * 132 * 4, GP_TASK = GP_F + 1024;
static_assert(2 * GP_TASK <= 160 * 1024 - 64 && NTASK_GDN % 2 == 0, "gdn prep lds");
__device__ __forceinline__ void gdn_chunk_prep2(const Params& p, char* lds, int l, int task0) {
    const int tid = TID(), wid = tid >> 6, lane = tid & 63, l15 = lane & 15, g = lane >> 4, tk = wid >> 2, w4 = wid & 3, t4 = tid & 255;
    const int task = task0 + tk, chain = task / NCH, n = task - chain * NCH;
    int b, h, dir, base, T, c; gdn_decode(chain, n, b, h, dir, base, T, c);
    char* L = lds + tk * GP_TASK;
    bf16_t* Kt = (bf16_t*)(L + GP_K); bf16_t* Vt = (bf16_t*)(L + GP_V); bf16_t* Ab = (bf16_t*)(L + GP_AB); float* Ad = (float*)(L + GP_AD); bf16_t* XT = (bf16_t*)(L + GP_XT); float* R = (float*)(L + GP_R);
    float* gcs = (float*)(L + GP_F); float* bet = gcs + 64; float* fac = gcs + 128;
    const bf16_t* GK = WSP(bf16_t, OFF_GK); const bf16_t* GV = WSP(bf16_t, OFF_GV); const float* GB = WSP(float, OFF_GB);
    __syncthreads();
#pragma unroll
    for (int q = 0; q < 2; ++q) { int pc = t4 + 256 * q, i = pc >> 3, s = pc & 7; long tok = base + gdn_pos(dir, T, c, i);
        *(U4*)(Kt + i * 80 + s * 8) = *(const U4*)(GK + tok * MW + h * 64 + s * 8);
        *(U4*)(Vt + i * 80 + s * 8) = *(const U4*)(GV + tok * MW + h * 64 + s * 8); }
    for (int i = t4; i < 128 * 80 / 8; i += 256) *(U4*)(XT + i * 8) = (U4){0u, 0u, 0u, 0u};
    if (w4 == 0) { long tok = base + gdn_pos(dir, T, c, lane); float gi = GB[tok * 4 * GH + dir * GH + h], be = GB[tok * 4 * GH + 2 * GH + dir * GH + h];
        float cs = gi;
        for (int o = 1; o < 64; o <<= 1) { float t = __shfl_up(cs, o); if (lane >= o) cs += t; }
        gcs[lane] = cs; bet[lane] = be; fac[lane] = be * __expf(cs);
        WSP(float, OFF_GB)[tok * 4 * GH + dir * GH + h] = cs; }
    __syncthreads();
    { const int mt = w4; const int i = mt * 16 + l15; const float bi = bet[i], gi = gcs[i];
        bf16x8 bfr[2];
#pragma unroll
        for (int ks = 0; ks < 2; ++ks) bfr[ks] = ld8(Kt + (mt * 16 + l15) * 80 + ks * 32 + g * 8);
        for (int nt = 0; nt <= mt; ++nt) { f32x4 acc = (f32x4){0.f, 0.f, 0.f, 0.f};
#pragma unroll
            for (int ks = 0; ks < 2; ++ks) acc = MFMA16(ld8(Kt + (nt * 16 + l15) * 80 + ks * 32 + g * 8), bfr[ks], acc);
            float v[4];
#pragma unroll
            for (int jj = 0; jj < 4; ++jj) { const int j = nt * 16 + g * 4 + jj; v[jj] = j < i ? bi * acc[jj] * __expf(gi - gcs[j]) : 0.f; }
            if (nt < mt) *(U2*)(Ab + i * 80 + nt * 16 + g * 4) = (U2){pack2(v[0], v[1]), pack2(v[2], v[3])};
            else { *(U2*)(Ab + i * 80 + nt * 16 + g * 4) = (U2){0u, 0u}; *(F4*)(Ad + (mt * 16 + l15) * 16 + g * 4) = (F4){v[0], v[1], v[2], v[3]}; } }
    }
    __syncthreads();
    const bool wcol = t4 < 64; const int cc = t4 & 63;
    const bf16_t* src = wcol ? Kt : Vt; const float* scl = wcol ? fac : bet;
    bf16_t* dst = WSP(bf16_t, OFF_WU) + ((long)task * 2 + (wcol ? 0 : 1)) * 4096 + cc;
#pragma unroll
    for (int I = 0; I < 4; ++I) {
        if (I > 0) {
#pragma unroll
            for (int q = 0; q < 2; ++q) { const int nt = w4 * 2 + q; f32x4 acc = (f32x4){0.f, 0.f, 0.f, 0.f};
                acc = MFMA16(ld8(Ab + (I * 16 + l15) * 80 + g * 8), ld8(XT + (nt * 16 + l15) * 80 + g * 8), acc);
                if (I == 3) acc = MFMA16(ld8(Ab + (I * 16 + l15) * 80 + 32 + g * 8), ld8(XT + (nt * 16 + l15) * 80 + 32 + g * 8), acc);
#pragma unroll
                for (int jj = 0; jj < 4; ++jj) R[(g * 4 + jj) * 132 + nt * 16 + l15] = acc[jj]; }
            __syncthreads();
        }
        if (t4 < 128) {
            float x[16];
#pragma unroll
            for (int ii = 0; ii < 16; ++ii) { float a = scl[I * 16 + ii] * bf2f(src[(I * 16 + ii) * 80 + cc]); if (I > 0) a -= R[ii * 132 + t4];
#pragma unroll
                for (int jj = 0; jj < ii; ++jj) a -= Ad[(I * 16 + ii) * 16 + jj] * x[jj];
                x[ii] = a; }
            *(U4*)(XT + t4 * 80 + I * 16) = (U4){pack2(x[0], x[1]), pack2(x[2], x[3]), pack2(x[4], x[5]), pack2(x[6], x[7])};
            *(U4*)(XT + t4 * 80 + I * 16 + 8) = (U4){pack2(x[8], x[9]), pack2(x[10], x[11]), pack2(x[12], x[13]), pack2(x[14], x[15])};
            if (wcol) {
#pragma unroll
                for (int ii = 0; ii < 16; ++ii) dst[(I * 16 + ii) * 64] = f2bf(x[ii]);
            } else {
                bf16_t* du = WSP(bf16_t, OFF_WU) + ((long)task * 2 + 1) * 4096 + cc * 64 + I * 16;
                *(U4*)du = (U4){pack2(x[0], x[1]), pack2(x[2], x[3]), pack2(x[4], x[5]), pack2(x[6], x[7])};
                *(U4*)(du + 8) = (U4){pack2(x[8], x[9]), pack2(x[10], x[11]), pack2(x[12], x[13]), pack2(x[14], x[15])}; }
        }
        __syncthreads();
    }
}

constexpr int GS_W = 0, GS_Q = 10240, GS_K = 20480, GS_KT = 30720, GS_GC = 40960, GS_STAGE = 40960 + 512;
constexpr int GS_STB = 64 * 80 * 2  , GS_ST = 2 * GS_STAGE, GS_VNT = GS_ST + 2 * GS_STB, GS_VNT2 = GS_VNT + GS_STB, GS_ATT = GS_VNT2 + GS_STB, GS_TOTAL = GS_ATT + 10240;
static_assert(GS_TOTAL <= 160 * 1024 - 512, "gdn scan lds");
__device__ __forceinline__ void gdn_scan_item(const Params& p, char* lds, int l, int chain) {
    const int tid = TID(), wid = tid >> 6, lane = tid & 63, l15 = lane & 15, g = lane >> 4, mt = wid >> 1, nt = wid & 1;
    {
    const bf16_t* GQ = WSP(bf16_t, OFF_GQ); const bf16_t* GK = WSP(bf16_t, OFF_GK); const float* GB = WSP(float, OFF_GB); const bf16_t* WU = WSP(bf16_t, OFF_WU);
    const int sr = tid >> 3, ss = tid & 7;
    f32x4 sacc[2] = {(f32x4){0.f, 0.f, 0.f, 0.f}, (f32x4){0.f, 0.f, 0.f, 0.f}};
    U4 rw, rq, rk; float ucur[2][4], unext[2][4]; float gnext = 0.f;
    auto load_chunk = [&](int n) {
        int b, h, dir, base, T, c; gdn_decode(chain, n, b, h, dir, base, T, c);
        const long task = (long)chain * NCH + n; const long tok = base + gdn_pos(dir, T, c, sr);
        rw = *(const U4*)(WU + (task * 2 + 0) * 4096 + sr * 64 + ss * 8);
        rq = *(const U4*)(GQ + tok * MW + h * 64 + ss * 8);
        rk = *(const U4*)(GK + tok * MW + h * 64 + ss * 8);
#pragma unroll
        for (int half = 0; half < 2; ++half) { const U2 uu = *(const U2*)(WU + (task * 2 + 1) * 4096 + (half * 32 + nt * 16 + l15) * 64 + mt * 16 + g * 4);
            unext[half][0] = bflo(uu.x); unext[half][1] = bfhi(uu.x); unext[half][2] = bflo(uu.y); unext[half][3] = bfhi(uu.y); }
        if (wid == 0) { const long tk = base + gdn_pos(dir, T, c, lane); gnext = GB[tk * 4 * GH + dir * GH + h]; }
    };
    auto store_chunk = [&](int st) {
        char* S = lds + st * GS_STAGE;
        *(U4*)((bf16_t*)(S + GS_W) + sr * 80 + ss * 8) = rw;
        *(U4*)((bf16_t*)(S + GS_Q) + sr * 80 + ss * 8) = rq;
        *(U4*)((bf16_t*)(S + GS_K) + sr * 80 + ss * 8) = rk;
        bf16_t* KT = (bf16_t*)(S + GS_KT);
        const u32 kw[4] = {rk.x, rk.y, rk.z, rk.w};
#pragma unroll
        for (int e = 0; e < 4; ++e) { KT[(ss * 8 + 2 * e) * 80 + sr] = (bf16_t)(kw[e] & 0xffffu); KT[(ss * 8 + 2 * e + 1) * 80 + sr] = (bf16_t)(kw[e] >> 16); }
        if (wid == 0) ((float*)(S + GS_GC))[lane] = gnext;
    };
    __syncthreads();
    { bf16_t* ST0 = (bf16_t*)(lds + GS_ST); for (int i = tid; i < 64 * 80; i += NTH) ST0[i] = 0; }
    load_chunk(0); store_chunk(0);
#pragma unroll
    for (int half = 0; half < 2; ++half)
#pragma unroll
        for (int j = 0; j < 4; ++j) ucur[half][j] = unext[half][j];
    __syncthreads();
    for (int n = 0; n < NCH; ++n) {
        const int st = n & 1;
        if (n + 1 < NCH) load_chunk(n + 1);
        const char* S = lds + st * GS_STAGE;
        const bf16_t* Wt = (const bf16_t*)(S + GS_W); const bf16_t* Qt = (const bf16_t*)(S + GS_Q); const bf16_t* Kt = (const bf16_t*)(S + GS_K); const bf16_t* KT = (const bf16_t*)(S + GS_KT);
        const float* gc = (const float*)(S + GS_GC);
        const bf16_t* STc = (const bf16_t*)(lds + GS_ST + st * GS_STB); bf16_t* STn = (bf16_t*)(lds + GS_ST + (st ^ 1) * GS_STB);
        bf16_t* VNT = (bf16_t*)(lds + GS_VNT); bf16_t* VNT2 = (bf16_t*)(lds + GS_VNT2); bf16_t* ATT = (bf16_t*)(lds + GS_ATT);
        const float gl = gc[63];
#pragma unroll
        for (int q = 0; q < 2; ++q) { const int tile = wid * 2 + q, it = tile >> 2, jt = tile & 3;
            f32x4 acc = (f32x4){0.f, 0.f, 0.f, 0.f};
            if (jt <= it) {
#pragma unroll
                for (int ks = 0; ks < 2; ++ks) acc = MFMA16(ld8(Kt + (jt * 16 + l15) * 80 + ks * 32 + g * 8), ld8(Qt + (it * 16 + l15) * 80 + ks * 32 + g * 8), acc);
            }
            const int i = it * 16 + l15; const float gi = gc[i]; float v[4];
#pragma unroll
            for (int j = 0; j < 4; ++j) { const int jp = jt * 16 + g * 4 + j; v[j] = jp <= i ? acc[j] * __expf(gi - gc[jp]) : 0.f; }
            U2 o; o.x = pack2(v[0], v[1]); o.y = pack2(v[2], v[3]); *(U2*)(ATT + i * 80 + jt * 16 + g * 4) = o; }
#pragma unroll
        for (int half = 0; half < 2; ++half) { const int dvr = half * 32 + nt * 16 + l15;
            f32x4 acc = (f32x4){0.f, 0.f, 0.f, 0.f};
#pragma unroll
            for (int ks = 0; ks < 2; ++ks) acc = MFMA16(ld8(Wt + (mt * 16 + l15) * 80 + ks * 32 + g * 8), ld8(STc + dvr * 80 + ks * 32 + g * 8), acc);
            float vn[4], vn2[4];
#pragma unroll
            for (int j = 0; j < 4; ++j) { vn[j] = ucur[half][j] - acc[j]; vn2[j] = vn[j] * __expf(gl - gc[mt * 16 + g * 4 + j]); }
            U2 o; o.x = pack2(vn[0], vn[1]); o.y = pack2(vn[2], vn[3]); *(U2*)(VNT + dvr * 80 + mt * 16 + g * 4) = o;
            U2 o2; o2.x = pack2(vn2[0], vn2[1]); o2.y = pack2(vn2[2], vn2[3]); *(U2*)(VNT2 + dvr * 80 + mt * 16 + g * 4) = o2;
        }
        __syncthreads();
#pragma unroll
        for (int half = 0; half < 2; ++half) { const int dvr = half * 32 + nt * 16 + l15;
            f32x4 a1 = (f32x4){0.f, 0.f, 0.f, 0.f}, a2 = (f32x4){0.f, 0.f, 0.f, 0.f};
#pragma unroll
            for (int ks = 0; ks < 2; ++ks) { a1 = MFMA16(ld8(STc + dvr * 80 + ks * 32 + g * 8), ld8(Qt + (mt * 16 + l15) * 80 + ks * 32 + g * 8), a1);
                a2 = MFMA16(ld8(VNT + dvr * 80 + ks * 32 + g * 8), ld8(ATT + (mt * 16 + l15) * 80 + ks * 32 + g * 8), a2); }
            int b, h, dir, base, T, c; gdn_decode(chain, n, b, h, dir, base, T, c);
            bf16_t* O = WSP(bf16_t, dir ? OFF_OB : OFF_OF);
            { const int i = mt * 16 + l15; const long tok = base + gdn_pos(dir, T, c, i); const float eg = __expf(gc[i]);
                st4bf(O + tok * MW + h * 64 + half * 32 + nt * 16 + g * 4, (f32x4){eg * a1[0] + a2[0], eg * a1[1] + a2[1], eg * a1[2] + a2[2], eg * a1[3] + a2[3]}); }
        }
#pragma unroll
        for (int half = 0; half < 2; ++half) { const int dvr = half * 32 + nt * 16 + l15;
            f32x4 acc = sacc[half] * __expf(gl);
#pragma unroll
            for (int ks = 0; ks < 2; ++ks) acc = MFMA16(ld8(KT + (mt * 16 + l15) * 80 + ks * 32 + g * 8), ld8(VNT2 + dvr * 80 + ks * 32 + g * 8), acc);
            sacc[half] = acc;
            U2 o; o.x = pack2(acc[0], acc[1]); o.y = pack2(acc[2], acc[3]); *(U2*)(STn + dvr * 80 + mt * 16 + g * 4) = o;
        }
        if (n + 1 < NCH) { store_chunk(st ^ 1);
#pragma unroll
            for (int half = 0; half < 2; ++half)
#pragma unroll
                for (int j = 0; j < 4; ++j) ucur[half][j] = unext[half][j]; }
        __syncthreads();
    }
    }
}
__device__ __forceinline__ int hy_phys(int p) { return p + ((p >> 6) << 2); }
constexpr int HY_X = 0, HY_T1 = (int)HY_XN * 8, HY_T2 = HY_T1 + 128 * 8, HY_W3 = HY_T2 + 128 * 8, HY_RED = HY_W3 + 2 * 64 * 4, HY_TOTAL = HY_RED + 64 * 4;
static_assert(HY_TOTAL <= 160 * 1024 - 64, "hyena lds");
#ifdef CPU_EMU
__device__ __forceinline__ F2 cmul(F2 a, F2 b) { return (F2){a.x * b.x - a.y * b.y, a.x * b.y + a.y * b.x}; }
__device__ __forceinline__ F2 cmulc(F2 a, F2 b) { return (F2){a.x * b.x + a.y * b.y, a.y * b.x - a.x * b.y}; }
__device__ __forceinline__ F2 add_mi(F2 a, F2 d) { return (F2){a.x + d.y, a.y - d.x}; }
__device__ __forceinline__ F2 sub_mi(F2 a, F2 d) { return (F2){a.x - d.y, a.y + d.x}; }
#else
__device__ __forceinline__ F2 cmul(F2 a, F2 b) { F2 t, r;
    asm("v_pk_mul_f32 %0, %1, %2 op_sel:[1,1] op_sel_hi:[1,0] neg_lo:[0,1]" : "=v"(t) : "v"(a), "v"(b));
    asm("v_pk_fma_f32 %0, %1, %2, %3 op_sel_hi:[0,1,1]" : "=v"(r) : "v"(a), "v"(b), "v"(t));
    return r; }
__device__ __forceinline__ F2 cmulc(F2 a, F2 b) { F2 t, r;
    asm("v_pk_mul_f32 %0, %1, %2 op_sel:[1,1] op_sel_hi:[1,0]" : "=v"(t) : "v"(a), "v"(b));
    asm("v_pk_fma_f32 %0, %1, %2, %3 op_sel_hi:[0,1,1] neg_hi:[0,1,0]" : "=v"(r) : "v"(a), "v"(b), "v"(t));
    return r; }
__device__ __forceinline__ F2 add_mi(F2 a, F2 d) { F2 r; asm("v_pk_add_f32 %0, %1, %2 op_sel:[0,1] op_sel_hi:[1,0] neg_hi:[0,1]" : "=v"(r) : "v"(a), "v"(d)); return r; }
__device__ __forceinline__ F2 sub_mi(F2 a, F2 d) { F2 r; asm("v_pk_add_f32 %0, %1, %2 op_sel:[0,1] op_sel_hi:[1,0] neg_lo:[0,1]" : "=v"(r) : "v"(a), "v"(d)); return r; }
#endif
__device__ __forceinline__ F2 twid(const F2* T1, const F2* T2, int q) { return cmul(T1[q >> 7], T2[q & 127]); }

constexpr int ilog2c(int n) { return n <= 1 ? 0 : 1 + ilog2c(n >> 1); }
__device__ __forceinline__ void bf4_fwd(F2& x0, F2& x1, F2& x2, F2& x3, F2 w1, F2 w2) {
    const F2 a0 = x0 + x2, a2 = cmul(x0 - x2, w1), a1 = x1 + x3, d = cmul(x1 - x3, w1);
    x0 = a0 + a1; x1 = cmul(a0 - a1, w2); x2 = add_mi(a2, d); x3 = cmul(sub_mi(a2, d), w2); }
__device__ __forceinline__ void bf4_inv(F2& y0, F2& y1, F2& y2, F2& y3, F2 w1, F2 w2) {
    F2 t = cmulc(y1, w2); const F2 a0 = y0 + t, a1 = y0 - t; t = cmulc(y3, w2); const F2 a2 = y2 + t, a3 = y2 - t;
    t = cmulc(a2, w1); y0 = a0 + t; y2 = a0 - t; const F2 u = cmulc(a3, w1); y1 = sub_mi(a1, u); y3 = add_mi(a1, u); }
#define W16_1 ((F2){0.9238795325112867f, -0.3826834323650898f})
#define W16_2 ((F2){0.7071067811865476f, -0.7071067811865476f})
#define W16_3 ((F2){0.3826834323650898f, -0.9238795325112867f})
struct LdsLd { static constexpr bool REGS = false; const F2* X; __device__ __forceinline__ F2 operator()(int p, int = 0) const { return X[p]; } };
struct LdsSt { static constexpr bool REGS = false; F2* X; __device__ __forceinline__ void operator()(int p, F2 v, int = 0) const { X[p] = v; } };
struct HfGlbSt { static constexpr bool REGS = false; F2* HF; __device__ __forceinline__ void operator()(int p, F2 v, int = 0) const { HF[p] = v; } };
struct HfGlbLd { static constexpr bool REGS = false; const F2* X; const F2* HF; __device__ __forceinline__ F2 operator()(int p, int = 0) const { return cmul(X[p], HF[p]); } };
struct HfRegSt { static constexpr bool REGS = true; F2 (&h)[20]; F2* HF; __device__ __forceinline__ void operator()(int p, F2 v, int slot) const { if (slot < 20) h[slot] = v; else HF[p] = v; } };
struct HfRegLd { static constexpr bool REGS = true; const F2* X; const F2 (&h)[20]; const F2* HF; __device__ __forceinline__ F2 operator()(int p, int slot) const { return cmul(X[p], slot < 20 ? h[slot] : HF[p]); } };
template <int N, int M, bool INV, class LD, class ST>
__device__ __forceinline__ void fft_r16(const F2* T1, const F2* T2, int tid, LD& ld, ST& st) {
    constexpr int q16 = M / 16, sh = N / M, NB = N / 16;
#pragma unroll
    for (int it_ = 0; it_ < (NB + NTH - 1) / NTH; ++it_) { const int idx = tid + it_ * NTH; if (NB % NTH != 0 && idx >= NB) break;
        const int blk = idx / q16, j = idx - blk * q16, p0 = blk * M + j, pp0 = hy_phys(p0);
        auto el = [&](int k) { if constexpr (q16 % 64 == 0) return pp0 + k * (q16 / 64 * 68); else if constexpr (M <= 64) return pp0 + k * q16; else return hy_phys(p0 + k * q16); };
        F2 e[16];
#pragma unroll
        for (int k = 0; k < 16; ++k) e[k] = ld(el(k));
        const F2 wa0 = twid(T1, T2, j * sh);
        const F2 wa1 = cmul(wa0, W16_1), wa2 = cmul(wa0, W16_2), wa3 = cmul(wa0, W16_3);
        const F2 wa0s = cmul(wa0, wa0); const F2 wb = cmul(wa0s, wa0s), wbs = cmul(wb, wb);
        if (!INV) {
            bf4_fwd(e[0], e[4], e[8], e[12], wa0, wa0s); bf4_fwd(e[1], e[5], e[9], e[13], wa1, cmul(wa1, wa1));
            bf4_fwd(e[2], e[6], e[10], e[14], wa2, cmul(wa2, wa2)); bf4_fwd(e[3], e[7], e[11], e[15], wa3, cmul(wa3, wa3));
#pragma unroll
            for (int c = 0; c < 4; ++c) bf4_fwd(e[4 * c], e[4 * c + 1], e[4 * c + 2], e[4 * c + 3], wb, wbs);
        } else {
#pragma unroll
            for (int c = 0; c < 4; ++c) bf4_inv(e[4 * c], e[4 * c + 1], e[4 * c + 2], e[4 * c + 3], wb, wbs);
            bf4_inv(e[0], e[4], e[8], e[12], wa0, wa0s); bf4_inv(e[1], e[5], e[9], e[13], wa1, cmul(wa1, wa1));
            bf4_inv(e[2], e[6], e[10], e[14], wa2, cmul(wa2, wa2)); bf4_inv(e[3], e[7], e[11], e[15], wa3, cmul(wa3, wa3));
        }
#pragma unroll
        for (int k = 0; k < 16; ++k) st(el(k), e[k]);
    }
    __syncthreads();
}
template <int N, int M, bool INV, class LD, class ST>
__device__ __forceinline__ void fft_r4(const F2* T1, const F2* T2, int tid, LD& ld, ST& st) {
    constexpr int q4 = M / 4, sh = N / M, NB = N / 4, NI = (NB + NTH - 1) / NTH;
    auto body = [&](int it_) { const int idx = tid + it_ * NTH;
        const int blk = idx / q4, j = idx - blk * q4, p0 = blk * M + j, pp0 = hy_phys(p0);
        auto el = [&](int k) { if constexpr (q4 % 64 == 0) return pp0 + k * (q4 / 64 * 68); else if constexpr (M <= 64) return pp0 + k * q4; else return hy_phys(p0 + k * q4); };
        F2 x0 = ld(el(0), it_ * 4), x1 = ld(el(1), it_ * 4 + 1), x2 = ld(el(2), it_ * 4 + 2), x3 = ld(el(3), it_ * 4 + 3);
        const F2 w1 = twid(T1, T2, j * sh), w2 = cmul(w1, w1);
        if (!INV) bf4_fwd(x0, x1, x2, x3, w1, w2); else bf4_inv(x0, x1, x2, x3, w1, w2);
        st(el(0), x0, it_ * 4); st(el(1), x1, it_ * 4 + 1); st(el(2), x2, it_ * 4 + 2); st(el(3), x3, it_ * 4 + 3); };
    if constexpr (LD::REGS || ST::REGS) { static_assert(NI * 4 == 32 && NB % NTH == 0, "register-resident hook: 32 slots");
#pragma unroll
        for (int it_ = 0; it_ < NI; ++it_) { body(it_); SCHED_FENCE(); }
    } else {
#pragma unroll
        for (int it_ = 0; it_ < NI; ++it_) { if (NB % NTH != 0 && tid + it_ * NTH >= NB) break; body(it_); }
    }
    __syncthreads();
}
template <int N, class LD, class ST>
__device__ __forceinline__ void fft_r2(int tid, LD& ld, ST& st) {
#pragma unroll
    for (int it_ = 0; it_ < ((N >> 1) + NTH - 1) / NTH; ++it_) { const int idx = tid + it_ * NTH; if ((N >> 1) % NTH != 0 && idx >= (N >> 1)) break;
        const int pp = hy_phys(2 * idx); const F2 x0 = ld(pp), x1 = ld(pp + 1); st(pp, x0 + x1); st(pp + 1, x0 - x1); }
    __syncthreads();
}
template <int N, int M> struct FftFwd16 { template <class LD, class ST> static __device__ __forceinline__ void run(F2* X, const F2* T1, const F2* T2, int tid, LD& ld0, ST& stl) {
    LdsLd ldx{X}; LdsSt stx{X};
    if constexpr (M >= 16) {
        constexpr bool first = (M == N), last = (M / 16 <= 1);
        if constexpr (first && last) fft_r16<N, M, false>(T1, T2, tid, ld0, stl); else if constexpr (first) fft_r16<N, M, false>(T1, T2, tid, ld0, stx);
        else if constexpr (last) fft_r16<N, M, false>(T1, T2, tid, ldx, stl); else fft_r16<N, M, false>(T1, T2, tid, ldx, stx);
        if constexpr (!last) FftFwd16<N, M / 16>::run(X, T1, T2, tid, ld0, stl); }
    else if constexpr (M == 8) { fft_r4<N, 8, false>(T1, T2, tid, ldx, stx); fft_r2<N>(tid, ldx, stl); }
    else if constexpr (M == 4) { fft_r4<N, 4, false>(T1, T2, tid, ldx, stl); }
    else if constexpr (M == 2) { fft_r2<N>(tid, ldx, stl); } } };
template <int N, int M> struct FftInv16 { template <class LD, class ST> static __device__ __forceinline__ void run(F2* X, const F2* T1, const F2* T2, int tid, LD& ld0, ST& stl) {
    LdsLd ldx{X}; LdsSt stx{X};
    if constexpr (M >= 16) {
        constexpr bool last = (M == N), first = (M / 16 <= 1);
        if constexpr (!first) FftInv16<N, M / 16>::run(X, T1, T2, tid, ld0, stl);
        if constexpr (first && last) fft_r16<N, M, true>(T1, T2, tid, ld0, stl); else if constexpr (first) fft_r16<N, M, true>(T1, T2, tid, ld0, stx);
        else if constexpr (last) fft_r16<N, M, true>(T1, T2, tid, ldx, stl); else fft_r16<N, M, true>(T1, T2, tid, ldx, stx); }
    else if constexpr (M == 8) { fft_r2<N>(tid, ld0, stx); fft_r4<N, 8, true>(T1, T2, tid, ldx, stx); }
    else if constexpr (M == 4) { fft_r4<N, 4, true>(T1, T2, tid, ld0, stx); }
    else if constexpr (M == 2) { fft_r2<N>(tid, ld0, stx); } } };
template <int N, class LD, class ST> __device__ __forceinline__ void fft_fwd(F2* X, const F2* T1, const F2* T2, int tid, LD& ld0, ST& stl) { static_assert(N >= 32, "fft"); FftFwd16<N, N>::run(X, T1, T2, tid, ld0, stl); }
template <int N, class LD, class ST> __device__ __forceinline__ void fft_inv(F2* X, const F2* T1, const F2* T2, int tid, LD& ld0, ST& stl) { FftInv16<N, N>::run(X, T1, T2, tid, ld0, stl); }

template <bool ctxs>
__device__ __forceinline__ void hyena_item(const Params& p, char* lds, int l, int ch) {
    const int tid = TID(), bid = BID(), lane = tid & 63, wid = tid >> 6;
    constexpr int L = ctxs ? CTX : SEQ, N = 2 * L, k0 = ctxs ? SEQ : 0;
    F2* X = (F2*)(lds + HY_X); F2* T1 = (F2*)(lds + HY_T1); F2* T2 = (F2*)(lds + HY_T2); float* red = (float*)(lds + HY_RED);
    const bf16_t* HYT = WSP(bf16_t, OFF_HYT);
    F2* HF = WSP(F2, OFF_HF) + (long)bid * HY_XN; float* ZT = WSP(float, OFF_ZT) + (long)bid * 2 * SEQ; bf16_t* YAT = WSP(bf16_t, OFF_YAT);
    __syncthreads();
    if (tid < 128) { float s, c; float a = -6.283185307179586f * (float)(tid * 128) / (float)N; s = sinf(a); c = cosf(a); T1[tid] = (F2){c, s}; }
    else if (tid < 256) { int b_ = tid - 128; float s, c; float a = -6.283185307179586f * (float)b_ / (float)N; s = sinf(a); c = cosf(a); T2[b_] = (F2){c, s}; }
    __syncthreads();
    const float* cwp = GIN(p.hy_conv) + ((long)l * 3 * MW + ch) * 3;
    auto conv8 = [&](int seg, int b, int t0, float (&o8)[8]) { const bf16_t* r = HYT + ((long)b * 3 * MW + seg * MW + ch) * KEYS + k0 + t0;
        const U4 c = *(const U4*)r; const float vm = t0 > 0 ? bf2f(r[-1]) : 0.f, vp = t0 + 8 < L ? bf2f(r[8]) : 0.f;
        const float v[10] = {vm, bflo(c.x), bfhi(c.x), bflo(c.y), bfhi(c.y), bflo(c.z), bfhi(c.z), bflo(c.w), bfhi(c.w), vp};
        const float* wq = cwp + (long)seg * MW * 3; const F4 w = (F4){wq[0], wq[1], wq[2], 0.f};
#pragma unroll
        for (int j = 0; j < 8; ++j) o8[j] = v[j + 1] * w.y + v[j] * w.x + v[j + 2] * w.z; };
    constexpr int L8 = L / 8, NIT8 = (L8 + NTH - 1) / NTH;
    for (int o = 0; o < 2; ++o) {
        const bf16_t* tf = WSP(bf16_t, OFF_TAPS) + (long)(o * HYW + ch) * KEYS + k0; const bf16_t* tb = WSP(bf16_t, OFF_TAPS) + (long)(2 * HYW + o * HYW + ch) * KEYS + k0;
        const float sk = GIN(p.hy_skip)[((long)l * 2 + o) * HYW + ch];
        float nrm = 0.f;
#pragma unroll
        for (int it_ = 0; it_ < NIT8; ++it_) { const int i8 = tid + it_ * NTH; if (L8 % NTH != 0 && i8 >= L8) break; const int t0 = i8 * 8;
            const U4 fa = *(const U4*)(tf + t0), fb = *(const U4*)(tb + t0);
            const float af[8] = {bflo(fa.x), bfhi(fa.x), bflo(fa.y), bfhi(fa.y), bflo(fa.z), bfhi(fa.z), bflo(fa.w), bfhi(fa.w)};
            const float ab[8] = {bflo(fb.x), bfhi(fb.x), bflo(fb.y), bfhi(fb.y), bflo(fb.z), bfhi(fb.z), bflo(fb.w), bfhi(fb.w)};
#pragma unroll
            for (int j = 0; j < 4; ++j) *(F4*)(X + hy_phys(t0) + 2 * j) = (F4){af[2 * j], 0.f, af[2 * j + 1], 0.f};
#pragma unroll
            for (int j = 0; j < 8; ++j) { nrm += fabsf(af[j]);
                if (j == 0 && t0 == 0) X[hy_phys(L)] = (F2){0.f, 0.f}; else { X[hy_phys(N - t0 - j)] = (F2){ab[j], 0.f}; nrm += fabsf(ab[j]); } } }
        nrm = wave_sum(nrm);
        if (lane == 0) red[wid] = nrm;
        __syncthreads();
        constexpr bool HREG = (N == 16384);
        F2 hreg[20];
        if constexpr (HREG) { LdsLd ldx0{X}; HfRegSt sth{hreg, HF}; fft_fwd<N>(X, T1, T2, tid, ldx0, sth); }
        else { LdsLd ldx0{X}; HfGlbSt sth{HF}; fft_fwd<N>(X, T1, T2, tid, ldx0, sth); }
        auto zval8 = [&](int t0, float (&z0)[8], float (&z1)[8]) {
            if (o == 0) { conv8(0, 0, t0, z0); conv8(0, 1, t0, z1); }
            else { const F4 a0 = *(const F4*)(ZT + t0), a1 = *(const F4*)(ZT + t0 + 4), b0 = *(const F4*)(ZT + SEQ + t0), b1 = *(const F4*)(ZT + SEQ + t0 + 4);
                z0[0] = a0.x; z0[1] = a0.y; z0[2] = a0.z; z0[3] = a0.w; z0[4] = a1.x; z0[5] = a1.y; z0[6] = a1.z; z0[7] = a1.w;
                z1[0] = b0.x; z1[1] = b0.y; z1[2] = b0.z; z1[3] = b0.w; z1[4] = b1.x; z1[5] = b1.y; z1[6] = b1.z; z1[7] = b1.w; } };
        LdsSt stx{X}; LdsLd ldx{X};
#pragma unroll
        for (int it_ = 0; it_ < NIT8; ++it_) { const int i8 = tid + it_ * NTH; if (L8 % NTH != 0 && i8 >= L8) break; const int t0 = i8 * 8;
            float z0[8], z1[8]; zval8(t0, z0, z1);
            float zr = 0.f;
#ifndef CPU_EMU
            asm volatile("v_mov_b32 %0, 0" : "=v"(zr));
#endif
#pragma unroll
            for (int j = 0; j < 4; ++j) { *(F4*)(X + hy_phys(t0) + 2 * j) = (F4){z0[2 * j], z1[2 * j], z0[2 * j + 1], z1[2 * j + 1]}; *(F4*)(X + hy_phys(L + t0) + 2 * j) = (F4){zr, zr, zr, zr}; } }
        __syncthreads();
        fft_fwd<N>(X, T1, T2, tid, ldx, stx);
        float tot = 0.f;
#pragma unroll
        for (int w = 0; w < 8; ++w) tot += red[w];
        const float sc = 1.0f / (tot * (float)N);
        if constexpr (HREG) { HfRegLd ldm{X, hreg, HF}; fft_inv<N>(X, T1, T2, tid, ldm, stx); }
        else { HfGlbLd ldm{X, HF}; fft_inv<N>(X, T1, T2, tid, ldm, stx); }
#pragma unroll
        for (int it_ = 0; it_ < NIT8; ++it_) { const int i8 = tid + it_ * NTH; if (L8 % NTH != 0 && i8 >= L8) break; const int t0 = i8 * 8;
            float z0[8], z1[8], g0[8], g1[8], r0[8], r1[8]; zval8(t0, z0, z1); conv8(1 + o, 0, t0, g0); conv8(1 + o, 1, t0, g1);
#pragma unroll
            for (int j = 0; j < 4; ++j) { const F4 y = *(const F4*)(X + hy_phys(t0) + 2 * j);
                r0[2 * j] = g0[2 * j] * (y.x * sc + z0[2 * j] * sk); r1[2 * j] = g1[2 * j] * (y.y * sc + z1[2 * j] * sk);
                r0[2 * j + 1] = g0[2 * j + 1] * (y.z * sc + z0[2 * j + 1] * sk); r1[2 * j + 1] = g1[2 * j + 1] * (y.w * sc + z1[2 * j + 1] * sk); }
            if (o == 0) { *(F4*)(ZT + t0) = (F4){r0[0], r0[1], r0[2], r0[3]}; *(F4*)(ZT + t0 + 4) = (F4){r0[4], r0[5], r0[6], r0[7]};
                *(F4*)(ZT + SEQ + t0) = (F4){r1[0], r1[1], r1[2], r1[3]}; *(F4*)(ZT + SEQ + t0 + 4) = (F4){r1[4], r1[5], r1[6], r1[7]}; }
            else { *(U4*)(YAT + ((long)0 * MW + ch) * KEYS + k0 + t0) = (U4){pack2(r0[0], r0[1]), pack2(r0[2], r0[3]), pack2(r0[4], r0[5]), pack2(r0[6], r0[7])};
                *(U4*)(YAT + ((long)1 * MW + ch) * KEYS + k0 + t0) = (U4){pack2(r1[0], r1[1]), pack2(r1[2], r1[3]), pack2(r1[4], r1[5]), pack2(r1[6], r1[7])}; } }
        __syncthreads();
    }
}

__device__ __forceinline__ void phase_gdn_prep(const Params& p, char* lds, int l) {
    const int bid = BID(), G = gridDim.x;
    for (int rep_ = 0; rep_ < REP_GP; ++rep_) for (int it = bid; it < NTASK_GDN / 2; it += G) gdn_chunk_prep2(p, lds, l, it * 2);
}
__device__ __forceinline__ void phase_mixers(const Params& p, char* lds, int l, int qoff = 0, bool scans_only = false) {
    const int tid = TID();
    const bool ctx_out = l < DEPTH - 1;
    constexpr int NSCAN = BATCH * GH * 2, NQT_L = SEQ / 256, U_DL = BATCH * DH * NQT_L * 2, U_HY = MW, U_NA = BATCH * NH * (R_ROWS / 4);
    constexpr int NQC = CTX / 128, U_DC = BATCH * DH * NQC, U_NC = BATCH * NH * NQC, U_HC = MW;
    constexpr int U_CV8 = (U_CVT + 7) / 8, U_W3 = (4 * HYW * 128 + 8191) / 8192, U_H2 = (KEYS + 63) / 64;
    const int e0 = NSCAN * REP_GS, e1 = e0 + U_DL * REP_DIFF, e2 = e1 + U_HY * REP_HY, e3 = e2 + U_NA * REP_NA, e4 = e3 + (ctx_out ? U_DC : 0), e5 = e4 + (ctx_out ? U_NC : 0), e6 = e5 + (ctx_out ? U_HC : 0), e7 = e6 + (ctx_out ? U_CV8 : 0), e8 = e7 + (ctx_out ? U_W3 : 0), e9 = e8 + (ctx_out ? U_H2 : 0);
    u32* qctr = WSP(u32, OFF_CNT) + 64 + qoff + l;
    int* qs = (int*)(lds + LDS_BYTES - 16);
    for (;;) {
        __syncthreads();
        if (tid == 0) qs[0] = (int)atomicAdd(qctr, 1u);
        __syncthreads();
        const int u = qs[0];
        if (u >= (scans_only ? e0 : e9)) break;
        if (u < e0) gdn_scan_item(p, lds, l, u % NSCAN);
        else if (u < e1) { int v = (u - e0) % U_DL; const int comp = v & 1; v >>= 1; int b = v / (DH * NQT_L), r = v - b * DH * NQT_L, h = r / NQT_L, qt = r - h * NQT_L; diff32_item(p, lds, l, b, h, qt * 256, comp); }
        else if (u < e2) hyena_item<false>(p, lds, l, (u - e1) % U_HY);
        else if (u < e3) { int v = (u - e2) % U_NA; int b = v / (NH * (R_ROWS / 4)), r = v - b * NH * (R_ROWS / 4), h = r / (R_ROWS / 4), rq = r - h * (R_ROWS / 4); na32_item(p, lds, l, b, h, rq); }
        else if (u < e4) { int v = u - e3; int b = v / (DH * NQC), r = v - b * DH * NQC, h = r / NQC, q = r - h * NQC; diff_attn_item<1>(p, lds, l, b, h, q * 128, true); }
        else if (u < e5) { int v = u - e4; int b = v / (NH * NQC), r = v - b * NH * NQC, h = r / NQC, q = r - h * NQC; na_ctx_item(p, lds, b, h, q * 128); }
        else if (u < e6) hyena_item<true>(p, lds, l, u - e5);
        else if (u < e7) { const int c0 = (u - e6) * 8; for (int q = c0; q < c0 + 8 && q < U_CVT; ++q) cvt_unit(p, lds, l + 1, q); }
        else if (u < e8) w3t_chunk(p, l + 1, (u - e7) * 8192, 8192);
        else h2f_positions(p, l + 1, (u - e8) * 64, 8);
    }
}

__device__ __forceinline__ void phase_finish(const Params& p, char* lds, int l) {
    const int tid = TID(), bid = BID(), G = gridDim.x, lane = tid & 63, wid = tid >> 6;
    bf16_t* Y = WSP(bf16_t, OFF_Y);
    { const bf16_t* OFp = WSP(bf16_t, OFF_OF); const bf16_t* OBp = WSP(bf16_t, OFF_OB); const bf16_t* GZ = WSP(bf16_t, OFF_GZ); const float nw = GIN(p.gdn_norm)[l * 64 + lane];
        const long NR = (long)NTOK * GH, st8 = (long)G * 8;
        for (long i = (long)bid * 8 + wid; i < NR; i += 2 * st8) { const long i2 = i + st8; const bool two = i2 < NR;
            const long tokA = i / GH, tokB = two ? i2 / GH : tokA; const int hA = (int)(i - tokA * GH), hB = two ? (int)(i2 - tokB * GH) : hA;
            const long oA = tokA * MW + hA * 64 + lane, oB = tokB * MW + hB * 64 + lane;
            const float vA = bf2f(OFp[oA]) + bf2f(OBp[oA]), vB = bf2f(OFp[oB]) + bf2f(OBp[oB]);
            const float zA = bf2f(GZ[oA]), zB = bf2f(GZ[oB]);
            float sA = vA * vA, sB = vB * vB;
            sA = xadd<32>(sA); sB = xadd<32>(sB); sA = xadd<16>(sA); sB = xadd<16>(sB); sA = xadd<8>(sA); sB = xadd<8>(sB); sA = xadd<4>(sA); sB = xadd<4>(sB); sA = xadd<2>(sA); sB = xadd<2>(sB); sA = xadd<1>(sA); sB = xadd<1>(sB);
            Y[tokA * 4 * MW + MW + hA * 64 + lane] = f2bf(vA * rsqrtf(sA * (1.0f / 64.0f) + RMS_EPS) * nw * siluf(zA));
            if (two) Y[tokB * 4 * MW + MW + hB * 64 + lane] = f2bf(vB * rsqrtf(sB * (1.0f / 64.0f) + RMS_EPS) * nw * siluf(zB)); } }
    { const bf16_t* YAT = WSP(bf16_t, OFF_YAT); bf16_t* t = (bf16_t*)lds;
        constexpr int KT_ = KEYS / 64, CT_ = MW / 128;
        float lam, lam_init; diff_lambda(p, l, lam, lam_init);
        const float* nw = GIN(p.diff_norm) + l * 128;
        for (int u = bid; u < BATCH * CT_ * KT_; u += G) { int b = u / (CT_ * KT_), r = u - b * CT_ * KT_, ct = r / KT_, kt = r - ct * KT_;
            __syncthreads();
#pragma unroll
            for (int q = 0; q < 2; ++q) { int c = (tid >> 3) + 64 * q, s = tid & 7; *(U4*)(t + c * 72 + s * 8) = *(const U4*)(YAT + ((long)b * MW + ct * 128 + c) * KEYS + kt * 64 + s * 8); }
            if (kt * 64 < SEQ) {
                const int k = tid >> 3, sub = tid & 7; const long tok = bk_tok(b, kt * 64 + k); bf16_t* yr = Y + tok * 4 * MW;
                const U4 a0 = *(const U4*)(yr + 2 * MW + ct * 128 + sub * 16), a1 = *(const U4*)(yr + 2 * MW + ct * 128 + sub * 16 + 8), b0 = *(const U4*)(yr + ct * 128 + sub * 16), b1 = *(const U4*)(yr + ct * 128 + sub * 16 + 8);
                const u32 aw[8] = {a0.x, a0.y, a0.z, a0.w, a1.x, a1.y, a1.z, a1.w}, bw[8] = {b0.x, b0.y, b0.z, b0.w, b1.x, b1.y, b1.z, b1.w};
                float v[16]; float ss = 0.f;
#pragma unroll
                for (int e = 0; e < 8; ++e) { v[2 * e] = bflo(aw[e]) - lam * bflo(bw[e]); v[2 * e + 1] = bfhi(aw[e]) - lam * bfhi(bw[e]); ss += v[2 * e] * v[2 * e] + v[2 * e + 1] * v[2 * e + 1]; }
                ss = xadd<1>(ss); ss = xadd<2>(ss); ss = xadd<4>(ss);
                const float rr = rsqrtf(ss * (1.0f / 128.0f) + RMS_EPS) * (1.0f - lam_init);
                u32 o[8];
#pragma unroll
                for (int e = 0; e < 8; ++e) o[e] = pack2(v[2 * e] * rr * nw[sub * 16 + 2 * e], v[2 * e + 1] * rr * nw[sub * 16 + 2 * e + 1]);
                *(U4*)(yr + 2 * MW + ct * 128 + sub * 16) = (U4){o[0], o[1], o[2], o[3]}; *(U4*)(yr + 2 * MW + ct * 128 + sub * 16 + 8) = (U4){o[4], o[5], o[6], o[7]};
            }
            __syncthreads();
            { int k = tid >> 3; long tok = bk_tok(b, kt * 64 + k);
#pragma unroll
                for (int q = 0; q < 2; ++q) { const int c8 = (tid & 7) * 8 + 64 * q;
                    U4 o; o.x = (u32)t[(c8 + 0) * 72 + k] | ((u32)t[(c8 + 1) * 72 + k] << 16); o.y = (u32)t[(c8 + 2) * 72 + k] | ((u32)t[(c8 + 3) * 72 + k] << 16);
                    o.z = (u32)t[(c8 + 4) * 72 + k] | ((u32)t[(c8 + 5) * 72 + k] << 16); o.w = (u32)t[(c8 + 6) * 72 + k] | ((u32)t[(c8 + 7) * 72 + k] << 16);
                    *(U4*)(Y + tok * 4 * MW + ct * 128 + c8) = o; } } } }
}
__device__ __forceinline__ bool xcd_unit(int bid, int G, int i, int ntm, int ntn, int& tm, int& tn) {
    if ((G & 7) == 0) { const int x = bid & 7, v = i * (G >> 3) + (bid >> 3); tm = (v / ntn) * 8 + x; tn = v - (v / ntn) * ntn; return tm < ntm; }
    const int u = bid + i * G; tn = u / ntm; tm = u - tn * ntm; return u < ntm * ntn;
}
struct Merge1Prov {
    static constexpr int MT = 3, BM1 = 64 * MT, ntm = NTOK / BM1, ntn = D / G_BN;
    const bf16_t *Y, *BP, *GATE; bf16_t* MIXG; int bid, G; U2 tot[MT][4];
    __device__ __forceinline__ void tile(int i, int& row0, int& col0, int& br) const { int tm, tn; xcd_unit(bid, G, i >> 2, ntm, ntn, tm, tn); br = i & 3; row0 = tm * BM1; col0 = tn * G_BN; }
    __device__ __forceinline__ bool valid(int i) const { int tm, tn; return xcd_unit(bid, G, i >> 2, ntm, ntn, tm, tn); }
    __device__ __forceinline__ const bf16_t* arow(int i, int r) const { int row0, col0, br; tile(i, row0, col0, br); return Y + (long)(row0 + r) * 4 * MW + br * MW; }
    __device__ __forceinline__ const bf16_t* bbase(int i) const { int row0, col0, br; tile(i, row0, col0, br); return BP + (long)col0 * 4 * MW + br * MW; }
    U2 gpre[MT][4];
    __device__ __forceinline__ void pre(int i) { int row0, col0, br; tile(i, row0, col0, br);
        const int tid = TID(), wid = tid >> 6, lane = tid & 63, wm = wid >> 1, wn = wid & 1, l15 = lane & 15, g = lane >> 4;
#pragma unroll
        for (int m = 0; m < MT; ++m)
#pragma unroll
            for (int n = 0; n < 4; ++n) gpre[m][n] = *(const U2*)(GATE + ((((long)((row0 / BM1) * ntn + col0 / G_BN) * 4 + br) * 8 + wid) * 12 + (m * 4 + n)) * 256 + lane * 4);
        (void)wm; (void)wn; (void)l15; (void)g; }
    __device__ __forceinline__ void epi(int i, const f32x4 (&acc)[MT][4]) { int row0, col0, br; tile(i, row0, col0, br);
        const int tid = TID(), wid = tid >> 6, lane = tid & 63, wm = wid >> 1, wn = wid & 1, l15 = lane & 15, g = lane >> 4;
#pragma unroll
        for (int m = 0; m < MT; ++m) { const long row = row0 + wm * 16 * MT + m * 16 + l15;
#pragma unroll
            for (int n = 0; n < 4; ++n) { const U2 gv = gpre[m][n];
                const U2 tp = tot[m][n];
                f32x4 t = br == 0 ? (f32x4){0.f, 0.f, 0.f, 0.f} : (f32x4){bflo(tp.x), bfhi(tp.x), bflo(tp.y), bfhi(tp.y)};
                t[0] += sigmoidf(bflo(gv.x)) * acc[m][n][0]; t[1] += sigmoidf(bfhi(gv.x)) * acc[m][n][1]; t[2] += sigmoidf(bflo(gv.y)) * acc[m][n][2]; t[3] += sigmoidf(bfhi(gv.y)) * acc[m][n][3];
                const U2 o = (U2){pack2(t[0], t[1]), pack2(t[2], t[3])};
                tot[m][n] = o;
                if (br == 3) *(U2*)(MIXG + row * D + col0 + wn * 64 + n * 16 + g * 4) = o; } } }
};
#ifdef PROBE_G1
struct Merge1Dry : Merge1Prov { bool fire; __device__ __forceinline__ void epi(int i, const f32x4 (&acc)[MT][4]) { if (fire) Merge1Prov::epi(i, acc); }
#ifdef PROBE_G1NP
    __device__ __forceinline__ void pre(int i) { if (fire) Merge1Prov::pre(i); }
#endif
};
#endif
__device__ __forceinline__ void phase_merge1(const Params& p, char* lds, int l) {
    Merge1Prov pv; pv.Y = WSP(bf16_t, OFF_Y); pv.BP = WSP(bf16_t, off_bp(l)); pv.GATE = WSP(bf16_t, OFF_SEG_GATE); pv.MIXG = WSP(bf16_t, OFF_MIXG);
    pv.bid = BID(); pv.G = (int)gridDim.x;
    gemm_stream<Merge1Prov::MT>(lds, pv, 4 * MW, MW);
#ifdef PROBE_G1
    { Merge1Dry pd; pd.Y = pv.Y; pd.BP = pv.BP; pd.GATE = pv.GATE; pd.MIXG = pv.MIXG; pd.bid = pv.bid; pd.G = pv.G; pd.fire = p.stop_phase == 123456;
      for (int r_ = 0; r_ < 2; ++r_) gemm_stream<Merge1Prov::MT, Merge1Dry, PROBE_G1>(lds, pd, 4 * MW, MW); }
#endif
}
struct Merge2Prov {
    static constexpr int MT = 3, BM1 = 64 * MT, ntm = NTOK / BM1, ntn = D / G_BN;
    const bf16_t *MIXG, *WO; bf16_t* MIX; int bid, G;
    __device__ __forceinline__ void pre(int) const {}
    __device__ __forceinline__ void tile(int i, int& row0, int& col0) const { int tm, tn; xcd_unit(bid, G, i, ntm, ntn, tm, tn); row0 = tm * BM1; col0 = tn * G_BN; }
    __device__ __forceinline__ bool valid(int i) const { int tm, tn; return xcd_unit(bid, G, i, ntm, ntn, tm, tn); }
    __device__ __forceinline__ const bf16_t* arow(int i, int r) const { int row0, col0; tile(i, row0, col0); return MIXG + (long)(row0 + r) * D; }
    __device__ __forceinline__ const bf16_t* bbase(int i) const { int row0, col0; tile(i, row0, col0); return WO + (long)col0 * D; }
    __device__ __forceinline__ void epi(int i, const f32x4 (&acc)[MT][4]) const { int row0, col0; tile(i, row0, col0);
        const int tid = TID(), wid = tid >> 6, lane = tid & 63, wm = wid >> 1, wn = wid & 1, l15 = lane & 15, g = lane >> 4;
#pragma unroll
        for (int m = 0; m < MT; ++m) { const long row = row0 + wm * 16 * MT + m * 16 + l15;
#pragma unroll
            for (int n = 0; n < 4; ++n) st4bf(MIX + row * D + col0 + wn * 64 + n * 16 + g * 4, acc[m][n]); } }
};
#ifdef PROBE_G2
struct Merge2Dry : Merge2Prov { bool fire; __device__ __forceinline__ void epi(int i, const f32x4 (&acc)[MT][4]) const { if (fire) Merge2Prov::epi(i, acc); } };
#endif
__device__ __forceinline__ void phase_merge2(const Params& p, char* lds, int l) {
    Merge2Prov pv; pv.MIXG = WSP(bf16_t, OFF_MIXG); pv.WO = WSP(bf16_t, off_wo(l)); pv.MIX = WSP(bf16_t, OFF_MIX);
    pv.bid = BID(); pv.G = (int)gridDim.x;
    gemm_stream<Merge2Prov::MT>(lds, pv, D, D);
#ifdef PROBE_G2
    { Merge2Dry pd; pd.MIXG = pv.MIXG; pd.WO = pv.WO; pd.MIX = pv.MIX; pd.bid = pv.bid; pd.G = pv.G; pd.fire = p.stop_phase == 123456;
#ifdef PROBE_G2H
      for (int r_ = 0; r_ < 8; ++r_) gemm_stream<Merge2Prov::MT, Merge2Dry, PROBE_G2>(lds, pd, D, D / 2); }
#else
      for (int r_ = 0; r_ < 4; ++r_) gemm_stream<Merge2Prov::MT, Merge2Dry, PROBE_G2>(lds, pd, D, D); }
#endif
#endif
}
struct MoeMap { int cnt[NE], off[NE], tile0[NE + 1]; };
__device__ __forceinline__ void moe_map_load(const Params& p, int* sm  ) {
    const int tid = TID();
    __syncthreads();
    if (tid == 0) { const u32* CNT = WSP(u32, OFF_CNT); int o = 0, t = 0;
        for (int e = 0; e < NE; ++e) { int c = (int)CNT[e]; sm[e] = c; sm[NE + e] = o; sm[2 * NE + e] = t; o += c; t += (c + G_BM - 1) / G_BM; }
        sm[3 * NE] = t; }
    __syncthreads();
}
struct MoeProvBase {
    const int* sm; int bid, G, ntile, ntn;
    __device__ __forceinline__ void pre(int) const {}
    __device__ __forceinline__ bool valid(int i) const { int tg, tn; return xcd_unit(bid, G, i, ntile, ntn, tg, tn); }
    __device__ __forceinline__ void unit(int i, int& e, int& tn, int& r0, int& nrow, long& orow0) const { int tg; xcd_unit(bid, G, i, ntile, ntn, tg, tn);
        e = 0;
#pragma unroll
        for (int q = 1; q < NE; ++q) if (tg >= sm[2 * NE + q]) e = q;
        const int mt = tg - sm[2 * NE + e], cnt = sm[e]; r0 = mt * G_BM; nrow = cnt - r0 < G_BM ? cnt - r0 : G_BM; orow0 = (long)sm[NE + e] + r0; }
};
struct Moe1Prov : MoeProvBase {
    const bf16_t *H, *W13; bf16_t* HMID; const int* ELIST;
    __device__ __forceinline__ const bf16_t* arow(int i, int r) const { int e, tn, r0, nrow; long orow0; unit(i, e, tn, r0, nrow, orow0); const int rr = r < nrow ? r0 + r : r0; return H + (long)ELIST[(long)e * NTOK + rr] * D; }
    __device__ __forceinline__ const bf16_t* bbase(int i) const { int e, tn, r0, nrow; long orow0; unit(i, e, tn, r0, nrow, orow0); return W13 + ((long)e * 2 * EFF + tn * G_BN) * D; }
    __device__ __forceinline__ void epi(int i, const f32x4 (&acc)[4][4]) const { int e, tn, r0, nrow; long orow0; unit(i, e, tn, r0, nrow, orow0);
        const int tid = TID(), wid = tid >> 6, lane = tid & 63, wm = wid >> 1, wn = wid & 1, l15 = lane & 15, g = lane >> 4;
#pragma unroll
        for (int m = 0; m < 4; ++m) { const int r = wm * 64 + m * 16 + l15;
            if (r < nrow) {
#pragma unroll
                for (int n2 = 0; n2 < 2; ++n2) { f32x4 a = acc[m][2 * n2], b = acc[m][2 * n2 + 1], hmid;
#pragma unroll
                    for (int j = 0; j < 4; ++j) hmid[j] = siluf(a[j]) * b[j];
                    st4bf(HMID + (orow0 + r) * EFF + tn * (G_BN / 2) + wn * 32 + n2 * 16 + g * 4, hmid); } } } }
};
struct Moe2Prov : MoeProvBase {
    const bf16_t *HMID, *W2; bf16_t* YE;
    __device__ __forceinline__ const bf16_t* arow(int i, int r) const { int e, tn, r0, nrow; long orow0; unit(i, e, tn, r0, nrow, orow0); return HMID + (orow0 + r) * EFF; }
    __device__ __forceinline__ const bf16_t* bbase(int i) const { int e, tn, r0, nrow; long orow0; unit(i, e, tn, r0, nrow, orow0); return W2 + ((long)e * D + tn * G_BN) * EFF; }
    __device__ __forceinline__ void epi(int i, const f32x4 (&acc)[4][4]) const { int e, tn, r0, nrow; long orow0; unit(i, e, tn, r0, nrow, orow0);
        const int tid = TID(), wid = tid >> 6, lane = tid & 63, wm = wid >> 1, wn = wid & 1, l15 = lane & 15, g = lane >> 4;
#pragma unroll
        for (int m = 0; m < 4; ++m) { const int r = wm * 64 + m * 16 + l15;
            if (r < nrow) {
#pragma unroll
                for (int n = 0; n < 4; ++n) st4bf(YE + (orow0 + r) * D + tn * G_BN + wn * 64 + n * 16 + g * 4, acc[m][n]); } } }
};
#ifdef PROBE_M1
struct Moe1Dry : Moe1Prov { bool fire; __device__ __forceinline__ void epi(int i, const f32x4 (&acc)[4][4]) const { if (fire) Moe1Prov::epi(i, acc); } };
#endif
__device__ __forceinline__ void phase_moe1(const Params& p, char* lds, int l) {
    int* sm = (int*)(lds + G_LDS);
    moe_map_load(p, sm);
    Moe1Prov pv; pv.sm = sm; pv.bid = BID(); pv.G = (int)gridDim.x; pv.ntile = sm[3 * NE]; pv.ntn = 2 * EFF / G_BN;
    pv.H = WSP(bf16_t, OFF_H); pv.W13 = WSP(bf16_t, OFF_W13); pv.HMID = WSP(bf16_t, OFF_HMID); pv.ELIST = WSP(int, OFF_ELIST);
    gemm_stream<4>(lds, pv, D, D);
#ifdef PROBE_M1
    { Moe1Dry pd; pd.sm = pv.sm; pd.bid = pv.bid; pd.G = pv.G; pd.ntile = pv.ntile; pd.ntn = pv.ntn; pd.H = pv.H; pd.W13 = pv.W13; pd.HMID = pv.HMID; pd.ELIST = pv.ELIST; pd.fire = p.stop_phase == 123456;
      for (int r_ = 0; r_ < 2; ++r_) gemm_stream<4, Moe1Dry, PROBE_M1>(lds, pd, D, D); }
#endif
}
#ifdef PROBE_M2
struct Moe2Dry : Moe2Prov { bool fire; __device__ __forceinline__ void epi(int i, const f32x4 (&acc)[4][4]) const { if (fire) Moe2Prov::epi(i, acc); } };
#endif
__device__ __forceinline__ void phase_moe2(const Params& p, char* lds, int l) {
    int* sm = (int*)(lds + G_LDS);
    moe_map_load(p, sm);
    Moe2Prov pv; pv.sm = sm; pv.bid = BID(); pv.G = (int)gridDim.x; pv.ntile = sm[3 * NE]; pv.ntn = D / G_BN;
    pv.HMID = WSP(bf16_t, OFF_HMID); pv.W2 = WSP(bf16_t, OFF_W2); pv.YE = WSP(bf16_t, OFF_YE);
    gemm_stream<4>(lds, pv, EFF, EFF);
#ifdef PROBE_M2
    { Moe2Dry pd; pd.sm = pv.sm; pd.bid = pv.bid; pd.G = pv.G; pd.ntile = pv.ntile; pd.ntn = pv.ntn; pd.HMID = pv.HMID; pd.W2 = pv.W2; pd.YE = pv.YE; pd.fire = p.stop_phase == 123456;
      for (int r_ = 0; r_ < 2; ++r_) gemm_stream<4, Moe2Dry, PROBE_M2>(lds, pd, EFF, EFF); }
#endif
}
#ifdef PROBE_BAR
#define PHASE_END(id) do { GSYNC(); GSYNC(); if (p.stop_phase == (id)) return; } while (0)
#else
#define PHASE_END(id) do { GSYNC(); if (p.stop_phase == (id)) return; } while (0)
#endif

#if defined(CPU_EMU) || !defined(KARG_LAUNDER)
#define PP p_in
#else
__device__ __forceinline__ const Params& launder_params(const Params* q) { asm volatile("" : "+s"(q)); return *q; }
#define PP launder_params(kargs)
#endif
__global__ void __launch_bounds__(NTH, 2) fwd_kernel(Params p_in) {
#ifdef CPU_EMU
    char* lds = emu_lds();
    const Params& p = p_in;
#else
#ifdef KARG_LAUNDER
    const Params* kargs = (const Params*)__builtin_amdgcn_kernarg_segment_ptr();
    const Params& p = *kargs;
#else
    const Params& p = p_in;
#endif
    extern __shared__ __attribute__((aligned(16))) char lds_raw[];
    char* lds = lds_raw + 16;
    if (threadIdx.x == 0) *(uint4*)lds_raw = make_uint4(0u, 0u, 0u, 0u);
    __syncthreads();
    XcdBarrier xbar = xcd_barrier_post((unsigned*)(p.ws + OFF_BAR), (volatile LAS unsigned*)lds_raw);
#endif
#ifdef CPU_EMU
    if (threadIdx.x < 32) ((const float**)(lds + LDS_TBL_OFF))[threadIdx.x] = ((const float* const*)&p_in)[threadIdx.x];
#else
    if (threadIdx.x < 32) ((const float**)(lds + LDS_TBL_OFF))[threadIdx.x] = *(const float* const*)((const char*)__builtin_amdgcn_kernarg_segment_ptr() + threadIdx.x * 8);
#endif
    __syncthreads();
    phase_prologue(PP, lds);
    PHASE_END(1);
    for (int l = 0; l < DEPTH; ++l) {
        const int pb = 100 * (l + 1);
        if (l == 0) { phase_weights(PP, lds, l); PHASE_END(pb + 0); }
        if (l == 0) { phase_modulate0(PP, l); PHASE_END(pb + 1); }
        for (int rep_ = 0; rep_ < REP_IP; ++rep_) phase_inproj(PP, lds, l, 0);
        PHASE_END(pb + 2);
        phase_prep(PP, lds, l);
#ifdef PROBE_PREP
        phase_prep(PP, lds, l, false, PROBE_PREP & 1, PROBE_PREP & 2);
#endif
        PHASE_END(pb + 3);
        phase_gdn_prep(PP, lds, l);
        PHASE_END(pb + 4);
        phase_mixers(PP, lds, l);
#ifdef PROBE_P5
        GSYNC();
        phase_mixers(PP, lds, l, 16, PROBE_P5 == 2);
#endif
        PHASE_END(pb + 5);
        for (int rep_ = 0; rep_ < REP_FIN; ++rep_) phase_finish(PP, lds, l);
        PHASE_END(pb + 6);
        for (int rep_ = 0; rep_ < REP_IP; ++rep_) phase_inproj(PP, lds, l, 1);
        PHASE_END(pb + 7);
        for (int rep_ = 0; rep_ < REP_MG; ++rep_) phase_merge1(PP, lds, l);
        PHASE_END(pb + 8);
        for (int rep_ = 0; rep_ < REP_MG; ++rep_) phase_merge2(PP, lds, l);
        PHASE_END(pb + 9);
#ifdef PROBE_PM
        phase_post_mix(PP, lds, l, true);
#endif
        phase_post_mix(PP, lds, l);
        PHASE_END(pb + 10);
        for (int rep_ = 0; rep_ < REP_MOE; ++rep_) phase_moe1(PP, lds, l);
        PHASE_END(pb + 11);
        for (int rep_ = 0; rep_ < REP_MOE; ++rep_) phase_moe2(PP, lds, l);
        PHASE_END(pb + 12);
#ifdef PROBE_PE
        phase_post_moe(PP, l, true);
#endif
        phase_post_moe(PP, l);
        PHASE_END(pb + 13);
    }
}

extern "C" void kernel_launch(void* const* d_in, const int* in_sizes, int n_in, void* d_out, int out_size, void* d_ws, size_t ws_size, hipStream_t stream) {
    (void)in_sizes; (void)n_in; (void)out_size;
    if (ws_size < WS_NEED) return;
    Params p;
    memset(&p, 0, sizeof(p));
    const float** pp = (const float**)&p;
    for (int i = 0; i < 32; ++i) pp[i] = (const float*)d_in[i];
    p.out = (float*)d_out; p.ws = (char*)d_ws; p.stop_phase = -1;
#ifdef CPU_EMU
    { const char* sp = getenv("EMU_STOP"); if (sp) p.stop_phase = atoi(sp); }
    memset(d_ws, 0, SZ_BAR);
    int grid = 4; { const char* g = getenv("EMU_GRID"); if (g) grid = atoi(g); }
    emu_launch([](void* a) { fwd_kernel(*(Params*)a); }, &p, grid, NTH, LDS_BYTES);
#else
    static int grid = 0;
    if (!grid) {
        int dev = 0, cus = 0, per_cu = 0;
        (void)hipGetDevice(&dev);
        (void)hipDeviceGetAttribute(&cus, hipDeviceAttributeMultiprocessorCount, dev);
        (void)hipFuncSetAttribute((const void*)fwd_kernel, hipFuncAttributeMaxDynamicSharedMemorySize, LDS_BYTES + 16);
        (void)hipOccupancyMaxActiveBlocksPerMultiprocessor(&per_cu, (const void*)fwd_kernel, NTH, LDS_BYTES + 16);
        grid = per_cu >= 1 ? cus : 0;
        if (grid > GRID_MAX) grid = GRID_MAX;
    }
    if (!grid) return;
    (void)hipMemsetAsync(d_ws, 0, SZ_BAR, stream);
    hipLaunchKernelGGL(fwd_kernel, dim3(grid), dim3(NTH), LDS_BYTES + 16, stream, p);
#endif
}
```
